# Optimizing an MI355X kernel written in HIP

```python
import jax, jax.numpy as jnp
from jax import lax
import numpy as np

D_MODEL = 1024
BATCH = 16
SEQ = 2048
DEPTH = 1

RWKV_HEADS = 8
RWKV_HEAD_DIM = 64
RWKV_WIDTH = RWKV_HEADS * RWKV_HEAD_DIM
DECAY_LORA = 64
ICLR_LORA = 64
GATE_LORA = 160
RWKV_GN_EPS = 64e-5
L2_EPS = 1e-12
ATT_HEADS = 8
ATT_HEAD_DIM = 64
ATT_WIDTH = ATT_HEADS * ATT_HEAD_DIM
IDX_HEADS = 8
IDX_DIM = 64
TOPK_MAX = 256
Q_BLOCK = 128
ROPE_THETA = 10000.0
N_BRANCH = 2
BRANCH_WIDTH = RWKV_WIDTH
FFN_HIDDEN = 4 * D_MODEL
NORM_EPS = 1e-6

RWKV_IN_SIZES = (RWKV_WIDTH, RWKV_WIDTH, RWKV_WIDTH, DECAY_LORA, ICLR_LORA, GATE_LORA)
RWKV_IN = 3 * RWKV_WIDTH + DECAY_LORA + ICLR_LORA + GATE_LORA
DSA_IN_SIZES = (ATT_WIDTH, ATT_HEAD_DIM, ATT_HEAD_DIM, IDX_HEADS * IDX_DIM, IDX_DIM, IDX_HEADS)
DSA_IN = ATT_WIDTH + 2 * ATT_HEAD_DIM + IDX_HEADS * IDX_DIM + IDX_DIM + IDX_HEADS
GATE_IN = N_BRANCH * D_MODEL
N_IN = RWKV_IN + DSA_IN + GATE_IN

kernel_name = "hybrid_rwkv7_dsa_gated_block"


def split_cols(z, sizes):
    idx = np.cumsum(sizes)[:-1].tolist()
    return jnp.split(z, idx, axis=-1)


def rms_norm(x, g):
    xf = x.astype(jnp.float32)
    y = xf * lax.rsqrt(jnp.mean(xf * xf, axis=-1, keepdims=True) + NORM_EPS)
    return (y * g.astype(jnp.float32)).astype(x.dtype)


def rope_tables(T, d):
    inv = 1.0 / (ROPE_THETA ** (jnp.arange(0, d, 2, dtype=jnp.float32) / d))
    ang = jnp.arange(T, dtype=jnp.float32)[:, None] * inv[None, :]
    return jnp.cos(ang), jnp.sin(ang)


def apply_rope(x, cos, sin):
    d2 = x.shape[-1] // 2
    shape = (1, x.shape[1]) + (1,) * (x.ndim - 3) + (d2,)
    c = cos.reshape(shape)
    s = sin.reshape(shape)
    xf = x.astype(jnp.float32)
    x1, x2 = xf[..., :d2], xf[..., d2:]
    return jnp.concatenate([x1 * c - x2 * s, x2 * c + x1 * s], axis=-1).astype(x.dtype)


def token_shift(z, mu):
    prev = jnp.pad(z[:, :-1], ((0, 0), (1, 0), (0, 0)))
    return z + (prev - z) * mu


def rwkv7_mix(z, mu, decay_bias, w_decay_up, iclr_bias, w_iclr_up, w_gate_up,
              k_k, k_a, r_k, gn_w, gn_b):
    B, T, _ = z.shape
    H, N = RWKV_HEADS, RWKV_HEAD_DIM
    f32 = jnp.float32
    z = token_shift(z, mu)
    r, k, v, wd, ad, gd = split_cols(z, RWKV_IN_SIZES)
    w_log = -jax.nn.softplus(-(decay_bias + jnp.tanh(wd) @ w_decay_up)) - 0.5
    decay = jnp.exp(-jnp.exp(w_log.astype(f32)))
    iclr = jax.nn.sigmoid(iclr_bias + ad @ w_iclr_up)
    gate = jax.nn.sigmoid(gd) @ w_gate_up
    heads = lambda t: t.reshape(B, T, H, N).astype(f32)
    kk = heads(k * k_k)
    kk = kk / jnp.maximum(jnp.sqrt(jnp.sum(kk * kk, axis=-1, keepdims=True)), L2_EPS)
    k = k * (1.0 + (iclr - 1.0) * k_a)
    r_h, k_h, v_h, w_h, a_h = heads(r), heads(k), heads(v), heads(decay), heads(iclr)
    a_vec = -kk
    b_vec = kk * a_h

    def step(S, inp):
        r_t, w_t, k_t, v_t, a_t, b_t = inp
        sa = jnp.einsum('bhvk,bhk->bhv', S, a_t)
        S = (S * w_t[:, :, None, :] + sa[..., None] * b_t[:, :, None, :]
             + v_t[..., None] * k_t[:, :, None, :])
        return S, jnp.einsum('bhvk,bhk->bhv', S, r_t)

    tm = lambda t: jnp.moveaxis(t, 1, 0)
    S0 = jnp.zeros((B, H, N, N), f32)
    _, y = lax.scan(step, S0, (tm(r_h), tm(w_h), tm(k_h), tm(v_h), tm(a_vec), tm(b_vec)))
    y = jnp.moveaxis(y, 0, 1)
    mean = jnp.mean(y, axis=-1, keepdims=True)
    var = jnp.mean(jnp.square(y - mean), axis=-1, keepdims=True)
    y = ((y - mean) * lax.rsqrt(var + RWKV_GN_EPS) * gn_w.astype(f32).reshape(H, N)
         + gn_b.astype(f32).reshape(H, N))
    bonus = jnp.sum(r_h * k_h * r_k.astype(f32).reshape(H, N), axis=-1, keepdims=True) * v_h
    y = (y + bonus).reshape(B, T, RWKV_WIDTH)
    return (y * gate).astype(z.dtype)


def dsa_mix(z, cos, sin):
    B, T, _ = z.shape
    f32 = jnp.float32
    q, k, v, qi, ki, wi = split_cols(z, DSA_IN_SIZES)
    q = apply_rope(q.reshape(B, T, ATT_HEADS, ATT_HEAD_DIM), cos, sin)
    k = apply_rope(k, cos, sin)
    qi = apply_rope(qi.reshape(B, T, IDX_HEADS, IDX_DIM), cos, sin)
    ki = apply_rope(ki, cos, sin)
    wi = wi * (IDX_HEADS ** -0.5 * IDX_DIM ** -0.5)
    topk = min(TOPK_MAX, T // 4)
    nb = T // Q_BLOCK
    blocks = lambda t: jnp.moveaxis(t.reshape((B, nb, Q_BLOCK) + t.shape[2:]), 1, 0)
    key_pos = jnp.arange(T)
    gather = jax.vmap(lambda tab, i: tab[i])

    def one_block(args):
        q_b, qi_b, wi_b, qpos = args
        logits = jnp.einsum('bqhd,bsd->bqhs', qi_b, ki)
        score = jnp.einsum('bqh,bqhs->bqs', wi_b, jax.nn.relu(logits)).astype(f32)
        causal = key_pos[None, :] <= qpos[:, None]
        score = jnp.where(causal[None], score, -jnp.inf)
        _, idx = lax.top_k(score, topk)
        k_sel = gather(k, idx)
        v_sel = gather(v, idx)
        valid = idx <= qpos[None, :, None]
        s = jnp.einsum('bqhd,bqkd->bqhk', q_b, k_sel).astype(f32) * (ATT_HEAD_DIM ** -0.5)
        s = jnp.where(valid[:, :, None, :], s, -jnp.inf)
        p = jax.nn.softmax(s, axis=-1).astype(v_sel.dtype)
        return jnp.einsum('bqhk,bqkd->bqhd', p, v_sel)

    pos_blocks = jnp.arange(T).reshape(nb, Q_BLOCK)
    o = lax.map(one_block, (blocks(q), blocks(qi), blocks(wi), pos_blocks))
    return jnp.moveaxis(o, 0, 1).reshape(B, T, ATT_WIDTH)


def setup_inputs(seed: int = 0) -> dict:
    key = jax.random.key(seed)
    ks = jax.random.split(key, 20)
    f32 = jnp.float32
    L = DEPTH
    nrm = lambda k, shape, scale: jax.random.normal(k, shape, f32) * scale
    return {
        "x": nrm(ks[0], (BATCH, SEQ, D_MODEL), 1.0),
        "g_mix": 1.0 + nrm(ks[1], (L, D_MODEL), 0.02),
        "w_in": nrm(ks[2], (L, D_MODEL, N_IN), D_MODEL ** -0.5),
        "mu_shift": jax.random.uniform(ks[3], (L, RWKV_IN), f32),
        "decay_bias": jax.random.uniform(ks[4], (L, RWKV_WIDTH), f32, -6.0, 1.0),
        "w_decay_up": nrm(ks[5], (L, DECAY_LORA, RWKV_WIDTH), 0.5 * DECAY_LORA ** -0.5),
        "iclr_bias": nrm(ks[6], (L, RWKV_WIDTH), 0.5),
        "w_iclr_up": nrm(ks[7], (L, ICLR_LORA, RWKV_WIDTH), ICLR_LORA ** -0.5),
        "w_gate_up": nrm(ks[8], (L, GATE_LORA, RWKV_WIDTH), GATE_LORA ** -0.5),
        "k_k": 0.85 + nrm(ks[9], (L, RWKV_WIDTH), 0.02),
        "k_a": 1.0 + nrm(ks[10], (L, RWKV_WIDTH), 0.02),
        "r_k": nrm(ks[11], (L, RWKV_WIDTH), 0.1),
        "gn_w": 1.0 + nrm(ks[12], (L, RWKV_WIDTH), 0.02),
        "gn_b": nrm(ks[13], (L, RWKV_WIDTH), 0.01),
        "w_branch": nrm(ks[14], (L, N_BRANCH, BRANCH_WIDTH, D_MODEL), BRANCH_WIDTH ** -0.5),
        "w_out": nrm(ks[15], (L, D_MODEL, D_MODEL), D_MODEL ** -0.5),
        "g_ffn": 1.0 + nrm(ks[16], (L, D_MODEL), 0.02),
        "w_ffn_up": nrm(ks[17], (L, D_MODEL, FFN_HIDDEN), D_MODEL ** -0.5),
        "w_ffn_down": nrm(ks[18], (L, FFN_HIDDEN, D_MODEL), FFN_HIDDEN ** -0.5),
        "g_final": 1.0 + nrm(ks[19], (D_MODEL,), 0.02),
    }


def reference(x, g_mix, w_in, mu_shift, decay_bias, w_decay_up, iclr_bias, w_iclr_up,
              w_gate_up, k_k, k_a, r_k, gn_w, gn_b, w_branch, w_out, g_ffn,
              w_ffn_up, w_ffn_down, g_final):
    B, T, D = x.shape
    cos, sin = rope_tables(T, ATT_HEAD_DIM)
    for l in range(DEPTH):
        h = rms_norm(x, g_mix[l])
        z = h @ w_in[l]
        z_rwkv, z_dsa, z_gate = split_cols(z, (RWKV_IN, DSA_IN, GATE_IN))
        y_a = rwkv7_mix(z_rwkv, mu_shift[l], decay_bias[l], w_decay_up[l], iclr_bias[l],
                        w_iclr_up[l], w_gate_up[l], k_k[l], k_a[l], r_k[l], gn_w[l], gn_b[l])
        y_b = dsa_mix(z_dsa, cos, sin)
        branch = jnp.stack([y_a, y_b], axis=2)
        proj = jnp.einsum('btnc,ncd->btnd', branch, w_branch[l])
        gates = jax.nn.sigmoid(z_gate.reshape(B, T, N_BRANCH, D))
        merged = jnp.sum(gates * proj, axis=2)
        x = x + merged @ w_out[l]
        h2 = rms_norm(x, g_ffn[l])
        x = x + jnp.square(jax.nn.relu(h2 @ w_ffn_up[l])) @ w_ffn_down[l]
    return rms_norm(x, g_final)
```

```cpp
#include <hip/hip_runtime.h>
#include <hip/hip_cooperative_groups.h>
#include <cstdio>
#include <cstdint>
namespace cg = cooperative_groups;

#ifndef MK_PER_PHASE_LAUNCH
#define MK_PER_PHASE_LAUNCH 0
#endif

namespace pg8 {
#define PG8_LAS __attribute__((address_space(3)))
typedef unsigned short bf16_t;
typedef short bf16x8 __attribute__((ext_vector_type(8)));
typedef float f32x4 __attribute__((ext_vector_type(4)));
typedef unsigned u32x4 __attribute__((ext_vector_type(4)));
constexpr int BM = 256, BK = 64, HALF = 128, HTB = HALF * BK * 2  , STAGE_BYTES = 8 * HTB, NXCD = 8, WGM = 8;

__host__ __device__ __forceinline__ int lds_byte(int r, int c) { const int st = (r >> 4) * 2 + (c >> 5), rr = r & 15, cc = c & 31, ob = rr * 64 + cc * 2; return st * 1024 + (ob ^ (((ob >> 9) & 1) << 5)); }
__host__ __device__ __forceinline__ void stage_rc(int b, int& R, int& C) { const int st = b / 1024, sb = b % 1024, swz = sb ^ (((sb >> 9) & 1) << 5); R = (st >> 1) * 16 + swz / 64; C = (st & 1) * 32 + (swz % 64) / 2; }
__host__ __device__ __forceinline__ int perm32(int rho) { const int n = rho >> 4, i = rho & 15; return 8 * (i >> 2) + 4 * n + (i & 3); }

struct Unit { int pm, pn; };
struct Gemm { const bf16_t* A; const bf16_t* Bt; int M, N, K; };

struct StaticOrder {
    int nM, nN, nwg, G, c;
    __host__ __device__ void init(int M, int N, int G_, int c_) { nM = M / BM; nN = N / BM; nwg = nM * nN; G = G_; c = c_; }
    __host__ __device__ bool next(int i, Unit& u) const {
        const long L = (long)i * G + c; if (L >= nwg) return false;
        int wgid = (int)L; { const int q = nwg / NXCD, r = nwg % NXCD, xcd = wgid % NXCD, off = wgid / NXCD; wgid = (xcd < r ? xcd * (q + 1) : r * (q + 1) + (xcd - r) * q) + off; }
        const int nig = WGM * nN, gid = wgid / nig, fm = gid * WGM, gsz = (nM - fm) < WGM ? (nM - fm) : WGM;
        u.pm = fm + ((wgid % nig) % gsz); u.pn = (wgid % nig) / gsz; return true;
    }
    __device__ __forceinline__ void a_ready(const Unit&) const {}
    __device__ __forceinline__ void done(const Unit&) const {}
};
__device__ __forceinline__ unsigned cvt_pk_bf16(float lo, float hi) { unsigned r; asm volatile("v_cvt_pk_bf16_f32 %0, %1, %2" : "=v"(r) : "v"(lo), "v"(hi)); return r; }
typedef float f32x2 __attribute__((ext_vector_type(2)));
__device__ __forceinline__ float bflo(unsigned u) { return __uint_as_float(u << 16); }
__device__ __forceinline__ float bfhi(unsigned u) { return __uint_as_float(u & 0xffff0000u); }
__device__ __forceinline__ float sigm(float x) { return 1.0f / (1.0f + __expf(-x)); }

struct EpiZ {
    static constexpr bool PERM = true, AFTER_DRAIN = false;
    bf16_t* O; int ldc;
    __device__ __forceinline__ void operator()(const f32x4 (&acc)[2][2][4][2], const Unit& u, int wr, int wc, int fr, int fq) const {
        const int row0 = u.pm * BM + wr * 64 + fr, col0 = u.pn * BM + wc * 32 + 8 * fq;
#pragma unroll
        for (int ai = 0; ai < 2; ++ai)
#pragma unroll
            for (int m = 0; m < 4; ++m) { bf16_t* rowp = O + (size_t)(row0 + ai * HALF + m * 16) * ldc + col0;
#pragma unroll
                for (int bj = 0; bj < 2; ++bj) { const f32x4 v0 = acc[ai][bj][m][0], v1 = acc[ai][bj][m][1];
                    u32x4 w; w.x = cvt_pk_bf16(v0[0], v0[1]); w.y = cvt_pk_bf16(v0[2], v0[3]); w.z = cvt_pk_bf16(v1[0], v1[1]); w.w = cvt_pk_bf16(v1[2], v1[3]);
                    *(u32x4*)(rowp + bj * HALF) = w; } }
    }
};
template <int MODE> struct EpiGate {
    static constexpr bool PERM = true, AFTER_DRAIN = false;
    bf16_t* O; const bf16_t* Z; int zld; int gcol;
    __device__ __forceinline__ void operator()(const f32x4 (&acc)[2][2][4][2], const Unit& u, int wr, int wc, int fr, int fq) const {
        const int row0 = u.pm * BM + wr * 64 + fr, col0 = u.pn * BM + wc * 32 + 8 * fq;
#pragma unroll
        for (int ai = 0; ai < 2; ++ai)
#pragma unroll
            for (int m = 0; m < 4; ++m) { const size_t row = (size_t)(row0 + ai * HALF + m * 16);
                bf16_t* op = O + row * 1024 + col0; const bf16_t* zp = Z + row * zld + gcol + col0;
#pragma unroll
                for (int bj = 0; bj < 2; ++bj) { const f32x4 v0 = acc[ai][bj][m][0], v1 = acc[ai][bj][m][1];
                    const u32x4 g = *(const u32x4*)(zp + bj * HALF);
                    float r0 = v0[0] * sigm(bflo(g.x)), r1 = v0[1] * sigm(bfhi(g.x)), r2 = v0[2] * sigm(bflo(g.y)), r3 = v0[3] * sigm(bfhi(g.y));
                    float r4 = v1[0] * sigm(bflo(g.z)), r5 = v1[1] * sigm(bfhi(g.z)), r6 = v1[2] * sigm(bflo(g.w)), r7 = v1[3] * sigm(bfhi(g.w));
                    if (MODE == 1) { const u32x4 p = *(const u32x4*)(op + bj * HALF);
                        r0 += bflo(p.x); r1 += bfhi(p.x); r2 += bflo(p.y); r3 += bfhi(p.y); r4 += bflo(p.z); r5 += bfhi(p.z); r6 += bflo(p.w); r7 += bfhi(p.w); }
                    u32x4 w; w.x = cvt_pk_bf16(r0, r1); w.y = cvt_pk_bf16(r2, r3); w.z = cvt_pk_bf16(r4, r5); w.w = cvt_pk_bf16(r6, r7);
                    *(u32x4*)(op + bj * HALF) = w; } }
    }
};
template <bool WITH_XB> struct EpiRes {
    static constexpr bool PERM = false, AFTER_DRAIN = false;
    const float* X; float* O; bf16_t* XB; float* SS;
    __device__ __forceinline__ void operator()(const f32x4 (&acc)[2][2][4][2], const Unit& u, int wr, int wc, int fr, int fq) const {
        const int row0 = u.pm * BM + wr * 64 + fr, col0 = u.pn * BM + wc * 32 + 4 * fq;
#pragma unroll
        for (int ai = 0; ai < 2; ++ai)
#pragma unroll
            for (int m = 0; m < 4; ++m) { const size_t row = (size_t)(row0 + ai * HALF + m * 16); float ssq = 0.f;
#pragma unroll
                for (int bj = 0; bj < 2; ++bj)
#pragma unroll
                    for (int n = 0; n < 2; ++n) { const size_t off = row * 1024 + col0 + bj * HALF + n * 16;
                        const f32x4 xv = *(const f32x4*)(X + off); const f32x4 v = acc[ai][bj][m][n] + xv;
                        *(f32x4*)(O + off) = v; ssq += v[0] * v[0] + v[1] * v[1] + v[2] * v[2] + v[3] * v[3];
                        if (WITH_XB) { uint2 w; w.x = cvt_pk_bf16(v[0], v[1]); w.y = cvt_pk_bf16(v[2], v[3]); *(uint2*)(XB + off) = w; } }
                ssq += __shfl_xor(ssq, 16); ssq += __shfl_xor(ssq, 32);
                if (fq == 0) atomicAdd(SS + row, ssq); }
    }
};
struct EpiHid {
    static constexpr bool PERM = true, AFTER_DRAIN = false;
    bf16_t* O; const float* SS;
    __device__ __forceinline__ void operator()(const f32x4 (&acc)[2][2][4][2], const Unit& u, int wr, int wc, int fr, int fq) const {
        const int row0 = u.pm * BM + wr * 64 + fr, col0 = u.pn * BM + wc * 32 + 8 * fq;
#pragma unroll
        for (int ai = 0; ai < 2; ++ai)
#pragma unroll
            for (int m = 0; m < 4; ++m) { const size_t row = (size_t)(row0 + ai * HALF + m * 16);
                const float s2 = 1.0f / (SS[row] * (1.0f / 1024.0f) + 1e-6f);
                bf16_t* rowp = O + row * 4096 + col0;
#pragma unroll
                for (int bj = 0; bj < 2; ++bj) { f32x4 v0 = acc[ai][bj][m][0], v1 = acc[ai][bj][m][1];
#pragma unroll
                    for (int j = 0; j < 4; ++j) { float a = fmaxf(v0[j], 0.f), b = fmaxf(v1[j], 0.f); v0[j] = a * a * s2; v1[j] = b * b * s2; }
                    u32x4 w; w.x = cvt_pk_bf16(v0[0], v0[1]); w.y = cvt_pk_bf16(v0[2], v0[3]); w.z = cvt_pk_bf16(v1[0], v1[1]); w.w = cvt_pk_bf16(v1[2], v1[3]);
                    *(u32x4*)(rowp + bj * HALF) = w; } }
    }
};

template <class Epi, class Sched, bool STAMP = false>
__device__ __forceinline__ void gemm_phase(PG8_LAS unsigned char* lds, const Gemm g, const Sched& S, const Epi& E, unsigned long long* stamps) {
    const int tid = threadIdx.x, wid = __builtin_amdgcn_readfirstlane(tid >> 6), lane = tid & 63, wr = wid >> 2, wc = wid & 3, fr = lane & 15, fq = lane >> 4;
    const int K = g.K, nt = K / BK;
    int ts_lo = 0, ts_hi = 0, nts = 0; const unsigned long long rt_entry = STAMP ? (unsigned long long)wall_clock64() : 0ull;
#define PG8_STAMP() do { if (STAMP && wid == 0 && nts < 64) { const unsigned long long _c = (unsigned long long)clock64(); \
        ts_lo = (lane == nts) ? (int)(unsigned)_c : ts_lo; ts_hi = (lane == nts) ? (int)(unsigned)(_c >> 32) : ts_hi; ++nts; } } while (0)
    PG8_STAMP();
    unsigned voffA[2], voffB[2];
#pragma unroll
    for (int i = 0; i < 2; ++i) { int R, C; stage_rc(tid * 16 + i * 8192, R, C); const int Rb = Epi::PERM ? ((R & ~31) + perm32(R & 31)) : R;
        voffA[i] = (unsigned)(R * K + C) * 2u; voffB[i] = (unsigned)(Rb * K + C) * 2u; }
    const size_t kstep = (size_t)(BK * 2);
    const size_t hstep = (size_t)HALF * K * 2;
    const size_t tstep = 2 * hstep;
    const unsigned ldsw = (unsigned)wid * 1024u;
    const int aoff = lds_byte(wr * 64 + fr, fq * 8), boff = lds_byte(wc * 32 + fr, fq * 8);
#define PG8_SA(b, h) (((b) * 2 + (h)) * HTB)
#define PG8_SB(b, h) ((4 + (b) * 2 + (h)) * HTB)
#define PG8_STAGE(bufoff, gbase, voff) do { _Pragma("unroll") for (int _i = 0; _i < 2; ++_i) \
        __builtin_amdgcn_global_load_lds((const unsigned*)((const char*)(gbase) + (voff)[_i]), (PG8_LAS unsigned*)(lds + (bufoff) + ldsw + _i * 8192), 16, 0, 0); } while (0)
#define PG8_LDA(dst, b, h) do { _Pragma("unroll") for (int m = 0; m < 4; ++m) _Pragma("unroll") for (int k = 0; k < 2; ++k) dst[m][k] = *(const PG8_LAS bf16x8*)(lds + PG8_SA(b, h) + aoff + m * 2048 + k * 1024); } while (0)
#define PG8_LDB(dst, b, h) do { _Pragma("unroll") for (int n = 0; n < 2; ++n) _Pragma("unroll") for (int k = 0; k < 2; ++k) dst[n][k] = *(const PG8_LAS bf16x8*)(lds + PG8_SB(b, h) + boff + n * 2048 + k * 1024); } while (0)
#define PG8_MMA(ai, bj, At, Bt) do { __builtin_amdgcn_s_setprio(1); _Pragma("unroll") for (int m = 0; m < 4; ++m) _Pragma("unroll") for (int n = 0; n < 2; ++n) _Pragma("unroll") for (int k = 0; k < 2; ++k) \
        acc[ai][bj][m][n] = __builtin_amdgcn_mfma_f32_16x16x32_bf16(Bt[n][k], At[m][k], acc[ai][bj][m][n], 0, 0, 0); __builtin_amdgcn_s_setprio(0); } while (0)
#define PG8_WAIT_V(n) asm volatile("s_waitcnt vmcnt(" #n ")" ::: "memory")
#define PG8_WAIT_L(n) asm volatile("s_waitcnt lgkmcnt(" #n ")" ::: "memory")
#define PG8_BAR __builtin_amdgcn_s_barrier()
#define PG8_SCHED __builtin_amdgcn_sched_barrier(0)
    Unit cur, nxt; int ui = 0;
    if (!S.next(0, cur)) return;
    f32x4 acc[2][2][4][2];
#pragma unroll
    for (int a = 0; a < 2; ++a)
#pragma unroll
        for (int b = 0; b < 2; ++b)
#pragma unroll
            for (int m = 0; m < 4; ++m)
#pragma unroll
                for (int n = 0; n < 2; ++n) acc[a][b][m][n] = (f32x4){0.f, 0.f, 0.f, 0.f};
    bf16x8 At[4][2], B0[2][2], B1[2][2];
    const char* cA = (const char*)g.A + (size_t)cur.pm * tstep; const char* cB = (const char*)g.Bt + (size_t)cur.pn * tstep;
    S.a_ready(cur);
    PG8_STAGE(PG8_SB(0, 0), cB, voffB); PG8_STAGE(PG8_SA(0, 0), cA, voffA); PG8_STAGE(PG8_SB(0, 1), cB + hstep, voffB); PG8_STAGE(PG8_SA(0, 1), cA + hstep, voffA);
    if (wr == 1) PG8_BAR;
    PG8_WAIT_V(4); PG8_BAR;
    PG8_STAGE(PG8_SB(1, 0), cB + kstep, voffB); PG8_STAGE(PG8_SA(1, 0), cA + kstep, voffA); PG8_STAGE(PG8_SB(1, 1), cB + hstep + kstep, voffB);
    PG8_WAIT_V(6); PG8_BAR;
    PG8_STAMP();
    for (;;) {
        const bool has_next = S.next(ui + 1, nxt);
        const char* nA = has_next ? (const char*)g.A + (size_t)nxt.pm * tstep : cA; const char* nB = has_next ? (const char*)g.Bt + (size_t)nxt.pn * tstep : cB;
        for (int t = 0; t < nt; t += 2) {
            const bool last = (t == nt - 2);
            const char* a1 = cA + (size_t)(t + 1) * kstep;
            const char* a2 = last ? nA : cA + (size_t)(t + 2) * kstep; const char* b2 = last ? nB : cB + (size_t)(t + 2) * kstep;
            const char* a3 = a2 + kstep; const char* b3 = b2 + kstep;
            if (last && has_next) S.a_ready(nxt);
            PG8_LDB(B0, 0, 0); PG8_SCHED; PG8_LDA(At, 0, 0); PG8_STAGE(PG8_SA(1, 1), a1 + hstep, voffA);
            PG8_WAIT_L(8); PG8_BAR; PG8_WAIT_L(0); PG8_MMA(0, 0, At, B0); PG8_BAR; PG8_SCHED;
            PG8_LDB(B1, 0, 1); PG8_STAGE(PG8_SB(0, 0), b2, voffB);
            PG8_BAR; PG8_WAIT_L(0); PG8_MMA(0, 1, At, B1); PG8_BAR;
            PG8_LDA(At, 0, 1); PG8_STAGE(PG8_SA(0, 0), a2, voffA);
            PG8_BAR; PG8_WAIT_L(0); PG8_MMA(1, 0, At, B0); PG8_BAR; PG8_SCHED;
            PG8_STAGE(PG8_SB(0, 1), b2 + hstep, voffB);
            PG8_WAIT_V(6); PG8_BAR; PG8_MMA(1, 1, At, B1); PG8_BAR;
            PG8_LDB(B0, 1, 0); PG8_SCHED; PG8_LDA(At, 1, 0); PG8_STAGE(PG8_SA(0, 1), a2 + hstep, voffA);
            PG8_WAIT_L(8); PG8_BAR; PG8_WAIT_L(0); PG8_MMA(0, 0, At, B0); PG8_BAR; PG8_SCHED;
            PG8_LDB(B1, 1, 1); PG8_STAGE(PG8_SB(1, 0), b3, voffB);
            PG8_BAR; PG8_WAIT_L(0); PG8_MMA(0, 1, At, B1); PG8_BAR;
            PG8_LDA(At, 1, 1); PG8_STAGE(PG8_SA(1, 0), a3, voffA);
            PG8_BAR; PG8_WAIT_L(0); PG8_MMA(1, 0, At, B0); PG8_BAR; PG8_SCHED;
            PG8_STAGE(PG8_SB(1, 1), b3 + hstep, voffB);
            PG8_WAIT_V(6); PG8_BAR; PG8_MMA(1, 1, At, B1); PG8_BAR;
        }
        PG8_STAMP();
        if constexpr (!Epi::AFTER_DRAIN) { E(acc, cur, wr, wc, fr, fq); S.done(cur); }
        PG8_STAMP();
        if (!has_next) break;
#pragma unroll
        for (int a = 0; a < 2; ++a)
#pragma unroll
            for (int b = 0; b < 2; ++b)
#pragma unroll
                for (int m = 0; m < 4; ++m)
#pragma unroll
                    for (int n = 0; n < 2; ++n) acc[a][b][m][n] = (f32x4){0.f, 0.f, 0.f, 0.f};
        cur = nxt; cA = nA; cB = nB; ++ui;
    }
    PG8_WAIT_V(0);
    if (wr == 0) PG8_BAR;
    PG8_BAR;
    if constexpr (Epi::AFTER_DRAIN) { E.fused(acc, cur, wr, wc, fr, fq, lds, wid, lane); S.done(cur); }
    PG8_STAMP();
    if (STAMP && wid == 0) { stamps[lane] = lane < nts ? (((unsigned long long)(unsigned)ts_hi << 32) | (unsigned)ts_lo) : 0ull;
        if (lane == 62) stamps[62] = rt_entry; if (lane == 63) stamps[63] = (unsigned long long)wall_clock64(); }
#undef PG8_STAMP
#undef PG8_SA
#undef PG8_SB
#undef PG8_STAGE
#undef PG8_LDA
#undef PG8_LDB
#undef PG8_MMA
#undef PG8_WAIT_V
#undef PG8_WAIT_L
#undef PG8_BAR
#undef PG8_SCHED
}
}
extern __shared__ __attribute__((aligned(16))) unsigned char g_lds[];
using pg8::bf16_t; using pg8::bf16x8; using pg8::f32x4; using pg8::u32x4; using pg8::cvt_pk_bf16; using pg8::bflo; using pg8::bfhi; using pg8::sigm;

constexpr int NTOK = 32768, DM = 1024, SEQ = 2048, NB = 16, ZLD = 5120, NTHR = 512;
constexpr int C_R = 0, C_K = 512, C_V = 1024, C_WD = 1536, C_AD = 1600, C_GD = 1664;
constexpr int C_Q = 1824, C_KA = 2336, C_VA = 2400, C_QI = 2464, C_KI = 2976, C_WI = 3040, C_G0 = 3048, C_G1 = 4072;
constexpr size_t MiB = 1024 * 1024;
constexpr size_t WS_SS1 = 0, WS_SS2 = 128 * 1024, WS_BONUS = 256 * 1024, WS_ROPE = 1280 * 1024, WS_WD = 1792 * 1024, WS_WI = 1856 * 1024, WS_WG = 1920 * 1024;
constexpr size_t WS_WIN = 4 * MiB, WS_WUP = 14 * MiB, WS_WDN = 22 * MiB, WS_WB = 30 * MiB, WS_WO = 32 * MiB, WS_VT = 34 * MiB, WS_H = 38 * MiB, WS_Z = 102 * MiB, WS_P = 422 * MiB, WS_END = 486 * MiB;
constexpr int LDS_BYTES = 131072;

struct Args { const float* in[20]; float* out; unsigned char* ws; int ph_lo, ph_hi; };

struct Frame {
    const float* in[20]; float* out; unsigned char* ws; unsigned char* lds; int tid, lane, wave;
    float *ss1, *ss2, *bonus; float2* rope; bf16_t *wd, *wi, *wg, *win, *wup, *wdn, *wb, *wo, *vt, *h, *ya, *yb, *xb, *z, *hid, *lw, *ic, *mg, *gt; float* yraw;
};

__device__ __forceinline__ bf16_t f2bf(float f) { return (bf16_t)(cvt_pk_bf16(f, 0.f) & 0xffffu); }
__device__ __forceinline__ float bf2f(bf16_t b) { return __uint_as_float(((unsigned)b) << 16); }
template <int CTRL> __device__ __forceinline__ float dpp_mov(float x) { return __int_as_float(__builtin_amdgcn_update_dpp(0, __float_as_int(x), CTRL, 0xF, 0xF, true)); }
__device__ __forceinline__ float red16(float x) { x += dpp_mov<0xB1>(x); x += dpp_mov<0x4E>(x); x += dpp_mov<0x141>(x); x += dpp_mov<0x140>(x); return x; }
__device__ __forceinline__ float red32(float x) { x += __shfl_xor(x, 1); x += __shfl_xor(x, 2); x += __shfl_xor(x, 4); x += __shfl_xor(x, 8); x += __shfl_xor(x, 16); return x; }
__device__ __forceinline__ float red64(float x) { x = red32(x); x += __shfl_xor(x, 32); return x; }
__device__ __forceinline__ float softplus_f(float x) { return fmaxf(x, 0.f) + log1pf(__expf(-fabsf(x))); }

__device__ void tconv(const Frame& F, const float* __restrict__ W, int K, int N, int Npad, bf16_t* __restrict__ Wt, const float* __restrict__ rs) {
    float* tile = (float*)g_lds;
    const int ktn = (K + 63) / 64, ntn = Npad / 64, tid = F.tid;
    for (int tl = blockIdx.x; tl < ktn * ntn; tl += gridDim.x) {
        const int kt = tl % ktn, nt = tl / ktn;
#pragma unroll
        for (int i = 0; i < 8; ++i) { const int idx = tid + i * NTHR, kk = idx >> 6, nn = idx & 63, k = kt * 64 + kk, n = nt * 64 + nn;
            float v = (k < K && n < N) ? W[(size_t)k * N + n] : 0.f; if (rs != nullptr && k < K) v *= rs[k]; tile[kk * 65 + nn] = v; }
        __syncthreads();
#pragma unroll
        for (int i = 0; i < 8; ++i) { const int idx = tid + i * NTHR, nn = idx >> 6, kk = idx & 63, k = kt * 64 + kk, n = nt * 64 + nn;
            if (k < K) Wt[(size_t)n * K + k] = f2bf(tile[kk * 65 + nn]); }
        __syncthreads();
    }
}
__device__ void p0_prologue(const Frame& F) {
    const int tid = F.tid, gtid = blockIdx.x * NTHR + tid, gn = gridDim.x * NTHR;
    for (int i = gtid; i < 2 * NTOK; i += gn) F.ss1[i] = 0.f;
    for (int i = gtid; i < SEQ * 32; i += gn) { const int pos = i >> 5, j = i & 31;
        const float inv = 1.0f / powf(10000.0f, (float)(2 * j) / 64.0f); const float ang = (float)pos * inv;
        double rev = (double)ang * 0.15915494309189535; rev -= floor(rev); const float fr = (float)rev;
        F.rope[i] = make_float2(__builtin_amdgcn_cosf(fr), __builtin_amdgcn_sinf(fr)); }
    tconv(F, F.in[2], 1024, 5096, 5120, F.win, nullptr);
    tconv(F, F.in[17], 1024, 4096, 4096, F.wup, F.in[16]);
    tconv(F, F.in[18], 4096, 1024, 1024, F.wdn, nullptr);
    tconv(F, F.in[14], 512, 1024, 1024, F.wb, nullptr);
    tconv(F, F.in[14] + 512 * 1024, 512, 1024, 1024, F.wb + 1024 * 512, nullptr);
    tconv(F, F.in[15], 1024, 1024, 1024, F.wo, nullptr);
    tconv(F, F.in[5], 64, 512, 512, F.wd, nullptr);
    tconv(F, F.in[7], 64, 512, 512, F.wi, nullptr);
    tconv(F, F.in[8], 160, 512, 512, F.wg, nullptr);
    const float* x = F.in[0]; const float* g = F.in[1]; const int lane = F.lane;
    for (int row = blockIdx.x * 8 + F.wave; row < NTOK; row += gridDim.x * 8) {
        const float* xr = x + (size_t)row * DM; f32x4 v[4]; float ss = 0.f;
#pragma unroll
        for (int i = 0; i < 4; ++i) { v[i] = *(const f32x4*)(xr + i * 256 + lane * 4); ss += v[i][0] * v[i][0] + v[i][1] * v[i][1] + v[i][2] * v[i][2] + v[i][3] * v[i][3]; }
        ss = red64(ss); const float sc = rsqrtf(ss * (1.0f / 1024.0f) + 1e-6f);
#pragma unroll
        for (int i = 0; i < 4; ++i) { const f32x4 gg = *(const f32x4*)(g + i * 256 + lane * 4); uint2 w;
            w.x = cvt_pk_bf16(v[i][0] * sc * gg[0], v[i][1] * sc * gg[1]); w.y = cvt_pk_bf16(v[i][2] * sc * gg[2], v[i][3] * sc * gg[3]);
            *(uint2*)(F.h + (size_t)row * DM + i * 256 + lane * 4) = w; }
    }
}

__device__ void p2_prep(const Frame& F) {
    const int tid = F.tid, lane = F.lane, wave = F.wave, fr = lane & 15, fq = lane >> 4;
    bf16_t* z = F.z; const float* mu = F.in[3];
    {
        constexpr int LDA = 296; bf16_t* At = (bf16_t*)g_lds;
        const float* dbias = F.in[4]; const float* ibias = F.in[6];
        for (int tile = blockIdx.x; tile < NTOK / 16; tile += gridDim.x) {
            const int t0 = tile * 16;
            for (int idx = tid; idx < 16 * 288; idx += NTHR) { const int tok = idx / 288, c = idx - tok * 288, t = t0 + tok, col = C_WD + c;
                const float zt = bf2f(z[(size_t)t * ZLD + col]); const float zp = (t & (SEQ - 1)) ? bf2f(z[(size_t)(t - 1) * ZLD + col]) : 0.f;
                float v = zt + (zp - zt) * mu[col];
                if (c < 64) v = tanhf(v); else if (c >= 128) v = sigm(v);
                At[tok * LDA + c] = f2bf(v); }
            __syncthreads();
            const int h = wave;
#pragma unroll 1
            for (int j = 0; j < 4; ++j) { const int n = h * 64 + j * 16 + fr;
                f32x4 ad = {0.f, 0.f, 0.f, 0.f}, ai = ad, ag = ad;
#pragma unroll
                for (int ks = 0; ks < 2; ++ks) { const bf16x8 a = *(const bf16x8*)(At + fr * LDA + ks * 32 + fq * 8); const bf16x8 b = *(const bf16x8*)(F.wd + n * 64 + ks * 32 + fq * 8);
                    ad = __builtin_amdgcn_mfma_f32_16x16x32_bf16(a, b, ad, 0, 0, 0); }
#pragma unroll
                for (int ks = 0; ks < 2; ++ks) { const bf16x8 a = *(const bf16x8*)(At + fr * LDA + 64 + ks * 32 + fq * 8); const bf16x8 b = *(const bf16x8*)(F.wi + n * 64 + ks * 32 + fq * 8);
                    ai = __builtin_amdgcn_mfma_f32_16x16x32_bf16(a, b, ai, 0, 0, 0); }
#pragma unroll
                for (int ks = 0; ks < 5; ++ks) { const bf16x8 a = *(const bf16x8*)(At + fr * LDA + 128 + ks * 32 + fq * 8); const bf16x8 b = *(const bf16x8*)(F.wg + n * 160 + ks * 32 + fq * 8);
                    ag = __builtin_amdgcn_mfma_f32_16x16x32_bf16(a, b, ag, 0, 0, 0); }
                const float db = dbias[n], ib = ibias[n];
#pragma unroll
                for (int jj = 0; jj < 4; ++jj) { const size_t t = (size_t)(t0 + fq * 4 + jj);
                    const float dw = db + ad[jj]; const float wlog = -softplus_f(-dw) - 0.5f; const float lwv = -__expf(wlog);
                    F.lw[t * 512 + n] = f2bf(lwv); F.ic[t * 512 + n] = f2bf(sigm(ib + ai[jj])); F.gt[t * 512 + n] = f2bf(ag[jj]); }
            }
            __syncthreads();
        }
    }
    {
        unsigned short* tl = (unsigned short*)g_lds;
        for (int tile = blockIdx.x; tile < NTOK / 64; tile += gridDim.x) { const int t0 = tile * 64, b = t0 / SEQ, tt0 = t0 % SEQ;
#pragma unroll
            for (int i = 0; i < 8; ++i) { const int idx = tid + i * NTHR, tok = idx >> 6, d = idx & 63; tl[tok * 66 + d] = z[(size_t)(t0 + tok) * ZLD + C_VA + d]; }
            __syncthreads();
#pragma unroll
            for (int i = 0; i < 8; ++i) { const int idx = tid + i * NTHR, d = idx >> 6, tok = idx & 63; F.vt[((size_t)b * 64 + d) * SEQ + tt0 + tok] = tl[tok * 66 + d]; }
            __syncthreads();
        }
    }
    {
        const int gtid = blockIdx.x * NTHR + tid, gn = gridDim.x * NTHR;
        for (int idx = gtid; idx < NTOK * 576; idx += gn) { const int t = idx / 576, p = idx - t * 576, hd = p >> 5, i = p & 31;
            const int base = hd < 8 ? C_Q + hd * 64 : (hd == 8 ? C_KA : (hd < 17 ? C_QI + (hd - 9) * 64 : C_KI));
            const float2 cs = F.rope[(t & (SEQ - 1)) * 32 + i];
            bf16_t* p1 = z + (size_t)t * ZLD + base + i; const float x1 = bf2f(p1[0]), x2 = bf2f(p1[32]);
            p1[0] = f2bf(x1 * cs.x - x2 * cs.y); p1[32] = f2bf(x2 * cs.x + x1 * cs.y); }
    }
}

__device__ void p3_scan(const Frame& F) {
    const int tid = F.tid;
    float* ops = (float*)g_lds;
    float* vv = ops + 16 * 5 * 64;
    float* yo = vv + 16 * 32;
    const bf16_t* z = F.z; const float* mu = F.in[3]; const float* k_k = F.in[9]; const float* k_a = F.in[10]; const float* r_k = F.in[11];
    for (int item = blockIdx.x; item < 256; item += gridDim.x) {
        const int bh = item >> 1, half = item & 1, b = bh >> 3, h = bh & 7, v0 = half * 32;
        const int ptok = tid >> 5, pc = (tid & 31) * 2, gc = h * 64 + pc;
        const float mur0 = mu[C_R + gc], mur1 = mu[C_R + gc + 1], muk0 = mu[C_K + gc], muk1 = mu[C_K + gc + 1], muv0 = mu[C_V + gc], muv1 = mu[C_V + gc + 1];
        const float kk0 = k_k[gc], kk1 = k_k[gc + 1], ka0 = k_a[gc], ka1 = k_a[gc + 1], rk0 = r_k[gc], rk1 = r_k[gc + 1];
        const int row = tid >> 4, ks = tid & 15;
        float S0 = 0.f, S1 = 0.f, S2 = 0.f, S3 = 0.f;
        const size_t tokbase = (size_t)b * SEQ;
        unsigned zr_c, zr_p, zk_c, zk_p, zv_c, zv_p, lwu, icu;
#define SCAN_LOAD(ch) do { const int _t = (ch) * 16 + ptok; const size_t _T = tokbase + _t; const bf16_t* _zp = z + _T * ZLD + gc; \
            zr_c = *(const unsigned*)(_zp + C_R); zk_c = *(const unsigned*)(_zp + C_K); zv_c = *(const unsigned*)(_zp + C_V); \
            if (_t > 0) { zr_p = *(const unsigned*)(_zp - ZLD + C_R); zk_p = *(const unsigned*)(_zp - ZLD + C_K); zv_p = *(const unsigned*)(_zp - ZLD + C_V); } else { zr_p = 0u; zk_p = 0u; zv_p = 0u; } \
            lwu = *(const unsigned*)(F.lw + _T * 512 + gc); icu = *(const unsigned*)(F.ic + _T * 512 + gc); } while (0)
        SCAN_LOAD(0);
        for (int ch = 0; ch < SEQ / 16; ++ch) {
            {
                const float rc0 = bflo(zr_c), rc1 = bfhi(zr_c), rp0 = bflo(zr_p), rp1 = bfhi(zr_p);
                const float kc0 = bflo(zk_c), kc1 = bfhi(zk_c), kp0 = bflo(zk_p), kp1 = bfhi(zk_p);
                const float vc0 = bflo(zv_c), vc1 = bfhi(zv_c), vp0 = bflo(zv_p), vp1 = bfhi(zv_p);
                const float r0 = rc0 + (rp0 - rc0) * mur0, r1 = rc1 + (rp1 - rc1) * mur1;
                const float k0 = kc0 + (kp0 - kc0) * muk0, k1 = kc1 + (kp1 - kc1) * muk1;
                const float vs0 = vc0 + (vp0 - vc0) * muv0, vs1 = vc1 + (vp1 - vc1) * muv1;
                const float ic0 = bflo(icu), ic1 = bfhi(icu); const float w0 = __expf(bflo(lwu)), w1 = __expf(bfhi(lwu));
                const float q0 = k0 * kk0, q1 = k1 * kk1; const float ss = red32(q0 * q0 + q1 * q1);
                const float inv = 1.0f / fmaxf(sqrtf(ss), 1e-12f); const float n0 = q0 * inv, n1 = q1 * inv;
                const float kn0 = k0 * (1.0f + (ic0 - 1.0f) * ka0), kn1 = k1 * (1.0f + (ic1 - 1.0f) * ka1);
                const float bon = red32(r0 * kn0 * rk0 + r1 * kn1 * rk1);
                if (half == 0 && (tid & 31) == 0) F.bonus[(tokbase + ch * 16 + ptok) * 8 + h] = bon;
                float* op = ops + ptok * 320 + pc;
                *(float2*)(op) = make_float2(-n0, -n1); *(float2*)(op + 64) = make_float2(w0, w1); *(float2*)(op + 128) = make_float2(n0 * ic0, n1 * ic1);
                *(float2*)(op + 192) = make_float2(kn0, kn1); *(float2*)(op + 256) = make_float2(r0, r1);
                if (pc >= v0 && pc < v0 + 32) *(float2*)(vv + ptok * 32 + pc - v0) = make_float2(vs0, vs1);
            }
            __syncthreads();
            if (ch + 1 < SEQ / 16) SCAN_LOAD(ch + 1);
#pragma unroll 4
            for (int s = 0; s < 16; ++s) {
                const float* o = ops + s * 320 + ks * 4;
                const f32x4 a4 = *(const f32x4*)(o), w4 = *(const f32x4*)(o + 64), b4 = *(const f32x4*)(o + 128), k4 = *(const f32x4*)(o + 192), r4 = *(const f32x4*)(o + 256);
                const float vval = vv[s * 32 + row];
                float sa = S0 * a4[0] + S1 * a4[1] + S2 * a4[2] + S3 * a4[3]; sa = red16(sa);
                S0 = S0 * w4[0] + sa * b4[0] + vval * k4[0]; S1 = S1 * w4[1] + sa * b4[1] + vval * k4[1];
                S2 = S2 * w4[2] + sa * b4[2] + vval * k4[2]; S3 = S3 * w4[3] + sa * b4[3] + vval * k4[3];
                float y = S0 * r4[0] + S1 * r4[1] + S2 * r4[2] + S3 * r4[3]; y = red16(y);
                if (ks == 0) yo[s * 32 + row] = y;
            }
            __syncthreads();
            { const int tok = tid >> 5, r = tid & 31; F.yraw[(tokbase + ch * 16 + tok) * 512 + h * 64 + v0 + r] = yo[tok * 32 + r]; }
        }
#undef SCAN_LOAD
        __syncthreads();
    }
}

__device__ __forceinline__ unsigned ordkey(float f) { const unsigned u = __float_as_uint(f); return (u & 0x80000000u) ? ~u : (u | 0x80000000u); }
__device__ void p3_dsa(const Frame& F) {
    const int tid = F.tid, lane = F.lane, wave = F.wave, fr = lane & 15, fq = lane >> 4;
    unsigned* selm = (unsigned*)g_lds;
    unsigned* eqm = selm + 1024;
    int* cnt = (int*)(eqm + 1024);
    float* oacc = (float*)(cnt + 256);
    float* rsum = oacc + 8192;
    int* eqpre = (int*)(rsum + 128);
    const bf16_t* z = F.z; const int G = gridDim.x, bx = blockIdx.x;
    const f32x4 zero4 = {0.f, 0.f, 0.f, 0.f};
    for (int rnd = 0; rnd * G < 2048; ++rnd) {
        const int n = rnd * G + ((rnd & 1) ? (G - 1 - bx) : bx);
        if (n >= 2048) continue;
        const int qg = 127 - (n >> 4), b = n & 15, q0 = qg * 16; const size_t Tb = (size_t)b * SEQ;
        for (int i = tid; i < 2048; i += NTHR) selm[i] = 0u;
        for (int i = tid; i < 8192 + 128; i += NTHR) oacc[i] = 0.f;
        __syncthreads();
        const bf16_t* zq = z + (Tb + q0 + fr) * ZLD;
        const unsigned lofk = (unsigned)((fr * ZLD + fq * 8) * 2), lofv = (unsigned)((fr * SEQ + fq * 4) * 2);
        if (qg >= 16) {
            float sacc[16][4];
#pragma unroll
            for (int i = 0; i < 16; ++i)
#pragma unroll
                for (int jj = 0; jj < 4; ++jj) sacc[i][jj] = 0.f;
            const u32x4 wv = *(const u32x4*)(zq + C_WI);
#pragma unroll 1
            for (int hp = 0; hp < 2; ++hp) {
                bf16x8 Bq[4][2];
#pragma unroll
                for (int hh = 0; hh < 4; ++hh)
#pragma unroll
                    for (int ks = 0; ks < 2; ++ks) Bq[hh][ks] = *(const bf16x8*)(zq + C_QI + (hp * 4 + hh) * 64 + ks * 32 + fq * 8);
                const unsigned wa = hp ? wv.z : wv.x, wb = hp ? wv.w : wv.y; const float sc = 0.044194173824159216f;
                float wih[4]; wih[0] = bflo(wa) * sc; wih[1] = bfhi(wa) * sc; wih[2] = bflo(wb) * sc; wih[3] = bfhi(wb) * sc;
#pragma unroll
                for (int i = 0; i < 16; ++i) { const int kt = wave + 8 * i;
                    if (kt <= qg) { const char* kb = (const char*)(z + (Tb + (size_t)kt * 16) * ZLD + C_KI);
                        unsigned lo2 = lofk; asm volatile("" : "+v"(lo2));
                        const bf16x8 A0 = *(const bf16x8*)(kb + lo2), A1 = *(const bf16x8*)(kb + lo2 + 64);
#pragma unroll
                        for (int hh = 0; hh < 4; ++hh) { f32x4 acc = __builtin_amdgcn_mfma_f32_16x16x32_bf16(A0, Bq[hh][0], zero4, 0, 0, 0);
                            acc = __builtin_amdgcn_mfma_f32_16x16x32_bf16(A1, Bq[hh][1], acc, 0, 0, 0);
#pragma unroll
                            for (int jj = 0; jj < 4; ++jj) sacc[i][jj] += wih[hh] * fmaxf(acc[jj], 0.f); }
                    }
                }
            }
            unsigned uk[16][4];
#pragma unroll
            for (int i = 0; i < 16; ++i) { const int kt = wave + 8 * i;
#pragma unroll
                for (int jj = 0; jj < 4; ++jj) { const bool masked = (kt > qg) || ((kt == qg) && (fq * 4 + jj > fr)); uk[i][jj] = masked ? 0x007fffffu : ordkey(sacc[i][jj]); } }
            unsigned T = 0u; bool found = false;
            for (int bit = 31; bit >= 0; --bit) {
                const unsigned cand = T | (1u << bit); int c = 0;
#pragma unroll
                for (int i = 0; i < 16; ++i) {
#pragma unroll
                    for (int jj = 0; jj < 4; ++jj) c += (uk[i][jj] >= cand) ? 1 : 0;
                    __builtin_amdgcn_sched_barrier(0); }
                c += __shfl_xor(c, 16); c += __shfl_xor(c, 32);
                const int par = bit & 1;
                if (fq == 0) cnt[(par * 8 + wave) * 16 + fr] = c;
                __syncthreads();
                int tot = 0;
#pragma unroll
                for (int w = 0; w < 8; ++w) tot += cnt[(par * 8 + w) * 16 + fr];
                if (!found && tot >= 256) { T = cand; if (tot == 256) found = true; }
                if (__all(found)) break;
            }
            int need;
            { int c = 0; unsigned Tp = T + 1u; asm volatile("" : "+v"(Tp));
#pragma unroll
              for (int i = 0; i < 16; ++i) {
#pragma unroll
                  for (int jj = 0; jj < 4; ++jj) c += (uk[i][jj] >= Tp) ? 1 : 0;
                  __builtin_amdgcn_sched_barrier(0); }
              c += __shfl_xor(c, 16); c += __shfl_xor(c, 32);
              __syncthreads();
              if (fq == 0) cnt[wave * 16 + fr] = c;
              __syncthreads();
              int tot = 0;
#pragma unroll
              for (int w = 0; w < 8; ++w) tot += cnt[w * 16 + fr];
              need = 256 - tot; }
#pragma unroll
            for (int i = 0; i < 16; ++i) { const int kt = wave + 8 * i; unsigned nib = 0u;
#pragma unroll
                for (int jj = 0; jj < 4; ++jj) nib |= (uk[i][jj] == T) ? (1u << jj) : 0u;
                if (nib) atomicOr(&eqm[fr * 64 + (kt >> 1)], nib << ((kt & 1) * 16 + fq * 4));
                __builtin_amdgcn_sched_barrier(0); }
            __syncthreads();
            unsigned T2 = T; asm volatile("" : "+v"(T2));
            for (int w = tid; w < 1024; w += NTHR) { const int word = w & 63; int sct = 0; for (int j = 0; j < word; ++j) sct += __popc(eqm[w - word + j]); eqpre[w] = sct; }
            __syncthreads();
#pragma unroll
            for (int i = 0; i < 16; ++i) { const int kt = wave + 8 * i; unsigned nib = 0u;
                const int word = kt >> 1, bp0 = (kt & 1) * 16 + fq * 4; const unsigned eqw = eqm[fr * 64 + word]; const int rbase = eqpre[fr * 64 + word];
#pragma unroll
                for (int jj = 0; jj < 4; ++jj) { const int rank = rbase + __popc(eqw & ((1u << (bp0 + jj)) - 1u));
                    const bool sel = (uk[i][jj] > T2) || ((uk[i][jj] == T2) && (rank < need));
                    nib |= sel ? (1u << jj) : 0u; }
                if (nib) atomicOr(&selm[fr * 64 + word], nib << bp0);
                __builtin_amdgcn_sched_barrier(0); }
        } else {
            for (int w = tid; w < 1024; w += NTHR) { const int q = w >> 6, word = w & 63, qpos = q0 + q, lo = word * 32;
                selm[w] = (qpos >= lo + 31) ? 0xffffffffu : (qpos < lo ? 0u : ((2u << (qpos - lo)) - 1u)); }
        }
        __syncthreads();
#pragma unroll 1
        for (int hp = 0; hp < 4; ++hp) {
            bf16x8 Bqa[2][2];
#pragma unroll
            for (int hh = 0; hh < 2; ++hh)
#pragma unroll
                for (int ks = 0; ks < 2; ++ks) Bqa[hh][ks] = *(const bf16x8*)(zq + C_Q + (hp * 2 + hh) * 64 + ks * 32 + fq * 8);
            f32x4 O[4][2]; float rs[2];
#pragma unroll
            for (int dt = 0; dt < 4; ++dt)
#pragma unroll
                for (int hh = 0; hh < 2; ++hh) O[dt][hh] = zero4;
#pragma unroll
            for (int hh = 0; hh < 2; ++hh) rs[hh] = 0.f;
#pragma unroll 1
            for (int t0 = wave; t0 <= qg; t0 += 16) {
                const int t1 = t0 + 8; const bool v1 = t1 <= qg; const int t1c = v1 ? t1 : t0;
                const char* kp0 = (const char*)(z + (Tb + (size_t)t0 * 16) * ZLD + C_KA); const char* kp1 = (const char*)(z + (Tb + (size_t)t1c * 16) * ZLD + C_KA);
                const bf16x8 KA00 = *(const bf16x8*)(kp0 + lofk), KA01 = *(const bf16x8*)(kp0 + lofk + 64), KA10 = *(const bf16x8*)(kp1 + lofk), KA11 = *(const bf16x8*)(kp1 + lofk + 64);
                const unsigned m0 = (selm[fr * 64 + (t0 >> 1)] >> ((t0 & 1) * 16 + fq * 4)) & 0xFu;
                const unsigned m1 = v1 ? ((selm[fr * 64 + (t1 >> 1)] >> ((t1 & 1) * 16 + fq * 4)) & 0xFu) : 0u;
                bf16x8 VA[4];
#pragma unroll
                for (int dt = 0; dt < 4; ++dt) { const char* vp = (const char*)(F.vt + ((size_t)b * 64 + dt * 16) * SEQ);
                    const uint2 lo = *(const uint2*)(vp + (size_t)t0 * 32 + lofv), hi = *(const uint2*)(vp + (size_t)t1c * 32 + lofv);
                    u32x4 pk; pk.x = lo.x; pk.y = lo.y; pk.z = hi.x; pk.w = hi.y; VA[dt] = __builtin_bit_cast(bf16x8, pk); }
#pragma unroll
                for (int hh = 0; hh < 2; ++hh) {
                    f32x4 s0 = __builtin_amdgcn_mfma_f32_16x16x32_bf16(KA00, Bqa[hh][0], zero4, 0, 0, 0); s0 = __builtin_amdgcn_mfma_f32_16x16x32_bf16(KA01, Bqa[hh][1], s0, 0, 0, 0);
                    f32x4 s1 = __builtin_amdgcn_mfma_f32_16x16x32_bf16(KA10, Bqa[hh][0], zero4, 0, 0, 0); s1 = __builtin_amdgcn_mfma_f32_16x16x32_bf16(KA11, Bqa[hh][1], s1, 0, 0, 0);
                    float p0[4], p1[4];
#pragma unroll
                    for (int jj = 0; jj < 4; ++jj) { p0[jj] = ((m0 >> jj) & 1u) ? __expf(fminf(s0[jj] * 0.125f, 60.f)) : 0.f; p1[jj] = ((m1 >> jj) & 1u) ? __expf(fminf(s1[jj] * 0.125f, 60.f)) : 0.f; }
                    rs[hh] += (p0[0] + p0[1]) + (p0[2] + p0[3]) + (p1[0] + p1[1]) + (p1[2] + p1[3]);
                    u32x4 pk; pk.x = cvt_pk_bf16(p0[0], p0[1]); pk.y = cvt_pk_bf16(p0[2], p0[3]); pk.z = cvt_pk_bf16(p1[0], p1[1]); pk.w = cvt_pk_bf16(p1[2], p1[3]);
                    const bf16x8 PB = __builtin_bit_cast(bf16x8, pk);
#pragma unroll
                    for (int dt = 0; dt < 4; ++dt) O[dt][hh] = __builtin_amdgcn_mfma_f32_16x16x32_bf16(VA[dt], PB, O[dt][hh], 0, 0, 0);
                    __builtin_amdgcn_sched_barrier(0);
                }
            }
#pragma unroll
            for (int hh = 0; hh < 2; ++hh) { const int hd = hp * 2 + hh;
#pragma unroll
                for (int dt = 0; dt < 4; ++dt)
#pragma unroll
                    for (int jj = 0; jj < 4; ++jj) atomicAdd(&oacc[(hd * 64 + dt * 16 + fq * 4 + jj) * 16 + fr], O[dt][hh][jj]);
                float r = rs[hh]; r += __shfl_xor(r, 16); r += __shfl_xor(r, 32);
                if (fq == 0) atomicAdd(&rsum[hd * 16 + fr], r); }
        }
        __syncthreads();
#pragma unroll
        for (int i = 0; i < 16; ++i) { const int idx = tid + i * NTHR, q = idx >> 9, c = idx & 511, hd = c >> 6, d = c & 63;
            F.yb[(Tb + q0 + q) * 512 + c] = f2bf(oacc[(hd * 64 + d) * 16 + q] / rsum[hd * 16 + q]); }
        __syncthreads();
    }
}

__device__ void p4_post(const Frame& F) {
    const int tid = F.tid; const float* mu = F.in[3]; const float* gnw = F.in[12]; const float* gnb = F.in[13]; const bf16_t* z = F.z;
    for (int g = blockIdx.x * 16 + (tid >> 5); g < NTOK * 8; g += gridDim.x * 16) { const size_t t = (size_t)(g >> 3); const int h = g & 7, c = h * 64 + (tid & 31) * 2;
        const float2 y = *(const float2*)(F.yraw + t * 512 + c);
        const float mean = red32(y.x + y.y) * (1.0f / 64.0f); const float dx = y.x - mean, dy = y.y - mean;
        const float var = red32(dx * dx + dy * dy) * (1.0f / 64.0f); const float rstd = rsqrtf(var + 64e-5f);
        const unsigned vc = *(const unsigned*)(z + t * ZLD + C_V + c); const unsigned vp = (t & (SEQ - 1)) ? *(const unsigned*)(z + (t - 1) * ZLD + C_V + c) : 0u;
        const float vs0 = bflo(vc) + (bflo(vp) - bflo(vc)) * mu[C_V + c], vs1 = bfhi(vc) + (bfhi(vp) - bfhi(vc)) * mu[C_V + c + 1];
        const float bon = F.bonus[t * 8 + h]; const unsigned gt = *(const unsigned*)(F.gt + t * 512 + c);
        const float o0 = (dx * rstd * gnw[c] + gnb[c] + bon * vs0) * bflo(gt), o1 = (dy * rstd * gnw[c + 1] + gnb[c + 1] + bon * vs1) * bfhi(gt);
        *(unsigned*)(F.ya + t * 512 + c) = cvt_pk_bf16(o0, o1); }
}

__device__ void p9_final(const Frame& F) {
    const float* g = F.in[19]; const int lane = F.lane;
    for (int row = blockIdx.x * 8 + F.wave; row < NTOK; row += gridDim.x * 8) {
        float* xr = F.out + (size_t)row * DM; const float sc = rsqrtf(F.ss2[row] * (1.0f / 1024.0f) + 1e-6f);
#pragma unroll
        for (int i = 0; i < 4; ++i) { f32x4 v = *(const f32x4*)(xr + i * 256 + lane * 4); const f32x4 gg = *(const f32x4*)(g + i * 256 + lane * 4);
            v[0] *= sc * gg[0]; v[1] *= sc * gg[1]; v[2] *= sc * gg[2]; v[3] *= sc * gg[3]; *(f32x4*)(xr + i * 256 + lane * 4) = v; }
    }
}
#ifndef PHASE_MASK
#define PHASE_MASK 0x3ff
#endif
constexpr int NPHASE = 10;
template <class Epi> __device__ __forceinline__ void run_gemm(const bf16_t* A, const bf16_t* Bt, int N, int K, const Epi& E) {
    pg8::Gemm g{A, Bt, NTOK, N, K}; pg8::StaticOrder S; S.init(NTOK, N, (int)gridDim.x, (int)blockIdx.x);
    pg8::gemm_phase<Epi, pg8::StaticOrder, false>((PG8_LAS unsigned char*)g_lds, g, S, E, nullptr);
}
__global__ void __launch_bounds__(NTHR, 2) mega_fwd(Args args) {
    Frame F;
#pragma unroll
    for (int i = 0; i < 20; ++i) F.in[i] = args.in[i];
    F.out = args.out; F.ws = args.ws; F.lds = nullptr; F.tid = threadIdx.x; F.lane = F.tid & 63; F.wave = __builtin_amdgcn_readfirstlane(F.tid >> 6);
    unsigned char* ws = args.ws;
    F.ss1 = (float*)(ws + WS_SS1); F.ss2 = (float*)(ws + WS_SS2); F.bonus = (float*)(ws + WS_BONUS); F.rope = (float2*)(ws + WS_ROPE);
    F.wd = (bf16_t*)(ws + WS_WD); F.wi = (bf16_t*)(ws + WS_WI); F.wg = (bf16_t*)(ws + WS_WG);
    F.win = (bf16_t*)(ws + WS_WIN); F.wup = (bf16_t*)(ws + WS_WUP); F.wdn = (bf16_t*)(ws + WS_WDN); F.wb = (bf16_t*)(ws + WS_WB); F.wo = (bf16_t*)(ws + WS_WO); F.vt = (bf16_t*)(ws + WS_VT);
    F.h = (bf16_t*)(ws + WS_H); F.ya = F.h; F.yb = F.h + (size_t)NTOK * 512; F.xb = F.h;
    F.z = (bf16_t*)(ws + WS_Z); F.hid = F.z;
    F.lw = (bf16_t*)(ws + WS_P); F.ic = F.lw + (size_t)NTOK * 512; F.mg = F.lw;
    F.yraw = args.out; F.gt = (bf16_t*)(args.out + (size_t)NTOK * 512);
    const int lo = args.ph_lo, hi = args.ph_hi;
    cg::grid_group grid = cg::this_grid();
#define IN(k) (lo <= (k) && (k) < hi)
#define SEAM(k) do { if (IN(k) && IN((k) + 1)) grid.sync(); } while (0)
    if (((PHASE_MASK >> 0) & 1) && IN(0)) { p0_prologue(F); __syncthreads(); } SEAM(0);
    if (((PHASE_MASK >> 1) & 1) && IN(1)) { pg8::EpiZ E{F.z, ZLD}; run_gemm(F.h, F.win, 5120, 1024, E); __syncthreads(); } SEAM(1);
    if (((PHASE_MASK >> 2) & 1) && IN(2)) { p2_prep(F); __syncthreads(); } SEAM(2);
    if (((PHASE_MASK >> 3) & 1) && IN(3)) { p3_scan(F); __syncthreads(); p3_dsa(F); __syncthreads(); } SEAM(3);
    if (((PHASE_MASK >> 4) & 1) && IN(4)) { p4_post(F); __syncthreads(); } SEAM(4);
    if (((PHASE_MASK >> 5) & 1) && IN(5)) { pg8::EpiGate<0> E0{F.mg, F.z, ZLD, C_G0}; run_gemm(F.ya, F.wb, 1024, 512, E0); __syncthreads();
                 pg8::EpiGate<1> E1{F.mg, F.z, ZLD, C_G1}; run_gemm(F.yb, F.wb + 1024 * 512, 1024, 512, E1); __syncthreads(); } SEAM(5);
    if (((PHASE_MASK >> 6) & 1) && IN(6)) { pg8::EpiRes<true> E{F.in[0], F.out, F.xb, F.ss1}; run_gemm(F.mg, F.wo, 1024, 1024, E); __syncthreads(); } SEAM(6);
    if (((PHASE_MASK >> 7) & 1) && IN(7)) { pg8::EpiHid E{F.hid, F.ss1}; run_gemm(F.xb, F.wup, 4096, 1024, E); __syncthreads(); } SEAM(7);
    if (((PHASE_MASK >> 8) & 1) && IN(8)) { pg8::EpiRes<false> E{F.out, F.out, nullptr, F.ss2}; run_gemm(F.hid, F.wdn, 1024, 4096, E); __syncthreads(); } SEAM(8);
    if (((PHASE_MASK >> 9) & 1) && IN(9)) { p9_final(F); }
#undef IN
#undef SEAM
}

extern "C" void kernel_launch(void* const* d_in, const int* in_sizes, int n_in, void* d_out, int out_size, void* d_ws, size_t ws_size, hipStream_t stream) {
    static int grid = 0;
    if (grid == 0) {
        if (n_in != 20 || out_size != NTOK * DM || ws_size < WS_END) { fprintf(stderr, "kernel_launch: unexpected shapes (n_in %d, out %d, ws %zu < %zu)\n", n_in, out_size, ws_size, (size_t)WS_END); grid = -1; return; }
        int dev = 0, cus = 0, per_cu = 0;
        hipGetDevice(&dev); hipDeviceGetAttribute(&cus, hipDeviceAttributeMultiprocessorCount, dev);
        if (hipFuncSetAttribute((const void*)mega_fwd, hipFuncAttributeMaxDynamicSharedMemorySize, LDS_BYTES) != hipSuccess) { fprintf(stderr, "kernel_launch: hipFuncSetAttribute failed\n"); grid = -1; return; }
        if (hipOccupancyMaxActiveBlocksPerMultiprocessor(&per_cu, (const void*)mega_fwd, NTHR, LDS_BYTES) != hipSuccess || per_cu < 1) { fprintf(stderr, "kernel_launch: occupancy query failed (%d)\n", per_cu); per_cu = 1; }
        (void)hipGetLastError();
        grid = cus * per_cu;
        fprintf(stderr, "kernel_launch: grid %d (%d CUs x %d)\n", grid, cus, per_cu);
    }
    if (grid < 0) return;
    Args a{};
    for (int i = 0; i < 20; ++i) a.in[i] = (const float*)d_in[i];
    a.out = (float*)d_out; a.ws = (unsigned char*)d_ws;
#if MK_PER_PHASE_LAUNCH
    for (int p = 0; p < NPHASE; ++p) { a.ph_lo = p; a.ph_hi = p + 1; hipLaunchKernelGGL(mega_fwd, dim3(grid), dim3(NTHR), LDS_BYTES, stream, a); }
#else
    a.ph_lo = 0; a.ph_hi = NPHASE;
    void* kargs[] = {&a};
    hipError_t e = hipLaunchCooperativeKernel((const void*)mega_fwd, dim3(grid), dim3(NTHR), kargs, LDS_BYTES, stream);
    if (e != hipSuccess) fprintf(stderr, "kernel_launch: cooperative launch failed: %s (grid %d)\n", hipGetErrorString(e), grid);
#endif
}
```

```cpp
#include <hip/hip_runtime.h>
#include <hip/hip_cooperative_groups.h>
#include <cstdio>
#include <cstdint>
namespace cg = cooperative_groups;

#ifndef MK_PER_PHASE_LAUNCH
#define MK_PER_PHASE_LAUNCH 0
#endif

namespace pg8 {
#define PG8_LAS __attribute__((address_space(3)))
typedef unsigned short bf16_t;
typedef short bf16x8 __attribute__((ext_vector_type(8)));
typedef float f32x4 __attribute__((ext_vector_type(4)));
typedef unsigned u32x4 __attribute__((ext_vector_type(4)));
constexpr int BM = 256, BK = 64, HALF = 128, HTB = HALF * BK * 2  , STAGE_BYTES = 8 * HTB, NXCD = 8, WGM = 8;

__host__ __device__ __forceinline__ int lds_byte(int r, int c) { const int st = (r >> 4) * 2 + (c >> 5), rr = r & 15, cc = c & 31, ob = rr * 64 + cc * 2; return st * 1024 + (ob ^ (((ob >> 9) & 1) << 5)); }
__host__ __device__ __forceinline__ void stage_rc(int b, int& R, int& C) { const int st = b / 1024, sb = b % 1024, swz = sb ^ (((sb >> 9) & 1) << 5); R = (st >> 1) * 16 + swz / 64; C = (st & 1) * 32 + (swz % 64) / 2; }
__host__ __device__ __forceinline__ int perm32(int rho) { const int n = rho >> 4, i = rho & 15; return 8 * (i >> 2) + 4 * n + (i & 3); }

struct Unit { int pm, pn; };
struct Gemm { const bf16_t* A; const bf16_t* Bt; int M, N, K; };

struct StaticOrder {
    int nM, nN, nwg, G, c;
    __host__ __device__ void init(int M, int N, int G_, int c_) { nM = M / BM; nN = N / BM; nwg = nM * nN; G = G_; c = c_; }
    __host__ __device__ bool next(int i, Unit& u) const {
        const long L = (long)i * G + c; if (L >= nwg) return false;
        int wgid = (int)L; { const int q = nwg / NXCD, r = nwg % NXCD, xcd = wgid % NXCD, off = wgid / NXCD; wgid = (xcd < r ? xcd * (q + 1) : r * (q + 1) + (xcd - r) * q) + off; }
        const int nig = WGM * nN, gid = wgid / nig, fm = gid * WGM, gsz = (nM - fm) < WGM ? (nM - fm) : WGM;
        u.pm = fm + ((wgid % nig) % gsz); u.pn = (wgid % nig) / gsz; return true;
    }
    __device__ __forceinline__ void a_ready(const Unit&) const {}
    __device__ __forceinline__ void done(const Unit&) const {}
};
__device__ __forceinline__ unsigned cvt_pk_bf16(float lo, float hi) { unsigned r; asm volatile("v_cvt_pk_bf16_f32 %0, %1, %2" : "=v"(r) : "v"(lo), "v"(hi)); return r; }
typedef float f32x2 __attribute__((ext_vector_type(2)));
__device__ __forceinline__ float bflo(unsigned u) { return __uint_as_float(u << 16); }
__device__ __forceinline__ float bfhi(unsigned u) { return __uint_as_float(u & 0xffff0000u); }
__device__ __forceinline__ float sigm(float x) { return 1.0f / (1.0f + __expf(-x)); }

struct EpiZ {
    static constexpr bool PERM = true, AFTER_DRAIN = false;
    bf16_t* O; int ldc;
    __device__ __forceinline__ void operator()(const f32x4 (&acc)[2][2][4][2], const Unit& u, int wr, int wc, int fr, int fq) const {
        const int row0 = u.pm * BM + wr * 64 + fr, col0 = u.pn * BM + wc * 32 + 8 * fq;
#pragma unroll
        for (int ai = 0; ai < 2; ++ai)
#pragma unroll
            for (int m = 0; m < 4; ++m) { bf16_t* rowp = O + (size_t)(row0 + ai * HALF + m * 16) * ldc + col0;
#pragma unroll
                for (int bj = 0; bj < 2; ++bj) { const f32x4 v0 = acc[ai][bj][m][0], v1 = acc[ai][bj][m][1];
                    u32x4 w; w.x = cvt_pk_bf16(v0[0], v0[1]); w.y = cvt_pk_bf16(v0[2], v0[3]); w.z = cvt_pk_bf16(v1[0], v1[1]); w.w = cvt_pk_bf16(v1[2], v1[3]);
                    *(u32x4*)(rowp + bj * HALF) = w; } }
    }
};
template <int MODE> struct EpiGate {
    static constexpr bool PERM = true, AFTER_DRAIN = false;
    bf16_t* O; const bf16_t* Z; int zld; int gcol;
    __device__ __forceinline__ void operator()(const f32x4 (&acc)[2][2][4][2], const Unit& u, int wr, int wc, int fr, int fq) const {
        const int row0 = u.pm * BM + wr * 64 + fr, col0 = u.pn * BM + wc * 32 + 8 * fq;
#pragma unroll
        for (int ai = 0; ai < 2; ++ai)
#pragma unroll
            for (int m = 0; m < 4; ++m) { const size_t row = (size_t)(row0 + ai * HALF + m * 16);
                bf16_t* op = O + row * 1024 + col0; const bf16_t* zp = Z + row * zld + gcol + col0;
#pragma unroll
                for (int bj = 0; bj < 2; ++bj) { const f32x4 v0 = acc[ai][bj][m][0], v1 = acc[ai][bj][m][1];
                    const u32x4 g = *(const u32x4*)(zp + bj * HALF);
                    float r0 = v0[0] * sigm(bflo(g.x)), r1 = v0[1] * sigm(bfhi(g.x)), r2 = v0[2] * sigm(bflo(g.y)), r3 = v0[3] * sigm(bfhi(g.y));
                    float r4 = v1[0] * sigm(bflo(g.z)), r5 = v1[1] * sigm(bfhi(g.z)), r6 = v1[2] * sigm(bflo(g.w)), r7 = v1[3] * sigm(bfhi(g.w));
                    if (MODE == 1) { const u32x4 p = *(const u32x4*)(op + bj * HALF);
                        r0 += bflo(p.x); r1 += bfhi(p.x); r2 += bflo(p.y); r3 += bfhi(p.y); r4 += bflo(p.z); r5 += bfhi(p.z); r6 += bflo(p.w); r7 += bfhi(p.w); }
                    u32x4 w; w.x = cvt_pk_bf16(r0, r1); w.y = cvt_pk_bf16(r2, r3); w.z = cvt_pk_bf16(r4, r5); w.w = cvt_pk_bf16(r6, r7);
                    *(u32x4*)(op + bj * HALF) = w; } }
    }
};
template <bool WITH_XB> struct EpiRes {
    static constexpr bool PERM = false, AFTER_DRAIN = false;
    const float* X; float* O; bf16_t* XB; float* SS;
    __device__ __forceinline__ void operator()(const f32x4 (&acc)[2][2][4][2], const Unit& u, int wr, int wc, int fr, int fq) const {
        const int row0 = u.pm * BM + wr * 64 + fr, col0 = u.pn * BM + wc * 32 + 4 * fq;
#pragma unroll
        for (int ai = 0; ai < 2; ++ai)
#pragma unroll
            for (int m = 0; m < 4; ++m) { const size_t row = (size_t)(row0 + ai * HALF + m * 16); float ssq = 0.f;
#pragma unroll
                for (int bj = 0; bj < 2; ++bj)
#pragma unroll
                    for (int n = 0; n < 2; ++n) { const size_t off = row * 1024 + col0 + bj * HALF + n * 16;
                        const f32x4 xv = *(const f32x4*)(X + off); const f32x4 v = acc[ai][bj][m][n] + xv;
                        *(f32x4*)(O + off) = v; ssq += v[0] * v[0] + v[1] * v[1] + v[2] * v[2] + v[3] * v[3];
                        if (WITH_XB) { uint2 w; w.x = cvt_pk_bf16(v[0], v[1]); w.y = cvt_pk_bf16(v[2], v[3]); *(uint2*)(XB + off) = w; } }
                ssq += __shfl_xor(ssq, 16); ssq += __shfl_xor(ssq, 32);
                if (fq == 0) atomicAdd(SS + row, ssq); }
    }
};
struct EpiHid {
    static constexpr bool PERM = true, AFTER_DRAIN = false;
    bf16_t* O; const float* SS;
    __device__ __forceinline__ void operator()(const f32x4 (&acc)[2][2][4][2], const Unit& u, int wr, int wc, int fr, int fq) const {
        const int row0 = u.pm * BM + wr * 64 + fr, col0 = u.pn * BM + wc * 32 + 8 * fq;
#pragma unroll
        for (int ai = 0; ai < 2; ++ai)
#pragma unroll
            for (int m = 0; m < 4; ++m) { const size_t row = (size_t)(row0 + ai * HALF + m * 16);
                const float s2 = 1.0f / (SS[row] * (1.0f / 1024.0f) + 1e-6f);
                bf16_t* rowp = O + row * 4096 + col0;
#pragma unroll
                for (int bj = 0; bj < 2; ++bj) { f32x4 v0 = acc[ai][bj][m][0], v1 = acc[ai][bj][m][1];
#pragma unroll
                    for (int j = 0; j < 4; ++j) { float a = fmaxf(v0[j], 0.f), b = fmaxf(v1[j], 0.f); v0[j] = a * a * s2; v1[j] = b * b * s2; }
                    u32x4 w; w.x = cvt_pk_bf16(v0[0], v0[1]); w.y = cvt_pk_bf16(v0[2], v0[3]); w.z = cvt_pk_bf16(v1[0], v1[1]); w.w = cvt_pk_bf16(v1[2], v1[3]);
                    *(u32x4*)(rowp + bj * HALF) = w; } }
    }
};

template <class Epi, class Sched, bool STAMP = false>
__device__ __forceinline__ void gemm_phase(PG8_LAS unsigned char* lds, const Gemm g, const Sched& S, const Epi& E, unsigned long long* stamps) {
    const int tid = threadIdx.x, wid = __builtin_amdgcn_readfirstlane(tid >> 6), lane = tid & 63, wr = wid >> 2, wc = wid & 3, fr = lane & 15, fq = lane >> 4;
    const int K = g.K, nt = K / BK;
    int ts_lo = 0, ts_hi = 0, nts = 0; const unsigned long long rt_entry = STAMP ? (unsigned long long)wall_clock64() : 0ull;
#define PG8_STAMP() do { if (STAMP && wid == 0 && nts < 64) { const unsigned long long _c = (unsigned long long)clock64(); \
        ts_lo = (lane == nts) ? (int)(unsigned)_c : ts_lo; ts_hi = (lane == nts) ? (int)(unsigned)(_c >> 32) : ts_hi; ++nts; } } while (0)
    PG8_STAMP();
    unsigned voffA[2], voffB[2];
#pragma unroll
    for (int i = 0; i < 2; ++i) { int R, C; stage_rc(tid * 16 + i * 8192, R, C); const int Rb = Epi::PERM ? ((R & ~31) + perm32(R & 31)) : R;
        voffA[i] = (unsigned)(R * K + C) * 2u; voffB[i] = (unsigned)(Rb * K + C) * 2u; }
    const size_t kstep = (size_t)(BK * 2);
    const size_t hstep = (size_t)HALF * K * 2;
    const size_t tstep = 2 * hstep;
    const unsigned ldsw = (unsigned)wid * 1024u;
    const int aoff = lds_byte(wr * 64 + fr, fq * 8), boff = lds_byte(wc * 32 + fr, fq * 8);
#define PG8_SA(b, h) (((b) * 2 + (h)) * HTB)
#define PG8_SB(b, h) ((4 + (b) * 2 + (h)) * HTB)
#define PG8_STAGE(bufoff, gbase, voff) do { _Pragma("unroll") for (int _i = 0; _i < 2; ++_i) \
        __builtin_amdgcn_global_load_lds((const unsigned*)((const char*)(gbase) + (voff)[_i]), (PG8_LAS unsigned*)(lds + (bufoff) + ldsw + _i * 8192), 16, 0, 0); } while (0)
#define PG8_LDA(dst, b, h) do { _Pragma("unroll") for (int m = 0; m < 4; ++m) _Pragma("unroll") for (int k = 0; k < 2; ++k) dst[m][k] = *(const PG8_LAS bf16x8*)(lds + PG8_SA(b, h) + aoff + m * 2048 + k * 1024); } while (0)
#define PG8_LDB(dst, b, h) do { _Pragma("unroll") for (int n = 0; n < 2; ++n) _Pragma("unroll") for (int k = 0; k < 2; ++k) dst[n][k] = *(const PG8_LAS bf16x8*)(lds + PG8_SB(b, h) + boff + n * 2048 + k * 1024); } while (0)
#define PG8_MMA(ai, bj, At, Bt) do { __builtin_amdgcn_s_setprio(1); _Pragma("unroll") for (int m = 0; m < 4; ++m) _Pragma("unroll") for (int n = 0; n < 2; ++n) _Pragma("unroll") for (int k = 0; k < 2; ++k) \
        acc[ai][bj][m][n] = __builtin_amdgcn_mfma_f32_16x16x32_bf16(Bt[n][k], At[m][k], acc[ai][bj][m][n], 0, 0, 0); __builtin_amdgcn_s_setprio(0); } while (0)
#define PG8_WAIT_V(n) asm volatile("s_waitcnt vmcnt(" #n ")" ::: "memory")
#define PG8_WAIT_L(n) asm volatile("s_waitcnt lgkmcnt(" #n ")" ::: "memory")
#define PG8_BAR __builtin_amdgcn_s_barrier()
#define PG8_SCHED __builtin_amdgcn_sched_barrier(0)
    Unit cur, nxt; int ui = 0;
    if (!S.next(0, cur)) return;
    f32x4 acc[2][2][4][2];
#pragma unroll
    for (int a = 0; a < 2; ++a)
#pragma unroll
        for (int b = 0; b < 2; ++b)
#pragma unroll
            for (int m = 0; m < 4; ++m)
#pragma unroll
                for (int n = 0; n < 2; ++n) acc[a][b][m][n] = (f32x4){0.f, 0.f, 0.f, 0.f};
    bf16x8 At[4][2], B0[2][2], B1[2][2];
    const char* cA = (const char*)g.A + (size_t)cur.pm * tstep; const char* cB = (const char*)g.Bt + (size_t)cur.pn * tstep;
    S.a_ready(cur);
    PG8_STAGE(PG8_SB(0, 0), cB, voffB); PG8_STAGE(PG8_SA(0, 0), cA, voffA); PG8_STAGE(PG8_SB(0, 1), cB + hstep, voffB); PG8_STAGE(PG8_SA(0, 1), cA + hstep, voffA);
    if (wr == 1) PG8_BAR;
    PG8_WAIT_V(4); PG8_BAR;
    PG8_STAGE(PG8_SB(1, 0), cB + kstep, voffB); PG8_STAGE(PG8_SA(1, 0), cA + kstep, voffA); PG8_STAGE(PG8_SB(1, 1), cB + hstep + kstep, voffB);
    PG8_WAIT_V(6); PG8_BAR;
    PG8_STAMP();
    for (;;) {
        const bool has_next = S.next(ui + 1, nxt);
        const char* nA = has_next ? (const char*)g.A + (size_t)nxt.pm * tstep : cA; const char* nB = has_next ? (const char*)g.Bt + (size_t)nxt.pn * tstep : cB;
        for (int t = 0; t < nt; t += 2) {
            const bool last = (t == nt - 2);
            const char* a1 = cA + (size_t)(t + 1) * kstep;
            const char* a2 = last ? nA : cA + (size_t)(t + 2) * kstep; const char* b2 = last ? nB : cB + (size_t)(t + 2) * kstep;
            const char* a3 = a2 + kstep; const char* b3 = b2 + kstep;
            if (last && has_next) S.a_ready(nxt);
            PG8_LDB(B0, 0, 0); PG8_SCHED; PG8_LDA(At, 0, 0); PG8_STAGE(PG8_SA(1, 1), a1 + hstep, voffA);
            PG8_WAIT_L(8); PG8_BAR; PG8_WAIT_L(0); PG8_MMA(0, 0, At, B0); PG8_BAR; PG8_SCHED;
            PG8_LDB(B1, 0, 1); PG8_STAGE(PG8_SB(0, 0), b2, voffB);
            PG8_BAR; PG8_WAIT_L(0); PG8_MMA(0, 1, At, B1); PG8_BAR;
            PG8_LDA(At, 0, 1); PG8_STAGE(PG8_SA(0, 0), a2, voffA);
            PG8_BAR; PG8_WAIT_L(0); PG8_MMA(1, 0, At, B0); PG8_BAR; PG8_SCHED;
            PG8_STAGE(PG8_SB(0, 1), b2 + hstep, voffB);
            PG8_WAIT_V(6); PG8_BAR; PG8_MMA(1, 1, At, B1); PG8_BAR;
            PG8_LDB(B0, 1, 0); PG8_SCHED; PG8_LDA(At, 1, 0); PG8_STAGE(PG8_SA(0, 1), a2 + hstep, voffA);
            PG8_WAIT_L(8); PG8_BAR; PG8_WAIT_L(0); PG8_MMA(0, 0, At, B0); PG8_BAR; PG8_SCHED;
            PG8_LDB(B1, 1, 1); PG8_STAGE(PG8_SB(1, 0), b3, voffB);
            PG8_BAR; PG8_WAIT_L(0); PG8_MMA(0, 1, At, B1); PG8_BAR;
            PG8_LDA(At, 1, 1); PG8_STAGE(PG8_SA(1, 0), a3, voffA);
            PG8_BAR; PG8_WAIT_L(0); PG8_MMA(1, 0, At, B0); PG8_BAR; PG8_SCHED;
            PG8_STAGE(PG8_SB(1, 1), b3 + hstep, voffB);
            PG8_WAIT_V(6); PG8_BAR; PG8_MMA(1, 1, At, B1); PG8_BAR;
        }
        PG8_STAMP();
        if constexpr (!Epi::AFTER_DRAIN) { E(acc, cur, wr, wc, fr, fq); S.done(cur); }
        PG8_STAMP();
        if (!has_next) break;
#pragma unroll
        for (int a = 0; a < 2; ++a)
#pragma unroll
            for (int b = 0; b < 2; ++b)
#pragma unroll
                for (int m = 0; m < 4; ++m)
#pragma unroll
                    for (int n = 0; n < 2; ++n) acc[a][b][m][n] = (f32x4){0.f, 0.f, 0.f, 0.f};
        cur = nxt; cA = nA; cB = nB; ++ui;
    }
    PG8_WAIT_V(0);
    if (wr == 0) PG8_BAR;
    PG8_BAR;
    if constexpr (Epi::AFTER_DRAIN) { E.fused(acc, cur, wr, wc, fr, fq, lds, wid, lane); S.done(cur); }
    PG8_STAMP();
    if (STAMP && wid == 0) { stamps[lane] = lane < nts ? (((unsigned long long)(unsigned)ts_hi << 32) | (unsigned)ts_lo) : 0ull;
        if (lane == 62) stamps[62] = rt_entry; if (lane == 63) stamps[63] = (unsigned long long)wall_clock64(); }
#undef PG8_STAMP
#undef PG8_SA
#undef PG8_SB
#undef PG8_STAGE
#undef PG8_LDA
#undef PG8_LDB
#undef PG8_MMA
#undef PG8_WAIT_V
#undef PG8_WAIT_L
#undef PG8_BAR
#undef PG8_SCHED
}
}
extern __shared__ __attribute__((aligned(16))) unsigned char g_lds[];
using pg8::bf16_t; using pg8::bf16x8; using pg8::f32x4; using pg8::u32x4; using pg8::cvt_pk_bf16; using pg8::bflo; using pg8::bfhi; using pg8::sigm;

constexpr int NTOK = 32768, DM = 1024, SEQ = 2048, NB = 16, ZLD = 5120, NTHR = 512;
constexpr int C_R = 0, C_K = 512, C_V = 1024, C_WD = 1536, C_AD = 1600, C_GD = 1664;
constexpr int C_Q = 1824, C_KA = 2336, C_VA = 2400, C_QI = 2464, C_KI = 2976, C_WI = 3040, C_G0 = 3048, C_G1 = 4072;
constexpr size_t MiB = 1024 * 1024;
constexpr size_t WS_SS1 = 0, WS_SS2 = 128 * 1024, WS_BONUS = 256 * 1024, WS_ROPE = 1280 * 1024, WS_WD = 1792 * 1024, WS_WI = 1856 * 1024, WS_WG = 1920 * 1024;
constexpr size_t WS_WIN = 4 * MiB, WS_WUP = 14 * MiB, WS_WDN = 22 * MiB, WS_WB = 30 * MiB, WS_WO = 32 * MiB, WS_VT = 34 * MiB, WS_H = 38 * MiB, WS_Z = 102 * MiB, WS_P = 422 * MiB, WS_END = 486 * MiB;
constexpr int LDS_BYTES = 131072;

struct Args { const float* in[20]; float* out; unsigned char* ws; int ph_lo, ph_hi; };

struct Frame {
    const float* in[20]; float* out; unsigned char* ws; unsigned char* lds; int tid, lane, wave;
    float *ss1, *ss2, *bonus; float2* rope; bf16_t *wd, *wi, *wg, *win, *wup, *wdn, *wb, *wo, *vt, *h, *ya, *yb, *xb, *z, *hid, *lw, *ic, *mg, *gt; float* yraw;
};

__device__ __forceinline__ bf16_t f2bf(float f) { return (bf16_t)(cvt_pk_bf16(f, 0.f) & 0xffffu); }
__device__ __forceinline__ float bf2f(bf16_t b) { return __uint_as_float(((unsigned)b) << 16); }
template <int CTRL> __device__ __forceinline__ float dpp_mov(float x) { return __int_as_float(__builtin_amdgcn_update_dpp(0, __float_as_int(x), CTRL, 0xF, 0xF, true)); }
__device__ __forceinline__ float red16(float x) { x += dpp_mov<0xB1>(x); x += dpp_mov<0x4E>(x); x += dpp_mov<0x141>(x); x += dpp_mov<0x140>(x); return x; }
__device__ __forceinline__ float red32(float x) { x += __shfl_xor(x, 1); x += __shfl_xor(x, 2); x += __shfl_xor(x, 4); x += __shfl_xor(x, 8); x += __shfl_xor(x, 16); return x; }
__device__ __forceinline__ float red64(float x) { x = red32(x); x += __shfl_xor(x, 32); return x; }
__device__ __forceinline__ float softplus_f(float x) { return fmaxf(x, 0.f) + log1pf(__expf(-fabsf(x))); }

__device__ void tconv(const Frame& F, const float* __restrict__ W, int K, int N, int Npad, bf16_t* __restrict__ Wt, const float* __restrict__ rs) {
    float* tile = (float*)g_lds;
    const int ktn = (K + 63) / 64, ntn = Npad / 64, tid = F.tid;
    for (int tl = blockIdx.x; tl < ktn * ntn; tl += gridDim.x) {
        const int kt = tl % ktn, nt = tl / ktn;
#pragma unroll
        for (int i = 0; i < 8; ++i) { const int idx = tid + i * NTHR, kk = idx >> 6, nn = idx & 63, k = kt * 64 + kk, n = nt * 64 + nn;
            float v = (k < K && n < N) ? W[(size_t)k * N + n] : 0.f; if (rs != nullptr && k < K) v *= rs[k]; tile[kk * 65 + nn] = v; }
        __syncthreads();
#pragma unroll
        for (int i = 0; i < 8; ++i) { const int idx = tid + i * NTHR, nn = idx >> 6, kk = idx & 63, k = kt * 64 + kk, n = nt * 64 + nn;
            if (k < K) Wt[(size_t)n * K + k] = f2bf(tile[kk * 65 + nn]); }
        __syncthreads();
    }
}
__device__ void p0_prologue(const Frame& F) {
    const int tid = F.tid, gtid = blockIdx.x * NTHR + tid, gn = gridDim.x * NTHR;
    for (int i = gtid; i < 2 * NTOK; i += gn) F.ss1[i] = 0.f;
    for (int i = gtid; i < SEQ * 32; i += gn) { const int pos = i >> 5, j = i & 31;
        const float inv = 1.0f / powf(10000.0f, (float)(2 * j) / 64.0f); const float ang = (float)pos * inv;
        double rev = (double)ang * 0.15915494309189535; rev -= floor(rev); const float fr = (float)rev;
        F.rope[i] = make_float2(__builtin_amdgcn_cosf(fr), __builtin_amdgcn_sinf(fr)); }
    tconv(F, F.in[2], 1024, 5096, 5120, F.win, nullptr);
    tconv(F, F.in[17], 1024, 4096, 4096, F.wup, F.in[16]);
    tconv(F, F.in[18], 4096, 1024, 1024, F.wdn, nullptr);
    tconv(F, F.in[14], 512, 1024, 1024, F.wb, nullptr);
    tconv(F, F.in[14] + 512 * 1024, 512, 1024, 1024, F.wb + 1024 * 512, nullptr);
    tconv(F, F.in[15], 1024, 1024, 1024, F.wo, nullptr);
    tconv(F, F.in[5], 64, 512, 512, F.wd, nullptr);
    tconv(F, F.in[7], 64, 512, 512, F.wi, nullptr);
    tconv(F, F.in[8], 160, 512, 512, F.wg, nullptr);
    const float* x = F.in[0]; const float* g = F.in[1]; const int lane = F.lane;
    for (int row = blockIdx.x * 8 + F.wave; row < NTOK; row += gridDim.x * 8) {
        const float* xr = x + (size_t)row * DM; f32x4 v[4]; float ss = 0.f;
#pragma unroll
        for (int i = 0; i < 4; ++i) { v[i] = *(const f32x4*)(xr + i * 256 + lane * 4); ss += v[i][0] * v[i][0] + v[i][1] * v[i][1] + v[i][2] * v[i][2] + v[i][3] * v[i][3]; }
        ss = red64(ss); const float sc = rsqrtf(ss * (1.0f / 1024.0f) + 1e-6f);
#pragma unroll
        for (int i = 0; i < 4; ++i) { const f32x4 gg = *(const f32x4*)(g + i * 256 + lane * 4); uint2 w;
            w.x = cvt_pk_bf16(v[i][0] * sc * gg[0], v[i][1] * sc * gg[1]); w.y = cvt_pk_bf16(v[i][2] * sc * gg[2], v[i][3] * sc * gg[3]);
            *(uint2*)(F.h + (size_t)row * DM + i * 256 + lane * 4) = w; }
    }
}

__device__ void p2_prep(const Frame& F, const bool do_rope) {
    const int tid = F.tid, lane = F.lane, wave = F.wave, fr = lane & 15, fq = lane >> 4;
    bf16_t* z = F.z; const float* mu = F.in[3];
    {
        constexpr int LDA = 296; bf16_t* At = (bf16_t*)g_lds;
        const float* dbias = F.in[4]; const float* ibias = F.in[6];
        for (int tile = blockIdx.x; tile < NTOK / 16; tile += gridDim.x) {
            const int t0 = tile * 16;
            for (int idx = tid; idx < 16 * 288; idx += NTHR) { const int tok = idx / 288, c = idx - tok * 288, t = t0 + tok, col = C_WD + c;
                const float zt = bf2f(z[(size_t)t * ZLD + col]); const float zp = (t & (SEQ - 1)) ? bf2f(z[(size_t)(t - 1) * ZLD + col]) : 0.f;
                float v = zt + (zp - zt) * mu[col];
                if (c < 64) v = tanhf(v); else if (c >= 128) v = sigm(v);
                At[tok * LDA + c] = f2bf(v); }
            __syncthreads();
            const int h = wave;
#pragma unroll 1
            for (int j = 0; j < 4; ++j) { const int n = h * 64 + j * 16 + fr;
                f32x4 ad = {0.f, 0.f, 0.f, 0.f}, ai = ad, ag = ad;
#pragma unroll
                for (int ks = 0; ks < 2; ++ks) { const bf16x8 a = *(const bf16x8*)(At + fr * LDA + ks * 32 + fq * 8); const bf16x8 b = *(const bf16x8*)(F.wd + n * 64 + ks * 32 + fq * 8);
                    ad = __builtin_amdgcn_mfma_f32_16x16x32_bf16(a, b, ad, 0, 0, 0); }
#pragma unroll
                for (int ks = 0; ks < 2; ++ks) { const bf16x8 a = *(const bf16x8*)(At + fr * LDA + 64 + ks * 32 + fq * 8); const bf16x8 b = *(const bf16x8*)(F.wi + n * 64 + ks * 32 + fq * 8);
                    ai = __builtin_amdgcn_mfma_f32_16x16x32_bf16(a, b, ai, 0, 0, 0); }
#pragma unroll
                for (int ks = 0; ks < 5; ++ks) { const bf16x8 a = *(const bf16x8*)(At + fr * LDA + 128 + ks * 32 + fq * 8); const bf16x8 b = *(const bf16x8*)(F.wg + n * 160 + ks * 32 + fq * 8);
                    ag = __builtin_amdgcn_mfma_f32_16x16x32_bf16(a, b, ag, 0, 0, 0); }
                const float db = dbias[n], ib = ibias[n];
#pragma unroll
                for (int jj = 0; jj < 4; ++jj) { const size_t t = (size_t)(t0 + fq * 4 + jj);
                    const float dw = db + ad[jj]; const float wlog = -softplus_f(-dw) - 0.5f; const float lwv = -__expf(wlog);
                    F.lw[t * 512 + n] = f2bf(lwv); F.ic[t * 512 + n] = f2bf(sigm(ib + ai[jj])); F.gt[t * 512 + n] = f2bf(ag[jj]); }
            }
            __syncthreads();
        }
    }
    {
        unsigned short* tl = (unsigned short*)g_lds;
        for (int tile = blockIdx.x; tile < NTOK / 64; tile += gridDim.x) { const int t0 = tile * 64, b = t0 / SEQ, tt0 = t0 % SEQ;
#pragma unroll
            for (int i = 0; i < 8; ++i) { const int idx = tid + i * NTHR, tok = idx >> 6, d = idx & 63; tl[tok * 66 + d] = z[(size_t)(t0 + tok) * ZLD + C_VA + d]; }
            __syncthreads();
#pragma unroll
            for (int i = 0; i < 8; ++i) { const int idx = tid + i * NTHR, d = idx >> 6, tok = idx & 63; F.vt[((size_t)b * 64 + d) * SEQ + tt0 + tok] = tl[tok * 66 + d]; }
            __syncthreads();
        }
    }
    if (do_rope) {
        const int gtid = blockIdx.x * NTHR + tid, gn = gridDim.x * NTHR;
        for (int idx = gtid; idx < NTOK * 576; idx += gn) { const int t = idx / 576, p = idx - t * 576, hd = p >> 5, i = p & 31;
            const int base = hd < 8 ? C_Q + hd * 64 : (hd == 8 ? C_KA : (hd < 17 ? C_QI + (hd - 9) * 64 : C_KI));
            const float2 cs = F.rope[(t & (SEQ - 1)) * 32 + i];
            bf16_t* p1 = z + (size_t)t * ZLD + base + i; const float x1 = bf2f(p1[0]), x2 = bf2f(p1[32]);
            p1[0] = f2bf(x1 * cs.x - x2 * cs.y); p1[32] = f2bf(x2 * cs.x + x1 * cs.y); }
    }
}

struct ScanRaw { unsigned zr_c, zr_p, zk_c, zk_p, zv_c, zv_p, lwu, icu; };
struct ScanConst { float mur0, mur1, muk0, muk1, muv0, muv1, kk0, kk1, ka0, ka1, rk0, rk1; };
__device__ __forceinline__ void scan_load(ScanRaw& R, const bf16_t* z, const bf16_t* lw, const bf16_t* ic, size_t tokbase, int ch, int ptok, int gc) {
    const int t = ch * 16 + ptok; const size_t T = tokbase + t; const bf16_t* zp = z + T * ZLD + gc;
    R.zr_c = *(const unsigned*)(zp + C_R); R.zk_c = *(const unsigned*)(zp + C_K); R.zv_c = *(const unsigned*)(zp + C_V);
    if (t > 0) { R.zr_p = *(const unsigned*)(zp - ZLD + C_R); R.zk_p = *(const unsigned*)(zp - ZLD + C_K); R.zv_p = *(const unsigned*)(zp - ZLD + C_V); } else { R.zr_p = 0u; R.zk_p = 0u; R.zv_p = 0u; }
    R.lwu = *(const unsigned*)(lw + T * 512 + gc); R.icu = *(const unsigned*)(ic + T * 512 + gc);
}
__device__ __forceinline__ void scan_prep(const ScanRaw& R, const ScanConst& C, float* ops, float* vv, float* bonus_out, bool wr_bonus, int ptok, int pc, int v0, int tid) {
    const float rc0 = bflo(R.zr_c), rc1 = bfhi(R.zr_c), rp0 = bflo(R.zr_p), rp1 = bfhi(R.zr_p);
    const float kc0 = bflo(R.zk_c), kc1 = bfhi(R.zk_c), kp0 = bflo(R.zk_p), kp1 = bfhi(R.zk_p);
    const float vc0 = bflo(R.zv_c), vc1 = bfhi(R.zv_c), vp0 = bflo(R.zv_p), vp1 = bfhi(R.zv_p);
    const float r0 = rc0 + (rp0 - rc0) * C.mur0, r1 = rc1 + (rp1 - rc1) * C.mur1;
    const float k0 = kc0 + (kp0 - kc0) * C.muk0, k1 = kc1 + (kp1 - kc1) * C.muk1;
    const float vs0 = vc0 + (vp0 - vc0) * C.muv0, vs1 = vc1 + (vp1 - vc1) * C.muv1;
    const float ic0 = bflo(R.icu), ic1 = bfhi(R.icu); const float w0 = __expf(bflo(R.lwu)), w1 = __expf(bfhi(R.lwu));
    const float q0 = k0 * C.kk0, q1 = k1 * C.kk1; const float ss = red32(q0 * q0 + q1 * q1);
    const float inv = 1.0f / fmaxf(sqrtf(ss), 1e-12f); const float n0 = q0 * inv, n1 = q1 * inv;
    const float kn0 = k0 * (1.0f + (ic0 - 1.0f) * C.ka0), kn1 = k1 * (1.0f + (ic1 - 1.0f) * C.ka1);
    const float bon = red32(r0 * kn0 * C.rk0 + r1 * kn1 * C.rk1);
    if (wr_bonus && (tid & 31) == 0) *bonus_out = bon;
    float* op = ops + ptok * 320 + pc;
    *(float2*)(op) = make_float2(-n0, -n1); *(float2*)(op + 64) = make_float2(w0, w1); *(float2*)(op + 128) = make_float2(n0 * ic0, n1 * ic1);
    *(float2*)(op + 192) = make_float2(kn0, kn1); *(float2*)(op + 256) = make_float2(r0, r1);
    if (pc >= v0 && pc < v0 + 32) *(float2*)(vv + ptok * 32 + pc - v0) = make_float2(vs0, vs1);
}
__device__ void p3_scan(const Frame& F) {
    const int tid = F.tid;
    float* opsb = (float*)g_lds;
    float* vvb = opsb + 2 * 5120;
    float* yob = vvb + 2 * 512;
    float* dummy = yob + 2 * 512;
    const bf16_t* z = F.z; const float* mu = F.in[3]; const float* k_k = F.in[9]; const float* k_a = F.in[10]; const float* r_k = F.in[11];
    for (int item = blockIdx.x; item < 256; item += gridDim.x) {
        const int bh = item >> 1, half = item & 1, b = bh >> 3, h = bh & 7, v0 = half * 32;
        const int ptok = tid >> 5, pc = (tid & 31) * 2, gc = h * 64 + pc;
        ScanConst C; C.mur0 = mu[C_R + gc]; C.mur1 = mu[C_R + gc + 1]; C.muk0 = mu[C_K + gc]; C.muk1 = mu[C_K + gc + 1]; C.muv0 = mu[C_V + gc]; C.muv1 = mu[C_V + gc + 1];
        C.kk0 = k_k[gc]; C.kk1 = k_k[gc + 1]; C.ka0 = k_a[gc]; C.ka1 = k_a[gc + 1]; C.rk0 = r_k[gc]; C.rk1 = r_k[gc + 1];
        const int row = tid >> 4, ks = tid & 15;
        float S0 = 0.f, S1 = 0.f, S2 = 0.f, S3 = 0.f;
        const size_t tokbase = (size_t)b * SEQ;
        const int ywoff = (ks == 0) ? row : (2 * 512 + tid), ywstep = (ks == 0) ? 32 : 0;
        ScanRaw R;
        scan_load(R, z, F.lw, F.ic, tokbase, 0, ptok, gc);
        scan_prep(R, C, opsb, vvb, F.bonus + (tokbase + ptok) * 8 + h, half == 0, ptok, pc, v0, tid);
        scan_load(R, z, F.lw, F.ic, tokbase, 1, ptok, gc);
        __syncthreads();
        for (int ch = 0; ch < SEQ / 16; ++ch) {
            const int cur = ch & 1, nxt = cur ^ 1;
            if (ch + 1 < SEQ / 16) {
                scan_prep(R, C, opsb + nxt * 5120, vvb + nxt * 512, F.bonus + (tokbase + (ch + 1) * 16 + ptok) * 8 + h, half == 0, ptok, pc, v0, tid);
                if (ch + 2 < SEQ / 16) scan_load(R, z, F.lw, F.ic, tokbase, ch + 2, ptok, gc);
            }
            const float* ops = opsb + cur * 5120 + ks * 4; const float* vv = vvb + cur * 512 + row; float* yw = yob + cur * 512 + ywoff;
#pragma unroll
            for (int s = 0; s < 16; ++s) {
                const float* o = ops + s * 320;
                const f32x4 a4 = *(const f32x4*)(o), w4 = *(const f32x4*)(o + 64), b4 = *(const f32x4*)(o + 128), k4 = *(const f32x4*)(o + 192), r4 = *(const f32x4*)(o + 256);
                const float vval = vv[s * 32];
                float sa = (S0 * a4[0] + S1 * a4[1]) + (S2 * a4[2] + S3 * a4[3]); sa = red16(sa);
                S0 = S0 * w4[0] + sa * b4[0] + vval * k4[0]; S1 = S1 * w4[1] + sa * b4[1] + vval * k4[1];
                S2 = S2 * w4[2] + sa * b4[2] + vval * k4[2]; S3 = S3 * w4[3] + sa * b4[3] + vval * k4[3];
                float y = (S0 * r4[0] + S1 * r4[1]) + (S2 * r4[2] + S3 * r4[3]); y = red16(y);
                yw[s * ywstep] = y;
            }
            __syncthreads();
            { const int tok = tid >> 5, r = tid & 31; F.yraw[(tokbase + ch * 16 + tok) * 512 + h * 64 + v0 + r] = yob[cur * 512 + tok * 32 + r]; }
        }
        __syncthreads();
    }
}

__device__ __forceinline__ unsigned ordkey(float f) { const unsigned u = __float_as_uint(f); return (u & 0x80000000u) ? ~u : (u | 0x80000000u); }
__device__ void p3_dsa(const Frame& F) {
    const int tid = F.tid, lane = F.lane, wave = F.wave, fr = lane & 15, fq = lane >> 4;
    unsigned* selm = (unsigned*)g_lds;
    unsigned* eqm = selm + 1024;
    int* cnt = (int*)(eqm + 1024);
    int* eqpre = cnt + 256;
    unsigned char* kbuf = (unsigned char*)(eqpre + 1024);
    unsigned char* vbuf = kbuf + 2 * 9216;
    const bf16_t* z = F.z; const int G = gridDim.x, bx = blockIdx.x;
    const f32x4 zero4 = {0.f, 0.f, 0.f, 0.f};
    for (int rnd = 0; rnd * G < 2048; ++rnd) {
        const int n = rnd * G + ((rnd & 1) ? (G - 1 - bx) : bx);
        if (n >= 2048) continue;
        const int qg = 127 - (n >> 4), b = n & 15, q0 = qg * 16; const size_t Tb = (size_t)b * SEQ;
        for (int i = tid; i < 2048; i += NTHR) selm[i] = 0u;
        __syncthreads();
        const bf16_t* zq = z + (Tb + q0 + fr) * ZLD;
        const unsigned lofk = (unsigned)((fr * ZLD + fq * 8) * 2), lofv = (unsigned)((fr * SEQ + fq * 4) * 2);
        if (qg >= 16) {
            float sacc[16][4];
#pragma unroll
            for (int i = 0; i < 16; ++i)
#pragma unroll
                for (int jj = 0; jj < 4; ++jj) sacc[i][jj] = 0.f;
            const u32x4 wv = *(const u32x4*)(zq + C_WI);
#pragma unroll 1
            for (int hp = 0; hp < 2; ++hp) {
                bf16x8 Bq[4][2];
#pragma unroll
                for (int hh = 0; hh < 4; ++hh)
#pragma unroll
                    for (int ks = 0; ks < 2; ++ks) Bq[hh][ks] = *(const bf16x8*)(zq + C_QI + (hp * 4 + hh) * 64 + ks * 32 + fq * 8);
                const unsigned wa = hp ? wv.z : wv.x, wb = hp ? wv.w : wv.y; const float sc = 0.044194173824159216f;
                float wih[4]; wih[0] = bflo(wa) * sc; wih[1] = bfhi(wa) * sc; wih[2] = bflo(wb) * sc; wih[3] = bfhi(wb) * sc;
                bf16x8 A0c, A1c;
                { const int kt0 = wave < qg ? wave : qg; const char* kb = (const char*)(z + (Tb + (size_t)kt0 * 16) * ZLD + C_KI);
                  A0c = *(const bf16x8*)(kb + lofk); A1c = *(const bf16x8*)(kb + lofk + 64); }
#pragma unroll
                for (int i = 0; i < 16; ++i) { const int kt = wave + 8 * i;
                    bf16x8 A0n = A0c, A1n = A1c;
                    if (i < 15) { const int ktn = (kt + 8) < qg ? (kt + 8) : qg; const char* kb = (const char*)(z + (Tb + (size_t)ktn * 16) * ZLD + C_KI);
                        unsigned lo2 = lofk; asm volatile("" : "+v"(lo2));
                        A0n = *(const bf16x8*)(kb + lo2); A1n = *(const bf16x8*)(kb + lo2 + 64); }
                    if (kt <= qg) {
#pragma unroll
                        for (int hh = 0; hh < 4; ++hh) { f32x4 acc = __builtin_amdgcn_mfma_f32_16x16x32_bf16(A0c, Bq[hh][0], zero4, 0, 0, 0);
                            acc = __builtin_amdgcn_mfma_f32_16x16x32_bf16(A1c, Bq[hh][1], acc, 0, 0, 0);
#pragma unroll
                            for (int jj = 0; jj < 4; ++jj) sacc[i][jj] += wih[hh] * fmaxf(acc[jj], 0.f); }
                    }
                    A0c = A0n; A1c = A1n;
                }
            }
            unsigned uk[16][4];
#pragma unroll
            for (int i = 0; i < 16; ++i) { const int kt = wave + 8 * i;
#pragma unroll
                for (int jj = 0; jj < 4; ++jj) { const bool masked = (kt > qg) || ((kt == qg) && (fq * 4 + jj > fr)); uk[i][jj] = masked ? 0x007fffffu : ordkey(sacc[i][jj]); } }
            unsigned T = 0u; bool found = false;
            for (int bit = 31; bit >= 0; --bit) {
                const unsigned cand = T | (1u << bit); int c = 0;
#pragma unroll
                for (int i = 0; i < 16; ++i) {
#pragma unroll
                    for (int jj = 0; jj < 4; ++jj) c += (uk[i][jj] >= cand) ? 1 : 0;
                    __builtin_amdgcn_sched_barrier(0); }
                c += __shfl_xor(c, 16); c += __shfl_xor(c, 32);
                const int par = bit & 1;
                if (fq == 0) cnt[(par * 8 + wave) * 16 + fr] = c;
                __syncthreads();
                int tot = 0;
#pragma unroll
                for (int w = 0; w < 8; ++w) tot += cnt[(par * 8 + w) * 16 + fr];
                if (!found && tot >= 256) { T = cand; if (tot == 256) found = true; }
                if (__all(found)) break;
            }
            int need;
            { int c = 0; unsigned Tp = T + 1u; asm volatile("" : "+v"(Tp));
#pragma unroll
              for (int i = 0; i < 16; ++i) {
#pragma unroll
                  for (int jj = 0; jj < 4; ++jj) c += (uk[i][jj] >= Tp) ? 1 : 0;
                  __builtin_amdgcn_sched_barrier(0); }
              c += __shfl_xor(c, 16); c += __shfl_xor(c, 32);
              __syncthreads();
              if (fq == 0) cnt[wave * 16 + fr] = c;
              __syncthreads();
              int tot = 0;
#pragma unroll
              for (int w = 0; w < 8; ++w) tot += cnt[w * 16 + fr];
              need = 256 - tot; }
#pragma unroll
            for (int i = 0; i < 16; ++i) { const int kt = wave + 8 * i; unsigned nib = 0u;
#pragma unroll
                for (int jj = 0; jj < 4; ++jj) nib |= (uk[i][jj] == T) ? (1u << jj) : 0u;
                if (nib) atomicOr(&eqm[fr * 64 + (kt >> 1)], nib << ((kt & 1) * 16 + fq * 4));
                __builtin_amdgcn_sched_barrier(0); }
            __syncthreads();
            unsigned T2 = T; asm volatile("" : "+v"(T2));
            for (int w = tid; w < 1024; w += NTHR) { const int word = w & 63; int sct = 0; for (int j = 0; j < word; ++j) sct += __popc(eqm[w - word + j]); eqpre[w] = sct; }
            __syncthreads();
#pragma unroll
            for (int i = 0; i < 16; ++i) { const int kt = wave + 8 * i; unsigned nib = 0u;
                const int word = kt >> 1, bp0 = (kt & 1) * 16 + fq * 4; const unsigned eqw = eqm[fr * 64 + word]; const int rbase = eqpre[fr * 64 + word];
#pragma unroll
                for (int jj = 0; jj < 4; ++jj) { const int rank = rbase + __popc(eqw & ((1u << (bp0 + jj)) - 1u));
                    const bool sel = (uk[i][jj] > T2) || ((uk[i][jj] == T2) && (rank < need));
                    nib |= sel ? (1u << jj) : 0u; }
                if (nib) atomicOr(&selm[fr * 64 + word], nib << bp0);
                __builtin_amdgcn_sched_barrier(0); }
        } else {
            for (int w = tid; w < 1024; w += NTHR) { const int q = w >> 6, word = w & 63, qpos = q0 + q, lo = word * 32;
                selm[w] = (qpos >= lo + 31) ? 0xffffffffu : (qpos < lo ? 0u : ((2u << (qpos - lo)) - 1u)); }
        }
        __syncthreads();
        {
            const int nchunk = (qg + 4) >> 2; const int lrow = tid >> 3, lseg = tid & 7;
            const bf16_t* kg = z + (Tb + lrow) * ZLD + C_KA + lseg * 8; const bf16_t* vg = F.vt + ((size_t)b * 64 + lrow) * SEQ + lseg * 8;
            const unsigned lst = (unsigned)(lrow * 144 + lseg * 16);
            u32x4 kr = *(const u32x4*)(kg), vr = *(const u32x4*)(vg);
            *(u32x4*)(kbuf + lst) = kr; *(u32x4*)(vbuf + lst) = vr;
            bf16x8 Bqa[2];
#pragma unroll
            for (int ks = 0; ks < 2; ++ks) Bqa[ks] = *(const bf16x8*)(zq + C_Q + wave * 64 + ks * 32 + fq * 8);
            f32x4 O[4]; float rs = 0.f;
#pragma unroll
            for (int dt = 0; dt < 4; ++dt) O[dt] = zero4;
            __syncthreads();
#pragma unroll 1
            for (int c = 0; c < nchunk; ++c) {
                const bool more = (c + 1) < nchunk;
                if (more) { kr = *(const u32x4*)(kg + (size_t)(c + 1) * 64 * ZLD); vr = *(const u32x4*)(vg + (c + 1) * 64); }
                const unsigned char* kb = kbuf + (c & 1) * 9216; const unsigned char* vb = vbuf + (c & 1) * 9216;
#pragma unroll
                for (int p = 0; p < 2; ++p) {
                    const unsigned char* k0p = kb + ((2 * p) * 16 + fr) * 144 + fq * 16; const unsigned char* k1p = k0p + 16 * 144;
                    const bf16x8 KA00 = *(const bf16x8*)(k0p), KA01 = *(const bf16x8*)(k0p + 64), KA10 = *(const bf16x8*)(k1p), KA11 = *(const bf16x8*)(k1p + 64);
                    const unsigned mw = selm[fr * 64 + 2 * c + p]; const unsigned m0 = (mw >> (fq * 4)) & 0xFu, m1 = (mw >> (16 + fq * 4)) & 0xFu;
                    f32x4 s0 = __builtin_amdgcn_mfma_f32_16x16x32_bf16(KA00, Bqa[0], zero4, 0, 0, 0); s0 = __builtin_amdgcn_mfma_f32_16x16x32_bf16(KA01, Bqa[1], s0, 0, 0, 0);
                    f32x4 s1 = __builtin_amdgcn_mfma_f32_16x16x32_bf16(KA10, Bqa[0], zero4, 0, 0, 0); s1 = __builtin_amdgcn_mfma_f32_16x16x32_bf16(KA11, Bqa[1], s1, 0, 0, 0);
                    float p0[4], p1[4];
#pragma unroll
                    for (int jj = 0; jj < 4; ++jj) { p0[jj] = ((m0 >> jj) & 1u) ? __expf(fminf(s0[jj] * 0.125f, 60.f)) : 0.f; p1[jj] = ((m1 >> jj) & 1u) ? __expf(fminf(s1[jj] * 0.125f, 60.f)) : 0.f; }
                    rs += (p0[0] + p0[1]) + (p0[2] + p0[3]) + (p1[0] + p1[1]) + (p1[2] + p1[3]);
                    u32x4 pk; pk.x = cvt_pk_bf16(p0[0], p0[1]); pk.y = cvt_pk_bf16(p0[2], p0[3]); pk.z = cvt_pk_bf16(p1[0], p1[1]); pk.w = cvt_pk_bf16(p1[2], p1[3]);
                    const bf16x8 PB = __builtin_bit_cast(bf16x8, pk);
#pragma unroll
                    for (int dt = 0; dt < 4; ++dt) { const unsigned char* vp = vb + (dt * 16 + fr) * 144 + (2 * p) * 32 + fq * 8;
                        const uint2 lo = *(const uint2*)(vp), hi = *(const uint2*)(vp + 32);
                        u32x4 va; va.x = lo.x; va.y = lo.y; va.z = hi.x; va.w = hi.y;
                        O[dt] = __builtin_amdgcn_mfma_f32_16x16x32_bf16(__builtin_bit_cast(bf16x8, va), PB, O[dt], 0, 0, 0); }
                }
                if (more) { *(u32x4*)(kbuf + ((c + 1) & 1) * 9216 + lst) = kr; *(u32x4*)(vbuf + ((c + 1) & 1) * 9216 + lst) = vr; }
                __syncthreads();
            }
            rs += __shfl_xor(rs, 16); rs += __shfl_xor(rs, 32);
            const float inv = 1.0f / rs;
            bf16_t* yp = F.yb + (Tb + q0 + fr) * 512 + wave * 64 + fq * 4;
#pragma unroll
            for (int dt = 0; dt < 4; ++dt) { uint2 w; w.x = cvt_pk_bf16(O[dt][0] * inv, O[dt][1] * inv); w.y = cvt_pk_bf16(O[dt][2] * inv, O[dt][3] * inv); *(uint2*)(yp + dt * 16) = w; }
        }
        __syncthreads();
    }
}

__device__ void p4_post(const Frame& F) {
    const int tid = F.tid; const float* mu = F.in[3]; const float* gnw = F.in[12]; const float* gnb = F.in[13]; const bf16_t* z = F.z;
    for (int g = blockIdx.x * 16 + (tid >> 5); g < NTOK * 8; g += gridDim.x * 16) { const size_t t = (size_t)(g >> 3); const int h = g & 7, c = h * 64 + (tid & 31) * 2;
        const float2 y = *(const float2*)(F.yraw + t * 512 + c);
        const float mean = red32(y.x + y.y) * (1.0f / 64.0f); const float dx = y.x - mean, dy = y.y - mean;
        const float var = red32(dx * dx + dy * dy) * (1.0f / 64.0f); const float rstd = rsqrtf(var + 64e-5f);
        const unsigned vc = *(const unsigned*)(z + t * ZLD + C_V + c); const unsigned vp = (t & (SEQ - 1)) ? *(const unsigned*)(z + (t - 1) * ZLD + C_V + c) : 0u;
        const float vs0 = bflo(vc) + (bflo(vp) - bflo(vc)) * mu[C_V + c], vs1 = bfhi(vc) + (bfhi(vp) - bfhi(vc)) * mu[C_V + c + 1];
        const float bon = F.bonus[t * 8 + h]; const unsigned gt = *(const unsigned*)(F.gt + t * 512 + c);
        const float o0 = (dx * rstd * gnw[c] + gnb[c] + bon * vs0) * bflo(gt), o1 = (dy * rstd * gnw[c + 1] + gnb[c + 1] + bon * vs1) * bfhi(gt);
        *(unsigned*)(F.ya + t * 512 + c) = cvt_pk_bf16(o0, o1); }
}

__device__ void p9_final(const Frame& F) {
    const float* g = F.in[19]; const int lane = F.lane;
    for (int row = blockIdx.x * 8 + F.wave; row < NTOK; row += gridDim.x * 8) {
        float* xr = F.out + (size_t)row * DM; const float sc = rsqrtf(F.ss2[row] * (1.0f / 1024.0f) + 1e-6f);
#pragma unroll
        for (int i = 0; i < 4; ++i) { f32x4 v = *(const f32x4*)(xr + i * 256 + lane * 4); const f32x4 gg = *(const f32x4*)(g + i * 256 + lane * 4);
            v[0] *= sc * gg[0]; v[1] *= sc * gg[1]; v[2] *= sc * gg[2]; v[3] *= sc * gg[3]; *(f32x4*)(xr + i * 256 + lane * 4) = v; }
    }
}
#ifndef PHASE_MASK
#define PHASE_MASK 0x3ff
#endif
#ifndef REPEAT_MASK
#define REPEAT_MASK 0
#endif
#define REP(k) ((REPEAT_MASK >> (k)) & 1)
constexpr int NPHASE = 10;
template <class Epi> __device__ __forceinline__ void run_gemm(const bf16_t* A, const bf16_t* Bt, int N, int K, const Epi& E) {
    pg8::Gemm g{A, Bt, NTOK, N, K}; pg8::StaticOrder S; S.init(NTOK, N, (int)gridDim.x, (int)blockIdx.x);
    pg8::gemm_phase<Epi, pg8::StaticOrder, false>((PG8_LAS unsigned char*)g_lds, g, S, E, nullptr);
}
__global__ void __launch_bounds__(NTHR, 2) mega_fwd(Args args) {
    Frame F;
#pragma unroll
    for (int i = 0; i < 20; ++i) F.in[i] = args.in[i];
    F.out = args.out; F.ws = args.ws; F.lds = nullptr; F.tid = threadIdx.x; F.lane = F.tid & 63; F.wave = __builtin_amdgcn_readfirstlane(F.tid >> 6);
    unsigned char* ws = args.ws;
    F.ss1 = (float*)(ws + WS_SS1); F.ss2 = (float*)(ws + WS_SS2); F.bonus = (float*)(ws + WS_BONUS); F.rope = (float2*)(ws + WS_ROPE);
    F.wd = (bf16_t*)(ws + WS_WD); F.wi = (bf16_t*)(ws + WS_WI); F.wg = (bf16_t*)(ws + WS_WG);
    F.win = (bf16_t*)(ws + WS_WIN); F.wup = (bf16_t*)(ws + WS_WUP); F.wdn = (bf16_t*)(ws + WS_WDN); F.wb = (bf16_t*)(ws + WS_WB); F.wo = (bf16_t*)(ws + WS_WO); F.vt = (bf16_t*)(ws + WS_VT);
    F.h = (bf16_t*)(ws + WS_H); F.ya = F.h; F.yb = F.h + (size_t)NTOK * 512; F.xb = F.h;
    F.z = (bf16_t*)(ws + WS_Z); F.hid = F.z;
    F.lw = (bf16_t*)(ws + WS_P); F.ic = F.lw + (size_t)NTOK * 512; F.mg = F.lw;
    F.yraw = args.out; F.gt = (bf16_t*)(args.out + (size_t)NTOK * 512);
    const int lo = args.ph_lo, hi = args.ph_hi;
    cg::grid_group grid = cg::this_grid();
#define IN(k) (lo <= (k) && (k) < hi)
#define SEAM(k) do { if (IN(k) && IN((k) + 1)) grid.sync(); } while (0)
    if (((PHASE_MASK >> 0) & 1) && IN(0)) { p0_prologue(F); __syncthreads(); if (REP(0)) { p0_prologue(F); __syncthreads(); } } SEAM(0);
    if (((PHASE_MASK >> 1) & 1) && IN(1)) { pg8::EpiZ E{F.z, ZLD}; run_gemm(F.h, F.win, 5120, 1024, E); __syncthreads(); if (REP(1)) { run_gemm(F.h, F.win, 5120, 1024, E); __syncthreads(); } } SEAM(1);
    if (((PHASE_MASK >> 2) & 1) && IN(2)) { if (REP(2)) { p2_prep(F, false); __syncthreads(); } p2_prep(F, true); __syncthreads(); } SEAM(2);
    if (((PHASE_MASK >> 3) & 1) && IN(3)) { p3_scan(F); __syncthreads(); if (REP(3)) { p3_scan(F); __syncthreads(); } p3_dsa(F); __syncthreads(); if (REP(10)) { p3_dsa(F); __syncthreads(); } } SEAM(3);
    if (((PHASE_MASK >> 4) & 1) && IN(4)) { p4_post(F); __syncthreads(); if (REP(4)) { p4_post(F); __syncthreads(); } } SEAM(4);
    if (((PHASE_MASK >> 5) & 1) && IN(5)) { pg8::EpiGate<0> E0{F.mg, F.z, ZLD, C_G0}; run_gemm(F.ya, F.wb, 1024, 512, E0); __syncthreads();
                 pg8::EpiGate<1> E1{F.mg, F.z, ZLD, C_G1}; run_gemm(F.yb, F.wb + 1024 * 512, 1024, 512, E1); __syncthreads(); } SEAM(5);
    if (((PHASE_MASK >> 6) & 1) && IN(6)) { pg8::EpiRes<true> E{F.in[0], F.out, F.xb, F.ss1}; run_gemm(F.mg, F.wo, 1024, 1024, E); __syncthreads(); } SEAM(6);
    if (((PHASE_MASK >> 7) & 1) && IN(7)) { pg8::EpiHid E{F.hid, F.ss1}; run_gemm(F.xb, F.wup, 4096, 1024, E); __syncthreads(); if (REP(7)) { run_gemm(F.xb, F.wup, 4096, 1024, E); __syncthreads(); } } SEAM(7);
    if (((PHASE_MASK >> 8) & 1) && IN(8)) { pg8::EpiRes<false> E{F.out, F.out, nullptr, F.ss2}; run_gemm(F.hid, F.wdn, 1024, 4096, E); __syncthreads(); } SEAM(8);
    if (((PHASE_MASK >> 9) & 1) && IN(9)) { p9_final(F); }
#undef IN
#undef SEAM
}

extern "C" void kernel_launch(void* const* d_in, const int* in_sizes, int n_in, void* d_out, int out_size, void* d_ws, size_t ws_size, hipStream_t stream) {
    static int grid = 0;
    if (grid == 0) {
        if (n_in != 20 || out_size != NTOK * DM || ws_size < WS_END) { fprintf(stderr, "kernel_launch: unexpected shapes (n_in %d, out %d, ws %zu < %zu)\n", n_in, out_size, ws_size, (size_t)WS_END); grid = -1; return; }
        int dev = 0, cus = 0, per_cu = 0;
        hipGetDevice(&dev); hipDeviceGetAttribute(&cus, hipDeviceAttributeMultiprocessorCount, dev);
        if (hipFuncSetAttribute((const void*)mega_fwd, hipFuncAttributeMaxDynamicSharedMemorySize, LDS_BYTES) != hipSuccess) { fprintf(stderr, "kernel_launch: hipFuncSetAttribute failed\n"); grid = -1; return; }
        if (hipOccupancyMaxActiveBlocksPerMultiprocessor(&per_cu, (const void*)mega_fwd, NTHR, LDS_BYTES) != hipSuccess || per_cu < 1) { fprintf(stderr, "kernel_launch: occupancy query failed (%d)\n", per_cu); per_cu = 1; }
        (void)hipGetLastError();
        grid = cus * per_cu;
        fprintf(stderr, "kernel_launch: grid %d (%d CUs x %d)\n", grid, cus, per_cu);
    }
    if (grid < 0) return;
    Args a{};
    for (int i = 0; i < 20; ++i) a.in[i] = (const float*)d_in[i];
    a.out = (float*)d_out; a.ws = (unsigned char*)d_ws;
#if MK_PER_PHASE_LAUNCH
    for (int p = 0; p < NPHASE; ++p) { a.ph_lo = p; a.ph_hi = p + 1; hipLaunchKernelGGL(mega_fwd, dim3(grid), dim3(NTHR), LDS_BYTES, stream, a); }
#else
    a.ph_lo = 0; a.ph_hi = NPHASE;
    void* kargs[] = {&a};
    hipError_t e = hipLaunchCooperativeKernel((const void*)mega_fwd, dim3(grid), dim3(NTHR), kargs, LDS_BYTES, stream);
    if (e != hipSuccess) fprintf(stderr, "kernel_launch: cooperative launch failed: %s (grid %d)\n", hipGetErrorString(e), grid);
#endif
}
```

```cpp
#include <hip/hip_runtime.h>
#include <hip/hip_cooperative_groups.h>
#include <cstdio>
#include <cstdint>
namespace cg = cooperative_groups;

#ifndef MK_PER_PHASE_LAUNCH
#define MK_PER_PHASE_LAUNCH 0
#endif

#ifndef REPEAT_MASK
#define REPEAT_MASK 0
#endif
#define REP(k) ((REPEAT_MASK >> (k)) & 1)

namespace pg8 {
#define PG8_LAS __attribute__((address_space(3)))
typedef unsigned short bf16_t;
typedef short bf16x8 __attribute__((ext_vector_type(8)));
typedef float f32x4 __attribute__((ext_vector_type(4)));
typedef unsigned u32x4 __attribute__((ext_vector_type(4)));
constexpr int BM = 256, BK = 64, HALF = 128, HTB = HALF * BK * 2  , STAGE_BYTES = 8 * HTB, NXCD = 8, WGM = 8;

__host__ __device__ __forceinline__ int lds_byte(int r, int c) { const int st = (r >> 4) * 2 + (c >> 5), rr = r & 15, cc = c & 31, ob = rr * 64 + cc * 2; return st * 1024 + (ob ^ (((ob >> 9) & 1) << 5)); }
__host__ __device__ __forceinline__ void stage_rc(int b, int& R, int& C) { const int st = b / 1024, sb = b % 1024, swz = sb ^ (((sb >> 9) & 1) << 5); R = (st >> 1) * 16 + swz / 64; C = (st & 1) * 32 + (swz % 64) / 2; }
__host__ __device__ __forceinline__ int perm32(int rho) { const int n = rho >> 4, i = rho & 15; return 8 * (i >> 2) + 4 * n + (i & 3); }

struct Unit { int pm, pn; };
struct Gemm { const bf16_t* A; const bf16_t* Bt; int M, N, K; };

struct StaticOrder {
    int nM, nN, nwg, G, c;
    __host__ __device__ void init(int M, int N, int G_, int c_) { nM = M / BM; nN = N / BM; nwg = nM * nN; G = G_; c = c_; }
    __host__ __device__ bool next(int i, Unit& u) const {
        const long L = (long)i * G + c; if (L >= nwg) return false;
        int wgid = (int)L; { const int q = nwg / NXCD, r = nwg % NXCD, xcd = wgid % NXCD, off = wgid / NXCD; wgid = (xcd < r ? xcd * (q + 1) : r * (q + 1) + (xcd - r) * q) + off; }
        const int nig = WGM * nN, gid = wgid / nig, fm = gid * WGM, gsz = (nM - fm) < WGM ? (nM - fm) : WGM;
        u.pm = fm + ((wgid % nig) % gsz); u.pn = (wgid % nig) / gsz; return true;
    }
    __device__ __forceinline__ void a_ready(const Unit&) const {}
    __device__ __forceinline__ void done(const Unit&) const {}
};
__device__ __forceinline__ unsigned cvt_pk_bf16(float lo, float hi) { unsigned r; asm volatile("v_cvt_pk_bf16_f32 %0, %1, %2" : "=v"(r) : "v"(lo), "v"(hi)); return r; }
typedef float f32x2 __attribute__((ext_vector_type(2)));
__device__ __forceinline__ float bflo(unsigned u) { return __uint_as_float(u << 16); }
__device__ __forceinline__ float bfhi(unsigned u) { return __uint_as_float(u & 0xffff0000u); }
__device__ __forceinline__ float sigm(float x) { return 1.0f / (1.0f + __expf(-x)); }

struct EpiZ {
    static constexpr bool PERM = true, AFTER_DRAIN = false;
    bf16_t* O; int ldc;
    __device__ __forceinline__ void operator()(const f32x4 (&acc)[2][2][4][2], const Unit& u, int wr, int wc, int fr, int fq) const {
        const int row0 = u.pm * BM + wr * 64 + fr, col0 = u.pn * BM + wc * 32 + 8 * fq;
#pragma unroll
        for (int ai = 0; ai < 2; ++ai)
#pragma unroll
            for (int m = 0; m < 4; ++m) { bf16_t* rowp = O + (size_t)(row0 + ai * HALF + m * 16) * ldc + col0;
#pragma unroll
                for (int bj = 0; bj < 2; ++bj) { const f32x4 v0 = acc[ai][bj][m][0], v1 = acc[ai][bj][m][1];
                    u32x4 w; w.x = cvt_pk_bf16(v0[0], v0[1]); w.y = cvt_pk_bf16(v0[2], v0[3]); w.z = cvt_pk_bf16(v1[0], v1[1]); w.w = cvt_pk_bf16(v1[2], v1[3]);
                    *(u32x4*)(rowp + bj * HALF) = w; } }
    }
};
template <int MODE> struct EpiGate {
    static constexpr bool PERM = true, AFTER_DRAIN = false;
    bf16_t* O; const bf16_t* Z; int zld; int gcol;
    __device__ __forceinline__ void operator()(const f32x4 (&acc)[2][2][4][2], const Unit& u, int wr, int wc, int fr, int fq) const {
        const int row0 = u.pm * BM + wr * 64 + fr, col0 = u.pn * BM + wc * 32 + 8 * fq;
#pragma unroll
        for (int ai = 0; ai < 2; ++ai)
#pragma unroll
            for (int m = 0; m < 4; ++m) { const size_t row = (size_t)(row0 + ai * HALF + m * 16);
                bf16_t* op = O + row * 1024 + col0; const bf16_t* zp = Z + row * zld + gcol + col0;
#pragma unroll
                for (int bj = 0; bj < 2; ++bj) { const f32x4 v0 = acc[ai][bj][m][0], v1 = acc[ai][bj][m][1];
                    const u32x4 g = *(const u32x4*)(zp + bj * HALF);
                    float r0 = v0[0] * sigm(bflo(g.x)), r1 = v0[1] * sigm(bfhi(g.x)), r2 = v0[2] * sigm(bflo(g.y)), r3 = v0[3] * sigm(bfhi(g.y));
                    float r4 = v1[0] * sigm(bflo(g.z)), r5 = v1[1] * sigm(bfhi(g.z)), r6 = v1[2] * sigm(bflo(g.w)), r7 = v1[3] * sigm(bfhi(g.w));
                    if (MODE == 1) { const u32x4 p = *(const u32x4*)(op + bj * HALF);
                        r0 += bflo(p.x); r1 += bfhi(p.x); r2 += bflo(p.y); r3 += bfhi(p.y); r4 += bflo(p.z); r5 += bfhi(p.z); r6 += bflo(p.w); r7 += bfhi(p.w); }
                    u32x4 w; w.x = cvt_pk_bf16(r0, r1); w.y = cvt_pk_bf16(r2, r3); w.z = cvt_pk_bf16(r4, r5); w.w = cvt_pk_bf16(r6, r7);
                    *(u32x4*)(op + bj * HALF) = w; } }
    }
};
template <bool WITH_XB> struct EpiRes {
    static constexpr bool PERM = false, AFTER_DRAIN = false;
    const float* X; float* O; bf16_t* XB; float* SS;
    __device__ __forceinline__ void operator()(const f32x4 (&acc)[2][2][4][2], const Unit& u, int wr, int wc, int fr, int fq) const {
        const int row0 = u.pm * BM + wr * 64 + fr, col0 = u.pn * BM + wc * 32 + 4 * fq;
#pragma unroll
        for (int ai = 0; ai < 2; ++ai)
#pragma unroll
            for (int m = 0; m < 4; ++m) { const size_t row = (size_t)(row0 + ai * HALF + m * 16); float ssq = 0.f;
#pragma unroll
                for (int bj = 0; bj < 2; ++bj)
#pragma unroll
                    for (int n = 0; n < 2; ++n) { const size_t off = row * 1024 + col0 + bj * HALF + n * 16;
                        const f32x4 xv = *(const f32x4*)(X + off); const f32x4 v = acc[ai][bj][m][n] + xv;
                        *(f32x4*)(O + off) = v; ssq += v[0] * v[0] + v[1] * v[1] + v[2] * v[2] + v[3] * v[3];
                        if (WITH_XB) { uint2 w; w.x = cvt_pk_bf16(v[0], v[1]); w.y = cvt_pk_bf16(v[2], v[3]); *(uint2*)(XB + off) = w; } }
                ssq += __shfl_xor(ssq, 16); ssq += __shfl_xor(ssq, 32);
                if (fq == 0) atomicAdd(SS + row, ssq); }
    }
};
struct EpiHid {
    static constexpr bool PERM = true, AFTER_DRAIN = false;
    bf16_t* O; const float* SS;
    __device__ __forceinline__ void operator()(const f32x4 (&acc)[2][2][4][2], const Unit& u, int wr, int wc, int fr, int fq) const {
        const int row0 = u.pm * BM + wr * 64 + fr, col0 = u.pn * BM + wc * 32 + 8 * fq;
#pragma unroll
        for (int ai = 0; ai < 2; ++ai)
#pragma unroll
            for (int m = 0; m < 4; ++m) { const size_t row = (size_t)(row0 + ai * HALF + m * 16);
                const float s2 = 1.0f / (SS[row] * (1.0f / 1024.0f) + 1e-6f);
                bf16_t* rowp = O + row * 4096 + col0;
#pragma unroll
                for (int bj = 0; bj < 2; ++bj) { f32x4 v0 = acc[ai][bj][m][0], v1 = acc[ai][bj][m][1];
#pragma unroll
                    for (int j = 0; j < 4; ++j) { float a = fmaxf(v0[j], 0.f), b = fmaxf(v1[j], 0.f); v0[j] = a * a * s2; v1[j] = b * b * s2; }
                    u32x4 w; w.x = cvt_pk_bf16(v0[0], v0[1]); w.y = cvt_pk_bf16(v0[2], v0[3]); w.z = cvt_pk_bf16(v1[0], v1[1]); w.w = cvt_pk_bf16(v1[2], v1[3]);
                    *(u32x4*)(rowp + bj * HALF) = w; } }
    }
};

template <class Epi, class Sched, bool STAMP = false>
__device__ __forceinline__ void gemm_phase(PG8_LAS unsigned char* lds, const Gemm g, const Sched& S, const Epi& E, unsigned long long* stamps) {
    const int tid = threadIdx.x, wid = __builtin_amdgcn_readfirstlane(tid >> 6), lane = tid & 63, wr = wid >> 2, wc = wid & 3, fr = lane & 15, fq = lane >> 4;
    const int K = g.K, nt = K / BK;
    int ts_lo = 0, ts_hi = 0, nts = 0; const unsigned long long rt_entry = STAMP ? (unsigned long long)wall_clock64() : 0ull;
#define PG8_STAMP() do { if (STAMP && wid == 0 && nts < 64) { const unsigned long long _c = (unsigned long long)clock64(); \
        ts_lo = (lane == nts) ? (int)(unsigned)_c : ts_lo; ts_hi = (lane == nts) ? (int)(unsigned)(_c >> 32) : ts_hi; ++nts; } } while (0)
    PG8_STAMP();
    unsigned voffA[2], voffB[2];
#pragma unroll
    for (int i = 0; i < 2; ++i) { int R, C; stage_rc(tid * 16 + i * 8192, R, C); const int Rb = Epi::PERM ? ((R & ~31) + perm32(R & 31)) : R;
        voffA[i] = (unsigned)(R * K + C) * 2u; voffB[i] = (unsigned)(Rb * K + C) * 2u; }
    const size_t kstep = (size_t)(BK * 2);
    const size_t hstep = (size_t)HALF * K * 2;
    const size_t tstep = 2 * hstep;
    const unsigned ldsw = (unsigned)wid * 1024u;
    const int aoff = lds_byte(wr * 64 + fr, fq * 8), boff = lds_byte(wc * 32 + fr, fq * 8);
#define PG8_SA(b, h) (((b) * 2 + (h)) * HTB)
#define PG8_SB(b, h) ((4 + (b) * 2 + (h)) * HTB)
#define PG8_STAGE(bufoff, gbase, voff) do { _Pragma("unroll") for (int _i = 0; _i < 2; ++_i) \
        __builtin_amdgcn_global_load_lds((const unsigned*)((const char*)(gbase) + (voff)[_i]), (PG8_LAS unsigned*)(lds + (bufoff) + ldsw + _i * 8192), 16, 0, 0); } while (0)
#define PG8_LDA(dst, b, h) do { _Pragma("unroll") for (int m = 0; m < 4; ++m) _Pragma("unroll") for (int k = 0; k < 2; ++k) dst[m][k] = *(const PG8_LAS bf16x8*)(lds + PG8_SA(b, h) + aoff + m * 2048 + k * 1024); } while (0)
#define PG8_LDB(dst, b, h) do { _Pragma("unroll") for (int n = 0; n < 2; ++n) _Pragma("unroll") for (int k = 0; k < 2; ++k) dst[n][k] = *(const PG8_LAS bf16x8*)(lds + PG8_SB(b, h) + boff + n * 2048 + k * 1024); } while (0)
#define PG8_MMA(ai, bj, At, Bt) do { __builtin_amdgcn_s_setprio(1); _Pragma("unroll") for (int m = 0; m < 4; ++m) _Pragma("unroll") for (int n = 0; n < 2; ++n) _Pragma("unroll") for (int k = 0; k < 2; ++k) \
        acc[ai][bj][m][n] = __builtin_amdgcn_mfma_f32_16x16x32_bf16(Bt[n][k], At[m][k], acc[ai][bj][m][n], 0, 0, 0); __builtin_amdgcn_s_setprio(0); } while (0)
#define PG8_WAIT_V(n) asm volatile("s_waitcnt vmcnt(" #n ")" ::: "memory")
#define PG8_WAIT_L(n) asm volatile("s_waitcnt lgkmcnt(" #n ")" ::: "memory")
#define PG8_BAR __builtin_amdgcn_s_barrier()
#define PG8_SCHED __builtin_amdgcn_sched_barrier(0)
    Unit cur, nxt; int ui = 0;
    if (!S.next(0, cur)) return;
    f32x4 acc[2][2][4][2];
#pragma unroll
    for (int a = 0; a < 2; ++a)
#pragma unroll
        for (int b = 0; b < 2; ++b)
#pragma unroll
            for (int m = 0; m < 4; ++m)
#pragma unroll
                for (int n = 0; n < 2; ++n) acc[a][b][m][n] = (f32x4){0.f, 0.f, 0.f, 0.f};
    bf16x8 At[4][2], B0[2][2], B1[2][2];
    const char* cA = (const char*)g.A + (size_t)cur.pm * tstep; const char* cB = (const char*)g.Bt + (size_t)cur.pn * tstep;
    S.a_ready(cur);
    PG8_STAGE(PG8_SB(0, 0), cB, voffB); PG8_STAGE(PG8_SA(0, 0), cA, voffA); PG8_STAGE(PG8_SB(0, 1), cB + hstep, voffB); PG8_STAGE(PG8_SA(0, 1), cA + hstep, voffA);
    if (wr == 1) PG8_BAR;
    PG8_WAIT_V(4); PG8_BAR;
    PG8_STAGE(PG8_SB(1, 0), cB + kstep, voffB); PG8_STAGE(PG8_SA(1, 0), cA + kstep, voffA); PG8_STAGE(PG8_SB(1, 1), cB + hstep + kstep, voffB);
    PG8_WAIT_V(6); PG8_BAR;
    PG8_STAMP();
    for (;;) {
        const bool has_next = S.next(ui + 1, nxt);
        const char* nA = has_next ? (const char*)g.A + (size_t)nxt.pm * tstep : cA; const char* nB = has_next ? (const char*)g.Bt + (size_t)nxt.pn * tstep : cB;
        for (int t = 0; t < nt; t += 2) {
            const bool last = (t == nt - 2);
            const char* a1 = cA + (size_t)(t + 1) * kstep;
            const char* a2 = last ? nA : cA + (size_t)(t + 2) * kstep; const char* b2 = last ? nB : cB + (size_t)(t + 2) * kstep;
            const char* a3 = a2 + kstep; const char* b3 = b2 + kstep;
            if (last && has_next) S.a_ready(nxt);
            PG8_LDB(B0, 0, 0); PG8_SCHED; PG8_LDA(At, 0, 0); PG8_STAGE(PG8_SA(1, 1), a1 + hstep, voffA);
            PG8_WAIT_L(8); PG8_BAR; PG8_WAIT_L(0); PG8_MMA(0, 0, At, B0); PG8_BAR; PG8_SCHED;
            PG8_LDB(B1, 0, 1); PG8_STAGE(PG8_SB(0, 0), b2, voffB);
            PG8_BAR; PG8_WAIT_L(0); PG8_MMA(0, 1, At, B1); PG8_BAR;
            PG8_LDA(At, 0, 1); PG8_STAGE(PG8_SA(0, 0), a2, voffA);
            PG8_BAR; PG8_WAIT_L(0); PG8_MMA(1, 0, At, B0); PG8_BAR; PG8_SCHED;
            PG8_STAGE(PG8_SB(0, 1), b2 + hstep, voffB);
            PG8_WAIT_V(6); PG8_BAR; PG8_MMA(1, 1, At, B1); PG8_BAR;
            PG8_LDB(B0, 1, 0); PG8_SCHED; PG8_LDA(At, 1, 0); PG8_STAGE(PG8_SA(0, 1), a2 + hstep, voffA);
            PG8_WAIT_L(8); PG8_BAR; PG8_WAIT_L(0); PG8_MMA(0, 0, At, B0); PG8_BAR; PG8_SCHED;
            PG8_LDB(B1, 1, 1); PG8_STAGE(PG8_SB(1, 0), b3, voffB);
            PG8_BAR; PG8_WAIT_L(0); PG8_MMA(0, 1, At, B1); PG8_BAR;
            PG8_LDA(At, 1, 1); PG8_STAGE(PG8_SA(1, 0), a3, voffA);
            PG8_BAR; PG8_WAIT_L(0); PG8_MMA(1, 0, At, B0); PG8_BAR; PG8_SCHED;
            PG8_STAGE(PG8_SB(1, 1), b3 + hstep, voffB);
            PG8_WAIT_V(6); PG8_BAR; PG8_MMA(1, 1, At, B1); PG8_BAR;
        }
        PG8_STAMP();
        if constexpr (!Epi::AFTER_DRAIN) { E(acc, cur, wr, wc, fr, fq); S.done(cur); }
        PG8_STAMP();
        if (!has_next) break;
#pragma unroll
        for (int a = 0; a < 2; ++a)
#pragma unroll
            for (int b = 0; b < 2; ++b)
#pragma unroll
                for (int m = 0; m < 4; ++m)
#pragma unroll
                    for (int n = 0; n < 2; ++n) acc[a][b][m][n] = (f32x4){0.f, 0.f, 0.f, 0.f};
        cur = nxt; cA = nA; cB = nB; ++ui;
    }
    PG8_WAIT_V(0);
    if (wr == 0) PG8_BAR;
    PG8_BAR;
    if constexpr (Epi::AFTER_DRAIN) { E.fused(acc, cur, wr, wc, fr, fq, lds, wid, lane); S.done(cur); }
    PG8_STAMP();
    if (STAMP && wid == 0) { stamps[lane] = lane < nts ? (((unsigned long long)(unsigned)ts_hi << 32) | (unsigned)ts_lo) : 0ull;
        if (lane == 62) stamps[62] = rt_entry; if (lane == 63) stamps[63] = (unsigned long long)wall_clock64(); }
#undef PG8_STAMP
#undef PG8_SA
#undef PG8_SB
#undef PG8_STAGE
#undef PG8_LDA
#undef PG8_LDB
#undef PG8_MMA
#undef PG8_WAIT_V
#undef PG8_WAIT_L
#undef PG8_BAR
#undef PG8_SCHED
}
}
extern __shared__ __attribute__((aligned(16))) unsigned char g_lds[];
using pg8::bf16_t; using pg8::bf16x8; using pg8::f32x4; using pg8::u32x4; using pg8::cvt_pk_bf16; using pg8::bflo; using pg8::bfhi; using pg8::sigm;

constexpr int NTOK = 32768, DM = 1024, SEQ = 2048, NB = 16, ZLD = 5120, NTHR = 512;
constexpr int C_R = 0, C_K = 512, C_V = 1024, C_WD = 1536, C_AD = 1600, C_GD = 1664;
constexpr int C_Q = 1824, C_KA = 2336, C_VA = 2400, C_QI = 2464, C_KI = 2976, C_WI = 3040, C_G0 = 3048, C_G1 = 4072;
constexpr size_t MiB = 1024 * 1024;
constexpr size_t WS_SS1 = 0, WS_SS2 = 128 * 1024, WS_BONUS = 256 * 1024, WS_ROPE = 1280 * 1024, WS_WD = 1792 * 1024, WS_WI = 1856 * 1024, WS_WG = 1920 * 1024;
constexpr size_t WS_WIN = 4 * MiB, WS_WUP = 14 * MiB, WS_WDN = 22 * MiB, WS_WB = 30 * MiB, WS_WO = 32 * MiB, WS_VT = 34 * MiB, WS_H = 38 * MiB, WS_Z = 102 * MiB, WS_P = 422 * MiB, WS_END = 486 * MiB;
constexpr int LDS_BYTES = 131072;

struct Args { const float* in[20]; float* out; unsigned char* ws; int ph_lo, ph_hi; };

struct Frame {
    const float* in[20]; float* out; unsigned char* ws; unsigned char* lds; int tid, lane, wave;
    float *ss1, *ss2, *bonus; float2* rope; bf16_t *wd, *wi, *wg, *win, *wup, *wdn, *wb, *wo, *vt, *h, *ya, *yb, *xb, *z, *hid, *lw, *ic, *mg, *gt; float* yraw;
};

__device__ __forceinline__ bf16_t f2bf(float f) { return (bf16_t)(cvt_pk_bf16(f, 0.f) & 0xffffu); }
__device__ __forceinline__ float bf2f(bf16_t b) { return __uint_as_float(((unsigned)b) << 16); }
template <int CTRL> __device__ __forceinline__ float dpp_mov(float x) { return __int_as_float(__builtin_amdgcn_update_dpp(0, __float_as_int(x), CTRL, 0xF, 0xF, true)); }
__device__ __forceinline__ float red16(float x) { x += dpp_mov<0xB1>(x); x += dpp_mov<0x4E>(x); x += dpp_mov<0x141>(x); x += dpp_mov<0x140>(x); return x; }
__device__ __forceinline__ float red32(float x) { x += __shfl_xor(x, 1); x += __shfl_xor(x, 2); x += __shfl_xor(x, 4); x += __shfl_xor(x, 8); x += __shfl_xor(x, 16); return x; }
__device__ __forceinline__ float red64(float x) { x = red32(x); x += __shfl_xor(x, 32); return x; }
__device__ __forceinline__ float softplus_f(float x) { return fmaxf(x, 0.f) + log1pf(__expf(-fabsf(x))); }

__device__ void tconv(const Frame& F, const float* __restrict__ W, int K, int N, int Npad, bf16_t* __restrict__ Wt, const float* __restrict__ rs) {
    float* tile = (float*)g_lds;
    const int ktn = (K + 63) / 64, ntn = Npad / 64, tid = F.tid;
    for (int tl = blockIdx.x; tl < ktn * ntn; tl += gridDim.x) {
        const int kt = tl % ktn, nt = tl / ktn;
#pragma unroll
        for (int i = 0; i < 2; ++i) { const int idx = tid + i * NTHR, kk = idx >> 4, n4 = (idx & 15) * 4, k = kt * 64 + kk, n = nt * 64 + n4;
            f32x4 v = {0.f, 0.f, 0.f, 0.f};
            if (k < K) { if (n + 3 < N) v = *(const f32x4*)(W + (size_t)k * N + n); else { for (int j = 0; j < 4; ++j) if (n + j < N) v[j] = W[(size_t)k * N + n + j]; }
                if (rs != nullptr) { const float r = rs[k]; v[0] *= r; v[1] *= r; v[2] *= r; v[3] *= r; } }
            tile[kk * 65 + n4] = v[0]; tile[kk * 65 + n4 + 1] = v[1]; tile[kk * 65 + n4 + 2] = v[2]; tile[kk * 65 + n4 + 3] = v[3]; }
        __syncthreads();
        { const int nn = tid >> 3, k8 = (tid & 7) * 8, k = kt * 64 + k8, n = nt * 64 + nn;
          if (k < K) { u32x4 w; const float* tp = tile + k8 * 65 + nn;
              w.x = cvt_pk_bf16(tp[0], tp[65]); w.y = cvt_pk_bf16(tp[130], tp[195]); w.z = cvt_pk_bf16(tp[260], tp[325]); w.w = cvt_pk_bf16(tp[390], tp[455]);
              *(u32x4*)(Wt + (size_t)n * K + k) = w; } }
        __syncthreads();
    }
}
__device__ void p0_prologue(const Frame& F) {
    const int tid = F.tid, gtid = blockIdx.x * NTHR + tid, gn = gridDim.x * NTHR;
    for (int i = gtid; i < 2 * NTOK; i += gn) F.ss1[i] = 0.f;
    for (int i = gtid; i < SEQ * 32; i += gn) { const int pos = i >> 5, j = i & 31;
        const float inv = 1.0f / powf(10000.0f, (float)(2 * j) / 64.0f); const float ang = (float)pos * inv;
        double rev = (double)ang * 0.15915494309189535; rev -= floor(rev); const float fr = (float)rev;
        F.rope[i] = make_float2(__builtin_amdgcn_cosf(fr), __builtin_amdgcn_sinf(fr)); }
    tconv(F, F.in[2], 1024, 5096, 5120, F.win, nullptr);
    tconv(F, F.in[17], 1024, 4096, 4096, F.wup, F.in[16]);
    tconv(F, F.in[18], 4096, 1024, 1024, F.wdn, nullptr);
    tconv(F, F.in[14], 512, 1024, 1024, F.wb, nullptr);
    tconv(F, F.in[14] + 512 * 1024, 512, 1024, 1024, F.wb + 1024 * 512, nullptr);
    tconv(F, F.in[15], 1024, 1024, 1024, F.wo, nullptr);
    tconv(F, F.in[5], 64, 512, 512, F.wd, nullptr);
    tconv(F, F.in[7], 64, 512, 512, F.wi, nullptr);
    tconv(F, F.in[8], 160, 512, 512, F.wg, nullptr);
    const float* x = F.in[0]; const float* g = F.in[1]; const int lane = F.lane;
    for (int row = blockIdx.x * 8 + F.wave; row < NTOK; row += gridDim.x * 8) {
        const float* xr = x + (size_t)row * DM; f32x4 v[4]; float ss = 0.f;
#pragma unroll
        for (int i = 0; i < 4; ++i) { v[i] = *(const f32x4*)(xr + i * 256 + lane * 4); ss += v[i][0] * v[i][0] + v[i][1] * v[i][1] + v[i][2] * v[i][2] + v[i][3] * v[i][3]; }
        ss = red64(ss); const float sc = rsqrtf(ss * (1.0f / 1024.0f) + 1e-6f);
#pragma unroll
        for (int i = 0; i < 4; ++i) { const f32x4 gg = *(const f32x4*)(g + i * 256 + lane * 4); uint2 w;
            w.x = cvt_pk_bf16(v[i][0] * sc * gg[0], v[i][1] * sc * gg[1]); w.y = cvt_pk_bf16(v[i][2] * sc * gg[2], v[i][3] * sc * gg[3]);
            *(uint2*)(F.h + (size_t)row * DM + i * 256 + lane * 4) = w; }
    }
}

__device__ void p2_prep(const Frame& F, const bool do_rope) {
    const int tid = F.tid, lane = F.lane, wave = F.wave, fr = lane & 15, fq = lane >> 4;
    bf16_t* z = F.z; const float* mu = F.in[3];
    {
        constexpr int LDA = 296; bf16_t* At = (bf16_t*)g_lds;
        bf16_t* Ot = At + 16 * LDA;
        const float* dbias = F.in[4]; const float* ibias = F.in[6];
        for (int tile = blockIdx.x; tile < NTOK / 16; tile += gridDim.x) {
            const int t0 = tile * 16;
            for (int idx = tid; idx < 16 * 36; idx += NTHR) { const int tok = idx / 36, c8 = (idx - tok * 36) * 8, t = t0 + tok, col = C_WD + c8;
                const u32x4 zc = *(const u32x4*)(z + (size_t)t * ZLD + col); u32x4 zp = {0u, 0u, 0u, 0u}; if (t & (SEQ - 1)) zp = *(const u32x4*)(z + (size_t)(t - 1) * ZLD + col);
                const f32x4 m0 = *(const f32x4*)(mu + col), m1 = *(const f32x4*)(mu + col + 4);
                float v[8]; const unsigned zcu[4] = {zc.x, zc.y, zc.z, zc.w}, zpu[4] = {zp.x, zp.y, zp.z, zp.w};
#pragma unroll
                for (int j = 0; j < 4; ++j) { const float a = bflo(zcu[j]), b2 = bfhi(zcu[j]), pa = bflo(zpu[j]), pb = bfhi(zpu[j]);
                    const float mm0 = (j < 2) ? m0[2 * j] : m1[2 * j - 4], mm1 = (j < 2) ? m0[2 * j + 1] : m1[2 * j - 3];
                    v[2 * j] = a + (pa - a) * mm0; v[2 * j + 1] = b2 + (pb - b2) * mm1; }
                if (c8 < 64) {
#pragma unroll
                    for (int j = 0; j < 8; ++j) v[j] = tanhf(v[j]); }
                else if (c8 >= 128) {
#pragma unroll
                    for (int j = 0; j < 8; ++j) v[j] = sigm(v[j]); }
                u32x4 w; w.x = cvt_pk_bf16(v[0], v[1]); w.y = cvt_pk_bf16(v[2], v[3]); w.z = cvt_pk_bf16(v[4], v[5]); w.w = cvt_pk_bf16(v[6], v[7]);
                *(u32x4*)(At + tok * LDA + c8) = w; }
            __syncthreads();
            const int h = wave;
#pragma unroll 1
            for (int j = 0; j < 4; ++j) { const int n = h * 64 + j * 16 + fr;
                f32x4 ad = {0.f, 0.f, 0.f, 0.f}, ai = ad, ag = ad;
#pragma unroll
                for (int ks = 0; ks < 2; ++ks) { const bf16x8 a = *(const bf16x8*)(At + fr * LDA + ks * 32 + fq * 8); const bf16x8 b = *(const bf16x8*)(F.wd + n * 64 + ks * 32 + fq * 8);
                    ad = __builtin_amdgcn_mfma_f32_16x16x32_bf16(a, b, ad, 0, 0, 0); }
#pragma unroll
                for (int ks = 0; ks < 2; ++ks) { const bf16x8 a = *(const bf16x8*)(At + fr * LDA + 64 + ks * 32 + fq * 8); const bf16x8 b = *(const bf16x8*)(F.wi + n * 64 + ks * 32 + fq * 8);
                    ai = __builtin_amdgcn_mfma_f32_16x16x32_bf16(a, b, ai, 0, 0, 0); }
#pragma unroll
                for (int ks = 0; ks < 5; ++ks) { const bf16x8 a = *(const bf16x8*)(At + fr * LDA + 128 + ks * 32 + fq * 8); const bf16x8 b = *(const bf16x8*)(F.wg + n * 160 + ks * 32 + fq * 8);
                    ag = __builtin_amdgcn_mfma_f32_16x16x32_bf16(a, b, ag, 0, 0, 0); }
                const float db = dbias[n], ib = ibias[n];
#pragma unroll
                for (int jj = 0; jj < 4; ++jj) { const size_t t = (size_t)(t0 + fq * 4 + jj);
                    const float dw = db + ad[jj]; (void)t; const float wlog = -softplus_f(-dw) - 0.5f; const float lwv = -__expf(wlog);
                    const int tk = fq * 4 + jj; Ot[tk * 520 + n] = f2bf(lwv); Ot[(16 + tk) * 520 + n] = f2bf(sigm(ib + ai[jj])); Ot[(32 + tk) * 520 + n] = f2bf(ag[jj]); }
            }
            __syncthreads();
#pragma unroll
            for (int i = 0; i < 6; ++i) { const int idx = tid + i * NTHR, arr = idx >> 10, rem = idx & 1023, tk = rem >> 6, c8 = (rem & 63) * 8;
                const u32x4 w = *(const u32x4*)(Ot + (arr * 16 + tk) * 520 + c8); bf16_t* dst = arr == 0 ? F.lw : (arr == 1 ? F.ic : F.gt);
                *(u32x4*)(dst + (size_t)(t0 + tk) * 512 + c8) = w; }
            __syncthreads();
        }
    }
    {
        unsigned short* tl = (unsigned short*)g_lds;
        for (int tile = blockIdx.x; tile < NTOK / 64; tile += gridDim.x) { const int t0 = tile * 64, b = t0 / SEQ, tt0 = t0 % SEQ;
#pragma unroll
            for (int i = 0; i < 8; ++i) { const int idx = tid + i * NTHR, tok = idx >> 6, d = idx & 63; tl[tok * 66 + d] = z[(size_t)(t0 + tok) * ZLD + C_VA + d]; }
            __syncthreads();
#pragma unroll
            for (int i = 0; i < 8; ++i) { const int idx = tid + i * NTHR, d = idx >> 6, tok = idx & 63; F.vt[((size_t)b * 64 + d) * SEQ + tt0 + tok] = tl[tok * 66 + d]; }
            __syncthreads();
        }
    }
    if (do_rope) {
        const int gtid = blockIdx.x * NTHR + tid, gn = gridDim.x * NTHR;
        for (int idx = gtid; idx < NTOK * 144; idx += gn) { const int t = idx / 144, p = idx - t * 144, hd = p >> 3, i4 = (p & 7) * 4;
            const int base = hd < 8 ? C_Q + hd * 64 : (hd == 8 ? C_KA : (hd < 17 ? C_QI + (hd - 9) * 64 : C_KI));
            const f32x4 cs0 = *(const f32x4*)(&F.rope[(t & (SEQ - 1)) * 32 + i4]), cs1 = *(const f32x4*)(&F.rope[(t & (SEQ - 1)) * 32 + i4 + 2]);
            bf16_t* p1 = z + (size_t)t * ZLD + base + i4; const uint2 a = *(const uint2*)(p1), b2 = *(const uint2*)(p1 + 32);
            const float x10 = bflo(a.x), x11 = bfhi(a.x), x12 = bflo(a.y), x13 = bfhi(a.y), x20 = bflo(b2.x), x21 = bfhi(b2.x), x22 = bflo(b2.y), x23 = bfhi(b2.y);
            uint2 o1, o2;
            o1.x = cvt_pk_bf16(x10 * cs0[0] - x20 * cs0[1], x11 * cs0[2] - x21 * cs0[3]); o1.y = cvt_pk_bf16(x12 * cs1[0] - x22 * cs1[1], x13 * cs1[2] - x23 * cs1[3]);
            o2.x = cvt_pk_bf16(x20 * cs0[0] + x10 * cs0[1], x21 * cs0[2] + x11 * cs0[3]); o2.y = cvt_pk_bf16(x22 * cs1[0] + x12 * cs1[1], x23 * cs1[2] + x13 * cs1[3]);
            *(uint2*)(p1) = o1; *(uint2*)(p1 + 32) = o2; }
    }
}

struct ScanRaw { uint2 zr_c, zr_p, zk_c, zk_p, zv_c, zv_p, lwu, icu; };
struct ScanConst { f32x4 mur, muk, muv, kk, ka, rk; };
__device__ __forceinline__ void scan_load(ScanRaw& R, const bf16_t* z, const bf16_t* lw, const bf16_t* ic, size_t tokbase, int ch, int ptok, int gc) {
    const int t = ch * 16 + ptok; const size_t T = tokbase + t; const bf16_t* zp = z + T * ZLD + gc;
    R.zr_c = *(const uint2*)(zp + C_R); R.zk_c = *(const uint2*)(zp + C_K); R.zv_c = *(const uint2*)(zp + C_V);
    const uint2 zz = make_uint2(0u, 0u);
    if (t > 0) { R.zr_p = *(const uint2*)(zp - ZLD + C_R); R.zk_p = *(const uint2*)(zp - ZLD + C_K); R.zv_p = *(const uint2*)(zp - ZLD + C_V); } else { R.zr_p = zz; R.zk_p = zz; R.zv_p = zz; }
    R.lwu = *(const uint2*)(lw + T * 512 + gc); R.icu = *(const uint2*)(ic + T * 512 + gc);
}
__device__ __forceinline__ f32x4 unpack4(uint2 u) { f32x4 r; r[0] = bflo(u.x); r[1] = bfhi(u.x); r[2] = bflo(u.y); r[3] = bfhi(u.y); return r; }
__device__ __forceinline__ void scan_prep(const ScanRaw& R, const ScanConst& C, float* ops, float* vv, float* bonus_out, bool wr_bonus, int ptok, int pc, int v0) {
    const f32x4 rc = unpack4(R.zr_c), rp = unpack4(R.zr_p), kc = unpack4(R.zk_c), kp = unpack4(R.zk_p), vc = unpack4(R.zv_c), vp = unpack4(R.zv_p), ic = unpack4(R.icu), lw = unpack4(R.lwu);
    const f32x4 r = rc + (rp - rc) * C.mur, k = kc + (kp - kc) * C.muk, vs = vc + (vp - vc) * C.muv;
    f32x4 w; w[0] = __expf(lw[0]); w[1] = __expf(lw[1]); w[2] = __expf(lw[2]); w[3] = __expf(lw[3]);
    const f32x4 q = k * C.kk; const float ss = red16((q[0] * q[0] + q[1] * q[1]) + (q[2] * q[2] + q[3] * q[3]));
    const float inv = 1.0f / fmaxf(sqrtf(ss), 1e-12f); const f32x4 n = q * inv;
    const f32x4 kn = k * (1.0f + (ic - 1.0f) * C.ka);
    const f32x4 bt = r * kn * C.rk; const float bon = red16((bt[0] + bt[1]) + (bt[2] + bt[3]));
    if (wr_bonus) *bonus_out = bon;
    float* op = ops + ptok * 320 + pc;
    *(f32x4*)(op) = -n; *(f32x4*)(op + 64) = w; *(f32x4*)(op + 128) = n * ic; *(f32x4*)(op + 192) = kn; *(f32x4*)(op + 256) = r;
    if (pc >= v0 && pc < v0 + 32) *(f32x4*)(vv + ptok * 32 + pc - v0) = vs;
}
__device__ void p3_scan(const Frame& F) {
    const int tid = F.tid;
    float* opsb = (float*)g_lds;
    float* vvb = opsb + 2 * 5120;
    float* yob = vvb + 2 * 512;
    const bf16_t* z = F.z; const float* mu = F.in[3]; const float* k_k = F.in[9]; const float* k_a = F.in[10]; const float* r_k = F.in[11];
    for (int item = blockIdx.x; item < 256; item += gridDim.x) {
        const int bh = item >> 1, half = item & 1, b = bh >> 3, h = bh & 7, v0 = half * 32;
        const size_t tokbase = (size_t)b * SEQ;
        if (F.wave >= 4) {
            const int pt = tid - 256, ptok = pt >> 4, pc = (pt & 15) * 4, gc = h * 64 + pc;
            ScanConst C; C.mur = *(const f32x4*)(mu + C_R + gc); C.muk = *(const f32x4*)(mu + C_K + gc); C.muv = *(const f32x4*)(mu + C_V + gc);
            C.kk = *(const f32x4*)(k_k + gc); C.ka = *(const f32x4*)(k_a + gc); C.rk = *(const f32x4*)(r_k + gc);
            const bool wrb = (half == 0) && ((pt & 15) == 0);
            ScanRaw R;
            scan_load(R, z, F.lw, F.ic, tokbase, 0, ptok, gc);
            scan_prep(R, C, opsb, vvb, F.bonus + (tokbase + ptok) * 8 + h, wrb, ptok, pc, v0);
            scan_load(R, z, F.lw, F.ic, tokbase, 1, ptok, gc);
            __syncthreads();
            for (int ch = 0; ch < SEQ / 16; ++ch) {
                const int cur = ch & 1, nxt = cur ^ 1;
                if (ch > 0) { const int tok = pt >> 4, r2 = (pt & 15) * 2;
                    *(float2*)(F.yraw + (tokbase + (ch - 1) * 16 + tok) * 512 + h * 64 + v0 + r2) = *(const float2*)(yob + nxt * 512 + tok * 32 + r2); }
                if (ch + 1 < SEQ / 16) {
                    scan_prep(R, C, opsb + nxt * 5120, vvb + nxt * 512, F.bonus + (tokbase + (ch + 1) * 16 + ptok) * 8 + h, wrb, ptok, pc, v0);
                    if (ch + 2 < SEQ / 16) scan_load(R, z, F.lw, F.ic, tokbase, ch + 2, ptok, gc);
                }
                __syncthreads();
            }
            { const int tok = pt >> 4, r2 = (pt & 15) * 2;
              *(float2*)(F.yraw + (tokbase + (SEQ / 16 - 1) * 16 + tok) * 512 + h * 64 + v0 + r2) = *(const float2*)(yob + 512 + tok * 32 + r2); }
        } else {
            const int rp = tid >> 4, ks = tid & 15;
            float A0 = 0.f, A1 = 0.f, A2 = 0.f, A3 = 0.f, B0 = 0.f, B1 = 0.f, B2 = 0.f, B3 = 0.f;
            const int ywoff = (ks == 0) ? 2 * rp : (2 * 512 + 2 * tid), ywstep = (ks == 0) ? 32 : 0;
            __syncthreads();
            for (int ch = 0; ch < SEQ / 16; ++ch) {
                const int cur = ch & 1;
                const float* ops = opsb + cur * 5120 + ks * 4; const float* vv = vvb + cur * 512 + 2 * rp; float* yw = yob + cur * 512 + ywoff;
#pragma unroll
                for (int s = 0; s < 16; ++s) {
                    const float* o = ops + s * 320;
                    const f32x4 a4 = *(const f32x4*)(o), w4 = *(const f32x4*)(o + 64), b4 = *(const f32x4*)(o + 128), k4 = *(const f32x4*)(o + 192), r4 = *(const f32x4*)(o + 256);
                    const float2 vab = *(const float2*)(vv + s * 32);
                    float sa = (A0 * a4[0] + A1 * a4[1]) + (A2 * a4[2] + A3 * a4[3]); float sb = (B0 * a4[0] + B1 * a4[1]) + (B2 * a4[2] + B3 * a4[3]);
                    sa = red16(sa); sb = red16(sb);
                    A0 = A0 * w4[0] + sa * b4[0] + vab.x * k4[0]; A1 = A1 * w4[1] + sa * b4[1] + vab.x * k4[1];
                    A2 = A2 * w4[2] + sa * b4[2] + vab.x * k4[2]; A3 = A3 * w4[3] + sa * b4[3] + vab.x * k4[3];
                    B0 = B0 * w4[0] + sb * b4[0] + vab.y * k4[0]; B1 = B1 * w4[1] + sb * b4[1] + vab.y * k4[1];
                    B2 = B2 * w4[2] + sb * b4[2] + vab.y * k4[2]; B3 = B3 * w4[3] + sb * b4[3] + vab.y * k4[3];
                    float ya = (A0 * r4[0] + A1 * r4[1]) + (A2 * r4[2] + A3 * r4[3]); float yb2 = (B0 * r4[0] + B1 * r4[1]) + (B2 * r4[2] + B3 * r4[3]);
                    ya = red16(ya); yb2 = red16(yb2);
                    *(float2*)(yw + s * ywstep) = make_float2(ya, yb2);
                }
                __syncthreads();
            }
        }
        __syncthreads();
    }
}

__device__ __forceinline__ unsigned ordkey(float f) { const unsigned u = __float_as_uint(f); return (u & 0x80000000u) ? ~u : (u | 0x80000000u); }
__device__ void p3_dsa(const Frame& F) {
    const int tid = F.tid, lane = F.lane, wave = F.wave, fr = lane & 15, fq = lane >> 4;
    unsigned* selm = (unsigned*)g_lds;
    unsigned* eqm = selm + 1024;
    int* cnt = (int*)(eqm + 1024);
    int* eqpre = cnt + 256;
    unsigned char* kbuf = (unsigned char*)(eqpre + 1024);
    unsigned char* vbuf = kbuf + 2 * 9216;
    const bf16_t* z = F.z; const int G = gridDim.x, bx = blockIdx.x;
    const f32x4 zero4 = {0.f, 0.f, 0.f, 0.f};
    for (int rnd = 0; rnd * G < 2048; ++rnd) {
        const int n = rnd * G + ((rnd & 1) ? (G - 1 - bx) : bx);
        if (n >= 2048) continue;
        const int qg = 127 - (n >> 4), b = n & 15, q0 = qg * 16; const size_t Tb = (size_t)b * SEQ;
        for (int i = tid; i < 2048; i += NTHR) selm[i] = 0u;
        __syncthreads();
        const bf16_t* zq = z + (Tb + q0 + fr) * ZLD;
        const unsigned lofk = (unsigned)((fr * ZLD + fq * 8) * 2), lofv = (unsigned)((fr * SEQ + fq * 4) * 2);
        if (qg >= 16) {
            float sacc[16][4];
#pragma unroll
            for (int i = 0; i < 16; ++i)
#pragma unroll
                for (int jj = 0; jj < 4; ++jj) sacc[i][jj] = 0.f;
            const u32x4 wv = *(const u32x4*)(zq + C_WI);
#pragma unroll 1
            for (int hp = 0; hp < 2 + 2 * REP(11); ++hp) {
                if (hp == 2) {
#pragma unroll
                    for (int i = 0; i < 16; ++i)
#pragma unroll
                        for (int jj = 0; jj < 4; ++jj) sacc[i][jj] = 0.f; }
                bf16x8 Bq[4][2];
#pragma unroll
                for (int hh = 0; hh < 4; ++hh)
#pragma unroll
                    for (int ks = 0; ks < 2; ++ks) Bq[hh][ks] = *(const bf16x8*)(zq + C_QI + ((hp & 1) * 4 + hh) * 64 + ks * 32 + fq * 8);
                const unsigned wa = (hp & 1) ? wv.z : wv.x, wb = (hp & 1) ? wv.w : wv.y; const float sc = 0.044194173824159216f;
                float wih[4]; wih[0] = bflo(wa) * sc; wih[1] = bfhi(wa) * sc; wih[2] = bflo(wb) * sc; wih[3] = bfhi(wb) * sc;
                bf16x8 A0c, A1c;
                { const int kt0 = wave < qg ? wave : qg; const char* kb = (const char*)(z + (Tb + (size_t)kt0 * 16) * ZLD + C_KI);
                  A0c = *(const bf16x8*)(kb + lofk); A1c = *(const bf16x8*)(kb + lofk + 64); }
#pragma unroll
                for (int i = 0; i < 16; ++i) { const int kt = wave + 8 * i;
                    bf16x8 A0n = A0c, A1n = A1c;
                    if (i < 15) { const int ktn = (kt + 8) < qg ? (kt + 8) : qg; const char* kb = (const char*)(z + (Tb + (size_t)ktn * 16) * ZLD + C_KI);
                        unsigned lo2 = lofk; asm volatile("" : "+v"(lo2));
                        A0n = *(const bf16x8*)(kb + lo2); A1n = *(const bf16x8*)(kb + lo2 + 64); }
                    if (kt <= qg) {
#pragma unroll
                        for (int hh = 0; hh < 4; ++hh) { f32x4 acc = __builtin_amdgcn_mfma_f32_16x16x32_bf16(A0c, Bq[hh][0], zero4, 0, 0, 0);
                            acc = __builtin_amdgcn_mfma_f32_16x16x32_bf16(A1c, Bq[hh][1], acc, 0, 0, 0);
#pragma unroll
                            for (int jj = 0; jj < 4; ++jj) sacc[i][jj] += wih[hh] * fmaxf(acc[jj], 0.f); }
                    }
                    A0c = A0n; A1c = A1n;
                }
            }
            unsigned uk[16][4];
#pragma unroll
            for (int i = 0; i < 16; ++i) { const int kt = wave + 8 * i;
#pragma unroll
                for (int jj = 0; jj < 4; ++jj) { const bool masked = (kt > qg) || ((kt == qg) && (fq * 4 + jj > fr)); uk[i][jj] = masked ? 0x007fffffu : ordkey(sacc[i][jj]); } }
            unsigned T = 0u; bool found = false;
#pragma unroll 1
            for (int brep = 0; brep < 1 + REP(12); ++brep) { T = 0u; found = false; __syncthreads();
            for (int bit = 31; bit >= 0; --bit) {
                const unsigned cand = T | (1u << bit); int c = 0;
#pragma unroll
                for (int i = 0; i < 16; ++i) {
#pragma unroll
                    for (int jj = 0; jj < 4; ++jj) c += (uk[i][jj] >= cand) ? 1 : 0;
                    __builtin_amdgcn_sched_barrier(0); }
                c += __shfl_xor(c, 16); c += __shfl_xor(c, 32);
                const int par = bit & 1;
                if (fq == 0) cnt[(par * 8 + wave) * 16 + fr] = c;
                __syncthreads();
                int tot = 0;
#pragma unroll
                for (int w = 0; w < 8; ++w) tot += cnt[(par * 8 + w) * 16 + fr];
                if (!found && tot >= 256) { T = cand; if (tot == 256) found = true; }
                if (__all(found)) break;
            } }
            int need;
            { int c = 0; unsigned Tp = T + 1u; asm volatile("" : "+v"(Tp));
#pragma unroll
              for (int i = 0; i < 16; ++i) {
#pragma unroll
                  for (int jj = 0; jj < 4; ++jj) c += (uk[i][jj] >= Tp) ? 1 : 0;
                  __builtin_amdgcn_sched_barrier(0); }
              c += __shfl_xor(c, 16); c += __shfl_xor(c, 32);
              __syncthreads();
              if (fq == 0) cnt[wave * 16 + fr] = c;
              __syncthreads();
              int tot = 0;
#pragma unroll
              for (int w = 0; w < 8; ++w) tot += cnt[w * 16 + fr];
              need = 256 - tot; }
#pragma unroll
            for (int i = 0; i < 16; ++i) { const int kt = wave + 8 * i; unsigned nib = 0u;
#pragma unroll
                for (int jj = 0; jj < 4; ++jj) nib |= (uk[i][jj] == T) ? (1u << jj) : 0u;
                if (nib) atomicOr(&eqm[fr * 64 + (kt >> 1)], nib << ((kt & 1) * 16 + fq * 4));
                __builtin_amdgcn_sched_barrier(0); }
            __syncthreads();
            unsigned T2 = T; asm volatile("" : "+v"(T2));
            for (int w = tid; w < 1024; w += NTHR) { const int word = w & 63; int sct = 0; for (int j = 0; j < word; ++j) sct += __popc(eqm[w - word + j]); eqpre[w] = sct; }
            __syncthreads();
#pragma unroll
            for (int i = 0; i < 16; ++i) { const int kt = wave + 8 * i; unsigned nib = 0u;
                const int word = kt >> 1, bp0 = (kt & 1) * 16 + fq * 4; const unsigned eqw = eqm[fr * 64 + word]; const int rbase = eqpre[fr * 64 + word];
#pragma unroll
                for (int jj = 0; jj < 4; ++jj) { const int rank = rbase + __popc(eqw & ((1u << (bp0 + jj)) - 1u));
                    const bool sel = (uk[i][jj] > T2) || ((uk[i][jj] == T2) && (rank < need));
                    nib |= sel ? (1u << jj) : 0u; }
                if (nib) atomicOr(&selm[fr * 64 + word], nib << bp0);
                __builtin_amdgcn_sched_barrier(0); }
        } else {
            for (int w = tid; w < 1024; w += NTHR) { const int q = w >> 6, word = w & 63, qpos = q0 + q, lo = word * 32;
                selm[w] = (qpos >= lo + 31) ? 0xffffffffu : (qpos < lo ? 0u : ((2u << (qpos - lo)) - 1u)); }
        }
        __syncthreads();
#pragma unroll 1
        for (int arep = 0; arep < 1 + REP(13); ++arep) {
            const int nchunk = (qg + 4) >> 2; const int lrow = tid >> 3, lseg = tid & 7;
            const bf16_t* kg = z + (Tb + lrow) * ZLD + C_KA + lseg * 8; const bf16_t* vg = F.vt + ((size_t)b * 64 + lrow) * SEQ + lseg * 8;
            const unsigned lst = (unsigned)(lrow * 144 + lseg * 16);
            u32x4 kr = *(const u32x4*)(kg), vr = *(const u32x4*)(vg);
            *(u32x4*)(kbuf + lst) = kr; *(u32x4*)(vbuf + lst) = vr;
            bf16x8 Bqa[2];
#pragma unroll
            for (int ks = 0; ks < 2; ++ks) Bqa[ks] = *(const bf16x8*)(zq + C_Q + wave * 64 + ks * 32 + fq * 8);
            f32x4 O[4]; float rs = 0.f;
#pragma unroll
            for (int dt = 0; dt < 4; ++dt) O[dt] = zero4;
            __syncthreads();
#pragma unroll 1
            for (int c = 0; c < nchunk; ++c) {
                const bool more = (c + 1) < nchunk;
                if (more) { kr = *(const u32x4*)(kg + (size_t)(c + 1) * 64 * ZLD); vr = *(const u32x4*)(vg + (c + 1) * 64); }
                const unsigned char* kb = kbuf + (c & 1) * 9216; const unsigned char* vb = vbuf + (c & 1) * 9216;
#pragma unroll
                for (int p = 0; p < 2; ++p) {
                    const unsigned char* k0p = kb + ((2 * p) * 16 + fr) * 144 + fq * 16; const unsigned char* k1p = k0p + 16 * 144;
                    const bf16x8 KA00 = *(const bf16x8*)(k0p), KA01 = *(const bf16x8*)(k0p + 64), KA10 = *(const bf16x8*)(k1p), KA11 = *(const bf16x8*)(k1p + 64);
                    const unsigned mw = selm[fr * 64 + 2 * c + p]; const unsigned m0 = (mw >> (fq * 4)) & 0xFu, m1 = (mw >> (16 + fq * 4)) & 0xFu;
                    f32x4 s0 = __builtin_amdgcn_mfma_f32_16x16x32_bf16(KA00, Bqa[0], zero4, 0, 0, 0); s0 = __builtin_amdgcn_mfma_f32_16x16x32_bf16(KA01, Bqa[1], s0, 0, 0, 0);
                    f32x4 s1 = __builtin_amdgcn_mfma_f32_16x16x32_bf16(KA10, Bqa[0], zero4, 0, 0, 0); s1 = __builtin_amdgcn_mfma_f32_16x16x32_bf16(KA11, Bqa[1], s1, 0, 0, 0);
                    float p0[4], p1[4];
#pragma unroll
                    for (int jj = 0; jj < 4; ++jj) { p0[jj] = ((m0 >> jj) & 1u) ? __expf(fminf(s0[jj] * 0.125f, 60.f)) : 0.f; p1[jj] = ((m1 >> jj) & 1u) ? __expf(fminf(s1[jj] * 0.125f, 60.f)) : 0.f; }
                    rs += (p0[0] + p0[1]) + (p0[2] + p0[3]) + (p1[0] + p1[1]) + (p1[2] + p1[3]);
                    u32x4 pk; pk.x = cvt_pk_bf16(p0[0], p0[1]); pk.y = cvt_pk_bf16(p0[2], p0[3]); pk.z = cvt_pk_bf16(p1[0], p1[1]); pk.w = cvt_pk_bf16(p1[2], p1[3]);
                    const bf16x8 PB = __builtin_bit_cast(bf16x8, pk);
#pragma unroll
                    for (int dt = 0; dt < 4; ++dt) { const unsigned char* vp = vb + (dt * 16 + fr) * 144 + (2 * p) * 32 + fq * 8;
                        const uint2 lo = *(const uint2*)(vp), hi = *(const uint2*)(vp + 32);
                        u32x4 va; va.x = lo.x; va.y = lo.y; va.z = hi.x; va.w = hi.y;
                        O[dt] = __builtin_amdgcn_mfma_f32_16x16x32_bf16(__builtin_bit_cast(bf16x8, va), PB, O[dt], 0, 0, 0); }
                }
                if (more) { *(u32x4*)(kbuf + ((c + 1) & 1) * 9216 + lst) = kr; *(u32x4*)(vbuf + ((c + 1) & 1) * 9216 + lst) = vr; }
                __syncthreads();
            }
            rs += __shfl_xor(rs, 16); rs += __shfl_xor(rs, 32);
            const float inv = 1.0f / rs;
            bf16_t* yp = F.yb + (Tb + q0 + fr) * 512 + wave * 64 + fq * 4;
#pragma unroll
            for (int dt = 0; dt < 4; ++dt) { uint2 w; w.x = cvt_pk_bf16(O[dt][0] * inv, O[dt][1] * inv); w.y = cvt_pk_bf16(O[dt][2] * inv, O[dt][3] * inv); *(uint2*)(yp + dt * 16) = w; }
        }
        __syncthreads();
    }
}

__device__ void p4_post(const Frame& F) {
    const int tid = F.tid; const float* mu = F.in[3]; const float* gnw = F.in[12]; const float* gnb = F.in[13]; const bf16_t* z = F.z;
    for (int g = blockIdx.x * 16 + (tid >> 5); g < NTOK * 8; g += gridDim.x * 16) { const size_t t = (size_t)(g >> 3); const int h = g & 7, c = h * 64 + (tid & 31) * 2;
        const float2 y = *(const float2*)(F.yraw + t * 512 + c);
        const float mean = red32(y.x + y.y) * (1.0f / 64.0f); const float dx = y.x - mean, dy = y.y - mean;
        const float var = red32(dx * dx + dy * dy) * (1.0f / 64.0f); const float rstd = rsqrtf(var + 64e-5f);
        const unsigned vc = *(const unsigned*)(z + t * ZLD + C_V + c); const unsigned vp = (t & (SEQ - 1)) ? *(const unsigned*)(z + (t - 1) * ZLD + C_V + c) : 0u;
        const float vs0 = bflo(vc) + (bflo(vp) - bflo(vc)) * mu[C_V + c], vs1 = bfhi(vc) + (bfhi(vp) - bfhi(vc)) * mu[C_V + c + 1];
        const float bon = F.bonus[t * 8 + h]; const unsigned gt = *(const unsigned*)(F.gt + t * 512 + c);
        const float o0 = (dx * rstd * gnw[c] + gnb[c] + bon * vs0) * bflo(gt), o1 = (dy * rstd * gnw[c + 1] + gnb[c + 1] + bon * vs1) * bfhi(gt);
        *(unsigned*)(F.ya + t * 512 + c) = cvt_pk_bf16(o0, o1); }
}

__device__ void p9_final(const Frame& F) {
    const float* g = F.in[19]; const int lane = F.lane;
    for (int row = blockIdx.x * 8 + F.wave; row < NTOK; row += gridDim.x * 8) {
        float* xr = F.out + (size_t)row * DM; const float sc = rsqrtf(F.ss2[row] * (1.0f / 1024.0f) + 1e-6f);
#pragma unroll
        for (int i = 0; i < 4; ++i) { f32x4 v = *(const f32x4*)(xr + i * 256 + lane * 4); const f32x4 gg = *(const f32x4*)(g + i * 256 + lane * 4);
            v[0] *= sc * gg[0]; v[1] *= sc * gg[1]; v[2] *= sc * gg[2]; v[3] *= sc * gg[3]; *(f32x4*)(xr + i * 256 + lane * 4) = v; }
    }
}
#ifndef PHASE_MASK
#define PHASE_MASK 0x3ff
#endif
constexpr int NPHASE = 10;
template <class Epi> __device__ __forceinline__ void run_gemm(const bf16_t* A, const bf16_t* Bt, int N, int K, const Epi& E) {
    pg8::Gemm g{A, Bt, NTOK, N, K}; pg8::StaticOrder S; S.init(NTOK, N, (int)gridDim.x, (int)blockIdx.x);
    pg8::gemm_phase<Epi, pg8::StaticOrder, false>((PG8_LAS unsigned char*)g_lds, g, S, E, nullptr);
}
__global__ void __launch_bounds__(NTHR, 2) mega_fwd(Args args) {
    Frame F;
#pragma unroll
    for (int i = 0; i < 20; ++i) F.in[i] = args.in[i];
    F.out = args.out; F.ws = args.ws; F.lds = nullptr; F.tid = threadIdx.x; F.lane = F.tid & 63; F.wave = __builtin_amdgcn_readfirstlane(F.tid >> 6);
    unsigned char* ws = args.ws;
    F.ss1 = (float*)(ws + WS_SS1); F.ss2 = (float*)(ws + WS_SS2); F.bonus = (float*)(ws + WS_BONUS); F.rope = (float2*)(ws + WS_ROPE);
    F.wd = (bf16_t*)(ws + WS_WD); F.wi = (bf16_t*)(ws + WS_WI); F.wg = (bf16_t*)(ws + WS_WG);
    F.win = (bf16_t*)(ws + WS_WIN); F.wup = (bf16_t*)(ws + WS_WUP); F.wdn = (bf16_t*)(ws + WS_WDN); F.wb = (bf16_t*)(ws + WS_WB); F.wo = (bf16_t*)(ws + WS_WO); F.vt = (bf16_t*)(ws + WS_VT);
    F.h = (bf16_t*)(ws + WS_H); F.ya = F.h; F.yb = F.h + (size_t)NTOK * 512; F.xb = F.h;
    F.z = (bf16_t*)(ws + WS_Z); F.hid = F.z;
    F.lw = (bf16_t*)(ws + WS_P); F.ic = F.lw + (size_t)NTOK * 512; F.mg = F.lw;
    F.yraw = args.out; F.gt = (bf16_t*)(args.out + (size_t)NTOK * 512);
    const int lo = args.ph_lo, hi = args.ph_hi;
    cg::grid_group grid = cg::this_grid();
#define IN(k) (lo <= (k) && (k) < hi)
#define SEAM(k) do { if (IN(k) && IN((k) + 1)) grid.sync(); } while (0)
    if (((PHASE_MASK >> 0) & 1) && IN(0)) { p0_prologue(F); __syncthreads(); if (REP(0)) { p0_prologue(F); __syncthreads(); } } SEAM(0);
    if (((PHASE_MASK >> 1) & 1) && IN(1)) { pg8::EpiZ E{F.z, ZLD}; run_gemm(F.h, F.win, 5120, 1024, E); __syncthreads(); if (REP(1)) { run_gemm(F.h, F.win, 5120, 1024, E); __syncthreads(); } } SEAM(1);
    if (((PHASE_MASK >> 2) & 1) && IN(2)) { if (REP(2)) { p2_prep(F, false); __syncthreads(); } p2_prep(F, true); __syncthreads(); } SEAM(2);
    if (((PHASE_MASK >> 3) & 1) && IN(3)) { p3_scan(F); __syncthreads(); if (REP(3)) { p3_scan(F); __syncthreads(); } p3_dsa(F); __syncthreads(); if (REP(10)) { p3_dsa(F); __syncthreads(); } } SEAM(3);
    if (((PHASE_MASK >> 4) & 1) && IN(4)) { p4_post(F); __syncthreads(); if (REP(4)) { p4_post(F); __syncthreads(); } } SEAM(4);
    if (((PHASE_MASK >> 5) & 1) && IN(5)) { pg8::EpiGate<0> E0{F.mg, F.z, ZLD, C_G0}; run_gemm(F.ya, F.wb, 1024, 512, E0); __syncthreads();
                 pg8::EpiGate<1> E1{F.mg, F.z, ZLD, C_G1}; run_gemm(F.yb, F.wb + 1024 * 512, 1024, 512, E1); __syncthreads(); } SEAM(5);
    if (((PHASE_MASK >> 6) & 1) && IN(6)) { pg8::EpiRes<true> E{F.in[0], F.out, F.xb, F.ss1}; run_gemm(F.mg, F.wo, 1024, 1024, E); __syncthreads(); } SEAM(6);
    if (((PHASE_MASK >> 7) & 1) && IN(7)) { pg8::EpiHid E{F.hid, F.ss1}; run_gemm(F.xb, F.wup, 4096, 1024, E); __syncthreads(); if (REP(7)) { run_gemm(F.xb, F.wup, 4096, 1024, E); __syncthreads(); } } SEAM(7);
    if (((PHASE_MASK >> 8) & 1) && IN(8)) { pg8::EpiRes<false> E{F.out, F.out, nullptr, F.ss2}; run_gemm(F.hid, F.wdn, 1024, 4096, E); __syncthreads(); } SEAM(8);
    if (((PHASE_MASK >> 9) & 1) && IN(9)) { p9_final(F); }
#undef IN
#undef SEAM
}

extern "C" void kernel_launch(void* const* d_in, const int* in_sizes, int n_in, void* d_out, int out_size, void* d_ws, size_t ws_size, hipStream_t stream) {
    static int grid = 0;
    if (grid == 0) {
        if (n_in != 20 || out_size != NTOK * DM || ws_size < WS_END) { fprintf(stderr, "kernel_launch: unexpected shapes (n_in %d, out %d, ws %zu < %zu)\n", n_in, out_size, ws_size, (size_t)WS_END); grid = -1; return; }
        int dev = 0, cus = 0, per_cu = 0;
        hipGetDevice(&dev); hipDeviceGetAttribute(&cus, hipDeviceAttributeMultiprocessorCount, dev);
        if (hipFuncSetAttribute((const void*)mega_fwd, hipFuncAttributeMaxDynamicSharedMemorySize, LDS_BYTES) != hipSuccess) { fprintf(stderr, "kernel_launch: hipFuncSetAttribute failed\n"); grid = -1; return; }
        if (hipOccupancyMaxActiveBlocksPerMultiprocessor(&per_cu, (const void*)mega_fwd, NTHR, LDS_BYTES) != hipSuccess || per_cu < 1) { fprintf(stderr, "kernel_launch: occupancy query failed (%d)\n", per_cu); per_cu = 1; }
        (void)hipGetLastError();
        grid = cus * per_cu;
        fprintf(stderr, "kernel_launch: grid %d (%d CUs x %d)\n", grid, cus, per_cu);
    }
    if (grid < 0) return;
    Args a{};
    for (int i = 0; i < 20; ++i) a.in[i] = (const float*)d_in[i];
    a.out = (float*)d_out; a.ws = (unsigned char*)d_ws;
#if MK_PER_PHASE_LAUNCH
    for (int p = 0; p < NPHASE; ++p) { a.ph_lo = p; a.ph_hi = p + 1; hipLaunchKernelGGL(mega_fwd, dim3(grid), dim3(NTHR), LDS_BYTES, stream, a); }
#else
    a.ph_lo = 0; a.ph_hi = NPHASE;
    void* kargs[] = {&a};
    hipError_t e = hipLaunchCooperativeKernel((const void*)mega_fwd, dim3(grid), dim3(NTHR), kargs, LDS_BYTES, stream);
    if (e != hipSuccess) fprintf(stderr, "kernel_launch: cooperative launch failed: %s (grid %d)\n", hipGetErrorString(e), grid);
#endif
}
```

```cpp
#include <hip/hip_runtime.h>
#include <hip/hip_cooperative_groups.h>
#include <cstdio>
#include <cstdint>
namespace cg = cooperative_groups;

#ifndef MK_PER_PHASE_LAUNCH
#define MK_PER_PHASE_LAUNCH 0
#endif

#ifndef REPEAT_MASK
#define REPEAT_MASK 0
#endif
#define REP(k) ((REPEAT_MASK >> (k)) & 1)

namespace pg8 {
#define PG8_LAS __attribute__((address_space(3)))
typedef unsigned short bf16_t;
typedef short bf16x8 __attribute__((ext_vector_type(8)));
typedef float f32x4 __attribute__((ext_vector_type(4)));
typedef unsigned u32x4 __attribute__((ext_vector_type(4)));
constexpr int BM = 256, BK = 64, HALF = 128, HTB = HALF * BK * 2  , STAGE_BYTES = 8 * HTB, NXCD = 8, WGM = 8;

__host__ __device__ __forceinline__ int lds_byte(int r, int c) { const int st = (r >> 4) * 2 + (c >> 5), rr = r & 15, cc = c & 31, ob = rr * 64 + cc * 2; return st * 1024 + (ob ^ (((ob >> 9) & 1) << 5)); }
__host__ __device__ __forceinline__ void stage_rc(int b, int& R, int& C) { const int st = b / 1024, sb = b % 1024, swz = sb ^ (((sb >> 9) & 1) << 5); R = (st >> 1) * 16 + swz / 64; C = (st & 1) * 32 + (swz % 64) / 2; }
__host__ __device__ __forceinline__ int perm32(int rho) { const int n = rho >> 4, i = rho & 15; return 8 * (i >> 2) + 4 * n + (i & 3); }

struct Unit { int pm, pn; };
struct Gemm { const bf16_t* A; const bf16_t* Bt; int M, N, K; };

struct StaticOrder {
    int nM, nN, nwg, G, c;
    __host__ __device__ void init(int M, int N, int G_, int c_) { nM = M / BM; nN = N / BM; nwg = nM * nN; G = G_; c = c_; }
    __host__ __device__ bool next(int i, Unit& u) const {
        const long L = (long)i * G + c; if (L >= nwg) return false;
        int wgid = (int)L; { const int q = nwg / NXCD, r = nwg % NXCD, xcd = wgid % NXCD, off = wgid / NXCD; wgid = (xcd < r ? xcd * (q + 1) : r * (q + 1) + (xcd - r) * q) + off; }
        const int nig = WGM * nN, gid = wgid / nig, fm = gid * WGM, gsz = (nM - fm) < WGM ? (nM - fm) : WGM;
        u.pm = fm + ((wgid % nig) % gsz); u.pn = (wgid % nig) / gsz; return true;
    }
    __device__ __forceinline__ void a_ready(const Unit&) const {}
    __device__ __forceinline__ void done(const Unit&) const {}
};
__device__ __forceinline__ unsigned cvt_pk_bf16(float lo, float hi) { unsigned r; asm volatile("v_cvt_pk_bf16_f32 %0, %1, %2" : "=v"(r) : "v"(lo), "v"(hi)); return r; }
typedef float f32x2 __attribute__((ext_vector_type(2)));
__device__ __forceinline__ float bflo(unsigned u) { return __uint_as_float(u << 16); }
__device__ __forceinline__ float bfhi(unsigned u) { return __uint_as_float(u & 0xffff0000u); }
__device__ __forceinline__ float sigm(float x) { return 1.0f / (1.0f + __expf(-x)); }

struct EpiZ {
    static constexpr bool PERM = true, AFTER_DRAIN = false;
    bf16_t* O; int ldc;
    __device__ __forceinline__ void operator()(const f32x4 (&acc)[2][2][4][2], const Unit& u, int wr, int wc, int fr, int fq) const {
        const int row0 = u.pm * BM + wr * 64 + fr, col0 = u.pn * BM + wc * 32 + 8 * fq;
#pragma unroll
        for (int ai = 0; ai < 2; ++ai)
#pragma unroll
            for (int m = 0; m < 4; ++m) { bf16_t* rowp = O + (size_t)(row0 + ai * HALF + m * 16) * ldc + col0;
#pragma unroll
                for (int bj = 0; bj < 2; ++bj) { const f32x4 v0 = acc[ai][bj][m][0], v1 = acc[ai][bj][m][1];
                    u32x4 w; w.x = cvt_pk_bf16(v0[0], v0[1]); w.y = cvt_pk_bf16(v0[2], v0[3]); w.z = cvt_pk_bf16(v1[0], v1[1]); w.w = cvt_pk_bf16(v1[2], v1[3]);
                    *(u32x4*)(rowp + bj * HALF) = w; } }
    }
};
template <int MODE> struct EpiGate {
    static constexpr bool PERM = true, AFTER_DRAIN = false;
    bf16_t* O; const bf16_t* Z; int zld; int gcol;
    __device__ __forceinline__ void operator()(const f32x4 (&acc)[2][2][4][2], const Unit& u, int wr, int wc, int fr, int fq) const {
        const int row0 = u.pm * BM + wr * 64 + fr, col0 = u.pn * BM + wc * 32 + 8 * fq;
#pragma unroll
        for (int ai = 0; ai < 2; ++ai)
#pragma unroll
            for (int m = 0; m < 4; ++m) { const size_t row = (size_t)(row0 + ai * HALF + m * 16);
                bf16_t* op = O + row * 1024 + col0; const bf16_t* zp = Z + row * zld + gcol + col0;
#pragma unroll
                for (int bj = 0; bj < 2; ++bj) { const f32x4 v0 = acc[ai][bj][m][0], v1 = acc[ai][bj][m][1];
                    const u32x4 g = *(const u32x4*)(zp + bj * HALF);
                    float r0 = v0[0] * sigm(bflo(g.x)), r1 = v0[1] * sigm(bfhi(g.x)), r2 = v0[2] * sigm(bflo(g.y)), r3 = v0[3] * sigm(bfhi(g.y));
                    float r4 = v1[0] * sigm(bflo(g.z)), r5 = v1[1] * sigm(bfhi(g.z)), r6 = v1[2] * sigm(bflo(g.w)), r7 = v1[3] * sigm(bfhi(g.w));
                    if (MODE == 1) { const u32x4 p = *(const u32x4*)(op + bj * HALF);
                        r0 += bflo(p.x); r1 += bfhi(p.x); r2 += bflo(p.y); r3 += bfhi(p.y); r4 += bflo(p.z); r5 += bfhi(p.z); r6 += bflo(p.w); r7 += bfhi(p.w); }
                    u32x4 w; w.x = cvt_pk_bf16(r0, r1); w.y = cvt_pk_bf16(r2, r3); w.z = cvt_pk_bf16(r4, r5); w.w = cvt_pk_bf16(r6, r7);
                    *(u32x4*)(op + bj * HALF) = w; } }
    }
};
template <bool WITH_XB> struct EpiRes {
    static constexpr bool PERM = false, AFTER_DRAIN = false;
    const float* X; float* O; bf16_t* XB; float* SS;
    __device__ __forceinline__ void operator()(const f32x4 (&acc)[2][2][4][2], const Unit& u, int wr, int wc, int fr, int fq) const {
        const int row0 = u.pm * BM + wr * 64 + fr, col0 = u.pn * BM + wc * 32 + 4 * fq;
#pragma unroll
        for (int ai = 0; ai < 2; ++ai)
#pragma unroll
            for (int m = 0; m < 4; ++m) { const size_t row = (size_t)(row0 + ai * HALF + m * 16); float ssq = 0.f;
#pragma unroll
                for (int bj = 0; bj < 2; ++bj)
#pragma unroll
                    for (int n = 0; n < 2; ++n) { const size_t off = row * 1024 + col0 + bj * HALF + n * 16;
                        const f32x4 xv = *(const f32x4*)(X + off); const f32x4 v = acc[ai][bj][m][n] + xv;
                        *(f32x4*)(O + off) = v; ssq += v[0] * v[0] + v[1] * v[1] + v[2] * v[2] + v[3] * v[3];
                        if (WITH_XB) { uint2 w; w.x = cvt_pk_bf16(v[0], v[1]); w.y = cvt_pk_bf16(v[2], v[3]); *(uint2*)(XB + off) = w; } }
                ssq += __shfl_xor(ssq, 16); ssq += __shfl_xor(ssq, 32);
                if (fq == 0) atomicAdd(SS + row, ssq); }
    }
};
struct EpiHid {
    static constexpr bool PERM = true, AFTER_DRAIN = false;
    bf16_t* O; const float* SS;
    __device__ __forceinline__ void operator()(const f32x4 (&acc)[2][2][4][2], const Unit& u, int wr, int wc, int fr, int fq) const {
        const int row0 = u.pm * BM + wr * 64 + fr, col0 = u.pn * BM + wc * 32 + 8 * fq;
#pragma unroll
        for (int ai = 0; ai < 2; ++ai)
#pragma unroll
            for (int m = 0; m < 4; ++m) { const size_t row = (size_t)(row0 + ai * HALF + m * 16);
                const float s2 = 1.0f / (SS[row] * (1.0f / 1024.0f) + 1e-6f);
                bf16_t* rowp = O + row * 4096 + col0;
#pragma unroll
                for (int bj = 0; bj < 2; ++bj) { f32x4 v0 = acc[ai][bj][m][0], v1 = acc[ai][bj][m][1];
#pragma unroll
                    for (int j = 0; j < 4; ++j) { float a = fmaxf(v0[j], 0.f), b = fmaxf(v1[j], 0.f); v0[j] = a * a * s2; v1[j] = b * b * s2; }
                    u32x4 w; w.x = cvt_pk_bf16(v0[0], v0[1]); w.y = cvt_pk_bf16(v0[2], v0[3]); w.z = cvt_pk_bf16(v1[0], v1[1]); w.w = cvt_pk_bf16(v1[2], v1[3]);
                    *(u32x4*)(rowp + bj * HALF) = w; } }
    }
};

template <class Epi, class Sched, bool STAMP = false>
__device__ __forceinline__ void gemm_phase(PG8_LAS unsigned char* lds, const Gemm g, const Sched& S, const Epi& E, unsigned long long* stamps) {
    const int tid = threadIdx.x, wid = __builtin_amdgcn_readfirstlane(tid >> 6), lane = tid & 63, wr = wid >> 2, wc = wid & 3, fr = lane & 15, fq = lane >> 4;
    const int K = g.K, nt = K / BK;
    int ts_lo = 0, ts_hi = 0, nts = 0; const unsigned long long rt_entry = STAMP ? (unsigned long long)wall_clock64() : 0ull;
#define PG8_STAMP() do { if (STAMP && wid == 0 && nts < 64) { const unsigned long long _c = (unsigned long long)clock64(); \
        ts_lo = (lane == nts) ? (int)(unsigned)_c : ts_lo; ts_hi = (lane == nts) ? (int)(unsigned)(_c >> 32) : ts_hi; ++nts; } } while (0)
    PG8_STAMP();
    unsigned voffA[2], voffB[2];
#pragma unroll
    for (int i = 0; i < 2; ++i) { int R, C; stage_rc(tid * 16 + i * 8192, R, C); const int Rb = Epi::PERM ? ((R & ~31) + perm32(R & 31)) : R;
        voffA[i] = (unsigned)(R * K + C) * 2u; voffB[i] = (unsigned)(Rb * K + C) * 2u; }
    const size_t kstep = (size_t)(BK * 2);
    const size_t hstep = (size_t)HALF * K * 2;
    const size_t tstep = 2 * hstep;
    const unsigned ldsw = (unsigned)wid * 1024u;
    const int aoff = lds_byte(wr * 64 + fr, fq * 8), boff = lds_byte(wc * 32 + fr, fq * 8);
#define PG8_SA(b, h) (((b) * 2 + (h)) * HTB)
#define PG8_SB(b, h) ((4 + (b) * 2 + (h)) * HTB)
#define PG8_STAGE(bufoff, gbase, voff) do { _Pragma("unroll") for (int _i = 0; _i < 2; ++_i) \
        __builtin_amdgcn_global_load_lds((const unsigned*)((const char*)(gbase) + (voff)[_i]), (PG8_LAS unsigned*)(lds + (bufoff) + ldsw + _i * 8192), 16, 0, 0); } while (0)
#define PG8_LDA(dst, b, h) do { _Pragma("unroll") for (int m = 0; m < 4; ++m) _Pragma("unroll") for (int k = 0; k < 2; ++k) dst[m][k] = *(const PG8_LAS bf16x8*)(lds + PG8_SA(b, h) + aoff + m * 2048 + k * 1024); } while (0)
#define PG8_LDB(dst, b, h) do { _Pragma("unroll") for (int n = 0; n < 2; ++n) _Pragma("unroll") for (int k = 0; k < 2; ++k) dst[n][k] = *(const PG8_LAS bf16x8*)(lds + PG8_SB(b, h) + boff + n * 2048 + k * 1024); } while (0)
#define PG8_MMA(ai, bj, At, Bt) do { __builtin_amdgcn_s_setprio(1); _Pragma("unroll") for (int m = 0; m < 4; ++m) _Pragma("unroll") for (int n = 0; n < 2; ++n) _Pragma("unroll") for (int k = 0; k < 2; ++k) \
        acc[ai][bj][m][n] = __builtin_amdgcn_mfma_f32_16x16x32_bf16(Bt[n][k], At[m][k], acc[ai][bj][m][n], 0, 0, 0); __builtin_amdgcn_s_setprio(0); } while (0)
#define PG8_WAIT_V(n) asm volatile("s_waitcnt vmcnt(" #n ")" ::: "memory")
#define PG8_WAIT_L(n) asm volatile("s_waitcnt lgkmcnt(" #n ")" ::: "memory")
#define PG8_BAR __builtin_amdgcn_s_barrier()
#define PG8_SCHED __builtin_amdgcn_sched_barrier(0)
    Unit cur, nxt; int ui = 0;
    if (!S.next(0, cur)) return;
    f32x4 acc[2][2][4][2];
#pragma unroll
    for (int a = 0; a < 2; ++a)
#pragma unroll
        for (int b = 0; b < 2; ++b)
#pragma unroll
            for (int m = 0; m < 4; ++m)
#pragma unroll
                for (int n = 0; n < 2; ++n) acc[a][b][m][n] = (f32x4){0.f, 0.f, 0.f, 0.f};
    bf16x8 At[4][2], B0[2][2], B1[2][2];
    const char* cA = (const char*)g.A + (size_t)cur.pm * tstep; const char* cB = (const char*)g.Bt + (size_t)cur.pn * tstep;
    S.a_ready(cur);
    PG8_STAGE(PG8_SB(0, 0), cB, voffB); PG8_STAGE(PG8_SA(0, 0), cA, voffA); PG8_STAGE(PG8_SB(0, 1), cB + hstep, voffB); PG8_STAGE(PG8_SA(0, 1), cA + hstep, voffA);
    if (wr == 1) PG8_BAR;
    PG8_WAIT_V(4); PG8_BAR;
    PG8_STAGE(PG8_SB(1, 0), cB + kstep, voffB); PG8_STAGE(PG8_SA(1, 0), cA + kstep, voffA); PG8_STAGE(PG8_SB(1, 1), cB + hstep + kstep, voffB);
    PG8_WAIT_V(6); PG8_BAR;
    PG8_STAMP();
    for (;;) {
        const bool has_next = S.next(ui + 1, nxt);
        const char* nA = has_next ? (const char*)g.A + (size_t)nxt.pm * tstep : cA; const char* nB = has_next ? (const char*)g.Bt + (size_t)nxt.pn * tstep : cB;
        for (int t = 0; t < nt; t += 2) {
            const bool last = (t == nt - 2);
            const char* a1 = cA + (size_t)(t + 1) * kstep;
            const char* a2 = last ? nA : cA + (size_t)(t + 2) * kstep; const char* b2 = last ? nB : cB + (size_t)(t + 2) * kstep;
            const char* a3 = a2 + kstep; const char* b3 = b2 + kstep;
            if (last && has_next) S.a_ready(nxt);
            PG8_LDB(B0, 0, 0); PG8_SCHED; PG8_LDA(At, 0, 0); PG8_STAGE(PG8_SA(1, 1), a1 + hstep, voffA);
            PG8_WAIT_L(8); PG8_BAR; PG8_WAIT_L(0); PG8_MMA(0, 0, At, B0); PG8_BAR; PG8_SCHED;
            PG8_LDB(B1, 0, 1); PG8_STAGE(PG8_SB(0, 0), b2, voffB);
            PG8_BAR; PG8_WAIT_L(0); PG8_MMA(0, 1, At, B1); PG8_BAR;
            PG8_LDA(At, 0, 1); PG8_STAGE(PG8_SA(0, 0), a2, voffA);
            PG8_BAR; PG8_WAIT_L(0); PG8_MMA(1, 0, At, B0); PG8_BAR; PG8_SCHED;
            PG8_STAGE(PG8_SB(0, 1), b2 + hstep, voffB);
            PG8_WAIT_V(6); PG8_BAR; PG8_MMA(1, 1, At, B1); PG8_BAR;
            PG8_LDB(B0, 1, 0); PG8_SCHED; PG8_LDA(At, 1, 0); PG8_STAGE(PG8_SA(0, 1), a2 + hstep, voffA);
            PG8_WAIT_L(8); PG8_BAR; PG8_WAIT_L(0); PG8_MMA(0, 0, At, B0); PG8_BAR; PG8_SCHED;
            PG8_LDB(B1, 1, 1); PG8_STAGE(PG8_SB(1, 0), b3, voffB);
            PG8_BAR; PG8_WAIT_L(0); PG8_MMA(0, 1, At, B1); PG8_BAR;
            PG8_LDA(At, 1, 1); PG8_STAGE(PG8_SA(1, 0), a3, voffA);
            PG8_BAR; PG8_WAIT_L(0); PG8_MMA(1, 0, At, B0); PG8_BAR; PG8_SCHED;
            PG8_STAGE(PG8_SB(1, 1), b3 + hstep, voffB);
            PG8_WAIT_V(6); PG8_BAR; PG8_MMA(1, 1, At, B1); PG8_BAR;
        }
        PG8_STAMP();
        if constexpr (!Epi::AFTER_DRAIN) { E(acc, cur, wr, wc, fr, fq); S.done(cur); }
        PG8_STAMP();
        if (!has_next) break;
#pragma unroll
        for (int a = 0; a < 2; ++a)
#pragma unroll
            for (int b = 0; b < 2; ++b)
#pragma unroll
                for (int m = 0; m < 4; ++m)
#pragma unroll
                    for (int n = 0; n < 2; ++n) acc[a][b][m][n] = (f32x4){0.f, 0.f, 0.f, 0.f};
        cur = nxt; cA = nA; cB = nB; ++ui;
    }
    PG8_WAIT_V(0);
    if (wr == 0) PG8_BAR;
    PG8_BAR;
    if constexpr (Epi::AFTER_DRAIN) { E.fused(acc, cur, wr, wc, fr, fq, lds, wid, lane); S.done(cur); }
    PG8_STAMP();
    if (STAMP && wid == 0) { stamps[lane] = lane < nts ? (((unsigned long long)(unsigned)ts_hi << 32) | (unsigned)ts_lo) : 0ull;
        if (lane == 62) stamps[62] = rt_entry; if (lane == 63) stamps[63] = (unsigned long long)wall_clock64(); }
#undef PG8_STAMP
#undef PG8_SA
#undef PG8_SB
#undef PG8_STAGE
#undef PG8_LDA
#undef PG8_LDB
#undef PG8_MMA
#undef PG8_WAIT_V
#undef PG8_WAIT_L
#undef PG8_BAR
#undef PG8_SCHED
}
}
extern __shared__ __attribute__((aligned(16))) unsigned char g_lds[];
using pg8::bf16_t; using pg8::bf16x8; using pg8::f32x4; using pg8::u32x4; using pg8::cvt_pk_bf16; using pg8::bflo; using pg8::bfhi; using pg8::sigm;

constexpr int NTOK = 32768, DM = 1024, SEQ = 2048, NB = 16, ZLD = 5120, NTHR = 512;
constexpr int C_R = 0, C_K = 512, C_V = 1024, C_WD = 1536, C_AD = 1600, C_GD = 1664;
constexpr int C_Q = 1824, C_KA = 2336, C_VA = 2400, C_QI = 2464, C_KI = 2976, C_WI = 3040, C_G0 = 3048, C_G1 = 4072;
constexpr size_t MiB = 1024 * 1024;
constexpr size_t WS_SS1 = 0, WS_SS2 = 128 * 1024, WS_BONUS = 256 * 1024, WS_ROPE = 1280 * 1024, WS_WD = 1792 * 1024, WS_WI = 1856 * 1024, WS_WG = 1920 * 1024;
constexpr size_t WS_WIN = 4 * MiB, WS_WUP = 14 * MiB, WS_WDN = 22 * MiB, WS_WB = 30 * MiB, WS_WO = 32 * MiB, WS_VT = 34 * MiB, WS_H = 38 * MiB, WS_Z = 102 * MiB, WS_P = 422 * MiB, WS_END = 486 * MiB;
constexpr int LDS_BYTES = 131072;

struct Args { const float* in[20]; float* out; unsigned char* ws; int ph_lo, ph_hi; };

struct Frame {
    const float* in[20]; float* out; unsigned char* ws; unsigned char* lds; int tid, lane, wave;
    float *ss1, *ss2, *bonus; float2* rope; bf16_t *wd, *wi, *wg, *win, *wup, *wdn, *wb, *wo, *vt, *h, *ya, *yb, *xb, *z, *hid, *lw, *ic, *mg, *gt; float* yraw;
};

__device__ __forceinline__ bf16_t f2bf(float f) { return (bf16_t)(cvt_pk_bf16(f, 0.f) & 0xffffu); }
__device__ __forceinline__ float bf2f(bf16_t b) { return __uint_as_float(((unsigned)b) << 16); }
template <int CTRL> __device__ __forceinline__ float dpp_mov(float x) { return __int_as_float(__builtin_amdgcn_update_dpp(0, __float_as_int(x), CTRL, 0xF, 0xF, true)); }
__device__ __forceinline__ float red16(float x) { x += dpp_mov<0xB1>(x); x += dpp_mov<0x4E>(x); x += dpp_mov<0x141>(x); x += dpp_mov<0x140>(x); return x; }


__device__ __forceinline__ void lds_barrier() { asm volatile("s_waitcnt lgkmcnt(0)" ::: "memory"); __builtin_amdgcn_s_barrier(); asm volatile("" ::: "memory"); }
__device__ __forceinline__ void red16x4(float& a, float& b, float& c, float& d) {
#define DPP4(ctl) "v_add_f32_dpp %0, %0, %0 " ctl " row_mask:0xf bank_mask:0xf bound_ctrl:1\n" "v_add_f32_dpp %1, %1, %1 " ctl " row_mask:0xf bank_mask:0xf bound_ctrl:1\n" \
                  "v_add_f32_dpp %2, %2, %2 " ctl " row_mask:0xf bank_mask:0xf bound_ctrl:1\n" "v_add_f32_dpp %3, %3, %3 " ctl " row_mask:0xf bank_mask:0xf bound_ctrl:1\n"
    asm volatile("s_nop 1\n" DPP4("quad_perm:[1,0,3,2]") DPP4("quad_perm:[2,3,0,1]") DPP4("row_half_mirror") DPP4("row_mirror") : "+v"(a), "+v"(b), "+v"(c), "+v"(d));
#undef DPP4
}
__device__ __forceinline__ float red32(float x) { x += __shfl_xor(x, 1); x += __shfl_xor(x, 2); x += __shfl_xor(x, 4); x += __shfl_xor(x, 8); x += __shfl_xor(x, 16); return x; }
__device__ __forceinline__ float red64(float x) { x = red32(x); x += __shfl_xor(x, 32); return x; }
__device__ __forceinline__ float softplus_f(float x) { return fmaxf(x, 0.f) + log1pf(__expf(-fabsf(x))); }

__device__ void tconv(const Frame& F, const float* __restrict__ W, int K, int N, int Npad, bf16_t* __restrict__ Wt, const float* __restrict__ rs) {
    float* tile = (float*)g_lds;
    const int ktn = (K + 63) / 64, ntn = Npad / 64, tid = F.tid;
    for (int tl = blockIdx.x; tl < ktn * ntn; tl += gridDim.x) {
        const int kt = tl % ktn, nt = tl / ktn;
#pragma unroll
        for (int i = 0; i < 2; ++i) { const int idx = tid + i * NTHR, kk = idx >> 4, n4 = (idx & 15) * 4, k = kt * 64 + kk, n = nt * 64 + n4;
            f32x4 v = {0.f, 0.f, 0.f, 0.f};
            if (k < K) { if (n + 3 < N) v = *(const f32x4*)(W + (size_t)k * N + n); else { for (int j = 0; j < 4; ++j) if (n + j < N) v[j] = W[(size_t)k * N + n + j]; }
                if (rs != nullptr) { const float r = rs[k]; v[0] *= r; v[1] *= r; v[2] *= r; v[3] *= r; } }
            tile[kk * 65 + n4] = v[0]; tile[kk * 65 + n4 + 1] = v[1]; tile[kk * 65 + n4 + 2] = v[2]; tile[kk * 65 + n4 + 3] = v[3]; }
        __syncthreads();
        { const int nn = tid >> 3, k8 = (tid & 7) * 8, k = kt * 64 + k8, n = nt * 64 + nn;
          if (k < K) { u32x4 w; const float* tp = tile + k8 * 65 + nn;
              w.x = cvt_pk_bf16(tp[0], tp[65]); w.y = cvt_pk_bf16(tp[130], tp[195]); w.z = cvt_pk_bf16(tp[260], tp[325]); w.w = cvt_pk_bf16(tp[390], tp[455]);
              *(u32x4*)(Wt + (size_t)n * K + k) = w; } }
        __syncthreads();
    }
}
__device__ void p0_prologue(const Frame& F) {
    const int tid = F.tid, gtid = blockIdx.x * NTHR + tid, gn = gridDim.x * NTHR;
    for (int i = gtid; i < 2 * NTOK; i += gn) F.ss1[i] = 0.f;
    for (int i = gtid; i < SEQ * 32; i += gn) { const int pos = i >> 5, j = i & 31;
        const float inv = 1.0f / powf(10000.0f, (float)(2 * j) / 64.0f); const float ang = (float)pos * inv;
        double rev = (double)ang * 0.15915494309189535; rev -= floor(rev); const float fr = (float)rev;
        F.rope[i] = make_float2(__builtin_amdgcn_cosf(fr), __builtin_amdgcn_sinf(fr)); }
    tconv(F, F.in[2], 1024, 5096, 5120, F.win, nullptr);
    tconv(F, F.in[17], 1024, 4096, 4096, F.wup, F.in[16]);
    tconv(F, F.in[18], 4096, 1024, 1024, F.wdn, nullptr);
    tconv(F, F.in[14], 512, 1024, 1024, F.wb, nullptr);
    tconv(F, F.in[14] + 512 * 1024, 512, 1024, 1024, F.wb + 1024 * 512, nullptr);
    tconv(F, F.in[15], 1024, 1024, 1024, F.wo, nullptr);
    tconv(F, F.in[5], 64, 512, 512, F.wd, nullptr);
    tconv(F, F.in[7], 64, 512, 512, F.wi, nullptr);
    tconv(F, F.in[8], 160, 512, 512, F.wg, nullptr);
    const float* x = F.in[0]; const float* g = F.in[1]; const int lane = F.lane;
    for (int row = blockIdx.x * 8 + F.wave; row < NTOK; row += gridDim.x * 8) {
        const float* xr = x + (size_t)row * DM; f32x4 v[4]; float ss = 0.f;
#pragma unroll
        for (int i = 0; i < 4; ++i) { v[i] = *(const f32x4*)(xr + i * 256 + lane * 4); ss += v[i][0] * v[i][0] + v[i][1] * v[i][1] + v[i][2] * v[i][2] + v[i][3] * v[i][3]; }
        ss = red64(ss); const float sc = rsqrtf(ss * (1.0f / 1024.0f) + 1e-6f);
#pragma unroll
        for (int i = 0; i < 4; ++i) { const f32x4 gg = *(const f32x4*)(g + i * 256 + lane * 4); uint2 w;
            w.x = cvt_pk_bf16(v[i][0] * sc * gg[0], v[i][1] * sc * gg[1]); w.y = cvt_pk_bf16(v[i][2] * sc * gg[2], v[i][3] * sc * gg[3]);
            *(uint2*)(F.h + (size_t)row * DM + i * 256 + lane * 4) = w; }
    }
}

__device__ void p2_prep(const Frame& F, const bool do_rope) {
    const int tid = F.tid, lane = F.lane, wave = F.wave, fr = lane & 15, fq = lane >> 4;
    bf16_t* z = F.z; const float* mu = F.in[3];
    {
        constexpr int LDA = 296; bf16_t* At = (bf16_t*)g_lds;
        bf16_t* Ot = At + 16 * LDA;
        const float* dbias = F.in[4]; const float* ibias = F.in[6];
        for (int tile = blockIdx.x; tile < NTOK / 16; tile += gridDim.x) {
            const int t0 = tile * 16;
            for (int idx = tid; idx < 16 * 36; idx += NTHR) { const int tok = idx / 36, c8 = (idx - tok * 36) * 8, t = t0 + tok, col = C_WD + c8;
                const u32x4 zc = *(const u32x4*)(z + (size_t)t * ZLD + col); u32x4 zp = {0u, 0u, 0u, 0u}; if (t & (SEQ - 1)) zp = *(const u32x4*)(z + (size_t)(t - 1) * ZLD + col);
                const f32x4 m0 = *(const f32x4*)(mu + col), m1 = *(const f32x4*)(mu + col + 4);
                float v[8]; const unsigned zcu[4] = {zc.x, zc.y, zc.z, zc.w}, zpu[4] = {zp.x, zp.y, zp.z, zp.w};
#pragma unroll
                for (int j = 0; j < 4; ++j) { const float a = bflo(zcu[j]), b2 = bfhi(zcu[j]), pa = bflo(zpu[j]), pb = bfhi(zpu[j]);
                    const float mm0 = (j < 2) ? m0[2 * j] : m1[2 * j - 4], mm1 = (j < 2) ? m0[2 * j + 1] : m1[2 * j - 3];
                    v[2 * j] = a + (pa - a) * mm0; v[2 * j + 1] = b2 + (pb - b2) * mm1; }
                if (c8 < 64) {
#pragma unroll
                    for (int j = 0; j < 8; ++j) v[j] = tanhf(v[j]); }
                else if (c8 >= 128) {
#pragma unroll
                    for (int j = 0; j < 8; ++j) v[j] = sigm(v[j]); }
                u32x4 w; w.x = cvt_pk_bf16(v[0], v[1]); w.y = cvt_pk_bf16(v[2], v[3]); w.z = cvt_pk_bf16(v[4], v[5]); w.w = cvt_pk_bf16(v[6], v[7]);
                *(u32x4*)(At + tok * LDA + c8) = w; }
            __syncthreads();
            const int h = wave;
#pragma unroll 1
            for (int j = 0; j < 4; ++j) { const int n = h * 64 + j * 16 + fr;
                f32x4 ad = {0.f, 0.f, 0.f, 0.f}, ai = ad, ag = ad;
#pragma unroll
                for (int ks = 0; ks < 2; ++ks) { const bf16x8 a = *(const bf16x8*)(At + fr * LDA + ks * 32 + fq * 8); const bf16x8 b = *(const bf16x8*)(F.wd + n * 64 + ks * 32 + fq * 8);
                    ad = __builtin_amdgcn_mfma_f32_16x16x32_bf16(a, b, ad, 0, 0, 0); }
#pragma unroll
                for (int ks = 0; ks < 2; ++ks) { const bf16x8 a = *(const bf16x8*)(At + fr * LDA + 64 + ks * 32 + fq * 8); const bf16x8 b = *(const bf16x8*)(F.wi + n * 64 + ks * 32 + fq * 8);
                    ai = __builtin_amdgcn_mfma_f32_16x16x32_bf16(a, b, ai, 0, 0, 0); }
#pragma unroll
                for (int ks = 0; ks < 5; ++ks) { const bf16x8 a = *(const bf16x8*)(At + fr * LDA + 128 + ks * 32 + fq * 8); const bf16x8 b = *(const bf16x8*)(F.wg + n * 160 + ks * 32 + fq * 8);
                    ag = __builtin_amdgcn_mfma_f32_16x16x32_bf16(a, b, ag, 0, 0, 0); }
                const float db = dbias[n], ib = ibias[n];
#pragma unroll
                for (int jj = 0; jj < 4; ++jj) { const size_t t = (size_t)(t0 + fq * 4 + jj);
                    const float dw = db + ad[jj]; (void)t; const float wlog = -softplus_f(-dw) - 0.5f; const float lwv = -__expf(wlog);
                    const int tk = fq * 4 + jj; Ot[tk * 520 + n] = f2bf(lwv); Ot[(16 + tk) * 520 + n] = f2bf(sigm(ib + ai[jj])); Ot[(32 + tk) * 520 + n] = f2bf(ag[jj]); }
            }
            __syncthreads();
#pragma unroll
            for (int i = 0; i < 6; ++i) { const int idx = tid + i * NTHR, arr = idx >> 10, rem = idx & 1023, tk = rem >> 6, c8 = (rem & 63) * 8;
                const u32x4 w = *(const u32x4*)(Ot + (arr * 16 + tk) * 520 + c8); bf16_t* dst = arr == 0 ? F.lw : (arr == 1 ? F.ic : F.gt);
                *(u32x4*)(dst + (size_t)(t0 + tk) * 512 + c8) = w; }
            __syncthreads();
        }
    }
    {
        unsigned short* tl = (unsigned short*)g_lds;
        for (int tile = blockIdx.x; tile < NTOK / 64; tile += gridDim.x) { const int t0 = tile * 64, b = t0 / SEQ, tt0 = t0 % SEQ;
#pragma unroll
            for (int i = 0; i < 8; ++i) { const int idx = tid + i * NTHR, tok = idx >> 6, d = idx & 63; tl[tok * 66 + d] = z[(size_t)(t0 + tok) * ZLD + C_VA + d]; }
            __syncthreads();
#pragma unroll
            for (int i = 0; i < 8; ++i) { const int idx = tid + i * NTHR, d = idx >> 6, tok = idx & 63; F.vt[((size_t)b * 64 + d) * SEQ + tt0 + tok] = tl[tok * 66 + d]; }
            __syncthreads();
        }
    }
    if (do_rope) {
        const int gtid = blockIdx.x * NTHR + tid, gn = gridDim.x * NTHR;
        for (int idx = gtid; idx < NTOK * 144; idx += gn) { const int t = idx / 144, p = idx - t * 144, hd = p >> 3, i4 = (p & 7) * 4;
            const int base = hd < 8 ? C_Q + hd * 64 : (hd == 8 ? C_KA : (hd < 17 ? C_QI + (hd - 9) * 64 : C_KI));
            const f32x4 cs0 = *(const f32x4*)(&F.rope[(t & (SEQ - 1)) * 32 + i4]), cs1 = *(const f32x4*)(&F.rope[(t & (SEQ - 1)) * 32 + i4 + 2]);
            bf16_t* p1 = z + (size_t)t * ZLD + base + i4; const uint2 a = *(const uint2*)(p1), b2 = *(const uint2*)(p1 + 32);
            const float x10 = bflo(a.x), x11 = bfhi(a.x), x12 = bflo(a.y), x13 = bfhi(a.y), x20 = bflo(b2.x), x21 = bfhi(b2.x), x22 = bflo(b2.y), x23 = bfhi(b2.y);
            uint2 o1, o2;
            o1.x = cvt_pk_bf16(x10 * cs0[0] - x20 * cs0[1], x11 * cs0[2] - x21 * cs0[3]); o1.y = cvt_pk_bf16(x12 * cs1[0] - x22 * cs1[1], x13 * cs1[2] - x23 * cs1[3]);
            o2.x = cvt_pk_bf16(x20 * cs0[0] + x10 * cs0[1], x21 * cs0[2] + x11 * cs0[3]); o2.y = cvt_pk_bf16(x22 * cs1[0] + x12 * cs1[1], x23 * cs1[2] + x13 * cs1[3]);
            *(uint2*)(p1) = o1; *(uint2*)(p1 + 32) = o2; }
    }
}

struct ScanRaw { uint2 zr_c, zr_p, zk_c, zk_p, zv_c, zv_p, lwu, icu; };
struct ScanConst { f32x4 mur, muk, muv, kk, ka, rk; };
__device__ __forceinline__ void scan_load(ScanRaw& R, const bf16_t* z, const bf16_t* lw, const bf16_t* ic, size_t tokbase, int ch, int ptok, int gc) {
    const int t = ch * 16 + ptok; const size_t T = tokbase + t; const bf16_t* zp = z + T * ZLD + gc;
    R.zr_c = *(const uint2*)(zp + C_R); R.zk_c = *(const uint2*)(zp + C_K); R.zv_c = *(const uint2*)(zp + C_V);
    const uint2 zz = make_uint2(0u, 0u);
    if (t > 0) { R.zr_p = *(const uint2*)(zp - ZLD + C_R); R.zk_p = *(const uint2*)(zp - ZLD + C_K); R.zv_p = *(const uint2*)(zp - ZLD + C_V); } else { R.zr_p = zz; R.zk_p = zz; R.zv_p = zz; }
    R.lwu = *(const uint2*)(lw + T * 512 + gc); R.icu = *(const uint2*)(ic + T * 512 + gc);
}
__device__ __forceinline__ f32x4 unpack4(uint2 u) { f32x4 r; r[0] = bflo(u.x); r[1] = bfhi(u.x); r[2] = bflo(u.y); r[3] = bfhi(u.y); return r; }
__device__ __forceinline__ void scan_prep(const ScanRaw& R, const ScanConst& C, float* ops, float* vv, float* bonus_out, bool wr_bonus, int ptok, int pc, int v0) {
    const f32x4 rc = unpack4(R.zr_c), rp = unpack4(R.zr_p), kc = unpack4(R.zk_c), kp = unpack4(R.zk_p), vc = unpack4(R.zv_c), vp = unpack4(R.zv_p), ic = unpack4(R.icu), lw = unpack4(R.lwu);
    const f32x4 r = rc + (rp - rc) * C.mur, k = kc + (kp - kc) * C.muk, vs = vc + (vp - vc) * C.muv;
    f32x4 w; w[0] = __expf(lw[0]); w[1] = __expf(lw[1]); w[2] = __expf(lw[2]); w[3] = __expf(lw[3]);
    const f32x4 q = k * C.kk; const float ss = red16((q[0] * q[0] + q[1] * q[1]) + (q[2] * q[2] + q[3] * q[3]));
    const float inv = 1.0f / fmaxf(sqrtf(ss), 1e-12f); const f32x4 n = q * inv;
    const f32x4 kn = k * (1.0f + (ic - 1.0f) * C.ka);
    const f32x4 bt = r * kn * C.rk; const float bon = red16((bt[0] + bt[1]) + (bt[2] + bt[3]));
    if (wr_bonus) *bonus_out = bon;
    float* op = ops + ptok * 320 + pc;
    *(f32x4*)(op) = -n; *(f32x4*)(op + 64) = w; *(f32x4*)(op + 128) = n * ic; *(f32x4*)(op + 192) = kn; *(f32x4*)(op + 256) = r;
    if (pc >= v0 && pc < v0 + 32) *(f32x4*)(vv + ptok * 32 + pc - v0) = vs;
}
__device__ void p3_scan(const Frame& F, const int mode) {
    const int tid = F.tid;
    float* opsb = (float*)g_lds;
    float* vvb = opsb + 2 * 5120;
    float* yob = vvb + 2 * 512;
    const bf16_t* z = F.z; const float* mu = F.in[3]; const float* k_k = F.in[9]; const float* k_a = F.in[10]; const float* r_k = F.in[11];
    for (int item = blockIdx.x; item < 256; item += gridDim.x) {
        const int bh = item >> 1, half = item & 1, b = bh >> 3, h = bh & 7, v0 = half * 32;
        const size_t tokbase = (size_t)b * SEQ;
        if (F.wave >= 4) {
            const int pt = tid - 256, ptok = pt >> 4, pc = (pt & 15) * 4, gc = h * 64 + pc;
            ScanConst C; C.mur = *(const f32x4*)(mu + C_R + gc); C.muk = *(const f32x4*)(mu + C_K + gc); C.muv = *(const f32x4*)(mu + C_V + gc);
            C.kk = *(const f32x4*)(k_k + gc); C.ka = *(const f32x4*)(k_a + gc); C.rk = *(const f32x4*)(r_k + gc);
            const bool wrb = (half == 0) && ((pt & 15) == 0);
            ScanRaw R;
            scan_load(R, z, F.lw, F.ic, tokbase, 0, ptok, gc);
            scan_prep(R, C, opsb, vvb, F.bonus + (tokbase + ptok) * 8 + h, wrb, ptok, pc, v0);
            scan_load(R, z, F.lw, F.ic, tokbase, 1, ptok, gc);
            lds_barrier();
            for (int ch = 0; ch < SEQ / 16; ++ch) {
                const int cur = ch & 1, nxt = cur ^ 1;
                if (mode != 2) {
                if (ch > 0) { const int tok = pt >> 4, r2 = (pt & 15) * 2;
                    *(float2*)(F.yraw + (tokbase + (ch - 1) * 16 + tok) * 512 + h * 64 + v0 + r2) = *(const float2*)(yob + nxt * 512 + tok * 32 + r2); }
                if (ch + 1 < SEQ / 16) {
                    scan_prep(R, C, opsb + nxt * 5120, vvb + nxt * 512, F.bonus + (tokbase + (ch + 1) * 16 + ptok) * 8 + h, wrb, ptok, pc, v0);
                    if (ch + 2 < SEQ / 16) scan_load(R, z, F.lw, F.ic, tokbase, ch + 2, ptok, gc);
                } }
                lds_barrier();
            }
            { const int tok = pt >> 4, r2 = (pt & 15) * 2;
              *(float2*)(F.yraw + (tokbase + (SEQ / 16 - 1) * 16 + tok) * 512 + h * 64 + v0 + r2) = *(const float2*)(yob + 512 + tok * 32 + r2); }
        } else {
            const int rp = tid >> 4, ks = tid & 15;
            float A0 = 0.f, A1 = 0.f, A2 = 0.f, A3 = 0.f, B0 = 0.f, B1 = 0.f, B2 = 0.f, B3 = 0.f;
            const int ywoff = (ks == 0) ? 2 * rp : (2 * 512 + 2 * tid), ywstep = (ks == 0) ? 32 : 0;
            lds_barrier();
            f32x4 rprev = {0.f, 0.f, 0.f, 0.f}; float* ywp = yob + 2 * 512 + 2 * tid;
            for (int ch = 0; ch < SEQ / 16; ++ch) {
                const int cur = ch & 1;
                const float* ops = opsb + cur * 5120 + ks * 4; const float* vv = vvb + cur * 512 + 2 * rp; float* yw = yob + cur * 512 + ywoff;
                if (mode != 1) {
#pragma unroll
                for (int s = 0; s < 16; ++s) {
                    const float* o = ops + s * 320;
                    const f32x4 a4 = *(const f32x4*)(o), w4 = *(const f32x4*)(o + 64), b4 = *(const f32x4*)(o + 128), k4 = *(const f32x4*)(o + 192), r4 = *(const f32x4*)(o + 256);
                    const float2 vab = *(const float2*)(vv + s * 32);
                    float sa = (A0 * a4[0] + A1 * a4[1]) + (A2 * a4[2] + A3 * a4[3]); float sb = (B0 * a4[0] + B1 * a4[1]) + (B2 * a4[2] + B3 * a4[3]);
                    float ya = (A0 * rprev[0] + A1 * rprev[1]) + (A2 * rprev[2] + A3 * rprev[3]); float yb2 = (B0 * rprev[0] + B1 * rprev[1]) + (B2 * rprev[2] + B3 * rprev[3]);
                    red16x4(sa, sb, ya, yb2);
                    *(float2*)(ywp) = make_float2(ya, yb2);
                    ywp = yw + s * ywstep;
                    A0 = A0 * w4[0] + sa * b4[0] + vab.x * k4[0]; A1 = A1 * w4[1] + sa * b4[1] + vab.x * k4[1];
                    A2 = A2 * w4[2] + sa * b4[2] + vab.x * k4[2]; A3 = A3 * w4[3] + sa * b4[3] + vab.x * k4[3];
                    B0 = B0 * w4[0] + sb * b4[0] + vab.y * k4[0]; B1 = B1 * w4[1] + sb * b4[1] + vab.y * k4[1];
                    B2 = B2 * w4[2] + sb * b4[2] + vab.y * k4[2]; B3 = B3 * w4[3] + sb * b4[3] + vab.y * k4[3];
                    rprev = r4;
                }
                {
                    float ya = (A0 * rprev[0] + A1 * rprev[1]) + (A2 * rprev[2] + A3 * rprev[3]); float yb2 = (B0 * rprev[0] + B1 * rprev[1]) + (B2 * rprev[2] + B3 * rprev[3]);
                    float d0 = 0.f, d1 = 0.f; red16x4(ya, yb2, d0, d1);
                    *(float2*)(ywp) = make_float2(ya, yb2); ywp = yob + 2 * 512 + 2 * tid; rprev = (f32x4){0.f, 0.f, 0.f, 0.f};
                } }
                lds_barrier();
            }
        }
        __syncthreads();
    }
}

__device__ __forceinline__ unsigned ordkey(float f) { const unsigned u = __float_as_uint(f); return (u & 0x80000000u) ? ~u : (u | 0x80000000u); }

__device__ __forceinline__ void attn_chunk(const unsigned char* kb, const unsigned char* vb, const unsigned* selm, int c, int fr, int fq, const bf16x8 (&Bqa)[2], f32x4 (&O)[4], float& rs) {
    const f32x4 zero4 = {0.f, 0.f, 0.f, 0.f};
#pragma unroll
    for (int p = 0; p < 2; ++p) {
        const unsigned char* k0p = kb + ((2 * p) * 16 + fr) * 144 + fq * 16; const unsigned char* k1p = k0p + 16 * 144;
        const bf16x8 KA00 = *(const bf16x8*)(k0p), KA01 = *(const bf16x8*)(k0p + 64), KA10 = *(const bf16x8*)(k1p), KA11 = *(const bf16x8*)(k1p + 64);
        const unsigned mw = selm[fr * 64 + 2 * c + p]; const unsigned m0 = (mw >> (fq * 4)) & 0xFu, m1 = (mw >> (16 + fq * 4)) & 0xFu;
        f32x4 s0 = __builtin_amdgcn_mfma_f32_16x16x32_bf16(KA00, Bqa[0], zero4, 0, 0, 0); s0 = __builtin_amdgcn_mfma_f32_16x16x32_bf16(KA01, Bqa[1], s0, 0, 0, 0);
        f32x4 s1 = __builtin_amdgcn_mfma_f32_16x16x32_bf16(KA10, Bqa[0], zero4, 0, 0, 0); s1 = __builtin_amdgcn_mfma_f32_16x16x32_bf16(KA11, Bqa[1], s1, 0, 0, 0);
        float p0[4], p1[4];
#pragma unroll
        for (int jj = 0; jj < 4; ++jj) { p0[jj] = ((m0 >> jj) & 1u) ? __expf(fminf(s0[jj] * 0.125f, 60.f)) : 0.f; p1[jj] = ((m1 >> jj) & 1u) ? __expf(fminf(s1[jj] * 0.125f, 60.f)) : 0.f; }
        rs += (p0[0] + p0[1]) + (p0[2] + p0[3]) + (p1[0] + p1[1]) + (p1[2] + p1[3]);
        u32x4 pk; pk.x = cvt_pk_bf16(p0[0], p0[1]); pk.y = cvt_pk_bf16(p0[2], p0[3]); pk.z = cvt_pk_bf16(p1[0], p1[1]); pk.w = cvt_pk_bf16(p1[2], p1[3]);
        const bf16x8 PB = __builtin_bit_cast(bf16x8, pk);
#pragma unroll
        for (int dt = 0; dt < 4; ++dt) { const unsigned char* vp = vb + (dt * 16 + fr) * 144 + (2 * p) * 32 + fq * 8;
            const uint2 lo = *(const uint2*)(vp), hi = *(const uint2*)(vp + 32);
            u32x4 va; va.x = lo.x; va.y = lo.y; va.z = hi.x; va.w = hi.y;
            O[dt] = __builtin_amdgcn_mfma_f32_16x16x32_bf16(__builtin_bit_cast(bf16x8, va), PB, O[dt], 0, 0, 0); }
    }
}
__device__ void p3_dsa(const Frame& F) {
    const int tid = F.tid, lane = F.lane, wave = F.wave, fr = lane & 15, fq = lane >> 4;
    unsigned* selm = (unsigned*)g_lds;
    unsigned* eqm = selm + 1024;
    int* cnt = (int*)(eqm + 1024);
    int* eqpre = cnt + 256;
    unsigned char* kbuf = (unsigned char*)(eqpre + 1024);
    unsigned char* vbuf = kbuf + 2 * 9216;
    const bf16_t* z = F.z; const int G = gridDim.x, bx = blockIdx.x;
    const f32x4 zero4 = {0.f, 0.f, 0.f, 0.f};
    for (int rnd = 0; rnd * G < 2048; ++rnd) {
        const int n = rnd * G + ((rnd & 1) ? (G - 1 - bx) : bx);
        if (n >= 2048) continue;
        const int qg = 127 - (n >> 4), b = n & 15, q0 = qg * 16; const size_t Tb = (size_t)b * SEQ;
        for (int i = tid; i < 2048; i += NTHR) selm[i] = 0u;
        __syncthreads();
        const bf16_t* zq = z + (Tb + q0 + fr) * ZLD;
        const unsigned lofk = (unsigned)((fr * ZLD + fq * 8) * 2), lofv = (unsigned)((fr * SEQ + fq * 4) * 2);
        if (qg >= 16) {
            float sacc[16][4];
#pragma unroll
            for (int i = 0; i < 16; ++i)
#pragma unroll
                for (int jj = 0; jj < 4; ++jj) sacc[i][jj] = 0.f;
            const u32x4 wv = *(const u32x4*)(zq + C_WI);
            {
                bf16x8 Bq[8][2];
#pragma unroll
                for (int hh = 0; hh < 8; ++hh)
#pragma unroll
                    for (int ks = 0; ks < 2; ++ks) Bq[hh][ks] = *(const bf16x8*)(zq + C_QI + hh * 64 + ks * 32 + fq * 8);
                const float sc = 0.044194173824159216f;
                float wih[8]; wih[0] = bflo(wv.x) * sc; wih[1] = bfhi(wv.x) * sc; wih[2] = bflo(wv.y) * sc; wih[3] = bfhi(wv.y) * sc; wih[4] = bflo(wv.z) * sc; wih[5] = bfhi(wv.z) * sc; wih[6] = bflo(wv.w) * sc; wih[7] = bfhi(wv.w) * sc;
                bf16x8 W0[2], W1[2];
#pragma unroll
                for (int j = 0; j < 2; ++j) { const int ktj = (wave + 8 * j) < qg ? (wave + 8 * j) : qg; const char* kb = (const char*)(z + (Tb + (size_t)ktj * 16) * ZLD + C_KI);
                    W0[j] = *(const bf16x8*)(kb + lofk); W1[j] = *(const bf16x8*)(kb + lofk + 64); }
#pragma unroll
                for (int i = 0; i < 16; ++i) { const int kt = wave + 8 * i;
                    if (kt <= qg) {
#pragma unroll
                        for (int hh = 0; hh < 8; ++hh) { f32x4 acc = __builtin_amdgcn_mfma_f32_16x16x32_bf16(W0[i & 1], Bq[hh][0], zero4, 0, 0, 0);
                            acc = __builtin_amdgcn_mfma_f32_16x16x32_bf16(W1[i & 1], Bq[hh][1], acc, 0, 0, 0);
#pragma unroll
                            for (int jj = 0; jj < 4; ++jj) sacc[i][jj] += wih[hh] * fmaxf(acc[jj], 0.f); }
                    }
                    if (i + 2 < 16) { const int ktn = (kt + 16) < qg ? (kt + 16) : qg; const char* kb = (const char*)(z + (Tb + (size_t)ktn * 16) * ZLD + C_KI);
                        unsigned lo2 = lofk; asm volatile("" : "+v"(lo2));
                        W0[i & 1] = *(const bf16x8*)(kb + lo2); W1[i & 1] = *(const bf16x8*)(kb + lo2 + 64); }
                }
            }
            unsigned uk[16][4];
#pragma unroll
            for (int i = 0; i < 16; ++i) { const int kt = wave + 8 * i;
#pragma unroll
                for (int jj = 0; jj < 4; ++jj) { const bool masked = (kt > qg) || ((kt == qg) && (fq * 4 + jj > fr)); uk[i][jj] = masked ? 0x007fffffu : ordkey(sacc[i][jj]); } }
            unsigned T = 0u; bool found = false;
#pragma unroll 1
            for (int brep = 0; brep < 1 + REP(12); ++brep) { T = 0u; found = false; __syncthreads();
            for (int bit = 31; bit >= 0; --bit) {
                const unsigned cand = T | (1u << bit); int c = 0;
#pragma unroll
                for (int i = 0; i < 16; ++i) {
#pragma unroll
                    for (int jj = 0; jj < 4; ++jj) c += (uk[i][jj] >= cand) ? 1 : 0;
                    __builtin_amdgcn_sched_barrier(0); }
                c += __shfl_xor(c, 16); c += __shfl_xor(c, 32);
                const int par = bit & 1;
                if (fq == 0) cnt[(par * 8 + wave) * 16 + fr] = c;
                __syncthreads();
                int tot = 0;
#pragma unroll
                for (int w = 0; w < 8; ++w) tot += cnt[(par * 8 + w) * 16 + fr];
                if (!found && tot >= 256) { T = cand; if (tot == 256) found = true; }
                if (__all(found)) break;
            } }
            int need;
            { int c = 0; unsigned Tp = T + 1u; asm volatile("" : "+v"(Tp));
#pragma unroll
              for (int i = 0; i < 16; ++i) {
#pragma unroll
                  for (int jj = 0; jj < 4; ++jj) c += (uk[i][jj] >= Tp) ? 1 : 0;
                  __builtin_amdgcn_sched_barrier(0); }
              c += __shfl_xor(c, 16); c += __shfl_xor(c, 32);
              __syncthreads();
              if (fq == 0) cnt[wave * 16 + fr] = c;
              __syncthreads();
              int tot = 0;
#pragma unroll
              for (int w = 0; w < 8; ++w) tot += cnt[w * 16 + fr];
              need = 256 - tot; }
#pragma unroll
            for (int i = 0; i < 16; ++i) { const int kt = wave + 8 * i; unsigned nib = 0u;
#pragma unroll
                for (int jj = 0; jj < 4; ++jj) nib |= (uk[i][jj] == T) ? (1u << jj) : 0u;
                if (nib) atomicOr(&eqm[fr * 64 + (kt >> 1)], nib << ((kt & 1) * 16 + fq * 4));
                __builtin_amdgcn_sched_barrier(0); }
            __syncthreads();
            unsigned T2 = T; asm volatile("" : "+v"(T2));
            for (int w = tid; w < 1024; w += NTHR) { const int word = w & 63; int sct = 0; for (int j = 0; j < word; ++j) sct += __popc(eqm[w - word + j]); eqpre[w] = sct; }
            __syncthreads();
#pragma unroll
            for (int i = 0; i < 16; ++i) { const int kt = wave + 8 * i; unsigned nib = 0u;
                const int word = kt >> 1, bp0 = (kt & 1) * 16 + fq * 4; const unsigned eqw = eqm[fr * 64 + word]; const int rbase = eqpre[fr * 64 + word];
#pragma unroll
                for (int jj = 0; jj < 4; ++jj) { const int rank = rbase + __popc(eqw & ((1u << (bp0 + jj)) - 1u));
                    const bool sel = (uk[i][jj] > T2) || ((uk[i][jj] == T2) && (rank < need));
                    nib |= sel ? (1u << jj) : 0u; }
                if (nib) atomicOr(&selm[fr * 64 + word], nib << bp0);
                __builtin_amdgcn_sched_barrier(0); }
        } else {
            for (int w = tid; w < 1024; w += NTHR) { const int q = w >> 6, word = w & 63, qpos = q0 + q, lo = word * 32;
                selm[w] = (qpos >= lo + 31) ? 0xffffffffu : (qpos < lo ? 0u : ((2u << (qpos - lo)) - 1u)); }
        }
        __syncthreads();
#pragma unroll 1
        for (int arep = 0; arep < 1 + REP(13); ++arep) {
            const int nchunk = (qg + 4) >> 2; const int lrow = tid >> 3, lseg = tid & 7;
            const bf16_t* kg = z + (Tb + lrow) * ZLD + C_KA + lseg * 8; const bf16_t* vg = F.vt + ((size_t)b * 64 + lrow) * SEQ + lseg * 8;
            const unsigned lst = (unsigned)(lrow * 144 + lseg * 16);
            u32x4 kx = *(const u32x4*)(kg), vx = *(const u32x4*)(vg), ky = kx, vy = vx;
            *(u32x4*)(kbuf + lst) = kx; *(u32x4*)(vbuf + lst) = vx;
            if (1 < nchunk) { kx = *(const u32x4*)(kg + (size_t)64 * ZLD); vx = *(const u32x4*)(vg + 64); }
            if (2 < nchunk) { ky = *(const u32x4*)(kg + (size_t)128 * ZLD); vy = *(const u32x4*)(vg + 128); }
            bf16x8 Bqa[2];
#pragma unroll
            for (int ks = 0; ks < 2; ++ks) Bqa[ks] = *(const bf16x8*)(zq + C_Q + wave * 64 + ks * 32 + fq * 8);
            f32x4 O[4]; float rs = 0.f;
#pragma unroll
            for (int dt = 0; dt < 4; ++dt) O[dt] = zero4;
            lds_barrier();
#pragma unroll 1
            for (int c = 0; c < nchunk; c += 2) {
                attn_chunk(kbuf, vbuf, selm, c, fr, fq, Bqa, O, rs);
                if (c + 1 < nchunk) { *(u32x4*)(kbuf + 9216 + lst) = kx; *(u32x4*)(vbuf + 9216 + lst) = vx; }
                if (c + 3 < nchunk) { kx = *(const u32x4*)(kg + (size_t)(c + 3) * 64 * ZLD); vx = *(const u32x4*)(vg + (c + 3) * 64); }
                lds_barrier();
                if (c + 1 < nchunk) {
                    attn_chunk(kbuf + 9216, vbuf + 9216, selm, c + 1, fr, fq, Bqa, O, rs);
                    if (c + 2 < nchunk) { *(u32x4*)(kbuf + lst) = ky; *(u32x4*)(vbuf + lst) = vy; }
                    if (c + 4 < nchunk) { ky = *(const u32x4*)(kg + (size_t)(c + 4) * 64 * ZLD); vy = *(const u32x4*)(vg + (c + 4) * 64); }
                    lds_barrier();
                }
            }
            rs += __shfl_xor(rs, 16); rs += __shfl_xor(rs, 32);
            const float inv = 1.0f / rs;
            bf16_t* yp = F.yb + (Tb + q0 + fr) * 512 + wave * 64 + fq * 4;
#pragma unroll
            for (int dt = 0; dt < 4; ++dt) { uint2 w; w.x = cvt_pk_bf16(O[dt][0] * inv, O[dt][1] * inv); w.y = cvt_pk_bf16(O[dt][2] * inv, O[dt][3] * inv); *(uint2*)(yp + dt * 16) = w; }
        }
        __syncthreads();
    }
}

__device__ void p4_post(const Frame& F) {
    const int tid = F.tid; const float* mu = F.in[3]; const float* gnw = F.in[12]; const float* gnb = F.in[13]; const bf16_t* z = F.z;
    for (int g = blockIdx.x * 16 + (tid >> 5); g < NTOK * 8; g += gridDim.x * 16) { const size_t t = (size_t)(g >> 3); const int h = g & 7, c = h * 64 + (tid & 31) * 2;
        const float2 y = *(const float2*)(F.yraw + t * 512 + c);
        const float mean = red32(y.x + y.y) * (1.0f / 64.0f); const float dx = y.x - mean, dy = y.y - mean;
        const float var = red32(dx * dx + dy * dy) * (1.0f / 64.0f); const float rstd = rsqrtf(var + 64e-5f);
        const unsigned vc = *(const unsigned*)(z + t * ZLD + C_V + c); const unsigned vp = (t & (SEQ - 1)) ? *(const unsigned*)(z + (t - 1) * ZLD + C_V + c) : 0u;
        const float vs0 = bflo(vc) + (bflo(vp) - bflo(vc)) * mu[C_V + c], vs1 = bfhi(vc) + (bfhi(vp) - bfhi(vc)) * mu[C_V + c + 1];
        const float bon = F.bonus[t * 8 + h]; const unsigned gt = *(const unsigned*)(F.gt + t * 512 + c);
        const float o0 = (dx * rstd * gnw[c] + gnb[c] + bon * vs0) * bflo(gt), o1 = (dy * rstd * gnw[c + 1] + gnb[c + 1] + bon * vs1) * bfhi(gt);
        *(unsigned*)(F.ya + t * 512 + c) = cvt_pk_bf16(o0, o1); }
}

__device__ void p9_final(const Frame& F) {
    const float* g = F.in[19]; const int lane = F.lane;
    for (int row = blockIdx.x * 8 + F.wave; row < NTOK; row += gridDim.x * 8) {
        float* xr = F.out + (size_t)row * DM; const float sc = rsqrtf(F.ss2[row] * (1.0f / 1024.0f) + 1e-6f);
#pragma unroll
        for (int i = 0; i < 4; ++i) { f32x4 v = *(const f32x4*)(xr + i * 256 + lane * 4); const f32x4 gg = *(const f32x4*)(g + i * 256 + lane * 4);
            v[0] *= sc * gg[0]; v[1] *= sc * gg[1]; v[2] *= sc * gg[2]; v[3] *= sc * gg[3]; *(f32x4*)(xr + i * 256 + lane * 4) = v; }
    }
}
#ifndef PHASE_MASK
#define PHASE_MASK 0x3ff
#endif
constexpr int NPHASE = 10;
template <class Epi> __device__ __forceinline__ void run_gemm(const bf16_t* A, const bf16_t* Bt, int N, int K, const Epi& E) {
    pg8::Gemm g{A, Bt, NTOK, N, K}; pg8::StaticOrder S; S.init(NTOK, N, (int)gridDim.x, (int)blockIdx.x);
    pg8::gemm_phase<Epi, pg8::StaticOrder, false>((PG8_LAS unsigned char*)g_lds, g, S, E, nullptr);
}
__global__ void __launch_bounds__(NTHR, 2) mega_fwd(Args args) {
    Frame F;
#pragma unroll
    for (int i = 0; i < 20; ++i) F.in[i] = args.in[i];
    F.out = args.out; F.ws = args.ws; F.lds = nullptr; F.tid = threadIdx.x; F.lane = F.tid & 63; F.wave = __builtin_amdgcn_readfirstlane(F.tid >> 6);
    unsigned char* ws = args.ws;
    F.ss1 = (float*)(ws + WS_SS1); F.ss2 = (float*)(ws + WS_SS2); F.bonus = (float*)(ws + WS_BONUS); F.rope = (float2*)(ws + WS_ROPE);
    F.wd = (bf16_t*)(ws + WS_WD); F.wi = (bf16_t*)(ws + WS_WI); F.wg = (bf16_t*)(ws + WS_WG);
    F.win = (bf16_t*)(ws + WS_WIN); F.wup = (bf16_t*)(ws + WS_WUP); F.wdn = (bf16_t*)(ws + WS_WDN); F.wb = (bf16_t*)(ws + WS_WB); F.wo = (bf16_t*)(ws + WS_WO); F.vt = (bf16_t*)(ws + WS_VT);
    F.h = (bf16_t*)(ws + WS_H); F.ya = F.h; F.yb = F.h + (size_t)NTOK * 512; F.xb = F.h;
    F.z = (bf16_t*)(ws + WS_Z); F.hid = F.z;
    F.lw = (bf16_t*)(ws + WS_P); F.ic = F.lw + (size_t)NTOK * 512; F.mg = F.lw;
    F.yraw = args.out; F.gt = (bf16_t*)(args.out + (size_t)NTOK * 512);
    const int lo = args.ph_lo, hi = args.ph_hi;
    cg::grid_group grid = cg::this_grid();
#define IN(k) (lo <= (k) && (k) < hi)
#define SEAM(k) do { if (IN(k) && IN((k) + 1)) grid.sync(); } while (0)
    if (((PHASE_MASK >> 0) & 1) && IN(0)) { p0_prologue(F); __syncthreads(); if (REP(0)) { p0_prologue(F); __syncthreads(); } } SEAM(0);
    if (((PHASE_MASK >> 1) & 1) && IN(1)) { pg8::EpiZ E{F.z, ZLD}; run_gemm(F.h, F.win, 5120, 1024, E); __syncthreads(); if (REP(1)) { run_gemm(F.h, F.win, 5120, 1024, E); __syncthreads(); } } SEAM(1);
    if (((PHASE_MASK >> 2) & 1) && IN(2)) { if (REP(2)) { p2_prep(F, false); __syncthreads(); } p2_prep(F, true); __syncthreads(); } SEAM(2);
    if (((PHASE_MASK >> 3) & 1) && IN(3)) { if (REP(14)) { p3_scan(F, 1); __syncthreads(); } if (REP(15)) { p3_scan(F, 2); __syncthreads(); } if (REP(3)) { p3_scan(F, 0); __syncthreads(); } p3_scan(F, 0); __syncthreads(); p3_dsa(F); __syncthreads(); if (REP(10)) { p3_dsa(F); __syncthreads(); } } SEAM(3);
    if (((PHASE_MASK >> 4) & 1) && IN(4)) { p4_post(F); __syncthreads(); if (REP(4)) { p4_post(F); __syncthreads(); } } SEAM(4);
    if (((PHASE_MASK >> 5) & 1) && IN(5)) { pg8::EpiGate<0> E0{F.mg, F.z, ZLD, C_G0}; run_gemm(F.ya, F.wb, 1024, 512, E0); __syncthreads();
                 pg8::EpiGate<1> E1{F.mg, F.z, ZLD, C_G1}; run_gemm(F.yb, F.wb + 1024 * 512, 1024, 512, E1); __syncthreads(); } SEAM(5);
    if (((PHASE_MASK >> 6) & 1) && IN(6)) { pg8::EpiRes<true> E{F.in[0], F.out, F.xb, F.ss1}; run_gemm(F.mg, F.wo, 1024, 1024, E); __syncthreads(); } SEAM(6);
    if (((PHASE_MASK >> 7) & 1) && IN(7)) { pg8::EpiHid E{F.hid, F.ss1}; run_gemm(F.xb, F.wup, 4096, 1024, E); __syncthreads(); if (REP(7)) { run_gemm(F.xb, F.wup, 4096, 1024, E); __syncthreads(); } } SEAM(7);
    if (((PHASE_MASK >> 8) & 1) && IN(8)) { pg8::EpiRes<false> E{F.out, F.out, nullptr, F.ss2}; run_gemm(F.hid, F.wdn, 1024, 4096, E); __syncthreads(); } SEAM(8);
    if (((PHASE_MASK >> 9) & 1) && IN(9)) { p9_final(F); }
#undef IN
#undef SEAM
}

extern "C" void kernel_launch(void* const* d_in, const int* in_sizes, int n_in, void* d_out, int out_size, void* d_ws, size_t ws_size, hipStream_t stream) {
    static int grid = 0;
    if (grid == 0) {
        if (n_in != 20 || out_size != NTOK * DM || ws_size < WS_END) { fprintf(stderr, "kernel_launch: unexpected shapes (n_in %d, out %d, ws %zu < %zu)\n", n_in, out_size, ws_size, (size_t)WS_END); grid = -1; return; }
        int dev = 0, cus = 0, per_cu = 0;
        hipGetDevice(&dev); hipDeviceGetAttribute(&cus, hipDeviceAttributeMultiprocessorCount, dev);
        if (hipFuncSetAttribute((const void*)mega_fwd, hipFuncAttributeMaxDynamicSharedMemorySize, LDS_BYTES) != hipSuccess) { fprintf(stderr, "kernel_launch: hipFuncSetAttribute failed\n"); grid = -1; return; }
        if (hipOccupancyMaxActiveBlocksPerMultiprocessor(&per_cu, (const void*)mega_fwd, NTHR, LDS_BYTES) != hipSuccess || per_cu < 1) { fprintf(stderr, "kernel_launch: occupancy query failed (%d)\n", per_cu); per_cu = 1; }
        (void)hipGetLastError();
        grid = cus * per_cu;
        fprintf(stderr, "kernel_launch: grid %d (%d CUs x %d)\n", grid, cus, per_cu);
    }
    if (grid < 0) return;
    Args a{};
    for (int i = 0; i < 20; ++i) a.in[i] = (const float*)d_in[i];
    a.out = (float*)d_out; a.ws = (unsigned char*)d_ws;
#if MK_PER_PHASE_LAUNCH
    for (int p = 0; p < NPHASE; ++p) { a.ph_lo = p; a.ph_hi = p + 1; hipLaunchKernelGGL(mega_fwd, dim3(grid), dim3(NTHR), LDS_BYTES, stream, a); }
#else
    a.ph_lo = 0; a.ph_hi = NPHASE;
    void* kargs[] = {&a};
    hipError_t e = hipLaunchCooperativeKernel((const void*)mega_fwd, dim3(grid), dim3(NTHR), kargs, LDS_BYTES, stream);
    if (e != hipSuccess) fprintf(stderr, "kernel_launch: cooperative launch failed: %s (grid %d)\n", hipGetErrorString(e), grid);
#endif
}
```

```cpp
#include <hip/hip_runtime.h>
#include <hip/hip_cooperative_groups.h>
#include <cstdio>
#include <cstdint>
namespace cg = cooperative_groups;

#ifndef MK_PER_PHASE_LAUNCH
#define MK_PER_PHASE_LAUNCH 0
#endif

#ifndef REPEAT_MASK
#define REPEAT_MASK 0
#endif
#define REP(k) ((REPEAT_MASK >> (k)) & 1)
#ifndef TS_SEL
#define TS_SEL -1
#endif

namespace pg8 {
#define PG8_LAS __attribute__((address_space(3)))
typedef unsigned short bf16_t;
typedef short bf16x8 __attribute__((ext_vector_type(8)));
typedef float f32x4 __attribute__((ext_vector_type(4)));
typedef unsigned u32x4 __attribute__((ext_vector_type(4)));
constexpr int BM = 256, BK = 64, HALF = 128, HTB = HALF * BK * 2  , STAGE_BYTES = 8 * HTB, NXCD = 8, WGM = 8;

__host__ __device__ __forceinline__ int lds_byte(int r, int c) { const int st = (r >> 4) * 2 + (c >> 5), rr = r & 15, cc = c & 31, ob = rr * 64 + cc * 2; return st * 1024 + (ob ^ (((ob >> 9) & 1) << 5)); }
__host__ __device__ __forceinline__ void stage_rc(int b, int& R, int& C) { const int st = b / 1024, sb = b % 1024, swz = sb ^ (((sb >> 9) & 1) << 5); R = (st >> 1) * 16 + swz / 64; C = (st & 1) * 32 + (swz % 64) / 2; }
__host__ __device__ __forceinline__ int perm32(int rho) { const int n = rho >> 4, i = rho & 15; return 8 * (i >> 2) + 4 * n + (i & 3); }

struct Unit { int pm, pn; };
struct Gemm { const bf16_t* A; const bf16_t* Bt; int M, N, K; };

struct StaticOrder {
    int nM, nN, nwg, G, c;
    __host__ __device__ void init(int M, int N, int G_, int c_) { nM = M / BM; nN = N / BM; nwg = nM * nN; G = G_; c = c_; }
    __host__ __device__ bool next(int i, Unit& u) const {
        const long L = (long)i * G + c; if (L >= nwg) return false;
        int wgid = (int)L; { const int q = nwg / NXCD, r = nwg % NXCD, xcd = wgid % NXCD, off = wgid / NXCD; wgid = (xcd < r ? xcd * (q + 1) : r * (q + 1) + (xcd - r) * q) + off; }
        const int nig = WGM * nN, gid = wgid / nig, fm = gid * WGM, gsz = (nM - fm) < WGM ? (nM - fm) : WGM;
        u.pm = fm + ((wgid % nig) % gsz); u.pn = (wgid % nig) / gsz; return true;
    }
    __device__ __forceinline__ void a_ready(const Unit&) const {}
    __device__ __forceinline__ void done(const Unit&) const {}
};
__device__ __forceinline__ unsigned cvt_pk_bf16(float lo, float hi) { unsigned r; asm volatile("v_cvt_pk_bf16_f32 %0, %1, %2" : "=v"(r) : "v"(lo), "v"(hi)); return r; }
typedef float f32x2 __attribute__((ext_vector_type(2)));
__device__ __forceinline__ float bflo(unsigned u) { return __uint_as_float(u << 16); }
__device__ __forceinline__ float bfhi(unsigned u) { return __uint_as_float(u & 0xffff0000u); }
__device__ __forceinline__ float sigm(float x) { return 1.0f / (1.0f + __expf(-x)); }

struct EpiZ {
    static constexpr bool PERM = true, AFTER_DRAIN = false;
    bf16_t* O; int ldc;
    __device__ __forceinline__ void operator()(const f32x4 (&acc)[2][2][4][2], const Unit& u, int wr, int wc, int fr, int fq) const {
        const int row0 = u.pm * BM + wr * 64 + fr, col0 = u.pn * BM + wc * 32 + 8 * fq;
#pragma unroll
        for (int ai = 0; ai < 2; ++ai)
#pragma unroll
            for (int m = 0; m < 4; ++m) { bf16_t* rowp = O + (size_t)(row0 + ai * HALF + m * 16) * ldc + col0;
#pragma unroll
                for (int bj = 0; bj < 2; ++bj) { const f32x4 v0 = acc[ai][bj][m][0], v1 = acc[ai][bj][m][1];
                    u32x4 w; w.x = cvt_pk_bf16(v0[0], v0[1]); w.y = cvt_pk_bf16(v0[2], v0[3]); w.z = cvt_pk_bf16(v1[0], v1[1]); w.w = cvt_pk_bf16(v1[2], v1[3]);
                    *(u32x4*)(rowp + bj * HALF) = w; } }
    }
};
template <int MODE> struct EpiGate {
    static constexpr bool PERM = true, AFTER_DRAIN = false;
    bf16_t* O; const bf16_t* Z; int zld; int gcol;
    __device__ __forceinline__ void operator()(const f32x4 (&acc)[2][2][4][2], const Unit& u, int wr, int wc, int fr, int fq) const {
        const int row0 = u.pm * BM + wr * 64 + fr, col0 = u.pn * BM + wc * 32 + 8 * fq;
#pragma unroll
        for (int ai = 0; ai < 2; ++ai)
#pragma unroll
            for (int m = 0; m < 4; ++m) { const size_t row = (size_t)(row0 + ai * HALF + m * 16);
                bf16_t* op = O + row * 1024 + col0; const bf16_t* zp = Z + row * zld + gcol + col0;
#pragma unroll
                for (int bj = 0; bj < 2; ++bj) { const f32x4 v0 = acc[ai][bj][m][0], v1 = acc[ai][bj][m][1];
                    const u32x4 g = *(const u32x4*)(zp + bj * HALF);
                    float r0 = v0[0] * sigm(bflo(g.x)), r1 = v0[1] * sigm(bfhi(g.x)), r2 = v0[2] * sigm(bflo(g.y)), r3 = v0[3] * sigm(bfhi(g.y));
                    float r4 = v1[0] * sigm(bflo(g.z)), r5 = v1[1] * sigm(bfhi(g.z)), r6 = v1[2] * sigm(bflo(g.w)), r7 = v1[3] * sigm(bfhi(g.w));
                    if (MODE == 1) { const u32x4 p = *(const u32x4*)(op + bj * HALF);
                        r0 += bflo(p.x); r1 += bfhi(p.x); r2 += bflo(p.y); r3 += bfhi(p.y); r4 += bflo(p.z); r5 += bfhi(p.z); r6 += bflo(p.w); r7 += bfhi(p.w); }
                    u32x4 w; w.x = cvt_pk_bf16(r0, r1); w.y = cvt_pk_bf16(r2, r3); w.z = cvt_pk_bf16(r4, r5); w.w = cvt_pk_bf16(r6, r7);
                    *(u32x4*)(op + bj * HALF) = w; } }
    }
};
template <bool WITH_XB> struct EpiRes {
    static constexpr bool PERM = false, AFTER_DRAIN = false;
    const float* X; float* O; bf16_t* XB; float* SS;
    __device__ __forceinline__ void operator()(const f32x4 (&acc)[2][2][4][2], const Unit& u, int wr, int wc, int fr, int fq) const {
        const int row0 = u.pm * BM + wr * 64 + fr, col0 = u.pn * BM + wc * 32 + 4 * fq;
#pragma unroll
        for (int ai = 0; ai < 2; ++ai)
#pragma unroll
            for (int m = 0; m < 4; ++m) { const size_t row = (size_t)(row0 + ai * HALF + m * 16); float ssq = 0.f;
#pragma unroll
                for (int bj = 0; bj < 2; ++bj)
#pragma unroll
                    for (int n = 0; n < 2; ++n) { const size_t off = row * 1024 + col0 + bj * HALF + n * 16;
                        const f32x4 xv = *(const f32x4*)(X + off); const f32x4 v = acc[ai][bj][m][n] + xv;
                        *(f32x4*)(O + off) = v; ssq += v[0] * v[0] + v[1] * v[1] + v[2] * v[2] + v[3] * v[3];
                        if (WITH_XB) { uint2 w; w.x = cvt_pk_bf16(v[0], v[1]); w.y = cvt_pk_bf16(v[2], v[3]); *(uint2*)(XB + off) = w; } }
                ssq += __shfl_xor(ssq, 16); ssq += __shfl_xor(ssq, 32);
                if (fq == 0) atomicAdd(SS + row, ssq); }
    }
};
struct EpiHid {
    static constexpr bool PERM = true, AFTER_DRAIN = false;
    bf16_t* O; const float* SS;
    __device__ __forceinline__ void operator()(const f32x4 (&acc)[2][2][4][2], const Unit& u, int wr, int wc, int fr, int fq) const {
        const int row0 = u.pm * BM + wr * 64 + fr, col0 = u.pn * BM + wc * 32 + 8 * fq;
#pragma unroll
        for (int ai = 0; ai < 2; ++ai)
#pragma unroll
            for (int m = 0; m < 4; ++m) { const size_t row = (size_t)(row0 + ai * HALF + m * 16);
                const float s2 = 1.0f / (SS[row] * (1.0f / 1024.0f) + 1e-6f);
                bf16_t* rowp = O + row * 4096 + col0;
#pragma unroll
                for (int bj = 0; bj < 2; ++bj) { f32x4 v0 = acc[ai][bj][m][0], v1 = acc[ai][bj][m][1];
#pragma unroll
                    for (int j = 0; j < 4; ++j) { float a = fmaxf(v0[j], 0.f), b = fmaxf(v1[j], 0.f); v0[j] = a * a * s2; v1[j] = b * b * s2; }
                    u32x4 w; w.x = cvt_pk_bf16(v0[0], v0[1]); w.y = cvt_pk_bf16(v0[2], v0[3]); w.z = cvt_pk_bf16(v1[0], v1[1]); w.w = cvt_pk_bf16(v1[2], v1[3]);
                    *(u32x4*)(rowp + bj * HALF) = w; } }
    }
};

template <class Epi, class Sched, bool STAMP = false>
__device__ __forceinline__ void gemm_phase(PG8_LAS unsigned char* lds, const Gemm g, const Sched& S, const Epi& E, unsigned long long* stamps) {
    const int tid = threadIdx.x, wid = __builtin_amdgcn_readfirstlane(tid >> 6), lane = tid & 63, wr = wid >> 2, wc = wid & 3, fr = lane & 15, fq = lane >> 4;
    const int K = g.K, nt = K / BK;
    int ts_lo = 0, ts_hi = 0, nts = 0; const unsigned long long rt_entry = STAMP ? (unsigned long long)wall_clock64() : 0ull;
#define PG8_STAMP() do { if (STAMP && wid == 0 && nts < 64) { const unsigned long long _c = (unsigned long long)clock64(); \
        ts_lo = (lane == nts) ? (int)(unsigned)_c : ts_lo; ts_hi = (lane == nts) ? (int)(unsigned)(_c >> 32) : ts_hi; ++nts; } } while (0)
    PG8_STAMP();
    unsigned voffA[2], voffB[2];
#pragma unroll
    for (int i = 0; i < 2; ++i) { int R, C; stage_rc(tid * 16 + i * 8192, R, C); const int Rb = Epi::PERM ? ((R & ~31) + perm32(R & 31)) : R;
        voffA[i] = (unsigned)(R * K + C) * 2u; voffB[i] = (unsigned)(Rb * K + C) * 2u; }
    const size_t kstep = (size_t)(BK * 2);
    const size_t hstep = (size_t)HALF * K * 2;
    const size_t tstep = 2 * hstep;
    const unsigned ldsw = (unsigned)wid * 1024u;
    const int aoff = lds_byte(wr * 64 + fr, fq * 8), boff = lds_byte(wc * 32 + fr, fq * 8);
#define PG8_SA(b, h) (((b) * 2 + (h)) * HTB)
#define PG8_SB(b, h) ((4 + (b) * 2 + (h)) * HTB)
#define PG8_STAGE(bufoff, gbase, voff) do { _Pragma("unroll") for (int _i = 0; _i < 2; ++_i) \
        __builtin_amdgcn_global_load_lds((const unsigned*)((const char*)(gbase) + (voff)[_i]), (PG8_LAS unsigned*)(lds + (bufoff) + ldsw + _i * 8192), 16, 0, 0); } while (0)
#define PG8_LDA(dst, b, h) do { _Pragma("unroll") for (int m = 0; m < 4; ++m) _Pragma("unroll") for (int k = 0; k < 2; ++k) dst[m][k] = *(const PG8_LAS bf16x8*)(lds + PG8_SA(b, h) + aoff + m * 2048 + k * 1024); } while (0)
#define PG8_LDB(dst, b, h) do { _Pragma("unroll") for (int n = 0; n < 2; ++n) _Pragma("unroll") for (int k = 0; k < 2; ++k) dst[n][k] = *(const PG8_LAS bf16x8*)(lds + PG8_SB(b, h) + boff + n * 2048 + k * 1024); } while (0)
#define PG8_MMA(ai, bj, At, Bt) do { __builtin_amdgcn_s_setprio(1); _Pragma("unroll") for (int m = 0; m < 4; ++m) _Pragma("unroll") for (int n = 0; n < 2; ++n) _Pragma("unroll") for (int k = 0; k < 2; ++k) \
        acc[ai][bj][m][n] = __builtin_amdgcn_mfma_f32_16x16x32_bf16(Bt[n][k], At[m][k], acc[ai][bj][m][n], 0, 0, 0); __builtin_amdgcn_s_setprio(0); } while (0)
#define PG8_WAIT_V(n) asm volatile("s_waitcnt vmcnt(" #n ")" ::: "memory")
#define PG8_WAIT_L(n) asm volatile("s_waitcnt lgkmcnt(" #n ")" ::: "memory")
#define PG8_BAR __builtin_amdgcn_s_barrier()
#define PG8_SCHED __builtin_amdgcn_sched_barrier(0)
    Unit cur, nxt; int ui = 0;
    if (!S.next(0, cur)) return;
    f32x4 acc[2][2][4][2];
#pragma unroll
    for (int a = 0; a < 2; ++a)
#pragma unroll
        for (int b = 0; b < 2; ++b)
#pragma unroll
            for (int m = 0; m < 4; ++m)
#pragma unroll
                for (int n = 0; n < 2; ++n) acc[a][b][m][n] = (f32x4){0.f, 0.f, 0.f, 0.f};
    bf16x8 At[4][2], B0[2][2], B1[2][2];
    const char* cA = (const char*)g.A + (size_t)cur.pm * tstep; const char* cB = (const char*)g.Bt + (size_t)cur.pn * tstep;
    S.a_ready(cur);
    PG8_STAGE(PG8_SB(0, 0), cB, voffB); PG8_STAGE(PG8_SA(0, 0), cA, voffA); PG8_STAGE(PG8_SB(0, 1), cB + hstep, voffB); PG8_STAGE(PG8_SA(0, 1), cA + hstep, voffA);
    if (wr == 1) PG8_BAR;
    PG8_WAIT_V(4); PG8_BAR;
    PG8_STAGE(PG8_SB(1, 0), cB + kstep, voffB); PG8_STAGE(PG8_SA(1, 0), cA + kstep, voffA); PG8_STAGE(PG8_SB(1, 1), cB + hstep + kstep, voffB);
    PG8_WAIT_V(6); PG8_BAR;
    PG8_STAMP();
    for (;;) {
        const bool has_next = S.next(ui + 1, nxt);
        const char* nA = has_next ? (const char*)g.A + (size_t)nxt.pm * tstep : cA; const char* nB = has_next ? (const char*)g.Bt + (size_t)nxt.pn * tstep : cB;
        for (int t = 0; t < nt; t += 2) {
            const bool last = (t == nt - 2);
            const char* a1 = cA + (size_t)(t + 1) * kstep;
            const char* a2 = last ? nA : cA + (size_t)(t + 2) * kstep; const char* b2 = last ? nB : cB + (size_t)(t + 2) * kstep;
            const char* a3 = a2 + kstep; const char* b3 = b2 + kstep;
            if (last && has_next) S.a_ready(nxt);
            PG8_LDB(B0, 0, 0); PG8_SCHED; PG8_LDA(At, 0, 0); PG8_STAGE(PG8_SA(1, 1), a1 + hstep, voffA);
            PG8_WAIT_L(8); PG8_BAR; PG8_WAIT_L(0); PG8_MMA(0, 0, At, B0); PG8_BAR; PG8_SCHED;
            PG8_LDB(B1, 0, 1); PG8_STAGE(PG8_SB(0, 0), b2, voffB);
            PG8_BAR; PG8_WAIT_L(0); PG8_MMA(0, 1, At, B1); PG8_BAR;
            PG8_LDA(At, 0, 1); PG8_STAGE(PG8_SA(0, 0), a2, voffA);
            PG8_BAR; PG8_WAIT_L(0); PG8_MMA(1, 0, At, B0); PG8_BAR; PG8_SCHED;
            PG8_STAGE(PG8_SB(0, 1), b2 + hstep, voffB);
            PG8_WAIT_V(6); PG8_BAR; PG8_MMA(1, 1, At, B1); PG8_BAR;
            PG8_LDB(B0, 1, 0); PG8_SCHED; PG8_LDA(At, 1, 0); PG8_STAGE(PG8_SA(0, 1), a2 + hstep, voffA);
            PG8_WAIT_L(8); PG8_BAR; PG8_WAIT_L(0); PG8_MMA(0, 0, At, B0); PG8_BAR; PG8_SCHED;
            PG8_LDB(B1, 1, 1); PG8_STAGE(PG8_SB(1, 0), b3, voffB);
            PG8_BAR; PG8_WAIT_L(0); PG8_MMA(0, 1, At, B1); PG8_BAR;
            PG8_LDA(At, 1, 1); PG8_STAGE(PG8_SA(1, 0), a3, voffA);
            PG8_BAR; PG8_WAIT_L(0); PG8_MMA(1, 0, At, B0); PG8_BAR; PG8_SCHED;
            PG8_STAGE(PG8_SB(1, 1), b3 + hstep, voffB);
            PG8_WAIT_V(6); PG8_BAR; PG8_MMA(1, 1, At, B1); PG8_BAR;
        }
        PG8_STAMP();
        if constexpr (!Epi::AFTER_DRAIN) { E(acc, cur, wr, wc, fr, fq); S.done(cur); }
        PG8_STAMP();
        if (!has_next) break;
#pragma unroll
        for (int a = 0; a < 2; ++a)
#pragma unroll
            for (int b = 0; b < 2; ++b)
#pragma unroll
                for (int m = 0; m < 4; ++m)
#pragma unroll
                    for (int n = 0; n < 2; ++n) acc[a][b][m][n] = (f32x4){0.f, 0.f, 0.f, 0.f};
        cur = nxt; cA = nA; cB = nB; ++ui;
    }
    PG8_WAIT_V(0);
    if (wr == 0) PG8_BAR;
    PG8_BAR;
    if constexpr (Epi::AFTER_DRAIN) { E.fused(acc, cur, wr, wc, fr, fq, lds, wid, lane); S.done(cur); }
    PG8_STAMP();
    if (STAMP && wid == 0) { stamps[lane] = lane < nts ? (((unsigned long long)(unsigned)ts_hi << 32) | (unsigned)ts_lo) : 0ull;
        if (lane == 62) stamps[62] = rt_entry; if (lane == 63) stamps[63] = (unsigned long long)wall_clock64(); }
#undef PG8_STAMP
#undef PG8_SA
#undef PG8_SB
#undef PG8_STAGE
#undef PG8_LDA
#undef PG8_LDB
#undef PG8_MMA
#undef PG8_WAIT_V
#undef PG8_WAIT_L
#undef PG8_BAR
#undef PG8_SCHED
}
}
extern __shared__ __attribute__((aligned(16))) unsigned char g_lds[];
using pg8::bf16_t; using pg8::bf16x8; using pg8::f32x4; using pg8::u32x4; using pg8::cvt_pk_bf16; using pg8::bflo; using pg8::bfhi; using pg8::sigm;

constexpr int NTOK = 32768, DM = 1024, SEQ = 2048, NB = 16, ZLD = 5120, NTHR = 512;
constexpr int C_R = 0, C_K = 512, C_V = 1024, C_WD = 1536, C_AD = 1600, C_GD = 1664;
constexpr int C_Q = 1824, C_KA = 2336, C_VA = 2400, C_QI = 2464, C_KI = 2976, C_WI = 3040, C_G0 = 3048, C_G1 = 4072;
constexpr size_t MiB = 1024 * 1024;
constexpr size_t WS_SS1 = 0, WS_SS2 = 128 * 1024, WS_BONUS = 256 * 1024, WS_ROPE = 1280 * 1024, WS_WD = 1792 * 1024, WS_WI = 1856 * 1024, WS_WG = 1920 * 1024;
constexpr size_t WS_WIN = 4 * MiB, WS_WUP = 14 * MiB, WS_WDN = 22 * MiB, WS_WB = 30 * MiB, WS_WO = 32 * MiB, WS_VT = 34 * MiB, WS_H = 38 * MiB, WS_Z = 102 * MiB, WS_P = 422 * MiB, WS_END = 486 * MiB;
constexpr int LDS_BYTES = 131072 + 64;

struct Args { const float* in[20]; float* out; unsigned char* ws; int ph_lo, ph_hi; };

struct Frame {
    const float* in[20]; float* out; unsigned char* ws; unsigned char* lds; int tid, lane, wave;
    float *ss1, *ss2, *bonus; float2* rope; bf16_t *wd, *wi, *wg, *win, *wup, *wdn, *wb, *wo, *vt, *h, *ya, *yb, *xb, *z, *hid, *lw, *ic, *mg, *gt; float* yraw;
};

__device__ __forceinline__ bf16_t f2bf(float f) { return (bf16_t)(cvt_pk_bf16(f, 0.f) & 0xffffu); }
__device__ __forceinline__ float bf2f(bf16_t b) { return __uint_as_float(((unsigned)b) << 16); }
template <int CTRL> __device__ __forceinline__ float dpp_mov(float x) { return __int_as_float(__builtin_amdgcn_update_dpp(0, __float_as_int(x), CTRL, 0xF, 0xF, true)); }
__device__ __forceinline__ float red16(float x) { x += dpp_mov<0xB1>(x); x += dpp_mov<0x4E>(x); x += dpp_mov<0x141>(x); x += dpp_mov<0x140>(x); return x; }


__device__ __forceinline__ void lds_barrier() { asm volatile("s_waitcnt lgkmcnt(0)" ::: "memory"); __builtin_amdgcn_s_barrier(); asm volatile("" ::: "memory"); }
__device__ __forceinline__ void red16x4(float& a, float& b, float& c, float& d) {
#define DPP4(ctl) "v_add_f32_dpp %0, %0, %0 " ctl " row_mask:0xf bank_mask:0xf bound_ctrl:1\n" "v_add_f32_dpp %1, %1, %1 " ctl " row_mask:0xf bank_mask:0xf bound_ctrl:1\n" \
                  "v_add_f32_dpp %2, %2, %2 " ctl " row_mask:0xf bank_mask:0xf bound_ctrl:1\n" "v_add_f32_dpp %3, %3, %3 " ctl " row_mask:0xf bank_mask:0xf bound_ctrl:1\n"
    asm volatile("s_nop 1\n" DPP4("quad_perm:[1,0,3,2]") DPP4("quad_perm:[2,3,0,1]") DPP4("row_half_mirror") DPP4("row_mirror") : "+v"(a), "+v"(b), "+v"(c), "+v"(d));
#undef DPP4
}
__device__ __forceinline__ float red32(float x) { x += __shfl_xor(x, 1); x += __shfl_xor(x, 2); x += __shfl_xor(x, 4); x += __shfl_xor(x, 8); x += __shfl_xor(x, 16); return x; }
__device__ __forceinline__ float red64(float x) { x = red32(x); x += __shfl_xor(x, 32); return x; }
__device__ __forceinline__ float softplus_f(float x) { return fmaxf(x, 0.f) + log1pf(__expf(-fabsf(x))); }

__device__ void tconv(const Frame& F, const float* __restrict__ W, int K, int N, int Npad, bf16_t* __restrict__ Wt, const float* __restrict__ rs) {
    float* tile = (float*)g_lds;
    const int ktn = (K + 63) / 64, ntn = Npad / 64, tid = F.tid;
    for (int tl = blockIdx.x; tl < ktn * ntn; tl += gridDim.x) {
        const int kt = tl % ktn, nt = tl / ktn;
#pragma unroll
        for (int i = 0; i < 2; ++i) { const int idx = tid + i * NTHR, kk = idx >> 4, n4 = (idx & 15) * 4, k = kt * 64 + kk, n = nt * 64 + n4;
            f32x4 v = {0.f, 0.f, 0.f, 0.f};
            if (k < K) { if (n + 3 < N) v = *(const f32x4*)(W + (size_t)k * N + n); else { for (int j = 0; j < 4; ++j) if (n + j < N) v[j] = W[(size_t)k * N + n + j]; }
                if (rs != nullptr) { const float r = rs[k]; v[0] *= r; v[1] *= r; v[2] *= r; v[3] *= r; } }
            tile[kk * 65 + n4] = v[0]; tile[kk * 65 + n4 + 1] = v[1]; tile[kk * 65 + n4 + 2] = v[2]; tile[kk * 65 + n4 + 3] = v[3]; }
        __syncthreads();
        { const int nn = tid >> 3, k8 = (tid & 7) * 8, k = kt * 64 + k8, n = nt * 64 + nn;
          if (k < K) { u32x4 w; const float* tp = tile + k8 * 65 + nn;
              w.x = cvt_pk_bf16(tp[0], tp[65]); w.y = cvt_pk_bf16(tp[130], tp[195]); w.z = cvt_pk_bf16(tp[260], tp[325]); w.w = cvt_pk_bf16(tp[390], tp[455]);
              *(u32x4*)(Wt + (size_t)n * K + k) = w; } }
        __syncthreads();
    }
}
__device__ void p0_prologue(const Frame& F) {
    const int tid = F.tid, gtid = blockIdx.x * NTHR + tid, gn = gridDim.x * NTHR;
    for (int i = gtid; i < 2 * NTOK; i += gn) F.ss1[i] = 0.f;
    for (int i = gtid; i < SEQ * 32; i += gn) { const int pos = i >> 5, j = i & 31;
        const float inv = 1.0f / powf(10000.0f, (float)(2 * j) / 64.0f); const float ang = (float)pos * inv;
        double rev = (double)ang * 0.15915494309189535; rev -= floor(rev); const float fr = (float)rev;
        F.rope[i] = make_float2(__builtin_amdgcn_cosf(fr), __builtin_amdgcn_sinf(fr)); }
    tconv(F, F.in[2], 1024, 5096, 5120, F.win, nullptr);
    tconv(F, F.in[17], 1024, 4096, 4096, F.wup, F.in[16]);
    tconv(F, F.in[18], 4096, 1024, 1024, F.wdn, nullptr);
    tconv(F, F.in[14], 512, 1024, 1024, F.wb, nullptr);
    tconv(F, F.in[14] + 512 * 1024, 512, 1024, 1024, F.wb + 1024 * 512, nullptr);
    tconv(F, F.in[15], 1024, 1024, 1024, F.wo, nullptr);
    tconv(F, F.in[5], 64, 512, 512, F.wd, nullptr);
    tconv(F, F.in[7], 64, 512, 512, F.wi, nullptr);
    tconv(F, F.in[8], 160, 512, 512, F.wg, nullptr);
    const float* x = F.in[0]; const float* g = F.in[1]; const int lane = F.lane;
    for (int row = blockIdx.x * 8 + F.wave; row < NTOK; row += gridDim.x * 8) {
        const float* xr = x + (size_t)row * DM; f32x4 v[4]; float ss = 0.f;
#pragma unroll
        for (int i = 0; i < 4; ++i) { v[i] = *(const f32x4*)(xr + i * 256 + lane * 4); ss += v[i][0] * v[i][0] + v[i][1] * v[i][1] + v[i][2] * v[i][2] + v[i][3] * v[i][3]; }
        ss = red64(ss); const float sc = rsqrtf(ss * (1.0f / 1024.0f) + 1e-6f);
#pragma unroll
        for (int i = 0; i < 4; ++i) { const f32x4 gg = *(const f32x4*)(g + i * 256 + lane * 4); uint2 w;
            w.x = cvt_pk_bf16(v[i][0] * sc * gg[0], v[i][1] * sc * gg[1]); w.y = cvt_pk_bf16(v[i][2] * sc * gg[2], v[i][3] * sc * gg[3]);
            *(uint2*)(F.h + (size_t)row * DM + i * 256 + lane * 4) = w; }
    }
}

__device__ void p2_prep(const Frame& F, const int mode) {
    const int tid = F.tid, lane = F.lane, wave = F.wave, fr = lane & 15, fq = lane >> 4;
    bf16_t* z = F.z; const float* mu = F.in[3];
    if (mode != 2) {
        constexpr int LDA = 296, TT = 32; bf16_t* At = (bf16_t*)g_lds;
        bf16_t* Ot = At + TT * LDA;
        const float* dbias = F.in[4]; const float* ibias = F.in[6];
        for (int tile = blockIdx.x; tile < NTOK / TT; tile += gridDim.x) {
            const int t0 = tile * TT;
            for (int idx = tid; idx < TT * 36; idx += NTHR) { const int tok = idx / 36, c8 = (idx - tok * 36) * 8, t = t0 + tok, col = C_WD + c8;
                const u32x4 zc = *(const u32x4*)(z + (size_t)t * ZLD + col); u32x4 zp = {0u, 0u, 0u, 0u}; if (t & (SEQ - 1)) zp = *(const u32x4*)(z + (size_t)(t - 1) * ZLD + col);
                const f32x4 m0 = *(const f32x4*)(mu + col), m1 = *(const f32x4*)(mu + col + 4);
                float v[8]; const unsigned zcu[4] = {zc.x, zc.y, zc.z, zc.w}, zpu[4] = {zp.x, zp.y, zp.z, zp.w};
#pragma unroll
                for (int j = 0; j < 4; ++j) { const float a = bflo(zcu[j]), b2 = bfhi(zcu[j]), pa = bflo(zpu[j]), pb = bfhi(zpu[j]);
                    const float mm0 = (j < 2) ? m0[2 * j] : m1[2 * j - 4], mm1 = (j < 2) ? m0[2 * j + 1] : m1[2 * j - 3];
                    v[2 * j] = a + (pa - a) * mm0; v[2 * j + 1] = b2 + (pb - b2) * mm1; }
                if (c8 < 64) {
#pragma unroll
                    for (int j = 0; j < 8; ++j) v[j] = tanhf(v[j]); }
                else if (c8 >= 128) {
#pragma unroll
                    for (int j = 0; j < 8; ++j) v[j] = sigm(v[j]); }
                u32x4 w; w.x = cvt_pk_bf16(v[0], v[1]); w.y = cvt_pk_bf16(v[2], v[3]); w.z = cvt_pk_bf16(v[4], v[5]); w.w = cvt_pk_bf16(v[6], v[7]);
                *(u32x4*)(At + tok * LDA + c8) = w; }
            __syncthreads();
            const int h = wave;
            bf16x8 Bc[9], Bn[9];
            { const int n = h * 64 + fr;
#pragma unroll
              for (int ks = 0; ks < 2; ++ks) { Bc[ks] = *(const bf16x8*)(F.wd + n * 64 + ks * 32 + fq * 8); Bc[2 + ks] = *(const bf16x8*)(F.wi + n * 64 + ks * 32 + fq * 8); }
#pragma unroll
              for (int ks = 0; ks < 5; ++ks) Bc[4 + ks] = *(const bf16x8*)(F.wg + n * 160 + ks * 32 + fq * 8); }
#pragma unroll 1
            for (int j = 0; j < 4; ++j) { const int n = h * 64 + j * 16 + fr;
                if (j < 3) { const int nn = n + 16;
#pragma unroll
                    for (int ks = 0; ks < 2; ++ks) { Bn[ks] = *(const bf16x8*)(F.wd + nn * 64 + ks * 32 + fq * 8); Bn[2 + ks] = *(const bf16x8*)(F.wi + nn * 64 + ks * 32 + fq * 8); }
#pragma unroll
                    for (int ks = 0; ks < 5; ++ks) Bn[4 + ks] = *(const bf16x8*)(F.wg + nn * 160 + ks * 32 + fq * 8); }
                const float db = dbias[n], ib = ibias[n];
#pragma unroll
                for (int mt = 0; mt < 2; ++mt) {
                    f32x4 ad = {0.f, 0.f, 0.f, 0.f}, ai = ad, ag = ad; const bf16_t* ap = At + (mt * 16 + fr) * LDA + fq * 8;
#pragma unroll
                    for (int ks = 0; ks < 2; ++ks) ad = __builtin_amdgcn_mfma_f32_16x16x32_bf16(*(const bf16x8*)(ap + ks * 32), Bc[ks], ad, 0, 0, 0);
#pragma unroll
                    for (int ks = 0; ks < 2; ++ks) ai = __builtin_amdgcn_mfma_f32_16x16x32_bf16(*(const bf16x8*)(ap + 64 + ks * 32), Bc[2 + ks], ai, 0, 0, 0);
#pragma unroll
                    for (int ks = 0; ks < 5; ++ks) ag = __builtin_amdgcn_mfma_f32_16x16x32_bf16(*(const bf16x8*)(ap + 128 + ks * 32), Bc[4 + ks], ag, 0, 0, 0);
#pragma unroll
                    for (int jj = 0; jj < 4; ++jj) {
                        const float dw = db + ad[jj]; const float wlog = -softplus_f(-dw) - 0.5f; const float lwv = -__expf(wlog);
                        const int tk = mt * 16 + fq * 4 + jj; Ot[tk * 520 + n] = f2bf(lwv); Ot[(TT + tk) * 520 + n] = f2bf(sigm(ib + ai[jj])); Ot[(2 * TT + tk) * 520 + n] = f2bf(ag[jj]); }
                }
#pragma unroll
                for (int q = 0; q < 9; ++q) Bc[q] = Bn[q];
            }
            __syncthreads();
#pragma unroll
            for (int i = 0; i < 12; ++i) { const int idx = tid + i * NTHR, arr = idx >> 11, rem = idx & 2047, tk = rem >> 6, c8 = (rem & 63) * 8;
                const u32x4 w = *(const u32x4*)(Ot + (arr * TT + tk) * 520 + c8); bf16_t* dst = arr == 0 ? F.lw : (arr == 1 ? F.ic : F.gt);
                *(u32x4*)(dst + (size_t)(t0 + tk) * 512 + c8) = w; }
            __syncthreads();
        }
    }
    if (mode != 2) {
        unsigned short* tl = (unsigned short*)g_lds;
        for (int tile = blockIdx.x; tile < NTOK / 64; tile += gridDim.x) { const int t0 = tile * 64, b = t0 / SEQ, tt0 = t0 % SEQ;
#pragma unroll
            for (int i = 0; i < 8; ++i) { const int idx = tid + i * NTHR, tok = idx >> 6, d = idx & 63; tl[tok * 66 + d] = z[(size_t)(t0 + tok) * ZLD + C_VA + d]; }
            __syncthreads();
#pragma unroll
            for (int i = 0; i < 8; ++i) { const int idx = tid + i * NTHR, d = idx >> 6, tok = idx & 63; F.vt[((size_t)b * 64 + d) * SEQ + tt0 + tok] = tl[tok * 66 + d]; }
            __syncthreads();
        }
    }
    if (mode != 0) {
        const int gtid = blockIdx.x * NTHR + tid, gn = gridDim.x * NTHR;
        for (int idx = gtid; idx < NTOK * 144; idx += gn) { const int t = idx / 144, p = idx - t * 144, hd = p >> 3, i4 = (p & 7) * 4;
            const int base = hd < 8 ? C_Q + hd * 64 : (hd == 8 ? C_KA : (hd < 17 ? C_QI + (hd - 9) * 64 : C_KI));
            f32x4 cs0 = *(const f32x4*)(&F.rope[(t & (SEQ - 1)) * 32 + i4]), cs1 = *(const f32x4*)(&F.rope[(t & (SEQ - 1)) * 32 + i4 + 2]);
            if (mode == 2) { cs0 = (f32x4){1.f, 0.f, 1.f, 0.f}; cs1 = cs0; }
            bf16_t* p1 = z + (size_t)t * ZLD + base + i4; const uint2 a = *(const uint2*)(p1), b2 = *(const uint2*)(p1 + 32);
            const float x10 = bflo(a.x), x11 = bfhi(a.x), x12 = bflo(a.y), x13 = bfhi(a.y), x20 = bflo(b2.x), x21 = bfhi(b2.x), x22 = bflo(b2.y), x23 = bfhi(b2.y);
            uint2 o1, o2;
            o1.x = cvt_pk_bf16(x10 * cs0[0] - x20 * cs0[1], x11 * cs0[2] - x21 * cs0[3]); o1.y = cvt_pk_bf16(x12 * cs1[0] - x22 * cs1[1], x13 * cs1[2] - x23 * cs1[3]);
            o2.x = cvt_pk_bf16(x20 * cs0[0] + x10 * cs0[1], x21 * cs0[2] + x11 * cs0[3]); o2.y = cvt_pk_bf16(x22 * cs1[0] + x12 * cs1[1], x23 * cs1[2] + x13 * cs1[3]);
            *(uint2*)(p1) = o1; *(uint2*)(p1 + 32) = o2; }
    }
}

struct ScanRaw { uint2 zr_c, zr_p, zk_c, zk_p, zv_c, zv_p, lwu, icu; };
struct ScanConst { f32x4 mur, muk, muv, kk, ka, rk; };
__device__ __forceinline__ void scan_load(ScanRaw& R, const bf16_t* z, const bf16_t* lw, const bf16_t* ic, size_t tokbase, int ch, int ptok, int gc) {
    const int t = ch * 16 + ptok; const size_t T = tokbase + t; const bf16_t* zp = z + T * ZLD + gc;
    R.zr_c = *(const uint2*)(zp + C_R); R.zk_c = *(const uint2*)(zp + C_K); R.zv_c = *(const uint2*)(zp + C_V);
    const uint2 zz = make_uint2(0u, 0u);
    if (t > 0) { R.zr_p = *(const uint2*)(zp - ZLD + C_R); R.zk_p = *(const uint2*)(zp - ZLD + C_K); R.zv_p = *(const uint2*)(zp - ZLD + C_V); } else { R.zr_p = zz; R.zk_p = zz; R.zv_p = zz; }
    R.lwu = *(const uint2*)(lw + T * 512 + gc); R.icu = *(const uint2*)(ic + T * 512 + gc);
}
__device__ __forceinline__ f32x4 unpack4(uint2 u) { f32x4 r; r[0] = bflo(u.x); r[1] = bfhi(u.x); r[2] = bflo(u.y); r[3] = bfhi(u.y); return r; }
__device__ __forceinline__ void scan_prep(const ScanRaw& R, const ScanConst& C, float* ops, float* vv, float* bonus_out, bool wr_bonus, int ptok, int pc, int v0) {
    const f32x4 rc = unpack4(R.zr_c), rp = unpack4(R.zr_p), kc = unpack4(R.zk_c), kp = unpack4(R.zk_p), vc = unpack4(R.zv_c), vp = unpack4(R.zv_p), ic = unpack4(R.icu), lw = unpack4(R.lwu);
    const f32x4 r = rc + (rp - rc) * C.mur, k = kc + (kp - kc) * C.muk, vs = vc + (vp - vc) * C.muv;
    f32x4 w; w[0] = __expf(lw[0]); w[1] = __expf(lw[1]); w[2] = __expf(lw[2]); w[3] = __expf(lw[3]);
    const f32x4 q = k * C.kk; const float ss = red16((q[0] * q[0] + q[1] * q[1]) + (q[2] * q[2] + q[3] * q[3]));
    const float inv = 1.0f / fmaxf(sqrtf(ss), 1e-12f); const f32x4 n = q * inv;
    const f32x4 kn = k * (1.0f + (ic - 1.0f) * C.ka);
    const f32x4 bt = r * kn * C.rk; const float bon = red16((bt[0] + bt[1]) + (bt[2] + bt[3]));
    if (wr_bonus) *bonus_out = bon;
    float* op = ops + ptok * 320 + pc;
    *(f32x4*)(op) = -n; *(f32x4*)(op + 64) = w; *(f32x4*)(op + 128) = n * ic; *(f32x4*)(op + 192) = kn; *(f32x4*)(op + 256) = r;
    if (pc >= v0 && pc < v0 + 32) *(f32x4*)(vv + ptok * 32 + pc - v0) = vs;
}
__device__ void p3_scan(const Frame& F, const int mode) {
    const int tid = F.tid;
    float* opsb = (float*)g_lds;
    float* vvb = opsb + 2 * 5120;
    float* yob = vvb + 2 * 512;
    const bf16_t* z = F.z; const float* mu = F.in[3]; const float* k_k = F.in[9]; const float* k_a = F.in[10]; const float* r_k = F.in[11];
    for (int item = blockIdx.x; item < 256; item += gridDim.x) {
        const int bh = item >> 1, half = item & 1, b = bh >> 3, h = bh & 7, v0 = half * 32;
        const size_t tokbase = (size_t)b * SEQ;
        if (F.wave >= 4) {
            const int pt = tid - 256, ptok = pt >> 4, pc = (pt & 15) * 4, gc = h * 64 + pc;
            ScanConst C; C.mur = *(const f32x4*)(mu + C_R + gc); C.muk = *(const f32x4*)(mu + C_K + gc); C.muv = *(const f32x4*)(mu + C_V + gc);
            C.kk = *(const f32x4*)(k_k + gc); C.ka = *(const f32x4*)(k_a + gc); C.rk = *(const f32x4*)(r_k + gc);
            const bool wrb = (half == 0) && ((pt & 15) == 0);
            ScanRaw R;
            scan_load(R, z, F.lw, F.ic, tokbase, 0, ptok, gc);
            scan_prep(R, C, opsb, vvb, F.bonus + (tokbase + ptok) * 8 + h, wrb, ptok, pc, v0);
            scan_load(R, z, F.lw, F.ic, tokbase, 1, ptok, gc);
            lds_barrier();
            for (int ch = 0; ch < SEQ / 16; ++ch) {
                const int cur = ch & 1, nxt = cur ^ 1;
                if (mode != 2) {
                if (ch > 0) { const int tok = pt >> 4, r2 = (pt & 15) * 2;
                    *(float2*)(F.yraw + (tokbase + (ch - 1) * 16 + tok) * 512 + h * 64 + v0 + r2) = *(const float2*)(yob + nxt * 512 + tok * 32 + r2); }
                if (ch + 1 < SEQ / 16) {
                    scan_prep(R, C, opsb + nxt * 5120, vvb + nxt * 512, F.bonus + (tokbase + (ch + 1) * 16 + ptok) * 8 + h, wrb, ptok, pc, v0);
                    if (ch + 2 < SEQ / 16) scan_load(R, z, F.lw, F.ic, tokbase, ch + 2, ptok, gc);
                } }
                lds_barrier();
            }
            { const int tok = pt >> 4, r2 = (pt & 15) * 2;
              *(float2*)(F.yraw + (tokbase + (SEQ / 16 - 1) * 16 + tok) * 512 + h * 64 + v0 + r2) = *(const float2*)(yob + 512 + tok * 32 + r2); }
        } else {
            const int rp = tid >> 4, ks = tid & 15;
            float A0 = 0.f, A1 = 0.f, A2 = 0.f, A3 = 0.f, B0 = 0.f, B1 = 0.f, B2 = 0.f, B3 = 0.f;
            const int ywoff = (ks == 0) ? 2 * rp : (2 * 512 + 2 * tid), ywstep = (ks == 0) ? 32 : 0;
            lds_barrier();
            f32x4 rprev = {0.f, 0.f, 0.f, 0.f}; float* ywp = yob + 2 * 512 + 2 * tid;
            for (int ch = 0; ch < SEQ / 16; ++ch) {
                const int cur = ch & 1;
                const float* ops = opsb + cur * 5120 + ks * 4; const float* vv = vvb + cur * 512 + 2 * rp; float* yw = yob + cur * 512 + ywoff;
                if (mode != 1) {
#pragma unroll
                for (int s = 0; s < 16; ++s) {
                    const float* o = ops + s * 320;
                    const f32x4 a4 = *(const f32x4*)(o), w4 = *(const f32x4*)(o + 64), b4 = *(const f32x4*)(o + 128), k4 = *(const f32x4*)(o + 192), r4 = *(const f32x4*)(o + 256);
                    const float2 vab = *(const float2*)(vv + s * 32);
                    float sa = (A0 * a4[0] + A1 * a4[1]) + (A2 * a4[2] + A3 * a4[3]); float sb = (B0 * a4[0] + B1 * a4[1]) + (B2 * a4[2] + B3 * a4[3]);
                    float ya = (A0 * rprev[0] + A1 * rprev[1]) + (A2 * rprev[2] + A3 * rprev[3]); float yb2 = (B0 * rprev[0] + B1 * rprev[1]) + (B2 * rprev[2] + B3 * rprev[3]);
                    red16x4(sa, sb, ya, yb2);
                    *(float2*)(ywp) = make_float2(ya, yb2);
                    ywp = yw + s * ywstep;
                    A0 = A0 * w4[0] + sa * b4[0] + vab.x * k4[0]; A1 = A1 * w4[1] + sa * b4[1] + vab.x * k4[1];
                    A2 = A2 * w4[2] + sa * b4[2] + vab.x * k4[2]; A3 = A3 * w4[3] + sa * b4[3] + vab.x * k4[3];
                    B0 = B0 * w4[0] + sb * b4[0] + vab.y * k4[0]; B1 = B1 * w4[1] + sb * b4[1] + vab.y * k4[1];
                    B2 = B2 * w4[2] + sb * b4[2] + vab.y * k4[2]; B3 = B3 * w4[3] + sb * b4[3] + vab.y * k4[3];
                    rprev = r4;
                }
                {
                    float ya = (A0 * rprev[0] + A1 * rprev[1]) + (A2 * rprev[2] + A3 * rprev[3]); float yb2 = (B0 * rprev[0] + B1 * rprev[1]) + (B2 * rprev[2] + B3 * rprev[3]);
                    float d0 = 0.f, d1 = 0.f; red16x4(ya, yb2, d0, d1);
                    *(float2*)(ywp) = make_float2(ya, yb2); ywp = yob + 2 * 512 + 2 * tid; rprev = (f32x4){0.f, 0.f, 0.f, 0.f};
                } }
                lds_barrier();
            }
        }
        __syncthreads();
    }
}

__device__ __forceinline__ unsigned ordkey(float f) { const unsigned u = __float_as_uint(f); return (u & 0x80000000u) ? ~u : (u | 0x80000000u); }

__device__ __forceinline__ void attn_chunk(const unsigned char* kb, const unsigned char* vb, const unsigned* selm, int c, int fr, int fq, const bf16x8 (&Bqa)[2], f32x4 (&O)[4], float& rs) {
    const f32x4 zero4 = {0.f, 0.f, 0.f, 0.f};
#pragma unroll
    for (int p = 0; p < 2; ++p) {
        const unsigned char* k0p = kb + ((2 * p) * 16 + fr) * 144 + fq * 16; const unsigned char* k1p = k0p + 16 * 144;
        const bf16x8 KA00 = *(const bf16x8*)(k0p), KA01 = *(const bf16x8*)(k0p + 64), KA10 = *(const bf16x8*)(k1p), KA11 = *(const bf16x8*)(k1p + 64);
        const unsigned mw = selm[fr * 64 + 2 * c + p]; const unsigned m0 = (mw >> (fq * 4)) & 0xFu, m1 = (mw >> (16 + fq * 4)) & 0xFu;
        f32x4 s0 = __builtin_amdgcn_mfma_f32_16x16x32_bf16(KA00, Bqa[0], zero4, 0, 0, 0); s0 = __builtin_amdgcn_mfma_f32_16x16x32_bf16(KA01, Bqa[1], s0, 0, 0, 0);
        f32x4 s1 = __builtin_amdgcn_mfma_f32_16x16x32_bf16(KA10, Bqa[0], zero4, 0, 0, 0); s1 = __builtin_amdgcn_mfma_f32_16x16x32_bf16(KA11, Bqa[1], s1, 0, 0, 0);
        float p0[4], p1[4];
#pragma unroll
        for (int jj = 0; jj < 4; ++jj) { p0[jj] = ((m0 >> jj) & 1u) ? __expf(fminf(s0[jj] * 0.125f, 60.f)) : 0.f; p1[jj] = ((m1 >> jj) & 1u) ? __expf(fminf(s1[jj] * 0.125f, 60.f)) : 0.f; }
        rs += (p0[0] + p0[1]) + (p0[2] + p0[3]) + (p1[0] + p1[1]) + (p1[2] + p1[3]);
        u32x4 pk; pk.x = cvt_pk_bf16(p0[0], p0[1]); pk.y = cvt_pk_bf16(p0[2], p0[3]); pk.z = cvt_pk_bf16(p1[0], p1[1]); pk.w = cvt_pk_bf16(p1[2], p1[3]);
        const bf16x8 PB = __builtin_bit_cast(bf16x8, pk);
#pragma unroll
        for (int dt = 0; dt < 4; ++dt) { const unsigned char* vp = vb + (dt * 16 + fr) * 144 + (2 * p) * 32 + fq * 8;
            const uint2 lo = *(const uint2*)(vp), hi = *(const uint2*)(vp + 32);
            u32x4 va; va.x = lo.x; va.y = lo.y; va.z = hi.x; va.w = hi.y;
            O[dt] = __builtin_amdgcn_mfma_f32_16x16x32_bf16(__builtin_bit_cast(bf16x8, va), PB, O[dt], 0, 0, 0); }
    }
}
__device__ void p3_dsa(const Frame& F) {
    const int tid = F.tid, lane = F.lane, wave = F.wave, fr = lane & 15, fq = lane >> 4;
    unsigned* selm = (unsigned*)g_lds;
    unsigned* eqm = selm + 1024;
    int* cnt = (int*)(eqm + 1024);
    int* eqpre = cnt + 256;
    unsigned char* kbuf = (unsigned char*)(eqpre + 1024);
    unsigned char* vbuf = kbuf + 2 * 9216;
    const bf16_t* z = F.z; const int G = gridDim.x, bx = blockIdx.x;
    const f32x4 zero4 = {0.f, 0.f, 0.f, 0.f};
    for (int rnd = 0; rnd * G < 2048; ++rnd) {
        const int n = rnd * G + ((rnd & 1) ? (G - 1 - bx) : bx);
        if (n >= 2048) continue;
        const int qg = 127 - (n >> 4), b = n & 15, q0 = qg * 16; const size_t Tb = (size_t)b * SEQ;
        for (int i = tid; i < 2048; i += NTHR) selm[i] = 0u;
        __syncthreads();
        const bf16_t* zq = z + (Tb + q0 + fr) * ZLD;
        const unsigned lofk = (unsigned)((fr * ZLD + fq * 8) * 2), lofv = (unsigned)((fr * SEQ + fq * 4) * 2);
        if (qg >= 16) {
            float sacc[16][4];
#pragma unroll
            for (int i = 0; i < 16; ++i)
#pragma unroll
                for (int jj = 0; jj < 4; ++jj) sacc[i][jj] = 0.f;
            const u32x4 wv = *(const u32x4*)(zq + C_WI);
            {
                bf16x8 Bq[8][2];
#pragma unroll
                for (int hh = 0; hh < 8; ++hh)
#pragma unroll
                    for (int ks = 0; ks < 2; ++ks) Bq[hh][ks] = *(const bf16x8*)(zq + C_QI + hh * 64 + ks * 32 + fq * 8);
                const float sc = 0.044194173824159216f;
                float wih[8]; wih[0] = bflo(wv.x) * sc; wih[1] = bfhi(wv.x) * sc; wih[2] = bflo(wv.y) * sc; wih[3] = bfhi(wv.y) * sc; wih[4] = bflo(wv.z) * sc; wih[5] = bfhi(wv.z) * sc; wih[6] = bflo(wv.w) * sc; wih[7] = bfhi(wv.w) * sc;
                bf16x8 W0[2], W1[2];
#pragma unroll
                for (int j = 0; j < 2; ++j) { const int ktj = (wave + 8 * j) < qg ? (wave + 8 * j) : qg; const char* kb = (const char*)(z + (Tb + (size_t)ktj * 16) * ZLD + C_KI);
                    W0[j] = *(const bf16x8*)(kb + lofk); W1[j] = *(const bf16x8*)(kb + lofk + 64); }
#pragma unroll
                for (int i = 0; i < 16; ++i) { const int kt = wave + 8 * i;
                    if (kt <= qg) {
#pragma unroll
                        for (int hh = 0; hh < 8; ++hh) { f32x4 acc = __builtin_amdgcn_mfma_f32_16x16x32_bf16(W0[i & 1], Bq[hh][0], zero4, 0, 0, 0);
                            acc = __builtin_amdgcn_mfma_f32_16x16x32_bf16(W1[i & 1], Bq[hh][1], acc, 0, 0, 0);
#pragma unroll
                            for (int jj = 0; jj < 4; ++jj) sacc[i][jj] += wih[hh] * fmaxf(acc[jj], 0.f); }
                    }
                    if (i + 2 < 16) { const int ktn = (kt + 16) < qg ? (kt + 16) : qg; const char* kb = (const char*)(z + (Tb + (size_t)ktn * 16) * ZLD + C_KI);
                        unsigned lo2 = lofk; asm volatile("" : "+v"(lo2));
                        W0[i & 1] = *(const bf16x8*)(kb + lo2); W1[i & 1] = *(const bf16x8*)(kb + lo2 + 64); }
                }
            }
            unsigned uk[16][4];
#pragma unroll
            for (int i = 0; i < 16; ++i) { const int kt = wave + 8 * i;
#pragma unroll
                for (int jj = 0; jj < 4; ++jj) { const bool masked = (kt > qg) || ((kt == qg) && (fq * 4 + jj > fr)); uk[i][jj] = masked ? 0x007fffffu : ordkey(sacc[i][jj]); } }
            unsigned T = 0u; bool found = false;
#pragma unroll 1
            for (int brep = 0; brep < 1 + REP(12); ++brep) { T = 0u; found = false; __syncthreads();
            for (int bit = 31; bit >= 0; --bit) {
                const unsigned cand = T | (1u << bit); int c = 0;
#pragma unroll
                for (int i = 0; i < 16; ++i) {
#pragma unroll
                    for (int jj = 0; jj < 4; ++jj) c += (uk[i][jj] >= cand) ? 1 : 0;
                    __builtin_amdgcn_sched_barrier(0); }
                c += __shfl_xor(c, 16); c += __shfl_xor(c, 32);
                const int par = bit & 1;
                if (fq == 0) cnt[(par * 8 + wave) * 16 + fr] = c;
                __syncthreads();
                int tot = 0;
#pragma unroll
                for (int w = 0; w < 8; ++w) tot += cnt[(par * 8 + w) * 16 + fr];
                if (!found && tot >= 256) { T = cand; if (tot == 256) found = true; }
                if (__all(found)) break;
            } }
            int need;
            { int c = 0; unsigned Tp = T + 1u; asm volatile("" : "+v"(Tp));
#pragma unroll
              for (int i = 0; i < 16; ++i) {
#pragma unroll
                  for (int jj = 0; jj < 4; ++jj) c += (uk[i][jj] >= Tp) ? 1 : 0;
                  __builtin_amdgcn_sched_barrier(0); }
              c += __shfl_xor(c, 16); c += __shfl_xor(c, 32);
              __syncthreads();
              if (fq == 0) cnt[wave * 16 + fr] = c;
              __syncthreads();
              int tot = 0;
#pragma unroll
              for (int w = 0; w < 8; ++w) tot += cnt[w * 16 + fr];
              need = 256 - tot; }
#pragma unroll
            for (int i = 0; i < 16; ++i) { const int kt = wave + 8 * i; unsigned nib = 0u;
#pragma unroll
                for (int jj = 0; jj < 4; ++jj) nib |= (uk[i][jj] == T) ? (1u << jj) : 0u;
                if (nib) atomicOr(&eqm[fr * 64 + (kt >> 1)], nib << ((kt & 1) * 16 + fq * 4));
                __builtin_amdgcn_sched_barrier(0); }
            __syncthreads();
            unsigned T2 = T; asm volatile("" : "+v"(T2));
            for (int w = tid; w < 1024; w += NTHR) { const int word = w & 63; int sct = 0; for (int j = 0; j < word; ++j) sct += __popc(eqm[w - word + j]); eqpre[w] = sct; }
            __syncthreads();
#pragma unroll
            for (int i = 0; i < 16; ++i) { const int kt = wave + 8 * i; unsigned nib = 0u;
                const int word = kt >> 1, bp0 = (kt & 1) * 16 + fq * 4; const unsigned eqw = eqm[fr * 64 + word]; const int rbase = eqpre[fr * 64 + word];
#pragma unroll
                for (int jj = 0; jj < 4; ++jj) { const int rank = rbase + __popc(eqw & ((1u << (bp0 + jj)) - 1u));
                    const bool sel = (uk[i][jj] > T2) || ((uk[i][jj] == T2) && (rank < need));
                    nib |= sel ? (1u << jj) : 0u; }
                if (nib) atomicOr(&selm[fr * 64 + word], nib << bp0);
                __builtin_amdgcn_sched_barrier(0); }
        } else {
            for (int w = tid; w < 1024; w += NTHR) { const int q = w >> 6, word = w & 63, qpos = q0 + q, lo = word * 32;
                selm[w] = (qpos >= lo + 31) ? 0xffffffffu : (qpos < lo ? 0u : ((2u << (qpos - lo)) - 1u)); }
        }
        __syncthreads();
#pragma unroll 1
        for (int arep = 0; arep < 1 + REP(13); ++arep) {
            const int nchunk = (qg + 4) >> 2; const int lrow = tid >> 3, lseg = tid & 7;
            const bf16_t* kg = z + (Tb + lrow) * ZLD + C_KA + lseg * 8; const bf16_t* vg = F.vt + ((size_t)b * 64 + lrow) * SEQ + lseg * 8;
            const unsigned lst = (unsigned)(lrow * 144 + lseg * 16);
            u32x4 kx = *(const u32x4*)(kg), vx = *(const u32x4*)(vg), ky = kx, vy = vx;
            *(u32x4*)(kbuf + lst) = kx; *(u32x4*)(vbuf + lst) = vx;
            if (1 < nchunk) { kx = *(const u32x4*)(kg + (size_t)64 * ZLD); vx = *(const u32x4*)(vg + 64); }
            if (2 < nchunk) { ky = *(const u32x4*)(kg + (size_t)128 * ZLD); vy = *(const u32x4*)(vg + 128); }
            bf16x8 Bqa[2];
#pragma unroll
            for (int ks = 0; ks < 2; ++ks) Bqa[ks] = *(const bf16x8*)(zq + C_Q + wave * 64 + ks * 32 + fq * 8);
            f32x4 O[4]; float rs = 0.f;
#pragma unroll
            for (int dt = 0; dt < 4; ++dt) O[dt] = zero4;
            lds_barrier();
#pragma unroll 1
            for (int c = 0; c < nchunk; c += 2) {
                attn_chunk(kbuf, vbuf, selm, c, fr, fq, Bqa, O, rs);
                if (c + 1 < nchunk) { *(u32x4*)(kbuf + 9216 + lst) = kx; *(u32x4*)(vbuf + 9216 + lst) = vx; }
                if (c + 3 < nchunk) { kx = *(const u32x4*)(kg + (size_t)(c + 3) * 64 * ZLD); vx = *(const u32x4*)(vg + (c + 3) * 64); }
                lds_barrier();
                if (c + 1 < nchunk) {
                    attn_chunk(kbuf + 9216, vbuf + 9216, selm, c + 1, fr, fq, Bqa, O, rs);
                    if (c + 2 < nchunk) { *(u32x4*)(kbuf + lst) = ky; *(u32x4*)(vbuf + lst) = vy; }
                    if (c + 4 < nchunk) { ky = *(const u32x4*)(kg + (size_t)(c + 4) * 64 * ZLD); vy = *(const u32x4*)(vg + (c + 4) * 64); }
                    lds_barrier();
                }
            }
            rs += __shfl_xor(rs, 16); rs += __shfl_xor(rs, 32);
            const float inv = 1.0f / rs;
            bf16_t* yp = F.yb + (Tb + q0 + fr) * 512 + wave * 64 + fq * 4;
#pragma unroll
            for (int dt = 0; dt < 4; ++dt) { uint2 w; w.x = cvt_pk_bf16(O[dt][0] * inv, O[dt][1] * inv); w.y = cvt_pk_bf16(O[dt][2] * inv, O[dt][3] * inv); *(uint2*)(yp + dt * 16) = w; }
        }
        __syncthreads();
    }
}

__device__ void p4_post(const Frame& F) {
    const int tid = F.tid; const float* mu = F.in[3]; const float* gnw = F.in[12]; const float* gnb = F.in[13]; const bf16_t* z = F.z;
    for (int g = blockIdx.x * 16 + (tid >> 5); g < NTOK * 8; g += gridDim.x * 16) { const size_t t = (size_t)(g >> 3); const int h = g & 7, c = h * 64 + (tid & 31) * 2;
        const float2 y = *(const float2*)(F.yraw + t * 512 + c);
        const float mean = red32(y.x + y.y) * (1.0f / 64.0f); const float dx = y.x - mean, dy = y.y - mean;
        const float var = red32(dx * dx + dy * dy) * (1.0f / 64.0f); const float rstd = rsqrtf(var + 64e-5f);
        const unsigned vc = *(const unsigned*)(z + t * ZLD + C_V + c); const unsigned vp = (t & (SEQ - 1)) ? *(const unsigned*)(z + (t - 1) * ZLD + C_V + c) : 0u;
        const float vs0 = bflo(vc) + (bflo(vp) - bflo(vc)) * mu[C_V + c], vs1 = bfhi(vc) + (bfhi(vp) - bfhi(vc)) * mu[C_V + c + 1];
        const float bon = F.bonus[t * 8 + h]; const unsigned gt = *(const unsigned*)(F.gt + t * 512 + c);
        const float o0 = (dx * rstd * gnw[c] + gnb[c] + bon * vs0) * bflo(gt), o1 = (dy * rstd * gnw[c + 1] + gnb[c + 1] + bon * vs1) * bfhi(gt);
        *(unsigned*)(F.ya + t * 512 + c) = cvt_pk_bf16(o0, o1); }
}

__device__ void p9_final(const Frame& F, const bool ident) {
    const float* g = F.in[19]; const int lane = F.lane;
    for (int row = blockIdx.x * 8 + F.wave; row < NTOK; row += gridDim.x * 8) {
        float* xr = F.out + (size_t)row * DM; const float sc = ident ? 1.0f : rsqrtf(F.ss2[row] * (1.0f / 1024.0f) + 1e-6f);
#pragma unroll
        for (int i = 0; i < 4; ++i) { f32x4 v = *(const f32x4*)(xr + i * 256 + lane * 4); const f32x4 gg = *(const f32x4*)(g + i * 256 + lane * 4);
            if (!ident) { v[0] *= sc * gg[0]; v[1] *= sc * gg[1]; v[2] *= sc * gg[2]; v[3] *= sc * gg[3]; } *(f32x4*)(xr + i * 256 + lane * 4) = v; }
    }
}
#define XB_TMO      128
#define XB_XCNT(j)  (256  + 64 * (j))
#define XB_XSUB(j)  (1280 + 64 * (j))
#define XB_XGEN(j)  (2304 + 64 * (j))
#define XB_TOP      3328
#define XB_TOPGEN   3392
#define XCD_BAR_WORDS 3456
#define XB_SPIN_CAP (1u << 18)
#define LAS __attribute__((address_space(3)))

__device__ __forceinline__ unsigned xb_ld(unsigned* p)              { return __hip_atomic_load(p, __ATOMIC_RELAXED, __HIP_MEMORY_SCOPE_AGENT); }
__device__ __forceinline__ unsigned xb_add(unsigned* p, unsigned v) { return __hip_atomic_fetch_add(p, v, __ATOMIC_RELAXED, __HIP_MEMORY_SCOPE_AGENT); }
__device__ __forceinline__ unsigned xb_xcc_id() { return (unsigned)__builtin_amdgcn_s_getreg((3 << 11) | 20) & 0xFu; }
#define XB_SPIN(cond, bar) do { unsigned _sp = 0; while (cond) { __builtin_amdgcn_s_sleep(1); \
    if ((++_sp & 255u) == 0u) { if (xb_ld(&(bar)[XB_TMO])) break; if (_sp > XB_SPIN_CAP) { atomicAdd(&(bar)[XB_TMO], 1u); break; } } } } while (0)

struct XcdBarrier {
    unsigned* bar; unsigned x;
    volatile LAS unsigned* st;
};

__device__ __forceinline__ XcdBarrier xcd_barrier_post(unsigned* bar, volatile LAS unsigned* st) {
    XcdBarrier b; b.bar = bar; b.x = xb_xcc_id(); b.st = st;
    if (threadIdx.x == 0) (void)xb_add(&bar[XB_XCNT(b.x)], 1u);
    return b;
}
__device__ __forceinline__ void xcd_barrier_complete(unsigned* bar, unsigned x, unsigned& nloc, unsigned& nx) {
    const unsigned G = gridDim.x * gridDim.y * gridDim.z;
    unsigned sum, cnt, mine, sp = 0u;
    for (;;) {
        sum = 0u; cnt = 0u; mine = 0u;
#pragma unroll
        for (unsigned j = 0; j < 16; ++j) { const unsigned c = xb_ld(&bar[XB_XCNT(j)]); sum += c; cnt += (c > 0u) ? 1u : 0u; mine = (j == x) ? c : mine; }
        if (sum == G) break;
        __builtin_amdgcn_s_sleep(1);
        if ((++sp & 255u) == 0u) { if (xb_ld(&bar[XB_TMO])) break; if (sp > XB_SPIN_CAP) { atomicAdd(&bar[XB_TMO], 1u); break; } }
    }
    nloc = mine > 0u ? mine : 1u; nx = cnt > 0u ? cnt : 1u;
}

__device__ __forceinline__ void xcd_barrier(const XcdBarrier& b) {
    asm volatile("s_waitcnt vmcnt(0)" ::: "memory");
    __syncthreads();
    if (threadIdx.x == 0) {
        unsigned* bar = b.bar;
        __builtin_amdgcn_s_waitcnt(0);
        unsigned nloc = b.st[0], nx = b.st[1];
        if (nloc == 0u) { xcd_barrier_complete(bar, b.x, nloc, nx); b.st[0] = nloc; b.st[1] = nx; }
        const unsigned old = xb_add(&bar[XB_XSUB(b.x)], 1u);
        const unsigned gen = old / nloc;
        if (old + 1u == (gen + 1u) * nloc) {
            __builtin_amdgcn_fence(__ATOMIC_RELEASE, "agent");
            asm volatile("s_waitcnt vmcnt(0)" ::: "memory");
            const unsigned og = xb_add(&bar[XB_TOP], 1u);
            const unsigned tg = og / nx;
            if (og + 1u == (tg + 1u) * nx) xb_add(&bar[XB_TOPGEN], 1u);
            else XB_SPIN(xb_ld(&bar[XB_TOPGEN]) == tg, bar);
            __builtin_amdgcn_fence(__ATOMIC_ACQUIRE, "agent");
            xb_add(&bar[XB_XGEN(b.x)], 1u);
            asm volatile("s_waitcnt vmcnt(0)" ::: "memory");
        } else {
            XB_SPIN(xb_ld(&bar[XB_XGEN(b.x)]) == gen, bar);
            __builtin_amdgcn_fence(__ATOMIC_ACQUIRE, "agent");
            asm volatile("s_waitcnt vmcnt(0)" ::: "memory");
        }
    }
    __syncthreads();
}
#ifndef PHASE_MASK
#define PHASE_MASK 0x3ff
#endif
constexpr int NPHASE = 10;
constexpr size_t WS_BAR = 3 * MiB;
template <class Epi> __device__ __forceinline__ void run_gemm(const bf16_t* A, const bf16_t* Bt, int N, int K, const Epi& E) {
    pg8::Gemm g{A, Bt, NTOK, N, K}; pg8::StaticOrder S; S.init(NTOK, N, (int)gridDim.x, (int)blockIdx.x);
    pg8::gemm_phase<Epi, pg8::StaticOrder, false>((PG8_LAS unsigned char*)g_lds, g, S, E, nullptr);
}
__global__ void __launch_bounds__(NTHR, 2) mega_fwd(Args args) {
    Frame F;
#pragma unroll
    for (int i = 0; i < 20; ++i) F.in[i] = args.in[i];
    F.out = args.out; F.ws = args.ws; F.lds = nullptr; F.tid = threadIdx.x; F.lane = F.tid & 63; F.wave = __builtin_amdgcn_readfirstlane(F.tid >> 6);
    unsigned char* ws = args.ws;
    F.ss1 = (float*)(ws + WS_SS1); F.ss2 = (float*)(ws + WS_SS2); F.bonus = (float*)(ws + WS_BONUS); F.rope = (float2*)(ws + WS_ROPE);
    F.wd = (bf16_t*)(ws + WS_WD); F.wi = (bf16_t*)(ws + WS_WI); F.wg = (bf16_t*)(ws + WS_WG);
    F.win = (bf16_t*)(ws + WS_WIN); F.wup = (bf16_t*)(ws + WS_WUP); F.wdn = (bf16_t*)(ws + WS_WDN); F.wb = (bf16_t*)(ws + WS_WB); F.wo = (bf16_t*)(ws + WS_WO); F.vt = (bf16_t*)(ws + WS_VT);
    F.h = (bf16_t*)(ws + WS_H); F.ya = F.h; F.yb = F.h + (size_t)NTOK * 512; F.xb = F.h;
    F.z = (bf16_t*)(ws + WS_Z); F.hid = F.z;
    F.lw = (bf16_t*)(ws + WS_P); F.ic = F.lw + (size_t)NTOK * 512; F.mg = F.lw;
    F.yraw = args.out; F.gt = (bf16_t*)(args.out + (size_t)NTOK * 512);
    const int lo = args.ph_lo, hi = args.ph_hi;
    cg::grid_group grid = cg::this_grid();
    if (args.ph_lo < 0) grid.sync();
    volatile LAS unsigned* xst = (volatile LAS unsigned*)(g_lds + 131072);
    if (threadIdx.x == 0) { xst[0] = 0u; xst[1] = 0u; }
    __syncthreads();
    XcdBarrier xbar = xcd_barrier_post((unsigned*)(ws + WS_BAR), xst);
#define IN(k) (lo <= (k) && (k) < hi)
#define SEAM(k) do { if (IN(k) && IN((k) + 1)) { xcd_barrier(xbar); if (REP(17)) xcd_barrier(xbar); } } while (0)
    if (((PHASE_MASK >> 0) & 1) && IN(0)) { p0_prologue(F); __syncthreads(); if (REP(0)) { p0_prologue(F); __syncthreads(); } } SEAM(0);
    if (((PHASE_MASK >> 1) & 1) && IN(1)) { pg8::EpiZ E{F.z, ZLD}; run_gemm(F.h, F.win, 5120, 1024, E); __syncthreads(); if (REP(1)) { run_gemm(F.h, F.win, 5120, 1024, E); __syncthreads(); } } SEAM(1);
    if (((PHASE_MASK >> 2) & 1) && IN(2)) { if (REP(2)) { p2_prep(F, 0); __syncthreads(); } if (REP(16)) { p2_prep(F, 2); __syncthreads(); } p2_prep(F, 1); __syncthreads(); } SEAM(2);
    if (((PHASE_MASK >> 3) & 1) && IN(3)) { if (REP(14)) { p3_scan(F, 1); __syncthreads(); } if (REP(15)) { p3_scan(F, 2); __syncthreads(); } if (REP(3)) { p3_scan(F, 0); __syncthreads(); } p3_scan(F, 0); __syncthreads(); p3_dsa(F); __syncthreads(); if (REP(10)) { p3_dsa(F); __syncthreads(); } } SEAM(3);
    if (((PHASE_MASK >> 4) & 1) && IN(4)) { p4_post(F); __syncthreads(); if (REP(4)) { p4_post(F); __syncthreads(); } } SEAM(4);
    if (((PHASE_MASK >> 5) & 1) && IN(5)) { pg8::EpiGate<0> E0{F.mg, F.z, ZLD, C_G0}; run_gemm(F.ya, F.wb, 1024, 512, E0); __syncthreads();
                 pg8::EpiGate<1> E1{F.mg, F.z, ZLD, C_G1}; run_gemm(F.yb, F.wb + 1024 * 512, 1024, 512, E1); __syncthreads();
                 if (REP(5)) { run_gemm(F.ya, F.wb, 1024, 512, E0); __syncthreads(); run_gemm(F.yb, F.wb + 1024 * 512, 1024, 512, E1); __syncthreads(); } } SEAM(5);
    if (((PHASE_MASK >> 6) & 1) && IN(6)) { if (REP(6)) { pg8::EpiRes<true> Ex{F.in[0], F.out, F.xb, F.bonus}; run_gemm(F.mg, F.wo, 1024, 1024, Ex); __syncthreads(); }
                 pg8::EpiRes<true> E{F.in[0], F.out, F.xb, F.ss1}; run_gemm(F.mg, F.wo, 1024, 1024, E); __syncthreads(); } SEAM(6);
    if (((PHASE_MASK >> 7) & 1) && IN(7)) { pg8::EpiHid E{F.hid, F.ss1}; run_gemm(F.xb, F.wup, 4096, 1024, E); __syncthreads(); if (REP(7)) { run_gemm(F.xb, F.wup, 4096, 1024, E); __syncthreads(); } } SEAM(7);
    if (((PHASE_MASK >> 8) & 1) && IN(8)) { pg8::EpiRes<false> E{F.out, F.out, nullptr, F.ss2}; run_gemm(F.hid, F.wdn, 1024, 4096, E); __syncthreads(); } SEAM(8);
    if (((PHASE_MASK >> 9) & 1) && IN(9)) { if (REP(9)) { p9_final(F, true); __syncthreads(); } p9_final(F, false); }
#undef IN
#undef SEAM
}

extern "C" void kernel_launch(void* const* d_in, const int* in_sizes, int n_in, void* d_out, int out_size, void* d_ws, size_t ws_size, hipStream_t stream) {
    static int grid = 0;
    if (grid == 0) {
        if (n_in != 20 || out_size != NTOK * DM || ws_size < WS_END) { fprintf(stderr, "kernel_launch: unexpected shapes (n_in %d, out %d, ws %zu < %zu)\n", n_in, out_size, ws_size, (size_t)WS_END); grid = -1; return; }
        int dev = 0, cus = 0, per_cu = 0;
        hipGetDevice(&dev); hipDeviceGetAttribute(&cus, hipDeviceAttributeMultiprocessorCount, dev);
        if (hipFuncSetAttribute((const void*)mega_fwd, hipFuncAttributeMaxDynamicSharedMemorySize, LDS_BYTES) != hipSuccess) { fprintf(stderr, "kernel_launch: hipFuncSetAttribute failed\n"); grid = -1; return; }
        if (hipOccupancyMaxActiveBlocksPerMultiprocessor(&per_cu, (const void*)mega_fwd, NTHR, LDS_BYTES) != hipSuccess || per_cu < 1) { fprintf(stderr, "kernel_launch: occupancy query failed (%d)\n", per_cu); per_cu = 1; }
        (void)hipGetLastError();
        grid = cus * per_cu;
        fprintf(stderr, "kernel_launch: grid %d (%d CUs x %d)\n", grid, cus, per_cu);
    }
    if (grid < 0) return;
    if (hipMemsetAsync((char*)d_ws + WS_BAR, 0, XCD_BAR_WORDS * 4, stream) != hipSuccess) { fprintf(stderr, "kernel_launch: memset of the barrier words failed\n"); return; }
    Args a{};
    for (int i = 0; i < 20; ++i) a.in[i] = (const float*)d_in[i];
    a.out = (float*)d_out; a.ws = (unsigned char*)d_ws;
#if MK_PER_PHASE_LAUNCH
    for (int p = 0; p < NPHASE; ++p) { a.ph_lo = p; a.ph_hi = p + 1; hipLaunchKernelGGL(mega_fwd, dim3(grid), dim3(NTHR), LDS_BYTES, stream, a); }
#else
    a.ph_lo = 0; a.ph_hi = NPHASE;
    void* kargs[] = {&a};
    hipError_t e = hipLaunchCooperativeKernel((const void*)mega_fwd, dim3(grid), dim3(NTHR), kargs, LDS_BYTES, stream);
    if (e != hipSuccess) fprintf(stderr, "kernel_launch: cooperative launch failed: %s (grid %d)\n", hipGetErrorString(e), grid);
#endif
}
```

```cpp
#include <hip/hip_runtime.h>
#include <hip/hip_cooperative_groups.h>
#include <cstdio>
#include <cstdint>
namespace cg = cooperative_groups;

#ifndef MK_PER_PHASE_LAUNCH
#define MK_PER_PHASE_LAUNCH 0
#endif

#ifndef REPEAT_MASK
#define REPEAT_MASK 0
#endif
#define REP(k) ((REPEAT_MASK >> (k)) & 1)
#ifndef TS_SEL
#define TS_SEL -1
#endif

namespace pg8 {
#define PG8_LAS __attribute__((address_space(3)))
typedef unsigned short bf16_t;
typedef short bf16x8 __attribute__((ext_vector_type(8)));
typedef float f32x4 __attribute__((ext_vector_type(4)));
typedef unsigned u32x4 __attribute__((ext_vector_type(4)));
constexpr int BM = 256, BK = 64, HALF = 128, HTB = HALF * BK * 2  , STAGE_BYTES = 8 * HTB, NXCD = 8, WGM = 8;

__host__ __device__ __forceinline__ int lds_byte(int r, int c) { const int st = (r >> 4) * 2 + (c >> 5), rr = r & 15, cc = c & 31, ob = rr * 64 + cc * 2; return st * 1024 + (ob ^ (((ob >> 9) & 1) << 5)); }
__host__ __device__ __forceinline__ void stage_rc(int b, int& R, int& C) { const int st = b / 1024, sb = b % 1024, swz = sb ^ (((sb >> 9) & 1) << 5); R = (st >> 1) * 16 + swz / 64; C = (st & 1) * 32 + (swz % 64) / 2; }
__host__ __device__ __forceinline__ int perm32(int rho) { const int n = rho >> 4, i = rho & 15; return 8 * (i >> 2) + 4 * n + (i & 3); }

struct Unit { int pm, pn; };
struct Gemm { const bf16_t* A; const bf16_t* Bt; int M, N, K; };

struct StaticOrder {
    int nM, nN, nwg, G, c;
    __host__ __device__ void init(int M, int N, int G_, int c_) { nM = M / BM; nN = N / BM; nwg = nM * nN; G = G_; c = c_; }
    __host__ __device__ bool next(int i, Unit& u) const {
        const long L = (long)i * G + c; if (L >= nwg) return false;
        int wgid = (int)L; { const int q = nwg / NXCD, r = nwg % NXCD, xcd = wgid % NXCD, off = wgid / NXCD; wgid = (xcd < r ? xcd * (q + 1) : r * (q + 1) + (xcd - r) * q) + off; }
        const int nig = WGM * nN, gid = wgid / nig, fm = gid * WGM, gsz = (nM - fm) < WGM ? (nM - fm) : WGM;
        u.pm = fm + ((wgid % nig) % gsz); u.pn = (wgid % nig) / gsz; return true;
    }
    __device__ __forceinline__ void a_ready(const Unit&) const {}
    __device__ __forceinline__ void done(const Unit&) const {}
};
__device__ __forceinline__ unsigned cvt_pk_bf16(float lo, float hi) { unsigned r; asm volatile("v_cvt_pk_bf16_f32 %0, %1, %2" : "=v"(r) : "v"(lo), "v"(hi)); return r; }
typedef float f32x2 __attribute__((ext_vector_type(2)));
__device__ __forceinline__ float bflo(unsigned u) { return __uint_as_float(u << 16); }
__device__ __forceinline__ float bfhi(unsigned u) { return __uint_as_float(u & 0xffff0000u); }
__device__ __forceinline__ float sigm(float x) { return 1.0f / (1.0f + __expf(-x)); }

struct EpiZ {
    static constexpr bool PERM = true, AFTER_DRAIN = false;
    bf16_t* O; int ldc;
    __device__ __forceinline__ void operator()(const f32x4 (&acc)[2][2][4][2], const Unit& u, int wr, int wc, int fr, int fq) const {
        const int row0 = u.pm * BM + wr * 64 + fr, col0 = u.pn * BM + wc * 32 + 8 * fq;
#pragma unroll
        for (int ai = 0; ai < 2; ++ai)
#pragma unroll
            for (int m = 0; m < 4; ++m) { bf16_t* rowp = O + (size_t)(row0 + ai * HALF + m * 16) * ldc + col0;
#pragma unroll
                for (int bj = 0; bj < 2; ++bj) { const f32x4 v0 = acc[ai][bj][m][0], v1 = acc[ai][bj][m][1];
                    u32x4 w; w.x = cvt_pk_bf16(v0[0], v0[1]); w.y = cvt_pk_bf16(v0[2], v0[3]); w.z = cvt_pk_bf16(v1[0], v1[1]); w.w = cvt_pk_bf16(v1[2], v1[3]);
                    *(u32x4*)(rowp + bj * HALF) = w; } }
    }
};
template <int MODE> struct EpiGate {
    static constexpr bool PERM = true, AFTER_DRAIN = false;
    bf16_t* O; const bf16_t* Z; int zld; int gcol;
    __device__ __forceinline__ void operator()(const f32x4 (&acc)[2][2][4][2], const Unit& u, int wr, int wc, int fr, int fq) const {
        const int row0 = u.pm * BM + wr * 64 + fr, col0 = u.pn * BM + wc * 32 + 8 * fq;
#pragma unroll
        for (int ai = 0; ai < 2; ++ai)
#pragma unroll
            for (int m = 0; m < 4; ++m) { const size_t row = (size_t)(row0 + ai * HALF + m * 16);
                bf16_t* op = O + row * 1024 + col0; const bf16_t* zp = Z + row * zld + gcol + col0;
#pragma unroll
                for (int bj = 0; bj < 2; ++bj) { const f32x4 v0 = acc[ai][bj][m][0], v1 = acc[ai][bj][m][1];
                    const u32x4 g = *(const u32x4*)(zp + bj * HALF);
                    float r0 = v0[0] * sigm(bflo(g.x)), r1 = v0[1] * sigm(bfhi(g.x)), r2 = v0[2] * sigm(bflo(g.y)), r3 = v0[3] * sigm(bfhi(g.y));
                    float r4 = v1[0] * sigm(bflo(g.z)), r5 = v1[1] * sigm(bfhi(g.z)), r6 = v1[2] * sigm(bflo(g.w)), r7 = v1[3] * sigm(bfhi(g.w));
                    if (MODE == 1) { const u32x4 p = *(const u32x4*)(op + bj * HALF);
                        r0 += bflo(p.x); r1 += bfhi(p.x); r2 += bflo(p.y); r3 += bfhi(p.y); r4 += bflo(p.z); r5 += bfhi(p.z); r6 += bflo(p.w); r7 += bfhi(p.w); }
                    u32x4 w; w.x = cvt_pk_bf16(r0, r1); w.y = cvt_pk_bf16(r2, r3); w.z = cvt_pk_bf16(r4, r5); w.w = cvt_pk_bf16(r6, r7);
                    *(u32x4*)(op + bj * HALF) = w; } }
    }
};
struct EpiRes1 {
    static constexpr bool PERM = false, AFTER_DRAIN = false;
    const float* X; bf16_t* XB; float* SS;
    __device__ __forceinline__ void operator()(const f32x4 (&acc)[2][2][4][2], const Unit& u, int wr, int wc, int fr, int fq) const {
        const int row0 = u.pm * BM + wr * 64 + fr, col0 = u.pn * BM + wc * 32 + 4 * fq;
#pragma unroll
        for (int ai = 0; ai < 2; ++ai)
#pragma unroll
            for (int m = 0; m < 4; ++m) { const size_t row = (size_t)(row0 + ai * HALF + m * 16); float ssq = 0.f;
#pragma unroll
                for (int bj = 0; bj < 2; ++bj)
#pragma unroll
                    for (int n = 0; n < 2; ++n) { const size_t off = row * 1024 + col0 + bj * HALF + n * 16;
                        const f32x4 xv = *(const f32x4*)(X + off); const f32x4 v = acc[ai][bj][m][n] + xv;
                        ssq += v[0] * v[0] + v[1] * v[1] + v[2] * v[2] + v[3] * v[3];
                        uint2 w; w.x = cvt_pk_bf16(v[0], v[1]); w.y = cvt_pk_bf16(v[2], v[3]); *(uint2*)(XB + off) = w; }
                ssq += __shfl_xor(ssq, 16); ssq += __shfl_xor(ssq, 32);
                if (fq == 0) atomicAdd(SS + row, ssq); }
    }
};
struct EpiRes2 {
    static constexpr bool PERM = false, AFTER_DRAIN = false;
    const bf16_t* XB; float* O; float* SS;
    __device__ __forceinline__ void operator()(const f32x4 (&acc)[2][2][4][2], const Unit& u, int wr, int wc, int fr, int fq) const {
        const int row0 = u.pm * BM + wr * 64 + fr, col0 = u.pn * BM + wc * 32 + 4 * fq;
#pragma unroll
        for (int ai = 0; ai < 2; ++ai)
#pragma unroll
            for (int m = 0; m < 4; ++m) { const size_t row = (size_t)(row0 + ai * HALF + m * 16); float ssq = 0.f;
#pragma unroll
                for (int bj = 0; bj < 2; ++bj)
#pragma unroll
                    for (int n = 0; n < 2; ++n) { const size_t off = row * 1024 + col0 + bj * HALF + n * 16;
                        const uint2 xw = *(const uint2*)(XB + off); f32x4 v = acc[ai][bj][m][n];
                        v[0] += bflo(xw.x); v[1] += bfhi(xw.x); v[2] += bflo(xw.y); v[3] += bfhi(xw.y);
                        *(f32x4*)(O + off) = v; ssq += v[0] * v[0] + v[1] * v[1] + v[2] * v[2] + v[3] * v[3]; }
                ssq += __shfl_xor(ssq, 16); ssq += __shfl_xor(ssq, 32);
                if (fq == 0) atomicAdd(SS + row, ssq); }
    }
};
struct EpiHid {
    static constexpr bool PERM = true, AFTER_DRAIN = false;
    bf16_t* O; const float* SS;
    __device__ __forceinline__ void operator()(const f32x4 (&acc)[2][2][4][2], const Unit& u, int wr, int wc, int fr, int fq) const {
        const int row0 = u.pm * BM + wr * 64 + fr, col0 = u.pn * BM + wc * 32 + 8 * fq;
#pragma unroll
        for (int ai = 0; ai < 2; ++ai)
#pragma unroll
            for (int m = 0; m < 4; ++m) { const size_t row = (size_t)(row0 + ai * HALF + m * 16);
                const float s2 = 1.0f / (SS[row] * (1.0f / 1024.0f) + 1e-6f);
                bf16_t* rowp = O + row * 4096 + col0;
#pragma unroll
                for (int bj = 0; bj < 2; ++bj) { f32x4 v0 = acc[ai][bj][m][0], v1 = acc[ai][bj][m][1];
#pragma unroll
                    for (int j = 0; j < 4; ++j) { float a = fmaxf(v0[j], 0.f), b = fmaxf(v1[j], 0.f); v0[j] = a * a * s2; v1[j] = b * b * s2; }
                    u32x4 w; w.x = cvt_pk_bf16(v0[0], v0[1]); w.y = cvt_pk_bf16(v0[2], v0[3]); w.z = cvt_pk_bf16(v1[0], v1[1]); w.w = cvt_pk_bf16(v1[2], v1[3]);
                    *(u32x4*)(rowp + bj * HALF) = w; } }
    }
};

template <class Epi, class Sched, bool ALIGN_EPI = false, bool SP2 = false>
__device__ __forceinline__ void gemm_phase(PG8_LAS unsigned char* lds, const Gemm g, const Sched& S, const Epi& E) {
    const int tid = threadIdx.x, wid = __builtin_amdgcn_readfirstlane(tid >> 6), lane = tid & 63, wr = wid >> 2, wc = wid & 3, fr = lane & 15, fq = lane >> 4;
    const int K = g.K, nt = K / BK;
    unsigned voffA[2], voffB[2];
#pragma unroll
    for (int i = 0; i < 2; ++i) { int R, C; stage_rc(tid * 16 + i * 8192, R, C); const int Rb = Epi::PERM ? ((R & ~31) + perm32(R & 31)) : R;
        voffA[i] = (unsigned)(R * K + C) * 2u; voffB[i] = (unsigned)(Rb * K + C) * 2u; }
    const size_t kstep = (size_t)(BK * 2);
    const size_t hstep = (size_t)HALF * K * 2;
    const size_t tstep = 2 * hstep;
    const unsigned ldsw = (unsigned)wid * 1024u;
    const int aoff = lds_byte(wr * 64 + fr, fq * 8), boff = lds_byte(wc * 32 + fr, fq * 8);
#define PG8_SA(b, h) (((b) * 2 + (h)) * HTB)
#define PG8_SB(b, h) ((4 + (b) * 2 + (h)) * HTB)
#define PG8_STAGE(bufoff, gbase, voff) do { _Pragma("unroll") for (int _i = 0; _i < 2; ++_i) \
        __builtin_amdgcn_global_load_lds((const unsigned*)((const char*)(gbase) + (voff)[_i]), (PG8_LAS unsigned*)(lds + (bufoff) + ldsw + _i * 8192), 16, 0, 0); } while (0)
#define PG8_LDA(dst, b, h) do { _Pragma("unroll") for (int m = 0; m < 4; ++m) _Pragma("unroll") for (int k = 0; k < 2; ++k) dst[m][k] = *(const PG8_LAS bf16x8*)(lds + PG8_SA(b, h) + aoff + m * 2048 + k * 1024); } while (0)
#define PG8_LDB(dst, b, h) do { _Pragma("unroll") for (int n = 0; n < 2; ++n) _Pragma("unroll") for (int k = 0; k < 2; ++k) dst[n][k] = *(const PG8_LAS bf16x8*)(lds + PG8_SB(b, h) + boff + n * 2048 + k * 1024); } while (0)
#define PG8_MMA(ai, bj, At, Bt) do { __builtin_amdgcn_s_setprio(1); _Pragma("unroll") for (int m = 0; m < 4; ++m) _Pragma("unroll") for (int n = 0; n < 2; ++n) _Pragma("unroll") for (int k = 0; k < 2; ++k) \
        acc[ai][bj][m][n] = __builtin_amdgcn_mfma_f32_16x16x32_bf16(Bt[n][k], At[m][k], acc[ai][bj][m][n], 0, 0, 0); __builtin_amdgcn_s_setprio(0); } while (0)
#define PG8_WAIT_V(n) asm volatile("s_waitcnt vmcnt(" #n ")" ::: "memory")
#define PG8_WAIT_L(n) asm volatile("s_waitcnt lgkmcnt(" #n ")" ::: "memory")
#define PG8_BAR __builtin_amdgcn_s_barrier()
#define PG8_SCHED __builtin_amdgcn_sched_barrier(0)
    Unit cur, nxt; int ui = 0;
    if (!S.next(0, cur)) return;
    f32x4 acc[2][2][4][2];
#pragma unroll
    for (int a = 0; a < 2; ++a)
#pragma unroll
        for (int b = 0; b < 2; ++b)
#pragma unroll
            for (int m = 0; m < 4; ++m)
#pragma unroll
                for (int n = 0; n < 2; ++n) acc[a][b][m][n] = (f32x4){0.f, 0.f, 0.f, 0.f};
    bf16x8 At[4][2], B0[2][2], B1[2][2];
    const char* cA = (const char*)g.A + (size_t)cur.pm * tstep; const char* cB = (const char*)g.Bt + (size_t)cur.pn * tstep;
    S.a_ready(cur);
    if constexpr (SP2) {
        PG8_STAGE(PG8_SB(0, 0), cB, voffB); PG8_STAGE(PG8_SB(0, 1), cB + hstep, voffB); PG8_STAGE(PG8_SA(0, 0), cA, voffA); PG8_STAGE(PG8_SA(0, 1), cA + hstep, voffA);
        if (wr == 1) PG8_BAR;
        PG8_WAIT_V(2); PG8_BAR;
        PG8_STAGE(PG8_SB(1, 0), cB + kstep, voffB); PG8_STAGE(PG8_SA(1, 0), cA + kstep, voffA); PG8_STAGE(PG8_SB(1, 1), cB + hstep + kstep, voffB);
        PG8_WAIT_V(6); PG8_BAR;
    } else {
        PG8_STAGE(PG8_SB(0, 0), cB, voffB); PG8_STAGE(PG8_SA(0, 0), cA, voffA); PG8_STAGE(PG8_SB(0, 1), cB + hstep, voffB); PG8_STAGE(PG8_SA(0, 1), cA + hstep, voffA);
        if (wr == 1) PG8_BAR;
        PG8_WAIT_V(4); PG8_BAR;
        PG8_STAGE(PG8_SB(1, 0), cB + kstep, voffB); PG8_STAGE(PG8_SA(1, 0), cA + kstep, voffA); PG8_STAGE(PG8_SB(1, 1), cB + hstep + kstep, voffB);
        PG8_WAIT_V(6); PG8_BAR;
    }
    for (;;) {
        const bool has_next = S.next(ui + 1, nxt);
        const char* nA = has_next ? (const char*)g.A + (size_t)nxt.pm * tstep : cA; const char* nB = has_next ? (const char*)g.Bt + (size_t)nxt.pn * tstep : cB;
        for (int t = 0; t < nt; t += 2) {
            const bool last = (t == nt - 2);
            const char* a1 = cA + (size_t)(t + 1) * kstep;
            const char* a2 = last ? nA : cA + (size_t)(t + 2) * kstep; const char* b2 = last ? nB : cB + (size_t)(t + 2) * kstep;
            const char* a3 = a2 + kstep; const char* b3 = b2 + kstep;
            if (last && has_next) S.a_ready(nxt);
            if constexpr (SP2) {
            PG8_LDB(B0, 0, 0); PG8_LDB(B1, 0, 1); PG8_SCHED; PG8_LDA(At, 0, 0); PG8_STAGE(PG8_SA(1, 1), a1 + hstep, voffA);
            PG8_WAIT_V(8); PG8_WAIT_L(0); PG8_BAR; PG8_MMA(0, 0, At, B0); PG8_MMA(0, 1, At, B1); PG8_BAR; PG8_SCHED;
            PG8_LDA(At, 0, 1); PG8_STAGE(PG8_SB(0, 0), b2, voffB); PG8_STAGE(PG8_SB(0, 1), b2 + hstep, voffB); PG8_STAGE(PG8_SA(0, 0), a2, voffA);
            PG8_WAIT_V(8); PG8_WAIT_L(0); PG8_BAR; PG8_MMA(1, 0, At, B0); PG8_MMA(1, 1, At, B1); PG8_BAR; PG8_SCHED;
            PG8_LDB(B0, 1, 0); PG8_LDB(B1, 1, 1); PG8_SCHED; PG8_LDA(At, 1, 0); PG8_STAGE(PG8_SA(0, 1), a2 + hstep, voffA);
            PG8_WAIT_V(8); PG8_WAIT_L(0); PG8_BAR; PG8_MMA(0, 0, At, B0); PG8_MMA(0, 1, At, B1); PG8_BAR; PG8_SCHED;
            PG8_LDA(At, 1, 1); PG8_STAGE(PG8_SB(1, 0), b3, voffB); PG8_STAGE(PG8_SB(1, 1), b3 + hstep, voffB); PG8_STAGE(PG8_SA(1, 0), a3, voffA);
            PG8_WAIT_V(8); PG8_WAIT_L(0); PG8_BAR; PG8_MMA(1, 0, At, B0); PG8_MMA(1, 1, At, B1); PG8_BAR; PG8_SCHED;
            } else {
            PG8_LDB(B0, 0, 0); PG8_SCHED; PG8_LDA(At, 0, 0); PG8_STAGE(PG8_SA(1, 1), a1 + hstep, voffA);
            PG8_WAIT_L(8); PG8_BAR; PG8_WAIT_L(0); PG8_MMA(0, 0, At, B0); PG8_BAR; PG8_SCHED;
            PG8_LDB(B1, 0, 1); PG8_STAGE(PG8_SB(0, 0), b2, voffB);
            PG8_BAR; PG8_WAIT_L(0); PG8_MMA(0, 1, At, B1); PG8_BAR;
            PG8_LDA(At, 0, 1); PG8_STAGE(PG8_SA(0, 0), a2, voffA);
            PG8_BAR; PG8_WAIT_L(0); PG8_MMA(1, 0, At, B0); PG8_BAR; PG8_SCHED;
            PG8_STAGE(PG8_SB(0, 1), b2 + hstep, voffB);
            PG8_WAIT_V(6); PG8_BAR; PG8_MMA(1, 1, At, B1); PG8_BAR;
            PG8_LDB(B0, 1, 0); PG8_SCHED; PG8_LDA(At, 1, 0); PG8_STAGE(PG8_SA(0, 1), a2 + hstep, voffA);
            PG8_WAIT_L(8); PG8_BAR; PG8_WAIT_L(0); PG8_MMA(0, 0, At, B0); PG8_BAR; PG8_SCHED;
            PG8_LDB(B1, 1, 1); PG8_STAGE(PG8_SB(1, 0), b3, voffB);
            PG8_BAR; PG8_WAIT_L(0); PG8_MMA(0, 1, At, B1); PG8_BAR;
            PG8_LDA(At, 1, 1); PG8_STAGE(PG8_SA(1, 0), a3, voffA);
            PG8_BAR; PG8_WAIT_L(0); PG8_MMA(1, 0, At, B0); PG8_BAR; PG8_SCHED;
            PG8_STAGE(PG8_SB(1, 1), b3 + hstep, voffB);
            PG8_WAIT_V(6); PG8_BAR; PG8_MMA(1, 1, At, B1); PG8_BAR;
            }
        }
        if constexpr (ALIGN_EPI) { if (wr == 0) PG8_BAR; }
        if constexpr (!Epi::AFTER_DRAIN) { E(acc, cur, wr, wc, fr, fq); S.done(cur); }
        if (!has_next) break;
#pragma unroll
        for (int a = 0; a < 2; ++a)
#pragma unroll
            for (int b = 0; b < 2; ++b)
#pragma unroll
                for (int m = 0; m < 4; ++m)
#pragma unroll
                    for (int n = 0; n < 2; ++n) acc[a][b][m][n] = (f32x4){0.f, 0.f, 0.f, 0.f};
        cur = nxt; cA = nA; cB = nB; ++ui;
        if constexpr (ALIGN_EPI) { if (wr == 1) PG8_BAR; }
    }
    PG8_WAIT_V(0);
    if constexpr (!ALIGN_EPI) { if (wr == 0) PG8_BAR; }
    PG8_BAR;
    if constexpr (Epi::AFTER_DRAIN) { E.fused(acc, cur, wr, wc, fr, fq, lds, wid, lane); S.done(cur); }
#undef PG8_SA
#undef PG8_SB
#undef PG8_STAGE
#undef PG8_LDA
#undef PG8_LDB
#undef PG8_MMA
#undef PG8_WAIT_V
#undef PG8_WAIT_L
#undef PG8_BAR
#undef PG8_SCHED
}
}
extern __shared__ __attribute__((aligned(16))) unsigned char g_lds[];
using pg8::bf16_t; using pg8::bf16x8; using pg8::f32x4; using pg8::u32x4; using pg8::cvt_pk_bf16; using pg8::bflo; using pg8::bfhi; using pg8::sigm;

constexpr int NTOK = 32768, DM = 1024, SEQ = 2048, NB = 16, ZLD = 5120, NTHR = 512;
constexpr int C_R = 0, C_K = 512, C_V = 1024, C_WD = 1536, C_AD = 1600, C_GD = 1664;
constexpr int C_Q = 1824, C_KA = 2336, C_VA = 2400, C_QI = 2464, C_KI = 2976, C_WI = 3040, C_G0 = 3048, C_G1 = 4072;
constexpr size_t MiB = 1024 * 1024;
constexpr size_t WS_SS1 = 0, WS_SS2 = 128 * 1024, WS_BONUS = 256 * 1024, WS_ROPE = 1280 * 1024, WS_WD = 1792 * 1024, WS_WI = 1856 * 1024, WS_WG = 1920 * 1024;
constexpr size_t WS_WIN = 4 * MiB, WS_WUP = 14 * MiB, WS_WDN = 22 * MiB, WS_WB = 30 * MiB, WS_WO = 32 * MiB, WS_VT = 34 * MiB, WS_H = 38 * MiB, WS_Z = 102 * MiB, WS_P = 422 * MiB, WS_END = 486 * MiB;
constexpr int LDS_BYTES = 131072 + 64;

struct Args { const float* in[20]; float* out; unsigned char* ws; int ph_lo, ph_hi; };

struct Frame {
    const float* in[20]; float* out; unsigned char* ws; unsigned char* lds; int tid, lane, wave;
    float *ss1, *ss2, *bonus; float2* rope; bf16_t *wd, *wi, *wg, *win, *wup, *wdn, *wb, *wo, *vt, *h, *ya, *yb, *xb, *z, *hid, *lw, *ic, *mg, *gt; float* yraw;
};

__device__ __forceinline__ bf16_t f2bf(float f) { return (bf16_t)(cvt_pk_bf16(f, 0.f) & 0xffffu); }
__device__ __forceinline__ float bf2f(bf16_t b) { return __uint_as_float(((unsigned)b) << 16); }
template <int CTRL> __device__ __forceinline__ float dpp_mov(float x) { return __int_as_float(__builtin_amdgcn_update_dpp(0, __float_as_int(x), CTRL, 0xF, 0xF, true)); }
__device__ __forceinline__ float red16(float x) { x += dpp_mov<0xB1>(x); x += dpp_mov<0x4E>(x); x += dpp_mov<0x141>(x); x += dpp_mov<0x140>(x); return x; }


__device__ __forceinline__ void lds_barrier() { asm volatile("s_waitcnt lgkmcnt(0)" ::: "memory"); __builtin_amdgcn_s_barrier(); asm volatile("" ::: "memory"); }
__device__ __forceinline__ void red16x4(float& a, float& b, float& c, float& d) {
#define DPP4(ctl) "v_add_f32_dpp %0, %0, %0 " ctl " row_mask:0xf bank_mask:0xf bound_ctrl:1\n" "v_add_f32_dpp %1, %1, %1 " ctl " row_mask:0xf bank_mask:0xf bound_ctrl:1\n" \
                  "v_add_f32_dpp %2, %2, %2 " ctl " row_mask:0xf bank_mask:0xf bound_ctrl:1\n" "v_add_f32_dpp %3, %3, %3 " ctl " row_mask:0xf bank_mask:0xf bound_ctrl:1\n"
    asm volatile("s_nop 1\n" DPP4("quad_perm:[1,0,3,2]") DPP4("quad_perm:[2,3,0,1]") DPP4("row_half_mirror") DPP4("row_mirror") : "+v"(a), "+v"(b), "+v"(c), "+v"(d));
#undef DPP4
}
__device__ __forceinline__ float red32(float x) { x += __shfl_xor(x, 1); x += __shfl_xor(x, 2); x += __shfl_xor(x, 4); x += __shfl_xor(x, 8); x += __shfl_xor(x, 16); return x; }
__device__ __forceinline__ float red64(float x) { x = red32(x); x += __shfl_xor(x, 32); return x; }
__device__ __forceinline__ float softplus_f(float x) { return fmaxf(x, 0.f) + log1pf(__expf(-fabsf(x))); }

__device__ void tconv(const Frame& F, const float* __restrict__ W, int K, int N, int Npad, bf16_t* __restrict__ Wt, const float* __restrict__ rs) {
    float* tile = (float*)g_lds;
    const int ktn = (K + 63) / 64, ntn = Npad / 64, tid = F.tid;
    for (int tl = blockIdx.x; tl < ktn * ntn; tl += gridDim.x) {
        const int kt = tl % ktn, nt = tl / ktn;
#pragma unroll
        for (int i = 0; i < 2; ++i) { const int idx = tid + i * NTHR, kk = idx >> 4, n4 = (idx & 15) * 4, k = kt * 64 + kk, n = nt * 64 + n4;
            f32x4 v = {0.f, 0.f, 0.f, 0.f};
            if (k < K) { if (n + 3 < N) v = *(const f32x4*)(W + (size_t)k * N + n); else { for (int j = 0; j < 4; ++j) if (n + j < N) v[j] = W[(size_t)k * N + n + j]; }
                if (rs != nullptr) { const float r = rs[k]; v[0] *= r; v[1] *= r; v[2] *= r; v[3] *= r; } }
            tile[kk * 65 + n4] = v[0]; tile[kk * 65 + n4 + 1] = v[1]; tile[kk * 65 + n4 + 2] = v[2]; tile[kk * 65 + n4 + 3] = v[3]; }
        __syncthreads();
        { const int nn = tid >> 3, k8 = (tid & 7) * 8, k = kt * 64 + k8, n = nt * 64 + nn;
          if (k < K) { u32x4 w; const float* tp = tile + k8 * 65 + nn;
              w.x = cvt_pk_bf16(tp[0], tp[65]); w.y = cvt_pk_bf16(tp[130], tp[195]); w.z = cvt_pk_bf16(tp[260], tp[325]); w.w = cvt_pk_bf16(tp[390], tp[455]);
              *(u32x4*)(Wt + (size_t)n * K + k) = w; } }
        __syncthreads();
    }
}
__device__ void p0_prologue(const Frame& F) {
    const int tid = F.tid, gtid = blockIdx.x * NTHR + tid, gn = gridDim.x * NTHR;
    for (int i = gtid; i < 2 * NTOK; i += gn) F.ss1[i] = 0.f;
    for (int i = gtid; i < SEQ * 32; i += gn) { const int pos = i >> 5, j = i & 31;
        const float inv = 1.0f / powf(10000.0f, (float)(2 * j) / 64.0f); const float ang = (float)pos * inv;
        double rev = (double)ang * 0.15915494309189535; rev -= floor(rev); const float fr = (float)rev;
        F.rope[i] = make_float2(__builtin_amdgcn_cosf(fr), __builtin_amdgcn_sinf(fr)); }
    tconv(F, F.in[2], 1024, 5096, 5120, F.win, nullptr);
    tconv(F, F.in[17], 1024, 4096, 4096, F.wup, F.in[16]);
    tconv(F, F.in[18], 4096, 1024, 1024, F.wdn, nullptr);
    tconv(F, F.in[14], 512, 1024, 1024, F.wb, nullptr);
    tconv(F, F.in[14] + 512 * 1024, 512, 1024, 1024, F.wb + 1024 * 512, nullptr);
    tconv(F, F.in[15], 1024, 1024, 1024, F.wo, nullptr);
    tconv(F, F.in[5], 64, 512, 512, F.wd, nullptr);
    tconv(F, F.in[7], 64, 512, 512, F.wi, nullptr);
    tconv(F, F.in[8], 160, 512, 512, F.wg, nullptr);
    const float* x = F.in[0]; const float* g = F.in[1]; const int lane = F.lane;
    for (int row = blockIdx.x * 8 + F.wave; row < NTOK; row += gridDim.x * 8) {
        const float* xr = x + (size_t)row * DM; f32x4 v[4]; float ss = 0.f;
#pragma unroll
        for (int i = 0; i < 4; ++i) { v[i] = *(const f32x4*)(xr + i * 256 + lane * 4); ss += v[i][0] * v[i][0] + v[i][1] * v[i][1] + v[i][2] * v[i][2] + v[i][3] * v[i][3]; }
        ss = red64(ss); const float sc = rsqrtf(ss * (1.0f / 1024.0f) + 1e-6f);
#pragma unroll
        for (int i = 0; i < 4; ++i) { const f32x4 gg = *(const f32x4*)(g + i * 256 + lane * 4); uint2 w;
            w.x = cvt_pk_bf16(v[i][0] * sc * gg[0], v[i][1] * sc * gg[1]); w.y = cvt_pk_bf16(v[i][2] * sc * gg[2], v[i][3] * sc * gg[3]);
            *(uint2*)(F.h + (size_t)row * DM + i * 256 + lane * 4) = w; }
    }
}

__device__ void p2_prep(const Frame& F, const int mode) {
    const int tid = F.tid, lane = F.lane, wave = F.wave, fr = lane & 15, fq = lane >> 4;
    bf16_t* z = F.z; const float* mu = F.in[3];
    if (mode != 2) {
        constexpr int LDA = 296, TT = 32; bf16_t* At = (bf16_t*)g_lds;
        bf16_t* Ot = At + TT * LDA;
        const float* dbias = F.in[4]; const float* ibias = F.in[6];
        for (int tile = blockIdx.x; tile < NTOK / TT; tile += gridDim.x) {
            const int t0 = tile * TT;
            for (int idx = tid; idx < TT * 36; idx += NTHR) { const int tok = idx / 36, c8 = (idx - tok * 36) * 8, t = t0 + tok, col = C_WD + c8;
                const u32x4 zc = *(const u32x4*)(z + (size_t)t * ZLD + col); u32x4 zp = {0u, 0u, 0u, 0u}; if (t & (SEQ - 1)) zp = *(const u32x4*)(z + (size_t)(t - 1) * ZLD + col);
                const f32x4 m0 = *(const f32x4*)(mu + col), m1 = *(const f32x4*)(mu + col + 4);
                float v[8]; const unsigned zcu[4] = {zc.x, zc.y, zc.z, zc.w}, zpu[4] = {zp.x, zp.y, zp.z, zp.w};
#pragma unroll
                for (int j = 0; j < 4; ++j) { const float a = bflo(zcu[j]), b2 = bfhi(zcu[j]), pa = bflo(zpu[j]), pb = bfhi(zpu[j]);
                    const float mm0 = (j < 2) ? m0[2 * j] : m1[2 * j - 4], mm1 = (j < 2) ? m0[2 * j + 1] : m1[2 * j - 3];
                    v[2 * j] = a + (pa - a) * mm0; v[2 * j + 1] = b2 + (pb - b2) * mm1; }
                if (c8 < 64) {
#pragma unroll
                    for (int j = 0; j < 8; ++j) v[j] = tanhf(v[j]); }
                else if (c8 >= 128) {
#pragma unroll
                    for (int j = 0; j < 8; ++j) v[j] = sigm(v[j]); }
                u32x4 w; w.x = cvt_pk_bf16(v[0], v[1]); w.y = cvt_pk_bf16(v[2], v[3]); w.z = cvt_pk_bf16(v[4], v[5]); w.w = cvt_pk_bf16(v[6], v[7]);
                *(u32x4*)(At + tok * LDA + c8) = w; }
            __syncthreads();
            const int h = wave;
            bf16x8 Bc[9], Bn[9];
            { const int n = h * 64 + fr;
#pragma unroll
              for (int ks = 0; ks < 2; ++ks) { Bc[ks] = *(const bf16x8*)(F.wd + n * 64 + ks * 32 + fq * 8); Bc[2 + ks] = *(const bf16x8*)(F.wi + n * 64 + ks * 32 + fq * 8); }
#pragma unroll
              for (int ks = 0; ks < 5; ++ks) Bc[4 + ks] = *(const bf16x8*)(F.wg + n * 160 + ks * 32 + fq * 8); }
#pragma unroll 1
            for (int j = 0; j < 4; ++j) { const int n = h * 64 + j * 16 + fr;
                if (j < 3) { const int nn = n + 16;
#pragma unroll
                    for (int ks = 0; ks < 2; ++ks) { Bn[ks] = *(const bf16x8*)(F.wd + nn * 64 + ks * 32 + fq * 8); Bn[2 + ks] = *(const bf16x8*)(F.wi + nn * 64 + ks * 32 + fq * 8); }
#pragma unroll
                    for (int ks = 0; ks < 5; ++ks) Bn[4 + ks] = *(const bf16x8*)(F.wg + nn * 160 + ks * 32 + fq * 8); }
                const float db = dbias[n], ib = ibias[n];
#pragma unroll
                for (int mt = 0; mt < 2; ++mt) {
                    f32x4 ad = {0.f, 0.f, 0.f, 0.f}, ai = ad, ag = ad; const bf16_t* ap = At + (mt * 16 + fr) * LDA + fq * 8;
#pragma unroll
                    for (int ks = 0; ks < 2; ++ks) ad = __builtin_amdgcn_mfma_f32_16x16x32_bf16(*(const bf16x8*)(ap + ks * 32), Bc[ks], ad, 0, 0, 0);
#pragma unroll
                    for (int ks = 0; ks < 2; ++ks) ai = __builtin_amdgcn_mfma_f32_16x16x32_bf16(*(const bf16x8*)(ap + 64 + ks * 32), Bc[2 + ks], ai, 0, 0, 0);
#pragma unroll
                    for (int ks = 0; ks < 5; ++ks) ag = __builtin_amdgcn_mfma_f32_16x16x32_bf16(*(const bf16x8*)(ap + 128 + ks * 32), Bc[4 + ks], ag, 0, 0, 0);
#pragma unroll
                    for (int jj = 0; jj < 4; ++jj) {
                        const float dw = db + ad[jj]; const float wlog = -softplus_f(-dw) - 0.5f; const float lwv = -__expf(wlog);
                        const int tk = mt * 16 + fq * 4 + jj; Ot[tk * 520 + n] = f2bf(lwv); Ot[(TT + tk) * 520 + n] = f2bf(sigm(ib + ai[jj])); Ot[(2 * TT + tk) * 520 + n] = f2bf(ag[jj]); }
                }
#pragma unroll
                for (int q = 0; q < 9; ++q) Bc[q] = Bn[q];
            }
            __syncthreads();
#pragma unroll
            for (int i = 0; i < 12; ++i) { const int idx = tid + i * NTHR, arr = idx >> 11, rem = idx & 2047, tk = rem >> 6, c8 = (rem & 63) * 8;
                const u32x4 w = *(const u32x4*)(Ot + (arr * TT + tk) * 520 + c8); bf16_t* dst = arr == 0 ? F.lw : (arr == 1 ? F.ic : F.gt);
                *(u32x4*)(dst + (size_t)(t0 + tk) * 512 + c8) = w; }
            __syncthreads();
        }
    }
    if (mode != 2) {
        unsigned short* tl = (unsigned short*)g_lds;
        for (int tile = blockIdx.x; tile < NTOK / 64; tile += gridDim.x) { const int t0 = tile * 64, b = t0 / SEQ, tt0 = t0 % SEQ;
#pragma unroll
            for (int i = 0; i < 8; ++i) { const int idx = tid + i * NTHR, tok = idx >> 6, d = idx & 63; tl[tok * 66 + d] = z[(size_t)(t0 + tok) * ZLD + C_VA + d]; }
            __syncthreads();
#pragma unroll
            for (int i = 0; i < 8; ++i) { const int idx = tid + i * NTHR, d = idx >> 6, tok = idx & 63; F.vt[((size_t)b * 64 + d) * SEQ + tt0 + tok] = tl[tok * 66 + d]; }
            __syncthreads();
        }
    }
    if (mode != 0) {
        const int gtid = blockIdx.x * NTHR + tid, gn = gridDim.x * NTHR;
        for (int idx = gtid; idx < NTOK * 144; idx += gn) { const int t = idx / 144, p = idx - t * 144, hd = p >> 3, i4 = (p & 7) * 4;
            const int base = hd < 8 ? C_Q + hd * 64 : (hd == 8 ? C_KA : (hd < 17 ? C_QI + (hd - 9) * 64 : C_KI));
            f32x4 cs0 = *(const f32x4*)(&F.rope[(t & (SEQ - 1)) * 32 + i4]), cs1 = *(const f32x4*)(&F.rope[(t & (SEQ - 1)) * 32 + i4 + 2]);
            if (mode == 2) { cs0 = (f32x4){1.f, 0.f, 1.f, 0.f}; cs1 = cs0; }
            bf16_t* p1 = z + (size_t)t * ZLD + base + i4; const uint2 a = *(const uint2*)(p1), b2 = *(const uint2*)(p1 + 32);
            const float x10 = bflo(a.x), x11 = bfhi(a.x), x12 = bflo(a.y), x13 = bfhi(a.y), x20 = bflo(b2.x), x21 = bfhi(b2.x), x22 = bflo(b2.y), x23 = bfhi(b2.y);
            uint2 o1, o2;
            o1.x = cvt_pk_bf16(x10 * cs0[0] - x20 * cs0[1], x11 * cs0[2] - x21 * cs0[3]); o1.y = cvt_pk_bf16(x12 * cs1[0] - x22 * cs1[1], x13 * cs1[2] - x23 * cs1[3]);
            o2.x = cvt_pk_bf16(x20 * cs0[0] + x10 * cs0[1], x21 * cs0[2] + x11 * cs0[3]); o2.y = cvt_pk_bf16(x22 * cs1[0] + x12 * cs1[1], x23 * cs1[2] + x13 * cs1[3]);
            *(uint2*)(p1) = o1; *(uint2*)(p1 + 32) = o2; }
    }
}

struct ScanRaw { uint2 zr_c, zr_p, zk_c, zk_p, zv_c, zv_p, lwu, icu; };
struct ScanConst { f32x4 mur, muk, muv, kk, ka, rk; };
__device__ __forceinline__ void scan_load(ScanRaw& R, const bf16_t* z, const bf16_t* lw, const bf16_t* ic, size_t tokbase, int ch, int ptok, int gc) {
    const int t = ch * 16 + ptok; const size_t T = tokbase + t; const bf16_t* zp = z + T * ZLD + gc;
    R.zr_c = *(const uint2*)(zp + C_R); R.zk_c = *(const uint2*)(zp + C_K); R.zv_c = *(const uint2*)(zp + C_V);
    const uint2 zz = make_uint2(0u, 0u);
    if (t > 0) { R.zr_p = *(const uint2*)(zp - ZLD + C_R); R.zk_p = *(const uint2*)(zp - ZLD + C_K); R.zv_p = *(const uint2*)(zp - ZLD + C_V); } else { R.zr_p = zz; R.zk_p = zz; R.zv_p = zz; }
    R.lwu = *(const uint2*)(lw + T * 512 + gc); R.icu = *(const uint2*)(ic + T * 512 + gc);
}
__device__ __forceinline__ f32x4 unpack4(uint2 u) { f32x4 r; r[0] = bflo(u.x); r[1] = bfhi(u.x); r[2] = bflo(u.y); r[3] = bfhi(u.y); return r; }
__device__ __forceinline__ void scan_prep(const ScanRaw& R, const ScanConst& C, float* ops, float* vv, float* bonus_out, bool wr_bonus, int ptok, int pc, int v0) {
    const f32x4 rc = unpack4(R.zr_c), rp = unpack4(R.zr_p), kc = unpack4(R.zk_c), kp = unpack4(R.zk_p), vc = unpack4(R.zv_c), vp = unpack4(R.zv_p), ic = unpack4(R.icu), lw = unpack4(R.lwu);
    const f32x4 r = rc + (rp - rc) * C.mur, k = kc + (kp - kc) * C.muk, vs = vc + (vp - vc) * C.muv;
    f32x4 w; w[0] = __expf(lw[0]); w[1] = __expf(lw[1]); w[2] = __expf(lw[2]); w[3] = __expf(lw[3]);
    const f32x4 q = k * C.kk; const float ss = red16((q[0] * q[0] + q[1] * q[1]) + (q[2] * q[2] + q[3] * q[3]));
    const float inv = 1.0f / fmaxf(sqrtf(ss), 1e-12f); const f32x4 n = q * inv;
    const f32x4 kn = k * (1.0f + (ic - 1.0f) * C.ka);
    const f32x4 bt = r * kn * C.rk; const float bon = red16((bt[0] + bt[1]) + (bt[2] + bt[3]));
    if (wr_bonus) *bonus_out = bon;
    float* op = ops + ptok * 320 + pc;
    *(f32x4*)(op) = -n; *(f32x4*)(op + 64) = w; *(f32x4*)(op + 128) = n * ic; *(f32x4*)(op + 192) = kn; *(f32x4*)(op + 256) = r;
    if (pc >= v0 && pc < v0 + 32) *(f32x4*)(vv + ptok * 32 + pc - v0) = vs;
}
__device__ void p3_scan(const Frame& F, const int mode) {
    const int tid = F.tid;
    float* opsb = (float*)g_lds;
    float* vvb = opsb + 2 * 5120;
    float* yob = vvb + 2 * 512;
    const bf16_t* z = F.z; const float* mu = F.in[3]; const float* k_k = F.in[9]; const float* k_a = F.in[10]; const float* r_k = F.in[11];
    for (int item = blockIdx.x; item < 256; item += gridDim.x) {
        const int bh = item >> 1, half = item & 1, b = bh >> 3, h = bh & 7, v0 = half * 32;
        const size_t tokbase = (size_t)b * SEQ;
        if (F.wave >= 4) {
            const int pt = tid - 256, ptok = pt >> 4, pc = (pt & 15) * 4, gc = h * 64 + pc;
            ScanConst C; C.mur = *(const f32x4*)(mu + C_R + gc); C.muk = *(const f32x4*)(mu + C_K + gc); C.muv = *(const f32x4*)(mu + C_V + gc);
            C.kk = *(const f32x4*)(k_k + gc); C.ka = *(const f32x4*)(k_a + gc); C.rk = *(const f32x4*)(r_k + gc);
            const bool wrb = (half == 0) && ((pt & 15) == 0);
            ScanRaw R;
            scan_load(R, z, F.lw, F.ic, tokbase, 0, ptok, gc);
            scan_prep(R, C, opsb, vvb, F.bonus + (tokbase + ptok) * 8 + h, wrb, ptok, pc, v0);
            scan_load(R, z, F.lw, F.ic, tokbase, 1, ptok, gc);
            lds_barrier();
            for (int ch = 0; ch < SEQ / 16; ++ch) {
                const int cur = ch & 1, nxt = cur ^ 1;
                if (mode != 2) {
                if (ch > 0) { const int tok = pt >> 4, r2 = (pt & 15) * 2;
                    *(float2*)(F.yraw + (tokbase + (ch - 1) * 16 + tok) * 512 + h * 64 + v0 + r2) = *(const float2*)(yob + nxt * 512 + tok * 32 + r2); }
                if (ch + 1 < SEQ / 16) {
                    scan_prep(R, C, opsb + nxt * 5120, vvb + nxt * 512, F.bonus + (tokbase + (ch + 1) * 16 + ptok) * 8 + h, wrb, ptok, pc, v0);
                    if (ch + 2 < SEQ / 16) scan_load(R, z, F.lw, F.ic, tokbase, ch + 2, ptok, gc);
                } }
                lds_barrier();
            }
            { const int tok = pt >> 4, r2 = (pt & 15) * 2;
              *(float2*)(F.yraw + (tokbase + (SEQ / 16 - 1) * 16 + tok) * 512 + h * 64 + v0 + r2) = *(const float2*)(yob + 512 + tok * 32 + r2); }
        } else {
            const int rp = tid >> 4, ks = tid & 15;
            float A0 = 0.f, A1 = 0.f, A2 = 0.f, A3 = 0.f, B0 = 0.f, B1 = 0.f, B2 = 0.f, B3 = 0.f;
            const int ywoff = (ks == 0) ? 2 * rp : (2 * 512 + 2 * tid), ywstep = (ks == 0) ? 32 : 0;
            lds_barrier();
            f32x4 rprev = {0.f, 0.f, 0.f, 0.f}; float* ywp = yob + 2 * 512 + 2 * tid;
            for (int ch = 0; ch < SEQ / 16; ++ch) {
                const int cur = ch & 1;
                const float* ops = opsb + cur * 5120 + ks * 4; const float* vv = vvb + cur * 512 + 2 * rp; float* yw = yob + cur * 512 + ywoff;
                if (mode != 1) {
#pragma unroll
                for (int s = 0; s < 16; ++s) {
                    const float* o = ops + s * 320;
                    const f32x4 a4 = *(const f32x4*)(o), w4 = *(const f32x4*)(o + 64), b4 = *(const f32x4*)(o + 128), k4 = *(const f32x4*)(o + 192), r4 = *(const f32x4*)(o + 256);
                    const float2 vab = *(const float2*)(vv + s * 32);
                    float sa = (A0 * a4[0] + A1 * a4[1]) + (A2 * a4[2] + A3 * a4[3]); float sb = (B0 * a4[0] + B1 * a4[1]) + (B2 * a4[2] + B3 * a4[3]);
                    float ya = (A0 * rprev[0] + A1 * rprev[1]) + (A2 * rprev[2] + A3 * rprev[3]); float yb2 = (B0 * rprev[0] + B1 * rprev[1]) + (B2 * rprev[2] + B3 * rprev[3]);
                    red16x4(sa, sb, ya, yb2);
                    *(float2*)(ywp) = make_float2(ya, yb2);
                    ywp = yw + s * ywstep;
                    A0 = A0 * w4[0] + sa * b4[0] + vab.x * k4[0]; A1 = A1 * w4[1] + sa * b4[1] + vab.x * k4[1];
                    A2 = A2 * w4[2] + sa * b4[2] + vab.x * k4[2]; A3 = A3 * w4[3] + sa * b4[3] + vab.x * k4[3];
                    B0 = B0 * w4[0] + sb * b4[0] + vab.y * k4[0]; B1 = B1 * w4[1] + sb * b4[1] + vab.y * k4[1];
                    B2 = B2 * w4[2] + sb * b4[2] + vab.y * k4[2]; B3 = B3 * w4[3] + sb * b4[3] + vab.y * k4[3];
                    rprev = r4;
                }
                {
                    float ya = (A0 * rprev[0] + A1 * rprev[1]) + (A2 * rprev[2] + A3 * rprev[3]); float yb2 = (B0 * rprev[0] + B1 * rprev[1]) + (B2 * rprev[2] + B3 * rprev[3]);
                    float d0 = 0.f, d1 = 0.f; red16x4(ya, yb2, d0, d1);
                    *(float2*)(ywp) = make_float2(ya, yb2); ywp = yob + 2 * 512 + 2 * tid; rprev = (f32x4){0.f, 0.f, 0.f, 0.f};
                } }
                lds_barrier();
            }
        }
        __syncthreads();
    }
}

__device__ __forceinline__ unsigned ordkey(float f) { const unsigned u = __float_as_uint(f); return (u & 0x80000000u) ? ~u : (u | 0x80000000u); }

__device__ __forceinline__ void attn_chunk(const unsigned char* kb, const unsigned char* vb, const unsigned* selm, int c, int fr, int fq, const bf16x8 (&Bqa)[2], f32x4 (&O)[4], f32x4& RS) {
    const f32x4 zero4 = {0.f, 0.f, 0.f, 0.f};
    const u32x4 onesu = {0x3f803f80u, 0x3f803f80u, 0x3f803f80u, 0x3f803f80u}; const bf16x8 ones = __builtin_bit_cast(bf16x8, onesu);
    const float csc = 0.125f * 1.4426950408889634f;
#pragma unroll
    for (int p = 0; p < 2; ++p) {
        const unsigned char* k0p = kb + ((2 * p) * 16 + fr) * 144 + fq * 16; const unsigned char* k1p = k0p + 16 * 144;
        const bf16x8 KA00 = *(const bf16x8*)(k0p), KA01 = *(const bf16x8*)(k0p + 64), KA10 = *(const bf16x8*)(k1p), KA11 = *(const bf16x8*)(k1p + 64);
        const int mw = (int)selm[fr * 64 + 2 * c + p];
        f32x4 s0 = __builtin_amdgcn_mfma_f32_16x16x32_bf16(KA00, Bqa[0], zero4, 0, 0, 0); s0 = __builtin_amdgcn_mfma_f32_16x16x32_bf16(KA01, Bqa[1], s0, 0, 0, 0);
        f32x4 s1 = __builtin_amdgcn_mfma_f32_16x16x32_bf16(KA10, Bqa[0], zero4, 0, 0, 0); s1 = __builtin_amdgcn_mfma_f32_16x16x32_bf16(KA11, Bqa[1], s1, 0, 0, 0);
        unsigned p0[4], p1[4];
#pragma unroll
        for (int jj = 0; jj < 4; ++jj) {
            const unsigned k0 = (unsigned)__builtin_amdgcn_sbfe(mw, fq * 4 + jj, 1), k1 = (unsigned)__builtin_amdgcn_sbfe(mw, 16 + fq * 4 + jj, 1);
            p0[jj] = __float_as_uint(__builtin_amdgcn_exp2f(fminf(s0[jj] * csc, 86.f))) & k0; p1[jj] = __float_as_uint(__builtin_amdgcn_exp2f(fminf(s1[jj] * csc, 86.f))) & k1; }
        u32x4 pk; pk.x = cvt_pk_bf16(__uint_as_float(p0[0]), __uint_as_float(p0[1])); pk.y = cvt_pk_bf16(__uint_as_float(p0[2]), __uint_as_float(p0[3]));
        pk.z = cvt_pk_bf16(__uint_as_float(p1[0]), __uint_as_float(p1[1])); pk.w = cvt_pk_bf16(__uint_as_float(p1[2]), __uint_as_float(p1[3]));
        const bf16x8 PB = __builtin_bit_cast(bf16x8, pk);
        RS = __builtin_amdgcn_mfma_f32_16x16x32_bf16(ones, PB, RS, 0, 0, 0);
#pragma unroll
        for (int dt = 0; dt < 4; ++dt) { const unsigned char* vp = vb + (dt * 16 + fr) * 144 + (2 * p) * 32 + fq * 8;
            const uint2 lo = *(const uint2*)(vp), hi = *(const uint2*)(vp + 32);
            u32x4 va; va.x = lo.x; va.y = lo.y; va.z = hi.x; va.w = hi.y;
            O[dt] = __builtin_amdgcn_mfma_f32_16x16x32_bf16(__builtin_bit_cast(bf16x8, va), PB, O[dt], 0, 0, 0); }
    }
}

__device__ void p3_dsa(const Frame& F) {
    const int tid = F.tid, lane = F.lane, wave = F.wave, fr = lane & 15, fq = lane >> 4;
    unsigned* selm = (unsigned*)g_lds;
    unsigned* eqm = selm + 1024;
    int* cnt = (int*)(eqm + 1024);
    int* eqpre = cnt + 256;
    unsigned char* kbuf = (unsigned char*)(eqpre + 1024);
    unsigned char* vbuf = kbuf + 2 * 9216;
    const bf16_t* z = F.z; const int G = gridDim.x, bx = blockIdx.x;
    const f32x4 zero4 = {0.f, 0.f, 0.f, 0.f};
    for (int rnd = 0; rnd * G < 2048; ++rnd) {
        const int n = rnd * G + ((rnd & 1) ? (G - 1 - bx) : bx);
        if (n >= 2048) continue;
        const int qg = 127 - (n >> 4), b = n & 15, q0 = qg * 16; const size_t Tb = (size_t)b * SEQ;
        for (int i = tid; i < 2048; i += NTHR) selm[i] = 0u;
        __syncthreads();
        const bf16_t* zq = z + (Tb + q0 + fr) * ZLD;
        const unsigned lofk = (unsigned)((fr * ZLD + fq * 8) * 2), lofv = (unsigned)((fr * SEQ + fq * 4) * 2);
        if (qg >= 16) {
            float sacc[16][4];
#pragma unroll
            for (int i = 0; i < 16; ++i)
#pragma unroll
                for (int jj = 0; jj < 4; ++jj) sacc[i][jj] = 0.f;
            const u32x4 wv = *(const u32x4*)(zq + C_WI);
            {
                bf16x8 Bq[8][2];
#pragma unroll
                for (int hh = 0; hh < 8; ++hh)
#pragma unroll
                    for (int ks = 0; ks < 2; ++ks) Bq[hh][ks] = *(const bf16x8*)(zq + C_QI + hh * 64 + ks * 32 + fq * 8);
                const float sc = 0.044194173824159216f;
                float wih[8]; wih[0] = bflo(wv.x) * sc; wih[1] = bfhi(wv.x) * sc; wih[2] = bflo(wv.y) * sc; wih[3] = bfhi(wv.y) * sc; wih[4] = bflo(wv.z) * sc; wih[5] = bfhi(wv.z) * sc; wih[6] = bflo(wv.w) * sc; wih[7] = bfhi(wv.w) * sc;
                bf16x8 W0[2], W1[2];
#pragma unroll
                for (int j = 0; j < 2; ++j) { const int ktj = (wave + 8 * j) < qg ? (wave + 8 * j) : qg; const char* kb = (const char*)(z + (Tb + (size_t)ktj * 16) * ZLD + C_KI);
                    W0[j] = *(const bf16x8*)(kb + lofk); W1[j] = *(const bf16x8*)(kb + lofk + 64); }
#pragma unroll
                for (int i = 0; i < 16; ++i) { const int kt = wave + 8 * i;
                    if (kt <= qg) {
#pragma unroll
                        for (int hh = 0; hh < 8; ++hh) { f32x4 acc = __builtin_amdgcn_mfma_f32_16x16x32_bf16(W0[i & 1], Bq[hh][0], zero4, 0, 0, 0);
                            acc = __builtin_amdgcn_mfma_f32_16x16x32_bf16(W1[i & 1], Bq[hh][1], acc, 0, 0, 0);
#pragma unroll
                            for (int jj = 0; jj < 4; ++jj) sacc[i][jj] += wih[hh] * fmaxf(acc[jj], 0.f); }
                    }
                    if (i + 2 < 16) { const int ktn = (kt + 16) < qg ? (kt + 16) : qg; const char* kb = (const char*)(z + (Tb + (size_t)ktn * 16) * ZLD + C_KI);
                        unsigned lo2 = lofk; asm volatile("" : "+v"(lo2));
                        W0[i & 1] = *(const bf16x8*)(kb + lo2); W1[i & 1] = *(const bf16x8*)(kb + lo2 + 64); }
                }
            }
            unsigned uk[16][4];
#pragma unroll
            for (int i = 0; i < 16; ++i) { const int kt = wave + 8 * i;
#pragma unroll
                for (int jj = 0; jj < 4; ++jj) { const bool masked = (kt > qg) || ((kt == qg) && (fq * 4 + jj > fr)); uk[i][jj] = masked ? 0x007fffffu : ordkey(sacc[i][jj]); } }
            unsigned T = 0u; bool found = false;
#pragma unroll 1
            for (int brep = 0; brep < 1 + REP(12); ++brep) { T = 0u; found = false; __syncthreads();
            for (int bit = 31; bit >= 0; --bit) {
                const unsigned cand = T | (1u << bit); int c = 0;
#pragma unroll
                for (int i = 0; i < 16; ++i) {
#pragma unroll
                    for (int jj = 0; jj < 4; ++jj) c += (uk[i][jj] >= cand) ? 1 : 0;
                    __builtin_amdgcn_sched_barrier(0); }
                c += __shfl_xor(c, 16); c += __shfl_xor(c, 32);
                const int par = bit & 1;
                if (fq == 0) cnt[(par * 8 + wave) * 16 + fr] = c;
                __syncthreads();
                int tot = 0;
#pragma unroll
                for (int w = 0; w < 8; ++w) tot += cnt[(par * 8 + w) * 16 + fr];
                if (!found && tot >= 256) { T = cand; if (tot == 256) found = true; }
                if (__all(found)) break;
            } }
            int need;
            { int c = 0; unsigned Tp = T + 1u; asm volatile("" : "+v"(Tp));
#pragma unroll
              for (int i = 0; i < 16; ++i) {
#pragma unroll
                  for (int jj = 0; jj < 4; ++jj) c += (uk[i][jj] >= Tp) ? 1 : 0;
                  __builtin_amdgcn_sched_barrier(0); }
              c += __shfl_xor(c, 16); c += __shfl_xor(c, 32);
              __syncthreads();
              if (fq == 0) cnt[wave * 16 + fr] = c;
              __syncthreads();
              int tot = 0;
#pragma unroll
              for (int w = 0; w < 8; ++w) tot += cnt[w * 16 + fr];
              need = 256 - tot; }
#pragma unroll
            for (int i = 0; i < 16; ++i) { const int kt = wave + 8 * i; unsigned nib = 0u;
#pragma unroll
                for (int jj = 0; jj < 4; ++jj) nib |= (uk[i][jj] == T) ? (1u << jj) : 0u;
                if (nib) atomicOr(&eqm[fr * 64 + (kt >> 1)], nib << ((kt & 1) * 16 + fq * 4));
                __builtin_amdgcn_sched_barrier(0); }
            __syncthreads();
            unsigned T2 = T; asm volatile("" : "+v"(T2));
            for (int w = tid; w < 1024; w += NTHR) { const int word = w & 63; int sct = 0; for (int j = 0; j < word; ++j) sct += __popc(eqm[w - word + j]); eqpre[w] = sct; }
            __syncthreads();
#pragma unroll
            for (int i = 0; i < 16; ++i) { const int kt = wave + 8 * i; unsigned nib = 0u;
                const int word = kt >> 1, bp0 = (kt & 1) * 16 + fq * 4; const unsigned eqw = eqm[fr * 64 + word]; const int rbase = eqpre[fr * 64 + word];
#pragma unroll
                for (int jj = 0; jj < 4; ++jj) { const int rank = rbase + __popc(eqw & ((1u << (bp0 + jj)) - 1u));
                    const bool sel = (uk[i][jj] > T2) || ((uk[i][jj] == T2) && (rank < need));
                    nib |= sel ? (1u << jj) : 0u; }
                if (nib) atomicOr(&selm[fr * 64 + word], nib << bp0);
                __builtin_amdgcn_sched_barrier(0); }
        } else {
            for (int w = tid; w < 1024; w += NTHR) { const int q = w >> 6, word = w & 63, qpos = q0 + q, lo = word * 32;
                selm[w] = (qpos >= lo + 31) ? 0xffffffffu : (qpos < lo ? 0u : ((2u << (qpos - lo)) - 1u)); }
        }
        __syncthreads();
#pragma unroll 1
        for (int arep = 0; arep < 1 + REP(13); ++arep) {
            const int nchunk = (qg + 4) >> 2; const int lrow = tid >> 3, lseg = tid & 7;
            const bf16_t* kg = z + (Tb + lrow) * ZLD + C_KA + lseg * 8; const bf16_t* vg = F.vt + ((size_t)b * 64 + lrow) * SEQ + lseg * 8;
            const unsigned lst = (unsigned)(lrow * 144 + lseg * 16);
            u32x4 kx = *(const u32x4*)(kg), vx = *(const u32x4*)(vg), ky = kx, vy = vx;
            *(u32x4*)(kbuf + lst) = kx; *(u32x4*)(vbuf + lst) = vx;
            if (1 < nchunk) { kx = *(const u32x4*)(kg + (size_t)64 * ZLD); vx = *(const u32x4*)(vg + 64); }
            if (2 < nchunk) { ky = *(const u32x4*)(kg + (size_t)128 * ZLD); vy = *(const u32x4*)(vg + 128); }
            bf16x8 Bqa[2];
#pragma unroll
            for (int ks = 0; ks < 2; ++ks) Bqa[ks] = *(const bf16x8*)(zq + C_Q + wave * 64 + ks * 32 + fq * 8);
            f32x4 O[4]; f32x4 rs = zero4;
#pragma unroll
            for (int dt = 0; dt < 4; ++dt) O[dt] = zero4;
            lds_barrier();
#pragma unroll 1
            for (int c = 0; c < nchunk; c += 2) {
                attn_chunk(kbuf, vbuf, selm, c, fr, fq, Bqa, O, rs);
                if (c + 1 < nchunk) { *(u32x4*)(kbuf + 9216 + lst) = kx; *(u32x4*)(vbuf + 9216 + lst) = vx; }
                if (c + 3 < nchunk) { kx = *(const u32x4*)(kg + (size_t)(c + 3) * 64 * ZLD); vx = *(const u32x4*)(vg + (c + 3) * 64); }
                lds_barrier();
                if (c + 1 < nchunk) {
                    attn_chunk(kbuf + 9216, vbuf + 9216, selm, c + 1, fr, fq, Bqa, O, rs);
                    if (c + 2 < nchunk) { *(u32x4*)(kbuf + lst) = ky; *(u32x4*)(vbuf + lst) = vy; }
                    if (c + 4 < nchunk) { ky = *(const u32x4*)(kg + (size_t)(c + 4) * 64 * ZLD); vy = *(const u32x4*)(vg + (c + 4) * 64); }
                    lds_barrier();
                }
            }
            const float inv = 1.0f / rs[0];
            bf16_t* yp = F.yb + (Tb + q0 + fr) * 512 + wave * 64 + fq * 4;
#pragma unroll
            for (int dt = 0; dt < 4; ++dt) { uint2 w; w.x = cvt_pk_bf16(O[dt][0] * inv, O[dt][1] * inv); w.y = cvt_pk_bf16(O[dt][2] * inv, O[dt][3] * inv); *(uint2*)(yp + dt * 16) = w; }
        }
        __syncthreads();
    }
}

__device__ void p4_post(const Frame& F) {
    const int tid = F.tid; const float* mu = F.in[3]; const float* gnw = F.in[12]; const float* gnb = F.in[13]; const bf16_t* z = F.z;
    for (int g = blockIdx.x * 16 + (tid >> 5); g < NTOK * 8; g += gridDim.x * 16) { const size_t t = (size_t)(g >> 3); const int h = g & 7, c = h * 64 + (tid & 31) * 2;
        const float2 y = *(const float2*)(F.yraw + t * 512 + c);
        const float mean = red32(y.x + y.y) * (1.0f / 64.0f); const float dx = y.x - mean, dy = y.y - mean;
        const float var = red32(dx * dx + dy * dy) * (1.0f / 64.0f); const float rstd = rsqrtf(var + 64e-5f);
        const unsigned vc = *(const unsigned*)(z + t * ZLD + C_V + c); const unsigned vp = (t & (SEQ - 1)) ? *(const unsigned*)(z + (t - 1) * ZLD + C_V + c) : 0u;
        const float vs0 = bflo(vc) + (bflo(vp) - bflo(vc)) * mu[C_V + c], vs1 = bfhi(vc) + (bfhi(vp) - bfhi(vc)) * mu[C_V + c + 1];
        const float bon = F.bonus[t * 8 + h]; const unsigned gt = *(const unsigned*)(F.gt + t * 512 + c);
        const float o0 = (dx * rstd * gnw[c] + gnb[c] + bon * vs0) * bflo(gt), o1 = (dy * rstd * gnw[c + 1] + gnb[c + 1] + bon * vs1) * bfhi(gt);
        *(unsigned*)(F.ya + t * 512 + c) = cvt_pk_bf16(o0, o1); }
}

__device__ void p9_final(const Frame& F, const bool ident) {
    const float* g = F.in[19]; const int lane = F.lane;
    for (int row = blockIdx.x * 8 + F.wave; row < NTOK; row += gridDim.x * 8) {
        float* xr = F.out + (size_t)row * DM; const float sc = ident ? 1.0f : rsqrtf(F.ss2[row] * (1.0f / 1024.0f) + 1e-6f);
#pragma unroll
        for (int i = 0; i < 4; ++i) { f32x4 v = *(const f32x4*)(xr + i * 256 + lane * 4); const f32x4 gg = *(const f32x4*)(g + i * 256 + lane * 4);
            if (!ident) { v[0] *= sc * gg[0]; v[1] *= sc * gg[1]; v[2] *= sc * gg[2]; v[3] *= sc * gg[3]; } *(f32x4*)(xr + i * 256 + lane * 4) = v; }
    }
}
#define XB_TMO      128
#define XB_XCNT(j)  (256  + 64 * (j))
#define XB_XSUB(j)  (1280 + 64 * (j))
#define XB_XGEN(j)  (2304 + 64 * (j))
#define XB_TOP      3328
#define XB_TOPGEN   3392
#define XCD_BAR_WORDS 3456
#define XB_SPIN_CAP (1u << 18)
#define LAS __attribute__((address_space(3)))

__device__ __forceinline__ unsigned xb_ld(unsigned* p)              { return __hip_atomic_load(p, __ATOMIC_RELAXED, __HIP_MEMORY_SCOPE_AGENT); }
__device__ __forceinline__ unsigned xb_add(unsigned* p, unsigned v) { return __hip_atomic_fetch_add(p, v, __ATOMIC_RELAXED, __HIP_MEMORY_SCOPE_AGENT); }
__device__ __forceinline__ unsigned xb_xcc_id() { return (unsigned)__builtin_amdgcn_s_getreg((3 << 11) | 20) & 0xFu; }
#define XB_SPIN(cond, bar) do { unsigned _sp = 0; while (cond) { __builtin_amdgcn_s_sleep(1); \
    if ((++_sp & 255u) == 0u) { if (xb_ld(&(bar)[XB_TMO])) break; if (_sp > XB_SPIN_CAP) { atomicAdd(&(bar)[XB_TMO], 1u); break; } } } } while (0)

struct XcdBarrier {
    unsigned* bar; unsigned x;
    volatile LAS unsigned* st;
};

__device__ __forceinline__ XcdBarrier xcd_barrier_post(unsigned* bar, volatile LAS unsigned* st) {
    XcdBarrier b; b.bar = bar; b.x = xb_xcc_id(); b.st = st;
    if (threadIdx.x == 0) (void)xb_add(&bar[XB_XCNT(b.x)], 1u);
    return b;
}
__device__ __forceinline__ void xcd_barrier_complete(unsigned* bar, unsigned x, unsigned& nloc, unsigned& nx) {
    const unsigned G = gridDim.x * gridDim.y * gridDim.z;
    unsigned sum, cnt, mine, sp = 0u;
    for (;;) {
        sum = 0u; cnt = 0u; mine = 0u;
#pragma unroll
        for (unsigned j = 0; j < 16; ++j) { const unsigned c = xb_ld(&bar[XB_XCNT(j)]); sum += c; cnt += (c > 0u) ? 1u : 0u; mine = (j == x) ? c : mine; }
        if (sum == G) break;
        __builtin_amdgcn_s_sleep(1);
        if ((++sp & 255u) == 0u) { if (xb_ld(&bar[XB_TMO])) break; if (sp > XB_SPIN_CAP) { atomicAdd(&bar[XB_TMO], 1u); break; } }
    }
    nloc = mine > 0u ? mine : 1u; nx = cnt > 0u ? cnt : 1u;
}

__device__ __forceinline__ void xcd_barrier(const XcdBarrier& b) {
    asm volatile("s_waitcnt vmcnt(0)" ::: "memory");
    __syncthreads();
    if (threadIdx.x == 0) {
        unsigned* bar = b.bar;
        __builtin_amdgcn_s_waitcnt(0);
        unsigned nloc = b.st[0], nx = b.st[1];
        if (nloc == 0u) { xcd_barrier_complete(bar, b.x, nloc, nx); b.st[0] = nloc; b.st[1] = nx; }
        const unsigned old = xb_add(&bar[XB_XSUB(b.x)], 1u);
        const unsigned gen = old / nloc;
        if (old + 1u == (gen + 1u) * nloc) {
            __builtin_amdgcn_fence(__ATOMIC_RELEASE, "agent");
            asm volatile("s_waitcnt vmcnt(0)" ::: "memory");
            const unsigned og = xb_add(&bar[XB_TOP], 1u);
            const unsigned tg = og / nx;
            if (og + 1u == (tg + 1u) * nx) xb_add(&bar[XB_TOPGEN], 1u);
            else XB_SPIN(xb_ld(&bar[XB_TOPGEN]) == tg, bar);
            __builtin_amdgcn_fence(__ATOMIC_ACQUIRE, "agent");
            xb_add(&bar[XB_XGEN(b.x)], 1u);
            asm volatile("s_waitcnt vmcnt(0)" ::: "memory");
        } else {
            XB_SPIN(xb_ld(&bar[XB_XGEN(b.x)]) == gen, bar);
            __builtin_amdgcn_fence(__ATOMIC_ACQUIRE, "agent");
            asm volatile("s_waitcnt vmcnt(0)" ::: "memory");
        }
    }
    __syncthreads();
}
#ifndef PHASE_MASK
#define PHASE_MASK 0x3ff
#endif
#ifndef GEMM_ALIGN
#define GEMM_ALIGN true
#endif
#ifndef GEMM_SP2
#define GEMM_SP2 true
#endif
constexpr int NPHASE = 10;
constexpr size_t WS_BAR = 3 * MiB;
template <class Epi> __device__ __forceinline__ void run_gemm(const bf16_t* A, const bf16_t* Bt, int N, int K, const Epi& E) {
    pg8::Gemm g{A, Bt, NTOK, N, K}; pg8::StaticOrder S; S.init(NTOK, N, (int)gridDim.x, (int)blockIdx.x);
    pg8::gemm_phase<Epi, pg8::StaticOrder, GEMM_ALIGN, GEMM_SP2>((PG8_LAS unsigned char*)g_lds, g, S, E);
}
__global__ void __launch_bounds__(NTHR, 2) mega_fwd(Args args) {
    Frame F;
#pragma unroll
    for (int i = 0; i < 20; ++i) F.in[i] = args.in[i];
    F.out = args.out; F.ws = args.ws; F.lds = nullptr; F.tid = threadIdx.x; F.lane = F.tid & 63; F.wave = __builtin_amdgcn_readfirstlane(F.tid >> 6);
    unsigned char* ws = args.ws;
    F.ss1 = (float*)(ws + WS_SS1); F.ss2 = (float*)(ws + WS_SS2); F.bonus = (float*)(ws + WS_BONUS); F.rope = (float2*)(ws + WS_ROPE);
    F.wd = (bf16_t*)(ws + WS_WD); F.wi = (bf16_t*)(ws + WS_WI); F.wg = (bf16_t*)(ws + WS_WG);
    F.win = (bf16_t*)(ws + WS_WIN); F.wup = (bf16_t*)(ws + WS_WUP); F.wdn = (bf16_t*)(ws + WS_WDN); F.wb = (bf16_t*)(ws + WS_WB); F.wo = (bf16_t*)(ws + WS_WO); F.vt = (bf16_t*)(ws + WS_VT);
    F.h = (bf16_t*)(ws + WS_H); F.ya = F.h; F.yb = F.h + (size_t)NTOK * 512; F.xb = F.h;
    F.z = (bf16_t*)(ws + WS_Z); F.hid = F.z;
    F.lw = (bf16_t*)(ws + WS_P); F.ic = F.lw + (size_t)NTOK * 512; F.mg = F.lw;
    F.yraw = args.out; F.gt = (bf16_t*)(args.out + (size_t)NTOK * 512);
    const int lo = args.ph_lo, hi = args.ph_hi;
    cg::grid_group grid = cg::this_grid();
    if (args.ph_lo < 0) grid.sync();
    volatile LAS unsigned* xst = (volatile LAS unsigned*)(g_lds + 131072);
    if (threadIdx.x == 0) { xst[0] = 0u; xst[1] = 0u; }
    __syncthreads();
    XcdBarrier xbar = xcd_barrier_post((unsigned*)(ws + WS_BAR), xst);
#define IN(k) (lo <= (k) && (k) < hi)
#define SEAM(k) do { if (IN(k) && IN((k) + 1)) { xcd_barrier(xbar); if (REP(17)) xcd_barrier(xbar); } } while (0)
    if (((PHASE_MASK >> 0) & 1) && IN(0)) { p0_prologue(F); __syncthreads(); if (REP(0)) { p0_prologue(F); __syncthreads(); } } SEAM(0);
    if (((PHASE_MASK >> 1) & 1) && IN(1)) { pg8::EpiZ E{F.z, ZLD}; run_gemm(F.h, F.win, 5120, 1024, E); __syncthreads(); if (REP(1)) { run_gemm(F.h, F.win, 5120, 1024, E); __syncthreads(); } if (REP(18)) { run_gemm(F.h, F.win, 4096, 1024, E); __syncthreads(); } } SEAM(1);
    if (((PHASE_MASK >> 2) & 1) && IN(2)) { if (REP(2)) { p2_prep(F, 0); __syncthreads(); } if (REP(16)) { p2_prep(F, 2); __syncthreads(); } p2_prep(F, 1); __syncthreads(); } SEAM(2);
    if (((PHASE_MASK >> 3) & 1) && IN(3)) { if (REP(14)) { p3_scan(F, 1); __syncthreads(); } if (REP(15)) { p3_scan(F, 2); __syncthreads(); } if (REP(3)) { p3_scan(F, 0); __syncthreads(); } p3_scan(F, 0); __syncthreads(); p3_dsa(F); __syncthreads(); if (REP(10)) { p3_dsa(F); __syncthreads(); } } SEAM(3);
    if (((PHASE_MASK >> 4) & 1) && IN(4)) { p4_post(F); __syncthreads(); if (REP(4)) { p4_post(F); __syncthreads(); } } SEAM(4);
    if (((PHASE_MASK >> 5) & 1) && IN(5)) { pg8::EpiGate<0> E0{F.mg, F.z, ZLD, C_G0}; run_gemm(F.ya, F.wb, 1024, 512, E0); __syncthreads();
                 pg8::EpiGate<1> E1{F.mg, F.z, ZLD, C_G1}; run_gemm(F.yb, F.wb + 1024 * 512, 1024, 512, E1); __syncthreads();
                 if (REP(5)) { run_gemm(F.ya, F.wb, 1024, 512, E0); __syncthreads(); run_gemm(F.yb, F.wb + 1024 * 512, 1024, 512, E1); __syncthreads(); } } SEAM(5);
    if (((PHASE_MASK >> 6) & 1) && IN(6)) { if (REP(6)) { pg8::EpiRes1 Ex{F.in[0], F.xb, F.bonus}; run_gemm(F.mg, F.wo, 1024, 1024, Ex); __syncthreads(); }
                 pg8::EpiRes1 E{F.in[0], F.xb, F.ss1}; run_gemm(F.mg, F.wo, 1024, 1024, E); __syncthreads(); } SEAM(6);
    if (((PHASE_MASK >> 7) & 1) && IN(7)) { pg8::EpiHid E{F.hid, F.ss1}; run_gemm(F.xb, F.wup, 4096, 1024, E); __syncthreads(); if (REP(7)) { run_gemm(F.xb, F.wup, 4096, 1024, E); __syncthreads(); } } SEAM(7);
    if (((PHASE_MASK >> 8) & 1) && IN(8)) { pg8::EpiRes2 E{F.xb, F.out, F.ss2}; run_gemm(F.hid, F.wdn, 1024, 4096, E); __syncthreads(); } SEAM(8);
    if (((PHASE_MASK >> 9) & 1) && IN(9)) { if (REP(9)) { p9_final(F, true); __syncthreads(); } p9_final(F, false); }
#undef IN
#undef SEAM
}

extern "C" void kernel_launch(void* const* d_in, const int* in_sizes, int n_in, void* d_out, int out_size, void* d_ws, size_t ws_size, hipStream_t stream) {
    static int grid = 0;
    if (grid == 0) {
        if (n_in != 20 || out_size != NTOK * DM || ws_size < WS_END) { fprintf(stderr, "kernel_launch: unexpected shapes (n_in %d, out %d, ws %zu < %zu)\n", n_in, out_size, ws_size, (size_t)WS_END); grid = -1; return; }
        int dev = 0, cus = 0, per_cu = 0;
        hipGetDevice(&dev); hipDeviceGetAttribute(&cus, hipDeviceAttributeMultiprocessorCount, dev);
        if (hipFuncSetAttribute((const void*)mega_fwd, hipFuncAttributeMaxDynamicSharedMemorySize, LDS_BYTES) != hipSuccess) { fprintf(stderr, "kernel_launch: hipFuncSetAttribute failed\n"); grid = -1; return; }
        if (hipOccupancyMaxActiveBlocksPerMultiprocessor(&per_cu, (const void*)mega_fwd, NTHR, LDS_BYTES) != hipSuccess || per_cu < 1) { fprintf(stderr, "kernel_launch: occupancy query failed (%d)\n", per_cu); per_cu = 1; }
        (void)hipGetLastError();
        grid = cus * per_cu;
        fprintf(stderr, "kernel_launch: grid %d (%d CUs x %d)\n", grid, cus, per_cu);
    }
    if (grid < 0) return;
    if (hipMemsetAsync((char*)d_ws + WS_BAR, 0, XCD_BAR_WORDS * 4, stream) != hipSuccess) { fprintf(stderr, "kernel_launch: memset of the barrier words failed\n"); return; }
    Args a{};
    for (int i = 0; i < 20; ++i) a.in[i] = (const float*)d_in[i];
    a.out = (float*)d_out; a.ws = (unsigned char*)d_ws;
#if MK_PER_PHASE_LAUNCH
    for (int p = 0; p < NPHASE; ++p) { a.ph_lo = p; a.ph_hi = p + 1; hipLaunchKernelGGL(mega_fwd, dim3(grid), dim3(NTHR), LDS_BYTES, stream, a); }
#else
    a.ph_lo = 0; a.ph_hi = NPHASE;
    void* kargs[] = {&a};
    hipError_t e = hipLaunchCooperativeKernel((const void*)mega_fwd, dim3(grid), dim3(NTHR), kargs, LDS_BYTES, stream);
    if (e != hipSuccess) fprintf(stderr, "kernel_launch: cooperative launch failed: %s (grid %d)\n", hipGetErrorString(e), grid);
#endif
}
```

```cpp
#include <hip/hip_runtime.h>
#include <hip/hip_cooperative_groups.h>
#include <cstdio>
#include <cstdint>
namespace cg = cooperative_groups;

#ifndef MK_PER_PHASE_LAUNCH
#define MK_PER_PHASE_LAUNCH 0
#endif

#ifndef REPEAT_MASK
#define REPEAT_MASK 0
#endif
#define REP(k) ((REPEAT_MASK >> (k)) & 1)
#ifndef TS_SEL
#define TS_SEL -1
#endif

namespace pg8 {
#define PG8_LAS __attribute__((address_space(3)))
typedef unsigned short bf16_t;
typedef short bf16x8 __attribute__((ext_vector_type(8)));
typedef float f32x4 __attribute__((ext_vector_type(4)));
typedef unsigned u32x4 __attribute__((ext_vector_type(4)));
constexpr int BM = 256, BK = 64, HALF = 128, HTB = HALF * BK * 2  , STAGE_BYTES = 8 * HTB, NXCD = 8, WGM = 8;

__host__ __device__ __forceinline__ int lds_byte(int r, int c) { const int st = (r >> 4) * 2 + (c >> 5), rr = r & 15, cc = c & 31, ob = rr * 64 + cc * 2; return st * 1024 + (ob ^ (((ob >> 9) & 1) << 5)); }
__host__ __device__ __forceinline__ void stage_rc(int b, int& R, int& C) { const int st = b / 1024, sb = b % 1024, swz = sb ^ (((sb >> 9) & 1) << 5); R = (st >> 1) * 16 + swz / 64; C = (st & 1) * 32 + (swz % 64) / 2; }
__host__ __device__ __forceinline__ int perm32(int rho) { const int n = rho >> 4, i = rho & 15; return 8 * (i >> 2) + 4 * n + (i & 3); }

struct Unit { int pm, pn; };
struct Gemm { const bf16_t* A; const bf16_t* Bt; int M, N, K; };

struct StaticOrder {
    int nM, nN, nwg, G, c;
    __host__ __device__ void init(int M, int N, int G_, int c_) { nM = M / BM; nN = N / BM; nwg = nM * nN; G = G_; c = c_; }
    __host__ __device__ bool next(int i, Unit& u) const {
        const long L = (long)i * G + c; if (L >= nwg) return false;
        int wgid = (int)L; { const int q = nwg / NXCD, r = nwg % NXCD, xcd = wgid % NXCD, off = wgid / NXCD; wgid = (xcd < r ? xcd * (q + 1) : r * (q + 1) + (xcd - r) * q) + off; }
        const int nig = WGM * nN, gid = wgid / nig, fm = gid * WGM, gsz = (nM - fm) < WGM ? (nM - fm) : WGM;
        u.pm = fm + ((wgid % nig) % gsz); u.pn = (wgid % nig) / gsz; return true;
    }
    __device__ __forceinline__ void a_ready(const Unit&) const {}
    __device__ __forceinline__ void done(const Unit&) const {}
};
__device__ __forceinline__ unsigned cvt_pk_bf16(float lo, float hi) { unsigned r; asm volatile("v_cvt_pk_bf16_f32 %0, %1, %2" : "=v"(r) : "v"(lo), "v"(hi)); return r; }
typedef float f32x2 __attribute__((ext_vector_type(2)));
__device__ __forceinline__ float bflo(unsigned u) { return __uint_as_float(u << 16); }
__device__ __forceinline__ float bfhi(unsigned u) { return __uint_as_float(u & 0xffff0000u); }
__device__ __forceinline__ float sigm(float x) { return 1.0f / (1.0f + __expf(-x)); }

struct EpiZ {
    static constexpr bool PERM = true, AFTER_DRAIN = false;
    bf16_t* O; int ldc;
    __device__ __forceinline__ void operator()(const f32x4 (&acc)[2][2][4][2], const Unit& u, int wr, int wc, int fr, int fq) const {
        const int row0 = u.pm * BM + wr * 64 + fr, col0 = u.pn * BM + wc * 32 + 8 * fq;
#pragma unroll
        for (int ai = 0; ai < 2; ++ai)
#pragma unroll
            for (int m = 0; m < 4; ++m) { bf16_t* rowp = O + (size_t)(row0 + ai * HALF + m * 16) * ldc + col0;
#pragma unroll
                for (int bj = 0; bj < 2; ++bj) { const f32x4 v0 = acc[ai][bj][m][0], v1 = acc[ai][bj][m][1];
                    u32x4 w; w.x = cvt_pk_bf16(v0[0], v0[1]); w.y = cvt_pk_bf16(v0[2], v0[3]); w.z = cvt_pk_bf16(v1[0], v1[1]); w.w = cvt_pk_bf16(v1[2], v1[3]);
                    *(u32x4*)(rowp + bj * HALF) = w; } }
    }
};
template <int MODE> struct EpiGate {
    static constexpr bool PERM = true, AFTER_DRAIN = false;
    bf16_t* O; const bf16_t* Z; int zld; int gcol;
    __device__ __forceinline__ void operator()(const f32x4 (&acc)[2][2][4][2], const Unit& u, int wr, int wc, int fr, int fq) const {
        const int row0 = u.pm * BM + wr * 64 + fr, col0 = u.pn * BM + wc * 32 + 8 * fq;
#pragma unroll
        for (int ai = 0; ai < 2; ++ai)
#pragma unroll
            for (int m = 0; m < 4; ++m) { const size_t row = (size_t)(row0 + ai * HALF + m * 16);
                bf16_t* op = O + row * 1024 + col0; const bf16_t* zp = Z + row * zld + gcol + col0;
#pragma unroll
                for (int bj = 0; bj < 2; ++bj) { const f32x4 v0 = acc[ai][bj][m][0], v1 = acc[ai][bj][m][1];
                    const u32x4 g = *(const u32x4*)(zp + bj * HALF);
                    float r0 = v0[0] * sigm(bflo(g.x)), r1 = v0[1] * sigm(bfhi(g.x)), r2 = v0[2] * sigm(bflo(g.y)), r3 = v0[3] * sigm(bfhi(g.y));
                    float r4 = v1[0] * sigm(bflo(g.z)), r5 = v1[1] * sigm(bfhi(g.z)), r6 = v1[2] * sigm(bflo(g.w)), r7 = v1[3] * sigm(bfhi(g.w));
                    if (MODE == 1) { const u32x4 p = *(const u32x4*)(op + bj * HALF);
                        r0 += bflo(p.x); r1 += bfhi(p.x); r2 += bflo(p.y); r3 += bfhi(p.y); r4 += bflo(p.z); r5 += bfhi(p.z); r6 += bflo(p.w); r7 += bfhi(p.w); }
                    u32x4 w; w.x = cvt_pk_bf16(r0, r1); w.y = cvt_pk_bf16(r2, r3); w.z = cvt_pk_bf16(r4, r5); w.w = cvt_pk_bf16(r6, r7);
                    *(u32x4*)(op + bj * HALF) = w; } }
    }
};
struct EpiRes1 {
    static constexpr bool PERM = false, AFTER_DRAIN = false;
    const float* X; bf16_t* XB; float* SS;
    __device__ __forceinline__ void operator()(const f32x4 (&acc)[2][2][4][2], const Unit& u, int wr, int wc, int fr, int fq) const {
        const int row0 = u.pm * BM + wr * 64 + fr, col0 = u.pn * BM + wc * 32 + 4 * fq;
#pragma unroll
        for (int ai = 0; ai < 2; ++ai)
#pragma unroll
            for (int m = 0; m < 4; ++m) { const size_t row = (size_t)(row0 + ai * HALF + m * 16); float ssq = 0.f;
#pragma unroll
                for (int bj = 0; bj < 2; ++bj)
#pragma unroll
                    for (int n = 0; n < 2; ++n) { const size_t off = row * 1024 + col0 + bj * HALF + n * 16;
                        const f32x4 xv = *(const f32x4*)(X + off); const f32x4 v = acc[ai][bj][m][n] + xv;
                        ssq += v[0] * v[0] + v[1] * v[1] + v[2] * v[2] + v[3] * v[3];
                        uint2 w; w.x = cvt_pk_bf16(v[0], v[1]); w.y = cvt_pk_bf16(v[2], v[3]); *(uint2*)(XB + off) = w; }
                ssq += __shfl_xor(ssq, 16); ssq += __shfl_xor(ssq, 32);
                if (fq == 0) atomicAdd(SS + row, ssq); }
    }
};
struct EpiRes2 {
    static constexpr bool PERM = false, AFTER_DRAIN = false;
    const bf16_t* XB; float* O; float* SS;
    __device__ __forceinline__ void operator()(const f32x4 (&acc)[2][2][4][2], const Unit& u, int wr, int wc, int fr, int fq) const {
        const int row0 = u.pm * BM + wr * 64 + fr, col0 = u.pn * BM + wc * 32 + 4 * fq;
#pragma unroll
        for (int ai = 0; ai < 2; ++ai)
#pragma unroll
            for (int m = 0; m < 4; ++m) { const size_t row = (size_t)(row0 + ai * HALF + m * 16); float ssq = 0.f;
#pragma unroll
                for (int bj = 0; bj < 2; ++bj)
#pragma unroll
                    for (int n = 0; n < 2; ++n) { const size_t off = row * 1024 + col0 + bj * HALF + n * 16;
                        const uint2 xw = *(const uint2*)(XB + off); f32x4 v = acc[ai][bj][m][n];
                        v[0] += bflo(xw.x); v[1] += bfhi(xw.x); v[2] += bflo(xw.y); v[3] += bfhi(xw.y);
                        *(f32x4*)(O + off) = v; ssq += v[0] * v[0] + v[1] * v[1] + v[2] * v[2] + v[3] * v[3]; }
                ssq += __shfl_xor(ssq, 16); ssq += __shfl_xor(ssq, 32);
                if (fq == 0) atomicAdd(SS + row, ssq); }
    }
};
struct EpiHid {
    static constexpr bool PERM = true, AFTER_DRAIN = false;
    bf16_t* O; const float* SS;
    __device__ __forceinline__ void operator()(const f32x4 (&acc)[2][2][4][2], const Unit& u, int wr, int wc, int fr, int fq) const {
        const int row0 = u.pm * BM + wr * 64 + fr, col0 = u.pn * BM + wc * 32 + 8 * fq;
#pragma unroll
        for (int ai = 0; ai < 2; ++ai)
#pragma unroll
            for (int m = 0; m < 4; ++m) { const size_t row = (size_t)(row0 + ai * HALF + m * 16);
                const float s2 = 1.0f / (SS[row] * (1.0f / 1024.0f) + 1e-6f);
                bf16_t* rowp = O + row * 4096 + col0;
#pragma unroll
                for (int bj = 0; bj < 2; ++bj) { f32x4 v0 = acc[ai][bj][m][0], v1 = acc[ai][bj][m][1];
#pragma unroll
                    for (int j = 0; j < 4; ++j) { float a = fmaxf(v0[j], 0.f), b = fmaxf(v1[j], 0.f); v0[j] = a * a * s2; v1[j] = b * b * s2; }
                    u32x4 w; w.x = cvt_pk_bf16(v0[0], v0[1]); w.y = cvt_pk_bf16(v0[2], v0[3]); w.z = cvt_pk_bf16(v1[0], v1[1]); w.w = cvt_pk_bf16(v1[2], v1[3]);
                    *(u32x4*)(rowp + bj * HALF) = w; } }
    }
};

template <class Epi, class Sched, bool ALIGN_EPI = false, bool SP2 = false>
__device__ __forceinline__ void gemm_phase(PG8_LAS unsigned char* lds, const Gemm g, const Sched& S, const Epi& E) {
    const int tid = threadIdx.x, wid = __builtin_amdgcn_readfirstlane(tid >> 6), lane = tid & 63, wr = wid >> 2, wc = wid & 3, fr = lane & 15, fq = lane >> 4;
    const int K = g.K, nt = K / BK;
    unsigned voffA[2], voffB[2];
#pragma unroll
    for (int i = 0; i < 2; ++i) { int R, C; stage_rc(tid * 16 + i * 8192, R, C); const int Rb = Epi::PERM ? ((R & ~31) + perm32(R & 31)) : R;
        voffA[i] = (unsigned)(R * K + C) * 2u; voffB[i] = (unsigned)(Rb * K + C) * 2u; }
    const size_t kstep = (size_t)(BK * 2);
    const size_t hstep = (size_t)HALF * K * 2;
    const size_t tstep = 2 * hstep;
    const unsigned ldsw = (unsigned)wid * 1024u;
    const int aoff = lds_byte(wr * 64 + fr, fq * 8), boff = lds_byte(wc * 32 + fr, fq * 8);
#define PG8_SA(b, h) (((b) * 2 + (h)) * HTB)
#define PG8_SB(b, h) ((4 + (b) * 2 + (h)) * HTB)
#define PG8_STAGE(bufoff, gbase, voff) do { _Pragma("unroll") for (int _i = 0; _i < 2; ++_i) \
        __builtin_amdgcn_global_load_lds((const unsigned*)((const char*)(gbase) + (voff)[_i]), (PG8_LAS unsigned*)(lds + (bufoff) + ldsw + _i * 8192), 16, 0, 0); } while (0)
#define PG8_LDA(dst, b, h) do { _Pragma("unroll") for (int m = 0; m < 4; ++m) _Pragma("unroll") for (int k = 0; k < 2; ++k) dst[m][k] = *(const PG8_LAS bf16x8*)(lds + PG8_SA(b, h) + aoff + m * 2048 + k * 1024); } while (0)
#define PG8_LDB(dst, b, h) do { _Pragma("unroll") for (int n = 0; n < 2; ++n) _Pragma("unroll") for (int k = 0; k < 2; ++k) dst[n][k] = *(const PG8_LAS bf16x8*)(lds + PG8_SB(b, h) + boff + n * 2048 + k * 1024); } while (0)
#define PG8_MMA(ai, bj, At, Bt) do { __builtin_amdgcn_s_setprio(1); _Pragma("unroll") for (int m = 0; m < 4; ++m) _Pragma("unroll") for (int n = 0; n < 2; ++n) _Pragma("unroll") for (int k = 0; k < 2; ++k) \
        acc[ai][bj][m][n] = __builtin_amdgcn_mfma_f32_16x16x32_bf16(Bt[n][k], At[m][k], acc[ai][bj][m][n], 0, 0, 0); __builtin_amdgcn_s_setprio(0); } while (0)
#define PG8_WAIT_V(n) asm volatile("s_waitcnt vmcnt(" #n ")" ::: "memory")
#define PG8_WAIT_L(n) asm volatile("s_waitcnt lgkmcnt(" #n ")" ::: "memory")
#define PG8_BAR __builtin_amdgcn_s_barrier()
#define PG8_SCHED __builtin_amdgcn_sched_barrier(0)
    Unit cur, nxt; int ui = 0;
    if (!S.next(0, cur)) return;
    f32x4 acc[2][2][4][2];
#pragma unroll
    for (int a = 0; a < 2; ++a)
#pragma unroll
        for (int b = 0; b < 2; ++b)
#pragma unroll
            for (int m = 0; m < 4; ++m)
#pragma unroll
                for (int n = 0; n < 2; ++n) acc[a][b][m][n] = (f32x4){0.f, 0.f, 0.f, 0.f};
    bf16x8 At[4][2], B0[2][2], B1[2][2];
    const char* cA = (const char*)g.A + (size_t)cur.pm * tstep; const char* cB = (const char*)g.Bt + (size_t)cur.pn * tstep;
    S.a_ready(cur);
    if constexpr (SP2) {
        PG8_STAGE(PG8_SB(0, 0), cB, voffB); PG8_STAGE(PG8_SB(0, 1), cB + hstep, voffB); PG8_STAGE(PG8_SA(0, 0), cA, voffA); PG8_STAGE(PG8_SA(0, 1), cA + hstep, voffA);
        if (wr == 1) PG8_BAR;
        PG8_WAIT_V(2); PG8_BAR;
        PG8_STAGE(PG8_SB(1, 0), cB + kstep, voffB); PG8_STAGE(PG8_SA(1, 0), cA + kstep, voffA); PG8_STAGE(PG8_SB(1, 1), cB + hstep + kstep, voffB);
        PG8_WAIT_V(6); PG8_BAR;
    } else {
        PG8_STAGE(PG8_SB(0, 0), cB, voffB); PG8_STAGE(PG8_SA(0, 0), cA, voffA); PG8_STAGE(PG8_SB(0, 1), cB + hstep, voffB); PG8_STAGE(PG8_SA(0, 1), cA + hstep, voffA);
        if (wr == 1) PG8_BAR;
        PG8_WAIT_V(4); PG8_BAR;
        PG8_STAGE(PG8_SB(1, 0), cB + kstep, voffB); PG8_STAGE(PG8_SA(1, 0), cA + kstep, voffA); PG8_STAGE(PG8_SB(1, 1), cB + hstep + kstep, voffB);
        PG8_WAIT_V(6); PG8_BAR;
    }
    for (;;) {
        const bool has_next = S.next(ui + 1, nxt);
        const char* nA = has_next ? (const char*)g.A + (size_t)nxt.pm * tstep : cA; const char* nB = has_next ? (const char*)g.Bt + (size_t)nxt.pn * tstep : cB;
        for (int t = 0; t < nt; t += 2) {
            const bool last = (t == nt - 2);
            const char* a1 = cA + (size_t)(t + 1) * kstep;
            const char* a2 = last ? nA : cA + (size_t)(t + 2) * kstep; const char* b2 = last ? nB : cB + (size_t)(t + 2) * kstep;
            const char* a3 = a2 + kstep; const char* b3 = b2 + kstep;
            if (last && has_next) S.a_ready(nxt);
            if constexpr (SP2) {
            PG8_LDB(B0, 0, 0); PG8_LDB(B1, 0, 1); PG8_SCHED; PG8_LDA(At, 0, 0); PG8_STAGE(PG8_SA(1, 1), a1 + hstep, voffA);
            PG8_WAIT_V(8); PG8_WAIT_L(0); PG8_BAR; PG8_MMA(0, 0, At, B0); PG8_MMA(0, 1, At, B1); PG8_BAR; PG8_SCHED;
            PG8_LDA(At, 0, 1); PG8_STAGE(PG8_SB(0, 0), b2, voffB); PG8_STAGE(PG8_SB(0, 1), b2 + hstep, voffB); PG8_STAGE(PG8_SA(0, 0), a2, voffA);
            PG8_WAIT_V(8); PG8_WAIT_L(0); PG8_BAR; PG8_MMA(1, 0, At, B0); PG8_MMA(1, 1, At, B1); PG8_BAR; PG8_SCHED;
            PG8_LDB(B0, 1, 0); PG8_LDB(B1, 1, 1); PG8_SCHED; PG8_LDA(At, 1, 0); PG8_STAGE(PG8_SA(0, 1), a2 + hstep, voffA);
            PG8_WAIT_V(8); PG8_WAIT_L(0); PG8_BAR; PG8_MMA(0, 0, At, B0); PG8_MMA(0, 1, At, B1); PG8_BAR; PG8_SCHED;
            PG8_LDA(At, 1, 1); PG8_STAGE(PG8_SB(1, 0), b3, voffB); PG8_STAGE(PG8_SB(1, 1), b3 + hstep, voffB); PG8_STAGE(PG8_SA(1, 0), a3, voffA);
            PG8_WAIT_V(8); PG8_WAIT_L(0); PG8_BAR; PG8_MMA(1, 0, At, B0); PG8_MMA(1, 1, At, B1); PG8_BAR; PG8_SCHED;
            } else {
            PG8_LDB(B0, 0, 0); PG8_SCHED; PG8_LDA(At, 0, 0); PG8_STAGE(PG8_SA(1, 1), a1 + hstep, voffA);
            PG8_WAIT_L(8); PG8_BAR; PG8_WAIT_L(0); PG8_MMA(0, 0, At, B0); PG8_BAR; PG8_SCHED;
            PG8_LDB(B1, 0, 1); PG8_STAGE(PG8_SB(0, 0), b2, voffB);
            PG8_BAR; PG8_WAIT_L(0); PG8_MMA(0, 1, At, B1); PG8_BAR;
            PG8_LDA(At, 0, 1); PG8_STAGE(PG8_SA(0, 0), a2, voffA);
            PG8_BAR; PG8_WAIT_L(0); PG8_MMA(1, 0, At, B0); PG8_BAR; PG8_SCHED;
            PG8_STAGE(PG8_SB(0, 1), b2 + hstep, voffB);
            PG8_WAIT_V(6); PG8_BAR; PG8_MMA(1, 1, At, B1); PG8_BAR;
            PG8_LDB(B0, 1, 0); PG8_SCHED; PG8_LDA(At, 1, 0); PG8_STAGE(PG8_SA(0, 1), a2 + hstep, voffA);
            PG8_WAIT_L(8); PG8_BAR; PG8_WAIT_L(0); PG8_MMA(0, 0, At, B0); PG8_BAR; PG8_SCHED;
            PG8_LDB(B1, 1, 1); PG8_STAGE(PG8_SB(1, 0), b3, voffB);
            PG8_BAR; PG8_WAIT_L(0); PG8_MMA(0, 1, At, B1); PG8_BAR;
            PG8_LDA(At, 1, 1); PG8_STAGE(PG8_SA(1, 0), a3, voffA);
            PG8_BAR; PG8_WAIT_L(0); PG8_MMA(1, 0, At, B0); PG8_BAR; PG8_SCHED;
            PG8_STAGE(PG8_SB(1, 1), b3 + hstep, voffB);
            PG8_WAIT_V(6); PG8_BAR; PG8_MMA(1, 1, At, B1); PG8_BAR;
            }
        }
        if constexpr (ALIGN_EPI) { if (wr == 0) PG8_BAR; }
        if constexpr (!Epi::AFTER_DRAIN) { E(acc, cur, wr, wc, fr, fq); S.done(cur); }
        if (!has_next) break;
#pragma unroll
        for (int a = 0; a < 2; ++a)
#pragma unroll
            for (int b = 0; b < 2; ++b)
#pragma unroll
                for (int m = 0; m < 4; ++m)
#pragma unroll
                    for (int n = 0; n < 2; ++n) acc[a][b][m][n] = (f32x4){0.f, 0.f, 0.f, 0.f};
        cur = nxt; cA = nA; cB = nB; ++ui;
        if constexpr (ALIGN_EPI) { if (wr == 1) PG8_BAR; }
    }
    PG8_WAIT_V(0);
    if constexpr (!ALIGN_EPI) { if (wr == 0) PG8_BAR; }
    PG8_BAR;
    if constexpr (Epi::AFTER_DRAIN) { E.fused(acc, cur, wr, wc, fr, fq, lds, wid, lane); S.done(cur); }
#undef PG8_SA
#undef PG8_SB
#undef PG8_STAGE
#undef PG8_LDA
#undef PG8_LDB
#undef PG8_MMA
#undef PG8_WAIT_V
#undef PG8_WAIT_L
#undef PG8_BAR
#undef PG8_SCHED
}
}
extern __shared__ __attribute__((aligned(16))) unsigned char g_lds[];
using pg8::bf16_t; using pg8::bf16x8; using pg8::f32x4; using pg8::u32x4; using pg8::cvt_pk_bf16; using pg8::bflo; using pg8::bfhi; using pg8::sigm;

constexpr int NTOK = 32768, DM = 1024, SEQ = 2048, NB = 16, ZLD = 5120, NTHR = 512;
constexpr int C_R = 0, C_K = 512, C_V = 1024, C_WD = 1536, C_AD = 1600, C_GD = 1664;
constexpr int C_Q = 1824, C_KA = 2336, C_VA = 2400, C_QI = 2464, C_KI = 2976, C_WI = 3040, C_G0 = 3048, C_G1 = 4072;
constexpr size_t MiB = 1024 * 1024;
constexpr size_t WS_SS1 = 0, WS_SS2 = 128 * 1024, WS_BONUS = 256 * 1024, WS_ROPE = 1280 * 1024, WS_WD = 1792 * 1024, WS_WI = 1856 * 1024, WS_WG = 1920 * 1024;
constexpr size_t WS_WIN = 4 * MiB, WS_WUP = 14 * MiB, WS_WDN = 22 * MiB, WS_WB = 30 * MiB, WS_WO = 32 * MiB, WS_VT = 34 * MiB, WS_H = 38 * MiB, WS_Z = 102 * MiB, WS_P = 422 * MiB, WS_END = 486 * MiB;
constexpr int LDS_BYTES = 163840;

struct Args { const float* in[20]; float* out; unsigned char* ws; int ph_lo, ph_hi; };

struct Frame {
    const float* in[20]; float* out; unsigned char* ws; unsigned char* lds; int tid, lane, wave;
    float *ss1, *ss2, *bonus; float2* rope; bf16_t *wd, *wi, *wg, *win, *wup, *wdn, *wb, *wo, *vt, *h, *ya, *yb, *xb, *z, *hid, *lw, *ic, *mg, *gt; float* yraw;
};

__device__ __forceinline__ bf16_t f2bf(float f) { return (bf16_t)(cvt_pk_bf16(f, 0.f) & 0xffffu); }
__device__ __forceinline__ float bf2f(bf16_t b) { return __uint_as_float(((unsigned)b) << 16); }
template <int CTRL> __device__ __forceinline__ float dpp_mov(float x) { return __int_as_float(__builtin_amdgcn_update_dpp(0, __float_as_int(x), CTRL, 0xF, 0xF, true)); }
__device__ __forceinline__ float red16(float x) { x += dpp_mov<0xB1>(x); x += dpp_mov<0x4E>(x); x += dpp_mov<0x141>(x); x += dpp_mov<0x140>(x); return x; }


__device__ __forceinline__ void lds_barrier() { asm volatile("s_waitcnt lgkmcnt(0)" ::: "memory"); __builtin_amdgcn_s_barrier(); asm volatile("" ::: "memory"); }
__device__ __forceinline__ void red16x4(float& a, float& b, float& c, float& d) {
#define DPP4(ctl) "v_add_f32_dpp %0, %0, %0 " ctl " row_mask:0xf bank_mask:0xf bound_ctrl:1\n" "v_add_f32_dpp %1, %1, %1 " ctl " row_mask:0xf bank_mask:0xf bound_ctrl:1\n" \
                  "v_add_f32_dpp %2, %2, %2 " ctl " row_mask:0xf bank_mask:0xf bound_ctrl:1\n" "v_add_f32_dpp %3, %3, %3 " ctl " row_mask:0xf bank_mask:0xf bound_ctrl:1\n"
    asm volatile("s_nop 1\n" DPP4("quad_perm:[1,0,3,2]") DPP4("quad_perm:[2,3,0,1]") DPP4("row_half_mirror") DPP4("row_mirror") : "+v"(a), "+v"(b), "+v"(c), "+v"(d));
#undef DPP4
}
__device__ __forceinline__ float red32(float x) { x += __shfl_xor(x, 1); x += __shfl_xor(x, 2); x += __shfl_xor(x, 4); x += __shfl_xor(x, 8); x += __shfl_xor(x, 16); return x; }
__device__ __forceinline__ float red64(float x) { x = red32(x); x += __shfl_xor(x, 32); return x; }
__device__ __forceinline__ float softplus_f(float x) { return fmaxf(x, 0.f) + log1pf(__expf(-fabsf(x))); }

__device__ __forceinline__ void tconv(const Frame& F, const float* __restrict__ W, int K, int N, int Npad, bf16_t* __restrict__ Wt, const float* __restrict__ rs) {
    float* tile = (float*)g_lds;
    const int ktn = (K + 63) / 64, ntn = Npad / 64, tid = F.tid;
    for (int tl = blockIdx.x; tl < ktn * ntn; tl += gridDim.x) {
        const int kt = tl % ktn, nt = tl / ktn;
#pragma unroll
        for (int i = 0; i < 2; ++i) { const int idx = tid + i * NTHR, kk = idx >> 4, n4 = (idx & 15) * 4, k = kt * 64 + kk, n = nt * 64 + n4;
            f32x4 v = {0.f, 0.f, 0.f, 0.f};
            if (k < K) { if (n + 3 < N) v = *(const f32x4*)(W + (size_t)k * N + n); else { for (int j = 0; j < 4; ++j) if (n + j < N) v[j] = W[(size_t)k * N + n + j]; }
                if (rs != nullptr) { const float r = rs[k]; v[0] *= r; v[1] *= r; v[2] *= r; v[3] *= r; } }
            tile[kk * 65 + n4] = v[0]; tile[kk * 65 + n4 + 1] = v[1]; tile[kk * 65 + n4 + 2] = v[2]; tile[kk * 65 + n4 + 3] = v[3]; }
        __syncthreads();
        { const int nn = tid >> 3, k8 = (tid & 7) * 8, k = kt * 64 + k8, n = nt * 64 + nn;
          if (k < K) { u32x4 w; const float* tp = tile + k8 * 65 + nn;
              w.x = cvt_pk_bf16(tp[0], tp[65]); w.y = cvt_pk_bf16(tp[130], tp[195]); w.z = cvt_pk_bf16(tp[260], tp[325]); w.w = cvt_pk_bf16(tp[390], tp[455]);
              *(u32x4*)(Wt + (size_t)n * K + k) = w; } }
        __syncthreads();
    }
}
__device__ __forceinline__ void p0_prologue(const Frame& F) {
    const int tid = F.tid, gtid = blockIdx.x * NTHR + tid, gn = gridDim.x * NTHR;
    for (int i = gtid; i < 2 * NTOK; i += gn) F.ss1[i] = 0.f;
    for (int i = gtid; i < SEQ * 32; i += gn) { const int pos = i >> 5, j = i & 31;
        const float inv = 1.0f / powf(10000.0f, (float)(2 * j) / 64.0f); const float ang = (float)pos * inv;
        double rev = (double)ang * 0.15915494309189535; rev -= floor(rev); const float fr = (float)rev;
        F.rope[i] = make_float2(__builtin_amdgcn_cosf(fr), __builtin_amdgcn_sinf(fr)); }
    tconv(F, F.in[2], 1024, 5096, 5120, F.win, nullptr);
    tconv(F, F.in[17], 1024, 4096, 4096, F.wup, F.in[16]);
    tconv(F, F.in[18], 4096, 1024, 1024, F.wdn, nullptr);
    tconv(F, F.in[14], 512, 1024, 1024, F.wb, nullptr);
    tconv(F, F.in[14] + 512 * 1024, 512, 1024, 1024, F.wb + 1024 * 512, nullptr);
    tconv(F, F.in[15], 1024, 1024, 1024, F.wo, nullptr);
    tconv(F, F.in[5], 64, 512, 512, F.wd, nullptr);
    tconv(F, F.in[7], 64, 512, 512, F.wi, nullptr);
    tconv(F, F.in[8], 160, 512, 512, F.wg, nullptr);
    const float* x = F.in[0]; const float* g = F.in[1]; const int lane = F.lane;
    for (int row = blockIdx.x * 8 + F.wave; row < NTOK; row += gridDim.x * 8) {
        const float* xr = x + (size_t)row * DM; f32x4 v[4]; float ss = 0.f;
#pragma unroll
        for (int i = 0; i < 4; ++i) { v[i] = *(const f32x4*)(xr + i * 256 + lane * 4); ss += v[i][0] * v[i][0] + v[i][1] * v[i][1] + v[i][2] * v[i][2] + v[i][3] * v[i][3]; }
        ss = red64(ss); const float sc = rsqrtf(ss * (1.0f / 1024.0f) + 1e-6f);
#pragma unroll
        for (int i = 0; i < 4; ++i) { const f32x4 gg = *(const f32x4*)(g + i * 256 + lane * 4); uint2 w;
            w.x = cvt_pk_bf16(v[i][0] * sc * gg[0], v[i][1] * sc * gg[1]); w.y = cvt_pk_bf16(v[i][2] * sc * gg[2], v[i][3] * sc * gg[3]);
            *(uint2*)(F.h + (size_t)row * DM + i * 256 + lane * 4) = w; }
    }
}

__device__ __forceinline__ void p2_prep(const Frame& F, const int mode) {
    const int tid = F.tid, lane = F.lane, wave = F.wave, fr = lane & 15, fq = lane >> 4;
    bf16_t* z = F.z; const float* mu = F.in[3];
    if (mode != 2) {
        constexpr int LDA = 296, TT = 32; bf16_t* At = (bf16_t*)g_lds;
        bf16_t* Ot = At + TT * LDA;
        const float* dbias = F.in[4]; const float* ibias = F.in[6];
        for (int tile = blockIdx.x; tile < NTOK / TT; tile += gridDim.x) {
            const int t0 = tile * TT;
            for (int idx = tid; idx < TT * 36; idx += NTHR) { const int tok = idx / 36, c8 = (idx - tok * 36) * 8, t = t0 + tok, col = C_WD + c8;
                const u32x4 zc = *(const u32x4*)(z + (size_t)t * ZLD + col); u32x4 zp = {0u, 0u, 0u, 0u}; if (t & (SEQ - 1)) zp = *(const u32x4*)(z + (size_t)(t - 1) * ZLD + col);
                const f32x4 m0 = *(const f32x4*)(mu + col), m1 = *(const f32x4*)(mu + col + 4);
                float v[8]; const unsigned zcu[4] = {zc.x, zc.y, zc.z, zc.w}, zpu[4] = {zp.x, zp.y, zp.z, zp.w};
#pragma unroll
                for (int j = 0; j < 4; ++j) { const float a = bflo(zcu[j]), b2 = bfhi(zcu[j]), pa = bflo(zpu[j]), pb = bfhi(zpu[j]);
                    const float mm0 = (j < 2) ? m0[2 * j] : m1[2 * j - 4], mm1 = (j < 2) ? m0[2 * j + 1] : m1[2 * j - 3];
                    v[2 * j] = a + (pa - a) * mm0; v[2 * j + 1] = b2 + (pb - b2) * mm1; }
                if (c8 < 64) {
#pragma unroll
                    for (int j = 0; j < 8; ++j) v[j] = tanhf(v[j]); }
                else if (c8 >= 128) {
#pragma unroll
                    for (int j = 0; j < 8; ++j) v[j] = sigm(v[j]); }
                u32x4 w; w.x = cvt_pk_bf16(v[0], v[1]); w.y = cvt_pk_bf16(v[2], v[3]); w.z = cvt_pk_bf16(v[4], v[5]); w.w = cvt_pk_bf16(v[6], v[7]);
                *(u32x4*)(At + tok * LDA + c8) = w; }
            __syncthreads();
            const int h = wave;
            bf16x8 Bc[9], Bn[9];
            { const int n = h * 64 + fr;
#pragma unroll
              for (int ks = 0; ks < 2; ++ks) { Bc[ks] = *(const bf16x8*)(F.wd + n * 64 + ks * 32 + fq * 8); Bc[2 + ks] = *(const bf16x8*)(F.wi + n * 64 + ks * 32 + fq * 8); }
#pragma unroll
              for (int ks = 0; ks < 5; ++ks) Bc[4 + ks] = *(const bf16x8*)(F.wg + n * 160 + ks * 32 + fq * 8); }
#pragma unroll 1
            for (int j = 0; j < 4; ++j) { const int n = h * 64 + j * 16 + fr;
                if (j < 3) { const int nn = n + 16;
#pragma unroll
                    for (int ks = 0; ks < 2; ++ks) { Bn[ks] = *(const bf16x8*)(F.wd + nn * 64 + ks * 32 + fq * 8); Bn[2 + ks] = *(const bf16x8*)(F.wi + nn * 64 + ks * 32 + fq * 8); }
#pragma unroll
                    for (int ks = 0; ks < 5; ++ks) Bn[4 + ks] = *(const bf16x8*)(F.wg + nn * 160 + ks * 32 + fq * 8); }
                const float db = dbias[n], ib = ibias[n];
#pragma unroll
                for (int mt = 0; mt < 2; ++mt) {
                    f32x4 ad = {0.f, 0.f, 0.f, 0.f}, ai = ad, ag = ad; const bf16_t* ap = At + (mt * 16 + fr) * LDA + fq * 8;
#pragma unroll
                    for (int ks = 0; ks < 2; ++ks) ad = __builtin_amdgcn_mfma_f32_16x16x32_bf16(*(const bf16x8*)(ap + ks * 32), Bc[ks], ad, 0, 0, 0);
#pragma unroll
                    for (int ks = 0; ks < 2; ++ks) ai = __builtin_amdgcn_mfma_f32_16x16x32_bf16(*(const bf16x8*)(ap + 64 + ks * 32), Bc[2 + ks], ai, 0, 0, 0);
#pragma unroll
                    for (int ks = 0; ks < 5; ++ks) ag = __builtin_amdgcn_mfma_f32_16x16x32_bf16(*(const bf16x8*)(ap + 128 + ks * 32), Bc[4 + ks], ag, 0, 0, 0);
#pragma unroll
                    for (int jj = 0; jj < 4; ++jj) {
                        const float dw = db + ad[jj]; const float wlog = -softplus_f(-dw) - 0.5f; const float lwv = -__expf(wlog);
                        const int tk = mt * 16 + fq * 4 + jj; Ot[tk * 520 + n] = f2bf(lwv); Ot[(TT + tk) * 520 + n] = f2bf(sigm(ib + ai[jj])); Ot[(2 * TT + tk) * 520 + n] = f2bf(ag[jj]); }
                }
#pragma unroll
                for (int q = 0; q < 9; ++q) Bc[q] = Bn[q];
            }
            __syncthreads();
#pragma unroll
            for (int i = 0; i < 12; ++i) { const int idx = tid + i * NTHR, arr = idx >> 11, rem = idx & 2047, tk = rem >> 6, c8 = (rem & 63) * 8;
                const u32x4 w = *(const u32x4*)(Ot + (arr * TT + tk) * 520 + c8); bf16_t* dst = arr == 0 ? F.lw : (arr == 1 ? F.ic : F.gt);
                *(u32x4*)(dst + (size_t)(t0 + tk) * 512 + c8) = w; }
            __syncthreads();
        }
    }
    if (mode != 2) {
        unsigned short* tl = (unsigned short*)g_lds;
        for (int tile = blockIdx.x; tile < NTOK / 64; tile += gridDim.x) { const int t0 = tile * 64, b = t0 / SEQ, tt0 = t0 % SEQ;
#pragma unroll
            for (int i = 0; i < 8; ++i) { const int idx = tid + i * NTHR, tok = idx >> 6, d = idx & 63; tl[tok * 66 + d] = z[(size_t)(t0 + tok) * ZLD + C_VA + d]; }
            __syncthreads();
#pragma unroll
            for (int i = 0; i < 8; ++i) { const int idx = tid + i * NTHR, d = idx >> 6, tok = idx & 63; F.vt[((size_t)b * 64 + d) * SEQ + tt0 + tok] = tl[tok * 66 + d]; }
            __syncthreads();
        }
    }
    if (mode != 0) {
        const int gtid = blockIdx.x * NTHR + tid, gn = gridDim.x * NTHR;
        for (int idx = gtid; idx < NTOK * 144; idx += gn) { const int t = idx / 144, p = idx - t * 144, hd = p >> 3, i4 = (p & 7) * 4;
            const int base = hd < 8 ? C_Q + hd * 64 : (hd == 8 ? C_KA : (hd < 17 ? C_QI + (hd - 9) * 64 : C_KI));
            f32x4 cs0 = *(const f32x4*)(&F.rope[(t & (SEQ - 1)) * 32 + i4]), cs1 = *(const f32x4*)(&F.rope[(t & (SEQ - 1)) * 32 + i4 + 2]);
            if (mode == 2) { cs0 = (f32x4){1.f, 0.f, 1.f, 0.f}; cs1 = cs0; }
            bf16_t* p1 = z + (size_t)t * ZLD + base + i4; const uint2 a = *(const uint2*)(p1), b2 = *(const uint2*)(p1 + 32);
            const float x10 = bflo(a.x), x11 = bfhi(a.x), x12 = bflo(a.y), x13 = bfhi(a.y), x20 = bflo(b2.x), x21 = bfhi(b2.x), x22 = bflo(b2.y), x23 = bfhi(b2.y);
            uint2 o1, o2;
            o1.x = cvt_pk_bf16(x10 * cs0[0] - x20 * cs0[1], x11 * cs0[2] - x21 * cs0[3]); o1.y = cvt_pk_bf16(x12 * cs1[0] - x22 * cs1[1], x13 * cs1[2] - x23 * cs1[3]);
            o2.x = cvt_pk_bf16(x20 * cs0[0] + x10 * cs0[1], x21 * cs0[2] + x11 * cs0[3]); o2.y = cvt_pk_bf16(x22 * cs1[0] + x12 * cs1[1], x23 * cs1[2] + x13 * cs1[3]);
            *(uint2*)(p1) = o1; *(uint2*)(p1 + 32) = o2; }
    }
}

struct ScanRaw { uint2 zr_c, zr_p, zk_c, zk_p, zv_c, zv_p, lwu, icu; };
struct ScanConst { f32x4 mur, muk, muv, kk, ka, rk; };
__device__ __forceinline__ void scan_load(ScanRaw& R, const bf16_t* z, const bf16_t* lw, const bf16_t* ic, size_t tokbase, int ch, int ptok, int gc) {
    const int t = ch * 16 + ptok; const size_t T = tokbase + t; const bf16_t* zp = z + T * ZLD + gc;
    R.zr_c = *(const uint2*)(zp + C_R); R.zk_c = *(const uint2*)(zp + C_K); R.zv_c = *(const uint2*)(zp + C_V);
    const uint2 zz = make_uint2(0u, 0u);
    if (t > 0) { R.zr_p = *(const uint2*)(zp - ZLD + C_R); R.zk_p = *(const uint2*)(zp - ZLD + C_K); R.zv_p = *(const uint2*)(zp - ZLD + C_V); } else { R.zr_p = zz; R.zk_p = zz; R.zv_p = zz; }
    R.lwu = *(const uint2*)(lw + T * 512 + gc); R.icu = *(const uint2*)(ic + T * 512 + gc);
}
__device__ __forceinline__ f32x4 unpack4(uint2 u) { f32x4 r; r[0] = bflo(u.x); r[1] = bfhi(u.x); r[2] = bflo(u.y); r[3] = bfhi(u.y); return r; }
__device__ __forceinline__ void scan_prep(const ScanRaw& R, const ScanConst& C, float* ops, float* vv, float* bonus_out, bool wr_bonus, int ptok, int pc, int v0) {
    const f32x4 rc = unpack4(R.zr_c), rp = unpack4(R.zr_p), kc = unpack4(R.zk_c), kp = unpack4(R.zk_p), vc = unpack4(R.zv_c), vp = unpack4(R.zv_p), ic = unpack4(R.icu), lw = unpack4(R.lwu);
    const f32x4 r = rc + (rp - rc) * C.mur, k = kc + (kp - kc) * C.muk, vs = vc + (vp - vc) * C.muv;
    f32x4 w; w[0] = __expf(lw[0]); w[1] = __expf(lw[1]); w[2] = __expf(lw[2]); w[3] = __expf(lw[3]);
    const f32x4 q = k * C.kk; const float ss = red16((q[0] * q[0] + q[1] * q[1]) + (q[2] * q[2] + q[3] * q[3]));
    const float inv = 1.0f / fmaxf(sqrtf(ss), 1e-12f); const f32x4 n = q * inv;
    const f32x4 kn = k * (1.0f + (ic - 1.0f) * C.ka);
    const f32x4 bt = r * kn * C.rk; const float bon = red16((bt[0] + bt[1]) + (bt[2] + bt[3]));
    if (wr_bonus) *bonus_out = bon;
    float* op = ops + ptok * 320 + pc;
    *(f32x4*)(op) = -n; *(f32x4*)(op + 64) = w; *(f32x4*)(op + 128) = n * ic; *(f32x4*)(op + 192) = kn; *(f32x4*)(op + 256) = r;
    if (pc >= v0 && pc < v0 + 32) *(f32x4*)(vv + ptok * 32 + pc - v0) = vs;
}
__device__ __forceinline__ void p3_scan(const Frame& F, const int mode) {
    const int tid = F.tid;
    float* opsb = (float*)g_lds;
    float* vvb = opsb + 2 * 5120;
    float* yob = vvb + 2 * 512;
    const bf16_t* z = F.z; const float* mu = F.in[3]; const float* k_k = F.in[9]; const float* k_a = F.in[10]; const float* r_k = F.in[11];
    for (int item = blockIdx.x; item < 256; item += gridDim.x) {
        const int bh = item >> 1, half = item & 1, b = bh >> 3, h = bh & 7, v0 = half * 32;
        const size_t tokbase = (size_t)b * SEQ;
        if (F.wave >= 4) {
            const int pt = tid - 256, ptok = pt >> 4, pc = (pt & 15) * 4, gc = h * 64 + pc;
            ScanConst C; C.mur = *(const f32x4*)(mu + C_R + gc); C.muk = *(const f32x4*)(mu + C_K + gc); C.muv = *(const f32x4*)(mu + C_V + gc);
            C.kk = *(const f32x4*)(k_k + gc); C.ka = *(const f32x4*)(k_a + gc); C.rk = *(const f32x4*)(r_k + gc);
            const bool wrb = (half == 0) && ((pt & 15) == 0);
            ScanRaw R;
            scan_load(R, z, F.lw, F.ic, tokbase, 0, ptok, gc);
            scan_prep(R, C, opsb, vvb, F.bonus + (tokbase + ptok) * 8 + h, wrb, ptok, pc, v0);
            scan_load(R, z, F.lw, F.ic, tokbase, 1, ptok, gc);
            lds_barrier();
            for (int ch = 0; ch < SEQ / 16; ++ch) {
                const int cur = ch & 1, nxt = cur ^ 1;
                if (mode != 2) {
                if (ch > 0) { const int tok = pt >> 4, r2 = (pt & 15) * 2;
                    *(float2*)(F.yraw + (tokbase + (ch - 1) * 16 + tok) * 512 + h * 64 + v0 + r2) = *(const float2*)(yob + nxt * 512 + tok * 32 + r2); }
                if (ch + 1 < SEQ / 16) {
                    scan_prep(R, C, opsb + nxt * 5120, vvb + nxt * 512, F.bonus + (tokbase + (ch + 1) * 16 + ptok) * 8 + h, wrb, ptok, pc, v0);
                    if (ch + 2 < SEQ / 16) scan_load(R, z, F.lw, F.ic, tokbase, ch + 2, ptok, gc);
                } }
                lds_barrier();
            }
            { const int tok = pt >> 4, r2 = (pt & 15) * 2;
              *(float2*)(F.yraw + (tokbase + (SEQ / 16 - 1) * 16 + tok) * 512 + h * 64 + v0 + r2) = *(const float2*)(yob + 512 + tok * 32 + r2); }
        } else {
            const int rp = tid >> 4, ks = tid & 15;
            float A0 = 0.f, A1 = 0.f, A2 = 0.f, A3 = 0.f, B0 = 0.f, B1 = 0.f, B2 = 0.f, B3 = 0.f;
            const int ywoff = (ks == 0) ? 2 * rp : (2 * 512 + 2 * tid), ywstep = (ks == 0) ? 32 : 0;
            lds_barrier();
            f32x4 rprev = {0.f, 0.f, 0.f, 0.f}; float* ywp = yob + 2 * 512 + 2 * tid;
            for (int ch = 0; ch < SEQ / 16; ++ch) {
                const int cur = ch & 1;
                const float* ops = opsb + cur * 5120 + ks * 4; const float* vv = vvb + cur * 512 + 2 * rp; float* yw = yob + cur * 512 + ywoff;
                if (mode != 1) {
#pragma unroll
                for (int s = 0; s < 16; ++s) {
                    const float* o = ops + s * 320;
                    const f32x4 a4 = *(const f32x4*)(o), w4 = *(const f32x4*)(o + 64), b4 = *(const f32x4*)(o + 128), k4 = *(const f32x4*)(o + 192), r4 = *(const f32x4*)(o + 256);
                    const float2 vab = *(const float2*)(vv + s * 32);
                    float sa = (A0 * a4[0] + A1 * a4[1]) + (A2 * a4[2] + A3 * a4[3]); float sb = (B0 * a4[0] + B1 * a4[1]) + (B2 * a4[2] + B3 * a4[3]);
                    float ya = (A0 * rprev[0] + A1 * rprev[1]) + (A2 * rprev[2] + A3 * rprev[3]); float yb2 = (B0 * rprev[0] + B1 * rprev[1]) + (B2 * rprev[2] + B3 * rprev[3]);
                    red16x4(sa, sb, ya, yb2);
                    *(float2*)(ywp) = make_float2(ya, yb2);
                    ywp = yw + s * ywstep;
                    A0 = A0 * w4[0] + sa * b4[0] + vab.x * k4[0]; A1 = A1 * w4[1] + sa * b4[1] + vab.x * k4[1];
                    A2 = A2 * w4[2] + sa * b4[2] + vab.x * k4[2]; A3 = A3 * w4[3] + sa * b4[3] + vab.x * k4[3];
                    B0 = B0 * w4[0] + sb * b4[0] + vab.y * k4[0]; B1 = B1 * w4[1] + sb * b4[1] + vab.y * k4[1];
                    B2 = B2 * w4[2] + sb * b4[2] + vab.y * k4[2]; B3 = B3 * w4[3] + sb * b4[3] + vab.y * k4[3];
                    rprev = r4;
                }
                {
                    float ya = (A0 * rprev[0] + A1 * rprev[1]) + (A2 * rprev[2] + A3 * rprev[3]); float yb2 = (B0 * rprev[0] + B1 * rprev[1]) + (B2 * rprev[2] + B3 * rprev[3]);
                    float d0 = 0.f, d1 = 0.f; red16x4(ya, yb2, d0, d1);
                    *(float2*)(ywp) = make_float2(ya, yb2); ywp = yob + 2 * 512 + 2 * tid; rprev = (f32x4){0.f, 0.f, 0.f, 0.f};
                } }
                lds_barrier();
            }
        }
        __syncthreads();
    }
}

__device__ __forceinline__ unsigned ordkey(float f) { const unsigned u = __float_as_uint(f); return (u & 0x80000000u) ? ~u : (u | 0x80000000u); }

__device__ __forceinline__ void attn_chunk(const unsigned char* kb, const unsigned char* vb, const unsigned* selm, int c, int p, int fr, int fq, const bf16x8 (&Bqa)[2][2], f32x4 (&O)[2][4], f32x4 (&RS)[2]) {
    const f32x4 zero4 = {0.f, 0.f, 0.f, 0.f};
    const u32x4 onesu = {0x3f803f80u, 0x3f803f80u, 0x3f803f80u, 0x3f803f80u}; const bf16x8 ones = __builtin_bit_cast(bf16x8, onesu);
    const float csc = 0.125f * 1.4426950408889634f;
    const unsigned char* k0p = kb + ((2 * p) * 16 + fr) * 144 + fq * 16; const unsigned char* k1p = k0p + 16 * 144;
    const bf16x8 KA00 = *(const bf16x8*)(k0p), KA01 = *(const bf16x8*)(k0p + 64), KA10 = *(const bf16x8*)(k1p), KA11 = *(const bf16x8*)(k1p + 64);
    const int mw = (int)selm[fr * 64 + 2 * c + p];
    bf16x8 VA[4];
#pragma unroll
    for (int dt = 0; dt < 4; ++dt) { const unsigned char* vp = vb + (dt * 16 + fr) * 144 + (2 * p) * 32 + fq * 8;
        const uint2 lo = *(const uint2*)(vp), hi = *(const uint2*)(vp + 32);
        u32x4 va; va.x = lo.x; va.y = lo.y; va.z = hi.x; va.w = hi.y; VA[dt] = __builtin_bit_cast(bf16x8, va); }
    unsigned km0[4], km1[4];
#pragma unroll
    for (int jj = 0; jj < 4; ++jj) { km0[jj] = (unsigned)__builtin_amdgcn_sbfe(mw, fq * 4 + jj, 1); km1[jj] = (unsigned)__builtin_amdgcn_sbfe(mw, 16 + fq * 4 + jj, 1); }
#pragma unroll
    for (int hh = 0; hh < 2; ++hh) {
        f32x4 s0 = __builtin_amdgcn_mfma_f32_16x16x32_bf16(KA00, Bqa[hh][0], zero4, 0, 0, 0); s0 = __builtin_amdgcn_mfma_f32_16x16x32_bf16(KA01, Bqa[hh][1], s0, 0, 0, 0);
        f32x4 s1 = __builtin_amdgcn_mfma_f32_16x16x32_bf16(KA10, Bqa[hh][0], zero4, 0, 0, 0); s1 = __builtin_amdgcn_mfma_f32_16x16x32_bf16(KA11, Bqa[hh][1], s1, 0, 0, 0);
        unsigned p0[4], p1[4];
#pragma unroll
        for (int jj = 0; jj < 4; ++jj) {
            p0[jj] = __float_as_uint(__builtin_amdgcn_exp2f(fminf(s0[jj] * csc, 86.f))) & km0[jj]; p1[jj] = __float_as_uint(__builtin_amdgcn_exp2f(fminf(s1[jj] * csc, 86.f))) & km1[jj]; }
        u32x4 pk; pk.x = cvt_pk_bf16(__uint_as_float(p0[0]), __uint_as_float(p0[1])); pk.y = cvt_pk_bf16(__uint_as_float(p0[2]), __uint_as_float(p0[3]));
        pk.z = cvt_pk_bf16(__uint_as_float(p1[0]), __uint_as_float(p1[1])); pk.w = cvt_pk_bf16(__uint_as_float(p1[2]), __uint_as_float(p1[3]));
        const bf16x8 PB = __builtin_bit_cast(bf16x8, pk);
        RS[hh] = __builtin_amdgcn_mfma_f32_16x16x32_bf16(ones, PB, RS[hh], 0, 0, 0);
#pragma unroll
        for (int dt = 0; dt < 4; ++dt) O[hh][dt] = __builtin_amdgcn_mfma_f32_16x16x32_bf16(VA[dt], PB, O[hh][dt], 0, 0, 0);
    }
}

__device__ __forceinline__ void p3_dsa(const Frame& F) {
    const int tid = F.tid, lane = F.lane, wave = F.wave, fr = lane & 15, fq = lane >> 4;
    unsigned* scl = (unsigned*)g_lds;
    unsigned* selm = (unsigned*)(g_lds + 131328);
    unsigned char* kbuf = (unsigned char*)g_lds;
    unsigned char* vbuf = kbuf + 2 * 9216;
    const bf16_t* z = F.z; const int G = gridDim.x, bx = blockIdx.x;
    const f32x4 zero4 = {0.f, 0.f, 0.f, 0.f};
    for (int rnd = 0; rnd * G < 2048; ++rnd) {
        const int n = rnd * G + ((rnd & 1) ? (G - 1 - bx) : bx);
        if (n >= 2048) continue;
        const int qg = 127 - (n >> 4), b = n & 15, q0 = qg * 16; const size_t Tb = (size_t)b * SEQ;
        for (int i = tid; i < 1024; i += NTHR) selm[i] = 0u;
        __syncthreads();
        const bf16_t* zq = z + (Tb + q0 + fr) * ZLD;
        const unsigned lofk = (unsigned)((fr * ZLD + fq * 8) * 2), lofv = (unsigned)((fr * SEQ + fq * 4) * 2);
        if (qg >= 16) {
            const u32x4 wv = *(const u32x4*)(zq + C_WI);
            {
                bf16x8 Bq[8][2];
#pragma unroll
                for (int hh = 0; hh < 8; ++hh)
#pragma unroll
                    for (int ks = 0; ks < 2; ++ks) Bq[hh][ks] = *(const bf16x8*)(zq + C_QI + hh * 64 + ks * 32 + fq * 8);
                const float sc = 0.044194173824159216f;
                float wih[8]; wih[0] = bflo(wv.x) * sc; wih[1] = bfhi(wv.x) * sc; wih[2] = bflo(wv.y) * sc; wih[3] = bfhi(wv.y) * sc; wih[4] = bflo(wv.z) * sc; wih[5] = bfhi(wv.z) * sc; wih[6] = bflo(wv.w) * sc; wih[7] = bfhi(wv.w) * sc;
#pragma unroll 1
                for (int half = 0; half < 2; ++half) {
                    const int ktb = wave + 64 * half; if (ktb > qg) break;
                    bf16x8 W0[2], W1[2];
#pragma unroll
                    for (int j = 0; j < 2; ++j) { const int ktj = (ktb + 8 * j) < qg ? (ktb + 8 * j) : qg; const char* kb = (const char*)(z + (Tb + (size_t)ktj * 16) * ZLD + C_KI);
                        W0[j] = *(const bf16x8*)(kb + lofk); W1[j] = *(const bf16x8*)(kb + lofk + 64); }
#pragma unroll
                    for (int i = 0; i < 8; ++i) { const int kt = ktb + 8 * i;
                        if (kt <= qg) { f32x4 sv = zero4;
#pragma unroll
                            for (int hh = 0; hh < 8; ++hh) { f32x4 acc = __builtin_amdgcn_mfma_f32_16x16x32_bf16(W0[i & 1], Bq[hh][0], zero4, 0, 0, 0);
                                acc = __builtin_amdgcn_mfma_f32_16x16x32_bf16(W1[i & 1], Bq[hh][1], acc, 0, 0, 0);
#pragma unroll
                                for (int jj = 0; jj < 4; ++jj) sv[jj] += wih[hh] * fmaxf(acc[jj], 0.f); }
                            u32x4 w; w.x = ordkey(sv[0]); w.y = ordkey(sv[1]); w.z = ordkey(sv[2]); w.w = ordkey(sv[3]);
                            *(u32x4*)(scl + fr * 2052 + kt * 16 + fq * 4) = w;
                        }
                        if (i + 2 < 8) { const int ktn = (kt + 16) < qg ? (kt + 16) : qg; const char* kb = (const char*)(z + (Tb + (size_t)ktn * 16) * ZLD + C_KI);
                            unsigned lo2 = lofk; asm volatile("" : "+v"(lo2));
                            W0[i & 1] = *(const bf16x8*)(kb + lo2); W1[i & 1] = *(const bf16x8*)(kb + lo2 + 64); }
                    }
                }
            }
            __syncthreads();
#pragma unroll 1
            for (int qq = 0; qq < 2; ++qq) {
                const int q = 2 * wave + qq, qpos = q0 + q;
                unsigned uk[32];
#pragma unroll
                for (int r = 0; r < 32; ++r) { const int key = r * 64 + lane; uk[r] = 0x007fffffu;
                    if (r * 64 <= qpos) { const unsigned v = scl[q * 2052 + key]; uk[r] = (key <= qpos) ? v : 0x007fffffu; } }
                unsigned T = 0u; bool exact = false;
#pragma unroll 1
                for (int bit = 31; bit >= 0; --bit) {
                    const unsigned cand = T | (1u << bit); int c = 0;
#pragma unroll
                    for (int r = 0; r < 32; ++r) c += __builtin_popcountll(__builtin_amdgcn_ballot_w64(uk[r] >= cand));
                    if (c >= 256) { T = cand; if (c == 256) { exact = true; break; } }
                }
                int need = 0;
                if (!exact) { int c = 0;
#pragma unroll
                    for (int r = 0; r < 32; ++r) c += __builtin_popcountll(__builtin_amdgcn_ballot_w64(uk[r] > T));
                    need = 256 - c; }
#pragma unroll
                for (int r = 0; r < 32; ++r) {
                    if (r * 64 <= qpos) {
                        unsigned long long sel;
                        if (exact) sel = __builtin_amdgcn_ballot_w64(uk[r] >= T);
                        else { sel = __builtin_amdgcn_ballot_w64(uk[r] > T); unsigned long long e = __builtin_amdgcn_ballot_w64(uk[r] == T);
                            const int ne = __builtin_popcountll(e);
                            if (ne <= need) { sel |= e; need -= ne; }
                            else { for (int k = 0; k < need; ++k) { const unsigned long long lb = e & (0ull - e); sel |= lb; e ^= lb; } need = 0; } }
                        if (lane == 0) { selm[q * 64 + 2 * r] = (unsigned)sel; selm[q * 64 + 2 * r + 1] = (unsigned)(sel >> 32); }
                    }
                }
            }
        } else {
            for (int w = tid; w < 1024; w += NTHR) { const int q = w >> 6, word = w & 63, qpos = q0 + q, lo = word * 32;
                selm[w] = (qpos >= lo + 31) ? 0xffffffffu : (qpos < lo ? 0u : ((2u << (qpos - lo)) - 1u)); }
        }
        __syncthreads();
#pragma unroll 1
        for (int arep = 0; arep < 1 + REP(13); ++arep) {
            const int nchunk = (qg + 4) >> 2; const int lrow = tid >> 3, lseg = tid & 7;
            const bf16_t* kg = z + (Tb + lrow) * ZLD + C_KA + lseg * 8; const bf16_t* vg = F.vt + ((size_t)b * 64 + lrow) * SEQ + lseg * 8;
            const unsigned lst = (unsigned)(lrow * 144 + lseg * 16);
            u32x4 kx = *(const u32x4*)(kg), vx = *(const u32x4*)(vg), ky = kx, vy = vx;
            *(u32x4*)(kbuf + lst) = kx; *(u32x4*)(vbuf + lst) = vx;
            if (1 < nchunk) { kx = *(const u32x4*)(kg + (size_t)64 * ZLD); vx = *(const u32x4*)(vg + 64); }
            if (2 < nchunk) { ky = *(const u32x4*)(kg + (size_t)128 * ZLD); vy = *(const u32x4*)(vg + 128); }
            const int hp = wave >> 1, kh = wave & 1;
            bf16x8 Bqa[2][2];
#pragma unroll
            for (int hh = 0; hh < 2; ++hh)
#pragma unroll
                for (int ks = 0; ks < 2; ++ks) Bqa[hh][ks] = *(const bf16x8*)(zq + C_Q + (2 * hp + hh) * 64 + ks * 32 + fq * 8);
            f32x4 O[2][4]; f32x4 rs[2];
#pragma unroll
            for (int hh = 0; hh < 2; ++hh) { rs[hh] = zero4;
#pragma unroll
                for (int dt = 0; dt < 4; ++dt) O[hh][dt] = zero4; }
            lds_barrier();
#pragma unroll 1
            for (int c = 0; c < nchunk; c += 2) {
                attn_chunk(kbuf, vbuf, selm, c, kh, fr, fq, Bqa, O, rs);
                if (c + 1 < nchunk) { *(u32x4*)(kbuf + 9216 + lst) = kx; *(u32x4*)(vbuf + 9216 + lst) = vx; }
                if (c + 3 < nchunk) { kx = *(const u32x4*)(kg + (size_t)(c + 3) * 64 * ZLD); vx = *(const u32x4*)(vg + (c + 3) * 64); }
                lds_barrier();
                if (c + 1 < nchunk) {
                    attn_chunk(kbuf + 9216, vbuf + 9216, selm, c + 1, kh, fr, fq, Bqa, O, rs);
                    if (c + 2 < nchunk) { *(u32x4*)(kbuf + lst) = ky; *(u32x4*)(vbuf + lst) = vy; }
                    if (c + 4 < nchunk) { ky = *(const u32x4*)(kg + (size_t)(c + 4) * 64 * ZLD); vy = *(const u32x4*)(vg + (c + 4) * 64); }
                    lds_barrier();
                }
            }
            float* xb = (float*)(vbuf + 2 * 9216) + (size_t)wave * (64 * 17);
            { const int oh = kh ^ 1;
#pragma unroll
              for (int dt = 0; dt < 4; ++dt)
#pragma unroll
                  for (int jj = 0; jj < 4; ++jj) xb[(dt * 4 + jj) * 64 + lane] = (oh == 0) ? O[0][dt][jj] : O[1][dt][jj];
              xb[16 * 64 + lane] = (oh == 0) ? rs[0][0] : rs[1][0]; }
            lds_barrier();
            { const float* pb = (const float*)(vbuf + 2 * 9216) + (size_t)(wave ^ 1) * (64 * 17);
              float tot = ((kh == 0) ? rs[0][0] : rs[1][0]) + pb[16 * 64 + lane];
              const float inv = 1.0f / tot;
              bf16_t* yp = F.yb + (Tb + q0 + fr) * 512 + (2 * hp + kh) * 64 + fq * 4;
#pragma unroll
              for (int dt = 0; dt < 4; ++dt) { float o[4];
#pragma unroll
                  for (int jj = 0; jj < 4; ++jj) o[jj] = (((kh == 0) ? O[0][dt][jj] : O[1][dt][jj]) + pb[(dt * 4 + jj) * 64 + lane]) * inv;
                  uint2 w; w.x = cvt_pk_bf16(o[0], o[1]); w.y = cvt_pk_bf16(o[2], o[3]); *(uint2*)(yp + dt * 16) = w; } }
        }
        __syncthreads();
    }
}

__device__ __forceinline__ void p4_post(const Frame& F) {
    const int tid = F.tid; const float* mu = F.in[3]; const float* gnw = F.in[12]; const float* gnb = F.in[13]; const bf16_t* z = F.z;
    for (int g = blockIdx.x * 16 + (tid >> 5); g < NTOK * 8; g += gridDim.x * 16) { const size_t t = (size_t)(g >> 3); const int h = g & 7, c = h * 64 + (tid & 31) * 2;
        const float2 y = *(const float2*)(F.yraw + t * 512 + c);
        const float mean = red32(y.x + y.y) * (1.0f / 64.0f); const float dx = y.x - mean, dy = y.y - mean;
        const float var = red32(dx * dx + dy * dy) * (1.0f / 64.0f); const float rstd = rsqrtf(var + 64e-5f);
        const unsigned vc = *(const unsigned*)(z + t * ZLD + C_V + c); const unsigned vp = (t & (SEQ - 1)) ? *(const unsigned*)(z + (t - 1) * ZLD + C_V + c) : 0u;
        const float vs0 = bflo(vc) + (bflo(vp) - bflo(vc)) * mu[C_V + c], vs1 = bfhi(vc) + (bfhi(vp) - bfhi(vc)) * mu[C_V + c + 1];
        const float bon = F.bonus[t * 8 + h]; const unsigned gt = *(const unsigned*)(F.gt + t * 512 + c);
        const float o0 = (dx * rstd * gnw[c] + gnb[c] + bon * vs0) * bflo(gt), o1 = (dy * rstd * gnw[c + 1] + gnb[c + 1] + bon * vs1) * bfhi(gt);
        *(unsigned*)(F.ya + t * 512 + c) = cvt_pk_bf16(o0, o1); }
}

__device__ __forceinline__ void p9_final(const Frame& F, const bool ident) {
    const float* g = F.in[19]; const int lane = F.lane;
    for (int row = blockIdx.x * 8 + F.wave; row < NTOK; row += gridDim.x * 8) {
        float* xr = F.out + (size_t)row * DM; const float sc = ident ? 1.0f : rsqrtf(F.ss2[row] * (1.0f / 1024.0f) + 1e-6f);
#pragma unroll
        for (int i = 0; i < 4; ++i) { f32x4 v = *(const f32x4*)(xr + i * 256 + lane * 4); const f32x4 gg = *(const f32x4*)(g + i * 256 + lane * 4);
            if (!ident) { v[0] *= sc * gg[0]; v[1] *= sc * gg[1]; v[2] *= sc * gg[2]; v[3] *= sc * gg[3]; } *(f32x4*)(xr + i * 256 + lane * 4) = v; }
    }
}
#define XB_TMO      128
#define XB_XCNT(j)  (256  + 64 * (j))
#define XB_XSUB(j)  (1280 + 64 * (j))
#define XB_XGEN(j)  (2304 + 64 * (j))
#define XB_TOP      3328
#define XB_TOPGEN   3392
#define XCD_BAR_WORDS 3456
#define XB_SPIN_CAP (1u << 18)
#define LAS __attribute__((address_space(3)))

__device__ __forceinline__ unsigned xb_ld(unsigned* p)              { return __hip_atomic_load(p, __ATOMIC_RELAXED, __HIP_MEMORY_SCOPE_AGENT); }
__device__ __forceinline__ unsigned xb_add(unsigned* p, unsigned v) { return __hip_atomic_fetch_add(p, v, __ATOMIC_RELAXED, __HIP_MEMORY_SCOPE_AGENT); }
__device__ __forceinline__ unsigned xb_xcc_id() { return (unsigned)__builtin_amdgcn_s_getreg((3 << 11) | 20) & 0xFu; }
#define XB_SPIN(cond, bar) do { unsigned _sp = 0; while (cond) { __builtin_amdgcn_s_sleep(1); \
    if ((++_sp & 255u) == 0u) { if (xb_ld(&(bar)[XB_TMO])) break; if (_sp > XB_SPIN_CAP) { atomicAdd(&(bar)[XB_TMO], 1u); break; } } } } while (0)

struct XcdBarrier {
    unsigned* bar; unsigned x;
    volatile LAS unsigned* st;
};

__device__ __forceinline__ XcdBarrier xcd_barrier_post(unsigned* bar, volatile LAS unsigned* st) {
    XcdBarrier b; b.bar = bar; b.x = xb_xcc_id(); b.st = st;
    if (threadIdx.x == 0) (void)xb_add(&bar[XB_XCNT(b.x)], 1u);
    return b;
}
__device__ __forceinline__ void xcd_barrier_complete(unsigned* bar, unsigned x, unsigned& nloc, unsigned& nx) {
    const unsigned G = gridDim.x * gridDim.y * gridDim.z;
    unsigned sum, cnt, mine, sp = 0u;
    for (;;) {
        sum = 0u; cnt = 0u; mine = 0u;
#pragma unroll
        for (unsigned j = 0; j < 16; ++j) { const unsigned c = xb_ld(&bar[XB_XCNT(j)]); sum += c; cnt += (c > 0u) ? 1u : 0u; mine = (j == x) ? c : mine; }
        if (sum == G) break;
        __builtin_amdgcn_s_sleep(1);
        if ((++sp & 255u) == 0u) { if (xb_ld(&bar[XB_TMO])) break; if (sp > XB_SPIN_CAP) { atomicAdd(&bar[XB_TMO], 1u); break; } }
    }
    nloc = mine > 0u ? mine : 1u; nx = cnt > 0u ? cnt : 1u;
}

__device__ __forceinline__ void xcd_barrier(const XcdBarrier& b) {
    asm volatile("s_waitcnt vmcnt(0)" ::: "memory");
    __syncthreads();
    if (threadIdx.x == 0) {
        unsigned* bar = b.bar;
        __builtin_amdgcn_s_waitcnt(0);
        unsigned nloc = b.st[0], nx = b.st[1];
        if (nloc == 0u) { xcd_barrier_complete(bar, b.x, nloc, nx); b.st[0] = nloc; b.st[1] = nx; }
        const unsigned old = xb_add(&bar[XB_XSUB(b.x)], 1u);
        const unsigned gen = old / nloc;
        if (old + 1u == (gen + 1u) * nloc) {
            __builtin_amdgcn_fence(__ATOMIC_RELEASE, "agent");
            asm volatile("s_waitcnt vmcnt(0)" ::: "memory");
            const unsigned og = xb_add(&bar[XB_TOP], 1u);
            const unsigned tg = og / nx;
            if (og + 1u == (tg + 1u) * nx) xb_add(&bar[XB_TOPGEN], 1u);
            else XB_SPIN(xb_ld(&bar[XB_TOPGEN]) == tg, bar);
            __builtin_amdgcn_fence(__ATOMIC_ACQUIRE, "agent");
            xb_add(&bar[XB_XGEN(b.x)], 1u);
            asm volatile("s_waitcnt vmcnt(0)" ::: "memory");
        } else {
            XB_SPIN(xb_ld(&bar[XB_XGEN(b.x)]) == gen, bar);
            __builtin_amdgcn_fence(__ATOMIC_ACQUIRE, "agent");
            asm volatile("s_waitcnt vmcnt(0)" ::: "memory");
        }
    }
    __syncthreads();
}
#ifndef PHASE_MASK
#define PHASE_MASK 0x3ff
#endif
#ifndef GEMM_ALIGN
#define GEMM_ALIGN true
#endif
#ifndef GEMM_SP2
#define GEMM_SP2 true
#endif
constexpr int NPHASE = 10;
constexpr size_t WS_BAR = 3 * MiB;
template <class Epi> __device__ __forceinline__ void run_gemm(const bf16_t* A, const bf16_t* Bt, int N, int K, const Epi& E) {
    pg8::Gemm g{A, Bt, NTOK, N, K}; pg8::StaticOrder S; S.init(NTOK, N, (int)gridDim.x, (int)blockIdx.x);
    pg8::gemm_phase<Epi, pg8::StaticOrder, GEMM_ALIGN, GEMM_SP2>((PG8_LAS unsigned char*)g_lds, g, S, E);
}
__global__ void __launch_bounds__(NTHR, 2) mega_fwd(Args args) {
    Frame F;
#pragma unroll
    for (int i = 0; i < 20; ++i) F.in[i] = args.in[i];
    F.out = args.out; F.ws = args.ws; F.lds = nullptr; F.tid = threadIdx.x; F.lane = F.tid & 63; F.wave = __builtin_amdgcn_readfirstlane(F.tid >> 6);
    unsigned char* ws = args.ws;
    F.ss1 = (float*)(ws + WS_SS1); F.ss2 = (float*)(ws + WS_SS2); F.bonus = (float*)(ws + WS_BONUS); F.rope = (float2*)(ws + WS_ROPE);
    F.wd = (bf16_t*)(ws + WS_WD); F.wi = (bf16_t*)(ws + WS_WI); F.wg = (bf16_t*)(ws + WS_WG);
    F.win = (bf16_t*)(ws + WS_WIN); F.wup = (bf16_t*)(ws + WS_WUP); F.wdn = (bf16_t*)(ws + WS_WDN); F.wb = (bf16_t*)(ws + WS_WB); F.wo = (bf16_t*)(ws + WS_WO); F.vt = (bf16_t*)(ws + WS_VT);
    F.h = (bf16_t*)(ws + WS_H); F.ya = F.h; F.yb = F.h + (size_t)NTOK * 512; F.xb = F.h;
    F.z = (bf16_t*)(ws + WS_Z); F.hid = F.z;
    F.lw = (bf16_t*)(ws + WS_P); F.ic = F.lw + (size_t)NTOK * 512; F.mg = F.lw;
    F.yraw = args.out; F.gt = (bf16_t*)(args.out + (size_t)NTOK * 512);
    const int lo = args.ph_lo, hi = args.ph_hi;
    cg::grid_group grid = cg::this_grid();
    if (args.ph_lo < 0) grid.sync();
    volatile LAS unsigned* xst = (volatile LAS unsigned*)(g_lds + LDS_BYTES - 64);
    if (threadIdx.x == 0) { xst[0] = 0u; xst[1] = 0u; }
    __syncthreads();
    XcdBarrier xbar = xcd_barrier_post((unsigned*)(ws + WS_BAR), xst);
#define IN(k) (lo <= (k) && (k) < hi)
#define SEAM(k) do { if (IN(k) && IN((k) + 1)) { xcd_barrier(xbar); if (REP(17)) xcd_barrier(xbar); } } while (0)
    if (((PHASE_MASK >> 0) & 1) && IN(0)) { p0_prologue(F); __syncthreads(); if (REP(0)) { p0_prologue(F); __syncthreads(); } } SEAM(0);
    if (((PHASE_MASK >> 1) & 1) && IN(1)) { pg8::EpiZ E{F.z, ZLD}; run_gemm(F.h, F.win, 5120, 1024, E); __syncthreads(); if (REP(1)) { run_gemm(F.h, F.win, 5120, 1024, E); __syncthreads(); } if (REP(18)) { run_gemm(F.h, F.win, 4096, 1024, E); __syncthreads(); } } SEAM(1);
    if (((PHASE_MASK >> 2) & 1) && IN(2)) { if (REP(2)) { p2_prep(F, 0); __syncthreads(); } if (REP(16)) { p2_prep(F, 2); __syncthreads(); } p2_prep(F, 1); __syncthreads(); } SEAM(2);
    if (((PHASE_MASK >> 3) & 1) && IN(3)) { if (REP(14)) { p3_scan(F, 1); __syncthreads(); } if (REP(15)) { p3_scan(F, 2); __syncthreads(); } if (REP(3)) { p3_scan(F, 0); __syncthreads(); } p3_scan(F, 0); __syncthreads(); p3_dsa(F); __syncthreads(); if (REP(10)) { p3_dsa(F); __syncthreads(); } } SEAM(3);
    if (((PHASE_MASK >> 4) & 1) && IN(4)) { p4_post(F); __syncthreads(); if (REP(4)) { p4_post(F); __syncthreads(); } } SEAM(4);
    if (((PHASE_MASK >> 5) & 1) && IN(5)) { pg8::EpiGate<0> E0{F.mg, F.z, ZLD, C_G0}; run_gemm(F.ya, F.wb, 1024, 512, E0); __syncthreads();
                 pg8::EpiGate<1> E1{F.mg, F.z, ZLD, C_G1}; run_gemm(F.yb, F.wb + 1024 * 512, 1024, 512, E1); __syncthreads();
                 if (REP(5)) { run_gemm(F.ya, F.wb, 1024, 512, E0); __syncthreads(); run_gemm(F.yb, F.wb + 1024 * 512, 1024, 512, E1); __syncthreads(); } } SEAM(5);
    if (((PHASE_MASK >> 6) & 1) && IN(6)) { if (REP(6)) { pg8::EpiRes1 Ex{F.in[0], F.xb, F.bonus}; run_gemm(F.mg, F.wo, 1024, 1024, Ex); __syncthreads(); }
                 pg8::EpiRes1 E{F.in[0], F.xb, F.ss1}; run_gemm(F.mg, F.wo, 1024, 1024, E); __syncthreads(); } SEAM(6);
    if (((PHASE_MASK >> 7) & 1) && IN(7)) { pg8::EpiHid E{F.hid, F.ss1}; run_gemm(F.xb, F.wup, 4096, 1024, E); __syncthreads(); if (REP(7)) { run_gemm(F.xb, F.wup, 4096, 1024, E); __syncthreads(); } } SEAM(7);
    if (((PHASE_MASK >> 8) & 1) && IN(8)) { pg8::EpiRes2 E{F.xb, F.out, F.ss2}; run_gemm(F.hid, F.wdn, 1024, 4096, E); __syncthreads(); } SEAM(8);
    if (((PHASE_MASK >> 9) & 1) && IN(9)) { if (REP(9)) { p9_final(F, true); __syncthreads(); } p9_final(F, false); }
#undef IN
#undef SEAM
}

extern "C" void kernel_launch(void* const* d_in, const int* in_sizes, int n_in, void* d_out, int out_size, void* d_ws, size_t ws_size, hipStream_t stream) {
    static int grid = 0;
    if (grid == 0) {
        if (n_in != 20 || out_size != NTOK * DM || ws_size < WS_END) { fprintf(stderr, "kernel_launch: unexpected shapes (n_in %d, out %d, ws %zu < %zu)\n", n_in, out_size, ws_size, (size_t)WS_END); grid = -1; return; }
        int dev = 0, cus = 0, per_cu = 0;
        hipGetDevice(&dev); hipDeviceGetAttribute(&cus, hipDeviceAttributeMultiprocessorCount, dev);
        if (hipFuncSetAttribute((const void*)mega_fwd, hipFuncAttributeMaxDynamicSharedMemorySize, LDS_BYTES) != hipSuccess) { fprintf(stderr, "kernel_launch: hipFuncSetAttribute failed\n"); grid = -1; return; }
        if (hipOccupancyMaxActiveBlocksPerMultiprocessor(&per_cu, (const void*)mega_fwd, NTHR, LDS_BYTES) != hipSuccess || per_cu < 1) { fprintf(stderr, "kernel_launch: occupancy query failed (%d)\n", per_cu); per_cu = 1; }
        (void)hipGetLastError();
        grid = cus * per_cu;
        fprintf(stderr, "kernel_launch: grid %d (%d CUs x %d)\n", grid, cus, per_cu);
    }
    if (grid < 0) return;
    if (hipMemsetAsync((char*)d_ws + WS_BAR, 0, XCD_BAR_WORDS * 4, stream) != hipSuccess) { fprintf(stderr, "kernel_launch: memset of the barrier words failed\n"); return; }
    Args a{};
    for (int i = 0; i < 20; ++i) a.in[i] = (const float*)d_in[i];
    a.out = (float*)d_out; a.ws = (unsigned char*)d_ws;
#if MK_PER_PHASE_LAUNCH
    for (int p = 0; p < NPHASE; ++p) { a.ph_lo = p; a.ph_hi = p + 1; hipLaunchKernelGGL(mega_fwd, dim3(grid), dim3(NTHR), LDS_BYTES, stream, a); }
#else
    a.ph_lo = 0; a.ph_hi = NPHASE;
    void* kargs[] = {&a};
    hipError_t e = hipLaunchCooperativeKernel((const void*)mega_fwd, dim3(grid), dim3(NTHR), kargs, LDS_BYTES, stream);
    if (e != hipSuccess) fprintf(stderr, "kernel_launch: cooperative launch failed: %s (grid %d)\n", hipGetErrorString(e), grid);
#endif
}
```

```cpp
#include <hip/hip_runtime.h>
#include <hip/hip_cooperative_groups.h>
#include <cstdio>
#include <cstdint>
namespace cg = cooperative_groups;

#ifndef MK_PER_PHASE_LAUNCH
#define MK_PER_PHASE_LAUNCH 0
#endif

#ifndef REPEAT_MASK
#define REPEAT_MASK 0
#endif
#define REP(k) ((REPEAT_MASK >> (k)) & 1)
#ifndef TS_SEL
#define TS_SEL -1
#endif

namespace pg8 {
#define PG8_LAS __attribute__((address_space(3)))
typedef unsigned short bf16_t;
typedef short bf16x8 __attribute__((ext_vector_type(8)));
typedef float f32x4 __attribute__((ext_vector_type(4)));
typedef unsigned u32x4 __attribute__((ext_vector_type(4)));
constexpr int BM = 256, BK = 64, HALF = 128, HTB = HALF * BK * 2  , STAGE_BYTES = 8 * HTB, NXCD = 8, WGM = 8;

__host__ __device__ __forceinline__ int lds_byte(int r, int c) { const int st = (r >> 4) * 2 + (c >> 5), rr = r & 15, cc = c & 31, ob = rr * 64 + cc * 2; return st * 1024 + (ob ^ (((ob >> 9) & 1) << 5)); }
__host__ __device__ __forceinline__ void stage_rc(int b, int& R, int& C) { const int st = b / 1024, sb = b % 1024, swz = sb ^ (((sb >> 9) & 1) << 5); R = (st >> 1) * 16 + swz / 64; C = (st & 1) * 32 + (swz % 64) / 2; }
__host__ __device__ __forceinline__ int perm32(int rho) { const int n = rho >> 4, i = rho & 15; return 8 * (i >> 2) + 4 * n + (i & 3); }

struct Unit { int pm, pn; };
struct Gemm { const bf16_t* A; const bf16_t* Bt; int M, N, K; };

struct StaticOrder {
    int nM, nN, nwg, G, c;
    __host__ __device__ void init(int M, int N, int G_, int c_) { nM = M / BM; nN = N / BM; nwg = nM * nN; G = G_; c = c_; }
    __host__ __device__ bool next(int i, Unit& u) const {
        const long L = (long)i * G + c; if (L >= nwg) return false;
        int wgid = (int)L; { const int q = nwg / NXCD, r = nwg % NXCD, xcd = wgid % NXCD, off = wgid / NXCD; wgid = (xcd < r ? xcd * (q + 1) : r * (q + 1) + (xcd - r) * q) + off; }
        const int nig = WGM * nN, gid = wgid / nig, fm = gid * WGM, gsz = (nM - fm) < WGM ? (nM - fm) : WGM;
        u.pm = fm + ((wgid % nig) % gsz); u.pn = (wgid % nig) / gsz; return true;
    }
    __device__ __forceinline__ void a_ready(const Unit&) const {}
    __device__ __forceinline__ void done(const Unit&) const {}
};
__device__ __forceinline__ unsigned cvt_pk_bf16(float lo, float hi) { unsigned r; asm volatile("v_cvt_pk_bf16_f32 %0, %1, %2" : "=v"(r) : "v"(lo), "v"(hi)); return r; }
typedef float f32x2 __attribute__((ext_vector_type(2)));
__device__ __forceinline__ float bflo(unsigned u) { return __uint_as_float(u << 16); }
__device__ __forceinline__ float bfhi(unsigned u) { return __uint_as_float(u & 0xffff0000u); }
__device__ __forceinline__ float sigm(float x) { return 1.0f / (1.0f + __expf(-x)); }

struct EpiZ {
    static constexpr bool PERM = true, AFTER_DRAIN = false;
    bf16_t* O; int ldc;
    __device__ __forceinline__ void operator()(const f32x4 (&acc)[2][2][4][2], const Unit& u, int wr, int wc, int fr, int fq) const {
        const int row0 = u.pm * BM + wr * 64 + fr, col0 = u.pn * BM + wc * 32 + 8 * fq;
#pragma unroll
        for (int ai = 0; ai < 2; ++ai)
#pragma unroll
            for (int m = 0; m < 4; ++m) { bf16_t* rowp = O + (size_t)(row0 + ai * HALF + m * 16) * ldc + col0;
#pragma unroll
                for (int bj = 0; bj < 2; ++bj) { const f32x4 v0 = acc[ai][bj][m][0], v1 = acc[ai][bj][m][1];
                    u32x4 w; w.x = cvt_pk_bf16(v0[0], v0[1]); w.y = cvt_pk_bf16(v0[2], v0[3]); w.z = cvt_pk_bf16(v1[0], v1[1]); w.w = cvt_pk_bf16(v1[2], v1[3]);
                    *(u32x4*)(rowp + bj * HALF) = w; } }
    }
};
template <int MODE> struct EpiGate {
    static constexpr bool PERM = true, AFTER_DRAIN = false;
    bf16_t* O; const bf16_t* Z; int zld; int gcol;
    __device__ __forceinline__ void operator()(const f32x4 (&acc)[2][2][4][2], const Unit& u, int wr, int wc, int fr, int fq) const {
        const int row0 = u.pm * BM + wr * 64 + fr, col0 = u.pn * BM + wc * 32 + 8 * fq;
#pragma unroll
        for (int ai = 0; ai < 2; ++ai)
#pragma unroll
            for (int m = 0; m < 4; ++m) { const size_t row = (size_t)(row0 + ai * HALF + m * 16);
                bf16_t* op = O + row * 1024 + col0; const bf16_t* zp = Z + row * zld + gcol + col0;
#pragma unroll
                for (int bj = 0; bj < 2; ++bj) { const f32x4 v0 = acc[ai][bj][m][0], v1 = acc[ai][bj][m][1];
                    const u32x4 g = *(const u32x4*)(zp + bj * HALF);
                    float r0 = v0[0] * sigm(bflo(g.x)), r1 = v0[1] * sigm(bfhi(g.x)), r2 = v0[2] * sigm(bflo(g.y)), r3 = v0[3] * sigm(bfhi(g.y));
                    float r4 = v1[0] * sigm(bflo(g.z)), r5 = v1[1] * sigm(bfhi(g.z)), r6 = v1[2] * sigm(bflo(g.w)), r7 = v1[3] * sigm(bfhi(g.w));
                    if (MODE == 1) { const u32x4 p = *(const u32x4*)(op + bj * HALF);
                        r0 += bflo(p.x); r1 += bfhi(p.x); r2 += bflo(p.y); r3 += bfhi(p.y); r4 += bflo(p.z); r5 += bfhi(p.z); r6 += bflo(p.w); r7 += bfhi(p.w); }
                    u32x4 w; w.x = cvt_pk_bf16(r0, r1); w.y = cvt_pk_bf16(r2, r3); w.z = cvt_pk_bf16(r4, r5); w.w = cvt_pk_bf16(r6, r7);
                    *(u32x4*)(op + bj * HALF) = w; } }
    }
};
struct EpiRes1 {
    static constexpr bool PERM = false, AFTER_DRAIN = false;
    const float* X; bf16_t* XB; float* SS;
    __device__ __forceinline__ void operator()(const f32x4 (&acc)[2][2][4][2], const Unit& u, int wr, int wc, int fr, int fq) const {
        const int row0 = u.pm * BM + wr * 64 + fr, col0 = u.pn * BM + wc * 32 + 4 * fq;
#pragma unroll
        for (int ai = 0; ai < 2; ++ai)
#pragma unroll
            for (int m = 0; m < 4; ++m) { const size_t row = (size_t)(row0 + ai * HALF + m * 16); float ssq = 0.f;
#pragma unroll
                for (int bj = 0; bj < 2; ++bj)
#pragma unroll
                    for (int n = 0; n < 2; ++n) { const size_t off = row * 1024 + col0 + bj * HALF + n * 16;
                        const f32x4 xv = *(const f32x4*)(X + off); const f32x4 v = acc[ai][bj][m][n] + xv;
                        ssq += v[0] * v[0] + v[1] * v[1] + v[2] * v[2] + v[3] * v[3];
                        uint2 w; w.x = cvt_pk_bf16(v[0], v[1]); w.y = cvt_pk_bf16(v[2], v[3]); *(uint2*)(XB + off) = w; }
                ssq += __shfl_xor(ssq, 16); ssq += __shfl_xor(ssq, 32);
                if (fq == 0) atomicAdd(SS + row, ssq); }
    }
};
struct EpiRes2 {
    static constexpr bool PERM = false, AFTER_DRAIN = false;
    const bf16_t* XB; float* O; float* SS;
    __device__ __forceinline__ void operator()(const f32x4 (&acc)[2][2][4][2], const Unit& u, int wr, int wc, int fr, int fq) const {
        const int row0 = u.pm * BM + wr * 64 + fr, col0 = u.pn * BM + wc * 32 + 4 * fq;
#pragma unroll
        for (int ai = 0; ai < 2; ++ai)
#pragma unroll
            for (int m = 0; m < 4; ++m) { const size_t row = (size_t)(row0 + ai * HALF + m * 16); float ssq = 0.f;
#pragma unroll
                for (int bj = 0; bj < 2; ++bj)
#pragma unroll
                    for (int n = 0; n < 2; ++n) { const size_t off = row * 1024 + col0 + bj * HALF + n * 16;
                        const uint2 xw = *(const uint2*)(XB + off); f32x4 v = acc[ai][bj][m][n];
                        v[0] += bflo(xw.x); v[1] += bfhi(xw.x); v[2] += bflo(xw.y); v[3] += bfhi(xw.y);
                        *(f32x4*)(O + off) = v; ssq += v[0] * v[0] + v[1] * v[1] + v[2] * v[2] + v[3] * v[3]; }
                ssq += __shfl_xor(ssq, 16); ssq += __shfl_xor(ssq, 32);
                if (fq == 0) atomicAdd(SS + row, ssq); }
    }
};
struct EpiHid {
    static constexpr bool PERM = true, AFTER_DRAIN = false;
    bf16_t* O; const float* SS;
    __device__ __forceinline__ void operator()(const f32x4 (&acc)[2][2][4][2], const Unit& u, int wr, int wc, int fr, int fq) const {
        const int row0 = u.pm * BM + wr * 64 + fr, col0 = u.pn * BM + wc * 32 + 8 * fq;
#pragma unroll
        for (int ai = 0; ai < 2; ++ai)
#pragma unroll
            for (int m = 0; m < 4; ++m) { const size_t row = (size_t)(row0 + ai * HALF + m * 16);
                const float s2 = 1.0f / (SS[row] * (1.0f / 1024.0f) + 1e-6f);
                bf16_t* rowp = O + row * 4096 + col0;
#pragma unroll
                for (int bj = 0; bj < 2; ++bj) { f32x4 v0 = acc[ai][bj][m][0], v1 = acc[ai][bj][m][1];
#pragma unroll
                    for (int j = 0; j < 4; ++j) { float a = fmaxf(v0[j], 0.f), b = fmaxf(v1[j], 0.f); v0[j] = a * a * s2; v1[j] = b * b * s2; }
                    u32x4 w; w.x = cvt_pk_bf16(v0[0], v0[1]); w.y = cvt_pk_bf16(v0[2], v0[3]); w.z = cvt_pk_bf16(v1[0], v1[1]); w.w = cvt_pk_bf16(v1[2], v1[3]);
                    *(u32x4*)(rowp + bj * HALF) = w; } }
    }
};

template <class Epi, class Sched, bool ALIGN_EPI = false, bool SP2 = false>
__device__ __forceinline__ void gemm_phase(PG8_LAS unsigned char* lds, const Gemm g, const Sched& S, const Epi& E) {
    const int tid = threadIdx.x, wid = __builtin_amdgcn_readfirstlane(tid >> 6), lane = tid & 63, wr = wid >> 2, wc = wid & 3, fr = lane & 15, fq = lane >> 4;
    const int K = g.K, nt = K / BK;
    unsigned voffA[2], voffB[2];
#pragma unroll
    for (int i = 0; i < 2; ++i) { int R, C; stage_rc(tid * 16 + i * 8192, R, C); const int Rb = Epi::PERM ? ((R & ~31) + perm32(R & 31)) : R;
        voffA[i] = (unsigned)(R * K + C) * 2u; voffB[i] = (unsigned)(Rb * K + C) * 2u; }
    const size_t kstep = (size_t)(BK * 2);
    const size_t hstep = (size_t)HALF * K * 2;
    const size_t tstep = 2 * hstep;
    const unsigned ldsw = (unsigned)wid * 1024u;
    const int aoff = lds_byte(wr * 64 + fr, fq * 8), boff = lds_byte(wc * 32 + fr, fq * 8);
#define PG8_SA(b, h) (((b) * 2 + (h)) * HTB)
#define PG8_SB(b, h) ((4 + (b) * 2 + (h)) * HTB)
#define PG8_STAGE(bufoff, gbase, voff) do { _Pragma("unroll") for (int _i = 0; _i < 2; ++_i) \
        __builtin_amdgcn_global_load_lds((const unsigned*)((const char*)(gbase) + (voff)[_i]), (PG8_LAS unsigned*)(lds + (bufoff) + ldsw + _i * 8192), 16, 0, 0); } while (0)
#define PG8_LDA(dst, b, h) do { _Pragma("unroll") for (int m = 0; m < 4; ++m) _Pragma("unroll") for (int k = 0; k < 2; ++k) dst[m][k] = *(const PG8_LAS bf16x8*)(lds + PG8_SA(b, h) + aoff + m * 2048 + k * 1024); } while (0)
#define PG8_LDB(dst, b, h) do { _Pragma("unroll") for (int n = 0; n < 2; ++n) _Pragma("unroll") for (int k = 0; k < 2; ++k) dst[n][k] = *(const PG8_LAS bf16x8*)(lds + PG8_SB(b, h) + boff + n * 2048 + k * 1024); } while (0)
#define PG8_MMA(ai, bj, At, Bt) do { __builtin_amdgcn_s_setprio(1); _Pragma("unroll") for (int m = 0; m < 4; ++m) _Pragma("unroll") for (int n = 0; n < 2; ++n) _Pragma("unroll") for (int k = 0; k < 2; ++k) \
        acc[ai][bj][m][n] = __builtin_amdgcn_mfma_f32_16x16x32_bf16(Bt[n][k], At[m][k], acc[ai][bj][m][n], 0, 0, 0); __builtin_amdgcn_s_setprio(0); } while (0)
#define PG8_WAIT_V(n) asm volatile("s_waitcnt vmcnt(" #n ")" ::: "memory")
#define PG8_WAIT_L(n) asm volatile("s_waitcnt lgkmcnt(" #n ")" ::: "memory")
#define PG8_BAR __builtin_amdgcn_s_barrier()
#define PG8_SCHED __builtin_amdgcn_sched_barrier(0)
    Unit cur, nxt; int ui = 0;
    if (!S.next(0, cur)) return;
    f32x4 acc[2][2][4][2];
#pragma unroll
    for (int a = 0; a < 2; ++a)
#pragma unroll
        for (int b = 0; b < 2; ++b)
#pragma unroll
            for (int m = 0; m < 4; ++m)
#pragma unroll
                for (int n = 0; n < 2; ++n) acc[a][b][m][n] = (f32x4){0.f, 0.f, 0.f, 0.f};
    bf16x8 At[4][2], B0[2][2], B1[2][2];
    const char* cA = (const char*)g.A + (size_t)cur.pm * tstep; const char* cB = (const char*)g.Bt + (size_t)cur.pn * tstep;
    S.a_ready(cur);
    if constexpr (SP2) {
        PG8_STAGE(PG8_SB(0, 0), cB, voffB); PG8_STAGE(PG8_SB(0, 1), cB + hstep, voffB); PG8_STAGE(PG8_SA(0, 0), cA, voffA); PG8_STAGE(PG8_SA(0, 1), cA + hstep, voffA);
        if (wr == 1) PG8_BAR;
        PG8_WAIT_V(2); PG8_BAR;
        PG8_STAGE(PG8_SB(1, 0), cB + kstep, voffB); PG8_STAGE(PG8_SA(1, 0), cA + kstep, voffA); PG8_STAGE(PG8_SB(1, 1), cB + hstep + kstep, voffB);
        PG8_WAIT_V(6); PG8_BAR;
    } else {
        PG8_STAGE(PG8_SB(0, 0), cB, voffB); PG8_STAGE(PG8_SA(0, 0), cA, voffA); PG8_STAGE(PG8_SB(0, 1), cB + hstep, voffB); PG8_STAGE(PG8_SA(0, 1), cA + hstep, voffA);
        if (wr == 1) PG8_BAR;
        PG8_WAIT_V(4); PG8_BAR;
        PG8_STAGE(PG8_SB(1, 0), cB + kstep, voffB); PG8_STAGE(PG8_SA(1, 0), cA + kstep, voffA); PG8_STAGE(PG8_SB(1, 1), cB + hstep + kstep, voffB);
        PG8_WAIT_V(6); PG8_BAR;
    }
    for (;;) {
        const bool has_next = S.next(ui + 1, nxt);
        const char* nA = has_next ? (const char*)g.A + (size_t)nxt.pm * tstep : cA; const char* nB = has_next ? (const char*)g.Bt + (size_t)nxt.pn * tstep : cB;
        for (int t = 0; t < nt; t += 2) {
            const bool last = (t == nt - 2);
            const char* a1 = cA + (size_t)(t + 1) * kstep;
            const char* a2 = last ? nA : cA + (size_t)(t + 2) * kstep; const char* b2 = last ? nB : cB + (size_t)(t + 2) * kstep;
            const char* a3 = a2 + kstep; const char* b3 = b2 + kstep;
            if (last && has_next) S.a_ready(nxt);
            if constexpr (SP2) {
            PG8_LDB(B0, 0, 0); PG8_LDB(B1, 0, 1); PG8_SCHED; PG8_LDA(At, 0, 0); PG8_STAGE(PG8_SA(1, 1), a1 + hstep, voffA);
            PG8_WAIT_V(8); PG8_WAIT_L(0); PG8_BAR; PG8_MMA(0, 0, At, B0); PG8_MMA(0, 1, At, B1); PG8_BAR; PG8_SCHED;
            PG8_LDA(At, 0, 1); PG8_STAGE(PG8_SB(0, 0), b2, voffB); PG8_STAGE(PG8_SB(0, 1), b2 + hstep, voffB); PG8_STAGE(PG8_SA(0, 0), a2, voffA);
            PG8_WAIT_V(8); PG8_WAIT_L(0); PG8_BAR; PG8_MMA(1, 0, At, B0); PG8_MMA(1, 1, At, B1); PG8_BAR; PG8_SCHED;
            PG8_LDB(B0, 1, 0); PG8_LDB(B1, 1, 1); PG8_SCHED; PG8_LDA(At, 1, 0); PG8_STAGE(PG8_SA(0, 1), a2 + hstep, voffA);
            PG8_WAIT_V(8); PG8_WAIT_L(0); PG8_BAR; PG8_MMA(0, 0, At, B0); PG8_MMA(0, 1, At, B1); PG8_BAR; PG8_SCHED;
            PG8_LDA(At, 1, 1); PG8_STAGE(PG8_SB(1, 0), b3, voffB); PG8_STAGE(PG8_SB(1, 1), b3 + hstep, voffB); PG8_STAGE(PG8_SA(1, 0), a3, voffA);
            PG8_WAIT_V(8); PG8_WAIT_L(0); PG8_BAR; PG8_MMA(1, 0, At, B0); PG8_MMA(1, 1, At, B1); PG8_BAR; PG8_SCHED;
            } else {
            PG8_LDB(B0, 0, 0); PG8_SCHED; PG8_LDA(At, 0, 0); PG8_STAGE(PG8_SA(1, 1), a1 + hstep, voffA);
            PG8_WAIT_L(8); PG8_BAR; PG8_WAIT_L(0); PG8_MMA(0, 0, At, B0); PG8_BAR; PG8_SCHED;
            PG8_LDB(B1, 0, 1); PG8_STAGE(PG8_SB(0, 0), b2, voffB);
            PG8_BAR; PG8_WAIT_L(0); PG8_MMA(0, 1, At, B1); PG8_BAR;
            PG8_LDA(At, 0, 1); PG8_STAGE(PG8_SA(0, 0), a2, voffA);
            PG8_BAR; PG8_WAIT_L(0); PG8_MMA(1, 0, At, B0); PG8_BAR; PG8_SCHED;
            PG8_STAGE(PG8_SB(0, 1), b2 + hstep, voffB);
            PG8_WAIT_V(6); PG8_BAR; PG8_MMA(1, 1, At, B1); PG8_BAR;
            PG8_LDB(B0, 1, 0); PG8_SCHED; PG8_LDA(At, 1, 0); PG8_STAGE(PG8_SA(0, 1), a2 + hstep, voffA);
            PG8_WAIT_L(8); PG8_BAR; PG8_WAIT_L(0); PG8_MMA(0, 0, At, B0); PG8_BAR; PG8_SCHED;
            PG8_LDB(B1, 1, 1); PG8_STAGE(PG8_SB(1, 0), b3, voffB);
            PG8_BAR; PG8_WAIT_L(0); PG8_MMA(0, 1, At, B1); PG8_BAR;
            PG8_LDA(At, 1, 1); PG8_STAGE(PG8_SA(1, 0), a3, voffA);
            PG8_BAR; PG8_WAIT_L(0); PG8_MMA(1, 0, At, B0); PG8_BAR; PG8_SCHED;
            PG8_STAGE(PG8_SB(1, 1), b3 + hstep, voffB);
            PG8_WAIT_V(6); PG8_BAR; PG8_MMA(1, 1, At, B1); PG8_BAR;
            }
        }
        if constexpr (ALIGN_EPI) { if (wr == 0) PG8_BAR; }
        if constexpr (!Epi::AFTER_DRAIN) { E(acc, cur, wr, wc, fr, fq); S.done(cur); }
        if (!has_next) break;
#pragma unroll
        for (int a = 0; a < 2; ++a)
#pragma unroll
            for (int b = 0; b < 2; ++b)
#pragma unroll
                for (int m = 0; m < 4; ++m)
#pragma unroll
                    for (int n = 0; n < 2; ++n) acc[a][b][m][n] = (f32x4){0.f, 0.f, 0.f, 0.f};
        cur = nxt; cA = nA; cB = nB; ++ui;
        if constexpr (ALIGN_EPI) { if (wr == 1) PG8_BAR; }
    }
    PG8_WAIT_V(0);
    if constexpr (!ALIGN_EPI) { if (wr == 0) PG8_BAR; }
    PG8_BAR;
    if constexpr (Epi::AFTER_DRAIN) { E.fused(acc, cur, wr, wc, fr, fq, lds, wid, lane); S.done(cur); }
#undef PG8_SA
#undef PG8_SB
#undef PG8_STAGE
#undef PG8_LDA
#undef PG8_LDB
#undef PG8_MMA
#undef PG8_WAIT_V
#undef PG8_WAIT_L
#undef PG8_BAR
#undef PG8_SCHED
}
}
extern __shared__ __attribute__((aligned(16))) unsigned char g_lds[];
using pg8::bf16_t; using pg8::bf16x8; using pg8::f32x4; using pg8::u32x4; using pg8::cvt_pk_bf16; using pg8::bflo; using pg8::bfhi; using pg8::sigm;

constexpr int NTOK = 32768, DM = 1024, SEQ = 2048, NB = 16, ZLD = 5120, NTHR = 512;
constexpr int C_R = 0, C_K = 512, C_V = 1024, C_WD = 1536, C_AD = 1600, C_GD = 1664;
constexpr int C_Q = 1824, C_KA = 2336, C_VA = 2400, C_QI = 2464, C_KI = 2976, C_WI = 3040, C_G0 = 3048, C_G1 = 4072;
constexpr size_t MiB = 1024 * 1024;
constexpr size_t WS_SS1 = 0, WS_SS2 = 128 * 1024, WS_BONUS = 256 * 1024, WS_ROPE = 1280 * 1024, WS_WD = 1792 * 1024, WS_WI = 1856 * 1024, WS_WG = 1920 * 1024;
constexpr size_t WS_WIN = 4 * MiB, WS_WUP = 14 * MiB, WS_WDN = 22 * MiB, WS_WB = 30 * MiB, WS_WO = 32 * MiB, WS_VT = 34 * MiB, WS_H = 38 * MiB, WS_Z = 102 * MiB, WS_P = 422 * MiB, WS_END = 486 * MiB;
constexpr int LDS_BYTES = 163840;

struct Args { const float* in[20]; float* out; unsigned char* ws; int ph_lo, ph_hi; };

struct Frame {
    const float* in[20]; float* out; unsigned char* ws; unsigned char* lds; int tid, lane, wave;
    float *ss1, *ss2, *bonus; float2* rope; bf16_t *wd, *wi, *wg, *win, *wup, *wdn, *wb, *wo, *vt, *h, *ya, *yb, *xb, *z, *hid, *lw, *ic, *mg, *gt; float* yraw;
};

__device__ __forceinline__ bf16_t f2bf(float f) { return (bf16_t)(cvt_pk_bf16(f, 0.f) & 0xffffu); }
__device__ __forceinline__ float bf2f(bf16_t b) { return __uint_as_float(((unsigned)b) << 16); }
template <int CTRL> __device__ __forceinline__ float dpp_mov(float x) { return __int_as_float(__builtin_amdgcn_update_dpp(0, __float_as_int(x), CTRL, 0xF, 0xF, true)); }
__device__ __forceinline__ float red16(float x) { x += dpp_mov<0xB1>(x); x += dpp_mov<0x4E>(x); x += dpp_mov<0x141>(x); x += dpp_mov<0x140>(x); return x; }


__device__ __forceinline__ void lds_barrier() { asm volatile("s_waitcnt lgkmcnt(0)" ::: "memory"); __builtin_amdgcn_s_barrier(); asm volatile("" ::: "memory"); }
__device__ __forceinline__ void red16x4(float& a, float& b, float& c, float& d) {
#define DPP4(ctl) "v_add_f32_dpp %0, %0, %0 " ctl " row_mask:0xf bank_mask:0xf bound_ctrl:1\n" "v_add_f32_dpp %1, %1, %1 " ctl " row_mask:0xf bank_mask:0xf bound_ctrl:1\n" \
                  "v_add_f32_dpp %2, %2, %2 " ctl " row_mask:0xf bank_mask:0xf bound_ctrl:1\n" "v_add_f32_dpp %3, %3, %3 " ctl " row_mask:0xf bank_mask:0xf bound_ctrl:1\n"
    asm volatile("s_nop 1\n" DPP4("quad_perm:[1,0,3,2]") DPP4("quad_perm:[2,3,0,1]") DPP4("row_half_mirror") DPP4("row_mirror") : "+v"(a), "+v"(b), "+v"(c), "+v"(d));
#undef DPP4
}
__device__ __forceinline__ float red32(float x) { x += __shfl_xor(x, 1); x += __shfl_xor(x, 2); x += __shfl_xor(x, 4); x += __shfl_xor(x, 8); x += __shfl_xor(x, 16); return x; }
__device__ __forceinline__ float red64(float x) { x = red32(x); x += __shfl_xor(x, 32); return x; }
__device__ __forceinline__ float softplus_f(float x) { return fmaxf(x, 0.f) + log1pf(__expf(-fabsf(x))); }

__device__ __forceinline__ void tconv(const Frame& F, const float* __restrict__ W, int K, int N, int Npad, bf16_t* __restrict__ Wt, const float* __restrict__ rs) {
    float* tile = (float*)g_lds;
    const int ktn = (K + 63) / 64, ntn = Npad / 64, tid = F.tid;
    for (int tl = blockIdx.x; tl < ktn * ntn; tl += gridDim.x) {
        const int kt = tl % ktn, nt = tl / ktn;
#pragma unroll
        for (int i = 0; i < 2; ++i) { const int idx = tid + i * NTHR, kk = idx >> 4, n4 = (idx & 15) * 4, k = kt * 64 + kk, n = nt * 64 + n4;
            f32x4 v = {0.f, 0.f, 0.f, 0.f};
            if (k < K) { if (n + 3 < N) v = *(const f32x4*)(W + (size_t)k * N + n); else { for (int j = 0; j < 4; ++j) if (n + j < N) v[j] = W[(size_t)k * N + n + j]; }
                if (rs != nullptr) { const float r = rs[k]; v[0] *= r; v[1] *= r; v[2] *= r; v[3] *= r; } }
            tile[kk * 65 + n4] = v[0]; tile[kk * 65 + n4 + 1] = v[1]; tile[kk * 65 + n4 + 2] = v[2]; tile[kk * 65 + n4 + 3] = v[3]; }
        __syncthreads();
        { const int nn = tid >> 3, k8 = (tid & 7) * 8, k = kt * 64 + k8, n = nt * 64 + nn;
          if (k < K) { u32x4 w; const float* tp = tile + k8 * 65 + nn;
              w.x = cvt_pk_bf16(tp[0], tp[65]); w.y = cvt_pk_bf16(tp[130], tp[195]); w.z = cvt_pk_bf16(tp[260], tp[325]); w.w = cvt_pk_bf16(tp[390], tp[455]);
              *(u32x4*)(Wt + (size_t)n * K + k) = w; } }
        __syncthreads();
    }
}
__device__ __forceinline__ void p0_prologue(const Frame& F) {
    const int tid = F.tid, gtid = blockIdx.x * NTHR + tid, gn = gridDim.x * NTHR;
    for (int i = gtid; i < 2 * NTOK; i += gn) F.ss1[i] = 0.f;
    for (int i = gtid; i < SEQ * 32; i += gn) { const int pos = i >> 5, j = i & 31;
        const float inv = 1.0f / powf(10000.0f, (float)(2 * j) / 64.0f); const float ang = (float)pos * inv;
        double rev = (double)ang * 0.15915494309189535; rev -= floor(rev); const float fr = (float)rev;
        F.rope[i] = make_float2(__builtin_amdgcn_cosf(fr), __builtin_amdgcn_sinf(fr)); }
    tconv(F, F.in[2], 1024, 5096, 5120, F.win, nullptr);
    tconv(F, F.in[17], 1024, 4096, 4096, F.wup, F.in[16]);
    tconv(F, F.in[18], 4096, 1024, 1024, F.wdn, nullptr);
    tconv(F, F.in[14], 512, 1024, 1024, F.wb, nullptr);
    tconv(F, F.in[14] + 512 * 1024, 512, 1024, 1024, F.wb + 1024 * 512, nullptr);
    tconv(F, F.in[15], 1024, 1024, 1024, F.wo, nullptr);
    tconv(F, F.in[5], 64, 512, 512, F.wd, nullptr);
    tconv(F, F.in[7], 64, 512, 512, F.wi, nullptr);
    tconv(F, F.in[8], 160, 512, 512, F.wg, nullptr);
    const float* x = F.in[0]; const float* g = F.in[1]; const int lane = F.lane;
    for (int row = blockIdx.x * 8 + F.wave; row < NTOK; row += gridDim.x * 8) {
        const float* xr = x + (size_t)row * DM; f32x4 v[4]; float ss = 0.f;
#pragma unroll
        for (int i = 0; i < 4; ++i) { v[i] = *(const f32x4*)(xr + i * 256 + lane * 4); ss += v[i][0] * v[i][0] + v[i][1] * v[i][1] + v[i][2] * v[i][2] + v[i][3] * v[i][3]; }
        ss = red64(ss); const float sc = rsqrtf(ss * (1.0f / 1024.0f) + 1e-6f);
#pragma unroll
        for (int i = 0; i < 4; ++i) { const f32x4 gg = *(const f32x4*)(g + i * 256 + lane * 4); uint2 w;
            w.x = cvt_pk_bf16(v[i][0] * sc * gg[0], v[i][1] * sc * gg[1]); w.y = cvt_pk_bf16(v[i][2] * sc * gg[2], v[i][3] * sc * gg[3]);
            *(uint2*)(F.h + (size_t)row * DM + i * 256 + lane * 4) = w; }
    }
}

__device__ __forceinline__ void p2_prep(const Frame& F, const int mode) {
    const int tid = F.tid, lane = F.lane, wave = F.wave, fr = lane & 15, fq = lane >> 4;
    bf16_t* z = F.z; const float* mu = F.in[3];
    if (mode != 2) {
        constexpr int LDA = 296, TT = 32; bf16_t* At = (bf16_t*)g_lds;
        bf16_t* Ot = At + TT * LDA;
        const float* dbias = F.in[4]; const float* ibias = F.in[6];
        for (int tile = blockIdx.x; tile < NTOK / TT; tile += gridDim.x) {
            const int t0 = tile * TT;
            for (int idx = tid; idx < TT * 36; idx += NTHR) { const int tok = idx / 36, c8 = (idx - tok * 36) * 8, t = t0 + tok, col = C_WD + c8;
                const u32x4 zc = *(const u32x4*)(z + (size_t)t * ZLD + col); u32x4 zp = {0u, 0u, 0u, 0u}; if (t & (SEQ - 1)) zp = *(const u32x4*)(z + (size_t)(t - 1) * ZLD + col);
                const f32x4 m0 = *(const f32x4*)(mu + col), m1 = *(const f32x4*)(mu + col + 4);
                float v[8]; const unsigned zcu[4] = {zc.x, zc.y, zc.z, zc.w}, zpu[4] = {zp.x, zp.y, zp.z, zp.w};
#pragma unroll
                for (int j = 0; j < 4; ++j) { const float a = bflo(zcu[j]), b2 = bfhi(zcu[j]), pa = bflo(zpu[j]), pb = bfhi(zpu[j]);
                    const float mm0 = (j < 2) ? m0[2 * j] : m1[2 * j - 4], mm1 = (j < 2) ? m0[2 * j + 1] : m1[2 * j - 3];
                    v[2 * j] = a + (pa - a) * mm0; v[2 * j + 1] = b2 + (pb - b2) * mm1; }
                if (c8 < 64) {
#pragma unroll
                    for (int j = 0; j < 8; ++j) v[j] = tanhf(v[j]); }
                else if (c8 >= 128) {
#pragma unroll
                    for (int j = 0; j < 8; ++j) v[j] = sigm(v[j]); }
                u32x4 w; w.x = cvt_pk_bf16(v[0], v[1]); w.y = cvt_pk_bf16(v[2], v[3]); w.z = cvt_pk_bf16(v[4], v[5]); w.w = cvt_pk_bf16(v[6], v[7]);
                *(u32x4*)(At + tok * LDA + c8) = w; }
            __syncthreads();
            const int h = wave;
            bf16x8 Bc[9], Bn[9];
            { const int n = h * 64 + fr;
#pragma unroll
              for (int ks = 0; ks < 2; ++ks) { Bc[ks] = *(const bf16x8*)(F.wd + n * 64 + ks * 32 + fq * 8); Bc[2 + ks] = *(const bf16x8*)(F.wi + n * 64 + ks * 32 + fq * 8); }
#pragma unroll
              for (int ks = 0; ks < 5; ++ks) Bc[4 + ks] = *(const bf16x8*)(F.wg + n * 160 + ks * 32 + fq * 8); }
#pragma unroll 1
            for (int j = 0; j < 4; ++j) { const int n = h * 64 + j * 16 + fr;
                if (j < 3) { const int nn = n + 16;
#pragma unroll
                    for (int ks = 0; ks < 2; ++ks) { Bn[ks] = *(const bf16x8*)(F.wd + nn * 64 + ks * 32 + fq * 8); Bn[2 + ks] = *(const bf16x8*)(F.wi + nn * 64 + ks * 32 + fq * 8); }
#pragma unroll
                    for (int ks = 0; ks < 5; ++ks) Bn[4 + ks] = *(const bf16x8*)(F.wg + nn * 160 + ks * 32 + fq * 8); }
                const float db = dbias[n], ib = ibias[n];
#pragma unroll
                for (int mt = 0; mt < 2; ++mt) {
                    f32x4 ad = {0.f, 0.f, 0.f, 0.f}, ai = ad, ag = ad; const bf16_t* ap = At + (mt * 16 + fr) * LDA + fq * 8;
#pragma unroll
                    for (int ks = 0; ks < 2; ++ks) ad = __builtin_amdgcn_mfma_f32_16x16x32_bf16(*(const bf16x8*)(ap + ks * 32), Bc[ks], ad, 0, 0, 0);
#pragma unroll
                    for (int ks = 0; ks < 2; ++ks) ai = __builtin_amdgcn_mfma_f32_16x16x32_bf16(*(const bf16x8*)(ap + 64 + ks * 32), Bc[2 + ks], ai, 0, 0, 0);
#pragma unroll
                    for (int ks = 0; ks < 5; ++ks) ag = __builtin_amdgcn_mfma_f32_16x16x32_bf16(*(const bf16x8*)(ap + 128 + ks * 32), Bc[4 + ks], ag, 0, 0, 0);
#pragma unroll
                    for (int jj = 0; jj < 4; ++jj) {
                        const float dw = db + ad[jj]; const float wlog = -softplus_f(-dw) - 0.5f; const float lwv = -__expf(wlog);
                        const int tk = mt * 16 + fq * 4 + jj; Ot[tk * 520 + n] = f2bf(lwv); Ot[(TT + tk) * 520 + n] = f2bf(sigm(ib + ai[jj])); Ot[(2 * TT + tk) * 520 + n] = f2bf(ag[jj]); }
                }
#pragma unroll
                for (int q = 0; q < 9; ++q) Bc[q] = Bn[q];
            }
            __syncthreads();
#pragma unroll
            for (int i = 0; i < 12; ++i) { const int idx = tid + i * NTHR, arr = idx >> 11, rem = idx & 2047, tk = rem >> 6, c8 = (rem & 63) * 8;
                const u32x4 w = *(const u32x4*)(Ot + (arr * TT + tk) * 520 + c8); bf16_t* dst = arr == 0 ? F.lw : (arr == 1 ? F.ic : F.gt);
                *(u32x4*)(dst + (size_t)(t0 + tk) * 512 + c8) = w; }
            __syncthreads();
        }
    }
    if (mode != 2) {
        unsigned short* tl = (unsigned short*)g_lds;
        for (int tile = blockIdx.x; tile < NTOK / 64; tile += gridDim.x) { const int t0 = tile * 64, b = t0 / SEQ, tt0 = t0 % SEQ;
#pragma unroll
            for (int i = 0; i < 8; ++i) { const int idx = tid + i * NTHR, tok = idx >> 6, d = idx & 63; tl[tok * 66 + d] = z[(size_t)(t0 + tok) * ZLD + C_VA + d]; }
            __syncthreads();
#pragma unroll
            for (int i = 0; i < 8; ++i) { const int idx = tid + i * NTHR, d = idx >> 6, tok = idx & 63; F.vt[((size_t)b * 64 + d) * SEQ + tt0 + tok] = tl[tok * 66 + d]; }
            __syncthreads();
        }
    }
    if (mode != 0) {
        const int gtid = blockIdx.x * NTHR + tid, gn = gridDim.x * NTHR;
        for (int idx = gtid; idx < NTOK * 144; idx += gn) { const int t = idx / 144, p = idx - t * 144, hd = p >> 3, i4 = (p & 7) * 4;
            const int base = hd < 8 ? C_Q + hd * 64 : (hd == 8 ? C_KA : (hd < 17 ? C_QI + (hd - 9) * 64 : C_KI));
            f32x4 cs0 = *(const f32x4*)(&F.rope[(t & (SEQ - 1)) * 32 + i4]), cs1 = *(const f32x4*)(&F.rope[(t & (SEQ - 1)) * 32 + i4 + 2]);
            if (mode == 2) { cs0 = (f32x4){1.f, 0.f, 1.f, 0.f}; cs1 = cs0; }
            bf16_t* p1 = z + (size_t)t * ZLD + base + i4; const uint2 a = *(const uint2*)(p1), b2 = *(const uint2*)(p1 + 32);
            const float x10 = bflo(a.x), x11 = bfhi(a.x), x12 = bflo(a.y), x13 = bfhi(a.y), x20 = bflo(b2.x), x21 = bfhi(b2.x), x22 = bflo(b2.y), x23 = bfhi(b2.y);
            uint2 o1, o2;
            o1.x = cvt_pk_bf16(x10 * cs0[0] - x20 * cs0[1], x11 * cs0[2] - x21 * cs0[3]); o1.y = cvt_pk_bf16(x12 * cs1[0] - x22 * cs1[1], x13 * cs1[2] - x23 * cs1[3]);
            o2.x = cvt_pk_bf16(x20 * cs0[0] + x10 * cs0[1], x21 * cs0[2] + x11 * cs0[3]); o2.y = cvt_pk_bf16(x22 * cs1[0] + x12 * cs1[1], x23 * cs1[2] + x13 * cs1[3]);
            *(uint2*)(p1) = o1; *(uint2*)(p1 + 32) = o2; }
    }
}

struct ScanRaw { uint2 zr_c, zr_p, zk_c, zk_p, zv_c, zv_p, lwu, icu; };
struct ScanConst { f32x4 mur, muk, muv, kk, ka, rk; };
__device__ __forceinline__ void scan_load(ScanRaw& R, const bf16_t* z, const bf16_t* lw, const bf16_t* ic, size_t tokbase, int ch, int ptok, int gc) {
    const int t = ch * 16 + ptok; const size_t T = tokbase + t; const bf16_t* zp = z + T * ZLD + gc;
    R.zr_c = *(const uint2*)(zp + C_R); R.zk_c = *(const uint2*)(zp + C_K); R.zv_c = *(const uint2*)(zp + C_V);
    const uint2 zz = make_uint2(0u, 0u);
    if (t > 0) { R.zr_p = *(const uint2*)(zp - ZLD + C_R); R.zk_p = *(const uint2*)(zp - ZLD + C_K); R.zv_p = *(const uint2*)(zp - ZLD + C_V); } else { R.zr_p = zz; R.zk_p = zz; R.zv_p = zz; }
    R.lwu = *(const uint2*)(lw + T * 512 + gc); R.icu = *(const uint2*)(ic + T * 512 + gc);
}
__device__ __forceinline__ f32x4 unpack4(uint2 u) { f32x4 r; r[0] = bflo(u.x); r[1] = bfhi(u.x); r[2] = bflo(u.y); r[3] = bfhi(u.y); return r; }
__device__ __forceinline__ void scan_prep(const ScanRaw& R, const ScanConst& C, float* ops, float* vv, float* bonus_out, bool wr_bonus, int ptok, int pc, int v0) {
    const f32x4 rc = unpack4(R.zr_c), rp = unpack4(R.zr_p), kc = unpack4(R.zk_c), kp = unpack4(R.zk_p), vc = unpack4(R.zv_c), vp = unpack4(R.zv_p), ic = unpack4(R.icu), lw = unpack4(R.lwu);
    const f32x4 r = rc + (rp - rc) * C.mur, k = kc + (kp - kc) * C.muk, vs = vc + (vp - vc) * C.muv;
    f32x4 w; w[0] = __expf(lw[0]); w[1] = __expf(lw[1]); w[2] = __expf(lw[2]); w[3] = __expf(lw[3]);
    const f32x4 q = k * C.kk; const float ss = red16((q[0] * q[0] + q[1] * q[1]) + (q[2] * q[2] + q[3] * q[3]));
    const float inv = 1.0f / fmaxf(sqrtf(ss), 1e-12f); const f32x4 n = q * inv;
    const f32x4 kn = k * (1.0f + (ic - 1.0f) * C.ka);
    const f32x4 bt = r * kn * C.rk; const float bon = red16((bt[0] + bt[1]) + (bt[2] + bt[3]));
    if (wr_bonus) *bonus_out = bon;
    float* op = ops + ptok * 320 + pc;
    *(f32x4*)(op) = -n; *(f32x4*)(op + 64) = w; *(f32x4*)(op + 128) = n * ic; *(f32x4*)(op + 192) = kn; *(f32x4*)(op + 256) = r;
    if (pc >= v0 && pc < v0 + 32) *(f32x4*)(vv + ptok * 32 + pc - v0) = vs;
}
__device__ __forceinline__ void p3_scan(const Frame& F, const int mode) {
    const int tid = F.tid;
    float* opsb = (float*)g_lds;
    float* vvb = opsb + 2 * 5120;
    float* yob = vvb + 2 * 512;
    const bf16_t* z = F.z; const float* mu = F.in[3]; const float* k_k = F.in[9]; const float* k_a = F.in[10]; const float* r_k = F.in[11];
    for (int item = blockIdx.x; item < 256; item += gridDim.x) {
        const int bh = item >> 1, half = item & 1, b = bh >> 3, h = bh & 7, v0 = half * 32;
        const size_t tokbase = (size_t)b * SEQ;
        if (F.wave >= 4) {
            const int pt = tid - 256, ptok = pt >> 4, pc = (pt & 15) * 4, gc = h * 64 + pc;
            ScanConst C; C.mur = *(const f32x4*)(mu + C_R + gc); C.muk = *(const f32x4*)(mu + C_K + gc); C.muv = *(const f32x4*)(mu + C_V + gc);
            C.kk = *(const f32x4*)(k_k + gc); C.ka = *(const f32x4*)(k_a + gc); C.rk = *(const f32x4*)(r_k + gc);
            const bool wrb = (half == 0) && ((pt & 15) == 0);
            ScanRaw R;
            scan_load(R, z, F.lw, F.ic, tokbase, 0, ptok, gc);
            scan_prep(R, C, opsb, vvb, F.bonus + (tokbase + ptok) * 8 + h, wrb, ptok, pc, v0);
            scan_load(R, z, F.lw, F.ic, tokbase, 1, ptok, gc);
            lds_barrier();
            for (int ch = 0; ch < SEQ / 16; ++ch) {
                const int cur = ch & 1, nxt = cur ^ 1;
                if (mode != 2) {
                if (ch > 0) { const int tok = pt >> 4, r2 = (pt & 15) * 2;
                    *(float2*)(F.yraw + (tokbase + (ch - 1) * 16 + tok) * 512 + h * 64 + v0 + r2) = *(const float2*)(yob + nxt * 512 + tok * 32 + r2); }
                if (ch + 1 < SEQ / 16) {
                    scan_prep(R, C, opsb + nxt * 5120, vvb + nxt * 512, F.bonus + (tokbase + (ch + 1) * 16 + ptok) * 8 + h, wrb, ptok, pc, v0);
                    if (ch + 2 < SEQ / 16) scan_load(R, z, F.lw, F.ic, tokbase, ch + 2, ptok, gc);
                } }
                lds_barrier();
            }
            { const int tok = pt >> 4, r2 = (pt & 15) * 2;
              *(float2*)(F.yraw + (tokbase + (SEQ / 16 - 1) * 16 + tok) * 512 + h * 64 + v0 + r2) = *(const float2*)(yob + 512 + tok * 32 + r2); }
        } else {
            const int rp = tid >> 4, ks = tid & 15;
            float A0 = 0.f, A1 = 0.f, A2 = 0.f, A3 = 0.f, B0 = 0.f, B1 = 0.f, B2 = 0.f, B3 = 0.f;
            const int ywoff = (ks == 0) ? 2 * rp : (2 * 512 + 2 * tid), ywstep = (ks == 0) ? 32 : 0;
            lds_barrier();
            f32x4 rprev = {0.f, 0.f, 0.f, 0.f}; float* ywp = yob + 2 * 512 + 2 * tid;
            for (int ch = 0; ch < SEQ / 16; ++ch) {
                const int cur = ch & 1;
                const float* ops = opsb + cur * 5120 + ks * 4; const float* vv = vvb + cur * 512 + 2 * rp; float* yw = yob + cur * 512 + ywoff;
                if (mode != 1) {
#pragma unroll
                for (int s = 0; s < 16; ++s) {
                    const float* o = ops + s * 320;
                    const f32x4 a4 = *(const f32x4*)(o), w4 = *(const f32x4*)(o + 64), b4 = *(const f32x4*)(o + 128), k4 = *(const f32x4*)(o + 192), r4 = *(const f32x4*)(o + 256);
                    const float2 vab = *(const float2*)(vv + s * 32);
                    float sa = (A0 * a4[0] + A1 * a4[1]) + (A2 * a4[2] + A3 * a4[3]); float sb = (B0 * a4[0] + B1 * a4[1]) + (B2 * a4[2] + B3 * a4[3]);
                    float ya = (A0 * rprev[0] + A1 * rprev[1]) + (A2 * rprev[2] + A3 * rprev[3]); float yb2 = (B0 * rprev[0] + B1 * rprev[1]) + (B2 * rprev[2] + B3 * rprev[3]);
                    red16x4(sa, sb, ya, yb2);
                    *(float2*)(ywp) = make_float2(ya, yb2);
                    ywp = yw + s * ywstep;
                    A0 = A0 * w4[0] + sa * b4[0] + vab.x * k4[0]; A1 = A1 * w4[1] + sa * b4[1] + vab.x * k4[1];
                    A2 = A2 * w4[2] + sa * b4[2] + vab.x * k4[2]; A3 = A3 * w4[3] + sa * b4[3] + vab.x * k4[3];
                    B0 = B0 * w4[0] + sb * b4[0] + vab.y * k4[0]; B1 = B1 * w4[1] + sb * b4[1] + vab.y * k4[1];
                    B2 = B2 * w4[2] + sb * b4[2] + vab.y * k4[2]; B3 = B3 * w4[3] + sb * b4[3] + vab.y * k4[3];
                    rprev = r4;
                }
                {
                    float ya = (A0 * rprev[0] + A1 * rprev[1]) + (A2 * rprev[2] + A3 * rprev[3]); float yb2 = (B0 * rprev[0] + B1 * rprev[1]) + (B2 * rprev[2] + B3 * rprev[3]);
                    float d0 = 0.f, d1 = 0.f; red16x4(ya, yb2, d0, d1);
                    *(float2*)(ywp) = make_float2(ya, yb2); ywp = yob + 2 * 512 + 2 * tid; rprev = (f32x4){0.f, 0.f, 0.f, 0.f};
                } }
                lds_barrier();
            }
        }
        __syncthreads();
    }
}

__device__ __forceinline__ unsigned ordkey(float f) { const unsigned u = __float_as_uint(f); return (u & 0x80000000u) ? ~u : (u | 0x80000000u); }

__device__ __forceinline__ void attn_chunk(const unsigned char* kb, const unsigned char* vb, const unsigned* selm, int c, int p, int fr, int fq, const bf16x8 (&Bqa)[2][2], f32x4 (&O)[2][4], f32x4 (&RS)[2]) {
    const f32x4 zero4 = {0.f, 0.f, 0.f, 0.f};
    const u32x4 onesu = {0x3f803f80u, 0x3f803f80u, 0x3f803f80u, 0x3f803f80u}; const bf16x8 ones = __builtin_bit_cast(bf16x8, onesu);
    const float csc = 0.125f * 1.4426950408889634f;
    const unsigned char* k0p = kb + ((2 * p) * 16 + fr) * 144 + fq * 16; const unsigned char* k1p = k0p + 16 * 144;
    const bf16x8 KA00 = *(const bf16x8*)(k0p), KA01 = *(const bf16x8*)(k0p + 64), KA10 = *(const bf16x8*)(k1p), KA11 = *(const bf16x8*)(k1p + 64);
    const int mw = (int)selm[fr * 64 + 2 * c + p];
    bf16x8 VA[4];
#pragma unroll
    for (int dt = 0; dt < 4; ++dt) { const unsigned char* vp = vb + (dt * 16 + fr) * 144 + (2 * p) * 32 + fq * 8;
        const uint2 lo = *(const uint2*)(vp), hi = *(const uint2*)(vp + 32);
        u32x4 va; va.x = lo.x; va.y = lo.y; va.z = hi.x; va.w = hi.y; VA[dt] = __builtin_bit_cast(bf16x8, va); }
    unsigned km0[4], km1[4];
#pragma unroll
    for (int jj = 0; jj < 4; ++jj) { km0[jj] = (unsigned)__builtin_amdgcn_sbfe(mw, fq * 4 + jj, 1); km1[jj] = (unsigned)__builtin_amdgcn_sbfe(mw, 16 + fq * 4 + jj, 1); }
#pragma unroll
    for (int hh = 0; hh < 2; ++hh) {
        f32x4 s0 = __builtin_amdgcn_mfma_f32_16x16x32_bf16(KA00, Bqa[hh][0], zero4, 0, 0, 0); s0 = __builtin_amdgcn_mfma_f32_16x16x32_bf16(KA01, Bqa[hh][1], s0, 0, 0, 0);
        f32x4 s1 = __builtin_amdgcn_mfma_f32_16x16x32_bf16(KA10, Bqa[hh][0], zero4, 0, 0, 0); s1 = __builtin_amdgcn_mfma_f32_16x16x32_bf16(KA11, Bqa[hh][1], s1, 0, 0, 0);
        unsigned p0[4], p1[4];
#pragma unroll
        for (int jj = 0; jj < 4; ++jj) {
            p0[jj] = __float_as_uint(__builtin_amdgcn_exp2f(fminf(s0[jj] * csc, 86.f))) & km0[jj]; p1[jj] = __float_as_uint(__builtin_amdgcn_exp2f(fminf(s1[jj] * csc, 86.f))) & km1[jj]; }
        u32x4 pk; pk.x = cvt_pk_bf16(__uint_as_float(p0[0]), __uint_as_float(p0[1])); pk.y = cvt_pk_bf16(__uint_as_float(p0[2]), __uint_as_float(p0[3]));
        pk.z = cvt_pk_bf16(__uint_as_float(p1[0]), __uint_as_float(p1[1])); pk.w = cvt_pk_bf16(__uint_as_float(p1[2]), __uint_as_float(p1[3]));
        const bf16x8 PB = __builtin_bit_cast(bf16x8, pk);
        RS[hh] = __builtin_amdgcn_mfma_f32_16x16x32_bf16(ones, PB, RS[hh], 0, 0, 0);
#pragma unroll
        for (int dt = 0; dt < 4; ++dt) O[hh][dt] = __builtin_amdgcn_mfma_f32_16x16x32_bf16(VA[dt], PB, O[hh][dt], 0, 0, 0);
    }
}

__device__ __forceinline__ void p3_dsa(const Frame& F) {
    const int tid = F.tid, lane = F.lane, wave = F.wave, fr = lane & 15, fq = lane >> 4;
    unsigned* scl = (unsigned*)g_lds;
    unsigned* selm = (unsigned*)(g_lds + 131328);
    unsigned char* kbuf = (unsigned char*)g_lds;
    unsigned char* vbuf = kbuf + 2 * 9216;
    const bf16_t* z = F.z; const int G = gridDim.x, bx = blockIdx.x;
    const f32x4 zero4 = {0.f, 0.f, 0.f, 0.f};
    for (int rnd = 0; rnd * G < 2048; ++rnd) {
        const int n = rnd * G + ((rnd & 1) ? (G - 1 - bx) : bx);
        if (n >= 2048) continue;
        const int qg = 127 - (n >> 4), b = n & 15, q0 = qg * 16; const size_t Tb = (size_t)b * SEQ;
        for (int i = tid; i < 1024; i += NTHR) selm[i] = 0u;
        __syncthreads();
        const bf16_t* zq = z + (Tb + q0 + fr) * ZLD;
        const unsigned lofk = (unsigned)((fr * ZLD + fq * 8) * 2), lofv = (unsigned)((fr * SEQ + fq * 4) * 2);
        if (qg >= 16) {
            const u32x4 wv = *(const u32x4*)(zq + C_WI);
            {
                bf16x8 Bq[8][2];
#pragma unroll
                for (int hh = 0; hh < 8; ++hh)
#pragma unroll
                    for (int ks = 0; ks < 2; ++ks) Bq[hh][ks] = *(const bf16x8*)(zq + C_QI + hh * 64 + ks * 32 + fq * 8);
                const float sc = 0.044194173824159216f;
                float wih[8]; wih[0] = bflo(wv.x) * sc; wih[1] = bfhi(wv.x) * sc; wih[2] = bflo(wv.y) * sc; wih[3] = bfhi(wv.y) * sc; wih[4] = bflo(wv.z) * sc; wih[5] = bfhi(wv.z) * sc; wih[6] = bflo(wv.w) * sc; wih[7] = bfhi(wv.w) * sc;
#pragma unroll 1
                for (int half = 0; half < 2; ++half) {
                    const int ktb = wave + 64 * half; if (ktb > qg) break;
                    bf16x8 W0[2], W1[2];
#pragma unroll
                    for (int j = 0; j < 2; ++j) { const int ktj = (ktb + 8 * j) < qg ? (ktb + 8 * j) : qg; const char* kb = (const char*)(z + (Tb + (size_t)ktj * 16) * ZLD + C_KI);
                        W0[j] = *(const bf16x8*)(kb + lofk); W1[j] = *(const bf16x8*)(kb + lofk + 64); }
#pragma unroll
                    for (int i = 0; i < 8; ++i) { const int kt = ktb + 8 * i;
                        if (kt <= qg) { f32x4 sv = zero4;
#pragma unroll
                            for (int hh = 0; hh < 8; ++hh) { f32x4 acc = __builtin_amdgcn_mfma_f32_16x16x32_bf16(W0[i & 1], Bq[hh][0], zero4, 0, 0, 0);
                                acc = __builtin_amdgcn_mfma_f32_16x16x32_bf16(W1[i & 1], Bq[hh][1], acc, 0, 0, 0);
#pragma unroll
                                for (int jj = 0; jj < 4; ++jj) sv[jj] += wih[hh] * fmaxf(acc[jj], 0.f); }
                            u32x4 w; w.x = ordkey(sv[0]); w.y = ordkey(sv[1]); w.z = ordkey(sv[2]); w.w = ordkey(sv[3]);
                            *(u32x4*)(scl + fr * 2052 + kt * 16 + fq * 4) = w;
                        }
                        if (i + 2 < 8) { const int ktn = (kt + 16) < qg ? (kt + 16) : qg; const char* kb = (const char*)(z + (Tb + (size_t)ktn * 16) * ZLD + C_KI);
                            unsigned lo2 = lofk; asm volatile("" : "+v"(lo2));
                            W0[i & 1] = *(const bf16x8*)(kb + lo2); W1[i & 1] = *(const bf16x8*)(kb + lo2 + 64); }
                    }
                }
            }
            __syncthreads();
#pragma unroll 1
            for (int qq = 0; qq < 2; ++qq) {
                const int q = 2 * wave + qq, qpos = q0 + q;
                unsigned uk[32];
#pragma unroll
                for (int r = 0; r < 32; ++r) { const int key = r * 64 + lane; uk[r] = 0x007fffffu;
                    if (r * 64 <= qpos) { const unsigned v = scl[q * 2052 + key]; uk[r] = (key <= qpos) ? v : 0x007fffffu; } }
                unsigned T = 0u; bool exact = false;
#pragma unroll 1
                for (int bit = 31; bit >= 0; --bit) {
                    const unsigned cand = T | (1u << bit); int c = 0;
#pragma unroll
                    for (int g = 0; g < 4; ++g) {
                        unsigned long long m[8];
                        asm("v_cmp_ge_u32_e64 %0, %8, %16\n\tv_cmp_ge_u32_e64 %1, %9, %16\n\tv_cmp_ge_u32_e64 %2, %10, %16\n\tv_cmp_ge_u32_e64 %3, %11, %16\n\t"
                            "v_cmp_ge_u32_e64 %4, %12, %16\n\tv_cmp_ge_u32_e64 %5, %13, %16\n\tv_cmp_ge_u32_e64 %6, %14, %16\n\tv_cmp_ge_u32_e64 %7, %15, %16"
                            : "=&s"(m[0]), "=&s"(m[1]), "=&s"(m[2]), "=&s"(m[3]), "=&s"(m[4]), "=&s"(m[5]), "=&s"(m[6]), "=&s"(m[7])
                            : "v"(uk[g * 8 + 0]), "v"(uk[g * 8 + 1]), "v"(uk[g * 8 + 2]), "v"(uk[g * 8 + 3]), "v"(uk[g * 8 + 4]), "v"(uk[g * 8 + 5]), "v"(uk[g * 8 + 6]), "v"(uk[g * 8 + 7]), "v"(cand));
#pragma unroll
                        for (int j = 0; j < 8; ++j) c += __builtin_popcountll(m[j]);
                    }
                    if (c >= 256) { T = cand; if (c == 256) { exact = true; break; } }
                }
                int need = 0;
                if (!exact) { int c = 0;
#pragma unroll
                    for (int r = 0; r < 32; ++r) c += __builtin_popcountll(__builtin_amdgcn_ballot_w64(uk[r] > T));
                    need = 256 - c; }
#pragma unroll
                for (int r = 0; r < 32; ++r) {
                    if (r * 64 <= qpos) {
                        unsigned long long sel;
                        if (exact) sel = __builtin_amdgcn_ballot_w64(uk[r] >= T);
                        else { sel = __builtin_amdgcn_ballot_w64(uk[r] > T); unsigned long long e = __builtin_amdgcn_ballot_w64(uk[r] == T);
                            const int ne = __builtin_popcountll(e);
                            if (ne <= need) { sel |= e; need -= ne; }
                            else { for (int k = 0; k < need; ++k) { const unsigned long long lb = e & (0ull - e); sel |= lb; e ^= lb; } need = 0; } }
                        if (lane == 0) { selm[q * 64 + 2 * r] = (unsigned)sel; selm[q * 64 + 2 * r + 1] = (unsigned)(sel >> 32); }
                    }
                }
            }
        } else {
            for (int w = tid; w < 1024; w += NTHR) { const int q = w >> 6, word = w & 63, qpos = q0 + q, lo = word * 32;
                selm[w] = (qpos >= lo + 31) ? 0xffffffffu : (qpos < lo ? 0u : ((2u << (qpos - lo)) - 1u)); }
        }
        __syncthreads();
#pragma unroll 1
        for (int arep = 0; arep < 1 + REP(13); ++arep) {
            const int nchunk = (qg + 4) >> 2; const int lrow = tid >> 3, lseg = tid & 7;
            const bf16_t* kg = z + (Tb + lrow) * ZLD + C_KA + lseg * 8; const bf16_t* vg = F.vt + ((size_t)b * 64 + lrow) * SEQ + lseg * 8;
            const unsigned lst = (unsigned)(lrow * 144 + lseg * 16);
            u32x4 kx = *(const u32x4*)(kg), vx = *(const u32x4*)(vg), ky = kx, vy = vx;
            *(u32x4*)(kbuf + lst) = kx; *(u32x4*)(vbuf + lst) = vx;
            if (1 < nchunk) { kx = *(const u32x4*)(kg + (size_t)64 * ZLD); vx = *(const u32x4*)(vg + 64); }
            if (2 < nchunk) { ky = *(const u32x4*)(kg + (size_t)128 * ZLD); vy = *(const u32x4*)(vg + 128); }
            const int hp = wave >> 1, kh = wave & 1;
            bf16x8 Bqa[2][2];
#pragma unroll
            for (int hh = 0; hh < 2; ++hh)
#pragma unroll
                for (int ks = 0; ks < 2; ++ks) Bqa[hh][ks] = *(const bf16x8*)(zq + C_Q + (2 * hp + hh) * 64 + ks * 32 + fq * 8);
            f32x4 O[2][4]; f32x4 rs[2];
#pragma unroll
            for (int hh = 0; hh < 2; ++hh) { rs[hh] = zero4;
#pragma unroll
                for (int dt = 0; dt < 4; ++dt) O[hh][dt] = zero4; }
            lds_barrier();
#pragma unroll 1
            for (int c = 0; c < nchunk; c += 2) {
                attn_chunk(kbuf, vbuf, selm, c, kh, fr, fq, Bqa, O, rs);
                if (c + 1 < nchunk) { *(u32x4*)(kbuf + 9216 + lst) = kx; *(u32x4*)(vbuf + 9216 + lst) = vx; }
                if (c + 3 < nchunk) { kx = *(const u32x4*)(kg + (size_t)(c + 3) * 64 * ZLD); vx = *(const u32x4*)(vg + (c + 3) * 64); }
                lds_barrier();
                if (c + 1 < nchunk) {
                    attn_chunk(kbuf + 9216, vbuf + 9216, selm, c + 1, kh, fr, fq, Bqa, O, rs);
                    if (c + 2 < nchunk) { *(u32x4*)(kbuf + lst) = ky; *(u32x4*)(vbuf + lst) = vy; }
                    if (c + 4 < nchunk) { ky = *(const u32x4*)(kg + (size_t)(c + 4) * 64 * ZLD); vy = *(const u32x4*)(vg + (c + 4) * 64); }
                    lds_barrier();
                }
            }
            float* xb = (float*)(vbuf + 2 * 9216) + (size_t)wave * (64 * 17);
            { const int oh = kh ^ 1;
#pragma unroll
              for (int dt = 0; dt < 4; ++dt)
#pragma unroll
                  for (int jj = 0; jj < 4; ++jj) xb[(dt * 4 + jj) * 64 + lane] = (oh == 0) ? O[0][dt][jj] : O[1][dt][jj];
              xb[16 * 64 + lane] = (oh == 0) ? rs[0][0] : rs[1][0]; }
            lds_barrier();
            { const float* pb = (const float*)(vbuf + 2 * 9216) + (size_t)(wave ^ 1) * (64 * 17);
              float tot = ((kh == 0) ? rs[0][0] : rs[1][0]) + pb[16 * 64 + lane];
              const float inv = 1.0f / tot;
              bf16_t* yp = F.yb + (Tb + q0 + fr) * 512 + (2 * hp + kh) * 64 + fq * 4;
#pragma unroll
              for (int dt = 0; dt < 4; ++dt) { float o[4];
#pragma unroll
                  for (int jj = 0; jj < 4; ++jj) o[jj] = (((kh == 0) ? O[0][dt][jj] : O[1][dt][jj]) + pb[(dt * 4 + jj) * 64 + lane]) * inv;
                  uint2 w; w.x = cvt_pk_bf16(o[0], o[1]); w.y = cvt_pk_bf16(o[2], o[3]); *(uint2*)(yp + dt * 16) = w; } }
        }
        __syncthreads();
    }
}

__device__ __forceinline__ void p4_post(const Frame& F) {
    const int tid = F.tid; const float* mu = F.in[3]; const float* gnw = F.in[12]; const float* gnb = F.in[13]; const bf16_t* z = F.z;
    for (int g = blockIdx.x * 16 + (tid >> 5); g < NTOK * 8; g += gridDim.x * 16) { const size_t t = (size_t)(g >> 3); const int h = g & 7, c = h * 64 + (tid & 31) * 2;
        const float2 y = *(const float2*)(F.yraw + t * 512 + c);
        const float mean = red32(y.x + y.y) * (1.0f / 64.0f); const float dx = y.x - mean, dy = y.y - mean;
        const float var = red32(dx * dx + dy * dy) * (1.0f / 64.0f); const float rstd = rsqrtf(var + 64e-5f);
        const unsigned vc = *(const unsigned*)(z + t * ZLD + C_V + c); const unsigned vp = (t & (SEQ - 1)) ? *(const unsigned*)(z + (t - 1) * ZLD + C_V + c) : 0u;
        const float vs0 = bflo(vc) + (bflo(vp) - bflo(vc)) * mu[C_V + c], vs1 = bfhi(vc) + (bfhi(vp) - bfhi(vc)) * mu[C_V + c + 1];
        const float bon = F.bonus[t * 8 + h]; const unsigned gt = *(const unsigned*)(F.gt + t * 512 + c);
        const float o0 = (dx * rstd * gnw[c] + gnb[c] + bon * vs0) * bflo(gt), o1 = (dy * rstd * gnw[c + 1] + gnb[c + 1] + bon * vs1) * bfhi(gt);
        *(unsigned*)(F.ya + t * 512 + c) = cvt_pk_bf16(o0, o1); }
}

__device__ __forceinline__ void p9_final(const Frame& F, const bool ident) {
    const float* g = F.in[19]; const int lane = F.lane;
    for (int row = blockIdx.x * 8 + F.wave; row < NTOK; row += gridDim.x * 8) {
        float* xr = F.out + (size_t)row * DM; const float sc = ident ? 1.0f : rsqrtf(F.ss2[row] * (1.0f / 1024.0f) + 1e-6f);
#pragma unroll
        for (int i = 0; i < 4; ++i) { f32x4 v = *(const f32x4*)(xr + i * 256 + lane * 4); const f32x4 gg = *(const f32x4*)(g + i * 256 + lane * 4);
            if (!ident) { v[0] *= sc * gg[0]; v[1] *= sc * gg[1]; v[2] *= sc * gg[2]; v[3] *= sc * gg[3]; } *(f32x4*)(xr + i * 256 + lane * 4) = v; }
    }
}
#define XB_TMO      128
#define XB_XCNT(j)  (256  + 64 * (j))
#define XB_XSUB(j)  (1280 + 64 * (j))
#define XB_XGEN(j)  (2304 + 64 * (j))
#define XB_TOP      3328
#define XB_TOPGEN   3392
#define XCD_BAR_WORDS 3456
#define XB_SPIN_CAP (1u << 18)
#define LAS __attribute__((address_space(3)))

__device__ __forceinline__ unsigned xb_ld(unsigned* p)              { return __hip_atomic_load(p, __ATOMIC_RELAXED, __HIP_MEMORY_SCOPE_AGENT); }
__device__ __forceinline__ unsigned xb_add(unsigned* p, unsigned v) { return __hip_atomic_fetch_add(p, v, __ATOMIC_RELAXED, __HIP_MEMORY_SCOPE_AGENT); }
__device__ __forceinline__ unsigned xb_xcc_id() { return (unsigned)__builtin_amdgcn_s_getreg((3 << 11) | 20) & 0xFu; }
#define XB_SPIN(cond, bar) do { unsigned _sp = 0; while (cond) { __builtin_amdgcn_s_sleep(1); \
    if ((++_sp & 255u) == 0u) { if (xb_ld(&(bar)[XB_TMO])) break; if (_sp > XB_SPIN_CAP) { atomicAdd(&(bar)[XB_TMO], 1u); break; } } } } while (0)

struct XcdBarrier {
    unsigned* bar; unsigned x;
    volatile LAS unsigned* st;
};

__device__ __forceinline__ XcdBarrier xcd_barrier_post(unsigned* bar, volatile LAS unsigned* st) {
    XcdBarrier b; b.bar = bar; b.x = xb_xcc_id(); b.st = st;
    if (threadIdx.x == 0) (void)xb_add(&bar[XB_XCNT(b.x)], 1u);
    return b;
}
__device__ __forceinline__ void xcd_barrier_complete(unsigned* bar, unsigned x, unsigned& nloc, unsigned& nx) {
    const unsigned G = gridDim.x * gridDim.y * gridDim.z;
    unsigned sum, cnt, mine, sp = 0u;
    for (;;) {
        sum = 0u; cnt = 0u; mine = 0u;
#pragma unroll
        for (unsigned j = 0; j < 16; ++j) { const unsigned c = xb_ld(&bar[XB_XCNT(j)]); sum += c; cnt += (c > 0u) ? 1u : 0u; mine = (j == x) ? c : mine; }
        if (sum == G) break;
        __builtin_amdgcn_s_sleep(1);
        if ((++sp & 255u) == 0u) { if (xb_ld(&bar[XB_TMO])) break; if (sp > XB_SPIN_CAP) { atomicAdd(&bar[XB_TMO], 1u); break; } }
    }
    nloc = mine > 0u ? mine : 1u; nx = cnt > 0u ? cnt : 1u;
}

__device__ __forceinline__ void xcd_barrier(const XcdBarrier& b) {
    asm volatile("s_waitcnt vmcnt(0)" ::: "memory");
    __syncthreads();
    if (threadIdx.x == 0) {
        unsigned* bar = b.bar;
        __builtin_amdgcn_s_waitcnt(0);
        unsigned nloc = b.st[0], nx = b.st[1];
        if (nloc == 0u) { xcd_barrier_complete(bar, b.x, nloc, nx); b.st[0] = nloc; b.st[1] = nx; }
        const unsigned old = xb_add(&bar[XB_XSUB(b.x)], 1u);
        const unsigned gen = old / nloc;
        if (old + 1u == (gen + 1u) * nloc) {
            __builtin_amdgcn_fence(__ATOMIC_RELEASE, "agent");
            asm volatile("s_waitcnt vmcnt(0)" ::: "memory");
            const unsigned og = xb_add(&bar[XB_TOP], 1u);
            const unsigned tg = og / nx;
            if (og + 1u == (tg + 1u) * nx) xb_add(&bar[XB_TOPGEN], 1u);
            else XB_SPIN(xb_ld(&bar[XB_TOPGEN]) == tg, bar);
            __builtin_amdgcn_fence(__ATOMIC_ACQUIRE, "agent");
            xb_add(&bar[XB_XGEN(b.x)], 1u);
            asm volatile("s_waitcnt vmcnt(0)" ::: "memory");
        } else {
            XB_SPIN(xb_ld(&bar[XB_XGEN(b.x)]) == gen, bar);
            __builtin_amdgcn_fence(__ATOMIC_ACQUIRE, "agent");
            asm volatile("s_waitcnt vmcnt(0)" ::: "memory");
        }
    }
    __syncthreads();
}
#ifndef PHASE_MASK
#define PHASE_MASK 0x3ff
#endif
#ifndef GEMM_ALIGN
#define GEMM_ALIGN true
#endif
#ifndef GEMM_SP2
#define GEMM_SP2 true
#endif
constexpr int NPHASE = 10;
constexpr size_t WS_BAR = 3 * MiB;
template <class Epi> __device__ __forceinline__ void run_gemm(const bf16_t* A, const bf16_t* Bt, int N, int K, const Epi& E) {
    pg8::Gemm g{A, Bt, NTOK, N, K}; pg8::StaticOrder S; S.init(NTOK, N, (int)gridDim.x, (int)blockIdx.x);
    pg8::gemm_phase<Epi, pg8::StaticOrder, GEMM_ALIGN, GEMM_SP2>((PG8_LAS unsigned char*)g_lds, g, S, E);
}
__global__ void __launch_bounds__(NTHR, 2) mega_fwd(Args args) {
    Frame F;
#pragma unroll
    for (int i = 0; i < 20; ++i) F.in[i] = args.in[i];
    F.out = args.out; F.ws = args.ws; F.lds = nullptr; F.tid = threadIdx.x; F.lane = F.tid & 63; F.wave = __builtin_amdgcn_readfirstlane(F.tid >> 6);
    unsigned char* ws = args.ws;
    F.ss1 = (float*)(ws + WS_SS1); F.ss2 = (float*)(ws + WS_SS2); F.bonus = (float*)(ws + WS_BONUS); F.rope = (float2*)(ws + WS_ROPE);
    F.wd = (bf16_t*)(ws + WS_WD); F.wi = (bf16_t*)(ws + WS_WI); F.wg = (bf16_t*)(ws + WS_WG);
    F.win = (bf16_t*)(ws + WS_WIN); F.wup = (bf16_t*)(ws + WS_WUP); F.wdn = (bf16_t*)(ws + WS_WDN); F.wb = (bf16_t*)(ws + WS_WB); F.wo = (bf16_t*)(ws + WS_WO); F.vt = (bf16_t*)(ws + WS_VT);
    F.h = (bf16_t*)(ws + WS_H); F.ya = F.h; F.yb = F.h + (size_t)NTOK * 512; F.xb = F.h;
    F.z = (bf16_t*)(ws + WS_Z); F.hid = F.z;
    F.lw = (bf16_t*)(ws + WS_P); F.ic = F.lw + (size_t)NTOK * 512; F.mg = F.lw;
    F.yraw = args.out; F.gt = (bf16_t*)(args.out + (size_t)NTOK * 512);
    const int lo = args.ph_lo, hi = args.ph_hi;
    cg::grid_group grid = cg::this_grid();
    if (args.ph_lo < 0) grid.sync();
    volatile LAS unsigned* xst = (volatile LAS unsigned*)(g_lds + LDS_BYTES - 64);
    if (threadIdx.x == 0) { xst[0] = 0u; xst[1] = 0u; }
    __syncthreads();
    XcdBarrier xbar = xcd_barrier_post((unsigned*)(ws + WS_BAR), xst);
#define IN(k) (lo <= (k) && (k) < hi)
#define SEAM(k) do { if (IN(k) && IN((k) + 1)) { xcd_barrier(xbar); if (REP(17)) xcd_barrier(xbar); } } while (0)
    if (((PHASE_MASK >> 0) & 1) && IN(0)) { p0_prologue(F); __syncthreads(); if (REP(0)) { p0_prologue(F); __syncthreads(); } } SEAM(0);
    if (((PHASE_MASK >> 1) & 1) && IN(1)) { pg8::EpiZ E{F.z, ZLD}; run_gemm(F.h, F.win, 5120, 1024, E); __syncthreads(); if (REP(1)) { run_gemm(F.h, F.win, 5120, 1024, E); __syncthreads(); } if (REP(18)) { run_gemm(F.h, F.win, 4096, 1024, E); __syncthreads(); } } SEAM(1);
    if (((PHASE_MASK >> 2) & 1) && IN(2)) { if (REP(2)) { p2_prep(F, 0); __syncthreads(); } if (REP(16)) { p2_prep(F, 2); __syncthreads(); } p2_prep(F, 1); __syncthreads(); } SEAM(2);
    if (((PHASE_MASK >> 3) & 1) && IN(3)) { if (REP(14)) { p3_scan(F, 1); __syncthreads(); } if (REP(15)) { p3_scan(F, 2); __syncthreads(); } if (REP(3)) { p3_scan(F, 0); __syncthreads(); } p3_scan(F, 0); __syncthreads(); p3_dsa(F); __syncthreads(); if (REP(10)) { p3_dsa(F); __syncthreads(); } } SEAM(3);
    if (((PHASE_MASK >> 4) & 1) && IN(4)) { p4_post(F); __syncthreads(); if (REP(4)) { p4_post(F); __syncthreads(); } } SEAM(4);
    if (((PHASE_MASK >> 5) & 1) && IN(5)) { pg8::EpiGate<0> E0{F.mg, F.z, ZLD, C_G0}; run_gemm(F.ya, F.wb, 1024, 512, E0); __syncthreads();
                 pg8::EpiGate<1> E1{F.mg, F.z, ZLD, C_G1}; run_gemm(F.yb, F.wb + 1024 * 512, 1024, 512, E1); __syncthreads();
                 if (REP(5)) { run_gemm(F.ya, F.wb, 1024, 512, E0); __syncthreads(); run_gemm(F.yb, F.wb + 1024 * 512, 1024, 512, E1); __syncthreads(); } } SEAM(5);
    if (((PHASE_MASK >> 6) & 1) && IN(6)) { if (REP(6)) { pg8::EpiRes1 Ex{F.in[0], F.xb, F.bonus}; run_gemm(F.mg, F.wo, 1024, 1024, Ex); __syncthreads(); }
                 pg8::EpiRes1 E{F.in[0], F.xb, F.ss1}; run_gemm(F.mg, F.wo, 1024, 1024, E); __syncthreads(); } SEAM(6);
    if (((PHASE_MASK >> 7) & 1) && IN(7)) { pg8::EpiHid E{F.hid, F.ss1}; run_gemm(F.xb, F.wup, 4096, 1024, E); __syncthreads(); if (REP(7)) { run_gemm(F.xb, F.wup, 4096, 1024, E); __syncthreads(); } } SEAM(7);
    if (((PHASE_MASK >> 8) & 1) && IN(8)) { pg8::EpiRes2 E{F.xb, F.out, F.ss2}; run_gemm(F.hid, F.wdn, 1024, 4096, E); __syncthreads(); } SEAM(8);
    if (((PHASE_MASK >> 9) & 1) && IN(9)) { if (REP(9)) { p9_final(F, true); __syncthreads(); } p9_final(F, false); }
#undef IN
#undef SEAM
}

extern "C" void kernel_launch(void* const* d_in, const int* in_sizes, int n_in, void* d_out, int out_size, void* d_ws, size_t ws_size, hipStream_t stream) {
    static int grid = 0;
    if (grid == 0) {
        if (n_in != 20 || out_size != NTOK * DM || ws_size < WS_END) { fprintf(stderr, "kernel_launch: unexpected shapes (n_in %d, out %d, ws %zu < %zu)\n", n_in, out_size, ws_size, (size_t)WS_END); grid = -1; return; }
        int dev = 0, cus = 0, per_cu = 0;
        hipGetDevice(&dev); hipDeviceGetAttribute(&cus, hipDeviceAttributeMultiprocessorCount, dev);
        if (hipFuncSetAttribute((const void*)mega_fwd, hipFuncAttributeMaxDynamicSharedMemorySize, LDS_BYTES) != hipSuccess) { fprintf(stderr, "kernel_launch: hipFuncSetAttribute failed\n"); grid = -1; return; }
        if (hipOccupancyMaxActiveBlocksPerMultiprocessor(&per_cu, (const void*)mega_fwd, NTHR, LDS_BYTES) != hipSuccess || per_cu < 1) { fprintf(stderr, "kernel_launch: occupancy query failed (%d)\n", per_cu); per_cu = 1; }
        (void)hipGetLastError();
        grid = cus * per_cu;
        fprintf(stderr, "kernel_launch: grid %d (%d CUs x %d)\n", grid, cus, per_cu);
    }
    if (grid < 0) return;
    if (hipMemsetAsync((char*)d_ws + WS_BAR, 0, XCD_BAR_WORDS * 4, stream) != hipSuccess) { fprintf(stderr, "kernel_launch: memset of the barrier words failed\n"); return; }
    Args a{};
    for (int i = 0; i < 20; ++i) a.in[i] = (const float*)d_in[i];
    a.out = (float*)d_out; a.ws = (unsigned char*)d_ws;
#if MK_PER_PHASE_LAUNCH
    for (int p = 0; p < NPHASE; ++p) { a.ph_lo = p; a.ph_hi = p + 1; hipLaunchKernelGGL(mega_fwd, dim3(grid), dim3(NTHR), LDS_BYTES, stream, a); }
#else
    a.ph_lo = 0; a.ph_hi = NPHASE;
    void* kargs[] = {&a};
    hipError_t e = hipLaunchCooperativeKernel((const void*)mega_fwd, dim3(grid), dim3(NTHR), kargs, LDS_BYTES, stream);
    if (e != hipSuccess) fprintf(stderr, "kernel_launch: cooperative launch failed: %s (grid %d)\n", hipGetErrorString(e), grid);
#endif
}
```

```cpp
#include <hip/hip_runtime.h>
#include <hip/hip_cooperative_groups.h>
#include <cstdio>
#include <cstdint>
namespace cg = cooperative_groups;

#ifndef MK_PER_PHASE_LAUNCH
#define MK_PER_PHASE_LAUNCH 0
#endif

#ifndef REPEAT_MASK
#define REPEAT_MASK 0
#endif
#define REP(k) ((REPEAT_MASK >> (k)) & 1)
#ifndef TS_SEL
#define TS_SEL -1
#endif

namespace pg8 {
#define PG8_LAS __attribute__((address_space(3)))
typedef unsigned short bf16_t;
typedef short bf16x8 __attribute__((ext_vector_type(8)));
typedef float f32x4 __attribute__((ext_vector_type(4)));
typedef unsigned u32x4 __attribute__((ext_vector_type(4)));
constexpr int BM = 256, BK = 64, HALF = 128, HTB = HALF * BK * 2  , STAGE_BYTES = 8 * HTB, NXCD = 8, WGM = 8;

__host__ __device__ __forceinline__ int lds_byte(int r, int c) { const int st = (r >> 4) * 2 + (c >> 5), rr = r & 15, cc = c & 31, ob = rr * 64 + cc * 2; return st * 1024 + (ob ^ (((ob >> 9) & 1) << 5)); }
__host__ __device__ __forceinline__ void stage_rc(int b, int& R, int& C) { const int st = b / 1024, sb = b % 1024, swz = sb ^ (((sb >> 9) & 1) << 5); R = (st >> 1) * 16 + swz / 64; C = (st & 1) * 32 + (swz % 64) / 2; }
__host__ __device__ __forceinline__ int perm32(int rho) { const int n = rho >> 4, i = rho & 15; return 8 * (i >> 2) + 4 * n + (i & 3); }

struct Unit { int pm, pn; };
struct Gemm { const bf16_t* A; const bf16_t* Bt; int M, N, K; };

struct StaticOrder {
    int nM, nN, nwg, G, c;
    __host__ __device__ void init(int M, int N, int G_, int c_) { nM = M / BM; nN = N / BM; nwg = nM * nN; G = G_; c = c_; }
    __host__ __device__ bool next(int i, Unit& u) const {
        const long L = (long)i * G + c; if (L >= nwg) return false;
        int wgid = (int)L; { const int q = nwg / NXCD, r = nwg % NXCD, xcd = wgid % NXCD, off = wgid / NXCD; wgid = (xcd < r ? xcd * (q + 1) : r * (q + 1) + (xcd - r) * q) + off; }
        const int nig = WGM * nN, gid = wgid / nig, fm = gid * WGM, gsz = (nM - fm) < WGM ? (nM - fm) : WGM;
        u.pm = fm + ((wgid % nig) % gsz); u.pn = (wgid % nig) / gsz; return true;
    }
    __device__ __forceinline__ void a_ready(const Unit&) const {}
    __device__ __forceinline__ void done(const Unit&) const {}
};
__device__ __forceinline__ unsigned cvt_pk_bf16(float lo, float hi) { unsigned r; asm volatile("v_cvt_pk_bf16_f32 %0, %1, %2" : "=v"(r) : "v"(lo), "v"(hi)); return r; }
typedef float f32x2 __attribute__((ext_vector_type(2)));
__device__ __forceinline__ float bflo(unsigned u) { return __uint_as_float(u << 16); }
__device__ __forceinline__ float bfhi(unsigned u) { return __uint_as_float(u & 0xffff0000u); }
__device__ __forceinline__ float sigm(float x) { return 1.0f / (1.0f + __expf(-x)); }

struct EpiZ {
    static constexpr bool PERM = true, AFTER_DRAIN = false;
    bf16_t* O; int ldc;
    __device__ __forceinline__ void operator()(const f32x4 (&acc)[2][2][4][2], const Unit& u, int wr, int wc, int fr, int fq) const {
        const int row0 = u.pm * BM + wr * 64 + fr, col0 = u.pn * BM + wc * 32 + 8 * fq;
#pragma unroll
        for (int ai = 0; ai < 2; ++ai)
#pragma unroll
            for (int m = 0; m < 4; ++m) { bf16_t* rowp = O + (size_t)(row0 + ai * HALF + m * 16) * ldc + col0;
#pragma unroll
                for (int bj = 0; bj < 2; ++bj) { const f32x4 v0 = acc[ai][bj][m][0], v1 = acc[ai][bj][m][1];
                    u32x4 w; w.x = cvt_pk_bf16(v0[0], v0[1]); w.y = cvt_pk_bf16(v0[2], v0[3]); w.z = cvt_pk_bf16(v1[0], v1[1]); w.w = cvt_pk_bf16(v1[2], v1[3]);
                    *(u32x4*)(rowp + bj * HALF) = w; } }
    }
};
template <int MODE> struct EpiGate {
    static constexpr bool PERM = true, AFTER_DRAIN = false;
    bf16_t* O; const bf16_t* Z; int zld; int gcol;
    __device__ __forceinline__ void operator()(const f32x4 (&acc)[2][2][4][2], const Unit& u, int wr, int wc, int fr, int fq) const {
        const int row0 = u.pm * BM + wr * 64 + fr, col0 = u.pn * BM + wc * 32 + 8 * fq;
#pragma unroll
        for (int ai = 0; ai < 2; ++ai)
#pragma unroll
            for (int m = 0; m < 4; ++m) { const size_t row = (size_t)(row0 + ai * HALF + m * 16);
                bf16_t* op = O + row * 1024 + col0; const bf16_t* zp = Z + row * zld + gcol + col0;
#pragma unroll
                for (int bj = 0; bj < 2; ++bj) { const f32x4 v0 = acc[ai][bj][m][0], v1 = acc[ai][bj][m][1];
                    const u32x4 g = *(const u32x4*)(zp + bj * HALF);
                    float r0 = v0[0] * sigm(bflo(g.x)), r1 = v0[1] * sigm(bfhi(g.x)), r2 = v0[2] * sigm(bflo(g.y)), r3 = v0[3] * sigm(bfhi(g.y));
                    float r4 = v1[0] * sigm(bflo(g.z)), r5 = v1[1] * sigm(bfhi(g.z)), r6 = v1[2] * sigm(bflo(g.w)), r7 = v1[3] * sigm(bfhi(g.w));
                    if (MODE == 1) { const u32x4 p = *(const u32x4*)(op + bj * HALF);
                        r0 += bflo(p.x); r1 += bfhi(p.x); r2 += bflo(p.y); r3 += bfhi(p.y); r4 += bflo(p.z); r5 += bfhi(p.z); r6 += bflo(p.w); r7 += bfhi(p.w); }
                    u32x4 w; w.x = cvt_pk_bf16(r0, r1); w.y = cvt_pk_bf16(r2, r3); w.z = cvt_pk_bf16(r4, r5); w.w = cvt_pk_bf16(r6, r7);
                    *(u32x4*)(op + bj * HALF) = w; } }
    }
};
struct EpiRes1 {
    static constexpr bool PERM = false, AFTER_DRAIN = false;
    const float* X; bf16_t* XB; float* SS;
    __device__ __forceinline__ void operator()(const f32x4 (&acc)[2][2][4][2], const Unit& u, int wr, int wc, int fr, int fq) const {
        const int row0 = u.pm * BM + wr * 64 + fr, col0 = u.pn * BM + wc * 32 + 4 * fq;
#pragma unroll
        for (int ai = 0; ai < 2; ++ai)
#pragma unroll
            for (int m = 0; m < 4; ++m) { const size_t row = (size_t)(row0 + ai * HALF + m * 16); float ssq = 0.f;
#pragma unroll
                for (int bj = 0; bj < 2; ++bj)
#pragma unroll
                    for (int n = 0; n < 2; ++n) { const size_t off = row * 1024 + col0 + bj * HALF + n * 16;
                        const f32x4 xv = *(const f32x4*)(X + off); const f32x4 v = acc[ai][bj][m][n] + xv;
                        ssq += v[0] * v[0] + v[1] * v[1] + v[2] * v[2] + v[3] * v[3];
                        uint2 w; w.x = cvt_pk_bf16(v[0], v[1]); w.y = cvt_pk_bf16(v[2], v[3]); *(uint2*)(XB + off) = w; }
                ssq += __shfl_xor(ssq, 16); ssq += __shfl_xor(ssq, 32);
                if (fq == 0) atomicAdd(SS + row, ssq); }
    }
};
struct EpiRes2 {
    static constexpr bool PERM = false, AFTER_DRAIN = false;
    const bf16_t* XB; float* O; float* SS;
    __device__ __forceinline__ void operator()(const f32x4 (&acc)[2][2][4][2], const Unit& u, int wr, int wc, int fr, int fq) const {
        const int row0 = u.pm * BM + wr * 64 + fr, col0 = u.pn * BM + wc * 32 + 4 * fq;
#pragma unroll
        for (int ai = 0; ai < 2; ++ai)
#pragma unroll
            for (int m = 0; m < 4; ++m) { const size_t row = (size_t)(row0 + ai * HALF + m * 16); float ssq = 0.f;
#pragma unroll
                for (int bj = 0; bj < 2; ++bj)
#pragma unroll
                    for (int n = 0; n < 2; ++n) { const size_t off = row * 1024 + col0 + bj * HALF + n * 16;
                        const uint2 xw = *(const uint2*)(XB + off); f32x4 v = acc[ai][bj][m][n];
                        v[0] += bflo(xw.x); v[1] += bfhi(xw.x); v[2] += bflo(xw.y); v[3] += bfhi(xw.y);
                        *(f32x4*)(O + off) = v; ssq += v[0] * v[0] + v[1] * v[1] + v[2] * v[2] + v[3] * v[3]; }
                ssq += __shfl_xor(ssq, 16); ssq += __shfl_xor(ssq, 32);
                if (fq == 0) atomicAdd(SS + row, ssq); }
    }
};
struct EpiHid {
    static constexpr bool PERM = true, AFTER_DRAIN = false;
    bf16_t* O; const float* SS;
    __device__ __forceinline__ void operator()(const f32x4 (&acc)[2][2][4][2], const Unit& u, int wr, int wc, int fr, int fq) const {
        const int row0 = u.pm * BM + wr * 64 + fr, col0 = u.pn * BM + wc * 32 + 8 * fq;
#pragma unroll
        for (int ai = 0; ai < 2; ++ai)
#pragma unroll
            for (int m = 0; m < 4; ++m) { const size_t row = (size_t)(row0 + ai * HALF + m * 16);
                const float s2 = 1.0f / (SS[row] * (1.0f / 1024.0f) + 1e-6f);
                bf16_t* rowp = O + row * 4096 + col0;
#pragma unroll
                for (int bj = 0; bj < 2; ++bj) { f32x4 v0 = acc[ai][bj][m][0], v1 = acc[ai][bj][m][1];
#pragma unroll
                    for (int j = 0; j < 4; ++j) { float a = fmaxf(v0[j], 0.f), b = fmaxf(v1[j], 0.f); v0[j] = a * a * s2; v1[j] = b * b * s2; }
                    u32x4 w; w.x = cvt_pk_bf16(v0[0], v0[1]); w.y = cvt_pk_bf16(v0[2], v0[3]); w.z = cvt_pk_bf16(v1[0], v1[1]); w.w = cvt_pk_bf16(v1[2], v1[3]);
                    *(u32x4*)(rowp + bj * HALF) = w; } }
    }
};

template <class Epi, class Sched, bool ALIGN_EPI = false, bool SP2 = false>
__device__ __forceinline__ void gemm_phase(PG8_LAS unsigned char* lds, const Gemm g, const Sched& S, const Epi& E) {
    const int tid = threadIdx.x, wid = __builtin_amdgcn_readfirstlane(tid >> 6), lane = tid & 63, wr = wid >> 2, wc = wid & 3, fr = lane & 15, fq = lane >> 4;
    const int K = g.K, nt = K / BK;
    unsigned voffA[2], voffB[2];
#pragma unroll
    for (int i = 0; i < 2; ++i) { int R, C; stage_rc(tid * 16 + i * 8192, R, C); const int Rb = Epi::PERM ? ((R & ~31) + perm32(R & 31)) : R;
        voffA[i] = (unsigned)(R * K + C) * 2u; voffB[i] = (unsigned)(Rb * K + C) * 2u; }
    const size_t kstep = (size_t)(BK * 2);
    const size_t hstep = (size_t)HALF * K * 2;
    const size_t tstep = 2 * hstep;
    const unsigned ldsw = (unsigned)wid * 1024u;
    const int aoff = lds_byte(wr * 64 + fr, fq * 8), boff = lds_byte(wc * 32 + fr, fq * 8);
#define PG8_SA(b, h) (((b) * 2 + (h)) * HTB)
#define PG8_SB(b, h) ((4 + (b) * 2 + (h)) * HTB)
#define PG8_STAGE(bufoff, gbase, voff) do { _Pragma("unroll") for (int _i = 0; _i < 2; ++_i) \
        __builtin_amdgcn_global_load_lds((const unsigned*)((const char*)(gbase) + (voff)[_i]), (PG8_LAS unsigned*)(lds + (bufoff) + ldsw + _i * 8192), 16, 0, 0); } while (0)
#define PG8_LDA(dst, b, h) do { _Pragma("unroll") for (int m = 0; m < 4; ++m) _Pragma("unroll") for (int k = 0; k < 2; ++k) dst[m][k] = *(const PG8_LAS bf16x8*)(lds + PG8_SA(b, h) + aoff + m * 2048 + k * 1024); } while (0)
#define PG8_LDB(dst, b, h) do { _Pragma("unroll") for (int n = 0; n < 2; ++n) _Pragma("unroll") for (int k = 0; k < 2; ++k) dst[n][k] = *(const PG8_LAS bf16x8*)(lds + PG8_SB(b, h) + boff + n * 2048 + k * 1024); } while (0)
#define PG8_MMA(ai, bj, At, Bt) do { __builtin_amdgcn_s_setprio(1); _Pragma("unroll") for (int m = 0; m < 4; ++m) _Pragma("unroll") for (int n = 0; n < 2; ++n) _Pragma("unroll") for (int k = 0; k < 2; ++k) \
        acc[ai][bj][m][n] = __builtin_amdgcn_mfma_f32_16x16x32_bf16(Bt[n][k], At[m][k], acc[ai][bj][m][n], 0, 0, 0); __builtin_amdgcn_s_setprio(0); } while (0)
#define PG8_WAIT_V(n) asm volatile("s_waitcnt vmcnt(" #n ")" ::: "memory")
#define PG8_WAIT_L(n) asm volatile("s_waitcnt lgkmcnt(" #n ")" ::: "memory")
#define PG8_BAR __builtin_amdgcn_s_barrier()
#define PG8_SCHED __builtin_amdgcn_sched_barrier(0)
    Unit cur, nxt; int ui = 0;
    if (!S.next(0, cur)) return;
    f32x4 acc[2][2][4][2];
#pragma unroll
    for (int a = 0; a < 2; ++a)
#pragma unroll
        for (int b = 0; b < 2; ++b)
#pragma unroll
            for (int m = 0; m < 4; ++m)
#pragma unroll
                for (int n = 0; n < 2; ++n) acc[a][b][m][n] = (f32x4){0.f, 0.f, 0.f, 0.f};
    bf16x8 At[4][2], B0[2][2], B1[2][2];
    const char* cA = (const char*)g.A + (size_t)cur.pm * tstep; const char* cB = (const char*)g.Bt + (size_t)cur.pn * tstep;
    S.a_ready(cur);
    if constexpr (SP2) {
        PG8_STAGE(PG8_SB(0, 0), cB, voffB); PG8_STAGE(PG8_SB(0, 1), cB + hstep, voffB); PG8_STAGE(PG8_SA(0, 0), cA, voffA); PG8_STAGE(PG8_SA(0, 1), cA + hstep, voffA);
        if (wr == 1) PG8_BAR;
        PG8_WAIT_V(2); PG8_BAR;
        PG8_STAGE(PG8_SB(1, 0), cB + kstep, voffB); PG8_STAGE(PG8_SA(1, 0), cA + kstep, voffA); PG8_STAGE(PG8_SB(1, 1), cB + hstep + kstep, voffB);
        PG8_WAIT_V(6); PG8_BAR;
    } else {
        PG8_STAGE(PG8_SB(0, 0), cB, voffB); PG8_STAGE(PG8_SA(0, 0), cA, voffA); PG8_STAGE(PG8_SB(0, 1), cB + hstep, voffB); PG8_STAGE(PG8_SA(0, 1), cA + hstep, voffA);
        if (wr == 1) PG8_BAR;
        PG8_WAIT_V(4); PG8_BAR;
        PG8_STAGE(PG8_SB(1, 0), cB + kstep, voffB); PG8_STAGE(PG8_SA(1, 0), cA + kstep, voffA); PG8_STAGE(PG8_SB(1, 1), cB + hstep + kstep, voffB);
        PG8_WAIT_V(6); PG8_BAR;
    }
    for (;;) {
        const bool has_next = S.next(ui + 1, nxt);
        const char* nA = has_next ? (const char*)g.A + (size_t)nxt.pm * tstep : cA; const char* nB = has_next ? (const char*)g.Bt + (size_t)nxt.pn * tstep : cB;
        for (int t = 0; t < nt; t += 2) {
            const bool last = (t == nt - 2);
            const char* a1 = cA + (size_t)(t + 1) * kstep;
            const char* a2 = last ? nA : cA + (size_t)(t + 2) * kstep; const char* b2 = last ? nB : cB + (size_t)(t + 2) * kstep;
            const char* a3 = a2 + kstep; const char* b3 = b2 + kstep;
            if (last && has_next) S.a_ready(nxt);
            if constexpr (SP2) {
            PG8_LDB(B0, 0, 0); PG8_LDB(B1, 0, 1); PG8_SCHED; PG8_LDA(At, 0, 0); PG8_STAGE(PG8_SA(1, 1), a1 + hstep, voffA);
            PG8_WAIT_V(8); PG8_WAIT_L(0); PG8_BAR; PG8_MMA(0, 0, At, B0); PG8_MMA(0, 1, At, B1); PG8_BAR; PG8_SCHED;
            PG8_LDA(At, 0, 1); PG8_STAGE(PG8_SB(0, 0), b2, voffB); PG8_STAGE(PG8_SB(0, 1), b2 + hstep, voffB); PG8_STAGE(PG8_SA(0, 0), a2, voffA);
            PG8_WAIT_V(8); PG8_WAIT_L(0); PG8_BAR; PG8_MMA(1, 0, At, B0); PG8_MMA(1, 1, At, B1); PG8_BAR; PG8_SCHED;
            PG8_LDB(B0, 1, 0); PG8_LDB(B1, 1, 1); PG8_SCHED; PG8_LDA(At, 1, 0); PG8_STAGE(PG8_SA(0, 1), a2 + hstep, voffA);
            PG8_WAIT_V(8); PG8_WAIT_L(0); PG8_BAR; PG8_MMA(0, 0, At, B0); PG8_MMA(0, 1, At, B1); PG8_BAR; PG8_SCHED;
            PG8_LDA(At, 1, 1); PG8_STAGE(PG8_SB(1, 0), b3, voffB); PG8_STAGE(PG8_SB(1, 1), b3 + hstep, voffB); PG8_STAGE(PG8_SA(1, 0), a3, voffA);
            PG8_WAIT_V(8); PG8_WAIT_L(0); PG8_BAR; PG8_MMA(1, 0, At, B0); PG8_MMA(1, 1, At, B1); PG8_BAR; PG8_SCHED;
            } else {
            PG8_LDB(B0, 0, 0); PG8_SCHED; PG8_LDA(At, 0, 0); PG8_STAGE(PG8_SA(1, 1), a1 + hstep, voffA);
            PG8_WAIT_L(8); PG8_BAR; PG8_WAIT_L(0); PG8_MMA(0, 0, At, B0); PG8_BAR; PG8_SCHED;
            PG8_LDB(B1, 0, 1); PG8_STAGE(PG8_SB(0, 0), b2, voffB);
            PG8_BAR; PG8_WAIT_L(0); PG8_MMA(0, 1, At, B1); PG8_BAR;
            PG8_LDA(At, 0, 1); PG8_STAGE(PG8_SA(0, 0), a2, voffA);
            PG8_BAR; PG8_WAIT_L(0); PG8_MMA(1, 0, At, B0); PG8_BAR; PG8_SCHED;
            PG8_STAGE(PG8_SB(0, 1), b2 + hstep, voffB);
            PG8_WAIT_V(6); PG8_BAR; PG8_MMA(1, 1, At, B1); PG8_BAR;
            PG8_LDB(B0, 1, 0); PG8_SCHED; PG8_LDA(At, 1, 0); PG8_STAGE(PG8_SA(0, 1), a2 + hstep, voffA);
            PG8_WAIT_L(8); PG8_BAR; PG8_WAIT_L(0); PG8_MMA(0, 0, At, B0); PG8_BAR; PG8_SCHED;
            PG8_LDB(B1, 1, 1); PG8_STAGE(PG8_SB(1, 0), b3, voffB);
            PG8_BAR; PG8_WAIT_L(0); PG8_MMA(0, 1, At, B1); PG8_BAR;
            PG8_LDA(At, 1, 1); PG8_STAGE(PG8_SA(1, 0), a3, voffA);
            PG8_BAR; PG8_WAIT_L(0); PG8_MMA(1, 0, At, B0); PG8_BAR; PG8_SCHED;
            PG8_STAGE(PG8_SB(1, 1), b3 + hstep, voffB);
            PG8_WAIT_V(6); PG8_BAR; PG8_MMA(1, 1, At, B1); PG8_BAR;
            }
        }
        if constexpr (ALIGN_EPI) { if (wr == 0) PG8_BAR; }
        if constexpr (!Epi::AFTER_DRAIN) { E(acc, cur, wr, wc, fr, fq); S.done(cur); }
        if (!has_next) break;
#pragma unroll
        for (int a = 0; a < 2; ++a)
#pragma unroll
            for (int b = 0; b < 2; ++b)
#pragma unroll
                for (int m = 0; m < 4; ++m)
#pragma unroll
                    for (int n = 0; n < 2; ++n) acc[a][b][m][n] = (f32x4){0.f, 0.f, 0.f, 0.f};
        cur = nxt; cA = nA; cB = nB; ++ui;
        if constexpr (ALIGN_EPI) { if (wr == 1) PG8_BAR; }
    }
    PG8_WAIT_V(0);
    if constexpr (!ALIGN_EPI) { if (wr == 0) PG8_BAR; }
    PG8_BAR;
    if constexpr (Epi::AFTER_DRAIN) { E.fused(acc, cur, wr, wc, fr, fq, lds, wid, lane); S.done(cur); }
#undef PG8_SA
#undef PG8_SB
#undef PG8_STAGE
#undef PG8_LDA
#undef PG8_LDB
#undef PG8_MMA
#undef PG8_WAIT_V
#undef PG8_WAIT_L
#undef PG8_BAR
#undef PG8_SCHED
}
}
extern __shared__ __attribute__((aligned(16))) unsigned char g_lds[];
using pg8::bf16_t; using pg8::bf16x8; using pg8::f32x4; using pg8::u32x4; using pg8::cvt_pk_bf16; using pg8::bflo; using pg8::bfhi; using pg8::sigm;

constexpr int NTOK = 32768, DM = 1024, SEQ = 2048, NB = 16, ZLD = 5120, NTHR = 512;
constexpr int C_R = 0, C_K = 512, C_V = 1024, C_WD = 1536, C_AD = 1600, C_GD = 1664;
constexpr int C_Q = 1824, C_KA = 2336, C_VA = 2400, C_QI = 2464, C_KI = 2976, C_WI = 3040, C_G0 = 3048, C_G1 = 4072;
constexpr size_t MiB = 1024 * 1024;
constexpr size_t WS_SS1 = 0, WS_SS2 = 128 * 1024, WS_BONUS = 256 * 1024, WS_ROPE = 1280 * 1024, WS_WD = 1792 * 1024, WS_WI = 1856 * 1024, WS_WG = 1920 * 1024;
constexpr size_t WS_WIN = 4 * MiB, WS_WUP = 14 * MiB, WS_WDN = 22 * MiB, WS_WB = 30 * MiB, WS_WO = 32 * MiB, WS_VT = 34 * MiB, WS_H = 38 * MiB, WS_Z = 102 * MiB, WS_P = 422 * MiB, WS_END = 486 * MiB;
constexpr int LDS_BYTES = 163840;

struct Args { const float* in[20]; float* out; unsigned char* ws; int ph_lo, ph_hi; };

struct Frame {
    const float* in[20]; float* out; unsigned char* ws; unsigned char* lds; int tid, lane, wave;
    float *ss1, *ss2, *bonus; float2* rope; bf16_t *wd, *wi, *wg, *win, *wup, *wdn, *wb, *wo, *vt, *h, *ya, *yb, *xb, *z, *hid, *lw, *ic, *mg, *gt; float* yraw;
};

__device__ __forceinline__ bf16_t f2bf(float f) { return (bf16_t)(cvt_pk_bf16(f, 0.f) & 0xffffu); }
__device__ __forceinline__ float bf2f(bf16_t b) { return __uint_as_float(((unsigned)b) << 16); }
template <int CTRL> __device__ __forceinline__ float dpp_mov(float x) { return __int_as_float(__builtin_amdgcn_update_dpp(0, __float_as_int(x), CTRL, 0xF, 0xF, true)); }
__device__ __forceinline__ float red16(float x) { x += dpp_mov<0xB1>(x); x += dpp_mov<0x4E>(x); x += dpp_mov<0x141>(x); x += dpp_mov<0x140>(x); return x; }


__device__ __forceinline__ void lds_barrier() { asm volatile("s_waitcnt lgkmcnt(0)" ::: "memory"); __builtin_amdgcn_s_barrier(); asm volatile("" ::: "memory"); }
__device__ __forceinline__ void red16x4(float& a, float& b, float& c, float& d) {
#define DPP4(ctl) "v_add_f32_dpp %0, %0, %0 " ctl " row_mask:0xf bank_mask:0xf bound_ctrl:1\n" "v_add_f32_dpp %1, %1, %1 " ctl " row_mask:0xf bank_mask:0xf bound_ctrl:1\n" \
                  "v_add_f32_dpp %2, %2, %2 " ctl " row_mask:0xf bank_mask:0xf bound_ctrl:1\n" "v_add_f32_dpp %3, %3, %3 " ctl " row_mask:0xf bank_mask:0xf bound_ctrl:1\n"
    asm volatile("s_nop 1\n" DPP4("quad_perm:[1,0,3,2]") DPP4("quad_perm:[2,3,0,1]") DPP4("row_half_mirror") DPP4("row_mirror") : "+v"(a), "+v"(b), "+v"(c), "+v"(d));
#undef DPP4
}
__device__ __forceinline__ float red32(float x) { x += __shfl_xor(x, 1); x += __shfl_xor(x, 2); x += __shfl_xor(x, 4); x += __shfl_xor(x, 8); x += __shfl_xor(x, 16); return x; }
__device__ __forceinline__ float red64(float x) { x = red32(x); x += __shfl_xor(x, 32); return x; }
__device__ __forceinline__ float softplus_f(float x) { return fmaxf(x, 0.f) + log1pf(__expf(-fabsf(x))); }

__device__ __forceinline__ void tconv(const Frame& F, const float* __restrict__ W, int K, int N, int Npad, bf16_t* __restrict__ Wt, const float* __restrict__ rs) {
    float* tile = (float*)g_lds;
    const int ktn = (K + 63) / 64, ntn = Npad / 64, tid = F.tid;
    for (int tl = blockIdx.x; tl < ktn * ntn; tl += gridDim.x) {
        const int kt = tl % ktn, nt = tl / ktn;
#pragma unroll
        for (int i = 0; i < 2; ++i) { const int idx = tid + i * NTHR, kk = idx >> 4, n4 = (idx & 15) * 4, k = kt * 64 + kk, n = nt * 64 + n4;
            f32x4 v = {0.f, 0.f, 0.f, 0.f};
            if (k < K) { if (n + 3 < N) v = *(const f32x4*)(W + (size_t)k * N + n); else { for (int j = 0; j < 4; ++j) if (n + j < N) v[j] = W[(size_t)k * N + n + j]; }
                if (rs != nullptr) { const float r = rs[k]; v[0] *= r; v[1] *= r; v[2] *= r; v[3] *= r; } }
            tile[kk * 65 + n4] = v[0]; tile[kk * 65 + n4 + 1] = v[1]; tile[kk * 65 + n4 + 2] = v[2]; tile[kk * 65 + n4 + 3] = v[3]; }
        __syncthreads();
        { const int nn = tid >> 3, k8 = (tid & 7) * 8, k = kt * 64 + k8, n = nt * 64 + nn;
          if (k < K) { u32x4 w; const float* tp = tile + k8 * 65 + nn;
              w.x = cvt_pk_bf16(tp[0], tp[65]); w.y = cvt_pk_bf16(tp[130], tp[195]); w.z = cvt_pk_bf16(tp[260], tp[325]); w.w = cvt_pk_bf16(tp[390], tp[455]);
              *(u32x4*)(Wt + (size_t)n * K + k) = w; } }
        __syncthreads();
    }
}
__device__ __forceinline__ void p0_prologue(const Frame& F) {
    const int tid = F.tid, gtid = blockIdx.x * NTHR + tid, gn = gridDim.x * NTHR;
    for (int i = gtid; i < 2 * NTOK; i += gn) F.ss1[i] = 0.f;
    for (int i = gtid; i < SEQ * 32; i += gn) { const int pos = i >> 5, j = i & 31;
        const float inv = 1.0f / powf(10000.0f, (float)(2 * j) / 64.0f); const float ang = (float)pos * inv;
        double rev = (double)ang * 0.15915494309189535; rev -= floor(rev); const float fr = (float)rev;
        F.rope[i] = make_float2(__builtin_amdgcn_cosf(fr), __builtin_amdgcn_sinf(fr)); }
    tconv(F, F.in[2], 1024, 5096, 5120, F.win, nullptr);
    tconv(F, F.in[17], 1024, 4096, 4096, F.wup, F.in[16]);
    tconv(F, F.in[18], 4096, 1024, 1024, F.wdn, nullptr);
    tconv(F, F.in[14], 512, 1024, 1024, F.wb, nullptr);
    tconv(F, F.in[14] + 512 * 1024, 512, 1024, 1024, F.wb + 1024 * 512, nullptr);
    tconv(F, F.in[15], 1024, 1024, 1024, F.wo, nullptr);
    tconv(F, F.in[5], 64, 512, 512, F.wd, nullptr);
    tconv(F, F.in[7], 64, 512, 512, F.wi, nullptr);
    tconv(F, F.in[8], 160, 512, 512, F.wg, nullptr);
    const float* x = F.in[0]; const float* g = F.in[1]; const int lane = F.lane;
    for (int row = blockIdx.x * 8 + F.wave; row < NTOK; row += gridDim.x * 8) {
        const float* xr = x + (size_t)row * DM; f32x4 v[4]; float ss = 0.f;
#pragma unroll
        for (int i = 0; i < 4; ++i) { v[i] = *(const f32x4*)(xr + i * 256 + lane * 4); ss += v[i][0] * v[i][0] + v[i][1] * v[i][1] + v[i][2] * v[i][2] + v[i][3] * v[i][3]; }
        ss = red64(ss); const float sc = rsqrtf(ss * (1.0f / 1024.0f) + 1e-6f);
#pragma unroll
        for (int i = 0; i < 4; ++i) { const f32x4 gg = *(const f32x4*)(g + i * 256 + lane * 4); uint2 w;
            w.x = cvt_pk_bf16(v[i][0] * sc * gg[0], v[i][1] * sc * gg[1]); w.y = cvt_pk_bf16(v[i][2] * sc * gg[2], v[i][3] * sc * gg[3]);
            *(uint2*)(F.h + (size_t)row * DM + i * 256 + lane * 4) = w; }
    }
}

__device__ __forceinline__ void p2_prep(const Frame& F, const int mode) {
    const int tid = F.tid, lane = F.lane, wave = F.wave, fr = lane & 15, fq = lane >> 4;
    bf16_t* z = F.z; const float* mu = F.in[3];
    if (mode != 2) {
        constexpr int LDA = 296, TT = 32; bf16_t* At = (bf16_t*)g_lds;
        bf16_t* Ot = At + TT * LDA;
        const float* dbias = F.in[4]; const float* ibias = F.in[6];
        for (int tile = blockIdx.x; tile < NTOK / TT; tile += gridDim.x) {
            const int t0 = tile * TT;
            for (int idx = tid; idx < TT * 36; idx += NTHR) { const int tok = idx / 36, c8 = (idx - tok * 36) * 8, t = t0 + tok, col = C_WD + c8;
                const u32x4 zc = *(const u32x4*)(z + (size_t)t * ZLD + col); u32x4 zp = {0u, 0u, 0u, 0u}; if (t & (SEQ - 1)) zp = *(const u32x4*)(z + (size_t)(t - 1) * ZLD + col);
                const f32x4 m0 = *(const f32x4*)(mu + col), m1 = *(const f32x4*)(mu + col + 4);
                float v[8]; const unsigned zcu[4] = {zc.x, zc.y, zc.z, zc.w}, zpu[4] = {zp.x, zp.y, zp.z, zp.w};
#pragma unroll
                for (int j = 0; j < 4; ++j) { const float a = bflo(zcu[j]), b2 = bfhi(zcu[j]), pa = bflo(zpu[j]), pb = bfhi(zpu[j]);
                    const float mm0 = (j < 2) ? m0[2 * j] : m1[2 * j - 4], mm1 = (j < 2) ? m0[2 * j + 1] : m1[2 * j - 3];
                    v[2 * j] = a + (pa - a) * mm0; v[2 * j + 1] = b2 + (pb - b2) * mm1; }
                if (c8 < 64) {
#pragma unroll
                    for (int j = 0; j < 8; ++j) v[j] = tanhf(v[j]); }
                else if (c8 >= 128) {
#pragma unroll
                    for (int j = 0; j < 8; ++j) v[j] = sigm(v[j]); }
                u32x4 w; w.x = cvt_pk_bf16(v[0], v[1]); w.y = cvt_pk_bf16(v[2], v[3]); w.z = cvt_pk_bf16(v[4], v[5]); w.w = cvt_pk_bf16(v[6], v[7]);
                *(u32x4*)(At + tok * LDA + c8) = w; }
            __syncthreads();
            const int h = wave;
            bf16x8 Bc[9], Bn[9];
            { const int n = h * 64 + fr;
#pragma unroll
              for (int ks = 0; ks < 2; ++ks) { Bc[ks] = *(const bf16x8*)(F.wd + n * 64 + ks * 32 + fq * 8); Bc[2 + ks] = *(const bf16x8*)(F.wi + n * 64 + ks * 32 + fq * 8); }
#pragma unroll
              for (int ks = 0; ks < 5; ++ks) Bc[4 + ks] = *(const bf16x8*)(F.wg + n * 160 + ks * 32 + fq * 8); }
#pragma unroll 1
            for (int j = 0; j < 4; ++j) { const int n = h * 64 + j * 16 + fr;
                if (j < 3) { const int nn = n + 16;
#pragma unroll
                    for (int ks = 0; ks < 2; ++ks) { Bn[ks] = *(const bf16x8*)(F.wd + nn * 64 + ks * 32 + fq * 8); Bn[2 + ks] = *(const bf16x8*)(F.wi + nn * 64 + ks * 32 + fq * 8); }
#pragma unroll
                    for (int ks = 0; ks < 5; ++ks) Bn[4 + ks] = *(const bf16x8*)(F.wg + nn * 160 + ks * 32 + fq * 8); }
                const float db = dbias[n], ib = ibias[n];
#pragma unroll
                for (int mt = 0; mt < 2; ++mt) {
                    f32x4 ad = {0.f, 0.f, 0.f, 0.f}, ai = ad, ag = ad; const bf16_t* ap = At + (mt * 16 + fr) * LDA + fq * 8;
#pragma unroll
                    for (int ks = 0; ks < 2; ++ks) ad = __builtin_amdgcn_mfma_f32_16x16x32_bf16(*(const bf16x8*)(ap + ks * 32), Bc[ks], ad, 0, 0, 0);
#pragma unroll
                    for (int ks = 0; ks < 2; ++ks) ai = __builtin_amdgcn_mfma_f32_16x16x32_bf16(*(const bf16x8*)(ap + 64 + ks * 32), Bc[2 + ks], ai, 0, 0, 0);
#pragma unroll
                    for (int ks = 0; ks < 5; ++ks) ag = __builtin_amdgcn_mfma_f32_16x16x32_bf16(*(const bf16x8*)(ap + 128 + ks * 32), Bc[4 + ks], ag, 0, 0, 0);
#pragma unroll
                    for (int jj = 0; jj < 4; ++jj) {
                        const float dw = db + ad[jj]; const float wlog = -softplus_f(-dw) - 0.5f; const float lwv = -__expf(wlog);
                        const int tk = mt * 16 + fq * 4 + jj; Ot[tk * 520 + n] = f2bf(lwv); Ot[(TT + tk) * 520 + n] = f2bf(sigm(ib + ai[jj])); Ot[(2 * TT + tk) * 520 + n] = f2bf(ag[jj]); }
                }
#pragma unroll
                for (int q = 0; q < 9; ++q) Bc[q] = Bn[q];
            }
            __syncthreads();
#pragma unroll
            for (int i = 0; i < 12; ++i) { const int idx = tid + i * NTHR, arr = idx >> 11, rem = idx & 2047, tk = rem >> 6, c8 = (rem & 63) * 8;
                const u32x4 w = *(const u32x4*)(Ot + (arr * TT + tk) * 520 + c8); bf16_t* dst = arr == 0 ? F.lw : (arr == 1 ? F.ic : F.gt);
                *(u32x4*)(dst + (size_t)(t0 + tk) * 512 + c8) = w; }
            __syncthreads();
        }
    }
    if (mode != 2) {
        unsigned short* tl = (unsigned short*)g_lds;
        for (int tile = blockIdx.x; tile < NTOK / 64; tile += gridDim.x) { const int t0 = tile * 64, b = t0 / SEQ, tt0 = t0 % SEQ;
#pragma unroll
            for (int i = 0; i < 8; ++i) { const int idx = tid + i * NTHR, tok = idx >> 6, d = idx & 63; tl[tok * 66 + d] = z[(size_t)(t0 + tok) * ZLD + C_VA + d]; }
            __syncthreads();
#pragma unroll
            for (int i = 0; i < 8; ++i) { const int idx = tid + i * NTHR, d = idx >> 6, tok = idx & 63; F.vt[((size_t)b * 64 + d) * SEQ + tt0 + tok] = tl[tok * 66 + d]; }
            __syncthreads();
        }
    }
    if (mode != 0) {
        const int gtid = blockIdx.x * NTHR + tid, gn = gridDim.x * NTHR;
        for (int idx = gtid; idx < NTOK * 144; idx += gn) { const int t = idx / 144, p = idx - t * 144, hd = p >> 3, i4 = (p & 7) * 4;
            const int base = hd < 8 ? C_Q + hd * 64 : (hd == 8 ? C_KA : (hd < 17 ? C_QI + (hd - 9) * 64 : C_KI));
            f32x4 cs0 = *(const f32x4*)(&F.rope[(t & (SEQ - 1)) * 32 + i4]), cs1 = *(const f32x4*)(&F.rope[(t & (SEQ - 1)) * 32 + i4 + 2]);
            if (mode == 2) { cs0 = (f32x4){1.f, 0.f, 1.f, 0.f}; cs1 = cs0; }
            bf16_t* p1 = z + (size_t)t * ZLD + base + i4; const uint2 a = *(const uint2*)(p1), b2 = *(const uint2*)(p1 + 32);
            const float x10 = bflo(a.x), x11 = bfhi(a.x), x12 = bflo(a.y), x13 = bfhi(a.y), x20 = bflo(b2.x), x21 = bfhi(b2.x), x22 = bflo(b2.y), x23 = bfhi(b2.y);
            uint2 o1, o2;
            o1.x = cvt_pk_bf16(x10 * cs0[0] - x20 * cs0[1], x11 * cs0[2] - x21 * cs0[3]); o1.y = cvt_pk_bf16(x12 * cs1[0] - x22 * cs1[1], x13 * cs1[2] - x23 * cs1[3]);
            o2.x = cvt_pk_bf16(x20 * cs0[0] + x10 * cs0[1], x21 * cs0[2] + x11 * cs0[3]); o2.y = cvt_pk_bf16(x22 * cs1[0] + x12 * cs1[1], x23 * cs1[2] + x13 * cs1[3]);
            *(uint2*)(p1) = o1; *(uint2*)(p1 + 32) = o2; }
    }
}

struct ScanRaw { uint2 zr_c, zr_p, zk_c, zk_p, zv_c, zv_p, lwu, icu; };
struct ScanConst { f32x4 mur, muk, muv, kk, ka, rk; };
__device__ __forceinline__ void scan_load(ScanRaw& R, const bf16_t* z, const bf16_t* lw, const bf16_t* ic, size_t tokbase, int ch, int ptok, int gc) {
    const int t = ch * 16 + ptok; const size_t T = tokbase + t; const bf16_t* zp = z + T * ZLD + gc;
    R.zr_c = *(const uint2*)(zp + C_R); R.zk_c = *(const uint2*)(zp + C_K); R.zv_c = *(const uint2*)(zp + C_V);
    const uint2 zz = make_uint2(0u, 0u);
    if (t > 0) { R.zr_p = *(const uint2*)(zp - ZLD + C_R); R.zk_p = *(const uint2*)(zp - ZLD + C_K); R.zv_p = *(const uint2*)(zp - ZLD + C_V); } else { R.zr_p = zz; R.zk_p = zz; R.zv_p = zz; }
    R.lwu = *(const uint2*)(lw + T * 512 + gc); R.icu = *(const uint2*)(ic + T * 512 + gc);
}
__device__ __forceinline__ f32x4 unpack4(uint2 u) { f32x4 r; r[0] = bflo(u.x); r[1] = bfhi(u.x); r[2] = bflo(u.y); r[3] = bfhi(u.y); return r; }
__device__ __forceinline__ void scan_prep(const ScanRaw& R, const ScanConst& C, float* ops, float* vv, float* bonus_out, bool wr_bonus, int ptok, int pc, int v0) {
    const f32x4 rc = unpack4(R.zr_c), rp = unpack4(R.zr_p), kc = unpack4(R.zk_c), kp = unpack4(R.zk_p), vc = unpack4(R.zv_c), vp = unpack4(R.zv_p), ic = unpack4(R.icu), lw = unpack4(R.lwu);
    const f32x4 r = rc + (rp - rc) * C.mur, k = kc + (kp - kc) * C.muk, vs = vc + (vp - vc) * C.muv;
    f32x4 w; w[0] = __expf(lw[0]); w[1] = __expf(lw[1]); w[2] = __expf(lw[2]); w[3] = __expf(lw[3]);
    const f32x4 q = k * C.kk; const float ss = red16((q[0] * q[0] + q[1] * q[1]) + (q[2] * q[2] + q[3] * q[3]));
    const float inv = 1.0f / fmaxf(sqrtf(ss), 1e-12f); const f32x4 n = q * inv;
    const f32x4 kn = k * (1.0f + (ic - 1.0f) * C.ka);
    const f32x4 bt = r * kn * C.rk; const float bon = red16((bt[0] + bt[1]) + (bt[2] + bt[3]));
    if (wr_bonus) *bonus_out = bon;
    float* op = ops + ptok * 320 + pc;
    *(f32x4*)(op) = -n; *(f32x4*)(op + 64) = w; *(f32x4*)(op + 128) = n * ic; *(f32x4*)(op + 192) = kn; *(f32x4*)(op + 256) = r;
    if (pc >= v0 && pc < v0 + 32) *(f32x4*)(vv + ptok * 32 + pc - v0) = vs;
}
__device__ __forceinline__ void p3_scan(const Frame& F, const int mode) {
    const int tid = F.tid;
    float* opsb = (float*)g_lds;
    float* vvb = opsb + 2 * 5120;
    float* yob = vvb + 2 * 512;
    const bf16_t* z = F.z; const float* mu = F.in[3]; const float* k_k = F.in[9]; const float* k_a = F.in[10]; const float* r_k = F.in[11];
    for (int item = blockIdx.x; item < 256; item += gridDim.x) {
        const int bh = item >> 1, half = item & 1, b = bh >> 3, h = bh & 7, v0 = half * 32;
        const size_t tokbase = (size_t)b * SEQ;
        if (F.wave >= 4) {
            const int pt = tid - 256, ptok = pt >> 4, pc = (pt & 15) * 4, gc = h * 64 + pc;
            ScanConst C; C.mur = *(const f32x4*)(mu + C_R + gc); C.muk = *(const f32x4*)(mu + C_K + gc); C.muv = *(const f32x4*)(mu + C_V + gc);
            C.kk = *(const f32x4*)(k_k + gc); C.ka = *(const f32x4*)(k_a + gc); C.rk = *(const f32x4*)(r_k + gc);
            const bool wrb = (half == 0) && ((pt & 15) == 0);
            ScanRaw R;
            scan_load(R, z, F.lw, F.ic, tokbase, 0, ptok, gc);
            scan_prep(R, C, opsb, vvb, F.bonus + (tokbase + ptok) * 8 + h, wrb, ptok, pc, v0);
            scan_load(R, z, F.lw, F.ic, tokbase, 1, ptok, gc);
            lds_barrier();
            for (int ch = 0; ch < SEQ / 16; ++ch) {
                const int cur = ch & 1, nxt = cur ^ 1;
                if (mode != 2) {
                if (ch > 0) { const int tok = pt >> 4, r2 = (pt & 15) * 2;
                    *(float2*)(F.yraw + (tokbase + (ch - 1) * 16 + tok) * 512 + h * 64 + v0 + r2) = *(const float2*)(yob + nxt * 512 + tok * 32 + r2); }
                if (ch + 1 < SEQ / 16) {
                    scan_prep(R, C, opsb + nxt * 5120, vvb + nxt * 512, F.bonus + (tokbase + (ch + 1) * 16 + ptok) * 8 + h, wrb, ptok, pc, v0);
                    if (ch + 2 < SEQ / 16) scan_load(R, z, F.lw, F.ic, tokbase, ch + 2, ptok, gc);
                } }
                lds_barrier();
            }
            { const int tok = pt >> 4, r2 = (pt & 15) * 2;
              *(float2*)(F.yraw + (tokbase + (SEQ / 16 - 1) * 16 + tok) * 512 + h * 64 + v0 + r2) = *(const float2*)(yob + 512 + tok * 32 + r2); }
        } else {
            const int rp = tid >> 4, ks = tid & 15;
            float A0 = 0.f, A1 = 0.f, A2 = 0.f, A3 = 0.f, B0 = 0.f, B1 = 0.f, B2 = 0.f, B3 = 0.f;
            const int ywoff = (ks == 0) ? 2 * rp : (2 * 512 + 2 * tid), ywstep = (ks == 0) ? 32 : 0;
            lds_barrier();
            f32x4 rprev = {0.f, 0.f, 0.f, 0.f}; float* ywp = yob + 2 * 512 + 2 * tid;
            for (int ch = 0; ch < SEQ / 16; ++ch) {
                const int cur = ch & 1;
                const float* ops = opsb + cur * 5120 + ks * 4; const float* vv = vvb + cur * 512 + 2 * rp; float* yw = yob + cur * 512 + ywoff;
                if (mode != 1) {
#pragma unroll
                for (int s = 0; s < 16; ++s) {
                    const float* o = ops + s * 320;
                    const f32x4 a4 = *(const f32x4*)(o), w4 = *(const f32x4*)(o + 64), b4 = *(const f32x4*)(o + 128), k4 = *(const f32x4*)(o + 192), r4 = *(const f32x4*)(o + 256);
                    const float2 vab = *(const float2*)(vv + s * 32);
                    float sa = (A0 * a4[0] + A1 * a4[1]) + (A2 * a4[2] + A3 * a4[3]); float sb = (B0 * a4[0] + B1 * a4[1]) + (B2 * a4[2] + B3 * a4[3]);
                    float ya = (A0 * rprev[0] + A1 * rprev[1]) + (A2 * rprev[2] + A3 * rprev[3]); float yb2 = (B0 * rprev[0] + B1 * rprev[1]) + (B2 * rprev[2] + B3 * rprev[3]);
                    red16x4(sa, sb, ya, yb2);
                    *(float2*)(ywp) = make_float2(ya, yb2);
                    ywp = yw + s * ywstep;
                    A0 = A0 * w4[0] + sa * b4[0] + vab.x * k4[0]; A1 = A1 * w4[1] + sa * b4[1] + vab.x * k4[1];
                    A2 = A2 * w4[2] + sa * b4[2] + vab.x * k4[2]; A3 = A3 * w4[3] + sa * b4[3] + vab.x * k4[3];
                    B0 = B0 * w4[0] + sb * b4[0] + vab.y * k4[0]; B1 = B1 * w4[1] + sb * b4[1] + vab.y * k4[1];
                    B2 = B2 * w4[2] + sb * b4[2] + vab.y * k4[2]; B3 = B3 * w4[3] + sb * b4[3] + vab.y * k4[3];
                    rprev = r4;
                }
                {
                    float ya = (A0 * rprev[0] + A1 * rprev[1]) + (A2 * rprev[2] + A3 * rprev[3]); float yb2 = (B0 * rprev[0] + B1 * rprev[1]) + (B2 * rprev[2] + B3 * rprev[3]);
                    float d0 = 0.f, d1 = 0.f; red16x4(ya, yb2, d0, d1);
                    *(float2*)(ywp) = make_float2(ya, yb2); ywp = yob + 2 * 512 + 2 * tid; rprev = (f32x4){0.f, 0.f, 0.f, 0.f};
                } }
                lds_barrier();
            }
        }
        __syncthreads();
    }
}

__device__ __forceinline__ unsigned ordkey(float f) { const unsigned u = __float_as_uint(f); return (u & 0x80000000u) ? ~u : (u | 0x80000000u); }

__device__ __forceinline__ void attn_chunk(const unsigned char* kb, const unsigned char* vb, const unsigned* selm, int c, int p, int fr, int fq, const bf16x8 (&Bqa)[2][2], f32x4 (&O)[2][4], f32x4 (&RS)[2]) {
    const f32x4 zero4 = {0.f, 0.f, 0.f, 0.f};
    const u32x4 onesu = {0x3f803f80u, 0x3f803f80u, 0x3f803f80u, 0x3f803f80u}; const bf16x8 ones = __builtin_bit_cast(bf16x8, onesu);
    const float csc = 0.125f * 1.4426950408889634f;
    const unsigned char* k0p = kb + ((2 * p) * 16 + fr) * 144 + fq * 16; const unsigned char* k1p = k0p + 16 * 144;
    const bf16x8 KA00 = *(const bf16x8*)(k0p), KA01 = *(const bf16x8*)(k0p + 64), KA10 = *(const bf16x8*)(k1p), KA11 = *(const bf16x8*)(k1p + 64);
    const int mw = (int)selm[fr * 64 + 2 * c + p];
    bf16x8 VA[4];
#pragma unroll
    for (int dt = 0; dt < 4; ++dt) { const unsigned char* vp = vb + (dt * 16 + fr) * 144 + (2 * p) * 32 + fq * 8;
        const uint2 lo = *(const uint2*)(vp), hi = *(const uint2*)(vp + 32);
        u32x4 va; va.x = lo.x; va.y = lo.y; va.z = hi.x; va.w = hi.y; VA[dt] = __builtin_bit_cast(bf16x8, va); }
    unsigned km0[4], km1[4];
#pragma unroll
    for (int jj = 0; jj < 4; ++jj) { km0[jj] = (unsigned)__builtin_amdgcn_sbfe(mw, fq * 4 + jj, 1); km1[jj] = (unsigned)__builtin_amdgcn_sbfe(mw, 16 + fq * 4 + jj, 1); }
#pragma unroll
    for (int hh = 0; hh < 2; ++hh) {
        f32x4 s0 = __builtin_amdgcn_mfma_f32_16x16x32_bf16(KA00, Bqa[hh][0], zero4, 0, 0, 0); s0 = __builtin_amdgcn_mfma_f32_16x16x32_bf16(KA01, Bqa[hh][1], s0, 0, 0, 0);
        f32x4 s1 = __builtin_amdgcn_mfma_f32_16x16x32_bf16(KA10, Bqa[hh][0], zero4, 0, 0, 0); s1 = __builtin_amdgcn_mfma_f32_16x16x32_bf16(KA11, Bqa[hh][1], s1, 0, 0, 0);
        unsigned p0[4], p1[4];
#pragma unroll
        for (int jj = 0; jj < 4; ++jj) {
            p0[jj] = __float_as_uint(__builtin_amdgcn_exp2f(fminf(s0[jj] * csc, 86.f))) & km0[jj]; p1[jj] = __float_as_uint(__builtin_amdgcn_exp2f(fminf(s1[jj] * csc, 86.f))) & km1[jj]; }
        u32x4 pk; pk.x = cvt_pk_bf16(__uint_as_float(p0[0]), __uint_as_float(p0[1])); pk.y = cvt_pk_bf16(__uint_as_float(p0[2]), __uint_as_float(p0[3]));
        pk.z = cvt_pk_bf16(__uint_as_float(p1[0]), __uint_as_float(p1[1])); pk.w = cvt_pk_bf16(__uint_as_float(p1[2]), __uint_as_float(p1[3]));
        const bf16x8 PB = __builtin_bit_cast(bf16x8, pk);
        RS[hh] = __builtin_amdgcn_mfma_f32_16x16x32_bf16(ones, PB, RS[hh], 0, 0, 0);
#pragma unroll
        for (int dt = 0; dt < 4; ++dt) O[hh][dt] = __builtin_amdgcn_mfma_f32_16x16x32_bf16(VA[dt], PB, O[hh][dt], 0, 0, 0);
    }
}

__device__ __forceinline__ void p3_dsa(const Frame& F) {
    const int tid = F.tid, lane = F.lane, wave = F.wave, fr = lane & 15, fq = lane >> 4;
    unsigned* scl = (unsigned*)g_lds;
    unsigned* selm = (unsigned*)(g_lds + 131328);
    unsigned char* kbuf = (unsigned char*)g_lds;
    unsigned char* vbuf = kbuf + 2 * 9216;
    const bf16_t* z = F.z; const int G = gridDim.x, bx = blockIdx.x;
    const f32x4 zero4 = {0.f, 0.f, 0.f, 0.f};
    for (int rnd = 0; rnd * G < 2048; ++rnd) {
        const int n = rnd * G + ((rnd & 1) ? (G - 1 - bx) : bx);
        if (n >= 2048) continue;
        const int qg = 127 - (n >> 4), b = n & 15, q0 = qg * 16; const size_t Tb = (size_t)b * SEQ;
        for (int i = tid; i < 1024; i += NTHR) selm[i] = 0u;
        __syncthreads();
        const bf16_t* zq = z + (Tb + q0 + fr) * ZLD;
        const unsigned lofk = (unsigned)((fr * ZLD + fq * 8) * 2), lofv = (unsigned)((fr * SEQ + fq * 4) * 2);
        const int nchunk = (qg + 4) >> 2; const int lrow = tid >> 3, lseg = tid & 7;
        const bf16_t* kg = z + (Tb + lrow) * ZLD + C_KA + lseg * 8; const bf16_t* vg = F.vt + ((size_t)b * 64 + lrow) * SEQ + lseg * 8;
        const unsigned lst = (unsigned)(lrow * 144 + lseg * 16);
        const int hp = wave >> 1, kh = wave & 1;
        const u32x4 kc0 = *(const u32x4*)(kg), vc0 = *(const u32x4*)(vg);
        u32x4 kx = kc0, vx = vc0, ky = kc0, vy = vc0;
        if (1 < nchunk) { kx = *(const u32x4*)(kg + (size_t)64 * ZLD); vx = *(const u32x4*)(vg + 64); }
        if (2 < nchunk) { ky = *(const u32x4*)(kg + (size_t)128 * ZLD); vy = *(const u32x4*)(vg + 128); }
        bf16x8 Bqa[2][2];
#pragma unroll
        for (int hh = 0; hh < 2; ++hh)
#pragma unroll
            for (int ks = 0; ks < 2; ++ks) Bqa[hh][ks] = *(const bf16x8*)(zq + C_Q + (2 * hp + hh) * 64 + ks * 32 + fq * 8);
        if (qg >= 16) {
            const u32x4 wv = *(const u32x4*)(zq + C_WI);
            {
                bf16x8 Bq[8][2];
#pragma unroll
                for (int hh = 0; hh < 8; ++hh)
#pragma unroll
                    for (int ks = 0; ks < 2; ++ks) Bq[hh][ks] = *(const bf16x8*)(zq + C_QI + hh * 64 + ks * 32 + fq * 8);
                const float sc = 0.044194173824159216f;
                float wih[8]; wih[0] = bflo(wv.x) * sc; wih[1] = bfhi(wv.x) * sc; wih[2] = bflo(wv.y) * sc; wih[3] = bfhi(wv.y) * sc; wih[4] = bflo(wv.z) * sc; wih[5] = bfhi(wv.z) * sc; wih[6] = bflo(wv.w) * sc; wih[7] = bfhi(wv.w) * sc;
#pragma unroll 1
                for (int half = 0; half < 2; ++half) {
                    const int ktb = wave + 64 * half; if (ktb > qg) break;
                    bf16x8 W0[2], W1[2];
#pragma unroll
                    for (int j = 0; j < 2; ++j) { const int ktj = (ktb + 8 * j) < qg ? (ktb + 8 * j) : qg; const char* kb = (const char*)(z + (Tb + (size_t)ktj * 16) * ZLD + C_KI);
                        W0[j] = *(const bf16x8*)(kb + lofk); W1[j] = *(const bf16x8*)(kb + lofk + 64); }
#pragma unroll
                    for (int i = 0; i < 8; ++i) { const int kt = ktb + 8 * i;
                        if (kt <= qg) { f32x4 sv = zero4;
#pragma unroll
                            for (int hh = 0; hh < 8; ++hh) { f32x4 acc = __builtin_amdgcn_mfma_f32_16x16x32_bf16(W0[i & 1], Bq[hh][0], zero4, 0, 0, 0);
                                acc = __builtin_amdgcn_mfma_f32_16x16x32_bf16(W1[i & 1], Bq[hh][1], acc, 0, 0, 0);
#pragma unroll
                                for (int jj = 0; jj < 4; ++jj) sv[jj] += wih[hh] * fmaxf(acc[jj], 0.f); }
                            u32x4 w; w.x = ordkey(sv[0]); w.y = ordkey(sv[1]); w.z = ordkey(sv[2]); w.w = ordkey(sv[3]);
                            *(u32x4*)(scl + fr * 2052 + kt * 16 + fq * 4) = w;
                        }
                        if (i + 2 < 8) { const int ktn = (kt + 16) < qg ? (kt + 16) : qg; const char* kb = (const char*)(z + (Tb + (size_t)ktn * 16) * ZLD + C_KI);
                            unsigned lo2 = lofk; asm volatile("" : "+v"(lo2));
                            W0[i & 1] = *(const bf16x8*)(kb + lo2); W1[i & 1] = *(const bf16x8*)(kb + lo2 + 64); }
                    }
                }
            }
            __syncthreads();
#pragma unroll 1
            for (int qq = 0; qq < 2; ++qq) {
                const int q = 2 * wave + qq, qpos = q0 + q;
                unsigned uk[32];
#pragma unroll
                for (int r = 0; r < 32; ++r) { const int key = r * 64 + lane; uk[r] = 0x007fffffu;
                    if (r * 64 <= qpos) { const unsigned v = scl[q * 2052 + key]; uk[r] = (key <= qpos) ? v : 0x007fffffu; } }
                unsigned T = 0u; bool exact = false;
#pragma unroll 1
                for (int bit = 31; bit >= 0; --bit) {
                    const unsigned cand = T | (1u << bit); int c = 0;
#pragma unroll
                    for (int g = 0; g < 4; ++g) {
                        unsigned long long m[8];
                        asm("v_cmp_ge_u32_e64 %0, %8, %16\n\tv_cmp_ge_u32_e64 %1, %9, %16\n\tv_cmp_ge_u32_e64 %2, %10, %16\n\tv_cmp_ge_u32_e64 %3, %11, %16\n\t"
                            "v_cmp_ge_u32_e64 %4, %12, %16\n\tv_cmp_ge_u32_e64 %5, %13, %16\n\tv_cmp_ge_u32_e64 %6, %14, %16\n\tv_cmp_ge_u32_e64 %7, %15, %16"
                            : "=&s"(m[0]), "=&s"(m[1]), "=&s"(m[2]), "=&s"(m[3]), "=&s"(m[4]), "=&s"(m[5]), "=&s"(m[6]), "=&s"(m[7])
                            : "v"(uk[g * 8 + 0]), "v"(uk[g * 8 + 1]), "v"(uk[g * 8 + 2]), "v"(uk[g * 8 + 3]), "v"(uk[g * 8 + 4]), "v"(uk[g * 8 + 5]), "v"(uk[g * 8 + 6]), "v"(uk[g * 8 + 7]), "v"(cand));
#pragma unroll
                        for (int j = 0; j < 8; ++j) c += __builtin_popcountll(m[j]);
                    }
                    if (c >= 256) { T = cand; if (c == 256) { exact = true; break; } }
                }
                int need = 0;
                if (!exact) { int c = 0;
#pragma unroll
                    for (int r = 0; r < 32; ++r) c += __builtin_popcountll(__builtin_amdgcn_ballot_w64(uk[r] > T));
                    need = 256 - c; }
#pragma unroll
                for (int r = 0; r < 32; ++r) {
                    if (r * 64 <= qpos) {
                        unsigned long long sel;
                        if (exact) sel = __builtin_amdgcn_ballot_w64(uk[r] >= T);
                        else { sel = __builtin_amdgcn_ballot_w64(uk[r] > T); unsigned long long e = __builtin_amdgcn_ballot_w64(uk[r] == T);
                            const int ne = __builtin_popcountll(e);
                            if (ne <= need) { sel |= e; need -= ne; }
                            else { for (int k = 0; k < need; ++k) { const unsigned long long lb = e & (0ull - e); sel |= lb; e ^= lb; } need = 0; } }
                        if (lane == 0) { selm[q * 64 + 2 * r] = (unsigned)sel; selm[q * 64 + 2 * r + 1] = (unsigned)(sel >> 32); }
                    }
                }
            }
        } else {
            for (int w = tid; w < 1024; w += NTHR) { const int q = w >> 6, word = w & 63, qpos = q0 + q, lo = word * 32;
                selm[w] = (qpos >= lo + 31) ? 0xffffffffu : (qpos < lo ? 0u : ((2u << (qpos - lo)) - 1u)); }
        }
        __syncthreads();
        {
            *(u32x4*)(kbuf + lst) = kc0; *(u32x4*)(vbuf + lst) = vc0;
            f32x4 O[2][4]; f32x4 rs[2];
#pragma unroll
            for (int hh = 0; hh < 2; ++hh) { rs[hh] = zero4;
#pragma unroll
                for (int dt = 0; dt < 4; ++dt) O[hh][dt] = zero4; }
            lds_barrier();
#pragma unroll 1
            for (int c = 0; c < nchunk; c += 2) {
                attn_chunk(kbuf, vbuf, selm, c, kh, fr, fq, Bqa, O, rs);
                if (c + 1 < nchunk) { *(u32x4*)(kbuf + 9216 + lst) = kx; *(u32x4*)(vbuf + 9216 + lst) = vx; }
                if (c + 3 < nchunk) { kx = *(const u32x4*)(kg + (size_t)(c + 3) * 64 * ZLD); vx = *(const u32x4*)(vg + (c + 3) * 64); }
                lds_barrier();
                if (c + 1 < nchunk) {
                    attn_chunk(kbuf + 9216, vbuf + 9216, selm, c + 1, kh, fr, fq, Bqa, O, rs);
                    if (c + 2 < nchunk) { *(u32x4*)(kbuf + lst) = ky; *(u32x4*)(vbuf + lst) = vy; }
                    if (c + 4 < nchunk) { ky = *(const u32x4*)(kg + (size_t)(c + 4) * 64 * ZLD); vy = *(const u32x4*)(vg + (c + 4) * 64); }
                    lds_barrier();
                }
            }
            float* xb = (float*)(vbuf + 2 * 9216) + (size_t)wave * (64 * 17);
            { const int oh = kh ^ 1;
#pragma unroll
              for (int dt = 0; dt < 4; ++dt)
#pragma unroll
                  for (int jj = 0; jj < 4; ++jj) xb[(dt * 4 + jj) * 64 + lane] = (oh == 0) ? O[0][dt][jj] : O[1][dt][jj];
              xb[16 * 64 + lane] = (oh == 0) ? rs[0][0] : rs[1][0]; }
            lds_barrier();
            { const float* pb = (const float*)(vbuf + 2 * 9216) + (size_t)(wave ^ 1) * (64 * 17);
              float tot = ((kh == 0) ? rs[0][0] : rs[1][0]) + pb[16 * 64 + lane];
              const float inv = 1.0f / tot;
              bf16_t* yp = F.yb + (Tb + q0 + fr) * 512 + (2 * hp + kh) * 64 + fq * 4;
#pragma unroll
              for (int dt = 0; dt < 4; ++dt) { float o[4];
#pragma unroll
                  for (int jj = 0; jj < 4; ++jj) o[jj] = (((kh == 0) ? O[0][dt][jj] : O[1][dt][jj]) + pb[(dt * 4 + jj) * 64 + lane]) * inv;
                  uint2 w; w.x = cvt_pk_bf16(o[0], o[1]); w.y = cvt_pk_bf16(o[2], o[3]); *(uint2*)(yp + dt * 16) = w; } }
        }
        __syncthreads();
    }
}

__device__ __forceinline__ void p4_post(const Frame& F) {
    const int tid = F.tid; const float* mu = F.in[3]; const float* gnw = F.in[12]; const float* gnb = F.in[13]; const bf16_t* z = F.z;
    for (int g = blockIdx.x * 16 + (tid >> 5); g < NTOK * 8; g += gridDim.x * 16) { const size_t t = (size_t)(g >> 3); const int h = g & 7, c = h * 64 + (tid & 31) * 2;
        const float2 y = *(const float2*)(F.yraw + t * 512 + c);
        const float mean = red32(y.x + y.y) * (1.0f / 64.0f); const float dx = y.x - mean, dy = y.y - mean;
        const float var = red32(dx * dx + dy * dy) * (1.0f / 64.0f); const float rstd = rsqrtf(var + 64e-5f);
        const unsigned vc = *(const unsigned*)(z + t * ZLD + C_V + c); const unsigned vp = (t & (SEQ - 1)) ? *(const unsigned*)(z + (t - 1) * ZLD + C_V + c) : 0u;
        const float vs0 = bflo(vc) + (bflo(vp) - bflo(vc)) * mu[C_V + c], vs1 = bfhi(vc) + (bfhi(vp) - bfhi(vc)) * mu[C_V + c + 1];
        const float bon = F.bonus[t * 8 + h]; const unsigned gt = *(const unsigned*)(F.gt + t * 512 + c);
        const float o0 = (dx * rstd * gnw[c] + gnb[c] + bon * vs0) * bflo(gt), o1 = (dy * rstd * gnw[c + 1] + gnb[c + 1] + bon * vs1) * bfhi(gt);
        *(unsigned*)(F.ya + t * 512 + c) = cvt_pk_bf16(o0, o1); }
}

__device__ __forceinline__ void p9_final(const Frame& F, const bool ident) {
    const float* g = F.in[19]; const int lane = F.lane;
    for (int row = blockIdx.x * 8 + F.wave; row < NTOK; row += gridDim.x * 8) {
        float* xr = F.out + (size_t)row * DM; const float sc = ident ? 1.0f : rsqrtf(F.ss2[row] * (1.0f / 1024.0f) + 1e-6f);
#pragma unroll
        for (int i = 0; i < 4; ++i) { f32x4 v = *(const f32x4*)(xr + i * 256 + lane * 4); const f32x4 gg = *(const f32x4*)(g + i * 256 + lane * 4);
            if (!ident) { v[0] *= sc * gg[0]; v[1] *= sc * gg[1]; v[2] *= sc * gg[2]; v[3] *= sc * gg[3]; } *(f32x4*)(xr + i * 256 + lane * 4) = v; }
    }
}
#define XB_TMO      128
#define XB_XCNT(j)  (256  + 64 * (j))
#define XB_XSUB(j)  (1280 + 64 * (j))
#define XB_XGEN(j)  (2304 + 64 * (j))
#define XB_TOP      3328
#define XB_TOPGEN   3392
#define XCD_BAR_WORDS 3456
#define XB_SPIN_CAP (1u << 18)
#define LAS __attribute__((address_space(3)))

__device__ __forceinline__ unsigned xb_ld(unsigned* p)              { return __hip_atomic_load(p, __ATOMIC_RELAXED, __HIP_MEMORY_SCOPE_AGENT); }
__device__ __forceinline__ unsigned xb_add(unsigned* p, unsigned v) { return __hip_atomic_fetch_add(p, v, __ATOMIC_RELAXED, __HIP_MEMORY_SCOPE_AGENT); }
__device__ __forceinline__ unsigned xb_xcc_id() { return (unsigned)__builtin_amdgcn_s_getreg((3 << 11) | 20) & 0xFu; }
#define XB_SPIN(cond, bar) do { unsigned _sp = 0; while (cond) { __builtin_amdgcn_s_sleep(1); \
    if ((++_sp & 255u) == 0u) { if (xb_ld(&(bar)[XB_TMO])) break; if (_sp > XB_SPIN_CAP) { atomicAdd(&(bar)[XB_TMO], 1u); break; } } } } while (0)

struct XcdBarrier {
    unsigned* bar; unsigned x;
    volatile LAS unsigned* st;
};

__device__ __forceinline__ XcdBarrier xcd_barrier_post(unsigned* bar, volatile LAS unsigned* st) {
    XcdBarrier b; b.bar = bar; b.x = xb_xcc_id(); b.st = st;
    if (threadIdx.x == 0) (void)xb_add(&bar[XB_XCNT(b.x)], 1u);
    return b;
}
__device__ __forceinline__ void xcd_barrier_complete(unsigned* bar, unsigned x, unsigned& nloc, unsigned& nx) {
    const unsigned G = gridDim.x * gridDim.y * gridDim.z;
    unsigned sum, cnt, mine, sp = 0u;
    for (;;) {
        sum = 0u; cnt = 0u; mine = 0u;
#pragma unroll
        for (unsigned j = 0; j < 16; ++j) { const unsigned c = xb_ld(&bar[XB_XCNT(j)]); sum += c; cnt += (c > 0u) ? 1u : 0u; mine = (j == x) ? c : mine; }
        if (sum == G) break;
        __builtin_amdgcn_s_sleep(1);
        if ((++sp & 255u) == 0u) { if (xb_ld(&bar[XB_TMO])) break; if (sp > XB_SPIN_CAP) { atomicAdd(&bar[XB_TMO], 1u); break; } }
    }
    nloc = mine > 0u ? mine : 1u; nx = cnt > 0u ? cnt : 1u;
}

__device__ __forceinline__ void xcd_barrier(const XcdBarrier& b) {
    asm volatile("s_waitcnt vmcnt(0)" ::: "memory");
    __syncthreads();
    if (threadIdx.x == 0) {
        unsigned* bar = b.bar;
        __builtin_amdgcn_s_waitcnt(0);
        unsigned nloc = b.st[0], nx = b.st[1];
        if (nloc == 0u) { xcd_barrier_complete(bar, b.x, nloc, nx); b.st[0] = nloc; b.st[1] = nx; }
        const unsigned old = xb_add(&bar[XB_XSUB(b.x)], 1u);
        const unsigned gen = old / nloc;
        if (old + 1u == (gen + 1u) * nloc) {
            __builtin_amdgcn_fence(__ATOMIC_RELEASE, "agent");
            asm volatile("s_waitcnt vmcnt(0)" ::: "memory");
            const unsigned og = xb_add(&bar[XB_TOP], 1u);
            const unsigned tg = og / nx;
            if (og + 1u == (tg + 1u) * nx) xb_add(&bar[XB_TOPGEN], 1u);
            else XB_SPIN(xb_ld(&bar[XB_TOPGEN]) == tg, bar);
            __builtin_amdgcn_fence(__ATOMIC_ACQUIRE, "agent");
            xb_add(&bar[XB_XGEN(b.x)], 1u);
            asm volatile("s_waitcnt vmcnt(0)" ::: "memory");
        } else {
            XB_SPIN(xb_ld(&bar[XB_XGEN(b.x)]) == gen, bar);
            __builtin_amdgcn_fence(__ATOMIC_ACQUIRE, "agent");
            asm volatile("s_waitcnt vmcnt(0)" ::: "memory");
        }
    }
    __syncthreads();
}
#ifndef PHASE_MASK
#define PHASE_MASK 0x3ff
#endif
#ifndef GEMM_ALIGN
#define GEMM_ALIGN true
#endif
#ifndef GEMM_SP2
#define GEMM_SP2 true
#endif
constexpr int NPHASE = 10;
constexpr size_t WS_BAR = 3 * MiB;
template <class Epi> __device__ __forceinline__ void run_gemm(const bf16_t* A, const bf16_t* Bt, int N, int K, const Epi& E) {
    pg8::Gemm g{A, Bt, NTOK, N, K}; pg8::StaticOrder S; S.init(NTOK, N, (int)gridDim.x, (int)blockIdx.x);
    pg8::gemm_phase<Epi, pg8::StaticOrder, GEMM_ALIGN, GEMM_SP2>((PG8_LAS unsigned char*)g_lds, g, S, E);
}
__global__ void __launch_bounds__(NTHR, 2) mega_fwd(Args args) {
    Frame F;
#pragma unroll
    for (int i = 0; i < 20; ++i) F.in[i] = args.in[i];
    F.out = args.out; F.ws = args.ws; F.lds = nullptr; F.tid = threadIdx.x; F.lane = F.tid & 63; F.wave = __builtin_amdgcn_readfirstlane(F.tid >> 6);
    unsigned char* ws = args.ws;
    F.ss1 = (float*)(ws + WS_SS1); F.ss2 = (float*)(ws + WS_SS2); F.bonus = (float*)(ws + WS_BONUS); F.rope = (float2*)(ws + WS_ROPE);
    F.wd = (bf16_t*)(ws + WS_WD); F.wi = (bf16_t*)(ws + WS_WI); F.wg = (bf16_t*)(ws + WS_WG);
    F.win = (bf16_t*)(ws + WS_WIN); F.wup = (bf16_t*)(ws + WS_WUP); F.wdn = (bf16_t*)(ws + WS_WDN); F.wb = (bf16_t*)(ws + WS_WB); F.wo = (bf16_t*)(ws + WS_WO); F.vt = (bf16_t*)(ws + WS_VT);
    F.h = (bf16_t*)(ws + WS_H); F.ya = F.h; F.yb = F.h + (size_t)NTOK * 512; F.xb = F.h;
    F.z = (bf16_t*)(ws + WS_Z); F.hid = F.z;
    F.lw = (bf16_t*)(ws + WS_P); F.ic = F.lw + (size_t)NTOK * 512; F.mg = F.lw;
    F.yraw = args.out; F.gt = (bf16_t*)(args.out + (size_t)NTOK * 512);
    const int lo = args.ph_lo, hi = args.ph_hi;
    cg::grid_group grid = cg::this_grid();
    if (args.ph_lo < 0) grid.sync();
    volatile LAS unsigned* xst = (volatile LAS unsigned*)(g_lds + LDS_BYTES - 64);
    if (threadIdx.x == 0) { xst[0] = 0u; xst[1] = 0u; }
    __syncthreads();
    XcdBarrier xbar = xcd_barrier_post((unsigned*)(ws + WS_BAR), xst);
#define IN(k) (lo <= (k) && (k) < hi)
#define SEAM(k) do { if (IN(k) && IN((k) + 1)) { xcd_barrier(xbar); if (REP(17)) xcd_barrier(xbar); } } while (0)
    if (((PHASE_MASK >> 0) & 1) && IN(0)) { p0_prologue(F); __syncthreads(); if (REP(0)) { p0_prologue(F); __syncthreads(); } } SEAM(0);
    if (((PHASE_MASK >> 1) & 1) && IN(1)) { pg8::EpiZ E{F.z, ZLD}; run_gemm(F.h, F.win, 5120, 1024, E); __syncthreads(); if (REP(1)) { run_gemm(F.h, F.win, 5120, 1024, E); __syncthreads(); } if (REP(18)) { run_gemm(F.h, F.win, 4096, 1024, E); __syncthreads(); } } SEAM(1);
    if (((PHASE_MASK >> 2) & 1) && IN(2)) { if (REP(2)) { p2_prep(F, 0); __syncthreads(); } if (REP(16)) { p2_prep(F, 2); __syncthreads(); } p2_prep(F, 1); __syncthreads(); } SEAM(2);
    if (((PHASE_MASK >> 3) & 1) && IN(3)) { if (REP(14)) { p3_scan(F, 1); __syncthreads(); } if (REP(15)) { p3_scan(F, 2); __syncthreads(); } if (REP(3)) { p3_scan(F, 0); __syncthreads(); } p3_scan(F, 0); __syncthreads(); p3_dsa(F); __syncthreads(); if (REP(10)) { p3_dsa(F); __syncthreads(); } } SEAM(3);
    if (((PHASE_MASK >> 4) & 1) && IN(4)) { p4_post(F); __syncthreads(); if (REP(4)) { p4_post(F); __syncthreads(); } } SEAM(4);
    if (((PHASE_MASK >> 5) & 1) && IN(5)) { pg8::EpiGate<0> E0{F.mg, F.z, ZLD, C_G0}; run_gemm(F.ya, F.wb, 1024, 512, E0); __syncthreads();
                 pg8::EpiGate<1> E1{F.mg, F.z, ZLD, C_G1}; run_gemm(F.yb, F.wb + 1024 * 512, 1024, 512, E1); __syncthreads();
                 if (REP(5)) { run_gemm(F.ya, F.wb, 1024, 512, E0); __syncthreads(); run_gemm(F.yb, F.wb + 1024 * 512, 1024, 512, E1); __syncthreads(); } } SEAM(5);
    if (((PHASE_MASK >> 6) & 1) && IN(6)) { if (REP(6)) { pg8::EpiRes1 Ex{F.in[0], F.xb, F.bonus}; run_gemm(F.mg, F.wo, 1024, 1024, Ex); __syncthreads(); }
                 pg8::EpiRes1 E{F.in[0], F.xb, F.ss1}; run_gemm(F.mg, F.wo, 1024, 1024, E); __syncthreads(); } SEAM(6);
    if (((PHASE_MASK >> 7) & 1) && IN(7)) { pg8::EpiHid E{F.hid, F.ss1}; run_gemm(F.xb, F.wup, 4096, 1024, E); __syncthreads(); if (REP(7)) { run_gemm(F.xb, F.wup, 4096, 1024, E); __syncthreads(); } } SEAM(7);
    if (((PHASE_MASK >> 8) & 1) && IN(8)) { pg8::EpiRes2 E{F.xb, F.out, F.ss2}; run_gemm(F.hid, F.wdn, 1024, 4096, E); __syncthreads(); } SEAM(8);
    if (((PHASE_MASK >> 9) & 1) && IN(9)) { if (REP(9)) { p9_final(F, true); __syncthreads(); } p9_final(F, false); }
#undef IN
#undef SEAM
}

extern "C" void kernel_launch(void* const* d_in, const int* in_sizes, int n_in, void* d_out, int out_size, void* d_ws, size_t ws_size, hipStream_t stream) {
    static int grid = 0;
    if (grid == 0) {
        if (n_in != 20 || out_size != NTOK * DM || ws_size < WS_END) { fprintf(stderr, "kernel_launch: unexpected shapes (n_in %d, out %d, ws %zu < %zu)\n", n_in, out_size, ws_size, (size_t)WS_END); grid = -1; return; }
        int dev = 0, cus = 0, per_cu = 0;
        hipGetDevice(&dev); hipDeviceGetAttribute(&cus, hipDeviceAttributeMultiprocessorCount, dev);
        if (hipFuncSetAttribute((const void*)mega_fwd, hipFuncAttributeMaxDynamicSharedMemorySize, LDS_BYTES) != hipSuccess) { fprintf(stderr, "kernel_launch: hipFuncSetAttribute failed\n"); grid = -1; return; }
        if (hipOccupancyMaxActiveBlocksPerMultiprocessor(&per_cu, (const void*)mega_fwd, NTHR, LDS_BYTES) != hipSuccess || per_cu < 1) { fprintf(stderr, "kernel_launch: occupancy query failed (%d)\n", per_cu); per_cu = 1; }
        (void)hipGetLastError();
        grid = cus * per_cu;
        fprintf(stderr, "kernel_launch: grid %d (%d CUs x %d)\n", grid, cus, per_cu);
    }
    if (grid < 0) return;
    if (hipMemsetAsync((char*)d_ws + WS_BAR, 0, XCD_BAR_WORDS * 4, stream) != hipSuccess) { fprintf(stderr, "kernel_launch: memset of the barrier words failed\n"); return; }
    Args a{};
    for (int i = 0; i < 20; ++i) a.in[i] = (const float*)d_in[i];
    a.out = (float*)d_out; a.ws = (unsigned char*)d_ws;
#if MK_PER_PHASE_LAUNCH
    for (int p = 0; p < NPHASE; ++p) { a.ph_lo = p; a.ph_hi = p + 1; hipLaunchKernelGGL(mega_fwd, dim3(grid), dim3(NTHR), LDS_BYTES, stream, a); }
#else
    a.ph_lo = 0; a.ph_hi = NPHASE;
    void* kargs[] = {&a};
    hipError_t e = hipLaunchCooperativeKernel((const void*)mega_fwd, dim3(grid), dim3(NTHR), kargs, LDS_BYTES, stream);
    if (e != hipSuccess) fprintf(stderr, "kernel_launch: cooperative launch failed: %s (grid %d)\n", hipGetErrorString(e), grid);
#endif
}
```

```cpp
#include <hip/hip_runtime.h>
#include <hip/hip_cooperative_groups.h>
#include <cstdio>
#include <cstdint>
namespace cg = cooperative_groups;

#ifndef MK_PER_PHASE_LAUNCH
#define MK_PER_PHASE_LAUNCH 0
#endif

#ifndef REPEAT_MASK
#define REPEAT_MASK 0
#endif
#define REP(k) ((REPEAT_MASK >> (k)) & 1)
#ifndef TS_SEL
#define TS_SEL -1
#endif

namespace pg8 {
#define PG8_LAS __attribute__((address_space(3)))
typedef unsigned short bf16_t;
typedef short bf16x8 __attribute__((ext_vector_type(8)));
typedef float f32x4 __attribute__((ext_vector_type(4)));
typedef unsigned u32x4 __attribute__((ext_vector_type(4)));
constexpr int BM = 256, BK = 64, HALF = 128, HTB = HALF * BK * 2  , STAGE_BYTES = 8 * HTB, NXCD = 8, WGM = 8;

__host__ __device__ __forceinline__ int lds_byte(int r, int c) { const int st = (r >> 4) * 2 + (c >> 5), rr = r & 15, cc = c & 31, ob = rr * 64 + cc * 2; return st * 1024 + (ob ^ (((ob >> 9) & 1) << 5)); }
__host__ __device__ __forceinline__ void stage_rc(int b, int& R, int& C) { const int st = b / 1024, sb = b % 1024, swz = sb ^ (((sb >> 9) & 1) << 5); R = (st >> 1) * 16 + swz / 64; C = (st & 1) * 32 + (swz % 64) / 2; }
__host__ __device__ __forceinline__ int perm32(int rho) { const int n = rho >> 4, i = rho & 15; return 8 * (i >> 2) + 4 * n + (i & 3); }

struct Unit { int pm, pn; };
struct Gemm { const bf16_t* A; const bf16_t* Bt; int M, N, K; };

struct StaticOrder {
    int nM, nN, nwg, G, c;
    __host__ __device__ void init(int M, int N, int G_, int c_) { nM = M / BM; nN = N / BM; nwg = nM * nN; G = G_; c = c_; }
    __host__ __device__ bool next(int i, Unit& u) const {
        const long L = (long)i * G + c; if (L >= nwg) return false;
        int wgid = (int)L; { const int q = nwg / NXCD, r = nwg % NXCD, xcd = wgid % NXCD, off = wgid / NXCD; wgid = (xcd < r ? xcd * (q + 1) : r * (q + 1) + (xcd - r) * q) + off; }
        const int nig = WGM * nN, gid = wgid / nig, fm = gid * WGM, gsz = (nM - fm) < WGM ? (nM - fm) : WGM;
        u.pm = fm + ((wgid % nig) % gsz); u.pn = (wgid % nig) / gsz; return true;
    }
    __device__ __forceinline__ void a_ready(const Unit&) const {}
    __device__ __forceinline__ void done(const Unit&) const {}
};
__device__ __forceinline__ unsigned cvt_pk_bf16(float lo, float hi) { unsigned r; asm volatile("v_cvt_pk_bf16_f32 %0, %1, %2" : "=v"(r) : "v"(lo), "v"(hi)); return r; }
typedef float f32x2 __attribute__((ext_vector_type(2)));
__device__ __forceinline__ float bflo(unsigned u) { return __uint_as_float(u << 16); }
__device__ __forceinline__ float bfhi(unsigned u) { return __uint_as_float(u & 0xffff0000u); }
__device__ __forceinline__ float sigm(float x) { return 1.0f / (1.0f + __expf(-x)); }

struct EpiZ {
    static constexpr bool PERM = true, AFTER_DRAIN = false;
    bf16_t* O; int ldc;
    __device__ __forceinline__ void operator()(const f32x4 (&acc)[2][2][4][2], const Unit& u, int wr, int wc, int fr, int fq) const {
        const int row0 = u.pm * BM + wr * 64 + fr, col0 = u.pn * BM + wc * 32 + 8 * fq;
#pragma unroll
        for (int ai = 0; ai < 2; ++ai)
#pragma unroll
            for (int m = 0; m < 4; ++m) { bf16_t* rowp = O + (size_t)(row0 + ai * HALF + m * 16) * ldc + col0;
#pragma unroll
                for (int bj = 0; bj < 2; ++bj) { const f32x4 v0 = acc[ai][bj][m][0], v1 = acc[ai][bj][m][1];
                    u32x4 w; w.x = cvt_pk_bf16(v0[0], v0[1]); w.y = cvt_pk_bf16(v0[2], v0[3]); w.z = cvt_pk_bf16(v1[0], v1[1]); w.w = cvt_pk_bf16(v1[2], v1[3]);
                    *(u32x4*)(rowp + bj * HALF) = w; } }
    }
};
template <int MODE> struct EpiGate {
    static constexpr bool PERM = true, AFTER_DRAIN = false;
    bf16_t* O; const bf16_t* Z; int zld; int gcol;
    __device__ __forceinline__ void operator()(const f32x4 (&acc)[2][2][4][2], const Unit& u, int wr, int wc, int fr, int fq) const {
        const int row0 = u.pm * BM + wr * 64 + fr, col0 = u.pn * BM + wc * 32 + 8 * fq;
#pragma unroll
        for (int ai = 0; ai < 2; ++ai)
#pragma unroll
            for (int m = 0; m < 4; ++m) { const size_t row = (size_t)(row0 + ai * HALF + m * 16);
                bf16_t* op = O + row * 1024 + col0; const bf16_t* zp = Z + row * zld + gcol + col0;
#pragma unroll
                for (int bj = 0; bj < 2; ++bj) { const f32x4 v0 = acc[ai][bj][m][0], v1 = acc[ai][bj][m][1];
                    const u32x4 g = *(const u32x4*)(zp + bj * HALF);
                    float r0 = v0[0] * sigm(bflo(g.x)), r1 = v0[1] * sigm(bfhi(g.x)), r2 = v0[2] * sigm(bflo(g.y)), r3 = v0[3] * sigm(bfhi(g.y));
                    float r4 = v1[0] * sigm(bflo(g.z)), r5 = v1[1] * sigm(bfhi(g.z)), r6 = v1[2] * sigm(bflo(g.w)), r7 = v1[3] * sigm(bfhi(g.w));
                    if (MODE == 1) { const u32x4 p = *(const u32x4*)(op + bj * HALF);
                        r0 += bflo(p.x); r1 += bfhi(p.x); r2 += bflo(p.y); r3 += bfhi(p.y); r4 += bflo(p.z); r5 += bfhi(p.z); r6 += bflo(p.w); r7 += bfhi(p.w); }
                    u32x4 w; w.x = cvt_pk_bf16(r0, r1); w.y = cvt_pk_bf16(r2, r3); w.z = cvt_pk_bf16(r4, r5); w.w = cvt_pk_bf16(r6, r7);
                    *(u32x4*)(op + bj * HALF) = w; } }
    }
};
struct EpiRes1 {
    static constexpr bool PERM = false, AFTER_DRAIN = false;
    const float* X; bf16_t* XB; float* SS;
    __device__ __forceinline__ void operator()(const f32x4 (&acc)[2][2][4][2], const Unit& u, int wr, int wc, int fr, int fq) const {
        const int row0 = u.pm * BM + wr * 64 + fr, col0 = u.pn * BM + wc * 32 + 4 * fq;
#pragma unroll
        for (int ai = 0; ai < 2; ++ai)
#pragma unroll
            for (int m = 0; m < 4; ++m) { const size_t row = (size_t)(row0 + ai * HALF + m * 16); float ssq = 0.f;
#pragma unroll
                for (int bj = 0; bj < 2; ++bj)
#pragma unroll
                    for (int n = 0; n < 2; ++n) { const size_t off = row * 1024 + col0 + bj * HALF + n * 16;
                        const f32x4 xv = *(const f32x4*)(X + off); const f32x4 v = acc[ai][bj][m][n] + xv;
                        ssq += v[0] * v[0] + v[1] * v[1] + v[2] * v[2] + v[3] * v[3];
                        uint2 w; w.x = cvt_pk_bf16(v[0], v[1]); w.y = cvt_pk_bf16(v[2], v[3]); *(uint2*)(XB + off) = w; }
                ssq += __shfl_xor(ssq, 16); ssq += __shfl_xor(ssq, 32);
                if (fq == 0) atomicAdd(SS + row, ssq); }
    }
};
struct EpiRes2 {
    static constexpr bool PERM = false, AFTER_DRAIN = false;
    const bf16_t* XB; float* O; float* SS;
    __device__ __forceinline__ void operator()(const f32x4 (&acc)[2][2][4][2], const Unit& u, int wr, int wc, int fr, int fq) const {
        const int row0 = u.pm * BM + wr * 64 + fr, col0 = u.pn * BM + wc * 32 + 4 * fq;
#pragma unroll
        for (int ai = 0; ai < 2; ++ai)
#pragma unroll
            for (int m = 0; m < 4; ++m) { const size_t row = (size_t)(row0 + ai * HALF + m * 16); float ssq = 0.f;
#pragma unroll
                for (int bj = 0; bj < 2; ++bj)
#pragma unroll
                    for (int n = 0; n < 2; ++n) { const size_t off = row * 1024 + col0 + bj * HALF + n * 16;
                        const uint2 xw = *(const uint2*)(XB + off); f32x4 v = acc[ai][bj][m][n];
                        v[0] += bflo(xw.x); v[1] += bfhi(xw.x); v[2] += bflo(xw.y); v[3] += bfhi(xw.y);
                        *(f32x4*)(O + off) = v; ssq += v[0] * v[0] + v[1] * v[1] + v[2] * v[2] + v[3] * v[3]; }
                ssq += __shfl_xor(ssq, 16); ssq += __shfl_xor(ssq, 32);
                if (fq == 0) atomicAdd(SS + row, ssq); }
    }
};
struct EpiHid {
    static constexpr bool PERM = true, AFTER_DRAIN = false;
    bf16_t* O; const float* SS;
    __device__ __forceinline__ void operator()(const f32x4 (&acc)[2][2][4][2], const Unit& u, int wr, int wc, int fr, int fq) const {
        const int row0 = u.pm * BM + wr * 64 + fr, col0 = u.pn * BM + wc * 32 + 8 * fq;
#pragma unroll
        for (int ai = 0; ai < 2; ++ai)
#pragma unroll
            for (int m = 0; m < 4; ++m) { const size_t row = (size_t)(row0 + ai * HALF + m * 16);
                const float s2 = 1.0f / (SS[row] * (1.0f / 1024.0f) + 1e-6f);
                bf16_t* rowp = O + row * 4096 + col0;
#pragma unroll
                for (int bj = 0; bj < 2; ++bj) { f32x4 v0 = acc[ai][bj][m][0], v1 = acc[ai][bj][m][1];
#pragma unroll
                    for (int j = 0; j < 4; ++j) { float a = fmaxf(v0[j], 0.f), b = fmaxf(v1[j], 0.f); v0[j] = a * a * s2; v1[j] = b * b * s2; }
                    u32x4 w; w.x = cvt_pk_bf16(v0[0], v0[1]); w.y = cvt_pk_bf16(v0[2], v0[3]); w.z = cvt_pk_bf16(v1[0], v1[1]); w.w = cvt_pk_bf16(v1[2], v1[3]);
                    *(u32x4*)(rowp + bj * HALF) = w; } }
    }
};

template <class Epi, class Sched, bool ALIGN_EPI = false, bool SP2 = false>
__device__ __forceinline__ void gemm_phase(PG8_LAS unsigned char* lds, const Gemm g, const Sched& S, const Epi& E) {
    const int tid = threadIdx.x, wid = __builtin_amdgcn_readfirstlane(tid >> 6), lane = tid & 63, wr = wid >> 2, wc = wid & 3, fr = lane & 15, fq = lane >> 4;
    const int K = g.K, nt = K / BK;
    unsigned voffA[2], voffB[2];
#pragma unroll
    for (int i = 0; i < 2; ++i) { int R, C; stage_rc(tid * 16 + i * 8192, R, C); const int Rb = Epi::PERM ? ((R & ~31) + perm32(R & 31)) : R;
        voffA[i] = (unsigned)(R * K + C) * 2u; voffB[i] = (unsigned)(Rb * K + C) * 2u; }
    const size_t kstep = (size_t)(BK * 2);
    const size_t hstep = (size_t)HALF * K * 2;
    const size_t tstep = 2 * hstep;
    const unsigned ldsw = (unsigned)wid * 1024u;
    const int aoff = lds_byte(wr * 64 + fr, fq * 8), boff = lds_byte(wc * 32 + fr, fq * 8);
#define PG8_SA(b, h) (((b) * 2 + (h)) * HTB)
#define PG8_SB(b, h) ((4 + (b) * 2 + (h)) * HTB)
#define PG8_STAGE(bufoff, gbase, voff) do { _Pragma("unroll") for (int _i = 0; _i < 2; ++_i) \
        __builtin_amdgcn_global_load_lds((const unsigned*)((const char*)(gbase) + (voff)[_i]), (PG8_LAS unsigned*)(lds + (bufoff) + ldsw + _i * 8192), 16, 0, 0); } while (0)
#define PG8_LDA(dst, b, h) do { _Pragma("unroll") for (int m = 0; m < 4; ++m) _Pragma("unroll") for (int k = 0; k < 2; ++k) dst[m][k] = *(const PG8_LAS bf16x8*)(lds + PG8_SA(b, h) + aoff + m * 2048 + k * 1024); } while (0)
#define PG8_LDB(dst, b, h) do { _Pragma("unroll") for (int n = 0; n < 2; ++n) _Pragma("unroll") for (int k = 0; k < 2; ++k) dst[n][k] = *(const PG8_LAS bf16x8*)(lds + PG8_SB(b, h) + boff + n * 2048 + k * 1024); } while (0)
#define PG8_MMA(ai, bj, At, Bt) do { __builtin_amdgcn_s_setprio(1); _Pragma("unroll") for (int m = 0; m < 4; ++m) _Pragma("unroll") for (int n = 0; n < 2; ++n) _Pragma("unroll") for (int k = 0; k < 2; ++k) \
        acc[ai][bj][m][n] = __builtin_amdgcn_mfma_f32_16x16x32_bf16(Bt[n][k], At[m][k], acc[ai][bj][m][n], 0, 0, 0); __builtin_amdgcn_s_setprio(0); } while (0)
#define PG8_WAIT_V(n) asm volatile("s_waitcnt vmcnt(" #n ")" ::: "memory")
#define PG8_WAIT_L(n) asm volatile("s_waitcnt lgkmcnt(" #n ")" ::: "memory")
#define PG8_BAR __builtin_amdgcn_s_barrier()
#define PG8_SCHED __builtin_amdgcn_sched_barrier(0)
    Unit cur, nxt; int ui = 0;
    if (!S.next(0, cur)) return;
    f32x4 acc[2][2][4][2];
#pragma unroll
    for (int a = 0; a < 2; ++a)
#pragma unroll
        for (int b = 0; b < 2; ++b)
#pragma unroll
            for (int m = 0; m < 4; ++m)
#pragma unroll
                for (int n = 0; n < 2; ++n) acc[a][b][m][n] = (f32x4){0.f, 0.f, 0.f, 0.f};
    bf16x8 At[4][2], B0[2][2], B1[2][2];
    const char* cA = (const char*)g.A + (size_t)cur.pm * tstep; const char* cB = (const char*)g.Bt + (size_t)cur.pn * tstep;
    S.a_ready(cur);
    if constexpr (SP2) {
        PG8_STAGE(PG8_SB(0, 0), cB, voffB); PG8_STAGE(PG8_SB(0, 1), cB + hstep, voffB); PG8_STAGE(PG8_SA(0, 0), cA, voffA); PG8_STAGE(PG8_SA(0, 1), cA + hstep, voffA);
        if (wr == 1) PG8_BAR;
        PG8_WAIT_V(2); PG8_BAR;
        PG8_STAGE(PG8_SB(1, 0), cB + kstep, voffB); PG8_STAGE(PG8_SA(1, 0), cA + kstep, voffA); PG8_STAGE(PG8_SB(1, 1), cB + hstep + kstep, voffB);
        PG8_WAIT_V(6); PG8_BAR;
    } else {
        PG8_STAGE(PG8_SB(0, 0), cB, voffB); PG8_STAGE(PG8_SA(0, 0), cA, voffA); PG8_STAGE(PG8_SB(0, 1), cB + hstep, voffB); PG8_STAGE(PG8_SA(0, 1), cA + hstep, voffA);
        if (wr == 1) PG8_BAR;
        PG8_WAIT_V(4); PG8_BAR;
        PG8_STAGE(PG8_SB(1, 0), cB + kstep, voffB); PG8_STAGE(PG8_SA(1, 0), cA + kstep, voffA); PG8_STAGE(PG8_SB(1, 1), cB + hstep + kstep, voffB);
        PG8_WAIT_V(6); PG8_BAR;
    }
    for (;;) {
        const bool has_next = S.next(ui + 1, nxt);
        const char* nA = has_next ? (const char*)g.A + (size_t)nxt.pm * tstep : cA; const char* nB = has_next ? (const char*)g.Bt + (size_t)nxt.pn * tstep : cB;
        for (int t = 0; t < nt; t += 2) {
            const bool last = (t == nt - 2);
            const char* a1 = cA + (size_t)(t + 1) * kstep;
            const char* a2 = last ? nA : cA + (size_t)(t + 2) * kstep; const char* b2 = last ? nB : cB + (size_t)(t + 2) * kstep;
            const char* a3 = a2 + kstep; const char* b3 = b2 + kstep;
            if (last && has_next) S.a_ready(nxt);
            if constexpr (SP2) {
            PG8_LDB(B0, 0, 0); PG8_LDB(B1, 0, 1); PG8_SCHED; PG8_LDA(At, 0, 0); PG8_STAGE(PG8_SA(1, 1), a1 + hstep, voffA);
            PG8_WAIT_V(8); PG8_WAIT_L(0); PG8_BAR; PG8_MMA(0, 0, At, B0); PG8_MMA(0, 1, At, B1); PG8_BAR; PG8_SCHED;
            PG8_LDA(At, 0, 1); PG8_STAGE(PG8_SB(0, 0), b2, voffB); PG8_STAGE(PG8_SB(0, 1), b2 + hstep, voffB); PG8_STAGE(PG8_SA(0, 0), a2, voffA);
            PG8_WAIT_V(8); PG8_WAIT_L(0); PG8_BAR; PG8_MMA(1, 0, At, B0); PG8_MMA(1, 1, At, B1); PG8_BAR; PG8_SCHED;
            PG8_LDB(B0, 1, 0); PG8_LDB(B1, 1, 1); PG8_SCHED; PG8_LDA(At, 1, 0); PG8_STAGE(PG8_SA(0, 1), a2 + hstep, voffA);
            PG8_WAIT_V(8); PG8_WAIT_L(0); PG8_BAR; PG8_MMA(0, 0, At, B0); PG8_MMA(0, 1, At, B1); PG8_BAR; PG8_SCHED;
            PG8_LDA(At, 1, 1); PG8_STAGE(PG8_SB(1, 0), b3, voffB); PG8_STAGE(PG8_SB(1, 1), b3 + hstep, voffB); PG8_STAGE(PG8_SA(1, 0), a3, voffA);
            PG8_WAIT_V(8); PG8_WAIT_L(0); PG8_BAR; PG8_MMA(1, 0, At, B0); PG8_MMA(1, 1, At, B1); PG8_BAR; PG8_SCHED;
            } else {
            PG8_LDB(B0, 0, 0); PG8_SCHED; PG8_LDA(At, 0, 0); PG8_STAGE(PG8_SA(1, 1), a1 + hstep, voffA);
            PG8_WAIT_L(8); PG8_BAR; PG8_WAIT_L(0); PG8_MMA(0, 0, At, B0); PG8_BAR; PG8_SCHED;
            PG8_LDB(B1, 0, 1); PG8_STAGE(PG8_SB(0, 0), b2, voffB);
            PG8_BAR; PG8_WAIT_L(0); PG8_MMA(0, 1, At, B1); PG8_BAR;
            PG8_LDA(At, 0, 1); PG8_STAGE(PG8_SA(0, 0), a2, voffA);
            PG8_BAR; PG8_WAIT_L(0); PG8_MMA(1, 0, At, B0); PG8_BAR; PG8_SCHED;
            PG8_STAGE(PG8_SB(0, 1), b2 + hstep, voffB);
            PG8_WAIT_V(6); PG8_BAR; PG8_MMA(1, 1, At, B1); PG8_BAR;
            PG8_LDB(B0, 1, 0); PG8_SCHED; PG8_LDA(At, 1, 0); PG8_STAGE(PG8_SA(0, 1), a2 + hstep, voffA);
            PG8_WAIT_L(8); PG8_BAR; PG8_WAIT_L(0); PG8_MMA(0, 0, At, B0); PG8_BAR; PG8_SCHED;
            PG8_LDB(B1, 1, 1); PG8_STAGE(PG8_SB(1, 0), b3, voffB);
            PG8_BAR; PG8_WAIT_L(0); PG8_MMA(0, 1, At, B1); PG8_BAR;
            PG8_LDA(At, 1, 1); PG8_STAGE(PG8_SA(1, 0), a3, voffA);
            PG8_BAR; PG8_WAIT_L(0); PG8_MMA(1, 0, At, B0); PG8_BAR; PG8_SCHED;
            PG8_STAGE(PG8_SB(1, 1), b3 + hstep, voffB);
            PG8_WAIT_V(6); PG8_BAR; PG8_MMA(1, 1, At, B1); PG8_BAR;
            }
        }
        if constexpr (ALIGN_EPI) { if (wr == 0) PG8_BAR; }
        if constexpr (!Epi::AFTER_DRAIN) { E(acc, cur, wr, wc, fr, fq); S.done(cur); }
        if (!has_next) break;
#pragma unroll
        for (int a = 0; a < 2; ++a)
#pragma unroll
            for (int b = 0; b < 2; ++b)
#pragma unroll
                for (int m = 0; m < 4; ++m)
#pragma unroll
                    for (int n = 0; n < 2; ++n) acc[a][b][m][n] = (f32x4){0.f, 0.f, 0.f, 0.f};
        cur = nxt; cA = nA; cB = nB; ++ui;
        if constexpr (ALIGN_EPI) { if (wr == 1) PG8_BAR; }
    }
    PG8_WAIT_V(0);
    if constexpr (!ALIGN_EPI) { if (wr == 0) PG8_BAR; }
    PG8_BAR;
    if constexpr (Epi::AFTER_DRAIN) { E.fused(acc, cur, wr, wc, fr, fq, lds, wid, lane); S.done(cur); }
#undef PG8_SA
#undef PG8_SB
#undef PG8_STAGE
#undef PG8_LDA
#undef PG8_LDB
#undef PG8_MMA
#undef PG8_WAIT_V
#undef PG8_WAIT_L
#undef PG8_BAR
#undef PG8_SCHED
}
}
extern __shared__ __attribute__((aligned(16))) unsigned char g_lds[];
using pg8::bf16_t; using pg8::bf16x8; using pg8::f32x4; using pg8::u32x4; using pg8::cvt_pk_bf16; using pg8::bflo; using pg8::bfhi; using pg8::sigm;

constexpr int NTOK = 32768, DM = 1024, SEQ = 2048, NB = 16, ZLD = 5120, NTHR = 512;
constexpr int C_R = 0, C_K = 512, C_V = 1024, C_WD = 1536, C_AD = 1600, C_GD = 1664;
constexpr int C_Q = 1824, C_KA = 2336, C_VA = 2400, C_QI = 2464, C_KI = 2976, C_WI = 3040, C_G0 = 3048, C_G1 = 4072;
constexpr size_t MiB = 1024 * 1024;
constexpr size_t WS_SS1 = 0, WS_SS2 = 128 * 1024, WS_BONUS = 256 * 1024, WS_ROPE = 1280 * 1024, WS_WD = 1792 * 1024, WS_WI = 1856 * 1024, WS_WG = 1920 * 1024;
constexpr size_t WS_WIN = 4 * MiB, WS_WUP = 14 * MiB, WS_WDN = 22 * MiB, WS_WB = 30 * MiB, WS_WO = 32 * MiB, WS_VT = 34 * MiB, WS_H = 38 * MiB, WS_Z = 102 * MiB, WS_P = 422 * MiB, WS_END = 486 * MiB;
constexpr int LDS_BYTES = 163840;

struct Args { const float* in[20]; float* out; unsigned char* ws; int ph_lo, ph_hi; };

struct Frame {
    const float* in[20]; float* out; unsigned char* ws; unsigned char* lds; int tid, lane, wave;
    float *ss1, *ss2, *bonus; float2* rope; bf16_t *wd, *wi, *wg, *win, *wup, *wdn, *wb, *wo, *vt, *h, *ya, *yb, *xb, *z, *hid, *lw, *ic, *mg, *gt; float* yraw;
};

__device__ __forceinline__ bf16_t f2bf(float f) { return (bf16_t)(cvt_pk_bf16(f, 0.f) & 0xffffu); }
__device__ __forceinline__ float bf2f(bf16_t b) { return __uint_as_float(((unsigned)b) << 16); }
template <int CTRL> __device__ __forceinline__ float dpp_mov(float x) { return __int_as_float(__builtin_amdgcn_update_dpp(0, __float_as_int(x), CTRL, 0xF, 0xF, true)); }
__device__ __forceinline__ float red16(float x) { x += dpp_mov<0xB1>(x); x += dpp_mov<0x4E>(x); x += dpp_mov<0x141>(x); x += dpp_mov<0x140>(x); return x; }


__device__ __forceinline__ void lds_barrier() { asm volatile("s_waitcnt lgkmcnt(0)" ::: "memory"); __builtin_amdgcn_s_barrier(); asm volatile("" ::: "memory"); }
__device__ __forceinline__ void red16x4(float& a, float& b, float& c, float& d) {
#define DPP4(ctl) "v_add_f32_dpp %0, %0, %0 " ctl " row_mask:0xf bank_mask:0xf bound_ctrl:1\n" "v_add_f32_dpp %1, %1, %1 " ctl " row_mask:0xf bank_mask:0xf bound_ctrl:1\n" \
                  "v_add_f32_dpp %2, %2, %2 " ctl " row_mask:0xf bank_mask:0xf bound_ctrl:1\n" "v_add_f32_dpp %3, %3, %3 " ctl " row_mask:0xf bank_mask:0xf bound_ctrl:1\n"
    asm volatile("s_nop 1\n" DPP4("quad_perm:[1,0,3,2]") DPP4("quad_perm:[2,3,0,1]") DPP4("row_half_mirror") DPP4("row_mirror") : "+v"(a), "+v"(b), "+v"(c), "+v"(d));
#undef DPP4
}
__device__ __forceinline__ float red32(float x) { x += __shfl_xor(x, 1); x += __shfl_xor(x, 2); x += __shfl_xor(x, 4); x += __shfl_xor(x, 8); x += __shfl_xor(x, 16); return x; }
__device__ __forceinline__ float red64(float x) { x = red32(x); x += __shfl_xor(x, 32); return x; }
__device__ __forceinline__ float softplus_f(float x) { return fmaxf(x, 0.f) + log1pf(__expf(-fabsf(x))); }

__device__ __forceinline__ void tconv(const Frame& F, const float* __restrict__ W, int K, int N, int Npad, bf16_t* __restrict__ Wt, const float* __restrict__ rs) {
    float* tile = (float*)g_lds;
    const int ktn = (K + 63) / 64, ntn = Npad / 64, tid = F.tid;
    for (int tl = blockIdx.x; tl < ktn * ntn; tl += gridDim.x) {
        const int kt = tl % ktn, nt = tl / ktn;
#pragma unroll
        for (int i = 0; i < 2; ++i) { const int idx = tid + i * NTHR, kk = idx >> 4, n4 = (idx & 15) * 4, k = kt * 64 + kk, n = nt * 64 + n4;
            f32x4 v = {0.f, 0.f, 0.f, 0.f};
            if (k < K) { if (n + 3 < N) v = *(const f32x4*)(W + (size_t)k * N + n); else { for (int j = 0; j < 4; ++j) if (n + j < N) v[j] = W[(size_t)k * N + n + j]; }
                if (rs != nullptr) { const float r = rs[k]; v[0] *= r; v[1] *= r; v[2] *= r; v[3] *= r; } }
            tile[kk * 65 + n4] = v[0]; tile[kk * 65 + n4 + 1] = v[1]; tile[kk * 65 + n4 + 2] = v[2]; tile[kk * 65 + n4 + 3] = v[3]; }
        __syncthreads();
        { const int nn = tid >> 3, k8 = (tid & 7) * 8, k = kt * 64 + k8, n = nt * 64 + nn;
          if (k < K) { u32x4 w; const float* tp = tile + k8 * 65 + nn;
              w.x = cvt_pk_bf16(tp[0], tp[65]); w.y = cvt_pk_bf16(tp[130], tp[195]); w.z = cvt_pk_bf16(tp[260], tp[325]); w.w = cvt_pk_bf16(tp[390], tp[455]);
              *(u32x4*)(Wt + (size_t)n * K + k) = w; } }
        __syncthreads();
    }
}
__device__ __forceinline__ void p0_prologue(const Frame& F) {
    const int tid = F.tid, gtid = blockIdx.x * NTHR + tid, gn = gridDim.x * NTHR;
    for (int i = gtid; i < 2 * NTOK; i += gn) F.ss1[i] = 0.f;
    for (int i = gtid; i < SEQ * 32; i += gn) { const int pos = i >> 5, j = i & 31;
        const float inv = 1.0f / powf(10000.0f, (float)(2 * j) / 64.0f); const float ang = (float)pos * inv;
        double rev = (double)ang * 0.15915494309189535; rev -= floor(rev); const float fr = (float)rev;
        F.rope[i] = make_float2(__builtin_amdgcn_cosf(fr), __builtin_amdgcn_sinf(fr)); }
    tconv(F, F.in[2], 1024, 5096, 5120, F.win, nullptr);
    tconv(F, F.in[17], 1024, 4096, 4096, F.wup, F.in[16]);
    tconv(F, F.in[18], 4096, 1024, 1024, F.wdn, nullptr);
    tconv(F, F.in[14], 512, 1024, 1024, F.wb, nullptr);
    tconv(F, F.in[14] + 512 * 1024, 512, 1024, 1024, F.wb + 1024 * 512, nullptr);
    tconv(F, F.in[15], 1024, 1024, 1024, F.wo, nullptr);
    tconv(F, F.in[5], 64, 512, 512, F.wd, nullptr);
    tconv(F, F.in[7], 64, 512, 512, F.wi, nullptr);
    tconv(F, F.in[8], 160, 512, 512, F.wg, nullptr);
    const float* x = F.in[0]; const float* g = F.in[1]; const int lane = F.lane;
    for (int row = blockIdx.x * 8 + F.wave; row < NTOK; row += gridDim.x * 8) {
        const float* xr = x + (size_t)row * DM; f32x4 v[4]; float ss = 0.f;
#pragma unroll
        for (int i = 0; i < 4; ++i) { v[i] = *(const f32x4*)(xr + i * 256 + lane * 4); ss += v[i][0] * v[i][0] + v[i][1] * v[i][1] + v[i][2] * v[i][2] + v[i][3] * v[i][3]; }
        ss = red64(ss); const float sc = rsqrtf(ss * (1.0f / 1024.0f) + 1e-6f);
#pragma unroll
        for (int i = 0; i < 4; ++i) { const f32x4 gg = *(const f32x4*)(g + i * 256 + lane * 4); uint2 w;
            w.x = cvt_pk_bf16(v[i][0] * sc * gg[0], v[i][1] * sc * gg[1]); w.y = cvt_pk_bf16(v[i][2] * sc * gg[2], v[i][3] * sc * gg[3]);
            *(uint2*)(F.h + (size_t)row * DM + i * 256 + lane * 4) = w; }
    }
}

__device__ __forceinline__ void p2_prep(const Frame& F, const int mode) {
    const int tid = F.tid, lane = F.lane, wave = F.wave, fr = lane & 15, fq = lane >> 4;
    bf16_t* z = F.z; const float* mu = F.in[3];
    if (mode != 2) {
        constexpr int LDA = 296, TT = 32; bf16_t* At = (bf16_t*)g_lds;
        bf16_t* Ot = At + TT * LDA;
        const float* dbias = F.in[4]; const float* ibias = F.in[6];
        for (int tile = blockIdx.x; tile < NTOK / TT; tile += gridDim.x) {
            const int t0 = tile * TT;
            for (int idx = tid; idx < TT * 36; idx += NTHR) { const int tok = idx / 36, c8 = (idx - tok * 36) * 8, t = t0 + tok, col = C_WD + c8;
                const u32x4 zc = *(const u32x4*)(z + (size_t)t * ZLD + col); u32x4 zp = {0u, 0u, 0u, 0u}; if (t & (SEQ - 1)) zp = *(const u32x4*)(z + (size_t)(t - 1) * ZLD + col);
                const f32x4 m0 = *(const f32x4*)(mu + col), m1 = *(const f32x4*)(mu + col + 4);
                float v[8]; const unsigned zcu[4] = {zc.x, zc.y, zc.z, zc.w}, zpu[4] = {zp.x, zp.y, zp.z, zp.w};
#pragma unroll
                for (int j = 0; j < 4; ++j) { const float a = bflo(zcu[j]), b2 = bfhi(zcu[j]), pa = bflo(zpu[j]), pb = bfhi(zpu[j]);
                    const float mm0 = (j < 2) ? m0[2 * j] : m1[2 * j - 4], mm1 = (j < 2) ? m0[2 * j + 1] : m1[2 * j - 3];
                    v[2 * j] = a + (pa - a) * mm0; v[2 * j + 1] = b2 + (pb - b2) * mm1; }
                if (c8 < 64) {
#pragma unroll
                    for (int j = 0; j < 8; ++j) v[j] = tanhf(v[j]); }
                else if (c8 >= 128) {
#pragma unroll
                    for (int j = 0; j < 8; ++j) v[j] = sigm(v[j]); }
                u32x4 w; w.x = cvt_pk_bf16(v[0], v[1]); w.y = cvt_pk_bf16(v[2], v[3]); w.z = cvt_pk_bf16(v[4], v[5]); w.w = cvt_pk_bf16(v[6], v[7]);
                *(u32x4*)(At + tok * LDA + c8) = w; }
            __syncthreads();
            const int h = wave;
            bf16x8 Bc[9], Bn[9];
            { const int n = h * 64 + fr;
#pragma unroll
              for (int ks = 0; ks < 2; ++ks) { Bc[ks] = *(const bf16x8*)(F.wd + n * 64 + ks * 32 + fq * 8); Bc[2 + ks] = *(const bf16x8*)(F.wi + n * 64 + ks * 32 + fq * 8); }
#pragma unroll
              for (int ks = 0; ks < 5; ++ks) Bc[4 + ks] = *(const bf16x8*)(F.wg + n * 160 + ks * 32 + fq * 8); }
#pragma unroll 1
            for (int j = 0; j < 4; ++j) { const int n = h * 64 + j * 16 + fr;
                if (j < 3) { const int nn = n + 16;
#pragma unroll
                    for (int ks = 0; ks < 2; ++ks) { Bn[ks] = *(const bf16x8*)(F.wd + nn * 64 + ks * 32 + fq * 8); Bn[2 + ks] = *(const bf16x8*)(F.wi + nn * 64 + ks * 32 + fq * 8); }
#pragma unroll
                    for (int ks = 0; ks < 5; ++ks) Bn[4 + ks] = *(const bf16x8*)(F.wg + nn * 160 + ks * 32 + fq * 8); }
                const float db = dbias[n], ib = ibias[n];
#pragma unroll
                for (int mt = 0; mt < 2; ++mt) {
                    f32x4 ad = {0.f, 0.f, 0.f, 0.f}, ai = ad, ag = ad; const bf16_t* ap = At + (mt * 16 + fr) * LDA + fq * 8;
#pragma unroll
                    for (int ks = 0; ks < 2; ++ks) ad = __builtin_amdgcn_mfma_f32_16x16x32_bf16(*(const bf16x8*)(ap + ks * 32), Bc[ks], ad, 0, 0, 0);
#pragma unroll
                    for (int ks = 0; ks < 2; ++ks) ai = __builtin_amdgcn_mfma_f32_16x16x32_bf16(*(const bf16x8*)(ap + 64 + ks * 32), Bc[2 + ks], ai, 0, 0, 0);
#pragma unroll
                    for (int ks = 0; ks < 5; ++ks) ag = __builtin_amdgcn_mfma_f32_16x16x32_bf16(*(const bf16x8*)(ap + 128 + ks * 32), Bc[4 + ks], ag, 0, 0, 0);
#pragma unroll
                    for (int jj = 0; jj < 4; ++jj) {
                        const float dw = db + ad[jj]; const float wlog = -softplus_f(-dw) - 0.5f; const float lwv = -__expf(wlog);
                        const int tk = mt * 16 + fq * 4 + jj; Ot[tk * 520 + n] = f2bf(lwv); Ot[(TT + tk) * 520 + n] = f2bf(sigm(ib + ai[jj])); Ot[(2 * TT + tk) * 520 + n] = f2bf(ag[jj]); }
                }
#pragma unroll
                for (int q = 0; q < 9; ++q) Bc[q] = Bn[q];
            }
            __syncthreads();
#pragma unroll
            for (int i = 0; i < 12; ++i) { const int idx = tid + i * NTHR, arr = idx >> 11, rem = idx & 2047, tk = rem >> 6, c8 = (rem & 63) * 8;
                const u32x4 w = *(const u32x4*)(Ot + (arr * TT + tk) * 520 + c8); bf16_t* dst = arr == 0 ? F.lw : (arr == 1 ? F.ic : F.gt);
                *(u32x4*)(dst + (size_t)(t0 + tk) * 512 + c8) = w; }
            __syncthreads();
        }
    }
    if (mode != 2) {
        unsigned short* tl = (unsigned short*)g_lds;
        for (int tile = blockIdx.x; tile < NTOK / 64; tile += gridDim.x) { const int t0 = tile * 64, b = t0 / SEQ, tt0 = t0 % SEQ;
#pragma unroll
            for (int i = 0; i < 8; ++i) { const int idx = tid + i * NTHR, tok = idx >> 6, d = idx & 63; tl[tok * 66 + d] = z[(size_t)(t0 + tok) * ZLD + C_VA + d]; }
            __syncthreads();
#pragma unroll
            for (int i = 0; i < 8; ++i) { const int idx = tid + i * NTHR, d = idx >> 6, tok = idx & 63; F.vt[((size_t)b * 64 + d) * SEQ + tt0 + tok] = tl[tok * 66 + d]; }
            __syncthreads();
        }
    }
    if (mode != 0) {
        const int gtid = blockIdx.x * NTHR + tid, gn = gridDim.x * NTHR;
        for (int idx = gtid; idx < NTOK * 144; idx += gn) { const int t = idx / 144, p = idx - t * 144, hd = p >> 3, i4 = (p & 7) * 4;
            const int base = hd < 8 ? C_Q + hd * 64 : (hd == 8 ? C_KA : (hd < 17 ? C_QI + (hd - 9) * 64 : C_KI));
            f32x4 cs0 = *(const f32x4*)(&F.rope[(t & (SEQ - 1)) * 32 + i4]), cs1 = *(const f32x4*)(&F.rope[(t & (SEQ - 1)) * 32 + i4 + 2]);
            if (mode == 2) { cs0 = (f32x4){1.f, 0.f, 1.f, 0.f}; cs1 = cs0; }
            bf16_t* p1 = z + (size_t)t * ZLD + base + i4; const uint2 a = *(const uint2*)(p1), b2 = *(const uint2*)(p1 + 32);
            const float x10 = bflo(a.x), x11 = bfhi(a.x), x12 = bflo(a.y), x13 = bfhi(a.y), x20 = bflo(b2.x), x21 = bfhi(b2.x), x22 = bflo(b2.y), x23 = bfhi(b2.y);
            uint2 o1, o2;
            o1.x = cvt_pk_bf16(x10 * cs0[0] - x20 * cs0[1], x11 * cs0[2] - x21 * cs0[3]); o1.y = cvt_pk_bf16(x12 * cs1[0] - x22 * cs1[1], x13 * cs1[2] - x23 * cs1[3]);
            o2.x = cvt_pk_bf16(x20 * cs0[0] + x10 * cs0[1], x21 * cs0[2] + x11 * cs0[3]); o2.y = cvt_pk_bf16(x22 * cs1[0] + x12 * cs1[1], x23 * cs1[2] + x13 * cs1[3]);
            *(uint2*)(p1) = o1; *(uint2*)(p1 + 32) = o2; }
    }
}

struct ScanRaw { uint2 zr_c, zr_p, zk_c, zk_p, zv_c, zv_p, lwu, icu; };
struct ScanConst { f32x4 mur, muk, muv, kk, ka, rk; };
__device__ __forceinline__ void scan_load(ScanRaw& R, const bf16_t* z, const bf16_t* lw, const bf16_t* ic, size_t tokbase, int ch, int ptok, int gc) {
    const int t = ch * 16 + ptok; const size_t T = tokbase + t; const bf16_t* zp = z + T * ZLD + gc;
    R.zr_c = *(const uint2*)(zp + C_R); R.zk_c = *(const uint2*)(zp + C_K); R.zv_c = *(const uint2*)(zp + C_V);
    const uint2 zz = make_uint2(0u, 0u);
    if (t > 0) { R.zr_p = *(const uint2*)(zp - ZLD + C_R); R.zk_p = *(const uint2*)(zp - ZLD + C_K); R.zv_p = *(const uint2*)(zp - ZLD + C_V); } else { R.zr_p = zz; R.zk_p = zz; R.zv_p = zz; }
    R.lwu = *(const uint2*)(lw + T * 512 + gc); R.icu = *(const uint2*)(ic + T * 512 + gc);
}
__device__ __forceinline__ f32x4 unpack4(uint2 u) { f32x4 r; r[0] = bflo(u.x); r[1] = bfhi(u.x); r[2] = bflo(u.y); r[3] = bfhi(u.y); return r; }
__device__ __forceinline__ void scan_prep(const ScanRaw& R, const ScanConst& C, float* ops, float* vv, float* bonus_out, bool wr_bonus, int ptok, int pc, int v0) {
    const f32x4 rc = unpack4(R.zr_c), rp = unpack4(R.zr_p), kc = unpack4(R.zk_c), kp = unpack4(R.zk_p), vc = unpack4(R.zv_c), vp = unpack4(R.zv_p), ic = unpack4(R.icu), lw = unpack4(R.lwu);
    const f32x4 r = rc + (rp - rc) * C.mur, k = kc + (kp - kc) * C.muk, vs = vc + (vp - vc) * C.muv;
    f32x4 w; w[0] = __expf(lw[0]); w[1] = __expf(lw[1]); w[2] = __expf(lw[2]); w[3] = __expf(lw[3]);
    const f32x4 q = k * C.kk; const float ss = red16((q[0] * q[0] + q[1] * q[1]) + (q[2] * q[2] + q[3] * q[3]));
    const float inv = 1.0f / fmaxf(sqrtf(ss), 1e-12f); const f32x4 n = q * inv;
    const f32x4 kn = k * (1.0f + (ic - 1.0f) * C.ka);
    const f32x4 bt = r * kn * C.rk; const float bon = red16((bt[0] + bt[1]) + (bt[2] + bt[3]));
    if (wr_bonus) *bonus_out = bon;
    float* op = ops + ptok * 320 + pc;
    *(f32x4*)(op) = -n; *(f32x4*)(op + 64) = w; *(f32x4*)(op + 128) = n * ic; *(f32x4*)(op + 192) = kn; *(f32x4*)(op + 256) = r;
    if (pc >= v0 && pc < v0 + 32) *(f32x4*)(vv + ptok * 32 + pc - v0) = vs;
}
__device__ __forceinline__ void p3_scan(const Frame& F, const int mode) {
    const int tid = F.tid;
    float* opsb = (float*)g_lds;
    float* vvb = opsb + 2 * 5120;
    float* yob = vvb + 2 * 512;
    const bf16_t* z = F.z; const float* mu = F.in[3]; const float* k_k = F.in[9]; const float* k_a = F.in[10]; const float* r_k = F.in[11];
    for (int item = blockIdx.x; item < 256; item += gridDim.x) {
        const int bh = item >> 1, half = item & 1, b = bh >> 3, h = bh & 7, v0 = half * 32;
        const size_t tokbase = (size_t)b * SEQ;
        if (F.wave >= 4) {
            const int pt = tid - 256, ptok = pt >> 4, pc = (pt & 15) * 4, gc = h * 64 + pc;
            ScanConst C; C.mur = *(const f32x4*)(mu + C_R + gc); C.muk = *(const f32x4*)(mu + C_K + gc); C.muv = *(const f32x4*)(mu + C_V + gc);
            C.kk = *(const f32x4*)(k_k + gc); C.ka = *(const f32x4*)(k_a + gc); C.rk = *(const f32x4*)(r_k + gc);
            const bool wrb = (half == 0) && ((pt & 15) == 0);
            ScanRaw R;
            scan_load(R, z, F.lw, F.ic, tokbase, 0, ptok, gc);
            scan_prep(R, C, opsb, vvb, F.bonus + (tokbase + ptok) * 8 + h, wrb, ptok, pc, v0);
            scan_load(R, z, F.lw, F.ic, tokbase, 1, ptok, gc);
            lds_barrier();
            for (int ch = 0; ch < SEQ / 16; ++ch) {
                const int cur = ch & 1, nxt = cur ^ 1;
                if (mode != 2) {
                if (ch > 0) { const int tok = pt >> 4, r2 = (pt & 15) * 2;
                    *(float2*)(F.yraw + (tokbase + (ch - 1) * 16 + tok) * 512 + h * 64 + v0 + r2) = *(const float2*)(yob + nxt * 512 + tok * 32 + r2); }
                if (ch + 1 < SEQ / 16) {
                    scan_prep(R, C, opsb + nxt * 5120, vvb + nxt * 512, F.bonus + (tokbase + (ch + 1) * 16 + ptok) * 8 + h, wrb, ptok, pc, v0);
                    if (ch + 2 < SEQ / 16) scan_load(R, z, F.lw, F.ic, tokbase, ch + 2, ptok, gc);
                } }
                lds_barrier();
            }
            { const int tok = pt >> 4, r2 = (pt & 15) * 2;
              *(float2*)(F.yraw + (tokbase + (SEQ / 16 - 1) * 16 + tok) * 512 + h * 64 + v0 + r2) = *(const float2*)(yob + 512 + tok * 32 + r2); }
        } else {
            const int rp = tid >> 4, ks = tid & 15;
            float A0 = 0.f, A1 = 0.f, A2 = 0.f, A3 = 0.f, B0 = 0.f, B1 = 0.f, B2 = 0.f, B3 = 0.f;
            const int ywoff = (ks == 0) ? 2 * rp : (2 * 512 + 2 * tid), ywstep = (ks == 0) ? 32 : 0;
            lds_barrier();
            f32x4 rprev = {0.f, 0.f, 0.f, 0.f}; float* ywp = yob + 2 * 512 + 2 * tid;
            for (int ch = 0; ch < SEQ / 16; ++ch) {
                const int cur = ch & 1;
                const float* ops = opsb + cur * 5120 + ks * 4; const float* vv = vvb + cur * 512 + 2 * rp; float* yw = yob + cur * 512 + ywoff;
                if (mode != 1) {
#pragma unroll
                for (int s = 0; s < 16; ++s) {
                    const float* o = ops + s * 320;
                    const f32x4 a4 = *(const f32x4*)(o), w4 = *(const f32x4*)(o + 64), b4 = *(const f32x4*)(o + 128), k4 = *(const f32x4*)(o + 192), r4 = *(const f32x4*)(o + 256);
                    const float2 vab = *(const float2*)(vv + s * 32);
                    float sa = (A0 * a4[0] + A1 * a4[1]) + (A2 * a4[2] + A3 * a4[3]); float sb = (B0 * a4[0] + B1 * a4[1]) + (B2 * a4[2] + B3 * a4[3]);
                    float ya = (A0 * rprev[0] + A1 * rprev[1]) + (A2 * rprev[2] + A3 * rprev[3]); float yb2 = (B0 * rprev[0] + B1 * rprev[1]) + (B2 * rprev[2] + B3 * rprev[3]);
                    red16x4(sa, sb, ya, yb2);
                    *(float2*)(ywp) = make_float2(ya, yb2);
                    ywp = yw + s * ywstep;
                    A0 = A0 * w4[0] + sa * b4[0] + vab.x * k4[0]; A1 = A1 * w4[1] + sa * b4[1] + vab.x * k4[1];
                    A2 = A2 * w4[2] + sa * b4[2] + vab.x * k4[2]; A3 = A3 * w4[3] + sa * b4[3] + vab.x * k4[3];
                    B0 = B0 * w4[0] + sb * b4[0] + vab.y * k4[0]; B1 = B1 * w4[1] + sb * b4[1] + vab.y * k4[1];
                    B2 = B2 * w4[2] + sb * b4[2] + vab.y * k4[2]; B3 = B3 * w4[3] + sb * b4[3] + vab.y * k4[3];
                    rprev = r4;
                }
                {
                    float ya = (A0 * rprev[0] + A1 * rprev[1]) + (A2 * rprev[2] + A3 * rprev[3]); float yb2 = (B0 * rprev[0] + B1 * rprev[1]) + (B2 * rprev[2] + B3 * rprev[3]);
                    float d0 = 0.f, d1 = 0.f; red16x4(ya, yb2, d0, d1);
                    *(float2*)(ywp) = make_float2(ya, yb2); ywp = yob + 2 * 512 + 2 * tid; rprev = (f32x4){0.f, 0.f, 0.f, 0.f};
                } }
                lds_barrier();
            }
        }
        __syncthreads();
    }
}

__device__ __forceinline__ unsigned ordkey(float f) { const unsigned u = __float_as_uint(f); return (u & 0x80000000u) ? ~u : (u | 0x80000000u); }

__device__ __forceinline__ void attn_chunk(const unsigned char* kb, const unsigned char* vb, const unsigned* selm, int c, int p, int fr, int fq, const bf16x8 (&Bqa)[2][2], f32x4 (&O)[2][4], f32x4 (&RS)[2]) {
    const f32x4 zero4 = {0.f, 0.f, 0.f, 0.f};
    const u32x4 onesu = {0x3f803f80u, 0x3f803f80u, 0x3f803f80u, 0x3f803f80u}; const bf16x8 ones = __builtin_bit_cast(bf16x8, onesu);
    const float csc = 0.125f * 1.4426950408889634f;
    const unsigned char* k0p = kb + ((2 * p) * 16 + fr) * 144 + fq * 16; const unsigned char* k1p = k0p + 16 * 144;
    const bf16x8 KA00 = *(const bf16x8*)(k0p), KA01 = *(const bf16x8*)(k0p + 64), KA10 = *(const bf16x8*)(k1p), KA11 = *(const bf16x8*)(k1p + 64);
    const int mw = (int)selm[fr * 64 + 2 * c + p];
    bf16x8 VA[4];
#pragma unroll
    for (int dt = 0; dt < 4; ++dt) { const unsigned char* vp = vb + (dt * 16 + fr) * 144 + (2 * p) * 32 + fq * 8;
        const uint2 lo = *(const uint2*)(vp), hi = *(const uint2*)(vp + 32);
        u32x4 va; va.x = lo.x; va.y = lo.y; va.z = hi.x; va.w = hi.y; VA[dt] = __builtin_bit_cast(bf16x8, va); }
    unsigned km0[4], km1[4];
#pragma unroll
    for (int jj = 0; jj < 4; ++jj) { km0[jj] = (unsigned)__builtin_amdgcn_sbfe(mw, fq * 4 + jj, 1); km1[jj] = (unsigned)__builtin_amdgcn_sbfe(mw, 16 + fq * 4 + jj, 1); }
#pragma unroll
    for (int hh = 0; hh < 2; ++hh) {
        f32x4 s0 = __builtin_amdgcn_mfma_f32_16x16x32_bf16(KA00, Bqa[hh][0], zero4, 0, 0, 0); s0 = __builtin_amdgcn_mfma_f32_16x16x32_bf16(KA01, Bqa[hh][1], s0, 0, 0, 0);
        f32x4 s1 = __builtin_amdgcn_mfma_f32_16x16x32_bf16(KA10, Bqa[hh][0], zero4, 0, 0, 0); s1 = __builtin_amdgcn_mfma_f32_16x16x32_bf16(KA11, Bqa[hh][1], s1, 0, 0, 0);
        unsigned p0[4], p1[4];
#pragma unroll
        for (int jj = 0; jj < 4; ++jj) {
            p0[jj] = __float_as_uint(__builtin_amdgcn_exp2f(fminf(s0[jj] * csc, 86.f))) & km0[jj]; p1[jj] = __float_as_uint(__builtin_amdgcn_exp2f(fminf(s1[jj] * csc, 86.f))) & km1[jj]; }
        u32x4 pk; pk.x = cvt_pk_bf16(__uint_as_float(p0[0]), __uint_as_float(p0[1])); pk.y = cvt_pk_bf16(__uint_as_float(p0[2]), __uint_as_float(p0[3]));
        pk.z = cvt_pk_bf16(__uint_as_float(p1[0]), __uint_as_float(p1[1])); pk.w = cvt_pk_bf16(__uint_as_float(p1[2]), __uint_as_float(p1[3]));
        const bf16x8 PB = __builtin_bit_cast(bf16x8, pk);
        RS[hh] = __builtin_amdgcn_mfma_f32_16x16x32_bf16(ones, PB, RS[hh], 0, 0, 0);
#pragma unroll
        for (int dt = 0; dt < 4; ++dt) O[hh][dt] = __builtin_amdgcn_mfma_f32_16x16x32_bf16(VA[dt], PB, O[hh][dt], 0, 0, 0);
    }
}

__device__ __forceinline__ void p3_dsa(const Frame& F) {
    const int tid = F.tid, lane = F.lane, wave = F.wave, fr = lane & 15, fq = lane >> 4;
    unsigned* scl = (unsigned*)g_lds;
    unsigned* selm = (unsigned*)(g_lds + 131328);
    unsigned char* kbuf = (unsigned char*)g_lds;
    unsigned char* vbuf = kbuf + 2 * 9216;
    const bf16_t* z = F.z; const int G = gridDim.x, bx = blockIdx.x;
    const f32x4 zero4 = {0.f, 0.f, 0.f, 0.f};
    for (int rnd = 0; rnd * G < 2048; ++rnd) {
        const int n = rnd * G + ((rnd & 1) ? (G - 1 - bx) : bx);
        if (n >= 2048) continue;
        const int qg = 127 - (n >> 4), b = n & 15, q0 = qg * 16; const size_t Tb = (size_t)b * SEQ;
        for (int i = tid; i < 1024; i += NTHR) selm[i] = 0u;
        __syncthreads();
        const bf16_t* zq = z + (Tb + q0 + fr) * ZLD;
        const unsigned lofk = (unsigned)((fr * ZLD + fq * 8) * 2), lofv = (unsigned)((fr * SEQ + fq * 4) * 2);
        const int nchunk = (qg + 4) >> 2; const int lrow = tid >> 3, lseg = tid & 7;
        const bf16_t* kg = z + (Tb + lrow) * ZLD + C_KA + lseg * 8; const bf16_t* vg = F.vt + ((size_t)b * 64 + lrow) * SEQ + lseg * 8;
        const unsigned lst = (unsigned)(lrow * 144 + lseg * 16);
        const int hp = wave >> 1, kh = wave & 1;
        const u32x4 kc0 = *(const u32x4*)(kg), vc0 = *(const u32x4*)(vg);
        u32x4 kx = kc0, vx = vc0, ky = kc0, vy = vc0;
        if (1 < nchunk) { kx = *(const u32x4*)(kg + (size_t)64 * ZLD); vx = *(const u32x4*)(vg + 64); }
        if (2 < nchunk) { ky = *(const u32x4*)(kg + (size_t)128 * ZLD); vy = *(const u32x4*)(vg + 128); }
        bf16x8 Bqa[2][2];
#pragma unroll
        for (int hh = 0; hh < 2; ++hh)
#pragma unroll
            for (int ks = 0; ks < 2; ++ks) Bqa[hh][ks] = *(const bf16x8*)(zq + C_Q + (2 * hp + hh) * 64 + ks * 32 + fq * 8);
        if (qg >= 16) {
            const u32x4 wv = *(const u32x4*)(zq + C_WI);
            {
                bf16x8 Bq[8][2];
#pragma unroll
                for (int hh = 0; hh < 8; ++hh)
#pragma unroll
                    for (int ks = 0; ks < 2; ++ks) Bq[hh][ks] = *(const bf16x8*)(zq + C_QI + hh * 64 + ks * 32 + fq * 8);
                const float sc = 0.044194173824159216f;
                float wih[8]; wih[0] = bflo(wv.x) * sc; wih[1] = bfhi(wv.x) * sc; wih[2] = bflo(wv.y) * sc; wih[3] = bfhi(wv.y) * sc; wih[4] = bflo(wv.z) * sc; wih[5] = bfhi(wv.z) * sc; wih[6] = bflo(wv.w) * sc; wih[7] = bfhi(wv.w) * sc;
#pragma unroll 1
                for (int half = 0; half < 2; ++half) {
                    const int ktb = wave + 64 * half; if (ktb > qg) break;
                    bf16x8 W0[2], W1[2];
#pragma unroll
                    for (int j = 0; j < 2; ++j) { const int ktj = (ktb + 8 * j) < qg ? (ktb + 8 * j) : qg; const char* kb = (const char*)(z + (Tb + (size_t)ktj * 16) * ZLD + C_KI);
                        W0[j] = *(const bf16x8*)(kb + lofk); W1[j] = *(const bf16x8*)(kb + lofk + 64); }
#pragma unroll
                    for (int i = 0; i < 8; ++i) { const int kt = ktb + 8 * i;
                        if (kt <= qg) { f32x4 sv = zero4;
#pragma unroll
                            for (int hh = 0; hh < 8; ++hh) { f32x4 acc = __builtin_amdgcn_mfma_f32_16x16x32_bf16(W0[i & 1], Bq[hh][0], zero4, 0, 0, 0);
                                acc = __builtin_amdgcn_mfma_f32_16x16x32_bf16(W1[i & 1], Bq[hh][1], acc, 0, 0, 0);
#pragma unroll
                                for (int jj = 0; jj < 4; ++jj) sv[jj] += wih[hh] * fmaxf(acc[jj], 0.f); }
                            u32x4 w; w.x = ordkey(sv[0]); w.y = ordkey(sv[1]); w.z = ordkey(sv[2]); w.w = ordkey(sv[3]);
                            *(u32x4*)(scl + fr * 2052 + kt * 16 + fq * 4) = w;
                        }
                        if (i + 2 < 8) { const int ktn = (kt + 16) < qg ? (kt + 16) : qg; const char* kb = (const char*)(z + (Tb + (size_t)ktn * 16) * ZLD + C_KI);
                            unsigned lo2 = lofk; asm volatile("" : "+v"(lo2));
                            W0[i & 1] = *(const bf16x8*)(kb + lo2); W1[i & 1] = *(const bf16x8*)(kb + lo2 + 64); }
                    }
                }
            }
            __syncthreads();
#pragma unroll 1
            for (int qq = 0; qq < 2; ++qq) {
                const int q = 2 * wave + qq, qpos = q0 + q;
                unsigned uk[32];
#pragma unroll
                for (int r = 0; r < 32; ++r) { const int key = r * 64 + lane; uk[r] = 0x007fffffu;
                    if (r * 64 <= qpos) { const unsigned v = scl[q * 2052 + key]; uk[r] = (key <= qpos) ? v : 0x007fffffu; } }
                unsigned T = 0u; bool exact = false;
#pragma unroll 1
                for (int bit = 31; bit >= 0; --bit) {
                    const unsigned cand = T | (1u << bit); int c = 0;
#pragma unroll
                    for (int g = 0; g < 4; ++g) {
                        if (g * 512 > qpos) break;
                        unsigned long long m[8];
                        asm("v_cmp_ge_u32_e64 %0, %8, %16\n\tv_cmp_ge_u32_e64 %1, %9, %16\n\tv_cmp_ge_u32_e64 %2, %10, %16\n\tv_cmp_ge_u32_e64 %3, %11, %16\n\t"
                            "v_cmp_ge_u32_e64 %4, %12, %16\n\tv_cmp_ge_u32_e64 %5, %13, %16\n\tv_cmp_ge_u32_e64 %6, %14, %16\n\tv_cmp_ge_u32_e64 %7, %15, %16"
                            : "=&s"(m[0]), "=&s"(m[1]), "=&s"(m[2]), "=&s"(m[3]), "=&s"(m[4]), "=&s"(m[5]), "=&s"(m[6]), "=&s"(m[7])
                            : "v"(uk[g * 8 + 0]), "v"(uk[g * 8 + 1]), "v"(uk[g * 8 + 2]), "v"(uk[g * 8 + 3]), "v"(uk[g * 8 + 4]), "v"(uk[g * 8 + 5]), "v"(uk[g * 8 + 6]), "v"(uk[g * 8 + 7]), "v"(cand));
#pragma unroll
                        for (int j = 0; j < 8; ++j) c += __builtin_popcountll(m[j]);
                    }
                    if (c >= 256) { T = cand; if (c == 256) { exact = true; break; } }
                }
                int need = 0;
                if (!exact) { int c = 0;
#pragma unroll
                    for (int r = 0; r < 32; ++r) c += __builtin_popcountll(__builtin_amdgcn_ballot_w64(uk[r] > T));
                    need = 256 - c; }
#pragma unroll
                for (int r = 0; r < 32; ++r) {
                    if (r * 64 <= qpos) {
                        unsigned long long sel;
                        if (exact) sel = __builtin_amdgcn_ballot_w64(uk[r] >= T);
                        else { sel = __builtin_amdgcn_ballot_w64(uk[r] > T); unsigned long long e = __builtin_amdgcn_ballot_w64(uk[r] == T);
                            const int ne = __builtin_popcountll(e);
                            if (ne <= need) { sel |= e; need -= ne; }
                            else { for (int k = 0; k < need; ++k) { const unsigned long long lb = e & (0ull - e); sel |= lb; e ^= lb; } need = 0; } }
                        if (lane == 0) { selm[q * 64 + 2 * r] = (unsigned)sel; selm[q * 64 + 2 * r + 1] = (unsigned)(sel >> 32); }
                    }
                }
            }
        } else {
            for (int w = tid; w < 1024; w += NTHR) { const int q = w >> 6, word = w & 63, qpos = q0 + q, lo = word * 32;
                selm[w] = (qpos >= lo + 31) ? 0xffffffffu : (qpos < lo ? 0u : ((2u << (qpos - lo)) - 1u)); }
        }
        __syncthreads();
        {
            *(u32x4*)(kbuf + lst) = kc0; *(u32x4*)(vbuf + lst) = vc0;
            f32x4 O[2][4]; f32x4 rs[2];
#pragma unroll
            for (int hh = 0; hh < 2; ++hh) { rs[hh] = zero4;
#pragma unroll
                for (int dt = 0; dt < 4; ++dt) O[hh][dt] = zero4; }
            lds_barrier();
#pragma unroll 1
            for (int c = 0; c < nchunk; c += 2) {
                attn_chunk(kbuf, vbuf, selm, c, kh, fr, fq, Bqa, O, rs);
                if (c + 1 < nchunk) { *(u32x4*)(kbuf + 9216 + lst) = kx; *(u32x4*)(vbuf + 9216 + lst) = vx; }
                if (c + 3 < nchunk) { kx = *(const u32x4*)(kg + (size_t)(c + 3) * 64 * ZLD); vx = *(const u32x4*)(vg + (c + 3) * 64); }
                lds_barrier();
                if (c + 1 < nchunk) {
                    attn_chunk(kbuf + 9216, vbuf + 9216, selm, c + 1, kh, fr, fq, Bqa, O, rs);
                    if (c + 2 < nchunk) { *(u32x4*)(kbuf + lst) = ky; *(u32x4*)(vbuf + lst) = vy; }
                    if (c + 4 < nchunk) { ky = *(const u32x4*)(kg + (size_t)(c + 4) * 64 * ZLD); vy = *(const u32x4*)(vg + (c + 4) * 64); }
                    lds_barrier();
                }
            }
            float* xb = (float*)(vbuf + 2 * 9216) + (size_t)wave * (64 * 17);
            { const int oh = kh ^ 1;
#pragma unroll
              for (int dt = 0; dt < 4; ++dt)
#pragma unroll
                  for (int jj = 0; jj < 4; ++jj) xb[(dt * 4 + jj) * 64 + lane] = (oh == 0) ? O[0][dt][jj] : O[1][dt][jj];
              xb[16 * 64 + lane] = (oh == 0) ? rs[0][0] : rs[1][0]; }
            lds_barrier();
            { const float* pb = (const float*)(vbuf + 2 * 9216) + (size_t)(wave ^ 1) * (64 * 17);
              float tot = ((kh == 0) ? rs[0][0] : rs[1][0]) + pb[16 * 64 + lane];
              const float inv = 1.0f / tot;
              bf16_t* yp = F.yb + (Tb + q0 + fr) * 512 + (2 * hp + kh) * 64 + fq * 4;
#pragma unroll
              for (int dt = 0; dt < 4; ++dt) { float o[4];
#pragma unroll
                  for (int jj = 0; jj < 4; ++jj) o[jj] = (((kh == 0) ? O[0][dt][jj] : O[1][dt][jj]) + pb[(dt * 4 + jj) * 64 + lane]) * inv;
                  uint2 w; w.x = cvt_pk_bf16(o[0], o[1]); w.y = cvt_pk_bf16(o[2], o[3]); *(uint2*)(yp + dt * 16) = w; } }
        }
        __syncthreads();
    }
}

__device__ __forceinline__ void p4_post(const Frame& F) {
    const int tid = F.tid; const float* mu = F.in[3]; const float* gnw = F.in[12]; const float* gnb = F.in[13]; const bf16_t* z = F.z;
    for (int g = blockIdx.x * 16 + (tid >> 5); g < NTOK * 8; g += gridDim.x * 16) { const size_t t = (size_t)(g >> 3); const int h = g & 7, c = h * 64 + (tid & 31) * 2;
        const float2 y = *(const float2*)(F.yraw + t * 512 + c);
        const float mean = red32(y.x + y.y) * (1.0f / 64.0f); const float dx = y.x - mean, dy = y.y - mean;
        const float var = red32(dx * dx + dy * dy) * (1.0f / 64.0f); const float rstd = rsqrtf(var + 64e-5f);
        const unsigned vc = *(const unsigned*)(z + t * ZLD + C_V + c); const unsigned vp = (t & (SEQ - 1)) ? *(const unsigned*)(z + (t - 1) * ZLD + C_V + c) : 0u;
        const float vs0 = bflo(vc) + (bflo(vp) - bflo(vc)) * mu[C_V + c], vs1 = bfhi(vc) + (bfhi(vp) - bfhi(vc)) * mu[C_V + c + 1];
        const float bon = F.bonus[t * 8 + h]; const unsigned gt = *(const unsigned*)(F.gt + t * 512 + c);
        const float o0 = (dx * rstd * gnw[c] + gnb[c] + bon * vs0) * bflo(gt), o1 = (dy * rstd * gnw[c + 1] + gnb[c + 1] + bon * vs1) * bfhi(gt);
        *(unsigned*)(F.ya + t * 512 + c) = cvt_pk_bf16(o0, o1); }
}

__device__ __forceinline__ void p9_final(const Frame& F, const bool ident) {
    const float* g = F.in[19]; const int lane = F.lane;
    for (int row = blockIdx.x * 8 + F.wave; row < NTOK; row += gridDim.x * 8) {
        float* xr = F.out + (size_t)row * DM; const float sc = ident ? 1.0f : rsqrtf(F.ss2[row] * (1.0f / 1024.0f) + 1e-6f);
#pragma unroll
        for (int i = 0; i < 4; ++i) { f32x4 v = *(const f32x4*)(xr + i * 256 + lane * 4); const f32x4 gg = *(const f32x4*)(g + i * 256 + lane * 4);
            if (!ident) { v[0] *= sc * gg[0]; v[1] *= sc * gg[1]; v[2] *= sc * gg[2]; v[3] *= sc * gg[3]; } *(f32x4*)(xr + i * 256 + lane * 4) = v; }
    }
}
#define XB_TMO      128
#define XB_XCNT(j)  (256  + 64 * (j))
#define XB_XSUB(j)  (1280 + 64 * (j))
#define XB_XGEN(j)  (2304 + 64 * (j))
#define XB_TOP      3328
#define XB_TOPGEN   3392
#define XCD_BAR_WORDS 3456
#define XB_SPIN_CAP (1u << 18)
#define LAS __attribute__((address_space(3)))

__device__ __forceinline__ unsigned xb_ld(unsigned* p)              { return __hip_atomic_load(p, __ATOMIC_RELAXED, __HIP_MEMORY_SCOPE_AGENT); }
__device__ __forceinline__ unsigned xb_add(unsigned* p, unsigned v) { return __hip_atomic_fetch_add(p, v, __ATOMIC_RELAXED, __HIP_MEMORY_SCOPE_AGENT); }
__device__ __forceinline__ unsigned xb_xcc_id() { return (unsigned)__builtin_amdgcn_s_getreg((3 << 11) | 20) & 0xFu; }
#define XB_SPIN(cond, bar) do { unsigned _sp = 0; while (cond) { __builtin_amdgcn_s_sleep(1); \
    if ((++_sp & 255u) == 0u) { if (xb_ld(&(bar)[XB_TMO])) break; if (_sp > XB_SPIN_CAP) { atomicAdd(&(bar)[XB_TMO], 1u); break; } } } } while (0)

struct XcdBarrier {
    unsigned* bar; unsigned x;
    volatile LAS unsigned* st;
};

__device__ __forceinline__ XcdBarrier xcd_barrier_post(unsigned* bar, volatile LAS unsigned* st) {
    XcdBarrier b; b.bar = bar; b.x = xb_xcc_id(); b.st = st;
    if (threadIdx.x == 0) (void)xb_add(&bar[XB_XCNT(b.x)], 1u);
    return b;
}
__device__ __forceinline__ void xcd_barrier_complete(unsigned* bar, unsigned x, unsigned& nloc, unsigned& nx) {
    const unsigned G = gridDim.x * gridDim.y * gridDim.z;
    unsigned sum, cnt, mine, sp = 0u;
    for (;;) {
        sum = 0u; cnt = 0u; mine = 0u;
#pragma unroll
        for (unsigned j = 0; j < 16; ++j) { const unsigned c = xb_ld(&bar[XB_XCNT(j)]); sum += c; cnt += (c > 0u) ? 1u : 0u; mine = (j == x) ? c : mine; }
        if (sum == G) break;
        __builtin_amdgcn_s_sleep(1);
        if ((++sp & 255u) == 0u) { if (xb_ld(&bar[XB_TMO])) break; if (sp > XB_SPIN_CAP) { atomicAdd(&bar[XB_TMO], 1u); break; } }
    }
    nloc = mine > 0u ? mine : 1u; nx = cnt > 0u ? cnt : 1u;
}

__device__ __forceinline__ void xcd_barrier(const XcdBarrier& b) {
    asm volatile("s_waitcnt vmcnt(0)" ::: "memory");
    __syncthreads();
    if (threadIdx.x == 0) {
        unsigned* bar = b.bar;
        __builtin_amdgcn_s_waitcnt(0);
        unsigned nloc = b.st[0], nx = b.st[1];
        if (nloc == 0u) { xcd_barrier_complete(bar, b.x, nloc, nx); b.st[0] = nloc; b.st[1] = nx; }
        const unsigned old = xb_add(&bar[XB_XSUB(b.x)], 1u);
        const unsigned gen = old / nloc;
        if (old + 1u == (gen + 1u) * nloc) {
            __builtin_amdgcn_fence(__ATOMIC_RELEASE, "agent");
            asm volatile("s_waitcnt vmcnt(0)" ::: "memory");
            const unsigned og = xb_add(&bar[XB_TOP], 1u);
            const unsigned tg = og / nx;
            if (og + 1u == (tg + 1u) * nx) xb_add(&bar[XB_TOPGEN], 1u);
            else XB_SPIN(xb_ld(&bar[XB_TOPGEN]) == tg, bar);
            __builtin_amdgcn_fence(__ATOMIC_ACQUIRE, "agent");
            xb_add(&bar[XB_XGEN(b.x)], 1u);
            asm volatile("s_waitcnt vmcnt(0)" ::: "memory");
        } else {
            XB_SPIN(xb_ld(&bar[XB_XGEN(b.x)]) == gen, bar);
            __builtin_amdgcn_fence(__ATOMIC_ACQUIRE, "agent");
            asm volatile("s_waitcnt vmcnt(0)" ::: "memory");
        }
    }
    __syncthreads();
}
#ifndef PHASE_MASK
#define PHASE_MASK 0x3ff
#endif
#ifndef GEMM_ALIGN
#define GEMM_ALIGN true
#endif
#ifndef GEMM_SP2
#define GEMM_SP2 true
#endif
constexpr int NPHASE = 10;
constexpr size_t WS_BAR = 3 * MiB;
template <class Epi> __device__ __forceinline__ void run_gemm(const bf16_t* A, const bf16_t* Bt, int N, int K, const Epi& E) {
    pg8::Gemm g{A, Bt, NTOK, N, K}; pg8::StaticOrder S; S.init(NTOK, N, (int)gridDim.x, (int)blockIdx.x);
    pg8::gemm_phase<Epi, pg8::StaticOrder, GEMM_ALIGN, GEMM_SP2>((PG8_LAS unsigned char*)g_lds, g, S, E);
}
__global__ void __launch_bounds__(NTHR, 2) mega_fwd(Args args) {
    Frame F;
#pragma unroll
    for (int i = 0; i < 20; ++i) F.in[i] = args.in[i];
    F.out = args.out; F.ws = args.ws; F.lds = nullptr; F.tid = threadIdx.x; F.lane = F.tid & 63; F.wave = __builtin_amdgcn_readfirstlane(F.tid >> 6);
    unsigned char* ws = args.ws;
    F.ss1 = (float*)(ws + WS_SS1); F.ss2 = (float*)(ws + WS_SS2); F.bonus = (float*)(ws + WS_BONUS); F.rope = (float2*)(ws + WS_ROPE);
    F.wd = (bf16_t*)(ws + WS_WD); F.wi = (bf16_t*)(ws + WS_WI); F.wg = (bf16_t*)(ws + WS_WG);
    F.win = (bf16_t*)(ws + WS_WIN); F.wup = (bf16_t*)(ws + WS_WUP); F.wdn = (bf16_t*)(ws + WS_WDN); F.wb = (bf16_t*)(ws + WS_WB); F.wo = (bf16_t*)(ws + WS_WO); F.vt = (bf16_t*)(ws + WS_VT);
    F.h = (bf16_t*)(ws + WS_H); F.ya = F.h; F.yb = F.h + (size_t)NTOK * 512; F.xb = F.h;
    F.z = (bf16_t*)(ws + WS_Z); F.hid = F.z;
    F.lw = (bf16_t*)(ws + WS_P); F.ic = F.lw + (size_t)NTOK * 512; F.mg = F.lw;
    F.yraw = args.out; F.gt = (bf16_t*)(args.out + (size_t)NTOK * 512);
    const int lo = args.ph_lo, hi = args.ph_hi;
    cg::grid_group grid = cg::this_grid();
    if (args.ph_lo < 0) grid.sync();
    volatile LAS unsigned* xst = (volatile LAS unsigned*)(g_lds + LDS_BYTES - 64);
    if (threadIdx.x == 0) { xst[0] = 0u; xst[1] = 0u; }
    __syncthreads();
    XcdBarrier xbar = xcd_barrier_post((unsigned*)(ws + WS_BAR), xst);
#define IN(k) (lo <= (k) && (k) < hi)
#define SEAM(k) do { if (IN(k) && IN((k) + 1)) { xcd_barrier(xbar); if (REP(17)) xcd_barrier(xbar); } } while (0)
    if (((PHASE_MASK >> 0) & 1) && IN(0)) { p0_prologue(F); __syncthreads(); if (REP(0)) { p0_prologue(F); __syncthreads(); } } SEAM(0);
    if (((PHASE_MASK >> 1) & 1) && IN(1)) { pg8::EpiZ E{F.z, ZLD}; run_gemm(F.h, F.win, 5120, 1024, E); __syncthreads(); if (REP(1)) { run_gemm(F.h, F.win, 5120, 1024, E); __syncthreads(); } if (REP(18)) { run_gemm(F.h, F.win, 4096, 1024, E); __syncthreads(); } } SEAM(1);
    if (((PHASE_MASK >> 2) & 1) && IN(2)) { if (REP(2)) { p2_prep(F, 0); __syncthreads(); } if (REP(16)) { p2_prep(F, 2); __syncthreads(); } p2_prep(F, 1); __syncthreads(); } SEAM(2);
    if (((PHASE_MASK >> 3) & 1) && IN(3)) { if (REP(14)) { p3_scan(F, 1); __syncthreads(); } if (REP(15)) { p3_scan(F, 2); __syncthreads(); } if (REP(3)) { p3_scan(F, 0); __syncthreads(); } p3_scan(F, 0); __syncthreads(); p3_dsa(F); __syncthreads(); if (REP(10)) { p3_dsa(F); __syncthreads(); } } SEAM(3);
    if (((PHASE_MASK >> 4) & 1) && IN(4)) { p4_post(F); __syncthreads(); if (REP(4)) { p4_post(F); __syncthreads(); } } SEAM(4);
    if (((PHASE_MASK >> 5) & 1) && IN(5)) { pg8::EpiGate<0> E0{F.mg, F.z, ZLD, C_G0}; run_gemm(F.ya, F.wb, 1024, 512, E0); __syncthreads();
                 pg8::EpiGate<1> E1{F.mg, F.z, ZLD, C_G1}; run_gemm(F.yb, F.wb + 1024 * 512, 1024, 512, E1); __syncthreads();
                 if (REP(5)) { run_gemm(F.ya, F.wb, 1024, 512, E0); __syncthreads(); run_gemm(F.yb, F.wb + 1024 * 512, 1024, 512, E1); __syncthreads(); } } SEAM(5);
    if (((PHASE_MASK >> 6) & 1) && IN(6)) { if (REP(6)) { pg8::EpiRes1 Ex{F.in[0], F.xb, F.bonus}; run_gemm(F.mg, F.wo, 1024, 1024, Ex); __syncthreads(); }
                 pg8::EpiRes1 E{F.in[0], F.xb, F.ss1}; run_gemm(F.mg, F.wo, 1024, 1024, E); __syncthreads(); } SEAM(6);
    if (((PHASE_MASK >> 7) & 1) && IN(7)) { pg8::EpiHid E{F.hid, F.ss1}; run_gemm(F.xb, F.wup, 4096, 1024, E); __syncthreads(); if (REP(7)) { run_gemm(F.xb, F.wup, 4096, 1024, E); __syncthreads(); } } SEAM(7);
    if (((PHASE_MASK >> 8) & 1) && IN(8)) { pg8::EpiRes2 E{F.xb, F.out, F.ss2}; run_gemm(F.hid, F.wdn, 1024, 4096, E); __syncthreads(); } SEAM(8);
    if (((PHASE_MASK >> 9) & 1) && IN(9)) { if (REP(9)) { p9_final(F, true); __syncthreads(); } p9_final(F, false); }
#undef IN
#undef SEAM
}

extern "C" void kernel_launch(void* const* d_in, const int* in_sizes, int n_in, void* d_out, int out_size, void* d_ws, size_t ws_size, hipStream_t stream) {
    static int grid = 0;
    if (grid == 0) {
        if (n_in != 20 || out_size != NTOK * DM || ws_size < WS_END) { fprintf(stderr, "kernel_launch: unexpected shapes (n_in %d, out %d, ws %zu < %zu)\n", n_in, out_size, ws_size, (size_t)WS_END); grid = -1; return; }
        int dev = 0, cus = 0, per_cu = 0;
        hipGetDevice(&dev); hipDeviceGetAttribute(&cus, hipDeviceAttributeMultiprocessorCount, dev);
        if (hipFuncSetAttribute((const void*)mega_fwd, hipFuncAttributeMaxDynamicSharedMemorySize, LDS_BYTES) != hipSuccess) { fprintf(stderr, "kernel_launch: hipFuncSetAttribute failed\n"); grid = -1; return; }
        if (hipOccupancyMaxActiveBlocksPerMultiprocessor(&per_cu, (const void*)mega_fwd, NTHR, LDS_BYTES) != hipSuccess || per_cu < 1) { fprintf(stderr, "kernel_launch: occupancy query failed (%d)\n", per_cu); per_cu = 1; }
        (void)hipGetLastError();
        grid = cus * per_cu;
        fprintf(stderr, "kernel_launch: grid %d (%d CUs x %d)\n", grid, cus, per_cu);
    }
    if (grid < 0) return;
    if (hipMemsetAsync((char*)d_ws + WS_BAR, 0, XCD_BAR_WORDS * 4, stream) != hipSuccess) { fprintf(stderr, "kernel_launch: memset of the barrier words failed\n"); return; }
    Args a{};
    for (int i = 0; i < 20; ++i) a.in[i] = (const float*)d_in[i];
    a.out = (float*)d_out; a.ws = (unsigned char*)d_ws;
#if MK_PER_PHASE_LAUNCH
    for (int p = 0; p < NPHASE; ++p) { a.ph_lo = p; a.ph_hi = p + 1; hipLaunchKernelGGL(mega_fwd, dim3(grid), dim3(NTHR), LDS_BYTES, stream, a); }
#else
    a.ph_lo = 0; a.ph_hi = NPHASE;
    void* kargs[] = {&a};
    hipError_t e = hipLaunchCooperativeKernel((const void*)mega_fwd, dim3(grid), dim3(NTHR), kargs, LDS_BYTES, stream);
    if (e != hipSuccess) fprintf(stderr, "kernel_launch: cooperative launch failed: %s (grid %d)\n", hipGetErrorString(e), grid);
#endif
}
```

```cpp
#include <hip/hip_runtime.h>
#include <hip/hip_cooperative_groups.h>
#include <cstdio>
#include <cstdint>
namespace cg = cooperative_groups;

#ifndef MK_PER_PHASE_LAUNCH
#define MK_PER_PHASE_LAUNCH 0
#endif

#ifndef REPEAT_MASK
#define REPEAT_MASK 0
#endif
#define REP(k) ((REPEAT_MASK >> (k)) & 1)
#ifndef TS_SEL
#define TS_SEL -1
#endif

namespace pg8 {
#define PG8_LAS __attribute__((address_space(3)))
typedef unsigned short bf16_t;
typedef short bf16x8 __attribute__((ext_vector_type(8)));
typedef float f32x4 __attribute__((ext_vector_type(4)));
typedef unsigned u32x4 __attribute__((ext_vector_type(4)));
constexpr int BM = 256, BK = 64, HALF = 128, HTB = HALF * BK * 2  , STAGE_BYTES = 8 * HTB, NXCD = 8, WGM = 8;

__host__ __device__ __forceinline__ int lds_byte(int r, int c) { const int st = (r >> 4) * 2 + (c >> 5), rr = r & 15, cc = c & 31, ob = rr * 64 + cc * 2; return st * 1024 + (ob ^ (((ob >> 9) & 1) << 5)); }
__host__ __device__ __forceinline__ void stage_rc(int b, int& R, int& C) { const int st = b / 1024, sb = b % 1024, swz = sb ^ (((sb >> 9) & 1) << 5); R = (st >> 1) * 16 + swz / 64; C = (st & 1) * 32 + (swz % 64) / 2; }
__host__ __device__ __forceinline__ int perm32(int rho) { const int n = rho >> 4, i = rho & 15; return 8 * (i >> 2) + 4 * n + (i & 3); }

struct Unit { int pm, pn; };
struct Gemm { const bf16_t* A; const bf16_t* Bt; int M, N, K; };

struct StaticOrder {
    int nM, nN, nwg, G, c;
    __host__ __device__ void init(int M, int N, int G_, int c_) { nM = M / BM; nN = N / BM; nwg = nM * nN; G = G_; c = c_; }
    __host__ __device__ bool next(int i, Unit& u) const {
        const long L = (long)i * G + c; if (L >= nwg) return false;
        int wgid = (int)L; { const int q = nwg / NXCD, r = nwg % NXCD, xcd = wgid % NXCD, off = wgid / NXCD; wgid = (xcd < r ? xcd * (q + 1) : r * (q + 1) + (xcd - r) * q) + off; }
        const int nig = WGM * nN, gid = wgid / nig, fm = gid * WGM, gsz = (nM - fm) < WGM ? (nM - fm) : WGM;
        u.pm = fm + ((wgid % nig) % gsz); u.pn = (wgid % nig) / gsz; return true;
    }
    __device__ __forceinline__ void a_ready(const Unit&) const {}
    __device__ __forceinline__ void done(const Unit&) const {}
};
__device__ __forceinline__ unsigned cvt_pk_bf16(float lo, float hi) { unsigned r; asm volatile("v_cvt_pk_bf16_f32 %0, %1, %2" : "=v"(r) : "v"(lo), "v"(hi)); return r; }
typedef float f32x2 __attribute__((ext_vector_type(2)));
__device__ __forceinline__ float bflo(unsigned u) { return __uint_as_float(u << 16); }
__device__ __forceinline__ float bfhi(unsigned u) { return __uint_as_float(u & 0xffff0000u); }
__device__ __forceinline__ float sigm(float x) { return 1.0f / (1.0f + __expf(-x)); }

struct EpiZ {
    static constexpr bool PERM = true, AFTER_DRAIN = false;
    bf16_t* O; int ldc;
    __device__ __forceinline__ void operator()(const f32x4 (&acc)[2][2][4][2], const Unit& u, int wr, int wc, int fr, int fq) const {
        const int row0 = u.pm * BM + wr * 64 + fr, col0 = u.pn * BM + wc * 32 + 8 * fq;
#pragma unroll
        for (int ai = 0; ai < 2; ++ai)
#pragma unroll
            for (int m = 0; m < 4; ++m) { bf16_t* rowp = O + (size_t)(row0 + ai * HALF + m * 16) * ldc + col0;
#pragma unroll
                for (int bj = 0; bj < 2; ++bj) { const f32x4 v0 = acc[ai][bj][m][0], v1 = acc[ai][bj][m][1];
                    u32x4 w; w.x = cvt_pk_bf16(v0[0], v0[1]); w.y = cvt_pk_bf16(v0[2], v0[3]); w.z = cvt_pk_bf16(v1[0], v1[1]); w.w = cvt_pk_bf16(v1[2], v1[3]);
                    *(u32x4*)(rowp + bj * HALF) = w; } }
    }
};
template <int MODE> struct EpiGate {
    static constexpr bool PERM = true, AFTER_DRAIN = false;
    bf16_t* O; const bf16_t* Z; int zld; int gcol;
    __device__ __forceinline__ void operator()(const f32x4 (&acc)[2][2][4][2], const Unit& u, int wr, int wc, int fr, int fq) const {
        const int row0 = u.pm * BM + wr * 64 + fr, col0 = u.pn * BM + wc * 32 + 8 * fq;
#pragma unroll
        for (int ai = 0; ai < 2; ++ai)
#pragma unroll
            for (int m = 0; m < 4; ++m) { const size_t row = (size_t)(row0 + ai * HALF + m * 16);
                bf16_t* op = O + row * 1024 + col0; const bf16_t* zp = Z + row * zld + gcol + col0;
#pragma unroll
                for (int bj = 0; bj < 2; ++bj) { const f32x4 v0 = acc[ai][bj][m][0], v1 = acc[ai][bj][m][1];
                    const u32x4 g = *(const u32x4*)(zp + bj * HALF);
                    float r0 = v0[0] * sigm(bflo(g.x)), r1 = v0[1] * sigm(bfhi(g.x)), r2 = v0[2] * sigm(bflo(g.y)), r3 = v0[3] * sigm(bfhi(g.y));
                    float r4 = v1[0] * sigm(bflo(g.z)), r5 = v1[1] * sigm(bfhi(g.z)), r6 = v1[2] * sigm(bflo(g.w)), r7 = v1[3] * sigm(bfhi(g.w));
                    if (MODE == 1) { const u32x4 p = *(const u32x4*)(op + bj * HALF);
                        r0 += bflo(p.x); r1 += bfhi(p.x); r2 += bflo(p.y); r3 += bfhi(p.y); r4 += bflo(p.z); r5 += bfhi(p.z); r6 += bflo(p.w); r7 += bfhi(p.w); }
                    u32x4 w; w.x = cvt_pk_bf16(r0, r1); w.y = cvt_pk_bf16(r2, r3); w.z = cvt_pk_bf16(r4, r5); w.w = cvt_pk_bf16(r6, r7);
                    *(u32x4*)(op + bj * HALF) = w; } }
    }
};
struct EpiRes1 {
    static constexpr bool PERM = false, AFTER_DRAIN = false;
    const float* X; bf16_t* XB; float* SS;
    __device__ __forceinline__ void operator()(const f32x4 (&acc)[2][2][4][2], const Unit& u, int wr, int wc, int fr, int fq) const {
        const int row0 = u.pm * BM + wr * 64 + fr, col0 = u.pn * BM + wc * 32 + 4 * fq;
#pragma unroll
        for (int ai = 0; ai < 2; ++ai)
#pragma unroll
            for (int m = 0; m < 4; ++m) { const size_t row = (size_t)(row0 + ai * HALF + m * 16); float ssq = 0.f;
#pragma unroll
                for (int bj = 0; bj < 2; ++bj)
#pragma unroll
                    for (int n = 0; n < 2; ++n) { const size_t off = row * 1024 + col0 + bj * HALF + n * 16;
                        const f32x4 xv = *(const f32x4*)(X + off); const f32x4 v = acc[ai][bj][m][n] + xv;
                        ssq += v[0] * v[0] + v[1] * v[1] + v[2] * v[2] + v[3] * v[3];
                        uint2 w; w.x = cvt_pk_bf16(v[0], v[1]); w.y = cvt_pk_bf16(v[2], v[3]); *(uint2*)(XB + off) = w; }
                ssq += __shfl_xor(ssq, 16); ssq += __shfl_xor(ssq, 32);
                if (fq == 0) atomicAdd(SS + row, ssq); }
    }
};
struct EpiRes2 {
    static constexpr bool PERM = false, AFTER_DRAIN = false;
    const bf16_t* XB; float* O; float* SS;
    __device__ __forceinline__ void operator()(const f32x4 (&acc)[2][2][4][2], const Unit& u, int wr, int wc, int fr, int fq) const {
        const int row0 = u.pm * BM + wr * 64 + fr, col0 = u.pn * BM + wc * 32 + 4 * fq;
#pragma unroll
        for (int ai = 0; ai < 2; ++ai)
#pragma unroll
            for (int m = 0; m < 4; ++m) { const size_t row = (size_t)(row0 + ai * HALF + m * 16); float ssq = 0.f;
#pragma unroll
                for (int bj = 0; bj < 2; ++bj)
#pragma unroll
                    for (int n = 0; n < 2; ++n) { const size_t off = row * 1024 + col0 + bj * HALF + n * 16;
                        const uint2 xw = *(const uint2*)(XB + off); f32x4 v = acc[ai][bj][m][n];
                        v[0] += bflo(xw.x); v[1] += bfhi(xw.x); v[2] += bflo(xw.y); v[3] += bfhi(xw.y);
                        *(f32x4*)(O + off) = v; ssq += v[0] * v[0] + v[1] * v[1] + v[2] * v[2] + v[3] * v[3]; }
                ssq += __shfl_xor(ssq, 16); ssq += __shfl_xor(ssq, 32);
                if (fq == 0) atomicAdd(SS + row, ssq); }
    }
};
struct EpiHid {
    static constexpr bool PERM = true, AFTER_DRAIN = false;
    bf16_t* O; const float* SS;
    __device__ __forceinline__ void operator()(const f32x4 (&acc)[2][2][4][2], const Unit& u, int wr, int wc, int fr, int fq) const {
        const int row0 = u.pm * BM + wr * 64 + fr, col0 = u.pn * BM + wc * 32 + 8 * fq;
#pragma unroll
        for (int ai = 0; ai < 2; ++ai)
#pragma unroll
            for (int m = 0; m < 4; ++m) { const size_t row = (size_t)(row0 + ai * HALF + m * 16);
                const float s2 = 1.0f / (SS[row] * (1.0f / 1024.0f) + 1e-6f);
                bf16_t* rowp = O + row * 4096 + col0;
#pragma unroll
                for (int bj = 0; bj < 2; ++bj) { f32x4 v0 = acc[ai][bj][m][0], v1 = acc[ai][bj][m][1];
#pragma unroll
                    for (int j = 0; j < 4; ++j) { float a = fmaxf(v0[j], 0.f), b = fmaxf(v1[j], 0.f); v0[j] = a * a * s2; v1[j] = b * b * s2; }
                    u32x4 w; w.x = cvt_pk_bf16(v0[0], v0[1]); w.y = cvt_pk_bf16(v0[2], v0[3]); w.z = cvt_pk_bf16(v1[0], v1[1]); w.w = cvt_pk_bf16(v1[2], v1[3]);
                    *(u32x4*)(rowp + bj * HALF) = w; } }
    }
};

template <class Epi, class Sched, bool ALIGN_EPI = false, bool SP2 = false>
__device__ __forceinline__ void gemm_phase(PG8_LAS unsigned char* lds, const Gemm g, const Sched& S, const Epi& E) {
    const int tid = threadIdx.x, wid = __builtin_amdgcn_readfirstlane(tid >> 6), lane = tid & 63, wr = wid >> 2, wc = wid & 3, fr = lane & 15, fq = lane >> 4;
    const int K = g.K, nt = K / BK;
    unsigned voffA[2], voffB[2];
#pragma unroll
    for (int i = 0; i < 2; ++i) { int R, C; stage_rc(tid * 16 + i * 8192, R, C); const int Rb = Epi::PERM ? ((R & ~31) + perm32(R & 31)) : R;
        voffA[i] = (unsigned)(R * K + C) * 2u; voffB[i] = (unsigned)(Rb * K + C) * 2u; }
    const size_t kstep = (size_t)(BK * 2);
    const size_t hstep = (size_t)HALF * K * 2;
    const size_t tstep = 2 * hstep;
    const unsigned ldsw = (unsigned)wid * 1024u;
    const int aoff = lds_byte(wr * 64 + fr, fq * 8), boff = lds_byte(wc * 32 + fr, fq * 8);
#define PG8_SA(b, h) (((b) * 2 + (h)) * HTB)
#define PG8_SB(b, h) ((4 + (b) * 2 + (h)) * HTB)
#define PG8_STAGE(bufoff, gbase, voff) do { _Pragma("unroll") for (int _i = 0; _i < 2; ++_i) \
        __builtin_amdgcn_global_load_lds((const unsigned*)((const char*)(gbase) + (voff)[_i]), (PG8_LAS unsigned*)(lds + (bufoff) + ldsw + _i * 8192), 16, 0, 0); } while (0)
#define PG8_LDA(dst, b, h) do { _Pragma("unroll") for (int m = 0; m < 4; ++m) _Pragma("unroll") for (int k = 0; k < 2; ++k) dst[m][k] = *(const PG8_LAS bf16x8*)(lds + PG8_SA(b, h) + aoff + m * 2048 + k * 1024); } while (0)
#define PG8_LDB(dst, b, h) do { _Pragma("unroll") for (int n = 0; n < 2; ++n) _Pragma("unroll") for (int k = 0; k < 2; ++k) dst[n][k] = *(const PG8_LAS bf16x8*)(lds + PG8_SB(b, h) + boff + n * 2048 + k * 1024); } while (0)
#define PG8_MMA(ai, bj, At, Bt) do { __builtin_amdgcn_s_setprio(1); _Pragma("unroll") for (int m = 0; m < 4; ++m) _Pragma("unroll") for (int n = 0; n < 2; ++n) _Pragma("unroll") for (int k = 0; k < 2; ++k) \
        acc[ai][bj][m][n] = __builtin_amdgcn_mfma_f32_16x16x32_bf16(Bt[n][k], At[m][k], acc[ai][bj][m][n], 0, 0, 0); __builtin_amdgcn_s_setprio(0); } while (0)
#define PG8_WAIT_V(n) asm volatile("s_waitcnt vmcnt(" #n ")" ::: "memory")
#define PG8_WAIT_L(n) asm volatile("s_waitcnt lgkmcnt(" #n ")" ::: "memory")
#define PG8_BAR __builtin_amdgcn_s_barrier()
#define PG8_SCHED __builtin_amdgcn_sched_barrier(0)
    Unit cur, nxt; int ui = 0;
    if (!S.next(0, cur)) return;
    f32x4 acc[2][2][4][2];
#pragma unroll
    for (int a = 0; a < 2; ++a)
#pragma unroll
        for (int b = 0; b < 2; ++b)
#pragma unroll
            for (int m = 0; m < 4; ++m)
#pragma unroll
                for (int n = 0; n < 2; ++n) acc[a][b][m][n] = (f32x4){0.f, 0.f, 0.f, 0.f};
    bf16x8 At[4][2], B0[2][2], B1[2][2];
    const char* cA = (const char*)g.A + (size_t)cur.pm * tstep; const char* cB = (const char*)g.Bt + (size_t)cur.pn * tstep;
    S.a_ready(cur);
    if constexpr (SP2) {
        PG8_STAGE(PG8_SB(0, 0), cB, voffB); PG8_STAGE(PG8_SB(0, 1), cB + hstep, voffB); PG8_STAGE(PG8_SA(0, 0), cA, voffA); PG8_STAGE(PG8_SA(0, 1), cA + hstep, voffA);
        if (wr == 1) PG8_BAR;
        PG8_WAIT_V(2); PG8_BAR;
        PG8_STAGE(PG8_SB(1, 0), cB + kstep, voffB); PG8_STAGE(PG8_SA(1, 0), cA + kstep, voffA); PG8_STAGE(PG8_SB(1, 1), cB + hstep + kstep, voffB);
        PG8_WAIT_V(6); PG8_BAR;
    } else {
        PG8_STAGE(PG8_SB(0, 0), cB, voffB); PG8_STAGE(PG8_SA(0, 0), cA, voffA); PG8_STAGE(PG8_SB(0, 1), cB + hstep, voffB); PG8_STAGE(PG8_SA(0, 1), cA + hstep, voffA);
        if (wr == 1) PG8_BAR;
        PG8_WAIT_V(4); PG8_BAR;
        PG8_STAGE(PG8_SB(1, 0), cB + kstep, voffB); PG8_STAGE(PG8_SA(1, 0), cA + kstep, voffA); PG8_STAGE(PG8_SB(1, 1), cB + hstep + kstep, voffB);
        PG8_WAIT_V(6); PG8_BAR;
    }
    for (;;) {
        const bool has_next = S.next(ui + 1, nxt);
        const char* nA = has_next ? (const char*)g.A + (size_t)nxt.pm * tstep : cA; const char* nB = has_next ? (const char*)g.Bt + (size_t)nxt.pn * tstep : cB;
        for (int t = 0; t < nt; t += 2) {
            const bool last = (t == nt - 2);
            const char* a1 = cA + (size_t)(t + 1) * kstep;
            const char* a2 = last ? nA : cA + (size_t)(t + 2) * kstep; const char* b2 = last ? nB : cB + (size_t)(t + 2) * kstep;
            const char* a3 = a2 + kstep; const char* b3 = b2 + kstep;
            if (last && has_next) S.a_ready(nxt);
            if constexpr (SP2) {
            PG8_LDB(B0, 0, 0); PG8_LDB(B1, 0, 1); PG8_SCHED; PG8_LDA(At, 0, 0); PG8_STAGE(PG8_SA(1, 1), a1 + hstep, voffA);
            PG8_WAIT_V(8); PG8_WAIT_L(0); PG8_BAR; PG8_MMA(0, 0, At, B0); PG8_MMA(0, 1, At, B1); PG8_BAR; PG8_SCHED;
            PG8_LDA(At, 0, 1); PG8_STAGE(PG8_SB(0, 0), b2, voffB); PG8_STAGE(PG8_SB(0, 1), b2 + hstep, voffB); PG8_STAGE(PG8_SA(0, 0), a2, voffA);
            PG8_WAIT_V(8); PG8_WAIT_L(0); PG8_BAR; PG8_MMA(1, 0, At, B0); PG8_MMA(1, 1, At, B1); PG8_BAR; PG8_SCHED;
            PG8_LDB(B0, 1, 0); PG8_LDB(B1, 1, 1); PG8_SCHED; PG8_LDA(At, 1, 0); PG8_STAGE(PG8_SA(0, 1), a2 + hstep, voffA);
            PG8_WAIT_V(8); PG8_WAIT_L(0); PG8_BAR; PG8_MMA(0, 0, At, B0); PG8_MMA(0, 1, At, B1); PG8_BAR; PG8_SCHED;
            PG8_LDA(At, 1, 1); PG8_STAGE(PG8_SB(1, 0), b3, voffB); PG8_STAGE(PG8_SB(1, 1), b3 + hstep, voffB); PG8_STAGE(PG8_SA(1, 0), a3, voffA);
            PG8_WAIT_V(8); PG8_WAIT_L(0); PG8_BAR; PG8_MMA(1, 0, At, B0); PG8_MMA(1, 1, At, B1); PG8_BAR; PG8_SCHED;
            } else {
            PG8_LDB(B0, 0, 0); PG8_SCHED; PG8_LDA(At, 0, 0); PG8_STAGE(PG8_SA(1, 1), a1 + hstep, voffA);
            PG8_WAIT_L(8); PG8_BAR; PG8_WAIT_L(0); PG8_MMA(0, 0, At, B0); PG8_BAR; PG8_SCHED;
            PG8_LDB(B1, 0, 1); PG8_STAGE(PG8_SB(0, 0), b2, voffB);
            PG8_BAR; PG8_WAIT_L(0); PG8_MMA(0, 1, At, B1); PG8_BAR;
            PG8_LDA(At, 0, 1); PG8_STAGE(PG8_SA(0, 0), a2, voffA);
            PG8_BAR; PG8_WAIT_L(0); PG8_MMA(1, 0, At, B0); PG8_BAR; PG8_SCHED;
            PG8_STAGE(PG8_SB(0, 1), b2 + hstep, voffB);
            PG8_WAIT_V(6); PG8_BAR; PG8_MMA(1, 1, At, B1); PG8_BAR;
            PG8_LDB(B0, 1, 0); PG8_SCHED; PG8_LDA(At, 1, 0); PG8_STAGE(PG8_SA(0, 1), a2 + hstep, voffA);
            PG8_WAIT_L(8); PG8_BAR; PG8_WAIT_L(0); PG8_MMA(0, 0, At, B0); PG8_BAR; PG8_SCHED;
            PG8_LDB(B1, 1, 1); PG8_STAGE(PG8_SB(1, 0), b3, voffB);
            PG8_BAR; PG8_WAIT_L(0); PG8_MMA(0, 1, At, B1); PG8_BAR;
            PG8_LDA(At, 1, 1); PG8_STAGE(PG8_SA(1, 0), a3, voffA);
            PG8_BAR; PG8_WAIT_L(0); PG8_MMA(1, 0, At, B0); PG8_BAR; PG8_SCHED;
            PG8_STAGE(PG8_SB(1, 1), b3 + hstep, voffB);
            PG8_WAIT_V(6); PG8_BAR; PG8_MMA(1, 1, At, B1); PG8_BAR;
            }
        }
        if constexpr (ALIGN_EPI) { if (wr == 0) PG8_BAR; }
        if constexpr (!Epi::AFTER_DRAIN) { E(acc, cur, wr, wc, fr, fq); S.done(cur); }
        if (!has_next) break;
#pragma unroll
        for (int a = 0; a < 2; ++a)
#pragma unroll
            for (int b = 0; b < 2; ++b)
#pragma unroll
                for (int m = 0; m < 4; ++m)
#pragma unroll
                    for (int n = 0; n < 2; ++n) acc[a][b][m][n] = (f32x4){0.f, 0.f, 0.f, 0.f};
        cur = nxt; cA = nA; cB = nB; ++ui;
        if constexpr (ALIGN_EPI) { if (wr == 1) PG8_BAR; }
    }
    PG8_WAIT_V(0);
    if constexpr (!ALIGN_EPI) { if (wr == 0) PG8_BAR; }
    PG8_BAR;
    if constexpr (Epi::AFTER_DRAIN) { E.fused(acc, cur, wr, wc, fr, fq, lds, wid, lane); S.done(cur); }
#undef PG8_SA
#undef PG8_SB
#undef PG8_STAGE
#undef PG8_LDA
#undef PG8_LDB
#undef PG8_MMA
#undef PG8_WAIT_V
#undef PG8_WAIT_L
#undef PG8_BAR
#undef PG8_SCHED
}
}
extern __shared__ __attribute__((aligned(16))) unsigned char g_lds[];
using pg8::bf16_t; using pg8::bf16x8; using pg8::f32x4; using pg8::u32x4; using pg8::cvt_pk_bf16; using pg8::bflo; using pg8::bfhi; using pg8::sigm;

constexpr int NTOK = 32768, DM = 1024, SEQ = 2048, NB = 16, ZLD = 5120, NTHR = 512;
constexpr int C_R = 0, C_K = 512, C_V = 1024, C_WD = 1536, C_AD = 1600, C_GD = 1664;
constexpr int C_Q = 1824, C_KA = 2336, C_VA = 2400, C_QI = 2464, C_KI = 2976, C_WI = 3040, C_G0 = 3048, C_G1 = 4072;
constexpr size_t MiB = 1024 * 1024;
constexpr size_t WS_SS1 = 0, WS_SS2 = 128 * 1024, WS_BONUS = 256 * 1024, WS_ROPE = 1280 * 1024, WS_WD = 1792 * 1024, WS_WI = 1856 * 1024, WS_WG = 1920 * 1024;
constexpr size_t WS_WIN = 4 * MiB, WS_WUP = 14 * MiB, WS_WDN = 22 * MiB, WS_WB = 30 * MiB, WS_WO = 32 * MiB, WS_VT = 34 * MiB, WS_H = 38 * MiB, WS_Z = 102 * MiB, WS_P = 422 * MiB, WS_END = 486 * MiB;
constexpr int LDS_BYTES = 163840;

struct Args { const float* in[20]; float* out; unsigned char* ws; int ph_lo, ph_hi; };

struct Frame {
    const float* in[20]; float* out; unsigned char* ws; unsigned char* lds; int tid, lane, wave;
    float *ss1, *ss2, *bonus; float2* rope; bf16_t *wd, *wi, *wg, *win, *wup, *wdn, *wb, *wo, *vt, *h, *ya, *yb, *xb, *z, *hid, *lw, *ic, *mg, *gt; float* yraw;
};

__device__ __forceinline__ bf16_t f2bf(float f) { return (bf16_t)(cvt_pk_bf16(f, 0.f) & 0xffffu); }
__device__ __forceinline__ float bf2f(bf16_t b) { return __uint_as_float(((unsigned)b) << 16); }
template <int CTRL> __device__ __forceinline__ float dpp_mov(float x) { return __int_as_float(__builtin_amdgcn_update_dpp(0, __float_as_int(x), CTRL, 0xF, 0xF, true)); }
__device__ __forceinline__ float red16(float x) { x += dpp_mov<0xB1>(x); x += dpp_mov<0x4E>(x); x += dpp_mov<0x141>(x); x += dpp_mov<0x140>(x); return x; }


__device__ __forceinline__ void lds_barrier() { asm volatile("s_waitcnt lgkmcnt(0)" ::: "memory"); __builtin_amdgcn_s_barrier(); asm volatile("" ::: "memory"); }
__device__ __forceinline__ void red16x4(float& a, float& b, float& c, float& d) {
#define DPP4(ctl) "v_add_f32_dpp %0, %0, %0 " ctl " row_mask:0xf bank_mask:0xf bound_ctrl:1\n" "v_add_f32_dpp %1, %1, %1 " ctl " row_mask:0xf bank_mask:0xf bound_ctrl:1\n" \
                  "v_add_f32_dpp %2, %2, %2 " ctl " row_mask:0xf bank_mask:0xf bound_ctrl:1\n" "v_add_f32_dpp %3, %3, %3 " ctl " row_mask:0xf bank_mask:0xf bound_ctrl:1\n"
    asm volatile("s_nop 1\n" DPP4("quad_perm:[1,0,3,2]") DPP4("quad_perm:[2,3,0,1]") DPP4("row_half_mirror") DPP4("row_mirror") : "+v"(a), "+v"(b), "+v"(c), "+v"(d));
#undef DPP4
}
__device__ __forceinline__ float red32(float x) { x += __shfl_xor(x, 1); x += __shfl_xor(x, 2); x += __shfl_xor(x, 4); x += __shfl_xor(x, 8); x += __shfl_xor(x, 16); return x; }
__device__ __forceinline__ float red64(float x) { x = red32(x); x += __shfl_xor(x, 32); return x; }
__device__ __forceinline__ float softplus_f(float x) { return fmaxf(x, 0.f) + log1pf(__expf(-fabsf(x))); }

__device__ __forceinline__ void tconv(const Frame& F, const float* __restrict__ W, int K, int N, int Npad, bf16_t* __restrict__ Wt, const float* __restrict__ rs) {
    float* tile = (float*)g_lds;
    const int ktn = (K + 63) / 64, ntn = Npad / 64, tid = F.tid;
    for (int tl = blockIdx.x; tl < ktn * ntn; tl += gridDim.x) {
        const int kt = tl % ktn, nt = tl / ktn;
#pragma unroll
        for (int i = 0; i < 2; ++i) { const int idx = tid + i * NTHR, kk = idx >> 4, n4 = (idx & 15) * 4, k = kt * 64 + kk, n = nt * 64 + n4;
            f32x4 v = {0.f, 0.f, 0.f, 0.f};
            if (k < K) { if (n + 3 < N) v = *(const f32x4*)(W + (size_t)k * N + n); else { for (int j = 0; j < 4; ++j) if (n + j < N) v[j] = W[(size_t)k * N + n + j]; }
                if (rs != nullptr) { const float r = rs[k]; v[0] *= r; v[1] *= r; v[2] *= r; v[3] *= r; } }
            tile[kk * 65 + n4] = v[0]; tile[kk * 65 + n4 + 1] = v[1]; tile[kk * 65 + n4 + 2] = v[2]; tile[kk * 65 + n4 + 3] = v[3]; }
        __syncthreads();
        { const int nn = tid >> 3, k8 = (tid & 7) * 8, k = kt * 64 + k8, n = nt * 64 + nn;
          if (k < K) { u32x4 w; const float* tp = tile + k8 * 65 + nn;
              w.x = cvt_pk_bf16(tp[0], tp[65]); w.y = cvt_pk_bf16(tp[130], tp[195]); w.z = cvt_pk_bf16(tp[260], tp[325]); w.w = cvt_pk_bf16(tp[390], tp[455]);
              *(u32x4*)(Wt + (size_t)n * K + k) = w; } }
        __syncthreads();
    }
}
__device__ __forceinline__ void p0_prologue(const Frame& F) {
    const int tid = F.tid, gtid = blockIdx.x * NTHR + tid, gn = gridDim.x * NTHR;
    for (int i = gtid; i < 2 * NTOK; i += gn) F.ss1[i] = 0.f;
    for (int i = gtid; i < SEQ * 32; i += gn) { const int pos = i >> 5, j = i & 31;
        const float inv = 1.0f / powf(10000.0f, (float)(2 * j) / 64.0f); const float ang = (float)pos * inv;
        double rev = (double)ang * 0.15915494309189535; rev -= floor(rev); const float fr = (float)rev;
        F.rope[i] = make_float2(__builtin_amdgcn_cosf(fr), __builtin_amdgcn_sinf(fr)); }
    tconv(F, F.in[2], 1024, 5096, 5120, F.win, nullptr);
    tconv(F, F.in[17], 1024, 4096, 4096, F.wup, F.in[16]);
    tconv(F, F.in[18], 4096, 1024, 1024, F.wdn, nullptr);
    tconv(F, F.in[14], 512, 1024, 1024, F.wb, nullptr);
    tconv(F, F.in[14] + 512 * 1024, 512, 1024, 1024, F.wb + 1024 * 512, nullptr);
    tconv(F, F.in[15], 1024, 1024, 1024, F.wo, nullptr);
    tconv(F, F.in[5], 64, 512, 512, F.wd, nullptr);
    tconv(F, F.in[7], 64, 512, 512, F.wi, nullptr);
    tconv(F, F.in[8], 160, 512, 512, F.wg, nullptr);
    const float* x = F.in[0]; const float* g = F.in[1]; const int lane = F.lane;
    for (int row = blockIdx.x * 8 + F.wave; row < NTOK; row += gridDim.x * 8) {
        const float* xr = x + (size_t)row * DM; f32x4 v[4]; float ss = 0.f;
#pragma unroll
        for (int i = 0; i < 4; ++i) { v[i] = *(const f32x4*)(xr + i * 256 + lane * 4); ss += v[i][0] * v[i][0] + v[i][1] * v[i][1] + v[i][2] * v[i][2] + v[i][3] * v[i][3]; }
        ss = red64(ss); const float sc = rsqrtf(ss * (1.0f / 1024.0f) + 1e-6f);
#pragma unroll
        for (int i = 0; i < 4; ++i) { const f32x4 gg = *(const f32x4*)(g + i * 256 + lane * 4); uint2 w;
            w.x = cvt_pk_bf16(v[i][0] * sc * gg[0], v[i][1] * sc * gg[1]); w.y = cvt_pk_bf16(v[i][2] * sc * gg[2], v[i][3] * sc * gg[3]);
            *(uint2*)(F.h + (size_t)row * DM + i * 256 + lane * 4) = w; }
    }
}

__device__ __forceinline__ void p2_prep(const Frame& F, const int mode) {
    const int tid = F.tid, lane = F.lane, wave = F.wave, fr = lane & 15, fq = lane >> 4;
    bf16_t* z = F.z; const float* mu = F.in[3];
    if (mode != 2) {
        constexpr int LDA = 296, TT = 32; bf16_t* At = (bf16_t*)g_lds;
        bf16_t* Ot = At + TT * LDA;
        const float* dbias = F.in[4]; const float* ibias = F.in[6];
        for (int tile = blockIdx.x; tile < NTOK / TT; tile += gridDim.x) {
            const int t0 = tile * TT;
            for (int idx = tid; idx < TT * 36; idx += NTHR) { const int tok = idx / 36, c8 = (idx - tok * 36) * 8, t = t0 + tok, col = C_WD + c8;
                const u32x4 zc = *(const u32x4*)(z + (size_t)t * ZLD + col); u32x4 zp = {0u, 0u, 0u, 0u}; if (t & (SEQ - 1)) zp = *(const u32x4*)(z + (size_t)(t - 1) * ZLD + col);
                const f32x4 m0 = *(const f32x4*)(mu + col), m1 = *(const f32x4*)(mu + col + 4);
                float v[8]; const unsigned zcu[4] = {zc.x, zc.y, zc.z, zc.w}, zpu[4] = {zp.x, zp.y, zp.z, zp.w};
#pragma unroll
                for (int j = 0; j < 4; ++j) { const float a = bflo(zcu[j]), b2 = bfhi(zcu[j]), pa = bflo(zpu[j]), pb = bfhi(zpu[j]);
                    const float mm0 = (j < 2) ? m0[2 * j] : m1[2 * j - 4], mm1 = (j < 2) ? m0[2 * j + 1] : m1[2 * j - 3];
                    v[2 * j] = a + (pa - a) * mm0; v[2 * j + 1] = b2 + (pb - b2) * mm1; }
                if (c8 < 64) {
#pragma unroll
                    for (int j = 0; j < 8; ++j) v[j] = tanhf(v[j]); }
                else if (c8 >= 128) {
#pragma unroll
                    for (int j = 0; j < 8; ++j) v[j] = sigm(v[j]); }
                u32x4 w; w.x = cvt_pk_bf16(v[0], v[1]); w.y = cvt_pk_bf16(v[2], v[3]); w.z = cvt_pk_bf16(v[4], v[5]); w.w = cvt_pk_bf16(v[6], v[7]);
                *(u32x4*)(At + tok * LDA + c8) = w; }
            __syncthreads();
            const int h = wave;
            bf16x8 Bc[9], Bn[9];
            { const int n = h * 64 + fr;
#pragma unroll
              for (int ks = 0; ks < 2; ++ks) { Bc[ks] = *(const bf16x8*)(F.wd + n * 64 + ks * 32 + fq * 8); Bc[2 + ks] = *(const bf16x8*)(F.wi + n * 64 + ks * 32 + fq * 8); }
#pragma unroll
              for (int ks = 0; ks < 5; ++ks) Bc[4 + ks] = *(const bf16x8*)(F.wg + n * 160 + ks * 32 + fq * 8); }
#pragma unroll 1
            for (int j = 0; j < 4; ++j) { const int n = h * 64 + j * 16 + fr;
                if (j < 3) { const int nn = n + 16;
#pragma unroll
                    for (int ks = 0; ks < 2; ++ks) { Bn[ks] = *(const bf16x8*)(F.wd + nn * 64 + ks * 32 + fq * 8); Bn[2 + ks] = *(const bf16x8*)(F.wi + nn * 64 + ks * 32 + fq * 8); }
#pragma unroll
                    for (int ks = 0; ks < 5; ++ks) Bn[4 + ks] = *(const bf16x8*)(F.wg + nn * 160 + ks * 32 + fq * 8); }
                const float db = dbias[n], ib = ibias[n];
#pragma unroll
                for (int mt = 0; mt < 2; ++mt) {
                    f32x4 ad = {0.f, 0.f, 0.f, 0.f}, ai = ad, ag = ad; const bf16_t* ap = At + (mt * 16 + fr) * LDA + fq * 8;
#pragma unroll
                    for (int ks = 0; ks < 2; ++ks) ad = __builtin_amdgcn_mfma_f32_16x16x32_bf16(*(const bf16x8*)(ap + ks * 32), Bc[ks], ad, 0, 0, 0);
#pragma unroll
                    for (int ks = 0; ks < 2; ++ks) ai = __builtin_amdgcn_mfma_f32_16x16x32_bf16(*(const bf16x8*)(ap + 64 + ks * 32), Bc[2 + ks], ai, 0, 0, 0);
#pragma unroll
                    for (int ks = 0; ks < 5; ++ks) ag = __builtin_amdgcn_mfma_f32_16x16x32_bf16(*(const bf16x8*)(ap + 128 + ks * 32), Bc[4 + ks], ag, 0, 0, 0);
#pragma unroll
                    for (int jj = 0; jj < 4; ++jj) {
                        const float dw = db + ad[jj]; const float wlog = -softplus_f(-dw) - 0.5f; const float lwv = -__expf(wlog);
                        const int tk = mt * 16 + fq * 4 + jj; Ot[tk * 520 + n] = f2bf(lwv); Ot[(TT + tk) * 520 + n] = f2bf(sigm(ib + ai[jj])); Ot[(2 * TT + tk) * 520 + n] = f2bf(ag[jj]); }
                }
#pragma unroll
                for (int q = 0; q < 9; ++q) Bc[q] = Bn[q];
            }
            __syncthreads();
#pragma unroll
            for (int i = 0; i < 12; ++i) { const int idx = tid + i * NTHR, arr = idx >> 11, rem = idx & 2047, tk = rem >> 6, c8 = (rem & 63) * 8;
                const u32x4 w = *(const u32x4*)(Ot + (arr * TT + tk) * 520 + c8); bf16_t* dst = arr == 0 ? F.lw : (arr == 1 ? F.ic : F.gt);
                *(u32x4*)(dst + (size_t)(t0 + tk) * 512 + c8) = w; }
            __syncthreads();
        }
    }
    if (mode != 2) {
        unsigned short* tl = (unsigned short*)g_lds;
        for (int tile = blockIdx.x; tile < NTOK / 64; tile += gridDim.x) { const int t0 = tile * 64, b = t0 / SEQ, tt0 = t0 % SEQ;
            { const int tok = tid >> 3, d8 = (tid & 7) * 8; *(u32x4*)(tl + tok * 72 + d8) = *(const u32x4*)(z + (size_t)(t0 + tok) * ZLD + C_VA + d8); }
            __syncthreads();
            { const int d = tid >> 3, k8 = (tid & 7) * 8; unsigned short e[8];
#pragma unroll
              for (int j = 0; j < 8; ++j) e[j] = tl[(k8 + j) * 72 + d];
              u32x4 w; w.x = e[0] | ((unsigned)e[1] << 16); w.y = e[2] | ((unsigned)e[3] << 16); w.z = e[4] | ((unsigned)e[5] << 16); w.w = e[6] | ((unsigned)e[7] << 16);
              *(u32x4*)(F.vt + ((size_t)b * 64 + d) * SEQ + tt0 + k8) = w; }
            __syncthreads();
        }
    }
    if (mode != 0) {
        const int gtid = blockIdx.x * NTHR + tid, gn = gridDim.x * NTHR;
        for (int idx = gtid; idx < NTOK * 72; idx += gn) { const int t = idx / 72, p = idx - t * 72, hd = p >> 2, i8 = (p & 3) * 8;
            const int base = hd < 8 ? C_Q + hd * 64 : (hd == 8 ? C_KA : (hd < 17 ? C_QI + (hd - 9) * 64 : C_KI));
            const float* rp = (const float*)&F.rope[(t & (SEQ - 1)) * 32 + i8];
            f32x4 cs[4];
#pragma unroll
            for (int j = 0; j < 4; ++j) { cs[j] = *(const f32x4*)(rp + 4 * j); if (mode == 2) cs[j] = (f32x4){1.f, 0.f, 1.f, 0.f}; }
            bf16_t* p1 = z + (size_t)t * ZLD + base + i8; const u32x4 a = *(const u32x4*)(p1), b2 = *(const u32x4*)(p1 + 32);
            const unsigned au[4] = {a.x, a.y, a.z, a.w}, bu[4] = {b2.x, b2.y, b2.z, b2.w}; unsigned o1[4], o2[4];
#pragma unroll
            for (int j = 0; j < 4; ++j) { const float x1a = bflo(au[j]), x1b = bfhi(au[j]), x2a = bflo(bu[j]), x2b = bfhi(bu[j]);
                o1[j] = cvt_pk_bf16(x1a * cs[j][0] - x2a * cs[j][1], x1b * cs[j][2] - x2b * cs[j][3]);
                o2[j] = cvt_pk_bf16(x2a * cs[j][0] + x1a * cs[j][1], x2b * cs[j][2] + x1b * cs[j][3]); }
            u32x4 w1, w2; w1.x = o1[0]; w1.y = o1[1]; w1.z = o1[2]; w1.w = o1[3]; w2.x = o2[0]; w2.y = o2[1]; w2.z = o2[2]; w2.w = o2[3];
            *(u32x4*)(p1) = w1; *(u32x4*)(p1 + 32) = w2; }
    }
}

struct ScanRaw { uint2 zr_c, zr_p, zk_c, zk_p, zv_c, zv_p, lwu, icu; };
struct ScanConst { f32x4 mur, muk, muv, kk, ka, rk; };
__device__ __forceinline__ void scan_load(ScanRaw& R, const bf16_t* z, const bf16_t* lw, const bf16_t* ic, size_t tokbase, int ch, int ptok, int gc) {
    const int t = ch * 16 + ptok; const size_t T = tokbase + t; const bf16_t* zp = z + T * ZLD + gc;
    R.zr_c = *(const uint2*)(zp + C_R); R.zk_c = *(const uint2*)(zp + C_K); R.zv_c = *(const uint2*)(zp + C_V);
    const uint2 zz = make_uint2(0u, 0u);
    if (t > 0) { R.zr_p = *(const uint2*)(zp - ZLD + C_R); R.zk_p = *(const uint2*)(zp - ZLD + C_K); R.zv_p = *(const uint2*)(zp - ZLD + C_V); } else { R.zr_p = zz; R.zk_p = zz; R.zv_p = zz; }
    R.lwu = *(const uint2*)(lw + T * 512 + gc); R.icu = *(const uint2*)(ic + T * 512 + gc);
}
__device__ __forceinline__ f32x4 unpack4(uint2 u) { f32x4 r; r[0] = bflo(u.x); r[1] = bfhi(u.x); r[2] = bflo(u.y); r[3] = bfhi(u.y); return r; }
__device__ __forceinline__ void scan_prep(const ScanRaw& R, const ScanConst& C, float* ops, float* vv, float* bonus_out, bool wr_bonus, int ptok, int pc, int v0) {
    const f32x4 rc = unpack4(R.zr_c), rp = unpack4(R.zr_p), kc = unpack4(R.zk_c), kp = unpack4(R.zk_p), vc = unpack4(R.zv_c), vp = unpack4(R.zv_p), ic = unpack4(R.icu), lw = unpack4(R.lwu);
    const f32x4 r = rc + (rp - rc) * C.mur, k = kc + (kp - kc) * C.muk, vs = vc + (vp - vc) * C.muv;
    f32x4 w; w[0] = __expf(lw[0]); w[1] = __expf(lw[1]); w[2] = __expf(lw[2]); w[3] = __expf(lw[3]);
    const f32x4 q = k * C.kk; const float ss = red16((q[0] * q[0] + q[1] * q[1]) + (q[2] * q[2] + q[3] * q[3]));
    const float inv = 1.0f / fmaxf(sqrtf(ss), 1e-12f); const f32x4 n = q * inv;
    const f32x4 kn = k * (1.0f + (ic - 1.0f) * C.ka);
    const f32x4 bt = r * kn * C.rk; const float bon = red16((bt[0] + bt[1]) + (bt[2] + bt[3]));
    if (wr_bonus) *bonus_out = bon;
    float* op = ops + ptok * 320 + pc;
    *(f32x4*)(op) = -n; *(f32x4*)(op + 64) = w; *(f32x4*)(op + 128) = n * ic; *(f32x4*)(op + 192) = kn; *(f32x4*)(op + 256) = r;
    if (pc >= v0 && pc < v0 + 32) *(f32x4*)(vv + ptok * 32 + pc - v0) = vs;
}
__device__ __forceinline__ void p3_scan(const Frame& F, const int mode) {
    const int tid = F.tid;
    float* opsb = (float*)g_lds;
    float* vvb = opsb + 2 * 5120;
    float* yob = vvb + 2 * 512;
    const bf16_t* z = F.z; const float* mu = F.in[3]; const float* k_k = F.in[9]; const float* k_a = F.in[10]; const float* r_k = F.in[11];
    for (int item = blockIdx.x; item < 256; item += gridDim.x) {
        const int bh = item >> 1, half = item & 1, b = bh >> 3, h = bh & 7, v0 = half * 32;
        const size_t tokbase = (size_t)b * SEQ;
        if (F.wave >= 4) {
            const int pt = tid - 256, ptok = pt >> 4, pc = (pt & 15) * 4, gc = h * 64 + pc;
            ScanConst C; C.mur = *(const f32x4*)(mu + C_R + gc); C.muk = *(const f32x4*)(mu + C_K + gc); C.muv = *(const f32x4*)(mu + C_V + gc);
            C.kk = *(const f32x4*)(k_k + gc); C.ka = *(const f32x4*)(k_a + gc); C.rk = *(const f32x4*)(r_k + gc);
            const bool wrb = (half == 0) && ((pt & 15) == 0);
            ScanRaw R;
            scan_load(R, z, F.lw, F.ic, tokbase, 0, ptok, gc);
            scan_prep(R, C, opsb, vvb, F.bonus + (tokbase + ptok) * 8 + h, wrb, ptok, pc, v0);
            scan_load(R, z, F.lw, F.ic, tokbase, 1, ptok, gc);
            lds_barrier();
            for (int ch = 0; ch < SEQ / 16; ++ch) {
                const int cur = ch & 1, nxt = cur ^ 1;
                if (mode != 2) {
                if (ch > 0) { const int tok = pt >> 4, r2 = (pt & 15) * 2;
                    *(float2*)(F.yraw + (tokbase + (ch - 1) * 16 + tok) * 512 + h * 64 + v0 + r2) = *(const float2*)(yob + nxt * 512 + tok * 32 + r2); }
                if (ch + 1 < SEQ / 16) {
                    scan_prep(R, C, opsb + nxt * 5120, vvb + nxt * 512, F.bonus + (tokbase + (ch + 1) * 16 + ptok) * 8 + h, wrb, ptok, pc, v0);
                    if (ch + 2 < SEQ / 16) scan_load(R, z, F.lw, F.ic, tokbase, ch + 2, ptok, gc);
                } }
                lds_barrier();
            }
            { const int tok = pt >> 4, r2 = (pt & 15) * 2;
              *(float2*)(F.yraw + (tokbase + (SEQ / 16 - 1) * 16 + tok) * 512 + h * 64 + v0 + r2) = *(const float2*)(yob + 512 + tok * 32 + r2); }
        } else {
            const int rp = tid >> 4, ks = tid & 15;
            float A0 = 0.f, A1 = 0.f, A2 = 0.f, A3 = 0.f, B0 = 0.f, B1 = 0.f, B2 = 0.f, B3 = 0.f;
            const int ywoff = (ks == 0) ? 2 * rp : (2 * 512 + 2 * tid), ywstep = (ks == 0) ? 32 : 0;
            lds_barrier();
            f32x4 rprev = {0.f, 0.f, 0.f, 0.f}; float* ywp = yob + 2 * 512 + 2 * tid;
            for (int ch = 0; ch < SEQ / 16; ++ch) {
                const int cur = ch & 1;
                const float* ops = opsb + cur * 5120 + ks * 4; const float* vv = vvb + cur * 512 + 2 * rp; float* yw = yob + cur * 512 + ywoff;
                if (mode != 1) {
#pragma unroll
                for (int s = 0; s < 16; ++s) {
                    const float* o = ops + s * 320;
                    const f32x4 a4 = *(const f32x4*)(o), w4 = *(const f32x4*)(o + 64), b4 = *(const f32x4*)(o + 128), k4 = *(const f32x4*)(o + 192), r4 = *(const f32x4*)(o + 256);
                    const float2 vab = *(const float2*)(vv + s * 32);
                    float sa = (A0 * a4[0] + A1 * a4[1]) + (A2 * a4[2] + A3 * a4[3]); float sb = (B0 * a4[0] + B1 * a4[1]) + (B2 * a4[2] + B3 * a4[3]);
                    float ya = (A0 * rprev[0] + A1 * rprev[1]) + (A2 * rprev[2] + A3 * rprev[3]); float yb2 = (B0 * rprev[0] + B1 * rprev[1]) + (B2 * rprev[2] + B3 * rprev[3]);
                    red16x4(sa, sb, ya, yb2);
                    *(float2*)(ywp) = make_float2(ya, yb2);
                    ywp = yw + s * ywstep;
                    A0 = A0 * w4[0] + sa * b4[0] + vab.x * k4[0]; A1 = A1 * w4[1] + sa * b4[1] + vab.x * k4[1];
                    A2 = A2 * w4[2] + sa * b4[2] + vab.x * k4[2]; A3 = A3 * w4[3] + sa * b4[3] + vab.x * k4[3];
                    B0 = B0 * w4[0] + sb * b4[0] + vab.y * k4[0]; B1 = B1 * w4[1] + sb * b4[1] + vab.y * k4[1];
                    B2 = B2 * w4[2] + sb * b4[2] + vab.y * k4[2]; B3 = B3 * w4[3] + sb * b4[3] + vab.y * k4[3];
                    rprev = r4;
                }
                {
                    float ya = (A0 * rprev[0] + A1 * rprev[1]) + (A2 * rprev[2] + A3 * rprev[3]); float yb2 = (B0 * rprev[0] + B1 * rprev[1]) + (B2 * rprev[2] + B3 * rprev[3]);
                    float d0 = 0.f, d1 = 0.f; red16x4(ya, yb2, d0, d1);
                    *(float2*)(ywp) = make_float2(ya, yb2); ywp = yob + 2 * 512 + 2 * tid; rprev = (f32x4){0.f, 0.f, 0.f, 0.f};
                } }
                lds_barrier();
            }
        }
        __syncthreads();
    }
}

__device__ __forceinline__ unsigned ordkey(float f) { const unsigned u = __float_as_uint(f); return (u & 0x80000000u) ? ~u : (u | 0x80000000u); }

__device__ __forceinline__ void attn_chunk(const unsigned char* kb, const unsigned char* vb, const unsigned* selm, int c, int p, int fr, int fq, const bf16x8 (&Bqa)[2][2], f32x4 (&O)[2][4], f32x4 (&RS)[2]) {
    const f32x4 zero4 = {0.f, 0.f, 0.f, 0.f};
    const u32x4 onesu = {0x3f803f80u, 0x3f803f80u, 0x3f803f80u, 0x3f803f80u}; const bf16x8 ones = __builtin_bit_cast(bf16x8, onesu);
    const float csc = 0.125f * 1.4426950408889634f;
    const unsigned char* k0p = kb + ((2 * p) * 16 + fr) * 144 + fq * 16; const unsigned char* k1p = k0p + 16 * 144;
    const bf16x8 KA00 = *(const bf16x8*)(k0p), KA01 = *(const bf16x8*)(k0p + 64), KA10 = *(const bf16x8*)(k1p), KA11 = *(const bf16x8*)(k1p + 64);
    const int mw = (int)selm[fr * 64 + 2 * c + p];
    bf16x8 VA[4];
#pragma unroll
    for (int dt = 0; dt < 4; ++dt) { const unsigned char* vp = vb + (dt * 16 + fr) * 144 + (2 * p) * 32 + fq * 8;
        const uint2 lo = *(const uint2*)(vp), hi = *(const uint2*)(vp + 32);
        u32x4 va; va.x = lo.x; va.y = lo.y; va.z = hi.x; va.w = hi.y; VA[dt] = __builtin_bit_cast(bf16x8, va); }
    unsigned km0[4], km1[4];
#pragma unroll
    for (int jj = 0; jj < 4; ++jj) { km0[jj] = (unsigned)__builtin_amdgcn_sbfe(mw, fq * 4 + jj, 1); km1[jj] = (unsigned)__builtin_amdgcn_sbfe(mw, 16 + fq * 4 + jj, 1); }
#pragma unroll
    for (int hh = 0; hh < 2; ++hh) {
        f32x4 s0 = __builtin_amdgcn_mfma_f32_16x16x32_bf16(KA00, Bqa[hh][0], zero4, 0, 0, 0); s0 = __builtin_amdgcn_mfma_f32_16x16x32_bf16(KA01, Bqa[hh][1], s0, 0, 0, 0);
        f32x4 s1 = __builtin_amdgcn_mfma_f32_16x16x32_bf16(KA10, Bqa[hh][0], zero4, 0, 0, 0); s1 = __builtin_amdgcn_mfma_f32_16x16x32_bf16(KA11, Bqa[hh][1], s1, 0, 0, 0);
        unsigned p0[4], p1[4];
#pragma unroll
        for (int jj = 0; jj < 4; ++jj) {
            p0[jj] = __float_as_uint(__builtin_amdgcn_exp2f(fminf(s0[jj] * csc, 86.f))) & km0[jj]; p1[jj] = __float_as_uint(__builtin_amdgcn_exp2f(fminf(s1[jj] * csc, 86.f))) & km1[jj]; }
        u32x4 pk; pk.x = cvt_pk_bf16(__uint_as_float(p0[0]), __uint_as_float(p0[1])); pk.y = cvt_pk_bf16(__uint_as_float(p0[2]), __uint_as_float(p0[3]));
        pk.z = cvt_pk_bf16(__uint_as_float(p1[0]), __uint_as_float(p1[1])); pk.w = cvt_pk_bf16(__uint_as_float(p1[2]), __uint_as_float(p1[3]));
        const bf16x8 PB = __builtin_bit_cast(bf16x8, pk);
        RS[hh] = __builtin_amdgcn_mfma_f32_16x16x32_bf16(ones, PB, RS[hh], 0, 0, 0);
#pragma unroll
        for (int dt = 0; dt < 4; ++dt) O[hh][dt] = __builtin_amdgcn_mfma_f32_16x16x32_bf16(VA[dt], PB, O[hh][dt], 0, 0, 0);
    }
}

__device__ __forceinline__ void p3_dsa(const Frame& F) {
    const int tid = F.tid, lane = F.lane, wave = F.wave, fr = lane & 15, fq = lane >> 4;
    unsigned* scl = (unsigned*)g_lds;
    unsigned* selm = (unsigned*)(g_lds + 131328);
    unsigned char* kbuf = (unsigned char*)g_lds;
    unsigned char* vbuf = kbuf + 2 * 9216;
    const bf16_t* z = F.z; const int G = gridDim.x, bx = blockIdx.x;
    const f32x4 zero4 = {0.f, 0.f, 0.f, 0.f};
    for (int rnd = 0; rnd * G < 2048; ++rnd) {
        const int n = rnd * G + ((rnd & 1) ? (G - 1 - bx) : bx);
        if (n >= 2048) continue;
        const int qg = 127 - (n >> 4), b = n & 15, q0 = qg * 16; const size_t Tb = (size_t)b * SEQ;
        for (int i = tid; i < 1024; i += NTHR) selm[i] = 0u;
        __syncthreads();
        const bf16_t* zq = z + (Tb + q0 + fr) * ZLD;
        const unsigned lofk = (unsigned)((fr * ZLD + fq * 8) * 2), lofv = (unsigned)((fr * SEQ + fq * 4) * 2);
        const int nchunk = (qg + 4) >> 2; const int lrow = tid >> 3, lseg = tid & 7;
        const bf16_t* kg = z + (Tb + lrow) * ZLD + C_KA + lseg * 8; const bf16_t* vg = F.vt + ((size_t)b * 64 + lrow) * SEQ + lseg * 8;
        const unsigned lst = (unsigned)(lrow * 144 + lseg * 16);
        const int hp = wave >> 1, kh = wave & 1;
        const u32x4 kc0 = *(const u32x4*)(kg), vc0 = *(const u32x4*)(vg);
        u32x4 kx = kc0, vx = vc0, ky = kc0, vy = vc0;
        if (1 < nchunk) { kx = *(const u32x4*)(kg + (size_t)64 * ZLD); vx = *(const u32x4*)(vg + 64); }
        if (2 < nchunk) { ky = *(const u32x4*)(kg + (size_t)128 * ZLD); vy = *(const u32x4*)(vg + 128); }
        bf16x8 Bqa[2][2];
#pragma unroll
        for (int hh = 0; hh < 2; ++hh)
#pragma unroll
            for (int ks = 0; ks < 2; ++ks) Bqa[hh][ks] = *(const bf16x8*)(zq + C_Q + (2 * hp + hh) * 64 + ks * 32 + fq * 8);
        if (qg >= 16) {
            const u32x4 wv = *(const u32x4*)(zq + C_WI);
            {
                bf16x8 Bq[8][2];
#pragma unroll
                for (int hh = 0; hh < 8; ++hh)
#pragma unroll
                    for (int ks = 0; ks < 2; ++ks) Bq[hh][ks] = *(const bf16x8*)(zq + C_QI + hh * 64 + ks * 32 + fq * 8);
                const float sc = 0.044194173824159216f;
                float wih[8]; wih[0] = bflo(wv.x) * sc; wih[1] = bfhi(wv.x) * sc; wih[2] = bflo(wv.y) * sc; wih[3] = bfhi(wv.y) * sc; wih[4] = bflo(wv.z) * sc; wih[5] = bfhi(wv.z) * sc; wih[6] = bflo(wv.w) * sc; wih[7] = bfhi(wv.w) * sc;
#pragma unroll 1
                for (int half = 0; half < 2; ++half) {
                    const int ktb = wave + 64 * half; if (ktb > qg) break;
                    bf16x8 W0[2], W1[2];
#pragma unroll
                    for (int j = 0; j < 2; ++j) { const int ktj = (ktb + 8 * j) < qg ? (ktb + 8 * j) : qg; const char* kb = (const char*)(z + (Tb + (size_t)ktj * 16) * ZLD + C_KI);
                        W0[j] = *(const bf16x8*)(kb + lofk); W1[j] = *(const bf16x8*)(kb + lofk + 64); }
#pragma unroll
                    for (int i = 0; i < 8; ++i) { const int kt = ktb + 8 * i;
                        if (kt <= qg) { f32x4 sv = zero4;
#pragma unroll
                            for (int hh = 0; hh < 8; ++hh) { f32x4 acc = __builtin_amdgcn_mfma_f32_16x16x32_bf16(W0[i & 1], Bq[hh][0], zero4, 0, 0, 0);
                                acc = __builtin_amdgcn_mfma_f32_16x16x32_bf16(W1[i & 1], Bq[hh][1], acc, 0, 0, 0);
#pragma unroll
                                for (int jj = 0; jj < 4; ++jj) sv[jj] += wih[hh] * fmaxf(acc[jj], 0.f); }
                            u32x4 w; w.x = ordkey(sv[0]); w.y = ordkey(sv[1]); w.z = ordkey(sv[2]); w.w = ordkey(sv[3]);
                            *(u32x4*)(scl + fr * 2052 + kt * 16 + fq * 4) = w;
                        }
                        if (i + 2 < 8) { const int ktn = (kt + 16) < qg ? (kt + 16) : qg; const char* kb = (const char*)(z + (Tb + (size_t)ktn * 16) * ZLD + C_KI);
                            unsigned lo2 = lofk; asm volatile("" : "+v"(lo2));
                            W0[i & 1] = *(const bf16x8*)(kb + lo2); W1[i & 1] = *(const bf16x8*)(kb + lo2 + 64); }
                    }
                }
            }
            __syncthreads();
#pragma unroll 1
            for (int qq = 0; qq < 2; ++qq) {
                const int q = 2 * wave + qq, qpos = q0 + q;
                unsigned uk[32];
#pragma unroll
                for (int r = 0; r < 32; ++r) { const int key = r * 64 + lane; uk[r] = 0x007fffffu;
                    if (r * 64 <= qpos) { const unsigned v = scl[q * 2052 + key]; uk[r] = (key <= qpos) ? v : 0x007fffffu; } }
                unsigned T = 0u; bool exact = false;
#pragma unroll 1
                for (int bit = 31; bit >= 0; --bit) {
                    const unsigned cand = T | (1u << bit); int c = 0;
#pragma unroll
                    for (int g = 0; g < 4; ++g) {
                        if (g * 512 > qpos) break;
                        unsigned long long m[8];
                        asm("v_cmp_ge_u32_e64 %0, %8, %16\n\tv_cmp_ge_u32_e64 %1, %9, %16\n\tv_cmp_ge_u32_e64 %2, %10, %16\n\tv_cmp_ge_u32_e64 %3, %11, %16\n\t"
                            "v_cmp_ge_u32_e64 %4, %12, %16\n\tv_cmp_ge_u32_e64 %5, %13, %16\n\tv_cmp_ge_u32_e64 %6, %14, %16\n\tv_cmp_ge_u32_e64 %7, %15, %16"
                            : "=&s"(m[0]), "=&s"(m[1]), "=&s"(m[2]), "=&s"(m[3]), "=&s"(m[4]), "=&s"(m[5]), "=&s"(m[6]), "=&s"(m[7])
                            : "v"(uk[g * 8 + 0]), "v"(uk[g * 8 + 1]), "v"(uk[g * 8 + 2]), "v"(uk[g * 8 + 3]), "v"(uk[g * 8 + 4]), "v"(uk[g * 8 + 5]), "v"(uk[g * 8 + 6]), "v"(uk[g * 8 + 7]), "v"(cand));
#pragma unroll
                        for (int j = 0; j < 8; ++j) c += __builtin_popcountll(m[j]);
                    }
                    if (c >= 256) { T = cand; if (c == 256) { exact = true; break; } }
                }
                int need = 0;
                if (!exact) { int c = 0;
#pragma unroll
                    for (int r = 0; r < 32; ++r) c += __builtin_popcountll(__builtin_amdgcn_ballot_w64(uk[r] > T));
                    need = 256 - c; }
#pragma unroll
                for (int r = 0; r < 32; ++r) {
                    if (r * 64 <= qpos) {
                        unsigned long long sel;
                        if (exact) sel = __builtin_amdgcn_ballot_w64(uk[r] >= T);
                        else { sel = __builtin_amdgcn_ballot_w64(uk[r] > T); unsigned long long e = __builtin_amdgcn_ballot_w64(uk[r] == T);
                            const int ne = __builtin_popcountll(e);
                            if (ne <= need) { sel |= e; need -= ne; }
                            else { for (int k = 0; k < need; ++k) { const unsigned long long lb = e & (0ull - e); sel |= lb; e ^= lb; } need = 0; } }
                        if (lane == 0) { selm[q * 64 + 2 * r] = (unsigned)sel; selm[q * 64 + 2 * r + 1] = (unsigned)(sel >> 32); }
                    }
                }
            }
        } else {
            for (int w = tid; w < 1024; w += NTHR) { const int q = w >> 6, word = w & 63, qpos = q0 + q, lo = word * 32;
                selm[w] = (qpos >= lo + 31) ? 0xffffffffu : (qpos < lo ? 0u : ((2u << (qpos - lo)) - 1u)); }
        }
        __syncthreads();
        {
            *(u32x4*)(kbuf + lst) = kc0; *(u32x4*)(vbuf + lst) = vc0;
            f32x4 O[2][4]; f32x4 rs[2];
#pragma unroll
            for (int hh = 0; hh < 2; ++hh) { rs[hh] = zero4;
#pragma unroll
                for (int dt = 0; dt < 4; ++dt) O[hh][dt] = zero4; }
            lds_barrier();
#pragma unroll 1
            for (int c = 0; c < nchunk; c += 2) {
                attn_chunk(kbuf, vbuf, selm, c, kh, fr, fq, Bqa, O, rs);
                if (c + 1 < nchunk) { *(u32x4*)(kbuf + 9216 + lst) = kx; *(u32x4*)(vbuf + 9216 + lst) = vx; }
                if (c + 3 < nchunk) { kx = *(const u32x4*)(kg + (size_t)(c + 3) * 64 * ZLD); vx = *(const u32x4*)(vg + (c + 3) * 64); }
                lds_barrier();
                if (c + 1 < nchunk) {
                    attn_chunk(kbuf + 9216, vbuf + 9216, selm, c + 1, kh, fr, fq, Bqa, O, rs);
                    if (c + 2 < nchunk) { *(u32x4*)(kbuf + lst) = ky; *(u32x4*)(vbuf + lst) = vy; }
                    if (c + 4 < nchunk) { ky = *(const u32x4*)(kg + (size_t)(c + 4) * 64 * ZLD); vy = *(const u32x4*)(vg + (c + 4) * 64); }
                    lds_barrier();
                }
            }
            float* xb = (float*)(vbuf + 2 * 9216) + (size_t)wave * (64 * 17);
            { const int oh = kh ^ 1;
#pragma unroll
              for (int dt = 0; dt < 4; ++dt)
#pragma unroll
                  for (int jj = 0; jj < 4; ++jj) xb[(dt * 4 + jj) * 64 + lane] = (oh == 0) ? O[0][dt][jj] : O[1][dt][jj];
              xb[16 * 64 + lane] = (oh == 0) ? rs[0][0] : rs[1][0]; }
            lds_barrier();
            { const float* pb = (const float*)(vbuf + 2 * 9216) + (size_t)(wave ^ 1) * (64 * 17);
              float tot = ((kh == 0) ? rs[0][0] : rs[1][0]) + pb[16 * 64 + lane];
              const float inv = 1.0f / tot;
              bf16_t* yp = F.yb + (Tb + q0 + fr) * 512 + (2 * hp + kh) * 64 + fq * 4;
#pragma unroll
              for (int dt = 0; dt < 4; ++dt) { float o[4];
#pragma unroll
                  for (int jj = 0; jj < 4; ++jj) o[jj] = (((kh == 0) ? O[0][dt][jj] : O[1][dt][jj]) + pb[(dt * 4 + jj) * 64 + lane]) * inv;
                  uint2 w; w.x = cvt_pk_bf16(o[0], o[1]); w.y = cvt_pk_bf16(o[2], o[3]); *(uint2*)(yp + dt * 16) = w; } }
        }
        __syncthreads();
    }
}

__device__ __forceinline__ void p4_post(const Frame& F) {
    const int tid = F.tid; const float* mu = F.in[3]; const float* gnw = F.in[12]; const float* gnb = F.in[13]; const bf16_t* z = F.z;
    for (int g = blockIdx.x * 32 + (tid >> 4); g < NTOK * 8; g += gridDim.x * 32) { const size_t t = (size_t)(g >> 3); const int h = g & 7, c = h * 64 + (tid & 15) * 4;
        const f32x4 y = *(const f32x4*)(F.yraw + t * 512 + c);
        const float mean = red16((y[0] + y[1]) + (y[2] + y[3])) * (1.0f / 64.0f);
        const f32x4 d = y - mean;
        const float var = red16((d[0] * d[0] + d[1] * d[1]) + (d[2] * d[2] + d[3] * d[3])) * (1.0f / 64.0f); const float rstd = rsqrtf(var + 64e-5f);
        const uint2 vc = *(const uint2*)(z + t * ZLD + C_V + c); uint2 vp = make_uint2(0u, 0u); if (t & (SEQ - 1)) vp = *(const uint2*)(z + (t - 1) * ZLD + C_V + c);
        const f32x4 m4 = *(const f32x4*)(mu + C_V + c), w4 = *(const f32x4*)(gnw + c), b4 = *(const f32x4*)(gnb + c);
        const uint2 gt = *(const uint2*)(F.gt + t * 512 + c); const float bon = F.bonus[t * 8 + h];
        f32x4 vcf, vpf, gtf; vcf[0] = bflo(vc.x); vcf[1] = bfhi(vc.x); vcf[2] = bflo(vc.y); vcf[3] = bfhi(vc.y); vpf[0] = bflo(vp.x); vpf[1] = bfhi(vp.x); vpf[2] = bflo(vp.y); vpf[3] = bfhi(vp.y);
        gtf[0] = bflo(gt.x); gtf[1] = bfhi(gt.x); gtf[2] = bflo(gt.y); gtf[3] = bfhi(gt.y);
        const f32x4 vs = vcf + (vpf - vcf) * m4;
        const f32x4 o = (d * rstd * w4 + b4 + vs * bon) * gtf;
        uint2 w; w.x = cvt_pk_bf16(o[0], o[1]); w.y = cvt_pk_bf16(o[2], o[3]); *(uint2*)(F.ya + t * 512 + c) = w; }
}

__device__ __forceinline__ void p9_final(const Frame& F, const bool ident) {
    const float* g = F.in[19]; const int lane = F.lane;
    for (int row = blockIdx.x * 8 + F.wave; row < NTOK; row += gridDim.x * 8) {
        float* xr = F.out + (size_t)row * DM; const float sc = ident ? 1.0f : rsqrtf(F.ss2[row] * (1.0f / 1024.0f) + 1e-6f);
#pragma unroll
        for (int i = 0; i < 4; ++i) { f32x4 v = *(const f32x4*)(xr + i * 256 + lane * 4); const f32x4 gg = *(const f32x4*)(g + i * 256 + lane * 4);
            if (!ident) { v[0] *= sc * gg[0]; v[1] *= sc * gg[1]; v[2] *= sc * gg[2]; v[3] *= sc * gg[3]; } *(f32x4*)(xr + i * 256 + lane * 4) = v; }
    }
}
#define XB_TMO      128
#define XB_XCNT(j)  (256  + 64 * (j))
#define XB_XSUB(j)  (1280 + 64 * (j))
#define XB_XGEN(j)  (2304 + 64 * (j))
#define XB_TOP      3328
#define XB_TOPGEN   3392
#define XCD_BAR_WORDS 3456
#define XB_SPIN_CAP (1u << 18)
#define LAS __attribute__((address_space(3)))

__device__ __forceinline__ unsigned xb_ld(unsigned* p)              { return __hip_atomic_load(p, __ATOMIC_RELAXED, __HIP_MEMORY_SCOPE_AGENT); }
__device__ __forceinline__ unsigned xb_add(unsigned* p, unsigned v) { return __hip_atomic_fetch_add(p, v, __ATOMIC_RELAXED, __HIP_MEMORY_SCOPE_AGENT); }
__device__ __forceinline__ unsigned xb_xcc_id() { return (unsigned)__builtin_amdgcn_s_getreg((3 << 11) | 20) & 0xFu; }
#define XB_SPIN(cond, bar) do { unsigned _sp = 0; while (cond) { __builtin_amdgcn_s_sleep(1); \
    if ((++_sp & 255u) == 0u) { if (xb_ld(&(bar)[XB_TMO])) break; if (_sp > XB_SPIN_CAP) { atomicAdd(&(bar)[XB_TMO], 1u); break; } } } } while (0)

struct XcdBarrier {
    unsigned* bar; unsigned x;
    volatile LAS unsigned* st;
};

__device__ __forceinline__ XcdBarrier xcd_barrier_post(unsigned* bar, volatile LAS unsigned* st) {
    XcdBarrier b; b.bar = bar; b.x = xb_xcc_id(); b.st = st;
    if (threadIdx.x == 0) (void)xb_add(&bar[XB_XCNT(b.x)], 1u);
    return b;
}
__device__ __forceinline__ void xcd_barrier_complete(unsigned* bar, unsigned x, unsigned& nloc, unsigned& nx) {
    const unsigned G = gridDim.x * gridDim.y * gridDim.z;
    unsigned sum, cnt, mine, sp = 0u;
    for (;;) {
        sum = 0u; cnt = 0u; mine = 0u;
#pragma unroll
        for (unsigned j = 0; j < 16; ++j) { const unsigned c = xb_ld(&bar[XB_XCNT(j)]); sum += c; cnt += (c > 0u) ? 1u : 0u; mine = (j == x) ? c : mine; }
        if (sum == G) break;
        __builtin_amdgcn_s_sleep(1);
        if ((++sp & 255u) == 0u) { if (xb_ld(&bar[XB_TMO])) break; if (sp > XB_SPIN_CAP) { atomicAdd(&bar[XB_TMO], 1u); break; } }
    }
    nloc = mine > 0u ? mine : 1u; nx = cnt > 0u ? cnt : 1u;
}

__device__ __forceinline__ void xcd_barrier(const XcdBarrier& b) {
    asm volatile("s_waitcnt vmcnt(0)" ::: "memory");
    __syncthreads();
    if (threadIdx.x == 0) {
        unsigned* bar = b.bar;
        __builtin_amdgcn_s_waitcnt(0);
        unsigned nloc = b.st[0], nx = b.st[1];
        if (nloc == 0u) { xcd_barrier_complete(bar, b.x, nloc, nx); b.st[0] = nloc; b.st[1] = nx; }
        const unsigned old = xb_add(&bar[XB_XSUB(b.x)], 1u);
        const unsigned gen = old / nloc;
        if (old + 1u == (gen + 1u) * nloc) {
            __builtin_amdgcn_fence(__ATOMIC_RELEASE, "agent");
            asm volatile("s_waitcnt vmcnt(0)" ::: "memory");
            const unsigned og = xb_add(&bar[XB_TOP], 1u);
            const unsigned tg = og / nx;
            if (og + 1u == (tg + 1u) * nx) xb_add(&bar[XB_TOPGEN], 1u);
            else XB_SPIN(xb_ld(&bar[XB_TOPGEN]) == tg, bar);
            __builtin_amdgcn_fence(__ATOMIC_ACQUIRE, "agent");
            xb_add(&bar[XB_XGEN(b.x)], 1u);
            asm volatile("s_waitcnt vmcnt(0)" ::: "memory");
        } else {
            XB_SPIN(xb_ld(&bar[XB_XGEN(b.x)]) == gen, bar);
            __builtin_amdgcn_fence(__ATOMIC_ACQUIRE, "agent");
            asm volatile("s_waitcnt vmcnt(0)" ::: "memory");
        }
    }
    __syncthreads();
}
#ifndef PHASE_MASK
#define PHASE_MASK 0x3ff
#endif
#ifndef GEMM_ALIGN
#define GEMM_ALIGN true
#endif
#ifndef GEMM_SP2
#define GEMM_SP2 true
#endif
constexpr int NPHASE = 10;
constexpr size_t WS_BAR = 3 * MiB;
template <class Epi> __device__ __forceinline__ void run_gemm(const bf16_t* A, const bf16_t* Bt, int N, int K, const Epi& E) {
    pg8::Gemm g{A, Bt, NTOK, N, K}; pg8::StaticOrder S; S.init(NTOK, N, (int)gridDim.x, (int)blockIdx.x);
    pg8::gemm_phase<Epi, pg8::StaticOrder, GEMM_ALIGN, GEMM_SP2>((PG8_LAS unsigned char*)g_lds, g, S, E);
}
__global__ void __launch_bounds__(NTHR, 2) mega_fwd(Args args) {
    Frame F;
#pragma unroll
    for (int i = 0; i < 20; ++i) F.in[i] = args.in[i];
    F.out = args.out; F.ws = args.ws; F.lds = nullptr; F.tid = threadIdx.x; F.lane = F.tid & 63; F.wave = __builtin_amdgcn_readfirstlane(F.tid >> 6);
    unsigned char* ws = args.ws;
    F.ss1 = (float*)(ws + WS_SS1); F.ss2 = (float*)(ws + WS_SS2); F.bonus = (float*)(ws + WS_BONUS); F.rope = (float2*)(ws + WS_ROPE);
    F.wd = (bf16_t*)(ws + WS_WD); F.wi = (bf16_t*)(ws + WS_WI); F.wg = (bf16_t*)(ws + WS_WG);
    F.win = (bf16_t*)(ws + WS_WIN); F.wup = (bf16_t*)(ws + WS_WUP); F.wdn = (bf16_t*)(ws + WS_WDN); F.wb = (bf16_t*)(ws + WS_WB); F.wo = (bf16_t*)(ws + WS_WO); F.vt = (bf16_t*)(ws + WS_VT);
    F.h = (bf16_t*)(ws + WS_H); F.ya = F.h; F.yb = F.h + (size_t)NTOK * 512; F.xb = F.h;
    F.z = (bf16_t*)(ws + WS_Z); F.hid = F.z;
    F.lw = (bf16_t*)(ws + WS_P); F.ic = F.lw + (size_t)NTOK * 512; F.mg = F.lw;
    F.yraw = args.out; F.gt = (bf16_t*)(args.out + (size_t)NTOK * 512);
    const int lo = args.ph_lo, hi = args.ph_hi;
    cg::grid_group grid = cg::this_grid();
    if (args.ph_lo < 0) grid.sync();
    volatile LAS unsigned* xst = (volatile LAS unsigned*)(g_lds + LDS_BYTES - 64);
    if (threadIdx.x == 0) { xst[0] = 0u; xst[1] = 0u; }
    __syncthreads();
    XcdBarrier xbar = xcd_barrier_post((unsigned*)(ws + WS_BAR), xst);
#define IN(k) (lo <= (k) && (k) < hi)
#define SEAM(k) do { if (IN(k) && IN((k) + 1)) { xcd_barrier(xbar); if (REP(17)) xcd_barrier(xbar); } } while (0)
    if (((PHASE_MASK >> 0) & 1) && IN(0)) { p0_prologue(F); __syncthreads(); if (REP(0)) { p0_prologue(F); __syncthreads(); } } SEAM(0);
    if (((PHASE_MASK >> 1) & 1) && IN(1)) { pg8::EpiZ E{F.z, ZLD}; run_gemm(F.h, F.win, 5120, 1024, E); __syncthreads(); if (REP(1)) { run_gemm(F.h, F.win, 5120, 1024, E); __syncthreads(); } if (REP(18)) { run_gemm(F.h, F.win, 4096, 1024, E); __syncthreads(); } } SEAM(1);
    if (((PHASE_MASK >> 2) & 1) && IN(2)) { if (REP(2)) { p2_prep(F, 0); __syncthreads(); } if (REP(16)) { p2_prep(F, 2); __syncthreads(); } p2_prep(F, 1); __syncthreads(); } SEAM(2);
    if (((PHASE_MASK >> 3) & 1) && IN(3)) { if (REP(14)) { p3_scan(F, 1); __syncthreads(); } if (REP(15)) { p3_scan(F, 2); __syncthreads(); } if (REP(3)) { p3_scan(F, 0); __syncthreads(); } p3_scan(F, 0); __syncthreads(); p3_dsa(F); __syncthreads(); if (REP(10)) { p3_dsa(F); __syncthreads(); } } SEAM(3);
    if (((PHASE_MASK >> 4) & 1) && IN(4)) { p4_post(F); __syncthreads(); if (REP(4)) { p4_post(F); __syncthreads(); } } SEAM(4);
    if (((PHASE_MASK >> 5) & 1) && IN(5)) { pg8::EpiGate<0> E0{F.mg, F.z, ZLD, C_G0}; run_gemm(F.ya, F.wb, 1024, 512, E0); __syncthreads();
                 pg8::EpiGate<1> E1{F.mg, F.z, ZLD, C_G1}; run_gemm(F.yb, F.wb + 1024 * 512, 1024, 512, E1); __syncthreads();
                 if (REP(5)) { run_gemm(F.ya, F.wb, 1024, 512, E0); __syncthreads(); run_gemm(F.yb, F.wb + 1024 * 512, 1024, 512, E1); __syncthreads(); } } SEAM(5);
    if (((PHASE_MASK >> 6) & 1) && IN(6)) { if (REP(6)) { pg8::EpiRes1 Ex{F.in[0], F.xb, F.bonus}; run_gemm(F.mg, F.wo, 1024, 1024, Ex); __syncthreads(); }
                 pg8::EpiRes1 E{F.in[0], F.xb, F.ss1}; run_gemm(F.mg, F.wo, 1024, 1024, E); __syncthreads(); } SEAM(6);
    if (((PHASE_MASK >> 7) & 1) && IN(7)) { pg8::EpiHid E{F.hid, F.ss1}; run_gemm(F.xb, F.wup, 4096, 1024, E); __syncthreads(); if (REP(7)) { run_gemm(F.xb, F.wup, 4096, 1024, E); __syncthreads(); } } SEAM(7);
    if (((PHASE_MASK >> 8) & 1) && IN(8)) { pg8::EpiRes2 E{F.xb, F.out, F.ss2}; run_gemm(F.hid, F.wdn, 1024, 4096, E); __syncthreads(); } SEAM(8);
    if (((PHASE_MASK >> 9) & 1) && IN(9)) { if (REP(9)) { p9_final(F, true); __syncthreads(); } p9_final(F, false); }
#undef IN
#undef SEAM
}

extern "C" void kernel_launch(void* const* d_in, const int* in_sizes, int n_in, void* d_out, int out_size, void* d_ws, size_t ws_size, hipStream_t stream) {
    static int grid = 0;
    if (grid == 0) {
        if (n_in != 20 || out_size != NTOK * DM || ws_size < WS_END) { fprintf(stderr, "kernel_launch: unexpected shapes (n_in %d, out %d, ws %zu < %zu)\n", n_in, out_size, ws_size, (size_t)WS_END); grid = -1; return; }
        int dev = 0, cus = 0, per_cu = 0;
        hipGetDevice(&dev); hipDeviceGetAttribute(&cus, hipDeviceAttributeMultiprocessorCount, dev);
        if (hipFuncSetAttribute((const void*)mega_fwd, hipFuncAttributeMaxDynamicSharedMemorySize, LDS_BYTES) != hipSuccess) { fprintf(stderr, "kernel_launch: hipFuncSetAttribute failed\n"); grid = -1; return; }
        if (hipOccupancyMaxActiveBlocksPerMultiprocessor(&per_cu, (const void*)mega_fwd, NTHR, LDS_BYTES) != hipSuccess || per_cu < 1) { fprintf(stderr, "kernel_launch: occupancy query failed (%d)\n", per_cu); per_cu = 1; }
        (void)hipGetLastError();
        grid = cus * per_cu;
        fprintf(stderr, "kernel_launch: grid %d (%d CUs x %d)\n", grid, cus, per_cu);
    }
    if (grid < 0) return;
    if (hipMemsetAsync((char*)d_ws + WS_BAR, 0, XCD_BAR_WORDS * 4, stream) != hipSuccess) { fprintf(stderr, "kernel_launch: memset of the barrier words failed\n"); return; }
    Args a{};
    for (int i = 0; i < 20; ++i) a.in[i] = (const float*)d_in[i];
    a.out = (float*)d_out; a.ws = (unsigned char*)d_ws;
#if MK_PER_PHASE_LAUNCH
    for (int p = 0; p < NPHASE; ++p) { a.ph_lo = p; a.ph_hi = p + 1; hipLaunchKernelGGL(mega_fwd, dim3(grid), dim3(NTHR), LDS_BYTES, stream, a); }
#else
    a.ph_lo = 0; a.ph_hi = NPHASE;
    void* kargs[] = {&a};
    hipError_t e = hipLaunchCooperativeKernel((const void*)mega_fwd, dim3(grid), dim3(NTHR), kargs, LDS_BYTES, stream);
    if (e != hipSuccess) fprintf(stderr, "kernel_launch: cooperative launch failed: %s (grid %d)\n", hipGetErrorString(e), grid);
#endif
}
```

```cpp
#include <hip/hip_runtime.h>
#include <hip/hip_cooperative_groups.h>
#include <cstdio>
#include <cstdint>
namespace cg = cooperative_groups;

#ifndef MK_PER_PHASE_LAUNCH
#define MK_PER_PHASE_LAUNCH 0
#endif

#ifndef REPEAT_MASK
#define REPEAT_MASK 0
#endif
#define REP(k) ((REPEAT_MASK >> (k)) & 1)
#ifndef TS_SEL
#define TS_SEL -1
#endif

namespace pg8 {
#define PG8_LAS __attribute__((address_space(3)))
typedef unsigned short bf16_t;
typedef short bf16x8 __attribute__((ext_vector_type(8)));
typedef float f32x4 __attribute__((ext_vector_type(4)));
typedef unsigned u32x4 __attribute__((ext_vector_type(4)));
constexpr int BM = 256, BK = 64, HALF = 128, HTB = HALF * BK * 2  , STAGE_BYTES = 8 * HTB, NXCD = 8, WGM = 8;

__host__ __device__ __forceinline__ int lds_byte(int r, int c) { const int st = (r >> 4) * 2 + (c >> 5), rr = r & 15, cc = c & 31, ob = rr * 64 + cc * 2; return st * 1024 + (ob ^ (((ob >> 9) & 1) << 5)); }
__host__ __device__ __forceinline__ void stage_rc(int b, int& R, int& C) { const int st = b / 1024, sb = b % 1024, swz = sb ^ (((sb >> 9) & 1) << 5); R = (st >> 1) * 16 + swz / 64; C = (st & 1) * 32 + (swz % 64) / 2; }
__host__ __device__ __forceinline__ int perm32(int rho) { const int n = rho >> 4, i = rho & 15; return 8 * (i >> 2) + 4 * n + (i & 3); }

struct Unit { int pm, pn; };
struct Gemm { const bf16_t* A; const bf16_t* Bt; int M, N, K; };

struct StaticOrder {
    int nM, nN, nwg, G, c;
    __host__ __device__ void init(int M, int N, int G_, int c_) { nM = M / BM; nN = N / BM; nwg = nM * nN; G = G_; c = c_; }
    __host__ __device__ bool next(int i, Unit& u) const {
        const long L = (long)i * G + c; if (L >= nwg) return false;
        int wgid = (int)L; { const int q = nwg / NXCD, r = nwg % NXCD, xcd = wgid % NXCD, off = wgid / NXCD; wgid = (xcd < r ? xcd * (q + 1) : r * (q + 1) + (xcd - r) * q) + off; }
        const int nig = WGM * nN, gid = wgid / nig, fm = gid * WGM, gsz = (nM - fm) < WGM ? (nM - fm) : WGM;
        u.pm = fm + ((wgid % nig) % gsz); u.pn = (wgid % nig) / gsz; return true;
    }
    __device__ __forceinline__ void a_ready(const Unit&) const {}
    __device__ __forceinline__ void done(const Unit&) const {}
};
__device__ __forceinline__ unsigned cvt_pk_bf16(float lo, float hi) { unsigned r; asm volatile("v_cvt_pk_bf16_f32 %0, %1, %2" : "=v"(r) : "v"(lo), "v"(hi)); return r; }
typedef float f32x2 __attribute__((ext_vector_type(2)));
__device__ __forceinline__ float bflo(unsigned u) { return __uint_as_float(u << 16); }
__device__ __forceinline__ float bfhi(unsigned u) { return __uint_as_float(u & 0xffff0000u); }
__device__ __forceinline__ float sigm(float x) { return 1.0f / (1.0f + __expf(-x)); }

struct EpiZ {
    static constexpr bool PERM = true, AFTER_DRAIN = false;
    bf16_t* O; int ldc;
    __device__ __forceinline__ void operator()(const f32x4 (&acc)[2][2][4][2], const Unit& u, int wr, int wc, int fr, int fq) const {
        const int row0 = u.pm * BM + wr * 64 + fr, col0 = u.pn * BM + wc * 32 + 8 * fq;
#pragma unroll
        for (int ai = 0; ai < 2; ++ai)
#pragma unroll
            for (int m = 0; m < 4; ++m) { bf16_t* rowp = O + (size_t)(row0 + ai * HALF + m * 16) * ldc + col0;
#pragma unroll
                for (int bj = 0; bj < 2; ++bj) { const f32x4 v0 = acc[ai][bj][m][0], v1 = acc[ai][bj][m][1];
                    u32x4 w; w.x = cvt_pk_bf16(v0[0], v0[1]); w.y = cvt_pk_bf16(v0[2], v0[3]); w.z = cvt_pk_bf16(v1[0], v1[1]); w.w = cvt_pk_bf16(v1[2], v1[3]);
                    *(u32x4*)(rowp + bj * HALF) = w; } }
    }
};
template <int MODE> struct EpiGate {
    static constexpr bool PERM = true, AFTER_DRAIN = false;
    bf16_t* O; const bf16_t* Z; int zld; int gcol;
    __device__ __forceinline__ void operator()(const f32x4 (&acc)[2][2][4][2], const Unit& u, int wr, int wc, int fr, int fq) const {
        const int row0 = u.pm * BM + wr * 64 + fr, col0 = u.pn * BM + wc * 32 + 8 * fq;
#pragma unroll
        for (int ai = 0; ai < 2; ++ai)
#pragma unroll
            for (int m = 0; m < 4; ++m) { const size_t row = (size_t)(row0 + ai * HALF + m * 16);
                bf16_t* op = O + row * 1024 + col0; const bf16_t* zp = Z + row * zld + gcol + col0;
#pragma unroll
                for (int bj = 0; bj < 2; ++bj) { const f32x4 v0 = acc[ai][bj][m][0], v1 = acc[ai][bj][m][1];
                    const u32x4 g = *(const u32x4*)(zp + bj * HALF);
                    float r0 = v0[0] * sigm(bflo(g.x)), r1 = v0[1] * sigm(bfhi(g.x)), r2 = v0[2] * sigm(bflo(g.y)), r3 = v0[3] * sigm(bfhi(g.y));
                    float r4 = v1[0] * sigm(bflo(g.z)), r5 = v1[1] * sigm(bfhi(g.z)), r6 = v1[2] * sigm(bflo(g.w)), r7 = v1[3] * sigm(bfhi(g.w));
                    if (MODE == 1) { const u32x4 p = *(const u32x4*)(op + bj * HALF);
                        r0 += bflo(p.x); r1 += bfhi(p.x); r2 += bflo(p.y); r3 += bfhi(p.y); r4 += bflo(p.z); r5 += bfhi(p.z); r6 += bflo(p.w); r7 += bfhi(p.w); }
                    u32x4 w; w.x = cvt_pk_bf16(r0, r1); w.y = cvt_pk_bf16(r2, r3); w.z = cvt_pk_bf16(r4, r5); w.w = cvt_pk_bf16(r6, r7);
                    *(u32x4*)(op + bj * HALF) = w; } }
    }
};
struct EpiRes1 {
    static constexpr bool PERM = true, AFTER_DRAIN = false;
    const float* X; bf16_t* XB; float* SS;
    __device__ __forceinline__ void operator()(const f32x4 (&acc)[2][2][4][2], const Unit& u, int wr, int wc, int fr, int fq) const {
        const int row0 = u.pm * BM + wr * 64 + fr, col0 = u.pn * BM + wc * 32 + 8 * fq;
#pragma unroll
        for (int ai = 0; ai < 2; ++ai)
#pragma unroll
            for (int m = 0; m < 4; ++m) { const size_t row = (size_t)(row0 + ai * HALF + m * 16); float ssq = 0.f;
#pragma unroll
                for (int bj = 0; bj < 2; ++bj) { const size_t off = row * 1024 + col0 + bj * HALF;
                    const f32x4 v0 = acc[ai][bj][m][0] + *(const f32x4*)(X + off), v1 = acc[ai][bj][m][1] + *(const f32x4*)(X + off + 4);
                    ssq += (v0[0] * v0[0] + v0[1] * v0[1]) + (v0[2] * v0[2] + v0[3] * v0[3]) + (v1[0] * v1[0] + v1[1] * v1[1]) + (v1[2] * v1[2] + v1[3] * v1[3]);
                    u32x4 w; w.x = cvt_pk_bf16(v0[0], v0[1]); w.y = cvt_pk_bf16(v0[2], v0[3]); w.z = cvt_pk_bf16(v1[0], v1[1]); w.w = cvt_pk_bf16(v1[2], v1[3]);
                    *(u32x4*)(XB + off) = w; }
                ssq += __shfl_xor(ssq, 16); ssq += __shfl_xor(ssq, 32);
                if (fq == 0) atomicAdd(SS + row, ssq); }
    }
};
struct EpiRes2 {
    static constexpr bool PERM = true, AFTER_DRAIN = false;
    const bf16_t* XB; float* O; float* SS;
    __device__ __forceinline__ void operator()(const f32x4 (&acc)[2][2][4][2], const Unit& u, int wr, int wc, int fr, int fq) const {
        const int row0 = u.pm * BM + wr * 64 + fr, col0 = u.pn * BM + wc * 32 + 8 * fq;
#pragma unroll
        for (int ai = 0; ai < 2; ++ai)
#pragma unroll
            for (int m = 0; m < 4; ++m) { const size_t row = (size_t)(row0 + ai * HALF + m * 16); float ssq = 0.f;
#pragma unroll
                for (int bj = 0; bj < 2; ++bj) { const size_t off = row * 1024 + col0 + bj * HALF;
                    const u32x4 xw = *(const u32x4*)(XB + off); f32x4 v0 = acc[ai][bj][m][0], v1 = acc[ai][bj][m][1];
                    v0[0] += bflo(xw.x); v0[1] += bfhi(xw.x); v0[2] += bflo(xw.y); v0[3] += bfhi(xw.y); v1[0] += bflo(xw.z); v1[1] += bfhi(xw.z); v1[2] += bflo(xw.w); v1[3] += bfhi(xw.w);
                    *(f32x4*)(O + off) = v0; *(f32x4*)(O + off + 4) = v1;
                    ssq += (v0[0] * v0[0] + v0[1] * v0[1]) + (v0[2] * v0[2] + v0[3] * v0[3]) + (v1[0] * v1[0] + v1[1] * v1[1]) + (v1[2] * v1[2] + v1[3] * v1[3]); }
                ssq += __shfl_xor(ssq, 16); ssq += __shfl_xor(ssq, 32);
                if (fq == 0) atomicAdd(SS + row, ssq); }
    }
};
struct EpiHid {
    static constexpr bool PERM = true, AFTER_DRAIN = false;
    bf16_t* O; const float* SS;
    __device__ __forceinline__ void operator()(const f32x4 (&acc)[2][2][4][2], const Unit& u, int wr, int wc, int fr, int fq) const {
        const int row0 = u.pm * BM + wr * 64 + fr, col0 = u.pn * BM + wc * 32 + 8 * fq;
#pragma unroll
        for (int ai = 0; ai < 2; ++ai)
#pragma unroll
            for (int m = 0; m < 4; ++m) { const size_t row = (size_t)(row0 + ai * HALF + m * 16);
                const float s2 = 1.0f / (SS[row] * (1.0f / 1024.0f) + 1e-6f);
                bf16_t* rowp = O + row * 4096 + col0;
#pragma unroll
                for (int bj = 0; bj < 2; ++bj) { f32x4 v0 = acc[ai][bj][m][0], v1 = acc[ai][bj][m][1];
#pragma unroll
                    for (int j = 0; j < 4; ++j) { float a = fmaxf(v0[j], 0.f), b = fmaxf(v1[j], 0.f); v0[j] = a * a * s2; v1[j] = b * b * s2; }
                    u32x4 w; w.x = cvt_pk_bf16(v0[0], v0[1]); w.y = cvt_pk_bf16(v0[2], v0[3]); w.z = cvt_pk_bf16(v1[0], v1[1]); w.w = cvt_pk_bf16(v1[2], v1[3]);
                    *(u32x4*)(rowp + bj * HALF) = w; } }
    }
};

template <class Epi, class Sched, bool ALIGN_EPI = false, bool SP2 = false>
__device__ __forceinline__ void gemm_phase(PG8_LAS unsigned char* lds, const Gemm g, const Sched& S, const Epi& E) {
    const int tid = threadIdx.x, wid = __builtin_amdgcn_readfirstlane(tid >> 6), lane = tid & 63, wr = wid >> 2, wc = wid & 3, fr = lane & 15, fq = lane >> 4;
    const int K = g.K, nt = K / BK;
    unsigned voffA[2], voffB[2];
#pragma unroll
    for (int i = 0; i < 2; ++i) { int R, C; stage_rc(tid * 16 + i * 8192, R, C); const int Rb = Epi::PERM ? ((R & ~31) + perm32(R & 31)) : R;
        voffA[i] = (unsigned)(R * K + C) * 2u; voffB[i] = (unsigned)(Rb * K + C) * 2u; }
    const size_t kstep = (size_t)(BK * 2);
    const size_t hstep = (size_t)HALF * K * 2;
    const size_t tstep = 2 * hstep;
    const unsigned ldsw = (unsigned)wid * 1024u;
    const int aoff = lds_byte(wr * 64 + fr, fq * 8), boff = lds_byte(wc * 32 + fr, fq * 8);
#define PG8_SA(b, h) (((b) * 2 + (h)) * HTB)
#define PG8_SB(b, h) ((4 + (b) * 2 + (h)) * HTB)
#define PG8_STAGE(bufoff, gbase, voff) do { _Pragma("unroll") for (int _i = 0; _i < 2; ++_i) \
        __builtin_amdgcn_global_load_lds((const unsigned*)((const char*)(gbase) + (voff)[_i]), (PG8_LAS unsigned*)(lds + (bufoff) + ldsw + _i * 8192), 16, 0, 0); } while (0)
#define PG8_LDA(dst, b, h) do { _Pragma("unroll") for (int m = 0; m < 4; ++m) _Pragma("unroll") for (int k = 0; k < 2; ++k) dst[m][k] = *(const PG8_LAS bf16x8*)(lds + PG8_SA(b, h) + aoff + m * 2048 + k * 1024); } while (0)
#define PG8_LDB(dst, b, h) do { _Pragma("unroll") for (int n = 0; n < 2; ++n) _Pragma("unroll") for (int k = 0; k < 2; ++k) dst[n][k] = *(const PG8_LAS bf16x8*)(lds + PG8_SB(b, h) + boff + n * 2048 + k * 1024); } while (0)
#define PG8_MMA(ai, bj, At, Bt) do { __builtin_amdgcn_s_setprio(1); _Pragma("unroll") for (int m = 0; m < 4; ++m) _Pragma("unroll") for (int n = 0; n < 2; ++n) _Pragma("unroll") for (int k = 0; k < 2; ++k) \
        acc[ai][bj][m][n] = __builtin_amdgcn_mfma_f32_16x16x32_bf16(Bt[n][k], At[m][k], acc[ai][bj][m][n], 0, 0, 0); __builtin_amdgcn_s_setprio(0); } while (0)
#define PG8_WAIT_V(n) asm volatile("s_waitcnt vmcnt(" #n ")" ::: "memory")
#define PG8_WAIT_L(n) asm volatile("s_waitcnt lgkmcnt(" #n ")" ::: "memory")
#define PG8_BAR __builtin_amdgcn_s_barrier()
#define PG8_SCHED __builtin_amdgcn_sched_barrier(0)
    Unit cur, nxt; int ui = 0;
    if (!S.next(0, cur)) return;
    f32x4 acc[2][2][4][2];
#pragma unroll
    for (int a = 0; a < 2; ++a)
#pragma unroll
        for (int b = 0; b < 2; ++b)
#pragma unroll
            for (int m = 0; m < 4; ++m)
#pragma unroll
                for (int n = 0; n < 2; ++n) acc[a][b][m][n] = (f32x4){0.f, 0.f, 0.f, 0.f};
    bf16x8 At[4][2], B0[2][2], B1[2][2];
    const char* cA = (const char*)g.A + (size_t)cur.pm * tstep; const char* cB = (const char*)g.Bt + (size_t)cur.pn * tstep;
    S.a_ready(cur);
    if constexpr (SP2) {
        PG8_STAGE(PG8_SB(0, 0), cB, voffB); PG8_STAGE(PG8_SB(0, 1), cB + hstep, voffB); PG8_STAGE(PG8_SA(0, 0), cA, voffA); PG8_STAGE(PG8_SA(0, 1), cA + hstep, voffA);
        if (wr == 1) PG8_BAR;
        PG8_WAIT_V(2); PG8_BAR;
        PG8_STAGE(PG8_SB(1, 0), cB + kstep, voffB); PG8_STAGE(PG8_SA(1, 0), cA + kstep, voffA); PG8_STAGE(PG8_SB(1, 1), cB + hstep + kstep, voffB);
        PG8_WAIT_V(6); PG8_BAR;
    } else {
        PG8_STAGE(PG8_SB(0, 0), cB, voffB); PG8_STAGE(PG8_SA(0, 0), cA, voffA); PG8_STAGE(PG8_SB(0, 1), cB + hstep, voffB); PG8_STAGE(PG8_SA(0, 1), cA + hstep, voffA);
        if (wr == 1) PG8_BAR;
        PG8_WAIT_V(4); PG8_BAR;
        PG8_STAGE(PG8_SB(1, 0), cB + kstep, voffB); PG8_STAGE(PG8_SA(1, 0), cA + kstep, voffA); PG8_STAGE(PG8_SB(1, 1), cB + hstep + kstep, voffB);
        PG8_WAIT_V(6); PG8_BAR;
    }
    for (;;) {
        const bool has_next = S.next(ui + 1, nxt);
        const char* nA = has_next ? (const char*)g.A + (size_t)nxt.pm * tstep : cA; const char* nB = has_next ? (const char*)g.Bt + (size_t)nxt.pn * tstep : cB;
        for (int t = 0; t < nt; t += 2) {
            const bool last = (t == nt - 2);
            const char* a1 = cA + (size_t)(t + 1) * kstep;
            const char* a2 = last ? nA : cA + (size_t)(t + 2) * kstep; const char* b2 = last ? nB : cB + (size_t)(t + 2) * kstep;
            const char* a3 = a2 + kstep; const char* b3 = b2 + kstep;
            if (last && has_next) S.a_ready(nxt);
            if constexpr (SP2) {
            PG8_LDB(B0, 0, 0); PG8_LDB(B1, 0, 1); PG8_SCHED; PG8_LDA(At, 0, 0); PG8_STAGE(PG8_SA(1, 1), a1 + hstep, voffA);
            PG8_WAIT_V(8); PG8_WAIT_L(0); PG8_BAR; PG8_MMA(0, 0, At, B0); PG8_MMA(0, 1, At, B1); PG8_BAR; PG8_SCHED;
            PG8_LDA(At, 0, 1); PG8_STAGE(PG8_SB(0, 0), b2, voffB); PG8_STAGE(PG8_SB(0, 1), b2 + hstep, voffB); PG8_STAGE(PG8_SA(0, 0), a2, voffA);
            PG8_WAIT_V(8); PG8_WAIT_L(0); PG8_BAR; PG8_MMA(1, 0, At, B0); PG8_MMA(1, 1, At, B1); PG8_BAR; PG8_SCHED;
            PG8_LDB(B0, 1, 0); PG8_LDB(B1, 1, 1); PG8_SCHED; PG8_LDA(At, 1, 0); PG8_STAGE(PG8_SA(0, 1), a2 + hstep, voffA);
            PG8_WAIT_V(8); PG8_WAIT_L(0); PG8_BAR; PG8_MMA(0, 0, At, B0); PG8_MMA(0, 1, At, B1); PG8_BAR; PG8_SCHED;
            PG8_LDA(At, 1, 1); PG8_STAGE(PG8_SB(1, 0), b3, voffB); PG8_STAGE(PG8_SB(1, 1), b3 + hstep, voffB); PG8_STAGE(PG8_SA(1, 0), a3, voffA);
            PG8_WAIT_V(8); PG8_WAIT_L(0); PG8_BAR; PG8_MMA(1, 0, At, B0); PG8_MMA(1, 1, At, B1); PG8_BAR; PG8_SCHED;
            } else {
            PG8_LDB(B0, 0, 0); PG8_SCHED; PG8_LDA(At, 0, 0); PG8_STAGE(PG8_SA(1, 1), a1 + hstep, voffA);
            PG8_WAIT_L(8); PG8_BAR; PG8_WAIT_L(0); PG8_MMA(0, 0, At, B0); PG8_BAR; PG8_SCHED;
            PG8_LDB(B1, 0, 1); PG8_STAGE(PG8_SB(0, 0), b2, voffB);
            PG8_BAR; PG8_WAIT_L(0); PG8_MMA(0, 1, At, B1); PG8_BAR;
            PG8_LDA(At, 0, 1); PG8_STAGE(PG8_SA(0, 0), a2, voffA);
            PG8_BAR; PG8_WAIT_L(0); PG8_MMA(1, 0, At, B0); PG8_BAR; PG8_SCHED;
            PG8_STAGE(PG8_SB(0, 1), b2 + hstep, voffB);
            PG8_WAIT_V(6); PG8_BAR; PG8_MMA(1, 1, At, B1); PG8_BAR;
            PG8_LDB(B0, 1, 0); PG8_SCHED; PG8_LDA(At, 1, 0); PG8_STAGE(PG8_SA(0, 1), a2 + hstep, voffA);
            PG8_WAIT_L(8); PG8_BAR; PG8_WAIT_L(0); PG8_MMA(0, 0, At, B0); PG8_BAR; PG8_SCHED;
            PG8_LDB(B1, 1, 1); PG8_STAGE(PG8_SB(1, 0), b3, voffB);
            PG8_BAR; PG8_WAIT_L(0); PG8_MMA(0, 1, At, B1); PG8_BAR;
            PG8_LDA(At, 1, 1); PG8_STAGE(PG8_SA(1, 0), a3, voffA);
            PG8_BAR; PG8_WAIT_L(0); PG8_MMA(1, 0, At, B0); PG8_BAR; PG8_SCHED;
            PG8_STAGE(PG8_SB(1, 1), b3 + hstep, voffB);
            PG8_WAIT_V(6); PG8_BAR; PG8_MMA(1, 1, At, B1); PG8_BAR;
            }
        }
        if constexpr (ALIGN_EPI) { if (wr == 0) PG8_BAR; }
        if constexpr (!Epi::AFTER_DRAIN) { E(acc, cur, wr, wc, fr, fq); S.done(cur); }
        if (!has_next) break;
#pragma unroll
        for (int a = 0; a < 2; ++a)
#pragma unroll
            for (int b = 0; b < 2; ++b)
#pragma unroll
                for (int m = 0; m < 4; ++m)
#pragma unroll
                    for (int n = 0; n < 2; ++n) acc[a][b][m][n] = (f32x4){0.f, 0.f, 0.f, 0.f};
        cur = nxt; cA = nA; cB = nB; ++ui;
        if constexpr (ALIGN_EPI) { if (wr == 1) PG8_BAR; }
    }
    PG8_WAIT_V(0);
    if constexpr (!ALIGN_EPI) { if (wr == 0) PG8_BAR; }
    PG8_BAR;
    if constexpr (Epi::AFTER_DRAIN) { E.fused(acc, cur, wr, wc, fr, fq, lds, wid, lane); S.done(cur); }
#undef PG8_SA
#undef PG8_SB
#undef PG8_STAGE
#undef PG8_LDA
#undef PG8_LDB
#undef PG8_MMA
#undef PG8_WAIT_V
#undef PG8_WAIT_L
#undef PG8_BAR
#undef PG8_SCHED
}
}
extern __shared__ __attribute__((aligned(16))) unsigned char g_lds[];
using pg8::bf16_t; using pg8::bf16x8; using pg8::f32x4; using pg8::u32x4; using pg8::cvt_pk_bf16; using pg8::bflo; using pg8::bfhi; using pg8::sigm;

constexpr int NTOK = 32768, DM = 1024, SEQ = 2048, NB = 16, ZLD = 5120, NTHR = 512;
constexpr int C_R = 0, C_K = 512, C_V = 1024, C_WD = 1536, C_AD = 1600, C_GD = 1664;
constexpr int C_Q = 1824, C_KA = 2336, C_VA = 2400, C_QI = 2464, C_KI = 2976, C_WI = 3040, C_G0 = 3048, C_G1 = 4072;
constexpr size_t MiB = 1024 * 1024;
constexpr size_t WS_SS1 = 0, WS_SS2 = 128 * 1024, WS_BONUS = 256 * 1024, WS_ROPE = 1280 * 1024, WS_WD = 1792 * 1024, WS_WI = 1856 * 1024, WS_WG = 1920 * 1024;
constexpr size_t WS_WIN = 4 * MiB, WS_WUP = 14 * MiB, WS_WDN = 22 * MiB, WS_WB = 30 * MiB, WS_WO = 32 * MiB, WS_VT = 34 * MiB, WS_H = 38 * MiB, WS_Z = 102 * MiB, WS_P = 422 * MiB, WS_END = 486 * MiB;
constexpr int LDS_BYTES = 163840;

struct Args { const float* in[20]; float* out; unsigned char* ws; int ph_lo, ph_hi; };

struct Frame {
    const float* in[20]; float* out; unsigned char* ws; unsigned char* lds; int tid, lane, wave;
    float *ss1, *ss2, *bonus; float2* rope; bf16_t *wd, *wi, *wg, *win, *wup, *wdn, *wb, *wo, *vt, *h, *ya, *yb, *xb, *z, *hid, *lw, *ic, *mg, *gt; float* yraw;
};

__device__ __forceinline__ bf16_t f2bf(float f) { return (bf16_t)(cvt_pk_bf16(f, 0.f) & 0xffffu); }
__device__ __forceinline__ float bf2f(bf16_t b) { return __uint_as_float(((unsigned)b) << 16); }
template <int CTRL> __device__ __forceinline__ float dpp_mov(float x) { return __int_as_float(__builtin_amdgcn_update_dpp(0, __float_as_int(x), CTRL, 0xF, 0xF, true)); }
__device__ __forceinline__ float red16(float x) { x += dpp_mov<0xB1>(x); x += dpp_mov<0x4E>(x); x += dpp_mov<0x141>(x); x += dpp_mov<0x140>(x); return x; }


__device__ __forceinline__ void lds_barrier() { asm volatile("s_waitcnt lgkmcnt(0)" ::: "memory"); __builtin_amdgcn_s_barrier(); asm volatile("" ::: "memory"); }
__device__ __forceinline__ void red16x4(float& a, float& b, float& c, float& d) {
#define DPP4(ctl) "v_add_f32_dpp %0, %0, %0 " ctl " row_mask:0xf bank_mask:0xf bound_ctrl:1\n" "v_add_f32_dpp %1, %1, %1 " ctl " row_mask:0xf bank_mask:0xf bound_ctrl:1\n" \
                  "v_add_f32_dpp %2, %2, %2 " ctl " row_mask:0xf bank_mask:0xf bound_ctrl:1\n" "v_add_f32_dpp %3, %3, %3 " ctl " row_mask:0xf bank_mask:0xf bound_ctrl:1\n"
    asm volatile("s_nop 1\n" DPP4("quad_perm:[1,0,3,2]") DPP4("quad_perm:[2,3,0,1]") DPP4("row_half_mirror") DPP4("row_mirror") : "+v"(a), "+v"(b), "+v"(c), "+v"(d));
#undef DPP4
}
__device__ __forceinline__ float red32(float x) { x += __shfl_xor(x, 1); x += __shfl_xor(x, 2); x += __shfl_xor(x, 4); x += __shfl_xor(x, 8); x += __shfl_xor(x, 16); return x; }
__device__ __forceinline__ float red64(float x) { x = red32(x); x += __shfl_xor(x, 32); return x; }
__device__ __forceinline__ float softplus_f(float x) { return fmaxf(x, 0.f) + log1pf(__expf(-fabsf(x))); }

__device__ __forceinline__ void tconv(const Frame& F, const float* __restrict__ W, int K, int N, int Npad, bf16_t* __restrict__ Wt, const float* __restrict__ rs) {
    float* tile = (float*)g_lds;
    const int ktn = (K + 63) / 64, ntn = Npad / 64, tid = F.tid;
    for (int tl = blockIdx.x; tl < ktn * ntn; tl += gridDim.x) {
        const int kt = tl % ktn, nt = tl / ktn;
#pragma unroll
        for (int i = 0; i < 2; ++i) { const int idx = tid + i * NTHR, kk = idx >> 4, n4 = (idx & 15) * 4, k = kt * 64 + kk, n = nt * 64 + n4;
            f32x4 v = {0.f, 0.f, 0.f, 0.f};
            if (k < K) { if (n + 3 < N) v = *(const f32x4*)(W + (size_t)k * N + n); else { for (int j = 0; j < 4; ++j) if (n + j < N) v[j] = W[(size_t)k * N + n + j]; }
                if (rs != nullptr) { const float r = rs[k]; v[0] *= r; v[1] *= r; v[2] *= r; v[3] *= r; } }
            tile[kk * 65 + n4] = v[0]; tile[kk * 65 + n4 + 1] = v[1]; tile[kk * 65 + n4 + 2] = v[2]; tile[kk * 65 + n4 + 3] = v[3]; }
        __syncthreads();
        { const int nn = tid >> 3, k8 = (tid & 7) * 8, k = kt * 64 + k8, n = nt * 64 + nn;
          if (k < K) { u32x4 w; const float* tp = tile + k8 * 65 + nn;
              w.x = cvt_pk_bf16(tp[0], tp[65]); w.y = cvt_pk_bf16(tp[130], tp[195]); w.z = cvt_pk_bf16(tp[260], tp[325]); w.w = cvt_pk_bf16(tp[390], tp[455]);
              *(u32x4*)(Wt + (size_t)n * K + k) = w; } }
        __syncthreads();
    }
}
__device__ __forceinline__ void p0_prologue(const Frame& F) {
    const int tid = F.tid, gtid = blockIdx.x * NTHR + tid, gn = gridDim.x * NTHR;
    for (int i = gtid; i < 2 * NTOK; i += gn) F.ss1[i] = 0.f;
    for (int i = gtid; i < SEQ * 32; i += gn) { const int pos = i >> 5, j = i & 31;
        const float inv = 1.0f / powf(10000.0f, (float)(2 * j) / 64.0f); const float ang = (float)pos * inv;
        double rev = (double)ang * 0.15915494309189535; rev -= floor(rev); const float fr = (float)rev;
        F.rope[i] = make_float2(__builtin_amdgcn_cosf(fr), __builtin_amdgcn_sinf(fr)); }
    tconv(F, F.in[2], 1024, 5096, 5120, F.win, nullptr);
    tconv(F, F.in[17], 1024, 4096, 4096, F.wup, F.in[16]);
    tconv(F, F.in[18], 4096, 1024, 1024, F.wdn, nullptr);
    tconv(F, F.in[14], 512, 1024, 1024, F.wb, nullptr);
    tconv(F, F.in[14] + 512 * 1024, 512, 1024, 1024, F.wb + 1024 * 512, nullptr);
    tconv(F, F.in[15], 1024, 1024, 1024, F.wo, nullptr);
    tconv(F, F.in[5], 64, 512, 512, F.wd, nullptr);
    tconv(F, F.in[7], 64, 512, 512, F.wi, nullptr);
    tconv(F, F.in[8], 160, 512, 512, F.wg, nullptr);
    const float* x = F.in[0]; const float* g = F.in[1]; const int lane = F.lane;
    for (int row = blockIdx.x * 8 + F.wave; row < NTOK; row += gridDim.x * 8) {
        const float* xr = x + (size_t)row * DM; f32x4 v[4]; float ss = 0.f;
#pragma unroll
        for (int i = 0; i < 4; ++i) { v[i] = *(const f32x4*)(xr + (i >> 1) * 512 + lane * 8 + (i & 1) * 4); ss += v[i][0] * v[i][0] + v[i][1] * v[i][1] + v[i][2] * v[i][2] + v[i][3] * v[i][3]; }
        ss = red64(ss); const float sc = rsqrtf(ss * (1.0f / 1024.0f) + 1e-6f);
#pragma unroll
        for (int i = 0; i < 2; ++i) { const f32x4 g0 = *(const f32x4*)(g + i * 512 + lane * 8), g1 = *(const f32x4*)(g + i * 512 + lane * 8 + 4); const f32x4 a = v[2 * i], b2 = v[2 * i + 1]; u32x4 w;
            w.x = cvt_pk_bf16(a[0] * sc * g0[0], a[1] * sc * g0[1]); w.y = cvt_pk_bf16(a[2] * sc * g0[2], a[3] * sc * g0[3]);
            w.z = cvt_pk_bf16(b2[0] * sc * g1[0], b2[1] * sc * g1[1]); w.w = cvt_pk_bf16(b2[2] * sc * g1[2], b2[3] * sc * g1[3]);
            *(u32x4*)(F.h + (size_t)row * DM + i * 512 + lane * 8) = w; }
    }
}

__device__ __forceinline__ void p2_prep(const Frame& F, const int mode) {
    const int tid = F.tid, lane = F.lane, wave = F.wave, fr = lane & 15, fq = lane >> 4;
    bf16_t* z = F.z; const float* mu = F.in[3];
    if (mode != 2) {
        constexpr int LDA = 296, TT = 32; bf16_t* At = (bf16_t*)g_lds;
        bf16_t* Ot = At + TT * LDA;
        const float* dbias = F.in[4]; const float* ibias = F.in[6];
        for (int tile = blockIdx.x; tile < NTOK / TT; tile += gridDim.x) {
            const int t0 = tile * TT;
            for (int idx = tid; idx < TT * 36; idx += NTHR) { const int tok = idx / 36, c8 = (idx - tok * 36) * 8, t = t0 + tok, col = C_WD + c8;
                const u32x4 zc = *(const u32x4*)(z + (size_t)t * ZLD + col); u32x4 zp = {0u, 0u, 0u, 0u}; if (t & (SEQ - 1)) zp = *(const u32x4*)(z + (size_t)(t - 1) * ZLD + col);
                const f32x4 m0 = *(const f32x4*)(mu + col), m1 = *(const f32x4*)(mu + col + 4);
                float v[8]; const unsigned zcu[4] = {zc.x, zc.y, zc.z, zc.w}, zpu[4] = {zp.x, zp.y, zp.z, zp.w};
#pragma unroll
                for (int j = 0; j < 4; ++j) { const float a = bflo(zcu[j]), b2 = bfhi(zcu[j]), pa = bflo(zpu[j]), pb = bfhi(zpu[j]);
                    const float mm0 = (j < 2) ? m0[2 * j] : m1[2 * j - 4], mm1 = (j < 2) ? m0[2 * j + 1] : m1[2 * j - 3];
                    v[2 * j] = a + (pa - a) * mm0; v[2 * j + 1] = b2 + (pb - b2) * mm1; }
                if (c8 < 64) {
#pragma unroll
                    for (int j = 0; j < 8; ++j) v[j] = tanhf(v[j]); }
                else if (c8 >= 128) {
#pragma unroll
                    for (int j = 0; j < 8; ++j) v[j] = sigm(v[j]); }
                u32x4 w; w.x = cvt_pk_bf16(v[0], v[1]); w.y = cvt_pk_bf16(v[2], v[3]); w.z = cvt_pk_bf16(v[4], v[5]); w.w = cvt_pk_bf16(v[6], v[7]);
                *(u32x4*)(At + tok * LDA + c8) = w; }
            __syncthreads();
            const int h = wave;
            bf16x8 Bc[9], Bn[9];
            { const int n = h * 64 + fr;
#pragma unroll
              for (int ks = 0; ks < 2; ++ks) { Bc[ks] = *(const bf16x8*)(F.wd + n * 64 + ks * 32 + fq * 8); Bc[2 + ks] = *(const bf16x8*)(F.wi + n * 64 + ks * 32 + fq * 8); }
#pragma unroll
              for (int ks = 0; ks < 5; ++ks) Bc[4 + ks] = *(const bf16x8*)(F.wg + n * 160 + ks * 32 + fq * 8); }
#pragma unroll 1
            for (int j = 0; j < 4; ++j) { const int n = h * 64 + j * 16 + fr;
                if (j < 3) { const int nn = n + 16;
#pragma unroll
                    for (int ks = 0; ks < 2; ++ks) { Bn[ks] = *(const bf16x8*)(F.wd + nn * 64 + ks * 32 + fq * 8); Bn[2 + ks] = *(const bf16x8*)(F.wi + nn * 64 + ks * 32 + fq * 8); }
#pragma unroll
                    for (int ks = 0; ks < 5; ++ks) Bn[4 + ks] = *(const bf16x8*)(F.wg + nn * 160 + ks * 32 + fq * 8); }
                const float db = dbias[n], ib = ibias[n];
#pragma unroll
                for (int mt = 0; mt < 2; ++mt) {
                    f32x4 ad = {0.f, 0.f, 0.f, 0.f}, ai = ad, ag = ad; const bf16_t* ap = At + (mt * 16 + fr) * LDA + fq * 8;
#pragma unroll
                    for (int ks = 0; ks < 2; ++ks) ad = __builtin_amdgcn_mfma_f32_16x16x32_bf16(*(const bf16x8*)(ap + ks * 32), Bc[ks], ad, 0, 0, 0);
#pragma unroll
                    for (int ks = 0; ks < 2; ++ks) ai = __builtin_amdgcn_mfma_f32_16x16x32_bf16(*(const bf16x8*)(ap + 64 + ks * 32), Bc[2 + ks], ai, 0, 0, 0);
#pragma unroll
                    for (int ks = 0; ks < 5; ++ks) ag = __builtin_amdgcn_mfma_f32_16x16x32_bf16(*(const bf16x8*)(ap + 128 + ks * 32), Bc[4 + ks], ag, 0, 0, 0);
#pragma unroll
                    for (int jj = 0; jj < 4; ++jj) {
                        const float dw = db + ad[jj]; const float wlog = -softplus_f(-dw) - 0.5f; const float lwv = -__expf(wlog);
                        const int tk = mt * 16 + fq * 4 + jj; Ot[tk * 520 + n] = f2bf(lwv); Ot[(TT + tk) * 520 + n] = f2bf(sigm(ib + ai[jj])); Ot[(2 * TT + tk) * 520 + n] = f2bf(ag[jj]); }
                }
#pragma unroll
                for (int q = 0; q < 9; ++q) Bc[q] = Bn[q];
            }
            __syncthreads();
#pragma unroll
            for (int i = 0; i < 12; ++i) { const int idx = tid + i * NTHR, arr = idx >> 11, rem = idx & 2047, tk = rem >> 6, c8 = (rem & 63) * 8;
                const u32x4 w = *(const u32x4*)(Ot + (arr * TT + tk) * 520 + c8); bf16_t* dst = arr == 0 ? F.lw : (arr == 1 ? F.ic : F.gt);
                *(u32x4*)(dst + (size_t)(t0 + tk) * 512 + c8) = w; }
            __syncthreads();
        }
    }
    if (mode != 2) {
        unsigned short* tl = (unsigned short*)g_lds;
        for (int tile = blockIdx.x; tile < NTOK / 64; tile += gridDim.x) { const int t0 = tile * 64, b = t0 / SEQ, tt0 = t0 % SEQ;
            { const int tok = tid >> 3, d8 = (tid & 7) * 8; *(u32x4*)(tl + tok * 72 + d8) = *(const u32x4*)(z + (size_t)(t0 + tok) * ZLD + C_VA + d8); }
            __syncthreads();
            { const int d = tid >> 3, k8 = (tid & 7) * 8; unsigned short e[8];
#pragma unroll
              for (int j = 0; j < 8; ++j) e[j] = tl[(k8 + j) * 72 + d];
              u32x4 w; w.x = e[0] | ((unsigned)e[1] << 16); w.y = e[2] | ((unsigned)e[3] << 16); w.z = e[4] | ((unsigned)e[5] << 16); w.w = e[6] | ((unsigned)e[7] << 16);
              *(u32x4*)(F.vt + ((size_t)b * 64 + d) * SEQ + tt0 + k8) = w; }
            __syncthreads();
        }
    }
    if (mode != 0) {
        const int gtid = blockIdx.x * NTHR + tid, gn = gridDim.x * NTHR;
        for (int idx = gtid; idx < NTOK * 72; idx += gn) { const int t = idx / 72, p = idx - t * 72, hd = p >> 2, i8 = (p & 3) * 8;
            const int base = hd < 8 ? C_Q + hd * 64 : (hd == 8 ? C_KA : (hd < 17 ? C_QI + (hd - 9) * 64 : C_KI));
            const float* rp = (const float*)&F.rope[(t & (SEQ - 1)) * 32 + i8];
            f32x4 cs[4];
#pragma unroll
            for (int j = 0; j < 4; ++j) { cs[j] = *(const f32x4*)(rp + 4 * j); if (mode == 2) cs[j] = (f32x4){1.f, 0.f, 1.f, 0.f}; }
            bf16_t* p1 = z + (size_t)t * ZLD + base + i8; const u32x4 a = *(const u32x4*)(p1), b2 = *(const u32x4*)(p1 + 32);
            const unsigned au[4] = {a.x, a.y, a.z, a.w}, bu[4] = {b2.x, b2.y, b2.z, b2.w}; unsigned o1[4], o2[4];
#pragma unroll
            for (int j = 0; j < 4; ++j) { const float x1a = bflo(au[j]), x1b = bfhi(au[j]), x2a = bflo(bu[j]), x2b = bfhi(bu[j]);
                o1[j] = cvt_pk_bf16(x1a * cs[j][0] - x2a * cs[j][1], x1b * cs[j][2] - x2b * cs[j][3]);
                o2[j] = cvt_pk_bf16(x2a * cs[j][0] + x1a * cs[j][1], x2b * cs[j][2] + x1b * cs[j][3]); }
            u32x4 w1, w2; w1.x = o1[0]; w1.y = o1[1]; w1.z = o1[2]; w1.w = o1[3]; w2.x = o2[0]; w2.y = o2[1]; w2.z = o2[2]; w2.w = o2[3];
            *(u32x4*)(p1) = w1; *(u32x4*)(p1 + 32) = w2; }
    }
}

struct ScanRaw { uint2 zr_c, zr_p, zk_c, zk_p, zv_c, zv_p, lwu, icu; };
struct ScanConst { f32x4 mur, muk, muv, kk, ka, rk; };
__device__ __forceinline__ void scan_load(ScanRaw& R, const bf16_t* z, const bf16_t* lw, const bf16_t* ic, size_t tokbase, int ch, int ptok, int gc) {
    const int t = ch * 16 + ptok; const size_t T = tokbase + t; const bf16_t* zp = z + T * ZLD + gc;
    R.zr_c = *(const uint2*)(zp + C_R); R.zk_c = *(const uint2*)(zp + C_K); R.zv_c = *(const uint2*)(zp + C_V);
    const uint2 zz = make_uint2(0u, 0u);
    if (t > 0) { R.zr_p = *(const uint2*)(zp - ZLD + C_R); R.zk_p = *(const uint2*)(zp - ZLD + C_K); R.zv_p = *(const uint2*)(zp - ZLD + C_V); } else { R.zr_p = zz; R.zk_p = zz; R.zv_p = zz; }
    R.lwu = *(const uint2*)(lw + T * 512 + gc); R.icu = *(const uint2*)(ic + T * 512 + gc);
}
__device__ __forceinline__ f32x4 unpack4(uint2 u) { f32x4 r; r[0] = bflo(u.x); r[1] = bfhi(u.x); r[2] = bflo(u.y); r[3] = bfhi(u.y); return r; }
__device__ __forceinline__ void scan_prep(const ScanRaw& R, const ScanConst& C, float* ops, float* vv, float* bonus_out, bool wr_bonus, int ptok, int pc, int v0) {
    const f32x4 rc = unpack4(R.zr_c), rp = unpack4(R.zr_p), kc = unpack4(R.zk_c), kp = unpack4(R.zk_p), vc = unpack4(R.zv_c), vp = unpack4(R.zv_p), ic = unpack4(R.icu), lw = unpack4(R.lwu);
    const f32x4 r = rc + (rp - rc) * C.mur, k = kc + (kp - kc) * C.muk, vs = vc + (vp - vc) * C.muv;
    f32x4 w; w[0] = __expf(lw[0]); w[1] = __expf(lw[1]); w[2] = __expf(lw[2]); w[3] = __expf(lw[3]);
    const f32x4 q = k * C.kk; const float ss = red16((q[0] * q[0] + q[1] * q[1]) + (q[2] * q[2] + q[3] * q[3]));
    const float inv = 1.0f / fmaxf(sqrtf(ss), 1e-12f); const f32x4 n = q * inv;
    const f32x4 kn = k * (1.0f + (ic - 1.0f) * C.ka);
    const f32x4 bt = r * kn * C.rk; const float bon = red16((bt[0] + bt[1]) + (bt[2] + bt[3]));
    if (wr_bonus) *bonus_out = bon;
    float* op = ops + ptok * 320 + pc;
    *(f32x4*)(op) = -n; *(f32x4*)(op + 64) = w; *(f32x4*)(op + 128) = n * ic; *(f32x4*)(op + 192) = kn; *(f32x4*)(op + 256) = r;
    if (pc >= v0 && pc < v0 + 32) *(f32x4*)(vv + ptok * 32 + pc - v0) = vs;
}
__device__ __forceinline__ void p3_scan(const Frame& F, const int mode) {
    const int tid = F.tid;
    float* opsb = (float*)g_lds;
    float* vvb = opsb + 2 * 5120;
    float* yob = vvb + 2 * 512;
    const bf16_t* z = F.z; const float* mu = F.in[3]; const float* k_k = F.in[9]; const float* k_a = F.in[10]; const float* r_k = F.in[11];
    for (int item = blockIdx.x; item < 256; item += gridDim.x) {
        const int bh = item >> 1, half = item & 1, b = bh >> 3, h = bh & 7, v0 = half * 32;
        const size_t tokbase = (size_t)b * SEQ;
        if (F.wave >= 4) {
            const int pt = tid - 256, ptok = pt >> 4, pc = (pt & 15) * 4, gc = h * 64 + pc;
            ScanConst C; C.mur = *(const f32x4*)(mu + C_R + gc); C.muk = *(const f32x4*)(mu + C_K + gc); C.muv = *(const f32x4*)(mu + C_V + gc);
            C.kk = *(const f32x4*)(k_k + gc); C.ka = *(const f32x4*)(k_a + gc); C.rk = *(const f32x4*)(r_k + gc);
            const bool wrb = (half == 0) && ((pt & 15) == 0);
            ScanRaw R;
            scan_load(R, z, F.lw, F.ic, tokbase, 0, ptok, gc);
            scan_prep(R, C, opsb, vvb, F.bonus + (tokbase + ptok) * 8 + h, wrb, ptok, pc, v0);
            scan_load(R, z, F.lw, F.ic, tokbase, 1, ptok, gc);
            lds_barrier();
            for (int ch = 0; ch < SEQ / 16; ++ch) {
                const int cur = ch & 1, nxt = cur ^ 1;
                if (mode != 2) {
                if (ch > 0) { const int tok = pt >> 4, r2 = (pt & 15) * 2;
                    *(float2*)(F.yraw + (tokbase + (ch - 1) * 16 + tok) * 512 + h * 64 + v0 + r2) = *(const float2*)(yob + nxt * 512 + tok * 32 + r2); }
                if (ch + 1 < SEQ / 16) {
                    scan_prep(R, C, opsb + nxt * 5120, vvb + nxt * 512, F.bonus + (tokbase + (ch + 1) * 16 + ptok) * 8 + h, wrb, ptok, pc, v0);
                    if (ch + 2 < SEQ / 16) scan_load(R, z, F.lw, F.ic, tokbase, ch + 2, ptok, gc);
                } }
                lds_barrier();
            }
            { const int tok = pt >> 4, r2 = (pt & 15) * 2;
              *(float2*)(F.yraw + (tokbase + (SEQ / 16 - 1) * 16 + tok) * 512 + h * 64 + v0 + r2) = *(const float2*)(yob + 512 + tok * 32 + r2); }
        } else {
            const int rp = tid >> 4, ks = tid & 15;
            float A0 = 0.f, A1 = 0.f, A2 = 0.f, A3 = 0.f, B0 = 0.f, B1 = 0.f, B2 = 0.f, B3 = 0.f;
            const int ywoff = (ks == 0) ? 2 * rp : (2 * 512 + 2 * tid), ywstep = (ks == 0) ? 32 : 0;
            lds_barrier();
            f32x4 rprev = {0.f, 0.f, 0.f, 0.f}; float* ywp = yob + 2 * 512 + 2 * tid;
            for (int ch = 0; ch < SEQ / 16; ++ch) {
                const int cur = ch & 1;
                const float* ops = opsb + cur * 5120 + ks * 4; const float* vv = vvb + cur * 512 + 2 * rp; float* yw = yob + cur * 512 + ywoff;
                if (mode != 1) {
#pragma unroll
                for (int s = 0; s < 16; ++s) {
                    const float* o = ops + s * 320;
                    const f32x4 a4 = *(const f32x4*)(o), w4 = *(const f32x4*)(o + 64), b4 = *(const f32x4*)(o + 128), k4 = *(const f32x4*)(o + 192), r4 = *(const f32x4*)(o + 256);
                    const float2 vab = *(const float2*)(vv + s * 32);
                    float sa = (A0 * a4[0] + A1 * a4[1]) + (A2 * a4[2] + A3 * a4[3]); float sb = (B0 * a4[0] + B1 * a4[1]) + (B2 * a4[2] + B3 * a4[3]);
                    float ya = (A0 * rprev[0] + A1 * rprev[1]) + (A2 * rprev[2] + A3 * rprev[3]); float yb2 = (B0 * rprev[0] + B1 * rprev[1]) + (B2 * rprev[2] + B3 * rprev[3]);
                    red16x4(sa, sb, ya, yb2);
                    *(float2*)(ywp) = make_float2(ya, yb2);
                    ywp = yw + s * ywstep;
                    A0 = A0 * w4[0] + sa * b4[0] + vab.x * k4[0]; A1 = A1 * w4[1] + sa * b4[1] + vab.x * k4[1];
                    A2 = A2 * w4[2] + sa * b4[2] + vab.x * k4[2]; A3 = A3 * w4[3] + sa * b4[3] + vab.x * k4[3];
                    B0 = B0 * w4[0] + sb * b4[0] + vab.y * k4[0]; B1 = B1 * w4[1] + sb * b4[1] + vab.y * k4[1];
                    B2 = B2 * w4[2] + sb * b4[2] + vab.y * k4[2]; B3 = B3 * w4[3] + sb * b4[3] + vab.y * k4[3];
                    rprev = r4;
                }
                {
                    float ya = (A0 * rprev[0] + A1 * rprev[1]) + (A2 * rprev[2] + A3 * rprev[3]); float yb2 = (B0 * rprev[0] + B1 * rprev[1]) + (B2 * rprev[2] + B3 * rprev[3]);
                    float d0 = 0.f, d1 = 0.f; red16x4(ya, yb2, d0, d1);
                    *(float2*)(ywp) = make_float2(ya, yb2); ywp = yob + 2 * 512 + 2 * tid; rprev = (f32x4){0.f, 0.f, 0.f, 0.f};
                } }
                lds_barrier();
            }
        }
        __syncthreads();
    }
}

__device__ __forceinline__ unsigned ordkey(float f) { const unsigned u = __float_as_uint(f); return (u & 0x80000000u) ? ~u : (u | 0x80000000u); }

__device__ __forceinline__ void attn_chunk(const unsigned char* kb, const unsigned char* vb, const unsigned* selm, int c, int p, int fr, int fq, const bf16x8 (&Bqa)[2][2], f32x4 (&O)[2][4], f32x4 (&RS)[2]) {
    const f32x4 zero4 = {0.f, 0.f, 0.f, 0.f};
    const u32x4 onesu = {0x3f803f80u, 0x3f803f80u, 0x3f803f80u, 0x3f803f80u}; const bf16x8 ones = __builtin_bit_cast(bf16x8, onesu);
    const float csc = 0.125f * 1.4426950408889634f;
    const unsigned char* k0p = kb + ((2 * p) * 16 + fr) * 144 + fq * 16; const unsigned char* k1p = k0p + 16 * 144;
    const bf16x8 KA00 = *(const bf16x8*)(k0p), KA01 = *(const bf16x8*)(k0p + 64), KA10 = *(const bf16x8*)(k1p), KA11 = *(const bf16x8*)(k1p + 64);
    const int mw = (int)selm[fr * 64 + 2 * c + p];
    bf16x8 VA[4];
#pragma unroll
    for (int dt = 0; dt < 4; ++dt) { const unsigned char* vp = vb + (dt * 16 + fr) * 144 + (2 * p) * 32 + fq * 8;
        const uint2 lo = *(const uint2*)(vp), hi = *(const uint2*)(vp + 32);
        u32x4 va; va.x = lo.x; va.y = lo.y; va.z = hi.x; va.w = hi.y; VA[dt] = __builtin_bit_cast(bf16x8, va); }
    unsigned km0[4], km1[4];
#pragma unroll
    for (int jj = 0; jj < 4; ++jj) { km0[jj] = (unsigned)__builtin_amdgcn_sbfe(mw, fq * 4 + jj, 1); km1[jj] = (unsigned)__builtin_amdgcn_sbfe(mw, 16 + fq * 4 + jj, 1); }
#pragma unroll
    for (int hh = 0; hh < 2; ++hh) {
        f32x4 s0 = __builtin_amdgcn_mfma_f32_16x16x32_bf16(KA00, Bqa[hh][0], zero4, 0, 0, 0); s0 = __builtin_amdgcn_mfma_f32_16x16x32_bf16(KA01, Bqa[hh][1], s0, 0, 0, 0);
        f32x4 s1 = __builtin_amdgcn_mfma_f32_16x16x32_bf16(KA10, Bqa[hh][0], zero4, 0, 0, 0); s1 = __builtin_amdgcn_mfma_f32_16x16x32_bf16(KA11, Bqa[hh][1], s1, 0, 0, 0);
        unsigned p0[4], p1[4];
#pragma unroll
        for (int jj = 0; jj < 4; ++jj) {
            p0[jj] = __float_as_uint(__builtin_amdgcn_exp2f(fminf(s0[jj] * csc, 86.f))) & km0[jj]; p1[jj] = __float_as_uint(__builtin_amdgcn_exp2f(fminf(s1[jj] * csc, 86.f))) & km1[jj]; }
        u32x4 pk; pk.x = cvt_pk_bf16(__uint_as_float(p0[0]), __uint_as_float(p0[1])); pk.y = cvt_pk_bf16(__uint_as_float(p0[2]), __uint_as_float(p0[3]));
        pk.z = cvt_pk_bf16(__uint_as_float(p1[0]), __uint_as_float(p1[1])); pk.w = cvt_pk_bf16(__uint_as_float(p1[2]), __uint_as_float(p1[3]));
        const bf16x8 PB = __builtin_bit_cast(bf16x8, pk);
        RS[hh] = __builtin_amdgcn_mfma_f32_16x16x32_bf16(ones, PB, RS[hh], 0, 0, 0);
#pragma unroll
        for (int dt = 0; dt < 4; ++dt) O[hh][dt] = __builtin_amdgcn_mfma_f32_16x16x32_bf16(VA[dt], PB, O[hh][dt], 0, 0, 0);
    }
}

__device__ __forceinline__ void p3_dsa(const Frame& F) {
    const int tid = F.tid, lane = F.lane, wave = F.wave, fr = lane & 15, fq = lane >> 4;
    unsigned* scl = (unsigned*)g_lds;
    unsigned* selm = (unsigned*)(g_lds + 131328);
    unsigned char* kbuf = (unsigned char*)g_lds;
    unsigned char* vbuf = kbuf + 2 * 9216;
    const bf16_t* z = F.z; const int G = gridDim.x, bx = blockIdx.x;
    const f32x4 zero4 = {0.f, 0.f, 0.f, 0.f};
    for (int rnd = 0; rnd * G < 2048; ++rnd) {
        const int n = rnd * G + ((rnd & 1) ? (G - 1 - bx) : bx);
        if (n >= 2048) continue;
        const int qg = 127 - (n >> 4), b = n & 15, q0 = qg * 16; const size_t Tb = (size_t)b * SEQ;
        for (int i = tid; i < 1024; i += NTHR) selm[i] = 0u;
        __syncthreads();
        const bf16_t* zq = z + (Tb + q0 + fr) * ZLD;
        const unsigned lofk = (unsigned)((fr * ZLD + fq * 8) * 2), lofv = (unsigned)((fr * SEQ + fq * 4) * 2);
        const int nchunk = (qg + 4) >> 2; const int lrow = tid >> 3, lseg = tid & 7;
        const bf16_t* kg = z + (Tb + lrow) * ZLD + C_KA + lseg * 8; const bf16_t* vg = F.vt + ((size_t)b * 64 + lrow) * SEQ + lseg * 8;
        const unsigned lst = (unsigned)(lrow * 144 + lseg * 16);
        const int hp = wave >> 1, kh = wave & 1;
        const u32x4 kc0 = *(const u32x4*)(kg), vc0 = *(const u32x4*)(vg);
        u32x4 kx = kc0, vx = vc0, ky = kc0, vy = vc0;
        if (1 < nchunk) { kx = *(const u32x4*)(kg + (size_t)64 * ZLD); vx = *(const u32x4*)(vg + 64); }
        if (2 < nchunk) { ky = *(const u32x4*)(kg + (size_t)128 * ZLD); vy = *(const u32x4*)(vg + 128); }
        bf16x8 Bqa[2][2];
#pragma unroll
        for (int hh = 0; hh < 2; ++hh)
#pragma unroll
            for (int ks = 0; ks < 2; ++ks) Bqa[hh][ks] = *(const bf16x8*)(zq + C_Q + (2 * hp + hh) * 64 + ks * 32 + fq * 8);
        if (qg >= 16) {
            const u32x4 wv = *(const u32x4*)(zq + C_WI);
            {
                bf16x8 Bq[8][2];
#pragma unroll
                for (int hh = 0; hh < 8; ++hh)
#pragma unroll
                    for (int ks = 0; ks < 2; ++ks) Bq[hh][ks] = *(const bf16x8*)(zq + C_QI + hh * 64 + ks * 32 + fq * 8);
                const float sc = 0.044194173824159216f;
                float wih[8]; wih[0] = bflo(wv.x) * sc; wih[1] = bfhi(wv.x) * sc; wih[2] = bflo(wv.y) * sc; wih[3] = bfhi(wv.y) * sc; wih[4] = bflo(wv.z) * sc; wih[5] = bfhi(wv.z) * sc; wih[6] = bflo(wv.w) * sc; wih[7] = bfhi(wv.w) * sc;
#pragma unroll 1
                for (int half = 0; half < 2; ++half) {
                    const int ktb = wave + 64 * half; if (ktb > qg) break;
                    bf16x8 W0[2], W1[2];
#pragma unroll
                    for (int j = 0; j < 2; ++j) { const int ktj = (ktb + 8 * j) < qg ? (ktb + 8 * j) : qg; const char* kb = (const char*)(z + (Tb + (size_t)ktj * 16) * ZLD + C_KI);
                        W0[j] = *(const bf16x8*)(kb + lofk); W1[j] = *(const bf16x8*)(kb + lofk + 64); }
#pragma unroll
                    for (int i = 0; i < 8; ++i) { const int kt = ktb + 8 * i;
                        if (kt <= qg) { f32x4 sv = zero4;
#pragma unroll
                            for (int hh = 0; hh < 8; ++hh) { f32x4 acc = __builtin_amdgcn_mfma_f32_16x16x32_bf16(W0[i & 1], Bq[hh][0], zero4, 0, 0, 0);
                                acc = __builtin_amdgcn_mfma_f32_16x16x32_bf16(W1[i & 1], Bq[hh][1], acc, 0, 0, 0);
#pragma unroll
                                for (int jj = 0; jj < 4; ++jj) sv[jj] += wih[hh] * fmaxf(acc[jj], 0.f); }
                            u32x4 w; w.x = ordkey(sv[0]); w.y = ordkey(sv[1]); w.z = ordkey(sv[2]); w.w = ordkey(sv[3]);
                            *(u32x4*)(scl + fr * 2052 + kt * 16 + fq * 4) = w;
                        }
                        if (i + 2 < 8) { const int ktn = (kt + 16) < qg ? (kt + 16) : qg; const char* kb = (const char*)(z + (Tb + (size_t)ktn * 16) * ZLD + C_KI);
                            unsigned lo2 = lofk; asm volatile("" : "+v"(lo2));
                            W0[i & 1] = *(const bf16x8*)(kb + lo2); W1[i & 1] = *(const bf16x8*)(kb + lo2 + 64); }
                    }
                }
            }
            __syncthreads();
#pragma unroll 1
            for (int qq = 0; qq < 2; ++qq) {
                const int q = 2 * wave + qq, qpos = q0 + q;
                unsigned uk[32];
#pragma unroll
                for (int r = 0; r < 32; ++r) { const int key = r * 64 + lane; uk[r] = 0x007fffffu;
                    if (r * 64 <= qpos) { const unsigned v = scl[q * 2052 + key]; uk[r] = (key <= qpos) ? v : 0x007fffffu; } }
                unsigned T = 0u; bool exact = false;
#pragma unroll 1
                for (int bit = 31; bit >= 0; --bit) {
                    const unsigned cand = T | (1u << bit); int c = 0;
#pragma unroll
                    for (int g = 0; g < 4; ++g) {
                        if (g * 512 > qpos) break;
                        unsigned long long m[8];
                        asm("v_cmp_ge_u32_e64 %0, %8, %16\n\tv_cmp_ge_u32_e64 %1, %9, %16\n\tv_cmp_ge_u32_e64 %2, %10, %16\n\tv_cmp_ge_u32_e64 %3, %11, %16\n\t"
                            "v_cmp_ge_u32_e64 %4, %12, %16\n\tv_cmp_ge_u32_e64 %5, %13, %16\n\tv_cmp_ge_u32_e64 %6, %14, %16\n\tv_cmp_ge_u32_e64 %7, %15, %16"
                            : "=&s"(m[0]), "=&s"(m[1]), "=&s"(m[2]), "=&s"(m[3]), "=&s"(m[4]), "=&s"(m[5]), "=&s"(m[6]), "=&s"(m[7])
                            : "v"(uk[g * 8 + 0]), "v"(uk[g * 8 + 1]), "v"(uk[g * 8 + 2]), "v"(uk[g * 8 + 3]), "v"(uk[g * 8 + 4]), "v"(uk[g * 8 + 5]), "v"(uk[g * 8 + 6]), "v"(uk[g * 8 + 7]), "v"(cand));
#pragma unroll
                        for (int j = 0; j < 8; ++j) c += __builtin_popcountll(m[j]);
                    }
                    if (c >= 256) { T = cand; if (c == 256) { exact = true; break; } }
                }
                int need = 0;
                if (!exact) { int c = 0;
#pragma unroll
                    for (int r = 0; r < 32; ++r) c += __builtin_popcountll(__builtin_amdgcn_ballot_w64(uk[r] > T));
                    need = 256 - c; }
#pragma unroll
                for (int r = 0; r < 32; ++r) {
                    if (r * 64 <= qpos) {
                        unsigned long long sel;
                        if (exact) sel = __builtin_amdgcn_ballot_w64(uk[r] >= T);
                        else { sel = __builtin_amdgcn_ballot_w64(uk[r] > T); unsigned long long e = __builtin_amdgcn_ballot_w64(uk[r] == T);
                            const int ne = __builtin_popcountll(e);
                            if (ne <= need) { sel |= e; need -= ne; }
                            else { for (int k = 0; k < need; ++k) { const unsigned long long lb = e & (0ull - e); sel |= lb; e ^= lb; } need = 0; } }
                        if (lane == 0) { selm[q * 64 + 2 * r] = (unsigned)sel; selm[q * 64 + 2 * r + 1] = (unsigned)(sel >> 32); }
                    }
                }
            }
        } else {
            for (int w = tid; w < 1024; w += NTHR) { const int q = w >> 6, word = w & 63, qpos = q0 + q, lo = word * 32;
                selm[w] = (qpos >= lo + 31) ? 0xffffffffu : (qpos < lo ? 0u : ((2u << (qpos - lo)) - 1u)); }
        }
        __syncthreads();
        {
            *(u32x4*)(kbuf + lst) = kc0; *(u32x4*)(vbuf + lst) = vc0;
            f32x4 O[2][4]; f32x4 rs[2];
#pragma unroll
            for (int hh = 0; hh < 2; ++hh) { rs[hh] = zero4;
#pragma unroll
                for (int dt = 0; dt < 4; ++dt) O[hh][dt] = zero4; }
            lds_barrier();
#pragma unroll 1
            for (int c = 0; c < nchunk; c += 2) {
                attn_chunk(kbuf, vbuf, selm, c, kh, fr, fq, Bqa, O, rs);
                if (c + 1 < nchunk) { *(u32x4*)(kbuf + 9216 + lst) = kx; *(u32x4*)(vbuf + 9216 + lst) = vx; }
                if (c + 3 < nchunk) { kx = *(const u32x4*)(kg + (size_t)(c + 3) * 64 * ZLD); vx = *(const u32x4*)(vg + (c + 3) * 64); }
                lds_barrier();
                if (c + 1 < nchunk) {
                    attn_chunk(kbuf + 9216, vbuf + 9216, selm, c + 1, kh, fr, fq, Bqa, O, rs);
                    if (c + 2 < nchunk) { *(u32x4*)(kbuf + lst) = ky; *(u32x4*)(vbuf + lst) = vy; }
                    if (c + 4 < nchunk) { ky = *(const u32x4*)(kg + (size_t)(c + 4) * 64 * ZLD); vy = *(const u32x4*)(vg + (c + 4) * 64); }
                    lds_barrier();
                }
            }
            float* xb = (float*)(vbuf + 2 * 9216) + (size_t)wave * (64 * 17);
            { const int oh = kh ^ 1;
#pragma unroll
              for (int dt = 0; dt < 4; ++dt)
#pragma unroll
                  for (int jj = 0; jj < 4; ++jj) xb[(dt * 4 + jj) * 64 + lane] = (oh == 0) ? O[0][dt][jj] : O[1][dt][jj];
              xb[16 * 64 + lane] = (oh == 0) ? rs[0][0] : rs[1][0]; }
            lds_barrier();
            { const float* pb = (const float*)(vbuf + 2 * 9216) + (size_t)(wave ^ 1) * (64 * 17);
              float tot = ((kh == 0) ? rs[0][0] : rs[1][0]) + pb[16 * 64 + lane];
              const float inv = 1.0f / tot;
              bf16_t* yp = F.yb + (Tb + q0 + fr) * 512 + (2 * hp + kh) * 64 + fq * 4;
#pragma unroll
              for (int dt = 0; dt < 4; ++dt) { float o[4];
#pragma unroll
                  for (int jj = 0; jj < 4; ++jj) o[jj] = (((kh == 0) ? O[0][dt][jj] : O[1][dt][jj]) + pb[(dt * 4 + jj) * 64 + lane]) * inv;
                  uint2 w; w.x = cvt_pk_bf16(o[0], o[1]); w.y = cvt_pk_bf16(o[2], o[3]); *(uint2*)(yp + dt * 16) = w; } }
        }
        __syncthreads();
    }
}

__device__ __forceinline__ void p4_post(const Frame& F) {
    const int tid = F.tid; const float* mu = F.in[3]; const float* gnw = F.in[12]; const float* gnb = F.in[13]; const bf16_t* z = F.z;
    for (int g = blockIdx.x * 32 + (tid >> 4); g < NTOK * 8; g += gridDim.x * 32) { const size_t t = (size_t)(g >> 3); const int h = g & 7, c = h * 64 + (tid & 15) * 4;
        const f32x4 y = *(const f32x4*)(F.yraw + t * 512 + c);
        const float mean = red16((y[0] + y[1]) + (y[2] + y[3])) * (1.0f / 64.0f);
        const f32x4 d = y - mean;
        const float var = red16((d[0] * d[0] + d[1] * d[1]) + (d[2] * d[2] + d[3] * d[3])) * (1.0f / 64.0f); const float rstd = rsqrtf(var + 64e-5f);
        const uint2 vc = *(const uint2*)(z + t * ZLD + C_V + c); uint2 vp = make_uint2(0u, 0u); if (t & (SEQ - 1)) vp = *(const uint2*)(z + (t - 1) * ZLD + C_V + c);
        const f32x4 m4 = *(const f32x4*)(mu + C_V + c), w4 = *(const f32x4*)(gnw + c), b4 = *(const f32x4*)(gnb + c);
        const uint2 gt = *(const uint2*)(F.gt + t * 512 + c); const float bon = F.bonus[t * 8 + h];
        f32x4 vcf, vpf, gtf; vcf[0] = bflo(vc.x); vcf[1] = bfhi(vc.x); vcf[2] = bflo(vc.y); vcf[3] = bfhi(vc.y); vpf[0] = bflo(vp.x); vpf[1] = bfhi(vp.x); vpf[2] = bflo(vp.y); vpf[3] = bfhi(vp.y);
        gtf[0] = bflo(gt.x); gtf[1] = bfhi(gt.x); gtf[2] = bflo(gt.y); gtf[3] = bfhi(gt.y);
        const f32x4 vs = vcf + (vpf - vcf) * m4;
        const f32x4 o = (d * rstd * w4 + b4 + vs * bon) * gtf;
        uint2 w; w.x = cvt_pk_bf16(o[0], o[1]); w.y = cvt_pk_bf16(o[2], o[3]); *(uint2*)(F.ya + t * 512 + c) = w; }
}

__device__ __forceinline__ void p9_final(const Frame& F, const bool ident) {
    const float* g = F.in[19]; const int lane = F.lane;
    for (int row = blockIdx.x * 8 + F.wave; row < NTOK; row += gridDim.x * 8) {
        float* xr = F.out + (size_t)row * DM; const float sc = ident ? 1.0f : rsqrtf(F.ss2[row] * (1.0f / 1024.0f) + 1e-6f);
#pragma unroll
        for (int i = 0; i < 4; ++i) { f32x4 v = *(const f32x4*)(xr + i * 256 + lane * 4); const f32x4 gg = *(const f32x4*)(g + i * 256 + lane * 4);
            if (!ident) { v[0] *= sc * gg[0]; v[1] *= sc * gg[1]; v[2] *= sc * gg[2]; v[3] *= sc * gg[3]; } *(f32x4*)(xr + i * 256 + lane * 4) = v; }
    }
}
#define XB_TMO      128
#define XB_XCNT(j)  (256  + 64 * (j))
#define XB_XSUB(j)  (1280 + 64 * (j))
#define XB_XGEN(j)  (2304 + 64 * (j))
#define XB_TOP      3328
#define XB_TOPGEN   3392
#define XCD_BAR_WORDS 3456
#define XB_SPIN_CAP (1u << 18)
#define LAS __attribute__((address_space(3)))

__device__ __forceinline__ unsigned xb_ld(unsigned* p)              { return __hip_atomic_load(p, __ATOMIC_RELAXED, __HIP_MEMORY_SCOPE_AGENT); }
__device__ __forceinline__ unsigned xb_add(unsigned* p, unsigned v) { return __hip_atomic_fetch_add(p, v, __ATOMIC_RELAXED, __HIP_MEMORY_SCOPE_AGENT); }
__device__ __forceinline__ unsigned xb_xcc_id() { return (unsigned)__builtin_amdgcn_s_getreg((3 << 11) | 20) & 0xFu; }
#define XB_SPIN(cond, bar) do { unsigned _sp = 0; while (cond) { __builtin_amdgcn_s_sleep(1); \
    if ((++_sp & 255u) == 0u) { if (xb_ld(&(bar)[XB_TMO])) break; if (_sp > XB_SPIN_CAP) { atomicAdd(&(bar)[XB_TMO], 1u); break; } } } } while (0)

struct XcdBarrier {
    unsigned* bar; unsigned x;
    volatile LAS unsigned* st;
};

__device__ __forceinline__ XcdBarrier xcd_barrier_post(unsigned* bar, volatile LAS unsigned* st) {
    XcdBarrier b; b.bar = bar; b.x = xb_xcc_id(); b.st = st;
    if (threadIdx.x == 0) (void)xb_add(&bar[XB_XCNT(b.x)], 1u);
    return b;
}
__device__ __forceinline__ void xcd_barrier_complete(unsigned* bar, unsigned x, unsigned& nloc, unsigned& nx) {
    const unsigned G = gridDim.x * gridDim.y * gridDim.z;
    unsigned sum, cnt, mine, sp = 0u;
    for (;;) {
        sum = 0u; cnt = 0u; mine = 0u;
#pragma unroll
        for (unsigned j = 0; j < 16; ++j) { const unsigned c = xb_ld(&bar[XB_XCNT(j)]); sum += c; cnt += (c > 0u) ? 1u : 0u; mine = (j == x) ? c : mine; }
        if (sum == G) break;
        __builtin_amdgcn_s_sleep(1);
        if ((++sp & 255u) == 0u) { if (xb_ld(&bar[XB_TMO])) break; if (sp > XB_SPIN_CAP) { atomicAdd(&bar[XB_TMO], 1u); break; } }
    }
    nloc = mine > 0u ? mine : 1u; nx = cnt > 0u ? cnt : 1u;
}

__device__ __forceinline__ void xcd_barrier(const XcdBarrier& b) {
    asm volatile("s_waitcnt vmcnt(0)" ::: "memory");
    __syncthreads();
    if (threadIdx.x == 0) {
        unsigned* bar = b.bar;
        __builtin_amdgcn_s_waitcnt(0);
        unsigned nloc = b.st[0], nx = b.st[1];
        if (nloc == 0u) { xcd_barrier_complete(bar, b.x, nloc, nx); b.st[0] = nloc; b.st[1] = nx; }
        const unsigned old = xb_add(&bar[XB_XSUB(b.x)], 1u);
        const unsigned gen = old / nloc;
        if (old + 1u == (gen + 1u) * nloc) {
            __builtin_amdgcn_fence(__ATOMIC_RELEASE, "agent");
            asm volatile("s_waitcnt vmcnt(0)" ::: "memory");
            const unsigned og = xb_add(&bar[XB_TOP], 1u);
            const unsigned tg = og / nx;
            if (og + 1u == (tg + 1u) * nx) xb_add(&bar[XB_TOPGEN], 1u);
            else XB_SPIN(xb_ld(&bar[XB_TOPGEN]) == tg, bar);
            __builtin_amdgcn_fence(__ATOMIC_ACQUIRE, "agent");
            xb_add(&bar[XB_XGEN(b.x)], 1u);
            asm volatile("s_waitcnt vmcnt(0)" ::: "memory");
        } else {
            XB_SPIN(xb_ld(&bar[XB_XGEN(b.x)]) == gen, bar);
            __builtin_amdgcn_fence(__ATOMIC_ACQUIRE, "agent");
            asm volatile("s_waitcnt vmcnt(0)" ::: "memory");
        }
    }
    __syncthreads();
}
#ifndef PHASE_MASK
#define PHASE_MASK 0x3ff
#endif
#ifndef GEMM_ALIGN
#define GEMM_ALIGN true
#endif
#ifndef GEMM_SP2
#define GEMM_SP2 true
#endif
constexpr int NPHASE = 10;
constexpr size_t WS_BAR = 3 * MiB;
template <class Epi> __device__ __forceinline__ void run_gemm(const bf16_t* A, const bf16_t* Bt, int N, int K, const Epi& E) {
    pg8::Gemm g{A, Bt, NTOK, N, K}; pg8::StaticOrder S; S.init(NTOK, N, (int)gridDim.x, (int)blockIdx.x);
    pg8::gemm_phase<Epi, pg8::StaticOrder, GEMM_ALIGN, GEMM_SP2>((PG8_LAS unsigned char*)g_lds, g, S, E);
}
__global__ void __launch_bounds__(NTHR, 2) mega_fwd(Args args) {
    Frame F;
#pragma unroll
    for (int i = 0; i < 20; ++i) F.in[i] = args.in[i];
    F.out = args.out; F.ws = args.ws; F.lds = nullptr; F.tid = threadIdx.x; F.lane = F.tid & 63; F.wave = __builtin_amdgcn_readfirstlane(F.tid >> 6);
    unsigned char* ws = args.ws;
    F.ss1 = (float*)(ws + WS_SS1); F.ss2 = (float*)(ws + WS_SS2); F.bonus = (float*)(ws + WS_BONUS); F.rope = (float2*)(ws + WS_ROPE);
    F.wd = (bf16_t*)(ws + WS_WD); F.wi = (bf16_t*)(ws + WS_WI); F.wg = (bf16_t*)(ws + WS_WG);
    F.win = (bf16_t*)(ws + WS_WIN); F.wup = (bf16_t*)(ws + WS_WUP); F.wdn = (bf16_t*)(ws + WS_WDN); F.wb = (bf16_t*)(ws + WS_WB); F.wo = (bf16_t*)(ws + WS_WO); F.vt = (bf16_t*)(ws + WS_VT);
    F.h = (bf16_t*)(ws + WS_H); F.ya = F.h; F.yb = F.h + (size_t)NTOK * 512; F.xb = F.h;
    F.z = (bf16_t*)(ws + WS_Z); F.hid = F.z;
    F.lw = (bf16_t*)(ws + WS_P); F.ic = F.lw + (size_t)NTOK * 512; F.mg = F.lw;
    F.yraw = args.out; F.gt = (bf16_t*)(args.out + (size_t)NTOK * 512);
    const int lo = args.ph_lo, hi = args.ph_hi;
    cg::grid_group grid = cg::this_grid();
    if (args.ph_lo < 0) grid.sync();
    volatile LAS unsigned* xst = (volatile LAS unsigned*)(g_lds + LDS_BYTES - 64);
    if (threadIdx.x == 0) { xst[0] = 0u; xst[1] = 0u; }
    __syncthreads();
    XcdBarrier xbar = xcd_barrier_post((unsigned*)(ws + WS_BAR), xst);
#define IN(k) (lo <= (k) && (k) < hi)
#define SEAM(k) do { if (IN(k) && IN((k) + 1)) { xcd_barrier(xbar); if (REP(17)) xcd_barrier(xbar); } } while (0)
    if (((PHASE_MASK >> 0) & 1) && IN(0)) { p0_prologue(F); __syncthreads(); if (REP(0)) { p0_prologue(F); __syncthreads(); } } SEAM(0);
    if (((PHASE_MASK >> 1) & 1) && IN(1)) { pg8::EpiZ E{F.z, ZLD}; run_gemm(F.h, F.win, 5120, 1024, E); __syncthreads(); if (REP(1)) { run_gemm(F.h, F.win, 5120, 1024, E); __syncthreads(); } if (REP(18)) { run_gemm(F.h, F.win, 4096, 1024, E); __syncthreads(); } } SEAM(1);
    if (((PHASE_MASK >> 2) & 1) && IN(2)) { if (REP(2)) { p2_prep(F, 0); __syncthreads(); } if (REP(16)) { p2_prep(F, 2); __syncthreads(); } p2_prep(F, 1); __syncthreads(); } SEAM(2);
    if (((PHASE_MASK >> 3) & 1) && IN(3)) { if (REP(14)) { p3_scan(F, 1); __syncthreads(); } if (REP(15)) { p3_scan(F, 2); __syncthreads(); } if (REP(3)) { p3_scan(F, 0); __syncthreads(); } p3_scan(F, 0); __syncthreads(); p3_dsa(F); __syncthreads(); if (REP(10)) { p3_dsa(F); __syncthreads(); } } SEAM(3);
    if (((PHASE_MASK >> 4) & 1) && IN(4)) { p4_post(F); __syncthreads(); if (REP(4)) { p4_post(F); __syncthreads(); } } SEAM(4);
    if (((PHASE_MASK >> 5) & 1) && IN(5)) { pg8::EpiGate<0> E0{F.mg, F.z, ZLD, C_G0}; run_gemm(F.ya, F.wb, 1024, 512, E0); __syncthreads();
                 pg8::EpiGate<1> E1{F.mg, F.z, ZLD, C_G1}; run_gemm(F.yb, F.wb + 1024 * 512, 1024, 512, E1); __syncthreads();
                 if (REP(5)) { run_gemm(F.ya, F.wb, 1024, 512, E0); __syncthreads(); run_gemm(F.yb, F.wb + 1024 * 512, 1024, 512, E1); __syncthreads(); } } SEAM(5);
    if (((PHASE_MASK >> 6) & 1) && IN(6)) { if (REP(6)) { pg8::EpiRes1 Ex{F.in[0], F.xb, F.bonus}; run_gemm(F.mg, F.wo, 1024, 1024, Ex); __syncthreads(); }
                 pg8::EpiRes1 E{F.in[0], F.xb, F.ss1}; run_gemm(F.mg, F.wo, 1024, 1024, E); __syncthreads(); } SEAM(6);
    if (((PHASE_MASK >> 7) & 1) && IN(7)) { pg8::EpiHid E{F.hid, F.ss1}; run_gemm(F.xb, F.wup, 4096, 1024, E); __syncthreads(); if (REP(7)) { run_gemm(F.xb, F.wup, 4096, 1024, E); __syncthreads(); } } SEAM(7);
    if (((PHASE_MASK >> 8) & 1) && IN(8)) { pg8::EpiRes2 E{F.xb, F.out, F.ss2}; run_gemm(F.hid, F.wdn, 1024, 4096, E); __syncthreads(); } SEAM(8);
    if (((PHASE_MASK >> 9) & 1) && IN(9)) { if (REP(9)) { p9_final(F, true); __syncthreads(); } p9_final(F, false); }
#undef IN
#undef SEAM
}

extern "C" void kernel_launch(void* const* d_in, const int* in_sizes, int n_in, void* d_out, int out_size, void* d_ws, size_t ws_size, hipStream_t stream) {
    static int grid = 0;
    if (grid == 0) {
        if (n_in != 20 || out_size != NTOK * DM || ws_size < WS_END) { fprintf(stderr, "kernel_launch: unexpected shapes (n_in %d, out %d, ws %zu < %zu)\n", n_in, out_size, ws_size, (size_t)WS_END); grid = -1; return; }
        int dev = 0, cus = 0, per_cu = 0;
        hipGetDevice(&dev); hipDeviceGetAttribute(&cus, hipDeviceAttributeMultiprocessorCount, dev);
        if (hipFuncSetAttribute((const void*)mega_fwd, hipFuncAttributeMaxDynamicSharedMemorySize, LDS_BYTES) != hipSuccess) { fprintf(stderr, "kernel_launch: hipFuncSetAttribute failed\n"); grid = -1; return; }
        if (hipOccupancyMaxActiveBlocksPerMultiprocessor(&per_cu, (const void*)mega_fwd, NTHR, LDS_BYTES) != hipSuccess || per_cu < 1) { fprintf(stderr, "kernel_launch: occupancy query failed (%d)\n", per_cu); per_cu = 1; }
        (void)hipGetLastError();
        grid = cus * per_cu;
        fprintf(stderr, "kernel_launch: grid %d (%d CUs x %d)\n", grid, cus, per_cu);
    }
    if (grid < 0) return;
    if (hipMemsetAsync((char*)d_ws + WS_BAR, 0, XCD_BAR_WORDS * 4, stream) != hipSuccess) { fprintf(stderr, "kernel_launch: memset of the barrier words failed\n"); return; }
    Args a{};
    for (int i = 0; i < 20; ++i) a.in[i] = (const float*)d_in[i];
    a.out = (float*)d_out; a.ws = (unsigned char*)d_ws;
#if MK_PER_PHASE_LAUNCH
    for (int p = 0; p < NPHASE; ++p) { a.ph_lo = p; a.ph_hi = p + 1; hipLaunchKernelGGL(mega_fwd, dim3(grid), dim3(NTHR), LDS_BYTES, stream, a); }
#else
    a.ph_lo = 0; a.ph_hi = NPHASE;
    void* kargs[] = {&a};
    hipError_t e = hipLaunchCooperativeKernel((const void*)mega_fwd, dim3(grid), dim3(NTHR), kargs, LDS_BYTES, stream);
    if (e != hipSuccess) fprintf(stderr, "kernel_launch: cooperative launch failed: %s (grid %d)\n", hipGetErrorString(e), grid);
#endif
}
```

```cpp
#include <hip/hip_runtime.h>
#include <hip/hip_cooperative_groups.h>
#include <cstdio>
#include <cstdint>
namespace cg = cooperative_groups;

#ifndef MK_PER_PHASE_LAUNCH
#define MK_PER_PHASE_LAUNCH 0
#endif

#ifndef REPEAT_MASK
#define REPEAT_MASK 0
#endif
#define REP(k) ((REPEAT_MASK >> (k)) & 1)
#ifndef TS_SEL
#define TS_SEL -1
#endif

namespace pg8 {
#define PG8_LAS __attribute__((address_space(3)))
typedef unsigned short bf16_t;
typedef short bf16x8 __attribute__((ext_vector_type(8)));
typedef float f32x4 __attribute__((ext_vector_type(4)));
typedef unsigned u32x4 __attribute__((ext_vector_type(4)));
constexpr int BM = 256, BK = 64, HALF = 128, HTB = HALF * BK * 2  , STAGE_BYTES = 8 * HTB, NXCD = 8, WGM = 8;

__host__ __device__ __forceinline__ int lds_byte(int r, int c) { const int st = (r >> 4) * 2 + (c >> 5), rr = r & 15, cc = c & 31, ob = rr * 64 + cc * 2; return st * 1024 + (ob ^ (((ob >> 9) & 1) << 5)); }
__host__ __device__ __forceinline__ void stage_rc(int b, int& R, int& C) { const int st = b / 1024, sb = b % 1024, swz = sb ^ (((sb >> 9) & 1) << 5); R = (st >> 1) * 16 + swz / 64; C = (st & 1) * 32 + (swz % 64) / 2; }
__host__ __device__ __forceinline__ int perm32(int rho) { const int n = rho >> 4, i = rho & 15; return 8 * (i >> 2) + 4 * n + (i & 3); }

struct Unit { int pm, pn; };
struct Gemm { const bf16_t* A; const bf16_t* Bt; int M, N, K; };

struct StaticOrder {
    int nM, nN, nwg, G, c;
    __host__ __device__ void init(int M, int N, int G_, int c_) { nM = M / BM; nN = N / BM; nwg = nM * nN; G = G_; c = c_; }
    __host__ __device__ bool next(int i, Unit& u) const {
        const long L = (long)i * G + c; if (L >= nwg) return false;
        int wgid = (int)L; { const int q = nwg / NXCD, r = nwg % NXCD, xcd = wgid % NXCD, off = wgid / NXCD; wgid = (xcd < r ? xcd * (q + 1) : r * (q + 1) + (xcd - r) * q) + off; }
        const int nig = WGM * nN, gid = wgid / nig, fm = gid * WGM, gsz = (nM - fm) < WGM ? (nM - fm) : WGM;
        u.pm = fm + ((wgid % nig) % gsz); u.pn = (wgid % nig) / gsz; return true;
    }
    __device__ __forceinline__ void a_ready(const Unit&) const {}
    __device__ __forceinline__ void done(const Unit&) const {}
};
__device__ __forceinline__ unsigned cvt_pk_bf16(float lo, float hi) { unsigned r; asm volatile("v_cvt_pk_bf16_f32 %0, %1, %2" : "=v"(r) : "v"(lo), "v"(hi)); return r; }
typedef float f32x2 __attribute__((ext_vector_type(2)));
__device__ __forceinline__ float bflo(unsigned u) { return __uint_as_float(u << 16); }
__device__ __forceinline__ float bfhi(unsigned u) { return __uint_as_float(u & 0xffff0000u); }
__device__ __forceinline__ float sigm(float x) { return 1.0f / (1.0f + __expf(-x)); }

struct EpiZ {
    static constexpr bool PERM = true, AFTER_DRAIN = false;
    bf16_t* O; int ldc;
    __device__ __forceinline__ void operator()(const f32x4 (&acc)[2][2][4][2], const Unit& u, int wr, int wc, int fr, int fq) const {
        const int row0 = u.pm * BM + wr * 64 + fr, col0 = u.pn * BM + wc * 32 + 8 * fq;
#pragma unroll
        for (int ai = 0; ai < 2; ++ai)
#pragma unroll
            for (int m = 0; m < 4; ++m) { bf16_t* rowp = O + (size_t)(row0 + ai * HALF + m * 16) * ldc + col0;
#pragma unroll
                for (int bj = 0; bj < 2; ++bj) { const f32x4 v0 = acc[ai][bj][m][0], v1 = acc[ai][bj][m][1];
                    u32x4 w; w.x = cvt_pk_bf16(v0[0], v0[1]); w.y = cvt_pk_bf16(v0[2], v0[3]); w.z = cvt_pk_bf16(v1[0], v1[1]); w.w = cvt_pk_bf16(v1[2], v1[3]);
                    *(u32x4*)(rowp + bj * HALF) = w; } }
    }
};
template <int MODE> struct EpiGate {
    static constexpr bool PERM = true, AFTER_DRAIN = false;
    bf16_t* O; const bf16_t* Z; int zld; int gcol;
    __device__ __forceinline__ void operator()(const f32x4 (&acc)[2][2][4][2], const Unit& u, int wr, int wc, int fr, int fq) const {
        const int row0 = u.pm * BM + wr * 64 + fr, col0 = u.pn * BM + wc * 32 + 8 * fq;
        u32x4 gn[2], pn[2];
        { const size_t row = (size_t)row0; gn[0] = *(const u32x4*)(Z + row * zld + gcol + col0); gn[1] = *(const u32x4*)(Z + row * zld + gcol + col0 + HALF);
          if (MODE == 1) { pn[0] = *(const u32x4*)(O + row * 1024 + col0); pn[1] = *(const u32x4*)(O + row * 1024 + col0 + HALF); } }
#pragma unroll
        for (int it = 0; it < 8; ++it) { const int ai = it >> 2, m = it & 3; const size_t row = (size_t)(row0 + ai * HALF + m * 16);
            u32x4 gc[2] = {gn[0], gn[1]}, pc[2];
            if (MODE == 1) { pc[0] = pn[0]; pc[1] = pn[1]; }
            if (it < 7) { const size_t rown = (size_t)(row0 + ((it + 1) >> 2) * HALF + ((it + 1) & 3) * 16);
                gn[0] = *(const u32x4*)(Z + rown * zld + gcol + col0); gn[1] = *(const u32x4*)(Z + rown * zld + gcol + col0 + HALF);
                if (MODE == 1) { pn[0] = *(const u32x4*)(O + rown * 1024 + col0); pn[1] = *(const u32x4*)(O + rown * 1024 + col0 + HALF); } }
            bf16_t* op = O + row * 1024 + col0;
#pragma unroll
            for (int bj = 0; bj < 2; ++bj) { const f32x4 v0 = acc[ai][bj][m][0], v1 = acc[ai][bj][m][1]; const u32x4 g = gc[bj];
                float r0 = v0[0] * sigm(bflo(g.x)), r1 = v0[1] * sigm(bfhi(g.x)), r2 = v0[2] * sigm(bflo(g.y)), r3 = v0[3] * sigm(bfhi(g.y));
                float r4 = v1[0] * sigm(bflo(g.z)), r5 = v1[1] * sigm(bfhi(g.z)), r6 = v1[2] * sigm(bflo(g.w)), r7 = v1[3] * sigm(bfhi(g.w));
                if (MODE == 1) { const u32x4 p = pc[bj];
                    r0 += bflo(p.x); r1 += bfhi(p.x); r2 += bflo(p.y); r3 += bfhi(p.y); r4 += bflo(p.z); r5 += bfhi(p.z); r6 += bflo(p.w); r7 += bfhi(p.w); }
                u32x4 w; w.x = cvt_pk_bf16(r0, r1); w.y = cvt_pk_bf16(r2, r3); w.z = cvt_pk_bf16(r4, r5); w.w = cvt_pk_bf16(r6, r7);
                *(u32x4*)(op + bj * HALF) = w; } }
    }
};
struct EpiRes1 {
    static constexpr bool PERM = true, AFTER_DRAIN = false;
    const float* X; bf16_t* XB; float* SS;
    __device__ __forceinline__ void operator()(const f32x4 (&acc)[2][2][4][2], const Unit& u, int wr, int wc, int fr, int fq) const {
        const int row0 = u.pm * BM + wr * 64 + fr, col0 = u.pn * BM + wc * 32 + 8 * fq;
        f32x4 xn[4];
        { const float* xp = X + (size_t)row0 * 1024 + col0; xn[0] = *(const f32x4*)(xp); xn[1] = *(const f32x4*)(xp + 4); xn[2] = *(const f32x4*)(xp + HALF); xn[3] = *(const f32x4*)(xp + HALF + 4); }
#pragma unroll
        for (int it = 0; it < 8; ++it) { const int ai = it >> 2, m = it & 3; const size_t row = (size_t)(row0 + ai * HALF + m * 16); float ssq = 0.f;
            const f32x4 xc[4] = {xn[0], xn[1], xn[2], xn[3]};
            if (it < 7) { const float* xp = X + (size_t)(row0 + ((it + 1) >> 2) * HALF + ((it + 1) & 3) * 16) * 1024 + col0;
                xn[0] = *(const f32x4*)(xp); xn[1] = *(const f32x4*)(xp + 4); xn[2] = *(const f32x4*)(xp + HALF); xn[3] = *(const f32x4*)(xp + HALF + 4); }
#pragma unroll
            for (int bj = 0; bj < 2; ++bj) { const size_t off = row * 1024 + col0 + bj * HALF;
                const f32x4 v0 = acc[ai][bj][m][0] + xc[2 * bj], v1 = acc[ai][bj][m][1] + xc[2 * bj + 1];
                ssq += (v0[0] * v0[0] + v0[1] * v0[1]) + (v0[2] * v0[2] + v0[3] * v0[3]) + (v1[0] * v1[0] + v1[1] * v1[1]) + (v1[2] * v1[2] + v1[3] * v1[3]);
                u32x4 w; w.x = cvt_pk_bf16(v0[0], v0[1]); w.y = cvt_pk_bf16(v0[2], v0[3]); w.z = cvt_pk_bf16(v1[0], v1[1]); w.w = cvt_pk_bf16(v1[2], v1[3]);
                *(u32x4*)(XB + off) = w; }
            ssq += __shfl_xor(ssq, 16); ssq += __shfl_xor(ssq, 32);
            if (fq == 0) atomicAdd(SS + row, ssq); }
    }
};
struct EpiRes2 {
    static constexpr bool PERM = true, AFTER_DRAIN = false;
    const bf16_t* XB; float* O; float* SS;
    __device__ __forceinline__ void operator()(const f32x4 (&acc)[2][2][4][2], const Unit& u, int wr, int wc, int fr, int fq) const {
        const int row0 = u.pm * BM + wr * 64 + fr, col0 = u.pn * BM + wc * 32 + 8 * fq;
        u32x4 xn[2];
        { const bf16_t* xp = XB + (size_t)row0 * 1024 + col0; xn[0] = *(const u32x4*)(xp); xn[1] = *(const u32x4*)(xp + HALF); }
#pragma unroll
        for (int it = 0; it < 8; ++it) { const int ai = it >> 2, m = it & 3; const size_t row = (size_t)(row0 + ai * HALF + m * 16); float ssq = 0.f;
            const u32x4 xc[2] = {xn[0], xn[1]};
            if (it < 7) { const bf16_t* xp = XB + (size_t)(row0 + ((it + 1) >> 2) * HALF + ((it + 1) & 3) * 16) * 1024 + col0; xn[0] = *(const u32x4*)(xp); xn[1] = *(const u32x4*)(xp + HALF); }
#pragma unroll
            for (int bj = 0; bj < 2; ++bj) { const size_t off = row * 1024 + col0 + bj * HALF;
                const u32x4 xw = xc[bj]; f32x4 v0 = acc[ai][bj][m][0], v1 = acc[ai][bj][m][1];
                v0[0] += bflo(xw.x); v0[1] += bfhi(xw.x); v0[2] += bflo(xw.y); v0[3] += bfhi(xw.y); v1[0] += bflo(xw.z); v1[1] += bfhi(xw.z); v1[2] += bflo(xw.w); v1[3] += bfhi(xw.w);
                *(f32x4*)(O + off) = v0; *(f32x4*)(O + off + 4) = v1;
                ssq += (v0[0] * v0[0] + v0[1] * v0[1]) + (v0[2] * v0[2] + v0[3] * v0[3]) + (v1[0] * v1[0] + v1[1] * v1[1]) + (v1[2] * v1[2] + v1[3] * v1[3]); }
            ssq += __shfl_xor(ssq, 16); ssq += __shfl_xor(ssq, 32);
            if (fq == 0) atomicAdd(SS + row, ssq); }
    }
};
struct EpiHid {
    static constexpr bool PERM = true, AFTER_DRAIN = false;
    bf16_t* O; const float* SS;
    __device__ __forceinline__ void operator()(const f32x4 (&acc)[2][2][4][2], const Unit& u, int wr, int wc, int fr, int fq) const {
        const int row0 = u.pm * BM + wr * 64 + fr, col0 = u.pn * BM + wc * 32 + 8 * fq;
#pragma unroll
        for (int ai = 0; ai < 2; ++ai)
#pragma unroll
            for (int m = 0; m < 4; ++m) { const size_t row = (size_t)(row0 + ai * HALF + m * 16);
                const float s2 = 1.0f / (SS[row] * (1.0f / 1024.0f) + 1e-6f);
                bf16_t* rowp = O + row * 4096 + col0;
#pragma unroll
                for (int bj = 0; bj < 2; ++bj) { f32x4 v0 = acc[ai][bj][m][0], v1 = acc[ai][bj][m][1];
#pragma unroll
                    for (int j = 0; j < 4; ++j) { float a = fmaxf(v0[j], 0.f), b = fmaxf(v1[j], 0.f); v0[j] = a * a * s2; v1[j] = b * b * s2; }
                    u32x4 w; w.x = cvt_pk_bf16(v0[0], v0[1]); w.y = cvt_pk_bf16(v0[2], v0[3]); w.z = cvt_pk_bf16(v1[0], v1[1]); w.w = cvt_pk_bf16(v1[2], v1[3]);
                    *(u32x4*)(rowp + bj * HALF) = w; } }
    }
};

template <class Epi, class Sched, bool ALIGN_EPI = false, bool SP2 = false>
__device__ __forceinline__ void gemm_phase(PG8_LAS unsigned char* lds, const Gemm g, const Sched& S, const Epi& E) {
    const int tid = threadIdx.x, wid = __builtin_amdgcn_readfirstlane(tid >> 6), lane = tid & 63, wr = wid >> 2, wc = wid & 3, fr = lane & 15, fq = lane >> 4;
    const int K = g.K, nt = K / BK;
    unsigned voffA[2], voffB[2];
#pragma unroll
    for (int i = 0; i < 2; ++i) { int R, C; stage_rc(tid * 16 + i * 8192, R, C); const int Rb = Epi::PERM ? ((R & ~31) + perm32(R & 31)) : R;
        voffA[i] = (unsigned)(R * K + C) * 2u; voffB[i] = (unsigned)(Rb * K + C) * 2u; }
    const size_t kstep = (size_t)(BK * 2);
    const size_t hstep = (size_t)HALF * K * 2;
    const size_t tstep = 2 * hstep;
    const unsigned ldsw = (unsigned)wid * 1024u;
    const int aoff = lds_byte(wr * 64 + fr, fq * 8), boff = lds_byte(wc * 32 + fr, fq * 8);
#define PG8_SA(b, h) (((b) * 2 + (h)) * HTB)
#define PG8_SB(b, h) ((4 + (b) * 2 + (h)) * HTB)
#define PG8_STAGE(bufoff, gbase, voff) do { _Pragma("unroll") for (int _i = 0; _i < 2; ++_i) \
        __builtin_amdgcn_global_load_lds((const unsigned*)((const char*)(gbase) + (voff)[_i]), (PG8_LAS unsigned*)(lds + (bufoff) + ldsw + _i * 8192), 16, 0, 0); } while (0)
#define PG8_LDA(dst, b, h) do { _Pragma("unroll") for (int m = 0; m < 4; ++m) _Pragma("unroll") for (int k = 0; k < 2; ++k) dst[m][k] = *(const PG8_LAS bf16x8*)(lds + PG8_SA(b, h) + aoff + m * 2048 + k * 1024); } while (0)
#define PG8_LDB(dst, b, h) do { _Pragma("unroll") for (int n = 0; n < 2; ++n) _Pragma("unroll") for (int k = 0; k < 2; ++k) dst[n][k] = *(const PG8_LAS bf16x8*)(lds + PG8_SB(b, h) + boff + n * 2048 + k * 1024); } while (0)
#define PG8_MMA(ai, bj, At, Bt) do { __builtin_amdgcn_s_setprio(1); _Pragma("unroll") for (int m = 0; m < 4; ++m) _Pragma("unroll") for (int n = 0; n < 2; ++n) _Pragma("unroll") for (int k = 0; k < 2; ++k) \
        acc[ai][bj][m][n] = __builtin_amdgcn_mfma_f32_16x16x32_bf16(Bt[n][k], At[m][k], acc[ai][bj][m][n], 0, 0, 0); __builtin_amdgcn_s_setprio(0); } while (0)
#define PG8_WAIT_V(n) asm volatile("s_waitcnt vmcnt(" #n ")" ::: "memory")
#define PG8_WAIT_L(n) asm volatile("s_waitcnt lgkmcnt(" #n ")" ::: "memory")
#define PG8_BAR __builtin_amdgcn_s_barrier()
#define PG8_SCHED __builtin_amdgcn_sched_barrier(0)
    Unit cur, nxt; int ui = 0;
    if (!S.next(0, cur)) return;
    f32x4 acc[2][2][4][2];
#pragma unroll
    for (int a = 0; a < 2; ++a)
#pragma unroll
        for (int b = 0; b < 2; ++b)
#pragma unroll
            for (int m = 0; m < 4; ++m)
#pragma unroll
                for (int n = 0; n < 2; ++n) acc[a][b][m][n] = (f32x4){0.f, 0.f, 0.f, 0.f};
    bf16x8 At[4][2], B0[2][2], B1[2][2];
    const char* cA = (const char*)g.A + (size_t)cur.pm * tstep; const char* cB = (const char*)g.Bt + (size_t)cur.pn * tstep;
    S.a_ready(cur);
    if constexpr (SP2) {
        PG8_STAGE(PG8_SB(0, 0), cB, voffB); PG8_STAGE(PG8_SB(0, 1), cB + hstep, voffB); PG8_STAGE(PG8_SA(0, 0), cA, voffA); PG8_STAGE(PG8_SA(0, 1), cA + hstep, voffA);
        if (wr == 1) PG8_BAR;
        PG8_WAIT_V(2); PG8_BAR;
        PG8_STAGE(PG8_SB(1, 0), cB + kstep, voffB); PG8_STAGE(PG8_SA(1, 0), cA + kstep, voffA); PG8_STAGE(PG8_SB(1, 1), cB + hstep + kstep, voffB);
        PG8_WAIT_V(6); PG8_BAR;
    } else {
        PG8_STAGE(PG8_SB(0, 0), cB, voffB); PG8_STAGE(PG8_SA(0, 0), cA, voffA); PG8_STAGE(PG8_SB(0, 1), cB + hstep, voffB); PG8_STAGE(PG8_SA(0, 1), cA + hstep, voffA);
        if (wr == 1) PG8_BAR;
        PG8_WAIT_V(4); PG8_BAR;
        PG8_STAGE(PG8_SB(1, 0), cB + kstep, voffB); PG8_STAGE(PG8_SA(1, 0), cA + kstep, voffA); PG8_STAGE(PG8_SB(1, 1), cB + hstep + kstep, voffB);
        PG8_WAIT_V(6); PG8_BAR;
    }
    for (;;) {
        const bool has_next = S.next(ui + 1, nxt);
        const char* nA = has_next ? (const char*)g.A + (size_t)nxt.pm * tstep : cA; const char* nB = has_next ? (const char*)g.Bt + (size_t)nxt.pn * tstep : cB;
        for (int t = 0; t < nt; t += 2) {
            const bool last = (t == nt - 2);
            const char* a1 = cA + (size_t)(t + 1) * kstep;
            const char* a2 = last ? nA : cA + (size_t)(t + 2) * kstep; const char* b2 = last ? nB : cB + (size_t)(t + 2) * kstep;
            const char* a3 = a2 + kstep; const char* b3 = b2 + kstep;
            if (last && has_next) S.a_ready(nxt);
            if constexpr (SP2) {
            PG8_LDB(B0, 0, 0); PG8_LDB(B1, 0, 1); PG8_SCHED; PG8_LDA(At, 0, 0); PG8_STAGE(PG8_SA(1, 1), a1 + hstep, voffA);
            PG8_WAIT_V(8); PG8_WAIT_L(0); PG8_BAR; PG8_MMA(0, 0, At, B0); PG8_MMA(0, 1, At, B1); PG8_BAR; PG8_SCHED;
            PG8_LDA(At, 0, 1); PG8_STAGE(PG8_SB(0, 0), b2, voffB); PG8_STAGE(PG8_SB(0, 1), b2 + hstep, voffB); PG8_STAGE(PG8_SA(0, 0), a2, voffA);
            PG8_WAIT_V(8); PG8_WAIT_L(0); PG8_BAR; PG8_MMA(1, 0, At, B0); PG8_MMA(1, 1, At, B1); PG8_BAR; PG8_SCHED;
            PG8_LDB(B0, 1, 0); PG8_LDB(B1, 1, 1); PG8_SCHED; PG8_LDA(At, 1, 0); PG8_STAGE(PG8_SA(0, 1), a2 + hstep, voffA);
            PG8_WAIT_V(8); PG8_WAIT_L(0); PG8_BAR; PG8_MMA(0, 0, At, B0); PG8_MMA(0, 1, At, B1); PG8_BAR; PG8_SCHED;
            PG8_LDA(At, 1, 1); PG8_STAGE(PG8_SB(1, 0), b3, voffB); PG8_STAGE(PG8_SB(1, 1), b3 + hstep, voffB); PG8_STAGE(PG8_SA(1, 0), a3, voffA);
            PG8_WAIT_V(8); PG8_WAIT_L(0); PG8_BAR; PG8_MMA(1, 0, At, B0); PG8_MMA(1, 1, At, B1); PG8_BAR; PG8_SCHED;
            } else {
            PG8_LDB(B0, 0, 0); PG8_SCHED; PG8_LDA(At, 0, 0); PG8_STAGE(PG8_SA(1, 1), a1 + hstep, voffA);
            PG8_WAIT_L(8); PG8_BAR; PG8_WAIT_L(0); PG8_MMA(0, 0, At, B0); PG8_BAR; PG8_SCHED;
            PG8_LDB(B1, 0, 1); PG8_STAGE(PG8_SB(0, 0), b2, voffB);
            PG8_BAR; PG8_WAIT_L(0); PG8_MMA(0, 1, At, B1); PG8_BAR;
            PG8_LDA(At, 0, 1); PG8_STAGE(PG8_SA(0, 0), a2, voffA);
            PG8_BAR; PG8_WAIT_L(0); PG8_MMA(1, 0, At, B0); PG8_BAR; PG8_SCHED;
            PG8_STAGE(PG8_SB(0, 1), b2 + hstep, voffB);
            PG8_WAIT_V(6); PG8_BAR; PG8_MMA(1, 1, At, B1); PG8_BAR;
            PG8_LDB(B0, 1, 0); PG8_SCHED; PG8_LDA(At, 1, 0); PG8_STAGE(PG8_SA(0, 1), a2 + hstep, voffA);
            PG8_WAIT_L(8); PG8_BAR; PG8_WAIT_L(0); PG8_MMA(0, 0, At, B0); PG8_BAR; PG8_SCHED;
            PG8_LDB(B1, 1, 1); PG8_STAGE(PG8_SB(1, 0), b3, voffB);
            PG8_BAR; PG8_WAIT_L(0); PG8_MMA(0, 1, At, B1); PG8_BAR;
            PG8_LDA(At, 1, 1); PG8_STAGE(PG8_SA(1, 0), a3, voffA);
            PG8_BAR; PG8_WAIT_L(0); PG8_MMA(1, 0, At, B0); PG8_BAR; PG8_SCHED;
            PG8_STAGE(PG8_SB(1, 1), b3 + hstep, voffB);
            PG8_WAIT_V(6); PG8_BAR; PG8_MMA(1, 1, At, B1); PG8_BAR;
            }
        }
        if constexpr (ALIGN_EPI) { if (wr == 0) PG8_BAR; }
        if constexpr (!Epi::AFTER_DRAIN) { E(acc, cur, wr, wc, fr, fq); S.done(cur); }
        if (!has_next) break;
#pragma unroll
        for (int a = 0; a < 2; ++a)
#pragma unroll
            for (int b = 0; b < 2; ++b)
#pragma unroll
                for (int m = 0; m < 4; ++m)
#pragma unroll
                    for (int n = 0; n < 2; ++n) acc[a][b][m][n] = (f32x4){0.f, 0.f, 0.f, 0.f};
        cur = nxt; cA = nA; cB = nB; ++ui;
        if constexpr (ALIGN_EPI) { if (wr == 1) PG8_BAR; }
    }
    PG8_WAIT_V(0);
    if constexpr (!ALIGN_EPI) { if (wr == 0) PG8_BAR; }
    PG8_BAR;
    if constexpr (Epi::AFTER_DRAIN) { E.fused(acc, cur, wr, wc, fr, fq, lds, wid, lane); S.done(cur); }
#undef PG8_SA
#undef PG8_SB
#undef PG8_STAGE
#undef PG8_LDA
#undef PG8_LDB
#undef PG8_MMA
#undef PG8_WAIT_V
#undef PG8_WAIT_L
#undef PG8_BAR
#undef PG8_SCHED
}
}
extern __shared__ __attribute__((aligned(16))) unsigned char g_lds[];
using pg8::bf16_t; using pg8::bf16x8; using pg8::f32x4; using pg8::u32x4; using pg8::cvt_pk_bf16; using pg8::bflo; using pg8::bfhi; using pg8::sigm;

constexpr int NTOK = 32768, DM = 1024, SEQ = 2048, NB = 16, ZLD = 5120, NTHR = 512;
constexpr int C_R = 0, C_K = 512, C_V = 1024, C_WD = 1536, C_AD = 1600, C_GD = 1664;
constexpr int C_Q = 1824, C_KA = 2336, C_VA = 2400, C_QI = 2464, C_KI = 2976, C_WI = 3040, C_G0 = 3048, C_G1 = 4072;
constexpr size_t MiB = 1024 * 1024;
constexpr size_t WS_SS1 = 0, WS_SS2 = 128 * 1024, WS_BONUS = 256 * 1024, WS_ROPE = 1280 * 1024, WS_WD = 1792 * 1024, WS_WI = 1856 * 1024, WS_WG = 1920 * 1024;
constexpr size_t WS_WIN = 4 * MiB, WS_WUP = 14 * MiB, WS_WDN = 22 * MiB, WS_WB = 30 * MiB, WS_WO = 32 * MiB, WS_VT = 34 * MiB, WS_H = 38 * MiB, WS_Z = 102 * MiB, WS_P = 422 * MiB, WS_END = 486 * MiB;
constexpr int LDS_BYTES = 163840;

struct Args { const float* in[20]; float* out; unsigned char* ws; int ph_lo, ph_hi; };

struct Frame {
    const float* in[20]; float* out; unsigned char* ws; unsigned char* lds; int tid, lane, wave;
    float *ss1, *ss2, *bonus; float2* rope; bf16_t *wd, *wi, *wg, *win, *wup, *wdn, *wb, *wo, *vt, *h, *ya, *yb, *xb, *z, *hid, *lw, *ic, *mg, *gt; float* yraw;
};

__device__ __forceinline__ bf16_t f2bf(float f) { return (bf16_t)(cvt_pk_bf16(f, 0.f) & 0xffffu); }
__device__ __forceinline__ float bf2f(bf16_t b) { return __uint_as_float(((unsigned)b) << 16); }
template <int CTRL> __device__ __forceinline__ float dpp_mov(float x) { return __int_as_float(__builtin_amdgcn_update_dpp(0, __float_as_int(x), CTRL, 0xF, 0xF, true)); }
__device__ __forceinline__ float red16(float x) { x += dpp_mov<0xB1>(x); x += dpp_mov<0x4E>(x); x += dpp_mov<0x141>(x); x += dpp_mov<0x140>(x); return x; }


__device__ __forceinline__ void lds_barrier() { asm volatile("s_waitcnt lgkmcnt(0)" ::: "memory"); __builtin_amdgcn_s_barrier(); asm volatile("" ::: "memory"); }
__device__ __forceinline__ void red16x4(float& a, float& b, float& c, float& d) {
#define DPP4(ctl) "v_add_f32_dpp %0, %0, %0 " ctl " row_mask:0xf bank_mask:0xf bound_ctrl:1\n" "v_add_f32_dpp %1, %1, %1 " ctl " row_mask:0xf bank_mask:0xf bound_ctrl:1\n" \
                  "v_add_f32_dpp %2, %2, %2 " ctl " row_mask:0xf bank_mask:0xf bound_ctrl:1\n" "v_add_f32_dpp %3, %3, %3 " ctl " row_mask:0xf bank_mask:0xf bound_ctrl:1\n"
    asm volatile("s_nop 1\n" DPP4("quad_perm:[1,0,3,2]") DPP4("quad_perm:[2,3,0,1]") DPP4("row_half_mirror") DPP4("row_mirror") : "+v"(a), "+v"(b), "+v"(c), "+v"(d));
#undef DPP4
}
__device__ __forceinline__ float red32(float x) { x += __shfl_xor(x, 1); x += __shfl_xor(x, 2); x += __shfl_xor(x, 4); x += __shfl_xor(x, 8); x += __shfl_xor(x, 16); return x; }
__device__ __forceinline__ float red64(float x) { x = red32(x); x += __shfl_xor(x, 32); return x; }
__device__ __forceinline__ float softplus_f(float x) { return fmaxf(x, 0.f) + log1pf(__expf(-fabsf(x))); }

__device__ __forceinline__ void tconv(const Frame& F, const float* __restrict__ W, int K, int N, int Npad, bf16_t* __restrict__ Wt, const float* __restrict__ rs) {
    float* tile = (float*)g_lds;
    const int ktn = (K + 63) / 64, ntn = Npad / 64, tid = F.tid;
    for (int tl = blockIdx.x; tl < ktn * ntn; tl += gridDim.x) {
        const int kt = tl % ktn, nt = tl / ktn;
#pragma unroll
        for (int i = 0; i < 2; ++i) { const int idx = tid + i * NTHR, kk = idx >> 4, n4 = (idx & 15) * 4, k = kt * 64 + kk, n = nt * 64 + n4;
            f32x4 v = {0.f, 0.f, 0.f, 0.f};
            if (k < K) { if (n + 3 < N) v = *(const f32x4*)(W + (size_t)k * N + n); else { for (int j = 0; j < 4; ++j) if (n + j < N) v[j] = W[(size_t)k * N + n + j]; }
                if (rs != nullptr) { const float r = rs[k]; v[0] *= r; v[1] *= r; v[2] *= r; v[3] *= r; } }
            tile[kk * 65 + n4] = v[0]; tile[kk * 65 + n4 + 1] = v[1]; tile[kk * 65 + n4 + 2] = v[2]; tile[kk * 65 + n4 + 3] = v[3]; }
        __syncthreads();
        { const int nn = tid >> 3, k8 = (tid & 7) * 8, k = kt * 64 + k8, n = nt * 64 + nn;
          if (k < K) { u32x4 w; const float* tp = tile + k8 * 65 + nn;
              w.x = cvt_pk_bf16(tp[0], tp[65]); w.y = cvt_pk_bf16(tp[130], tp[195]); w.z = cvt_pk_bf16(tp[260], tp[325]); w.w = cvt_pk_bf16(tp[390], tp[455]);
              *(u32x4*)(Wt + (size_t)n * K + k) = w; } }
        __syncthreads();
    }
}
__device__ __forceinline__ void p0_prologue(const Frame& F) {
    const int tid = F.tid, gtid = blockIdx.x * NTHR + tid, gn = gridDim.x * NTHR;
    for (int i = gtid; i < 2 * NTOK; i += gn) F.ss1[i] = 0.f;
    for (int i = gtid; i < SEQ * 32; i += gn) { const int pos = i >> 5, j = i & 31;
        const float inv = 1.0f / powf(10000.0f, (float)(2 * j) / 64.0f); const float ang = (float)pos * inv;
        double rev = (double)ang * 0.15915494309189535; rev -= floor(rev); const float fr = (float)rev;
        F.rope[i] = make_float2(__builtin_amdgcn_cosf(fr), __builtin_amdgcn_sinf(fr)); }
    tconv(F, F.in[2], 1024, 5096, 5120, F.win, nullptr);
    tconv(F, F.in[17], 1024, 4096, 4096, F.wup, F.in[16]);
    tconv(F, F.in[18], 4096, 1024, 1024, F.wdn, nullptr);
    tconv(F, F.in[14], 512, 1024, 1024, F.wb, nullptr);
    tconv(F, F.in[14] + 512 * 1024, 512, 1024, 1024, F.wb + 1024 * 512, nullptr);
    tconv(F, F.in[15], 1024, 1024, 1024, F.wo, nullptr);
    tconv(F, F.in[5], 64, 512, 512, F.wd, nullptr);
    tconv(F, F.in[7], 64, 512, 512, F.wi, nullptr);
    tconv(F, F.in[8], 160, 512, 512, F.wg, nullptr);
    const float* x = F.in[0]; const float* g = F.in[1]; const int lane = F.lane;
    for (int row = blockIdx.x * 8 + F.wave; row < NTOK; row += gridDim.x * 8) {
        const float* xr = x + (size_t)row * DM; f32x4 v[4]; float ss = 0.f;
#pragma unroll
        for (int i = 0; i < 4; ++i) { v[i] = *(const f32x4*)(xr + (i >> 1) * 512 + lane * 8 + (i & 1) * 4); ss += v[i][0] * v[i][0] + v[i][1] * v[i][1] + v[i][2] * v[i][2] + v[i][3] * v[i][3]; }
        ss = red64(ss); const float sc = rsqrtf(ss * (1.0f / 1024.0f) + 1e-6f);
#pragma unroll
        for (int i = 0; i < 2; ++i) { const f32x4 g0 = *(const f32x4*)(g + i * 512 + lane * 8), g1 = *(const f32x4*)(g + i * 512 + lane * 8 + 4); const f32x4 a = v[2 * i], b2 = v[2 * i + 1]; u32x4 w;
            w.x = cvt_pk_bf16(a[0] * sc * g0[0], a[1] * sc * g0[1]); w.y = cvt_pk_bf16(a[2] * sc * g0[2], a[3] * sc * g0[3]);
            w.z = cvt_pk_bf16(b2[0] * sc * g1[0], b2[1] * sc * g1[1]); w.w = cvt_pk_bf16(b2[2] * sc * g1[2], b2[3] * sc * g1[3]);
            *(u32x4*)(F.h + (size_t)row * DM + i * 512 + lane * 8) = w; }
    }
}

__device__ __forceinline__ void p2_prep(const Frame& F, const int mode) {
    const int tid = F.tid, lane = F.lane, wave = F.wave, fr = lane & 15, fq = lane >> 4;
    bf16_t* z = F.z; const float* mu = F.in[3];
    if (mode != 2) {
        constexpr int LDA = 296, TT = 32; bf16_t* At = (bf16_t*)g_lds;
        bf16_t* Ot = At + TT * LDA;
        const float* dbias = F.in[4]; const float* ibias = F.in[6];
        for (int tile = blockIdx.x; tile < NTOK / TT; tile += gridDim.x) {
            const int t0 = tile * TT;
            for (int idx = tid; idx < TT * 36; idx += NTHR) { const int tok = idx / 36, c8 = (idx - tok * 36) * 8, t = t0 + tok, col = C_WD + c8;
                const u32x4 zc = *(const u32x4*)(z + (size_t)t * ZLD + col); u32x4 zp = {0u, 0u, 0u, 0u}; if (t & (SEQ - 1)) zp = *(const u32x4*)(z + (size_t)(t - 1) * ZLD + col);
                const f32x4 m0 = *(const f32x4*)(mu + col), m1 = *(const f32x4*)(mu + col + 4);
                float v[8]; const unsigned zcu[4] = {zc.x, zc.y, zc.z, zc.w}, zpu[4] = {zp.x, zp.y, zp.z, zp.w};
#pragma unroll
                for (int j = 0; j < 4; ++j) { const float a = bflo(zcu[j]), b2 = bfhi(zcu[j]), pa = bflo(zpu[j]), pb = bfhi(zpu[j]);
                    const float mm0 = (j < 2) ? m0[2 * j] : m1[2 * j - 4], mm1 = (j < 2) ? m0[2 * j + 1] : m1[2 * j - 3];
                    v[2 * j] = a + (pa - a) * mm0; v[2 * j + 1] = b2 + (pb - b2) * mm1; }
                if (c8 < 64) {
#pragma unroll
                    for (int j = 0; j < 8; ++j) v[j] = tanhf(v[j]); }
                else if (c8 >= 128) {
#pragma unroll
                    for (int j = 0; j < 8; ++j) v[j] = sigm(v[j]); }
                u32x4 w; w.x = cvt_pk_bf16(v[0], v[1]); w.y = cvt_pk_bf16(v[2], v[3]); w.z = cvt_pk_bf16(v[4], v[5]); w.w = cvt_pk_bf16(v[6], v[7]);
                *(u32x4*)(At + tok * LDA + c8) = w; }
            __syncthreads();
            const int h = wave;
            bf16x8 Bc[9], Bn[9];
            { const int n = h * 64 + fr;
#pragma unroll
              for (int ks = 0; ks < 2; ++ks) { Bc[ks] = *(const bf16x8*)(F.wd + n * 64 + ks * 32 + fq * 8); Bc[2 + ks] = *(const bf16x8*)(F.wi + n * 64 + ks * 32 + fq * 8); }
#pragma unroll
              for (int ks = 0; ks < 5; ++ks) Bc[4 + ks] = *(const bf16x8*)(F.wg + n * 160 + ks * 32 + fq * 8); }
#pragma unroll 1
            for (int j = 0; j < 4; ++j) { const int n = h * 64 + j * 16 + fr;
                if (j < 3) { const int nn = n + 16;
#pragma unroll
                    for (int ks = 0; ks < 2; ++ks) { Bn[ks] = *(const bf16x8*)(F.wd + nn * 64 + ks * 32 + fq * 8); Bn[2 + ks] = *(const bf16x8*)(F.wi + nn * 64 + ks * 32 + fq * 8); }
#pragma unroll
                    for (int ks = 0; ks < 5; ++ks) Bn[4 + ks] = *(const bf16x8*)(F.wg + nn * 160 + ks * 32 + fq * 8); }
                const float db = dbias[n], ib = ibias[n];
#pragma unroll
                for (int mt = 0; mt < 2; ++mt) {
                    f32x4 ad = {0.f, 0.f, 0.f, 0.f}, ai = ad, ag = ad; const bf16_t* ap = At + (mt * 16 + fr) * LDA + fq * 8;
#pragma unroll
                    for (int ks = 0; ks < 2; ++ks) ad = __builtin_amdgcn_mfma_f32_16x16x32_bf16(*(const bf16x8*)(ap + ks * 32), Bc[ks], ad, 0, 0, 0);
#pragma unroll
                    for (int ks = 0; ks < 2; ++ks) ai = __builtin_amdgcn_mfma_f32_16x16x32_bf16(*(const bf16x8*)(ap + 64 + ks * 32), Bc[2 + ks], ai, 0, 0, 0);
#pragma unroll
                    for (int ks = 0; ks < 5; ++ks) ag = __builtin_amdgcn_mfma_f32_16x16x32_bf16(*(const bf16x8*)(ap + 128 + ks * 32), Bc[4 + ks], ag, 0, 0, 0);
#pragma unroll
                    for (int jj = 0; jj < 4; ++jj) {
                        const float dw = db + ad[jj]; const float wlog = -softplus_f(-dw) - 0.5f; const float lwv = -__expf(wlog);
                        const int tk = mt * 16 + fq * 4 + jj; Ot[tk * 520 + n] = f2bf(lwv); Ot[(TT + tk) * 520 + n] = f2bf(sigm(ib + ai[jj])); Ot[(2 * TT + tk) * 520 + n] = f2bf(ag[jj]); }
                }
#pragma unroll
                for (int q = 0; q < 9; ++q) Bc[q] = Bn[q];
            }
            __syncthreads();
#pragma unroll
            for (int i = 0; i < 12; ++i) { const int idx = tid + i * NTHR, arr = idx >> 11, rem = idx & 2047, tk = rem >> 6, c8 = (rem & 63) * 8;
                const u32x4 w = *(const u32x4*)(Ot + (arr * TT + tk) * 520 + c8); bf16_t* dst = arr == 0 ? F.lw : (arr == 1 ? F.ic : F.gt);
                *(u32x4*)(dst + (size_t)(t0 + tk) * 512 + c8) = w; }
            __syncthreads();
        }
    }
    if (mode != 2) {
        unsigned short* tl = (unsigned short*)g_lds;
        for (int tile = blockIdx.x; tile < NTOK / 64; tile += gridDim.x) { const int t0 = tile * 64, b = t0 / SEQ, tt0 = t0 % SEQ;
            { const int tok = tid >> 3, d8 = (tid & 7) * 8; *(u32x4*)(tl + tok * 72 + d8) = *(const u32x4*)(z + (size_t)(t0 + tok) * ZLD + C_VA + d8); }
            __syncthreads();
            { const int d = tid >> 3, k8 = (tid & 7) * 8; unsigned short e[8];
#pragma unroll
              for (int j = 0; j < 8; ++j) e[j] = tl[(k8 + j) * 72 + d];
              u32x4 w; w.x = e[0] | ((unsigned)e[1] << 16); w.y = e[2] | ((unsigned)e[3] << 16); w.z = e[4] | ((unsigned)e[5] << 16); w.w = e[6] | ((unsigned)e[7] << 16);
              *(u32x4*)(F.vt + ((size_t)b * 64 + d) * SEQ + tt0 + k8) = w; }
            __syncthreads();
        }
    }
    if (mode != 0) {
        const int gtid = blockIdx.x * NTHR + tid, gn = gridDim.x * NTHR;
        for (int idx = gtid; idx < NTOK * 72; idx += gn) { const int t = idx / 72, p = idx - t * 72, hd = p >> 2, i8 = (p & 3) * 8;
            const int base = hd < 8 ? C_Q + hd * 64 : (hd == 8 ? C_KA : (hd < 17 ? C_QI + (hd - 9) * 64 : C_KI));
            const float* rp = (const float*)&F.rope[(t & (SEQ - 1)) * 32 + i8];
            f32x4 cs[4];
#pragma unroll
            for (int j = 0; j < 4; ++j) { cs[j] = *(const f32x4*)(rp + 4 * j); if (mode == 2) cs[j] = (f32x4){1.f, 0.f, 1.f, 0.f}; }
            bf16_t* p1 = z + (size_t)t * ZLD + base + i8; const u32x4 a = *(const u32x4*)(p1), b2 = *(const u32x4*)(p1 + 32);
            const unsigned au[4] = {a.x, a.y, a.z, a.w}, bu[4] = {b2.x, b2.y, b2.z, b2.w}; unsigned o1[4], o2[4];
#pragma unroll
            for (int j = 0; j < 4; ++j) { const float x1a = bflo(au[j]), x1b = bfhi(au[j]), x2a = bflo(bu[j]), x2b = bfhi(bu[j]);
                o1[j] = cvt_pk_bf16(x1a * cs[j][0] - x2a * cs[j][1], x1b * cs[j][2] - x2b * cs[j][3]);
                o2[j] = cvt_pk_bf16(x2a * cs[j][0] + x1a * cs[j][1], x2b * cs[j][2] + x1b * cs[j][3]); }
            u32x4 w1, w2; w1.x = o1[0]; w1.y = o1[1]; w1.z = o1[2]; w1.w = o1[3]; w2.x = o2[0]; w2.y = o2[1]; w2.z = o2[2]; w2.w = o2[3];
            *(u32x4*)(p1) = w1; *(u32x4*)(p1 + 32) = w2; }
    }
}

struct ScanRaw { uint2 zr_c, zr_p, zk_c, zk_p, zv_c, zv_p, lwu, icu; };
struct ScanConst { f32x4 mur, muk, muv, kk, ka, rk; };
__device__ __forceinline__ void scan_load(ScanRaw& R, const bf16_t* z, const bf16_t* lw, const bf16_t* ic, size_t tokbase, int ch, int ptok, int gc) {
    const int t = ch * 16 + ptok; const size_t T = tokbase + t; const bf16_t* zp = z + T * ZLD + gc;
    R.zr_c = *(const uint2*)(zp + C_R); R.zk_c = *(const uint2*)(zp + C_K); R.zv_c = *(const uint2*)(zp + C_V);
    const uint2 zz = make_uint2(0u, 0u);
    if (t > 0) { R.zr_p = *(const uint2*)(zp - ZLD + C_R); R.zk_p = *(const uint2*)(zp - ZLD + C_K); R.zv_p = *(const uint2*)(zp - ZLD + C_V); } else { R.zr_p = zz; R.zk_p = zz; R.zv_p = zz; }
    R.lwu = *(const uint2*)(lw + T * 512 + gc); R.icu = *(const uint2*)(ic + T * 512 + gc);
}
__device__ __forceinline__ f32x4 unpack4(uint2 u) { f32x4 r; r[0] = bflo(u.x); r[1] = bfhi(u.x); r[2] = bflo(u.y); r[3] = bfhi(u.y); return r; }
__device__ __forceinline__ void scan_prep(const ScanRaw& R, const ScanConst& C, float* ops, float* vv, float* bonus_out, bool wr_bonus, int ptok, int pc, int v0) {
    const f32x4 rc = unpack4(R.zr_c), rp = unpack4(R.zr_p), kc = unpack4(R.zk_c), kp = unpack4(R.zk_p), vc = unpack4(R.zv_c), vp = unpack4(R.zv_p), ic = unpack4(R.icu), lw = unpack4(R.lwu);
    const f32x4 r = rc + (rp - rc) * C.mur, k = kc + (kp - kc) * C.muk, vs = vc + (vp - vc) * C.muv;
    f32x4 w; w[0] = __expf(lw[0]); w[1] = __expf(lw[1]); w[2] = __expf(lw[2]); w[3] = __expf(lw[3]);
    const f32x4 q = k * C.kk; const float ss = red16((q[0] * q[0] + q[1] * q[1]) + (q[2] * q[2] + q[3] * q[3]));
    const float inv = 1.0f / fmaxf(sqrtf(ss), 1e-12f); const f32x4 n = q * inv;
    const f32x4 kn = k * (1.0f + (ic - 1.0f) * C.ka);
    const f32x4 bt = r * kn * C.rk; const float bon = red16((bt[0] + bt[1]) + (bt[2] + bt[3]));
    if (wr_bonus) *bonus_out = bon;
    float* op = ops + ptok * 320 + pc;
    *(f32x4*)(op) = -n; *(f32x4*)(op + 64) = w; *(f32x4*)(op + 128) = n * ic; *(f32x4*)(op + 192) = kn; *(f32x4*)(op + 256) = r;
    if (pc >= v0 && pc < v0 + 32) *(f32x4*)(vv + ptok * 32 + pc - v0) = vs;
}
__device__ __forceinline__ void p3_scan(const Frame& F, const int mode) {
    const int tid = F.tid;
    float* opsb = (float*)g_lds;
    float* vvb = opsb + 2 * 5120;
    float* yob = vvb + 2 * 512;
    const bf16_t* z = F.z; const float* mu = F.in[3]; const float* k_k = F.in[9]; const float* k_a = F.in[10]; const float* r_k = F.in[11];
    for (int item = blockIdx.x; item < 256; item += gridDim.x) {
        const int bh = item >> 1, half = item & 1, b = bh >> 3, h = bh & 7, v0 = half * 32;
        const size_t tokbase = (size_t)b * SEQ;
        if (F.wave >= 4) {
            const int pt = tid - 256, ptok = pt >> 4, pc = (pt & 15) * 4, gc = h * 64 + pc;
            ScanConst C; C.mur = *(const f32x4*)(mu + C_R + gc); C.muk = *(const f32x4*)(mu + C_K + gc); C.muv = *(const f32x4*)(mu + C_V + gc);
            C.kk = *(const f32x4*)(k_k + gc); C.ka = *(const f32x4*)(k_a + gc); C.rk = *(const f32x4*)(r_k + gc);
            const bool wrb = (half == 0) && ((pt & 15) == 0);
            ScanRaw R;
            scan_load(R, z, F.lw, F.ic, tokbase, 0, ptok, gc);
            scan_prep(R, C, opsb, vvb, F.bonus + (tokbase + ptok) * 8 + h, wrb, ptok, pc, v0);
            scan_load(R, z, F.lw, F.ic, tokbase, 1, ptok, gc);
            lds_barrier();
            for (int ch = 0; ch < SEQ / 16; ++ch) {
                const int cur = ch & 1, nxt = cur ^ 1;
                if (mode != 2) {
                if (ch > 0) { const int tok = pt >> 4, r2 = (pt & 15) * 2;
                    *(float2*)(F.yraw + (tokbase + (ch - 1) * 16 + tok) * 512 + h * 64 + v0 + r2) = *(const float2*)(yob + nxt * 512 + tok * 32 + r2); }
                if (ch + 1 < SEQ / 16) {
                    scan_prep(R, C, opsb + nxt * 5120, vvb + nxt * 512, F.bonus + (tokbase + (ch + 1) * 16 + ptok) * 8 + h, wrb, ptok, pc, v0);
                    if (ch + 2 < SEQ / 16) scan_load(R, z, F.lw, F.ic, tokbase, ch + 2, ptok, gc);
                } }
                lds_barrier();
            }
            { const int tok = pt >> 4, r2 = (pt & 15) * 2;
              *(float2*)(F.yraw + (tokbase + (SEQ / 16 - 1) * 16 + tok) * 512 + h * 64 + v0 + r2) = *(const float2*)(yob + 512 + tok * 32 + r2); }
        } else {
            const int rp = tid >> 4, ks = tid & 15;
            float A0 = 0.f, A1 = 0.f, A2 = 0.f, A3 = 0.f, B0 = 0.f, B1 = 0.f, B2 = 0.f, B3 = 0.f;
            const int ywoff = (ks == 0) ? 2 * rp : (2 * 512 + 2 * tid), ywstep = (ks == 0) ? 32 : 0;
            lds_barrier();
            f32x4 rprev = {0.f, 0.f, 0.f, 0.f}; float* ywp = yob + 2 * 512 + 2 * tid;
            for (int ch = 0; ch < SEQ / 16; ++ch) {
                const int cur = ch & 1;
                const float* ops = opsb + cur * 5120 + ks * 4; const float* vv = vvb + cur * 512 + 2 * rp; float* yw = yob + cur * 512 + ywoff;
                if (mode != 1) {
#pragma unroll
                for (int s = 0; s < 16; ++s) {
                    const float* o = ops + s * 320;
                    const f32x4 a4 = *(const f32x4*)(o), w4 = *(const f32x4*)(o + 64), b4 = *(const f32x4*)(o + 128), k4 = *(const f32x4*)(o + 192), r4 = *(const f32x4*)(o + 256);
                    const float2 vab = *(const float2*)(vv + s * 32);
                    float sa = (A0 * a4[0] + A1 * a4[1]) + (A2 * a4[2] + A3 * a4[3]); float sb = (B0 * a4[0] + B1 * a4[1]) + (B2 * a4[2] + B3 * a4[3]);
                    float ya = (A0 * rprev[0] + A1 * rprev[1]) + (A2 * rprev[2] + A3 * rprev[3]); float yb2 = (B0 * rprev[0] + B1 * rprev[1]) + (B2 * rprev[2] + B3 * rprev[3]);
                    red16x4(sa, sb, ya, yb2);
                    *(float2*)(ywp) = make_float2(ya, yb2);
                    ywp = yw + s * ywstep;
                    A0 = A0 * w4[0] + sa * b4[0] + vab.x * k4[0]; A1 = A1 * w4[1] + sa * b4[1] + vab.x * k4[1];
                    A2 = A2 * w4[2] + sa * b4[2] + vab.x * k4[2]; A3 = A3 * w4[3] + sa * b4[3] + vab.x * k4[3];
                    B0 = B0 * w4[0] + sb * b4[0] + vab.y * k4[0]; B1 = B1 * w4[1] + sb * b4[1] + vab.y * k4[1];
                    B2 = B2 * w4[2] + sb * b4[2] + vab.y * k4[2]; B3 = B3 * w4[3] + sb * b4[3] + vab.y * k4[3];
                    rprev = r4;
                }
                {
                    float ya = (A0 * rprev[0] + A1 * rprev[1]) + (A2 * rprev[2] + A3 * rprev[3]); float yb2 = (B0 * rprev[0] + B1 * rprev[1]) + (B2 * rprev[2] + B3 * rprev[3]);
                    float d0 = 0.f, d1 = 0.f; red16x4(ya, yb2, d0, d1);
                    *(float2*)(ywp) = make_float2(ya, yb2); ywp = yob + 2 * 512 + 2 * tid; rprev = (f32x4){0.f, 0.f, 0.f, 0.f};
                } }
                lds_barrier();
            }
        }
        __syncthreads();
    }
}

__device__ __forceinline__ unsigned ordkey(float f) { const unsigned u = __float_as_uint(f); return (u & 0x80000000u) ? ~u : (u | 0x80000000u); }

__device__ __forceinline__ void attn_chunk(const unsigned char* kb, const unsigned char* vb, const unsigned* selm, int c, int p, int fr, int fq, const bf16x8 (&Bqa)[2][2], f32x4 (&O)[2][4], f32x4 (&RS)[2]) {
    const f32x4 zero4 = {0.f, 0.f, 0.f, 0.f};
    const u32x4 onesu = {0x3f803f80u, 0x3f803f80u, 0x3f803f80u, 0x3f803f80u}; const bf16x8 ones = __builtin_bit_cast(bf16x8, onesu);
    const float csc = 0.125f * 1.4426950408889634f;
    const unsigned char* k0p = kb + ((2 * p) * 16 + fr) * 144 + fq * 16; const unsigned char* k1p = k0p + 16 * 144;
    const bf16x8 KA00 = *(const bf16x8*)(k0p), KA01 = *(const bf16x8*)(k0p + 64), KA10 = *(const bf16x8*)(k1p), KA11 = *(const bf16x8*)(k1p + 64);
    const int mw = (int)selm[fr * 64 + 2 * c + p];
    bf16x8 VA[4];
#pragma unroll
    for (int dt = 0; dt < 4; ++dt) { const unsigned char* vp = vb + (dt * 16 + fr) * 144 + (2 * p) * 32 + fq * 8;
        const uint2 lo = *(const uint2*)(vp), hi = *(const uint2*)(vp + 32);
        u32x4 va; va.x = lo.x; va.y = lo.y; va.z = hi.x; va.w = hi.y; VA[dt] = __builtin_bit_cast(bf16x8, va); }
    unsigned km0[4], km1[4];
#pragma unroll
    for (int jj = 0; jj < 4; ++jj) { km0[jj] = (unsigned)__builtin_amdgcn_sbfe(mw, fq * 4 + jj, 1); km1[jj] = (unsigned)__builtin_amdgcn_sbfe(mw, 16 + fq * 4 + jj, 1); }
#pragma unroll
    for (int hh = 0; hh < 2; ++hh) {
        f32x4 s0 = __builtin_amdgcn_mfma_f32_16x16x32_bf16(KA00, Bqa[hh][0], zero4, 0, 0, 0); s0 = __builtin_amdgcn_mfma_f32_16x16x32_bf16(KA01, Bqa[hh][1], s0, 0, 0, 0);
        f32x4 s1 = __builtin_amdgcn_mfma_f32_16x16x32_bf16(KA10, Bqa[hh][0], zero4, 0, 0, 0); s1 = __builtin_amdgcn_mfma_f32_16x16x32_bf16(KA11, Bqa[hh][1], s1, 0, 0, 0);
        unsigned p0[4], p1[4];
#pragma unroll
        for (int jj = 0; jj < 4; ++jj) {
            p0[jj] = __float_as_uint(__builtin_amdgcn_exp2f(fminf(s0[jj] * csc, 86.f))) & km0[jj]; p1[jj] = __float_as_uint(__builtin_amdgcn_exp2f(fminf(s1[jj] * csc, 86.f))) & km1[jj]; }
        u32x4 pk; pk.x = cvt_pk_bf16(__uint_as_float(p0[0]), __uint_as_float(p0[1])); pk.y = cvt_pk_bf16(__uint_as_float(p0[2]), __uint_as_float(p0[3]));
        pk.z = cvt_pk_bf16(__uint_as_float(p1[0]), __uint_as_float(p1[1])); pk.w = cvt_pk_bf16(__uint_as_float(p1[2]), __uint_as_float(p1[3]));
        const bf16x8 PB = __builtin_bit_cast(bf16x8, pk);
        RS[hh] = __builtin_amdgcn_mfma_f32_16x16x32_bf16(ones, PB, RS[hh], 0, 0, 0);
#pragma unroll
        for (int dt = 0; dt < 4; ++dt) O[hh][dt] = __builtin_amdgcn_mfma_f32_16x16x32_bf16(VA[dt], PB, O[hh][dt], 0, 0, 0);
    }
}

__device__ __forceinline__ void p3_dsa(const Frame& F) {
    const int tid = F.tid, lane = F.lane, wave = F.wave, fr = lane & 15, fq = lane >> 4;
    unsigned* scl = (unsigned*)g_lds;
    unsigned* selm = (unsigned*)(g_lds + 131328);
    unsigned char* kbuf = (unsigned char*)g_lds;
    unsigned char* vbuf = kbuf + 2 * 9216;
    const bf16_t* z = F.z; const int G = gridDim.x, bx = blockIdx.x;
    const f32x4 zero4 = {0.f, 0.f, 0.f, 0.f};
    for (int rnd = 0; rnd * G < 2048; ++rnd) {
        const int n = rnd * G + ((rnd & 1) ? (G - 1 - bx) : bx);
        if (n >= 2048) continue;
        const int qg = 127 - (n >> 4), b = n & 15, q0 = qg * 16; const size_t Tb = (size_t)b * SEQ;
        for (int i = tid; i < 1024; i += NTHR) selm[i] = 0u;
        __syncthreads();
        const bf16_t* zq = z + (Tb + q0 + fr) * ZLD;
        const unsigned lofk = (unsigned)((fr * ZLD + fq * 8) * 2), lofv = (unsigned)((fr * SEQ + fq * 4) * 2);
        const int nchunk = (qg + 4) >> 2; const int lrow = tid >> 3, lseg = tid & 7;
        const bf16_t* kg = z + (Tb + lrow) * ZLD + C_KA + lseg * 8; const bf16_t* vg = F.vt + ((size_t)b * 64 + lrow) * SEQ + lseg * 8;
        const unsigned lst = (unsigned)(lrow * 144 + lseg * 16);
        const int hp = wave >> 1, kh = wave & 1;
        const u32x4 kc0 = *(const u32x4*)(kg), vc0 = *(const u32x4*)(vg);
        u32x4 kx = kc0, vx = vc0, ky = kc0, vy = vc0;
        if (1 < nchunk) { kx = *(const u32x4*)(kg + (size_t)64 * ZLD); vx = *(const u32x4*)(vg + 64); }
        if (2 < nchunk) { ky = *(const u32x4*)(kg + (size_t)128 * ZLD); vy = *(const u32x4*)(vg + 128); }
        bf16x8 Bqa[2][2];
#pragma unroll
        for (int hh = 0; hh < 2; ++hh)
#pragma unroll
            for (int ks = 0; ks < 2; ++ks) Bqa[hh][ks] = *(const bf16x8*)(zq + C_Q + (2 * hp + hh) * 64 + ks * 32 + fq * 8);
        if (qg >= 16) {
            const u32x4 wv = *(const u32x4*)(zq + C_WI);
            {
                bf16x8 Bq[8][2];
#pragma unroll
                for (int hh = 0; hh < 8; ++hh)
#pragma unroll
                    for (int ks = 0; ks < 2; ++ks) Bq[hh][ks] = *(const bf16x8*)(zq + C_QI + hh * 64 + ks * 32 + fq * 8);
                const float sc = 0.044194173824159216f;
                float wih[8]; wih[0] = bflo(wv.x) * sc; wih[1] = bfhi(wv.x) * sc; wih[2] = bflo(wv.y) * sc; wih[3] = bfhi(wv.y) * sc; wih[4] = bflo(wv.z) * sc; wih[5] = bfhi(wv.z) * sc; wih[6] = bflo(wv.w) * sc; wih[7] = bfhi(wv.w) * sc;
#pragma unroll 1
                for (int half = 0; half < 2; ++half) {
                    const int ktb = wave + 64 * half; if (ktb > qg) break;
                    bf16x8 W0[2], W1[2];
#pragma unroll
                    for (int j = 0; j < 2; ++j) { const int ktj = (ktb + 8 * j) < qg ? (ktb + 8 * j) : qg; const char* kb = (const char*)(z + (Tb + (size_t)ktj * 16) * ZLD + C_KI);
                        W0[j] = *(const bf16x8*)(kb + lofk); W1[j] = *(const bf16x8*)(kb + lofk + 64); }
#pragma unroll
                    for (int i = 0; i < 8; ++i) { const int kt = ktb + 8 * i;
                        if (kt <= qg) { f32x4 sv = zero4;
#pragma unroll
                            for (int hh = 0; hh < 8; ++hh) { f32x4 acc = __builtin_amdgcn_mfma_f32_16x16x32_bf16(W0[i & 1], Bq[hh][0], zero4, 0, 0, 0);
                                acc = __builtin_amdgcn_mfma_f32_16x16x32_bf16(W1[i & 1], Bq[hh][1], acc, 0, 0, 0);
#pragma unroll
                                for (int jj = 0; jj < 4; ++jj) sv[jj] += wih[hh] * fmaxf(acc[jj], 0.f); }
                            u32x4 w; w.x = ordkey(sv[0]); w.y = ordkey(sv[1]); w.z = ordkey(sv[2]); w.w = ordkey(sv[3]);
                            *(u32x4*)(scl + fr * 2052 + kt * 16 + fq * 4) = w;
                        }
                        if (i + 2 < 8) { const int ktn = (kt + 16) < qg ? (kt + 16) : qg; const char* kb = (const char*)(z + (Tb + (size_t)ktn * 16) * ZLD + C_KI);
                            unsigned lo2 = lofk; asm volatile("" : "+v"(lo2));
                            W0[i & 1] = *(const bf16x8*)(kb + lo2); W1[i & 1] = *(const bf16x8*)(kb + lo2 + 64); }
                    }
                }
            }
            __syncthreads();
#pragma unroll 1
            for (int qq = 0; qq < 2; ++qq) {
                const int q = 2 * wave + qq, qpos = q0 + q;
                unsigned uk[32];
#pragma unroll
                for (int r = 0; r < 32; ++r) { const int key = r * 64 + lane; uk[r] = 0x007fffffu;
                    if (r * 64 <= qpos) { const unsigned v = scl[q * 2052 + key]; uk[r] = (key <= qpos) ? v : 0x007fffffu; } }
                unsigned T = 0u; bool exact = false;
#pragma unroll 1
                for (int bit = 31; bit >= 0; --bit) {
                    const unsigned cand = T | (1u << bit); int c = 0;
#pragma unroll
                    for (int g = 0; g < 4; ++g) {
                        if (g * 512 > qpos) break;
                        unsigned long long m[8];
                        asm("v_cmp_ge_u32_e64 %0, %8, %16\n\tv_cmp_ge_u32_e64 %1, %9, %16\n\tv_cmp_ge_u32_e64 %2, %10, %16\n\tv_cmp_ge_u32_e64 %3, %11, %16\n\t"
                            "v_cmp_ge_u32_e64 %4, %12, %16\n\tv_cmp_ge_u32_e64 %5, %13, %16\n\tv_cmp_ge_u32_e64 %6, %14, %16\n\tv_cmp_ge_u32_e64 %7, %15, %16"
                            : "=&s"(m[0]), "=&s"(m[1]), "=&s"(m[2]), "=&s"(m[3]), "=&s"(m[4]), "=&s"(m[5]), "=&s"(m[6]), "=&s"(m[7])
                            : "v"(uk[g * 8 + 0]), "v"(uk[g * 8 + 1]), "v"(uk[g * 8 + 2]), "v"(uk[g * 8 + 3]), "v"(uk[g * 8 + 4]), "v"(uk[g * 8 + 5]), "v"(uk[g * 8 + 6]), "v"(uk[g * 8 + 7]), "v"(cand));
#pragma unroll
                        for (int j = 0; j < 8; ++j) c += __builtin_popcountll(m[j]);
                    }
                    if (c >= 256) { T = cand; if (c == 256) { exact = true; break; } }
                }
                int need = 0;
                if (!exact) { int c = 0;
#pragma unroll
                    for (int r = 0; r < 32; ++r) c += __builtin_popcountll(__builtin_amdgcn_ballot_w64(uk[r] > T));
                    need = 256 - c; }
#pragma unroll
                for (int r = 0; r < 32; ++r) {
                    if (r * 64 <= qpos) {
                        unsigned long long sel;
                        if (exact) sel = __builtin_amdgcn_ballot_w64(uk[r] >= T);
                        else { sel = __builtin_amdgcn_ballot_w64(uk[r] > T); unsigned long long e = __builtin_amdgcn_ballot_w64(uk[r] == T);
                            const int ne = __builtin_popcountll(e);
                            if (ne <= need) { sel |= e; need -= ne; }
                            else { for (int k = 0; k < need; ++k) { const unsigned long long lb = e & (0ull - e); sel |= lb; e ^= lb; } need = 0; } }
                        if (lane == 0) { selm[q * 64 + 2 * r] = (unsigned)sel; selm[q * 64 + 2 * r + 1] = (unsigned)(sel >> 32); }
                    }
                }
            }
        } else {
            for (int w = tid; w < 1024; w += NTHR) { const int q = w >> 6, word = w & 63, qpos = q0 + q, lo = word * 32;
                selm[w] = (qpos >= lo + 31) ? 0xffffffffu : (qpos < lo ? 0u : ((2u << (qpos - lo)) - 1u)); }
        }
        __syncthreads();
        {
            *(u32x4*)(kbuf + lst) = kc0; *(u32x4*)(vbuf + lst) = vc0;
            f32x4 O[2][4]; f32x4 rs[2];
#pragma unroll
            for (int hh = 0; hh < 2; ++hh) { rs[hh] = zero4;
#pragma unroll
                for (int dt = 0; dt < 4; ++dt) O[hh][dt] = zero4; }
            lds_barrier();
#pragma unroll 1
            for (int c = 0; c < nchunk; c += 2) {
                attn_chunk(kbuf, vbuf, selm, c, kh, fr, fq, Bqa, O, rs);
                if (c + 1 < nchunk) { *(u32x4*)(kbuf + 9216 + lst) = kx; *(u32x4*)(vbuf + 9216 + lst) = vx; }
                if (c + 3 < nchunk) { kx = *(const u32x4*)(kg + (size_t)(c + 3) * 64 * ZLD); vx = *(const u32x4*)(vg + (c + 3) * 64); }
                lds_barrier();
                if (c + 1 < nchunk) {
                    attn_chunk(kbuf + 9216, vbuf + 9216, selm, c + 1, kh, fr, fq, Bqa, O, rs);
                    if (c + 2 < nchunk) { *(u32x4*)(kbuf + lst) = ky; *(u32x4*)(vbuf + lst) = vy; }
                    if (c + 4 < nchunk) { ky = *(const u32x4*)(kg + (size_t)(c + 4) * 64 * ZLD); vy = *(const u32x4*)(vg + (c + 4) * 64); }
                    lds_barrier();
                }
            }
            float* xb = (float*)(vbuf + 2 * 9216) + (size_t)wave * (64 * 17);
            { const int oh = kh ^ 1;
#pragma unroll
              for (int dt = 0; dt < 4; ++dt)
#pragma unroll
                  for (int jj = 0; jj < 4; ++jj) xb[(dt * 4 + jj) * 64 + lane] = (oh == 0) ? O[0][dt][jj] : O[1][dt][jj];
              xb[16 * 64 + lane] = (oh == 0) ? rs[0][0] : rs[1][0]; }
            lds_barrier();
            { const float* pb = (const float*)(vbuf + 2 * 9216) + (size_t)(wave ^ 1) * (64 * 17);
              float tot = ((kh == 0) ? rs[0][0] : rs[1][0]) + pb[16 * 64 + lane];
              const float inv = 1.0f / tot;
              bf16_t* yp = F.yb + (Tb + q0 + fr) * 512 + (2 * hp + kh) * 64 + fq * 4;
#pragma unroll
              for (int dt = 0; dt < 4; ++dt) { float o[4];
#pragma unroll
                  for (int jj = 0; jj < 4; ++jj) o[jj] = (((kh == 0) ? O[0][dt][jj] : O[1][dt][jj]) + pb[(dt * 4 + jj) * 64 + lane]) * inv;
                  uint2 w; w.x = cvt_pk_bf16(o[0], o[1]); w.y = cvt_pk_bf16(o[2], o[3]); *(uint2*)(yp + dt * 16) = w; } }
        }
        __syncthreads();
    }
}

__device__ __forceinline__ void p4_post(const Frame& F) {
    const int tid = F.tid; const float* mu = F.in[3]; const float* gnw = F.in[12]; const float* gnb = F.in[13]; const bf16_t* z = F.z;
    for (int g = blockIdx.x * 32 + (tid >> 4); g < NTOK * 8; g += gridDim.x * 32) { const size_t t = (size_t)(g >> 3); const int h = g & 7, c = h * 64 + (tid & 15) * 4;
        const f32x4 y = *(const f32x4*)(F.yraw + t * 512 + c);
        const float mean = red16((y[0] + y[1]) + (y[2] + y[3])) * (1.0f / 64.0f);
        const f32x4 d = y - mean;
        const float var = red16((d[0] * d[0] + d[1] * d[1]) + (d[2] * d[2] + d[3] * d[3])) * (1.0f / 64.0f); const float rstd = rsqrtf(var + 64e-5f);
        const uint2 vc = *(const uint2*)(z + t * ZLD + C_V + c); uint2 vp = make_uint2(0u, 0u); if (t & (SEQ - 1)) vp = *(const uint2*)(z + (t - 1) * ZLD + C_V + c);
        const f32x4 m4 = *(const f32x4*)(mu + C_V + c), w4 = *(const f32x4*)(gnw + c), b4 = *(const f32x4*)(gnb + c);
        const uint2 gt = *(const uint2*)(F.gt + t * 512 + c); const float bon = F.bonus[t * 8 + h];
        f32x4 vcf, vpf, gtf; vcf[0] = bflo(vc.x); vcf[1] = bfhi(vc.x); vcf[2] = bflo(vc.y); vcf[3] = bfhi(vc.y); vpf[0] = bflo(vp.x); vpf[1] = bfhi(vp.x); vpf[2] = bflo(vp.y); vpf[3] = bfhi(vp.y);
        gtf[0] = bflo(gt.x); gtf[1] = bfhi(gt.x); gtf[2] = bflo(gt.y); gtf[3] = bfhi(gt.y);
        const f32x4 vs = vcf + (vpf - vcf) * m4;
        const f32x4 o = (d * rstd * w4 + b4 + vs * bon) * gtf;
        uint2 w; w.x = cvt_pk_bf16(o[0], o[1]); w.y = cvt_pk_bf16(o[2], o[3]); *(uint2*)(F.ya + t * 512 + c) = w; }
}

__device__ __forceinline__ void p9_final(const Frame& F, const bool ident) {
    const float* g = F.in[19]; const int lane = F.lane;
    for (int row = blockIdx.x * 8 + F.wave; row < NTOK; row += gridDim.x * 8) {
        float* xr = F.out + (size_t)row * DM; const float sc = ident ? 1.0f : rsqrtf(F.ss2[row] * (1.0f / 1024.0f) + 1e-6f);
#pragma unroll
        for (int i = 0; i < 4; ++i) { f32x4 v = *(const f32x4*)(xr + i * 256 + lane * 4); const f32x4 gg = *(const f32x4*)(g + i * 256 + lane * 4);
            if (!ident) { v[0] *= sc * gg[0]; v[1] *= sc * gg[1]; v[2] *= sc * gg[2]; v[3] *= sc * gg[3]; } *(f32x4*)(xr + i * 256 + lane * 4) = v; }
    }
}
#define XB_TMO      128
#define XB_XCNT(j)  (256  + 64 * (j))
#define XB_XSUB(j)  (1280 + 64 * (j))
#define XB_XGEN(j)  (2304 + 64 * (j))
#define XB_TOP      3328
#define XB_TOPGEN   3392
#define XCD_BAR_WORDS 3456
#define XB_SPIN_CAP (1u << 18)
#define LAS __attribute__((address_space(3)))

__device__ __forceinline__ unsigned xb_ld(unsigned* p)              { return __hip_atomic_load(p, __ATOMIC_RELAXED, __HIP_MEMORY_SCOPE_AGENT); }
__device__ __forceinline__ unsigned xb_add(unsigned* p, unsigned v) { return __hip_atomic_fetch_add(p, v, __ATOMIC_RELAXED, __HIP_MEMORY_SCOPE_AGENT); }
__device__ __forceinline__ unsigned xb_xcc_id() { return (unsigned)__builtin_amdgcn_s_getreg((3 << 11) | 20) & 0xFu; }
#define XB_SPIN(cond, bar) do { unsigned _sp = 0; while (cond) { __builtin_amdgcn_s_sleep(1); \
    if ((++_sp & 255u) == 0u) { if (xb_ld(&(bar)[XB_TMO])) break; if (_sp > XB_SPIN_CAP) { atomicAdd(&(bar)[XB_TMO], 1u); break; } } } } while (0)

struct XcdBarrier {
    unsigned* bar; unsigned x;
    volatile LAS unsigned* st;
};

__device__ __forceinline__ XcdBarrier xcd_barrier_post(unsigned* bar, volatile LAS unsigned* st) {
    XcdBarrier b; b.bar = bar; b.x = xb_xcc_id(); b.st = st;
    if (threadIdx.x == 0) (void)xb_add(&bar[XB_XCNT(b.x)], 1u);
    return b;
}
__device__ __forceinline__ void xcd_barrier_complete(unsigned* bar, unsigned x, unsigned& nloc, unsigned& nx) {
    const unsigned G = gridDim.x * gridDim.y * gridDim.z;
    unsigned sum, cnt, mine, sp = 0u;
    for (;;) {
        sum = 0u; cnt = 0u; mine = 0u;
#pragma unroll
        for (unsigned j = 0; j < 16; ++j) { const unsigned c = xb_ld(&bar[XB_XCNT(j)]); sum += c; cnt += (c > 0u) ? 1u : 0u; mine = (j == x) ? c : mine; }
        if (sum == G) break;
        __builtin_amdgcn_s_sleep(1);
        if ((++sp & 255u) == 0u) { if (xb_ld(&bar[XB_TMO])) break; if (sp > XB_SPIN_CAP) { atomicAdd(&bar[XB_TMO], 1u); break; } }
    }
    nloc = mine > 0u ? mine : 1u; nx = cnt > 0u ? cnt : 1u;
}

__device__ __forceinline__ void xcd_barrier(const XcdBarrier& b) {
    asm volatile("s_waitcnt vmcnt(0)" ::: "memory");
    __syncthreads();
    if (threadIdx.x == 0) {
        unsigned* bar = b.bar;
        __builtin_amdgcn_s_waitcnt(0);
        unsigned nloc = b.st[0], nx = b.st[1];
        if (nloc == 0u) { xcd_barrier_complete(bar, b.x, nloc, nx); b.st[0] = nloc; b.st[1] = nx; }
        const unsigned old = xb_add(&bar[XB_XSUB(b.x)], 1u);
        const unsigned gen = old / nloc;
        if (old + 1u == (gen + 1u) * nloc) {
            __builtin_amdgcn_fence(__ATOMIC_RELEASE, "agent");
            asm volatile("s_waitcnt vmcnt(0)" ::: "memory");
            const unsigned og = xb_add(&bar[XB_TOP], 1u);
            const unsigned tg = og / nx;
            if (og + 1u == (tg + 1u) * nx) xb_add(&bar[XB_TOPGEN], 1u);
            else XB_SPIN(xb_ld(&bar[XB_TOPGEN]) == tg, bar);
            __builtin_amdgcn_fence(__ATOMIC_ACQUIRE, "agent");
            xb_add(&bar[XB_XGEN(b.x)], 1u);
            asm volatile("s_waitcnt vmcnt(0)" ::: "memory");
        } else {
            XB_SPIN(xb_ld(&bar[XB_XGEN(b.x)]) == gen, bar);
            __builtin_amdgcn_fence(__ATOMIC_ACQUIRE, "agent");
            asm volatile("s_waitcnt vmcnt(0)" ::: "memory");
        }
    }
    __syncthreads();
}
#ifndef PHASE_MASK
#define PHASE_MASK 0x3ff
#endif
#ifndef GEMM_ALIGN
#define GEMM_ALIGN true
#endif
#ifndef GEMM_SP2
#define GEMM_SP2 true
#endif
constexpr int NPHASE = 10;
constexpr size_t WS_BAR = 3 * MiB;
template <class Epi> __device__ __forceinline__ void run_gemm(const bf16_t* A, const bf16_t* Bt, int N, int K, const Epi& E) {
    pg8::Gemm g{A, Bt, NTOK, N, K}; pg8::StaticOrder S; S.init(NTOK, N, (int)gridDim.x, (int)blockIdx.x);
    pg8::gemm_phase<Epi, pg8::StaticOrder, GEMM_ALIGN, GEMM_SP2>((PG8_LAS unsigned char*)g_lds, g, S, E);
}
__global__ void __launch_bounds__(NTHR, 2) mega_fwd(Args args) {
    Frame F;
#pragma unroll
    for (int i = 0; i < 20; ++i) F.in[i] = args.in[i];
    F.out = args.out; F.ws = args.ws; F.lds = nullptr; F.tid = threadIdx.x; F.lane = F.tid & 63; F.wave = __builtin_amdgcn_readfirstlane(F.tid >> 6);
    unsigned char* ws = args.ws;
    F.ss1 = (float*)(ws + WS_SS1); F.ss2 = (float*)(ws + WS_SS2); F.bonus = (float*)(ws + WS_BONUS); F.rope = (float2*)(ws + WS_ROPE);
    F.wd = (bf16_t*)(ws + WS_WD); F.wi = (bf16_t*)(ws + WS_WI); F.wg = (bf16_t*)(ws + WS_WG);
    F.win = (bf16_t*)(ws + WS_WIN); F.wup = (bf16_t*)(ws + WS_WUP); F.wdn = (bf16_t*)(ws + WS_WDN); F.wb = (bf16_t*)(ws + WS_WB); F.wo = (bf16_t*)(ws + WS_WO); F.vt = (bf16_t*)(ws + WS_VT);
    F.h = (bf16_t*)(ws + WS_H); F.ya = F.h; F.yb = F.h + (size_t)NTOK * 512; F.xb = F.h;
    F.z = (bf16_t*)(ws + WS_Z); F.hid = F.z;
    F.lw = (bf16_t*)(ws + WS_P); F.ic = F.lw + (size_t)NTOK * 512; F.mg = F.lw;
    F.yraw = args.out; F.gt = (bf16_t*)(args.out + (size_t)NTOK * 512);
    const int lo = args.ph_lo, hi = args.ph_hi;
    cg::grid_group grid = cg::this_grid();
    if (args.ph_lo < 0) grid.sync();
    volatile LAS unsigned* xst = (volatile LAS unsigned*)(g_lds + LDS_BYTES - 64);
    if (threadIdx.x == 0) { xst[0] = 0u; xst[1] = 0u; }
    __syncthreads();
    XcdBarrier xbar = xcd_barrier_post((unsigned*)(ws + WS_BAR), xst);
#define IN(k) (lo <= (k) && (k) < hi)
#define SEAM(k) do { if (IN(k) && IN((k) + 1)) { xcd_barrier(xbar); if (REP(17)) xcd_barrier(xbar); } } while (0)
    if (((PHASE_MASK >> 0) & 1) && IN(0)) { p0_prologue(F); __syncthreads(); if (REP(0)) { p0_prologue(F); __syncthreads(); } } SEAM(0);
    if (((PHASE_MASK >> 1) & 1) && IN(1)) { pg8::EpiZ E{F.z, ZLD}; run_gemm(F.h, F.win, 5120, 1024, E); __syncthreads(); if (REP(1)) { run_gemm(F.h, F.win, 5120, 1024, E); __syncthreads(); } if (REP(18)) { run_gemm(F.h, F.win, 4096, 1024, E); __syncthreads(); } } SEAM(1);
    if (((PHASE_MASK >> 2) & 1) && IN(2)) { if (REP(2)) { p2_prep(F, 0); __syncthreads(); } if (REP(16)) { p2_prep(F, 2); __syncthreads(); } p2_prep(F, 1); __syncthreads(); } SEAM(2);
    if (((PHASE_MASK >> 3) & 1) && IN(3)) { if (REP(14)) { p3_scan(F, 1); __syncthreads(); } if (REP(15)) { p3_scan(F, 2); __syncthreads(); } if (REP(3)) { p3_scan(F, 0); __syncthreads(); } p3_scan(F, 0); __syncthreads(); p3_dsa(F); __syncthreads(); if (REP(10)) { p3_dsa(F); __syncthreads(); } } SEAM(3);
    if (((PHASE_MASK >> 4) & 1) && IN(4)) { p4_post(F); __syncthreads(); if (REP(4)) { p4_post(F); __syncthreads(); } } SEAM(4);
    if (((PHASE_MASK >> 5) & 1) && IN(5)) { pg8::EpiGate<0> E0{F.mg, F.z, ZLD, C_G0}; run_gemm(F.ya, F.wb, 1024, 512, E0); __syncthreads();
                 pg8::EpiGate<1> E1{F.mg, F.z, ZLD, C_G1}; run_gemm(F.yb, F.wb + 1024 * 512, 1024, 512, E1); __syncthreads();
                 if (REP(5)) { run_gemm(F.ya, F.wb, 1024, 512, E0); __syncthreads(); run_gemm(F.yb, F.wb + 1024 * 512, 1024, 512, E1); __syncthreads(); } } SEAM(5);
    if (((PHASE_MASK >> 6) & 1) && IN(6)) { if (REP(6)) { pg8::EpiRes1 Ex{F.in[0], F.xb, F.bonus}; run_gemm(F.mg, F.wo, 1024, 1024, Ex); __syncthreads(); }
                 pg8::EpiRes1 E{F.in[0], F.xb, F.ss1}; run_gemm(F.mg, F.wo, 1024, 1024, E); __syncthreads(); } SEAM(6);
    if (((PHASE_MASK >> 7) & 1) && IN(7)) { pg8::EpiHid E{F.hid, F.ss1}; run_gemm(F.xb, F.wup, 4096, 1024, E); __syncthreads(); if (REP(7)) { run_gemm(F.xb, F.wup, 4096, 1024, E); __syncthreads(); } } SEAM(7);
    if (((PHASE_MASK >> 8) & 1) && IN(8)) { pg8::EpiRes2 E{F.xb, F.out, F.ss2}; run_gemm(F.hid, F.wdn, 1024, 4096, E); __syncthreads(); } SEAM(8);
    if (((PHASE_MASK >> 9) & 1) && IN(9)) { if (REP(9)) { p9_final(F, true); __syncthreads(); } p9_final(F, false); }
#undef IN
#undef SEAM
}

extern "C" void kernel_launch(void* const* d_in, const int* in_sizes, int n_in, void* d_out, int out_size, void* d_ws, size_t ws_size, hipStream_t stream) {
    static int grid = 0;
    if (grid == 0) {
        if (n_in != 20 || out_size != NTOK * DM || ws_size < WS_END) { fprintf(stderr, "kernel_launch: unexpected shapes (n_in %d, out %d, ws %zu < %zu)\n", n_in, out_size, ws_size, (size_t)WS_END); grid = -1; return; }
        int dev = 0, cus = 0, per_cu = 0;
        hipGetDevice(&dev); hipDeviceGetAttribute(&cus, hipDeviceAttributeMultiprocessorCount, dev);
        if (hipFuncSetAttribute((const void*)mega_fwd, hipFuncAttributeMaxDynamicSharedMemorySize, LDS_BYTES) != hipSuccess) { fprintf(stderr, "kernel_launch: hipFuncSetAttribute failed\n"); grid = -1; return; }
        if (hipOccupancyMaxActiveBlocksPerMultiprocessor(&per_cu, (const void*)mega_fwd, NTHR, LDS_BYTES) != hipSuccess || per_cu < 1) { fprintf(stderr, "kernel_launch: occupancy query failed (%d)\n", per_cu); per_cu = 1; }
        (void)hipGetLastError();
        grid = cus * per_cu;
        fprintf(stderr, "kernel_launch: grid %d (%d CUs x %d)\n", grid, cus, per_cu);
    }
    if (grid < 0) return;
    if (hipMemsetAsync((char*)d_ws + WS_BAR, 0, XCD_BAR_WORDS * 4, stream) != hipSuccess) { fprintf(stderr, "kernel_launch: memset of the barrier words failed\n"); return; }
    Args a{};
    for (int i = 0; i < 20; ++i) a.in[i] = (const float*)d_in[i];
    a.out = (float*)d_out; a.ws = (unsigned char*)d_ws;
#if MK_PER_PHASE_LAUNCH
    for (int p = 0; p < NPHASE; ++p) { a.ph_lo = p; a.ph_hi = p + 1; hipLaunchKernelGGL(mega_fwd, dim3(grid), dim3(NTHR), LDS_BYTES, stream, a); }
#else
    a.ph_lo = 0; a.ph_hi = NPHASE;
    void* kargs[] = {&a};
    hipError_t e = hipLaunchCooperativeKernel((const void*)mega_fwd, dim3(grid), dim3(NTHR), kargs, LDS_BYTES, stream);
    if (e != hipSuccess) fprintf(stderr, "kernel_launch: cooperative launch failed: %s (grid %d)\n", hipGetErrorString(e), grid);
#endif
}
```

```cpp
#include <hip/hip_runtime.h>
#include <hip/hip_cooperative_groups.h>
#include <cstdio>
#include <cstdint>
namespace cg = cooperative_groups;

#ifndef MK_PER_PHASE_LAUNCH
#define MK_PER_PHASE_LAUNCH 0
#endif

#ifndef REPEAT_MASK
#define REPEAT_MASK 0
#endif
#define REP(k) ((REPEAT_MASK >> (k)) & 1)
#ifndef TS_SEL
#define TS_SEL -1
#endif

namespace pg8 {
#define PG8_LAS __attribute__((address_space(3)))
typedef unsigned short bf16_t;
typedef short bf16x8 __attribute__((ext_vector_type(8)));
typedef float f32x4 __attribute__((ext_vector_type(4)));
typedef unsigned u32x4 __attribute__((ext_vector_type(4)));
constexpr int BM = 256, BK = 64, HALF = 128, HTB = HALF * BK * 2  , STAGE_BYTES = 8 * HTB, NXCD = 8, WGM = 8;

__host__ __device__ __forceinline__ int lds_byte(int r, int c) { const int st = (r >> 4) * 2 + (c >> 5), rr = r & 15, cc = c & 31, ob = rr * 64 + cc * 2; return st * 1024 + (ob ^ (((ob >> 9) & 1) << 5)); }
__host__ __device__ __forceinline__ void stage_rc(int b, int& R, int& C) { const int st = b / 1024, sb = b % 1024, swz = sb ^ (((sb >> 9) & 1) << 5); R = (st >> 1) * 16 + swz / 64; C = (st & 1) * 32 + (swz % 64) / 2; }
__host__ __device__ __forceinline__ int perm32(int rho) { const int n = rho >> 4, i = rho & 15; return 8 * (i >> 2) + 4 * n + (i & 3); }

struct Unit { int pm, pn; };
struct Gemm { const bf16_t* A; const bf16_t* Bt; int M, N, K; };

struct StaticOrder {
    int nM, nN, nwg, G, c;
    __host__ __device__ void init(int M, int N, int G_, int c_) { nM = M / BM; nN = N / BM; nwg = nM * nN; G = G_; c = c_; }
    __host__ __device__ bool next(int i, Unit& u) const {
        const long L = (long)i * G + c; if (L >= nwg) return false;
        int wgid = (int)L; { const int q = nwg / NXCD, r = nwg % NXCD, xcd = wgid % NXCD, off = wgid / NXCD; wgid = (xcd < r ? xcd * (q + 1) : r * (q + 1) + (xcd - r) * q) + off; }
        const int nig = WGM * nN, gid = wgid / nig, fm = gid * WGM, gsz = (nM - fm) < WGM ? (nM - fm) : WGM;
        u.pm = fm + ((wgid % nig) % gsz); u.pn = (wgid % nig) / gsz; return true;
    }
    __device__ __forceinline__ void a_ready(const Unit&) const {}
    __device__ __forceinline__ void done(const Unit&) const {}
};
__device__ __forceinline__ unsigned cvt_pk_bf16(float lo, float hi) { unsigned r; asm volatile("v_cvt_pk_bf16_f32 %0, %1, %2" : "=v"(r) : "v"(lo), "v"(hi)); return r; }
typedef float f32x2 __attribute__((ext_vector_type(2)));
__device__ __forceinline__ float bflo(unsigned u) { return __uint_as_float(u << 16); }
__device__ __forceinline__ float bfhi(unsigned u) { return __uint_as_float(u & 0xffff0000u); }
__device__ __forceinline__ float sigm(float x) { return 1.0f / (1.0f + __expf(-x)); }

struct EpiZ {
    static constexpr bool PERM = true, AFTER_DRAIN = false;
    bf16_t* O; int ldc;
    __device__ __forceinline__ void operator()(const f32x4 (&acc)[2][2][4][2], const Unit& u, int wr, int wc, int fr, int fq) const {
        const int row0 = u.pm * BM + wr * 64 + fr, col0 = u.pn * BM + wc * 32 + 8 * fq;
#pragma unroll
        for (int ai = 0; ai < 2; ++ai)
#pragma unroll
            for (int m = 0; m < 4; ++m) { bf16_t* rowp = O + (size_t)(row0 + ai * HALF + m * 16) * ldc + col0;
#pragma unroll
                for (int bj = 0; bj < 2; ++bj) { const f32x4 v0 = acc[ai][bj][m][0], v1 = acc[ai][bj][m][1];
                    u32x4 w; w.x = cvt_pk_bf16(v0[0], v0[1]); w.y = cvt_pk_bf16(v0[2], v0[3]); w.z = cvt_pk_bf16(v1[0], v1[1]); w.w = cvt_pk_bf16(v1[2], v1[3]);
                    *(u32x4*)(rowp + bj * HALF) = w; } }
    }
};
template <int MODE> struct EpiGate {
    static constexpr bool PERM = true, AFTER_DRAIN = false;
    bf16_t* O; const bf16_t* Z; int zld; int gcol;
    __device__ __forceinline__ void operator()(const f32x4 (&acc)[2][2][4][2], const Unit& u, int wr, int wc, int fr, int fq) const {
        const int row0 = u.pm * BM + wr * 64 + fr, col0 = u.pn * BM + wc * 32 + 8 * fq;
        u32x4 gn[2], pn[2];
        { const size_t row = (size_t)row0; gn[0] = *(const u32x4*)(Z + row * zld + gcol + col0); gn[1] = *(const u32x4*)(Z + row * zld + gcol + col0 + HALF);
          if (MODE == 1) { pn[0] = *(const u32x4*)(O + row * 1024 + col0); pn[1] = *(const u32x4*)(O + row * 1024 + col0 + HALF); } }
#pragma unroll
        for (int it = 0; it < 8; ++it) { const int ai = it >> 2, m = it & 3; const size_t row = (size_t)(row0 + ai * HALF + m * 16);
            u32x4 gc[2] = {gn[0], gn[1]}, pc[2];
            if (MODE == 1) { pc[0] = pn[0]; pc[1] = pn[1]; }
            if (it < 7) { const size_t rown = (size_t)(row0 + ((it + 1) >> 2) * HALF + ((it + 1) & 3) * 16);
                gn[0] = *(const u32x4*)(Z + rown * zld + gcol + col0); gn[1] = *(const u32x4*)(Z + rown * zld + gcol + col0 + HALF);
                if (MODE == 1) { pn[0] = *(const u32x4*)(O + rown * 1024 + col0); pn[1] = *(const u32x4*)(O + rown * 1024 + col0 + HALF); } }
            bf16_t* op = O + row * 1024 + col0;
#pragma unroll
            for (int bj = 0; bj < 2; ++bj) { const f32x4 v0 = acc[ai][bj][m][0], v1 = acc[ai][bj][m][1]; const u32x4 g = gc[bj];
                float r0 = v0[0] * sigm(bflo(g.x)), r1 = v0[1] * sigm(bfhi(g.x)), r2 = v0[2] * sigm(bflo(g.y)), r3 = v0[3] * sigm(bfhi(g.y));
                float r4 = v1[0] * sigm(bflo(g.z)), r5 = v1[1] * sigm(bfhi(g.z)), r6 = v1[2] * sigm(bflo(g.w)), r7 = v1[3] * sigm(bfhi(g.w));
                if (MODE == 1) { const u32x4 p = pc[bj];
                    r0 += bflo(p.x); r1 += bfhi(p.x); r2 += bflo(p.y); r3 += bfhi(p.y); r4 += bflo(p.z); r5 += bfhi(p.z); r6 += bflo(p.w); r7 += bfhi(p.w); }
                u32x4 w; w.x = cvt_pk_bf16(r0, r1); w.y = cvt_pk_bf16(r2, r3); w.z = cvt_pk_bf16(r4, r5); w.w = cvt_pk_bf16(r6, r7);
                *(u32x4*)(op + bj * HALF) = w; } }
    }
};
struct EpiRes1 {
    static constexpr bool PERM = true, AFTER_DRAIN = false;
    const float* X; bf16_t* XB; float* SS;
    __device__ __forceinline__ void operator()(const f32x4 (&acc)[2][2][4][2], const Unit& u, int wr, int wc, int fr, int fq) const {
        const int row0 = u.pm * BM + wr * 64 + fr, col0 = u.pn * BM + wc * 32 + 8 * fq;
        f32x4 xn[4];
        { const float* xp = X + (size_t)row0 * 1024 + col0; xn[0] = *(const f32x4*)(xp); xn[1] = *(const f32x4*)(xp + 4); xn[2] = *(const f32x4*)(xp + HALF); xn[3] = *(const f32x4*)(xp + HALF + 4); }
#pragma unroll
        for (int it = 0; it < 8; ++it) { const int ai = it >> 2, m = it & 3; const size_t row = (size_t)(row0 + ai * HALF + m * 16); float ssq = 0.f;
            const f32x4 xc[4] = {xn[0], xn[1], xn[2], xn[3]};
            if (it < 7) { const float* xp = X + (size_t)(row0 + ((it + 1) >> 2) * HALF + ((it + 1) & 3) * 16) * 1024 + col0;
                xn[0] = *(const f32x4*)(xp); xn[1] = *(const f32x4*)(xp + 4); xn[2] = *(const f32x4*)(xp + HALF); xn[3] = *(const f32x4*)(xp + HALF + 4); }
#pragma unroll
            for (int bj = 0; bj < 2; ++bj) { const size_t off = row * 1024 + col0 + bj * HALF;
                const f32x4 v0 = acc[ai][bj][m][0] + xc[2 * bj], v1 = acc[ai][bj][m][1] + xc[2 * bj + 1];
                ssq += (v0[0] * v0[0] + v0[1] * v0[1]) + (v0[2] * v0[2] + v0[3] * v0[3]) + (v1[0] * v1[0] + v1[1] * v1[1]) + (v1[2] * v1[2] + v1[3] * v1[3]);
                u32x4 w; w.x = cvt_pk_bf16(v0[0], v0[1]); w.y = cvt_pk_bf16(v0[2], v0[3]); w.z = cvt_pk_bf16(v1[0], v1[1]); w.w = cvt_pk_bf16(v1[2], v1[3]);
                *(u32x4*)(XB + off) = w; }
            ssq += __shfl_xor(ssq, 16); ssq += __shfl_xor(ssq, 32);
            if (fq == 0) atomicAdd(SS + row, ssq); }
    }
};
struct EpiRes2 {
    static constexpr bool PERM = true, AFTER_DRAIN = false;
    const bf16_t* XB; float* O; float* SS;
    __device__ __forceinline__ void operator()(const f32x4 (&acc)[2][2][4][2], const Unit& u, int wr, int wc, int fr, int fq) const {
        const int row0 = u.pm * BM + wr * 64 + fr, col0 = u.pn * BM + wc * 32 + 8 * fq;
        u32x4 xn[2];
        { const bf16_t* xp = XB + (size_t)row0 * 1024 + col0; xn[0] = *(const u32x4*)(xp); xn[1] = *(const u32x4*)(xp + HALF); }
#pragma unroll
        for (int it = 0; it < 8; ++it) { const int ai = it >> 2, m = it & 3; const size_t row = (size_t)(row0 + ai * HALF + m * 16); float ssq = 0.f;
            const u32x4 xc[2] = {xn[0], xn[1]};
            if (it < 7) { const bf16_t* xp = XB + (size_t)(row0 + ((it + 1) >> 2) * HALF + ((it + 1) & 3) * 16) * 1024 + col0; xn[0] = *(const u32x4*)(xp); xn[1] = *(const u32x4*)(xp + HALF); }
#pragma unroll
            for (int bj = 0; bj < 2; ++bj) { const size_t off = row * 1024 + col0 + bj * HALF;
                const u32x4 xw = xc[bj]; f32x4 v0 = acc[ai][bj][m][0], v1 = acc[ai][bj][m][1];
                v0[0] += bflo(xw.x); v0[1] += bfhi(xw.x); v0[2] += bflo(xw.y); v0[3] += bfhi(xw.y); v1[0] += bflo(xw.z); v1[1] += bfhi(xw.z); v1[2] += bflo(xw.w); v1[3] += bfhi(xw.w);
                *(f32x4*)(O + off) = v0; *(f32x4*)(O + off + 4) = v1;
                ssq += (v0[0] * v0[0] + v0[1] * v0[1]) + (v0[2] * v0[2] + v0[3] * v0[3]) + (v1[0] * v1[0] + v1[1] * v1[1]) + (v1[2] * v1[2] + v1[3] * v1[3]); }
            ssq += __shfl_xor(ssq, 16); ssq += __shfl_xor(ssq, 32);
            if (fq == 0) atomicAdd(SS + row, ssq); }
    }
};
struct EpiHid {
    static constexpr bool PERM = true, AFTER_DRAIN = false;
    bf16_t* O; const float* SS;
    __device__ __forceinline__ void operator()(const f32x4 (&acc)[2][2][4][2], const Unit& u, int wr, int wc, int fr, int fq) const {
        const int row0 = u.pm * BM + wr * 64 + fr, col0 = u.pn * BM + wc * 32 + 8 * fq;
#pragma unroll
        for (int ai = 0; ai < 2; ++ai)
#pragma unroll
            for (int m = 0; m < 4; ++m) { const size_t row = (size_t)(row0 + ai * HALF + m * 16);
                const float s2 = 1.0f / (SS[row] * (1.0f / 1024.0f) + 1e-6f);
                bf16_t* rowp = O + row * 4096 + col0;
#pragma unroll
                for (int bj = 0; bj < 2; ++bj) { f32x4 v0 = acc[ai][bj][m][0], v1 = acc[ai][bj][m][1];
#pragma unroll
                    for (int j = 0; j < 4; ++j) { float a = fmaxf(v0[j], 0.f), b = fmaxf(v1[j], 0.f); v0[j] = a * a * s2; v1[j] = b * b * s2; }
                    u32x4 w; w.x = cvt_pk_bf16(v0[0], v0[1]); w.y = cvt_pk_bf16(v0[2], v0[3]); w.z = cvt_pk_bf16(v1[0], v1[1]); w.w = cvt_pk_bf16(v1[2], v1[3]);
                    *(u32x4*)(rowp + bj * HALF) = w; } }
    }
};

template <class Epi, class Sched, bool ALIGN_EPI = false, bool SP2 = false>
__device__ __forceinline__ void gemm_phase(PG8_LAS unsigned char* lds, const Gemm g, const Sched& S, const Epi& E) {
    const int tid = threadIdx.x, wid = __builtin_amdgcn_readfirstlane(tid >> 6), lane = tid & 63, wr = wid >> 2, wc = wid & 3, fr = lane & 15, fq = lane >> 4;
    const int K = g.K, nt = K / BK;
    unsigned voffA[2], voffB[2];
#pragma unroll
    for (int i = 0; i < 2; ++i) { int R, C; stage_rc(tid * 16 + i * 8192, R, C); const int Rb = Epi::PERM ? ((R & ~31) + perm32(R & 31)) : R;
        voffA[i] = (unsigned)(R * K + C) * 2u; voffB[i] = (unsigned)(Rb * K + C) * 2u; }
    const size_t kstep = (size_t)(BK * 2);
    const size_t hstep = (size_t)HALF * K * 2;
    const size_t tstep = 2 * hstep;
    const unsigned ldsw = (unsigned)wid * 1024u;
    const int aoff = lds_byte(wr * 64 + fr, fq * 8), boff = lds_byte(wc * 32 + fr, fq * 8);
#define PG8_SA(b, h) (((b) * 2 + (h)) * HTB)
#define PG8_SB(b, h) ((4 + (b) * 2 + (h)) * HTB)
#define PG8_STAGE(bufoff, gbase, voff) do { _Pragma("unroll") for (int _i = 0; _i < 2; ++_i) \
        __builtin_amdgcn_global_load_lds((const unsigned*)((const char*)(gbase) + (voff)[_i]), (PG8_LAS unsigned*)(lds + (bufoff) + ldsw + _i * 8192), 16, 0, 0); } while (0)
#define PG8_LDA(dst, b, h) do { _Pragma("unroll") for (int m = 0; m < 4; ++m) _Pragma("unroll") for (int k = 0; k < 2; ++k) dst[m][k] = *(const PG8_LAS bf16x8*)(lds + PG8_SA(b, h) + aoff + m * 2048 + k * 1024); } while (0)
#define PG8_LDB(dst, b, h) do { _Pragma("unroll") for (int n = 0; n < 2; ++n) _Pragma("unroll") for (int k = 0; k < 2; ++k) dst[n][k] = *(const PG8_LAS bf16x8*)(lds + PG8_SB(b, h) + boff + n * 2048 + k * 1024); } while (0)
#define PG8_MMA(ai, bj, At, Bt) do { __builtin_amdgcn_s_setprio(1); _Pragma("unroll") for (int m = 0; m < 4; ++m) _Pragma("unroll") for (int n = 0; n < 2; ++n) _Pragma("unroll") for (int k = 0; k < 2; ++k) \
        acc[ai][bj][m][n] = __builtin_amdgcn_mfma_f32_16x16x32_bf16(Bt[n][k], At[m][k], acc[ai][bj][m][n], 0, 0, 0); __builtin_amdgcn_s_setprio(0); } while (0)
#define PG8_WAIT_V(n) asm volatile("s_waitcnt vmcnt(" #n ")" ::: "memory")
#define PG8_WAIT_L(n) asm volatile("s_waitcnt lgkmcnt(" #n ")" ::: "memory")
#define PG8_BAR __builtin_amdgcn_s_barrier()
#define PG8_SCHED __builtin_amdgcn_sched_barrier(0)
    Unit cur, nxt; int ui = 0;
    if (!S.next(0, cur)) return;
    f32x4 acc[2][2][4][2];
#pragma unroll
    for (int a = 0; a < 2; ++a)
#pragma unroll
        for (int b = 0; b < 2; ++b)
#pragma unroll
            for (int m = 0; m < 4; ++m)
#pragma unroll
                for (int n = 0; n < 2; ++n) acc[a][b][m][n] = (f32x4){0.f, 0.f, 0.f, 0.f};
    bf16x8 At[4][2], B0[2][2], B1[2][2];
    const char* cA = (const char*)g.A + (size_t)cur.pm * tstep; const char* cB = (const char*)g.Bt + (size_t)cur.pn * tstep;
    S.a_ready(cur);
    if constexpr (SP2) {
        PG8_STAGE(PG8_SB(0, 0), cB, voffB); PG8_STAGE(PG8_SB(0, 1), cB + hstep, voffB); PG8_STAGE(PG8_SA(0, 0), cA, voffA); PG8_STAGE(PG8_SA(0, 1), cA + hstep, voffA);
        if (wr == 1) PG8_BAR;
        PG8_WAIT_V(2); PG8_BAR;
        PG8_STAGE(PG8_SB(1, 0), cB + kstep, voffB); PG8_STAGE(PG8_SA(1, 0), cA + kstep, voffA); PG8_STAGE(PG8_SB(1, 1), cB + hstep + kstep, voffB);
        PG8_WAIT_V(6); PG8_BAR;
    } else {
        PG8_STAGE(PG8_SB(0, 0), cB, voffB); PG8_STAGE(PG8_SA(0, 0), cA, voffA); PG8_STAGE(PG8_SB(0, 1), cB + hstep, voffB); PG8_STAGE(PG8_SA(0, 1), cA + hstep, voffA);
        if (wr == 1) PG8_BAR;
        PG8_WAIT_V(4); PG8_BAR;
        PG8_STAGE(PG8_SB(1, 0), cB + kstep, voffB); PG8_STAGE(PG8_SA(1, 0), cA + kstep, voffA); PG8_STAGE(PG8_SB(1, 1), cB + hstep + kstep, voffB);
        PG8_WAIT_V(6); PG8_BAR;
    }
    for (;;) {
        const bool has_next = S.next(ui + 1, nxt);
        const char* nA = has_next ? (const char*)g.A + (size_t)nxt.pm * tstep : cA; const char* nB = has_next ? (const char*)g.Bt + (size_t)nxt.pn * tstep : cB;
        for (int t = 0; t < nt; t += 2) {
            const bool last = (t == nt - 2);
            const char* a1 = cA + (size_t)(t + 1) * kstep;
            const char* a2 = last ? nA : cA + (size_t)(t + 2) * kstep; const char* b2 = last ? nB : cB + (size_t)(t + 2) * kstep;
            const char* a3 = a2 + kstep; const char* b3 = b2 + kstep;
            if (last && has_next) S.a_ready(nxt);
            if constexpr (SP2) {
            PG8_LDB(B0, 0, 0); PG8_LDB(B1, 0, 1); PG8_SCHED; PG8_LDA(At, 0, 0); PG8_STAGE(PG8_SA(1, 1), a1 + hstep, voffA);
            PG8_WAIT_V(8); PG8_WAIT_L(0); PG8_BAR; PG8_MMA(0, 0, At, B0); PG8_MMA(0, 1, At, B1); PG8_BAR; PG8_SCHED;
            PG8_LDA(At, 0, 1); PG8_STAGE(PG8_SB(0, 0), b2, voffB); PG8_STAGE(PG8_SB(0, 1), b2 + hstep, voffB); PG8_STAGE(PG8_SA(0, 0), a2, voffA);
            PG8_WAIT_V(8); PG8_WAIT_L(0); PG8_BAR; PG8_MMA(1, 0, At, B0); PG8_MMA(1, 1, At, B1); PG8_BAR; PG8_SCHED;
            PG8_LDB(B0, 1, 0); PG8_LDB(B1, 1, 1); PG8_SCHED; PG8_LDA(At, 1, 0); PG8_STAGE(PG8_SA(0, 1), a2 + hstep, voffA);
            PG8_WAIT_V(8); PG8_WAIT_L(0); PG8_BAR; PG8_MMA(0, 0, At, B0); PG8_MMA(0, 1, At, B1); PG8_BAR; PG8_SCHED;
            PG8_LDA(At, 1, 1); PG8_STAGE(PG8_SB(1, 0), b3, voffB); PG8_STAGE(PG8_SB(1, 1), b3 + hstep, voffB); PG8_STAGE(PG8_SA(1, 0), a3, voffA);
            PG8_WAIT_V(8); PG8_WAIT_L(0); PG8_BAR; PG8_MMA(1, 0, At, B0); PG8_MMA(1, 1, At, B1); PG8_BAR; PG8_SCHED;
            } else {
            PG8_LDB(B0, 0, 0); PG8_SCHED; PG8_LDA(At, 0, 0); PG8_STAGE(PG8_SA(1, 1), a1 + hstep, voffA);
            PG8_WAIT_L(8); PG8_BAR; PG8_WAIT_L(0); PG8_MMA(0, 0, At, B0); PG8_BAR; PG8_SCHED;
            PG8_LDB(B1, 0, 1); PG8_STAGE(PG8_SB(0, 0), b2, voffB);
            PG8_BAR; PG8_WAIT_L(0); PG8_MMA(0, 1, At, B1); PG8_BAR;
            PG8_LDA(At, 0, 1); PG8_STAGE(PG8_SA(0, 0), a2, voffA);
            PG8_BAR; PG8_WAIT_L(0); PG8_MMA(1, 0, At, B0); PG8_BAR; PG8_SCHED;
            PG8_STAGE(PG8_SB(0, 1), b2 + hstep, voffB);
            PG8_WAIT_V(6); PG8_BAR; PG8_MMA(1, 1, At, B1); PG8_BAR;
            PG8_LDB(B0, 1, 0); PG8_SCHED; PG8_LDA(At, 1, 0); PG8_STAGE(PG8_SA(0, 1), a2 + hstep, voffA);
            PG8_WAIT_L(8); PG8_BAR; PG8_WAIT_L(0); PG8_MMA(0, 0, At, B0); PG8_BAR; PG8_SCHED;
            PG8_LDB(B1, 1, 1); PG8_STAGE(PG8_SB(1, 0), b3, voffB);
            PG8_BAR; PG8_WAIT_L(0); PG8_MMA(0, 1, At, B1); PG8_BAR;
            PG8_LDA(At, 1, 1); PG8_STAGE(PG8_SA(1, 0), a3, voffA);
            PG8_BAR; PG8_WAIT_L(0); PG8_MMA(1, 0, At, B0); PG8_BAR; PG8_SCHED;
            PG8_STAGE(PG8_SB(1, 1), b3 + hstep, voffB);
            PG8_WAIT_V(6); PG8_BAR; PG8_MMA(1, 1, At, B1); PG8_BAR;
            }
        }
        if constexpr (ALIGN_EPI) { if (wr == 0) PG8_BAR; }
        if constexpr (!Epi::AFTER_DRAIN) { E(acc, cur, wr, wc, fr, fq); S.done(cur); }
        if (!has_next) break;
#pragma unroll
        for (int a = 0; a < 2; ++a)
#pragma unroll
            for (int b = 0; b < 2; ++b)
#pragma unroll
                for (int m = 0; m < 4; ++m)
#pragma unroll
                    for (int n = 0; n < 2; ++n) acc[a][b][m][n] = (f32x4){0.f, 0.f, 0.f, 0.f};
        cur = nxt; cA = nA; cB = nB; ++ui;
        if constexpr (ALIGN_EPI) { if (wr == 1) PG8_BAR; }
    }
    PG8_WAIT_V(0);
    if constexpr (!ALIGN_EPI) { if (wr == 0) PG8_BAR; }
    PG8_BAR;
    if constexpr (Epi::AFTER_DRAIN) { E.fused(acc, cur, wr, wc, fr, fq, lds, wid, lane); S.done(cur); }
#undef PG8_SA
#undef PG8_SB
#undef PG8_STAGE
#undef PG8_LDA
#undef PG8_LDB
#undef PG8_MMA
#undef PG8_WAIT_V
#undef PG8_WAIT_L
#undef PG8_BAR
#undef PG8_SCHED
}
}
extern __shared__ __attribute__((aligned(16))) unsigned char g_lds[];
using pg8::bf16_t; using pg8::bf16x8; using pg8::f32x4; using pg8::u32x4; using pg8::cvt_pk_bf16; using pg8::bflo; using pg8::bfhi; using pg8::sigm;

constexpr int NTOK = 32768, DM = 1024, SEQ = 2048, NB = 16, ZLD = 5120, NTHR = 512;
constexpr int C_R = 0, C_K = 512, C_V = 1024, C_WD = 1536, C_AD = 1600, C_GD = 1664;
constexpr int C_Q = 1824, C_KA = 2336, C_VA = 2400, C_QI = 2464, C_KI = 2976, C_WI = 3040, C_G0 = 3048, C_G1 = 4072;
constexpr size_t MiB = 1024 * 1024;
constexpr size_t WS_SS1 = 0, WS_SS2 = 128 * 1024, WS_BONUS = 256 * 1024, WS_ROPE = 1280 * 1024, WS_WD = 1792 * 1024, WS_WI = 1856 * 1024, WS_WG = 1920 * 1024;
constexpr size_t WS_WIN = 4 * MiB, WS_WUP = 14 * MiB, WS_WDN = 22 * MiB, WS_WB = 30 * MiB, WS_WO = 32 * MiB, WS_VT = 34 * MiB, WS_H = 38 * MiB, WS_Z = 102 * MiB, WS_P = 422 * MiB, WS_END = 486 * MiB;
constexpr int LDS_BYTES = 163840;

struct Args { const float* in[20]; float* out; unsigned char* ws; int ph_lo, ph_hi; };

struct Frame {
    const float* in[20]; float* out; unsigned char* ws; unsigned char* lds; int tid, lane, wave;
    float *ss1, *ss2, *bonus; float2* rope; bf16_t *wd, *wi, *wg, *win, *wup, *wdn, *wb, *wo, *vt, *h, *ya, *yb, *xb, *z, *hid, *lw, *ic, *mg, *gt; float* yraw;
};

__device__ __forceinline__ bf16_t f2bf(float f) { return (bf16_t)(cvt_pk_bf16(f, 0.f) & 0xffffu); }
__device__ __forceinline__ float bf2f(bf16_t b) { return __uint_as_float(((unsigned)b) << 16); }
template <int CTRL> __device__ __forceinline__ float dpp_mov(float x) { return __int_as_float(__builtin_amdgcn_update_dpp(0, __float_as_int(x), CTRL, 0xF, 0xF, true)); }
__device__ __forceinline__ float red16(float x) { x += dpp_mov<0xB1>(x); x += dpp_mov<0x4E>(x); x += dpp_mov<0x141>(x); x += dpp_mov<0x140>(x); return x; }


__device__ __forceinline__ void lds_barrier() { asm volatile("s_waitcnt lgkmcnt(0)" ::: "memory"); __builtin_amdgcn_s_barrier(); asm volatile("" ::: "memory"); }
__device__ __forceinline__ void red16x4(float& a, float& b, float& c, float& d) {
#define DPP4(ctl) "v_add_f32_dpp %0, %0, %0 " ctl " row_mask:0xf bank_mask:0xf bound_ctrl:1\n" "v_add_f32_dpp %1, %1, %1 " ctl " row_mask:0xf bank_mask:0xf bound_ctrl:1\n" \
                  "v_add_f32_dpp %2, %2, %2 " ctl " row_mask:0xf bank_mask:0xf bound_ctrl:1\n" "v_add_f32_dpp %3, %3, %3 " ctl " row_mask:0xf bank_mask:0xf bound_ctrl:1\n"
    asm volatile("s_nop 1\n" DPP4("quad_perm:[1,0,3,2]") DPP4("quad_perm:[2,3,0,1]") DPP4("row_half_mirror") DPP4("row_mirror") : "+v"(a), "+v"(b), "+v"(c), "+v"(d));
#undef DPP4
}
__device__ __forceinline__ float red32(float x) { x += __shfl_xor(x, 1); x += __shfl_xor(x, 2); x += __shfl_xor(x, 4); x += __shfl_xor(x, 8); x += __shfl_xor(x, 16); return x; }
__device__ __forceinline__ float red64(float x) { x = red32(x); x += __shfl_xor(x, 32); return x; }
__device__ __forceinline__ float softplus_f(float x) { return fmaxf(x, 0.f) + log1pf(__expf(-fabsf(x))); }

__device__ __forceinline__ void tconv(const Frame& F, const float* __restrict__ W, int K, int N, int Npad, bf16_t* __restrict__ Wt, const float* __restrict__ rs) {
    float* tile = (float*)g_lds;
    const int ktn = (K + 63) / 64, ntn = Npad / 64, tid = F.tid;
    for (int tl = blockIdx.x; tl < ktn * ntn; tl += gridDim.x) {
        const int kt = tl % ktn, nt = tl / ktn;
#pragma unroll
        for (int i = 0; i < 2; ++i) { const int idx = tid + i * NTHR, kk = idx >> 4, n4 = (idx & 15) * 4, k = kt * 64 + kk, n = nt * 64 + n4;
            f32x4 v = {0.f, 0.f, 0.f, 0.f};
            if (k < K) { if (n + 3 < N) v = *(const f32x4*)(W + (size_t)k * N + n); else { for (int j = 0; j < 4; ++j) if (n + j < N) v[j] = W[(size_t)k * N + n + j]; }
                if (rs != nullptr) { const float r = rs[k]; v[0] *= r; v[1] *= r; v[2] *= r; v[3] *= r; } }
            tile[kk * 65 + n4] = v[0]; tile[kk * 65 + n4 + 1] = v[1]; tile[kk * 65 + n4 + 2] = v[2]; tile[kk * 65 + n4 + 3] = v[3]; }
        __syncthreads();
        { const int nn = tid >> 3, k8 = (tid & 7) * 8, k = kt * 64 + k8, n = nt * 64 + nn;
          if (k < K) { u32x4 w; const float* tp = tile + k8 * 65 + nn;
              w.x = cvt_pk_bf16(tp[0], tp[65]); w.y = cvt_pk_bf16(tp[130], tp[195]); w.z = cvt_pk_bf16(tp[260], tp[325]); w.w = cvt_pk_bf16(tp[390], tp[455]);
              *(u32x4*)(Wt + (size_t)n * K + k) = w; } }
        __syncthreads();
    }
}
__device__ __forceinline__ void p0_prologue(const Frame& F) {
    const int tid = F.tid, gtid = blockIdx.x * NTHR + tid, gn = gridDim.x * NTHR;
    for (int i = gtid; i < 2 * NTOK; i += gn) F.ss1[i] = 0.f;
    for (int i = gtid; i < SEQ * 32; i += gn) { const int pos = i >> 5, j = i & 31;
        const float inv = 1.0f / powf(10000.0f, (float)(2 * j) / 64.0f); const float ang = (float)pos * inv;
        double rev = (double)ang * 0.15915494309189535; rev -= floor(rev); const float fr = (float)rev;
        F.rope[i] = make_float2(__builtin_amdgcn_cosf(fr), __builtin_amdgcn_sinf(fr)); }
    tconv(F, F.in[2], 1024, 5096, 5120, F.win, nullptr);
    tconv(F, F.in[17], 1024, 4096, 4096, F.wup, F.in[16]);
    tconv(F, F.in[18], 4096, 1024, 1024, F.wdn, nullptr);
    tconv(F, F.in[14], 512, 1024, 1024, F.wb, nullptr);
    tconv(F, F.in[14] + 512 * 1024, 512, 1024, 1024, F.wb + 1024 * 512, nullptr);
    tconv(F, F.in[15], 1024, 1024, 1024, F.wo, nullptr);
    tconv(F, F.in[5], 64, 512, 512, F.wd, nullptr);
    tconv(F, F.in[7], 64, 512, 512, F.wi, nullptr);
    tconv(F, F.in[8], 160, 512, 512, F.wg, nullptr);
    const float* x = F.in[0]; const float* g = F.in[1]; const int lane = F.lane;
    const int rstep = gridDim.x * 8;
    f32x4 gq[4];
#pragma unroll
    for (int i = 0; i < 4; ++i) gq[i] = *(const f32x4*)(g + (i >> 1) * 512 + lane * 8 + (i & 1) * 4);
    for (int row = blockIdx.x * 8 + F.wave; row < NTOK; row += 2 * rstep) {
        const int row2 = (row + rstep) < NTOK ? row + rstep : row; const bool two = row2 != row;
        const float* xr = x + (size_t)row * DM; const float* xr2 = x + (size_t)row2 * DM; f32x4 v[4], u[4]; float ss = 0.f, ss2 = 0.f;
#pragma unroll
        for (int i = 0; i < 4; ++i) { v[i] = *(const f32x4*)(xr + (i >> 1) * 512 + lane * 8 + (i & 1) * 4); u[i] = *(const f32x4*)(xr2 + (i >> 1) * 512 + lane * 8 + (i & 1) * 4); }
#pragma unroll
        for (int i = 0; i < 4; ++i) { ss += v[i][0] * v[i][0] + v[i][1] * v[i][1] + v[i][2] * v[i][2] + v[i][3] * v[i][3]; ss2 += u[i][0] * u[i][0] + u[i][1] * u[i][1] + u[i][2] * u[i][2] + u[i][3] * u[i][3]; }
        ss = red64(ss); ss2 = red64(ss2); const float sc = rsqrtf(ss * (1.0f / 1024.0f) + 1e-6f), sc2 = rsqrtf(ss2 * (1.0f / 1024.0f) + 1e-6f);
#pragma unroll
        for (int i = 0; i < 2; ++i) { const f32x4 a = v[2 * i] * gq[2 * i] * sc, b2 = v[2 * i + 1] * gq[2 * i + 1] * sc, a2 = u[2 * i] * gq[2 * i] * sc2, b3 = u[2 * i + 1] * gq[2 * i + 1] * sc2; u32x4 w, w2;
            w.x = cvt_pk_bf16(a[0], a[1]); w.y = cvt_pk_bf16(a[2], a[3]); w.z = cvt_pk_bf16(b2[0], b2[1]); w.w = cvt_pk_bf16(b2[2], b2[3]);
            w2.x = cvt_pk_bf16(a2[0], a2[1]); w2.y = cvt_pk_bf16(a2[2], a2[3]); w2.z = cvt_pk_bf16(b3[0], b3[1]); w2.w = cvt_pk_bf16(b3[2], b3[3]);
            *(u32x4*)(F.h + (size_t)row * DM + i * 512 + lane * 8) = w; if (two) *(u32x4*)(F.h + (size_t)row2 * DM + i * 512 + lane * 8) = w2; }
    }
}

__device__ __forceinline__ void p2_prep(const Frame& F, const int mode) {
    const int tid = F.tid, lane = F.lane, wave = F.wave, fr = lane & 15, fq = lane >> 4;
    bf16_t* z = F.z; const float* mu = F.in[3];
    if (mode != 2) {
        constexpr int LDA = 296, TT = 32; bf16_t* At = (bf16_t*)g_lds;
        bf16_t* Ot = At + TT * LDA;
        const float* dbias = F.in[4]; const float* ibias = F.in[6];
        for (int tile = blockIdx.x; tile < NTOK / TT; tile += gridDim.x) {
            const int t0 = tile * TT;
            for (int idx = tid; idx < TT * 36; idx += NTHR) { const int tok = idx / 36, c8 = (idx - tok * 36) * 8, t = t0 + tok, col = C_WD + c8;
                const u32x4 zc = *(const u32x4*)(z + (size_t)t * ZLD + col); u32x4 zp = {0u, 0u, 0u, 0u}; if (t & (SEQ - 1)) zp = *(const u32x4*)(z + (size_t)(t - 1) * ZLD + col);
                const f32x4 m0 = *(const f32x4*)(mu + col), m1 = *(const f32x4*)(mu + col + 4);
                float v[8]; const unsigned zcu[4] = {zc.x, zc.y, zc.z, zc.w}, zpu[4] = {zp.x, zp.y, zp.z, zp.w};
#pragma unroll
                for (int j = 0; j < 4; ++j) { const float a = bflo(zcu[j]), b2 = bfhi(zcu[j]), pa = bflo(zpu[j]), pb = bfhi(zpu[j]);
                    const float mm0 = (j < 2) ? m0[2 * j] : m1[2 * j - 4], mm1 = (j < 2) ? m0[2 * j + 1] : m1[2 * j - 3];
                    v[2 * j] = a + (pa - a) * mm0; v[2 * j + 1] = b2 + (pb - b2) * mm1; }
                if (c8 < 64) {
#pragma unroll
                    for (int j = 0; j < 8; ++j) v[j] = tanhf(v[j]); }
                else if (c8 >= 128) {
#pragma unroll
                    for (int j = 0; j < 8; ++j) v[j] = sigm(v[j]); }
                u32x4 w; w.x = cvt_pk_bf16(v[0], v[1]); w.y = cvt_pk_bf16(v[2], v[3]); w.z = cvt_pk_bf16(v[4], v[5]); w.w = cvt_pk_bf16(v[6], v[7]);
                *(u32x4*)(At + tok * LDA + c8) = w; }
            __syncthreads();
            const int h = wave;
            bf16x8 Bc[9], Bn[9];
            { const int n = h * 64 + fr;
#pragma unroll
              for (int ks = 0; ks < 2; ++ks) { Bc[ks] = *(const bf16x8*)(F.wd + n * 64 + ks * 32 + fq * 8); Bc[2 + ks] = *(const bf16x8*)(F.wi + n * 64 + ks * 32 + fq * 8); }
#pragma unroll
              for (int ks = 0; ks < 5; ++ks) Bc[4 + ks] = *(const bf16x8*)(F.wg + n * 160 + ks * 32 + fq * 8); }
#pragma unroll 1
            for (int j = 0; j < 4; ++j) { const int n = h * 64 + j * 16 + fr;
                if (j < 3) { const int nn = n + 16;
#pragma unroll
                    for (int ks = 0; ks < 2; ++ks) { Bn[ks] = *(const bf16x8*)(F.wd + nn * 64 + ks * 32 + fq * 8); Bn[2 + ks] = *(const bf16x8*)(F.wi + nn * 64 + ks * 32 + fq * 8); }
#pragma unroll
                    for (int ks = 0; ks < 5; ++ks) Bn[4 + ks] = *(const bf16x8*)(F.wg + nn * 160 + ks * 32 + fq * 8); }
                const float db = dbias[n], ib = ibias[n];
#pragma unroll
                for (int mt = 0; mt < 2; ++mt) {
                    f32x4 ad = {0.f, 0.f, 0.f, 0.f}, ai = ad, ag = ad; const bf16_t* ap = At + (mt * 16 + fr) * LDA + fq * 8;
#pragma unroll
                    for (int ks = 0; ks < 2; ++ks) ad = __builtin_amdgcn_mfma_f32_16x16x32_bf16(*(const bf16x8*)(ap + ks * 32), Bc[ks], ad, 0, 0, 0);
#pragma unroll
                    for (int ks = 0; ks < 2; ++ks) ai = __builtin_amdgcn_mfma_f32_16x16x32_bf16(*(const bf16x8*)(ap + 64 + ks * 32), Bc[2 + ks], ai, 0, 0, 0);
#pragma unroll
                    for (int ks = 0; ks < 5; ++ks) ag = __builtin_amdgcn_mfma_f32_16x16x32_bf16(*(const bf16x8*)(ap + 128 + ks * 32), Bc[4 + ks], ag, 0, 0, 0);
#pragma unroll
                    for (int jj = 0; jj < 4; ++jj) {
                        const float dw = db + ad[jj]; const float wlog = -softplus_f(-dw) - 0.5f; const float lwv = -__expf(wlog);
                        const int tk = mt * 16 + fq * 4 + jj; Ot[tk * 520 + n] = f2bf(lwv); Ot[(TT + tk) * 520 + n] = f2bf(sigm(ib + ai[jj])); Ot[(2 * TT + tk) * 520 + n] = f2bf(ag[jj]); }
                }
#pragma unroll
                for (int q = 0; q < 9; ++q) Bc[q] = Bn[q];
            }
            __syncthreads();
#pragma unroll
            for (int i = 0; i < 12; ++i) { const int idx = tid + i * NTHR, arr = idx >> 11, rem = idx & 2047, tk = rem >> 6, c8 = (rem & 63) * 8;
                const u32x4 w = *(const u32x4*)(Ot + (arr * TT + tk) * 520 + c8); bf16_t* dst = arr == 0 ? F.lw : (arr == 1 ? F.ic : F.gt);
                *(u32x4*)(dst + (size_t)(t0 + tk) * 512 + c8) = w; }
            __syncthreads();
        }
    }
    if (mode != 2) {
        unsigned short* tl = (unsigned short*)g_lds;
        for (int tile = blockIdx.x; tile < NTOK / 64; tile += gridDim.x) { const int t0 = tile * 64, b = t0 / SEQ, tt0 = t0 % SEQ;
            { const int tok = tid >> 3, d8 = (tid & 7) * 8; *(u32x4*)(tl + tok * 72 + d8) = *(const u32x4*)(z + (size_t)(t0 + tok) * ZLD + C_VA + d8); }
            __syncthreads();
            { const int d = tid >> 3, k8 = (tid & 7) * 8; unsigned short e[8];
#pragma unroll
              for (int j = 0; j < 8; ++j) e[j] = tl[(k8 + j) * 72 + d];
              u32x4 w; w.x = e[0] | ((unsigned)e[1] << 16); w.y = e[2] | ((unsigned)e[3] << 16); w.z = e[4] | ((unsigned)e[5] << 16); w.w = e[6] | ((unsigned)e[7] << 16);
              *(u32x4*)(F.vt + ((size_t)b * 64 + d) * SEQ + tt0 + k8) = w; }
            __syncthreads();
        }
    }
    if (mode != 0) {
        const int gtid = blockIdx.x * NTHR + tid, gn = gridDim.x * NTHR;
        for (int idx = gtid; idx < NTOK * 72; idx += gn) { const int t = idx / 72, p = idx - t * 72, hd = p >> 2, i8 = (p & 3) * 8;
            const int base = hd < 8 ? C_Q + hd * 64 : (hd == 8 ? C_KA : (hd < 17 ? C_QI + (hd - 9) * 64 : C_KI));
            const float* rp = (const float*)&F.rope[(t & (SEQ - 1)) * 32 + i8];
            f32x4 cs[4];
#pragma unroll
            for (int j = 0; j < 4; ++j) { cs[j] = *(const f32x4*)(rp + 4 * j); if (mode == 2) cs[j] = (f32x4){1.f, 0.f, 1.f, 0.f}; }
            bf16_t* p1 = z + (size_t)t * ZLD + base + i8; const u32x4 a = *(const u32x4*)(p1), b2 = *(const u32x4*)(p1 + 32);
            const unsigned au[4] = {a.x, a.y, a.z, a.w}, bu[4] = {b2.x, b2.y, b2.z, b2.w}; unsigned o1[4], o2[4];
#pragma unroll
            for (int j = 0; j < 4; ++j) { const float x1a = bflo(au[j]), x1b = bfhi(au[j]), x2a = bflo(bu[j]), x2b = bfhi(bu[j]);
                o1[j] = cvt_pk_bf16(x1a * cs[j][0] - x2a * cs[j][1], x1b * cs[j][2] - x2b * cs[j][3]);
                o2[j] = cvt_pk_bf16(x2a * cs[j][0] + x1a * cs[j][1], x2b * cs[j][2] + x1b * cs[j][3]); }
            u32x4 w1, w2; w1.x = o1[0]; w1.y = o1[1]; w1.z = o1[2]; w1.w = o1[3]; w2.x = o2[0]; w2.y = o2[1]; w2.z = o2[2]; w2.w = o2[3];
            *(u32x4*)(p1) = w1; *(u32x4*)(p1 + 32) = w2; }
    }
}

struct ScanRaw { uint2 zr_c, zr_p, zk_c, zk_p, zv_c, zv_p, lwu, icu; };
struct ScanConst { f32x4 mur, muk, muv, kk, ka, rk; };
__device__ __forceinline__ void scan_load(ScanRaw& R, const bf16_t* z, const bf16_t* lw, const bf16_t* ic, size_t tokbase, int ch, int ptok, int gc) {
    const int t = ch * 16 + ptok; const size_t T = tokbase + t; const bf16_t* zp = z + T * ZLD + gc;
    R.zr_c = *(const uint2*)(zp + C_R); R.zk_c = *(const uint2*)(zp + C_K); R.zv_c = *(const uint2*)(zp + C_V);
    const uint2 zz = make_uint2(0u, 0u);
    if (t > 0) { R.zr_p = *(const uint2*)(zp - ZLD + C_R); R.zk_p = *(const uint2*)(zp - ZLD + C_K); R.zv_p = *(const uint2*)(zp - ZLD + C_V); } else { R.zr_p = zz; R.zk_p = zz; R.zv_p = zz; }
    R.lwu = *(const uint2*)(lw + T * 512 + gc); R.icu = *(const uint2*)(ic + T * 512 + gc);
}
__device__ __forceinline__ f32x4 unpack4(uint2 u) { f32x4 r; r[0] = bflo(u.x); r[1] = bfhi(u.x); r[2] = bflo(u.y); r[3] = bfhi(u.y); return r; }
__device__ __forceinline__ void scan_prep(const ScanRaw& R, const ScanConst& C, float* ops, float* vv, float* bonus_out, bool wr_bonus, int ptok, int pc, int v0) {
    const f32x4 rc = unpack4(R.zr_c), rp = unpack4(R.zr_p), kc = unpack4(R.zk_c), kp = unpack4(R.zk_p), vc = unpack4(R.zv_c), vp = unpack4(R.zv_p), ic = unpack4(R.icu), lw = unpack4(R.lwu);
    const f32x4 r = rc + (rp - rc) * C.mur, k = kc + (kp - kc) * C.muk, vs = vc + (vp - vc) * C.muv;
    f32x4 w; w[0] = __expf(lw[0]); w[1] = __expf(lw[1]); w[2] = __expf(lw[2]); w[3] = __expf(lw[3]);
    const f32x4 q = k * C.kk; const float ss = red16((q[0] * q[0] + q[1] * q[1]) + (q[2] * q[2] + q[3] * q[3]));
    const float inv = 1.0f / fmaxf(sqrtf(ss), 1e-12f); const f32x4 n = q * inv;
    const f32x4 kn = k * (1.0f + (ic - 1.0f) * C.ka);
    const f32x4 bt = r * kn * C.rk; const float bon = red16((bt[0] + bt[1]) + (bt[2] + bt[3]));
    if (wr_bonus) *bonus_out = bon;
    float* op = ops + ptok * 320 + pc;
    *(f32x4*)(op) = -n; *(f32x4*)(op + 64) = w; *(f32x4*)(op + 128) = n * ic; *(f32x4*)(op + 192) = kn; *(f32x4*)(op + 256) = r;
    if (pc >= v0 && pc < v0 + 32) *(f32x4*)(vv + ptok * 32 + pc - v0) = vs;
}
__device__ __forceinline__ void p3_scan(const Frame& F, const int mode) {
    const int tid = F.tid;
    float* opsb = (float*)g_lds;
    float* vvb = opsb + 2 * 5120;
    float* yob = vvb + 2 * 512;
    const bf16_t* z = F.z; const float* mu = F.in[3]; const float* k_k = F.in[9]; const float* k_a = F.in[10]; const float* r_k = F.in[11];
    for (int item = blockIdx.x; item < 256; item += gridDim.x) {
        const int bh = item >> 1, half = item & 1, b = bh >> 3, h = bh & 7, v0 = half * 32;
        const size_t tokbase = (size_t)b * SEQ;
        if (F.wave >= 4) {
            const int pt = tid - 256, ptok = pt >> 4, pc = (pt & 15) * 4, gc = h * 64 + pc;
            ScanConst C; C.mur = *(const f32x4*)(mu + C_R + gc); C.muk = *(const f32x4*)(mu + C_K + gc); C.muv = *(const f32x4*)(mu + C_V + gc);
            C.kk = *(const f32x4*)(k_k + gc); C.ka = *(const f32x4*)(k_a + gc); C.rk = *(const f32x4*)(r_k + gc);
            const bool wrb = (half == 0) && ((pt & 15) == 0);
            ScanRaw R;
            scan_load(R, z, F.lw, F.ic, tokbase, 0, ptok, gc);
            scan_prep(R, C, opsb, vvb, F.bonus + (tokbase + ptok) * 8 + h, wrb, ptok, pc, v0);
            scan_load(R, z, F.lw, F.ic, tokbase, 1, ptok, gc);
            lds_barrier();
            for (int ch = 0; ch < SEQ / 16; ++ch) {
                const int cur = ch & 1, nxt = cur ^ 1;
                if (mode != 2) {
                if (ch > 0) { const int tok = pt >> 4, r2 = (pt & 15) * 2;
                    *(float2*)(F.yraw + (tokbase + (ch - 1) * 16 + tok) * 512 + h * 64 + v0 + r2) = *(const float2*)(yob + nxt * 512 + tok * 32 + r2); }
                if (ch + 1 < SEQ / 16) {
                    scan_prep(R, C, opsb + nxt * 5120, vvb + nxt * 512, F.bonus + (tokbase + (ch + 1) * 16 + ptok) * 8 + h, wrb, ptok, pc, v0);
                    if (ch + 2 < SEQ / 16) scan_load(R, z, F.lw, F.ic, tokbase, ch + 2, ptok, gc);
                } }
                lds_barrier();
            }
            { const int tok = pt >> 4, r2 = (pt & 15) * 2;
              *(float2*)(F.yraw + (tokbase + (SEQ / 16 - 1) * 16 + tok) * 512 + h * 64 + v0 + r2) = *(const float2*)(yob + 512 + tok * 32 + r2); }
        } else {
            const int rp = tid >> 4, ks = tid & 15;
            float A0 = 0.f, A1 = 0.f, A2 = 0.f, A3 = 0.f, B0 = 0.f, B1 = 0.f, B2 = 0.f, B3 = 0.f;
            const int ywoff = (ks == 0) ? 2 * rp : (2 * 512 + 2 * tid), ywstep = (ks == 0) ? 32 : 0;
            lds_barrier();
            f32x4 rprev = {0.f, 0.f, 0.f, 0.f}; float* ywp = yob + 2 * 512 + 2 * tid;
            for (int ch = 0; ch < SEQ / 16; ++ch) {
                const int cur = ch & 1;
                const float* ops = opsb + cur * 5120 + ks * 4; const float* vv = vvb + cur * 512 + 2 * rp; float* yw = yob + cur * 512 + ywoff;
                if (mode != 1) {
#pragma unroll
                for (int s = 0; s < 16; ++s) {
                    const float* o = ops + s * 320;
                    const f32x4 a4 = *(const f32x4*)(o), w4 = *(const f32x4*)(o + 64), b4 = *(const f32x4*)(o + 128), k4 = *(const f32x4*)(o + 192), r4 = *(const f32x4*)(o + 256);
                    const float2 vab = *(const float2*)(vv + s * 32);
                    float sa = (A0 * a4[0] + A1 * a4[1]) + (A2 * a4[2] + A3 * a4[3]); float sb = (B0 * a4[0] + B1 * a4[1]) + (B2 * a4[2] + B3 * a4[3]);
                    float ya = (A0 * rprev[0] + A1 * rprev[1]) + (A2 * rprev[2] + A3 * rprev[3]); float yb2 = (B0 * rprev[0] + B1 * rprev[1]) + (B2 * rprev[2] + B3 * rprev[3]);
                    red16x4(sa, sb, ya, yb2);
                    *(float2*)(ywp) = make_float2(ya, yb2);
                    ywp = yw + s * ywstep;
                    A0 = A0 * w4[0] + sa * b4[0] + vab.x * k4[0]; A1 = A1 * w4[1] + sa * b4[1] + vab.x * k4[1];
                    A2 = A2 * w4[2] + sa * b4[2] + vab.x * k4[2]; A3 = A3 * w4[3] + sa * b4[3] + vab.x * k4[3];
                    B0 = B0 * w4[0] + sb * b4[0] + vab.y * k4[0]; B1 = B1 * w4[1] + sb * b4[1] + vab.y * k4[1];
                    B2 = B2 * w4[2] + sb * b4[2] + vab.y * k4[2]; B3 = B3 * w4[3] + sb * b4[3] + vab.y * k4[3];
                    rprev = r4;
                }
                {
                    float ya = (A0 * rprev[0] + A1 * rprev[1]) + (A2 * rprev[2] + A3 * rprev[3]); float yb2 = (B0 * rprev[0] + B1 * rprev[1]) + (B2 * rprev[2] + B3 * rprev[3]);
                    float d0 = 0.f, d1 = 0.f; red16x4(ya, yb2, d0, d1);
                    *(float2*)(ywp) = make_float2(ya, yb2); ywp = yob + 2 * 512 + 2 * tid; rprev = (f32x4){0.f, 0.f, 0.f, 0.f};
                } }
                lds_barrier();
            }
        }
        __syncthreads();
    }
}

__device__ __forceinline__ unsigned ordkey(float f) { const unsigned u = __float_as_uint(f); return (u & 0x80000000u) ? ~u : (u | 0x80000000u); }

__device__ __forceinline__ void attn_chunk(const unsigned char* kb, const unsigned char* vb, const unsigned* selm, int c, int p, int fr, int fq, const bf16x8 (&Bqa)[2][2], f32x4 (&O)[2][4], f32x4 (&RS)[2]) {
    const f32x4 zero4 = {0.f, 0.f, 0.f, 0.f};
    const u32x4 onesu = {0x3f803f80u, 0x3f803f80u, 0x3f803f80u, 0x3f803f80u}; const bf16x8 ones = __builtin_bit_cast(bf16x8, onesu);
    const float csc = 0.125f * 1.4426950408889634f;
    const unsigned char* k0p = kb + ((2 * p) * 16 + fr) * 144 + fq * 16; const unsigned char* k1p = k0p + 16 * 144;
    const bf16x8 KA00 = *(const bf16x8*)(k0p), KA01 = *(const bf16x8*)(k0p + 64), KA10 = *(const bf16x8*)(k1p), KA11 = *(const bf16x8*)(k1p + 64);
    const int mw = (int)selm[fr * 64 + 2 * c + p];
    bf16x8 VA[4];
#pragma unroll
    for (int dt = 0; dt < 4; ++dt) { const unsigned char* vp = vb + (dt * 16 + fr) * 144 + (2 * p) * 32 + fq * 8;
        const uint2 lo = *(const uint2*)(vp), hi = *(const uint2*)(vp + 32);
        u32x4 va; va.x = lo.x; va.y = lo.y; va.z = hi.x; va.w = hi.y; VA[dt] = __builtin_bit_cast(bf16x8, va); }
    unsigned km0[4], km1[4];
#pragma unroll
    for (int jj = 0; jj < 4; ++jj) { km0[jj] = (unsigned)__builtin_amdgcn_sbfe(mw, fq * 4 + jj, 1); km1[jj] = (unsigned)__builtin_amdgcn_sbfe(mw, 16 + fq * 4 + jj, 1); }
#pragma unroll
    for (int hh = 0; hh < 2; ++hh) {
        f32x4 s0 = __builtin_amdgcn_mfma_f32_16x16x32_bf16(KA00, Bqa[hh][0], zero4, 0, 0, 0); s0 = __builtin_amdgcn_mfma_f32_16x16x32_bf16(KA01, Bqa[hh][1], s0, 0, 0, 0);
        f32x4 s1 = __builtin_amdgcn_mfma_f32_16x16x32_bf16(KA10, Bqa[hh][0], zero4, 0, 0, 0); s1 = __builtin_amdgcn_mfma_f32_16x16x32_bf16(KA11, Bqa[hh][1], s1, 0, 0, 0);
        unsigned p0[4], p1[4];
#pragma unroll
        for (int jj = 0; jj < 4; ++jj) {
            p0[jj] = __float_as_uint(__builtin_amdgcn_exp2f(fminf(s0[jj] * csc, 86.f))) & km0[jj]; p1[jj] = __float_as_uint(__builtin_amdgcn_exp2f(fminf(s1[jj] * csc, 86.f))) & km1[jj]; }
        u32x4 pk; pk.x = cvt_pk_bf16(__uint_as_float(p0[0]), __uint_as_float(p0[1])); pk.y = cvt_pk_bf16(__uint_as_float(p0[2]), __uint_as_float(p0[3]));
        pk.z = cvt_pk_bf16(__uint_as_float(p1[0]), __uint_as_float(p1[1])); pk.w = cvt_pk_bf16(__uint_as_float(p1[2]), __uint_as_float(p1[3]));
        const bf16x8 PB = __builtin_bit_cast(bf16x8, pk);
        RS[hh] = __builtin_amdgcn_mfma_f32_16x16x32_bf16(ones, PB, RS[hh], 0, 0, 0);
#pragma unroll
        for (int dt = 0; dt < 4; ++dt) O[hh][dt] = __builtin_amdgcn_mfma_f32_16x16x32_bf16(VA[dt], PB, O[hh][dt], 0, 0, 0);
    }
}

__device__ __forceinline__ void p3_dsa(const Frame& F) {
    const int tid = F.tid, lane = F.lane, wave = F.wave, fr = lane & 15, fq = lane >> 4;
    unsigned* scl = (unsigned*)g_lds;
    unsigned* selm = (unsigned*)(g_lds + 131328);
    unsigned char* kbuf = (unsigned char*)g_lds;
    unsigned char* vbuf = kbuf + 2 * 9216;
    const bf16_t* z = F.z; const int G = gridDim.x, bx = blockIdx.x;
    const f32x4 zero4 = {0.f, 0.f, 0.f, 0.f};
    for (int rnd = 0; rnd * G < 2048; ++rnd) {
        const int n = rnd * G + ((rnd & 1) ? (G - 1 - bx) : bx);
        if (n >= 2048) continue;
        const int qg = 127 - (n >> 4), b = n & 15, q0 = qg * 16; const size_t Tb = (size_t)b * SEQ;
        for (int i = tid; i < 1024; i += NTHR) selm[i] = 0u;
        __syncthreads();
        const bf16_t* zq = z + (Tb + q0 + fr) * ZLD;
        const unsigned lofk = (unsigned)((fr * ZLD + fq * 8) * 2), lofv = (unsigned)((fr * SEQ + fq * 4) * 2);
        const int nchunk = (qg + 4) >> 2; const int lrow = tid >> 3, lseg = tid & 7;
        const bf16_t* kg = z + (Tb + lrow) * ZLD + C_KA + lseg * 8; const bf16_t* vg = F.vt + ((size_t)b * 64 + lrow) * SEQ + lseg * 8;
        const unsigned lst = (unsigned)(lrow * 144 + lseg * 16);
        const int hp = wave >> 1, kh = wave & 1;
        const u32x4 kc0 = *(const u32x4*)(kg), vc0 = *(const u32x4*)(vg);
        u32x4 kx = kc0, vx = vc0, ky = kc0, vy = vc0;
        if (1 < nchunk) { kx = *(const u32x4*)(kg + (size_t)64 * ZLD); vx = *(const u32x4*)(vg + 64); }
        if (2 < nchunk) { ky = *(const u32x4*)(kg + (size_t)128 * ZLD); vy = *(const u32x4*)(vg + 128); }
        bf16x8 Bqa[2][2];
#pragma unroll
        for (int hh = 0; hh < 2; ++hh)
#pragma unroll
            for (int ks = 0; ks < 2; ++ks) Bqa[hh][ks] = *(const bf16x8*)(zq + C_Q + (2 * hp + hh) * 64 + ks * 32 + fq * 8);
        if (qg >= 16) {
            const u32x4 wv = *(const u32x4*)(zq + C_WI);
            {
                bf16x8 Bq[8][2];
#pragma unroll
                for (int hh = 0; hh < 8; ++hh)
#pragma unroll
                    for (int ks = 0; ks < 2; ++ks) Bq[hh][ks] = *(const bf16x8*)(zq + C_QI + hh * 64 + ks * 32 + fq * 8);
                const float sc = 0.044194173824159216f;
                float wih[8]; wih[0] = bflo(wv.x) * sc; wih[1] = bfhi(wv.x) * sc; wih[2] = bflo(wv.y) * sc; wih[3] = bfhi(wv.y) * sc; wih[4] = bflo(wv.z) * sc; wih[5] = bfhi(wv.z) * sc; wih[6] = bflo(wv.w) * sc; wih[7] = bfhi(wv.w) * sc;
#pragma unroll 1
                for (int half = 0; half < 2; ++half) {
                    const int ktb = wave + 64 * half; if (ktb > qg) break;
                    bf16x8 W0[2], W1[2];
#pragma unroll
                    for (int j = 0; j < 2; ++j) { const int ktj = (ktb + 8 * j) < qg ? (ktb + 8 * j) : qg; const char* kb = (const char*)(z + (Tb + (size_t)ktj * 16) * ZLD + C_KI);
                        W0[j] = *(const bf16x8*)(kb + lofk); W1[j] = *(const bf16x8*)(kb + lofk + 64); }
#pragma unroll
                    for (int i = 0; i < 8; ++i) { const int kt = ktb + 8 * i;
                        if (kt <= qg) { f32x4 sv = zero4;
#pragma unroll
                            for (int hh = 0; hh < 8; ++hh) { f32x4 acc = __builtin_amdgcn_mfma_f32_16x16x32_bf16(W0[i & 1], Bq[hh][0], zero4, 0, 0, 0);
                                acc = __builtin_amdgcn_mfma_f32_16x16x32_bf16(W1[i & 1], Bq[hh][1], acc, 0, 0, 0);
#pragma unroll
                                for (int jj = 0; jj < 4; ++jj) sv[jj] += wih[hh] * fmaxf(acc[jj], 0.f); }
                            u32x4 w; w.x = ordkey(sv[0]); w.y = ordkey(sv[1]); w.z = ordkey(sv[2]); w.w = ordkey(sv[3]);
                            *(u32x4*)(scl + fr * 2052 + kt * 16 + fq * 4) = w;
                        }
                        if (i + 2 < 8) { const int ktn = (kt + 16) < qg ? (kt + 16) : qg; const char* kb = (const char*)(z + (Tb + (size_t)ktn * 16) * ZLD + C_KI);
                            unsigned lo2 = lofk; asm volatile("" : "+v"(lo2));
                            W0[i & 1] = *(const bf16x8*)(kb + lo2); W1[i & 1] = *(const bf16x8*)(kb + lo2 + 64); }
                    }
                }
            }
            __syncthreads();
#pragma unroll 1
            for (int qq = 0; qq < 2; ++qq) {
                const int q = 2 * wave + qq, qpos = q0 + q;
                unsigned uk[32];
#pragma unroll
                for (int r = 0; r < 32; ++r) { const int key = r * 64 + lane; uk[r] = 0x007fffffu;
                    if (r * 64 <= qpos) { const unsigned v = scl[q * 2052 + key]; uk[r] = (key <= qpos) ? v : 0x007fffffu; } }
                unsigned T = 0u; bool exact = false;
#pragma unroll 1
                for (int bit = 31; bit >= 0; --bit) {
                    const unsigned cand = T | (1u << bit); int c = 0;
#pragma unroll
                    for (int g = 0; g < 4; ++g) {
                        if (g * 512 > qpos) break;
                        unsigned long long m[8];
                        asm("v_cmp_ge_u32_e64 %0, %8, %16\n\tv_cmp_ge_u32_e64 %1, %9, %16\n\tv_cmp_ge_u32_e64 %2, %10, %16\n\tv_cmp_ge_u32_e64 %3, %11, %16\n\t"
                            "v_cmp_ge_u32_e64 %4, %12, %16\n\tv_cmp_ge_u32_e64 %5, %13, %16\n\tv_cmp_ge_u32_e64 %6, %14, %16\n\tv_cmp_ge_u32_e64 %7, %15, %16"
                            : "=&s"(m[0]), "=&s"(m[1]), "=&s"(m[2]), "=&s"(m[3]), "=&s"(m[4]), "=&s"(m[5]), "=&s"(m[6]), "=&s"(m[7])
                            : "v"(uk[g * 8 + 0]), "v"(uk[g * 8 + 1]), "v"(uk[g * 8 + 2]), "v"(uk[g * 8 + 3]), "v"(uk[g * 8 + 4]), "v"(uk[g * 8 + 5]), "v"(uk[g * 8 + 6]), "v"(uk[g * 8 + 7]), "v"(cand));
#pragma unroll
                        for (int j = 0; j < 8; ++j) c += __builtin_popcountll(m[j]);
                    }
                    if (c >= 256) { T = cand; if (c == 256) { exact = true; break; } }
                }
                int need = 0;
                if (!exact) { int c = 0;
#pragma unroll
                    for (int r = 0; r < 32; ++r) c += __builtin_popcountll(__builtin_amdgcn_ballot_w64(uk[r] > T));
                    need = 256 - c; }
#pragma unroll
                for (int r = 0; r < 32; ++r) {
                    if (r * 64 <= qpos) {
                        unsigned long long sel;
                        if (exact) sel = __builtin_amdgcn_ballot_w64(uk[r] >= T);
                        else { sel = __builtin_amdgcn_ballot_w64(uk[r] > T); unsigned long long e = __builtin_amdgcn_ballot_w64(uk[r] == T);
                            const int ne = __builtin_popcountll(e);
                            if (ne <= need) { sel |= e; need -= ne; }
                            else { for (int k = 0; k < need; ++k) { const unsigned long long lb = e & (0ull - e); sel |= lb; e ^= lb; } need = 0; } }
                        if (lane == 0) { selm[q * 64 + 2 * r] = (unsigned)sel; selm[q * 64 + 2 * r + 1] = (unsigned)(sel >> 32); }
                    }
                }
            }
        } else {
            for (int w = tid; w < 1024; w += NTHR) { const int q = w >> 6, word = w & 63, qpos = q0 + q, lo = word * 32;
                selm[w] = (qpos >= lo + 31) ? 0xffffffffu : (qpos < lo ? 0u : ((2u << (qpos - lo)) - 1u)); }
        }
        __syncthreads();
        {
            *(u32x4*)(kbuf + lst) = kc0; *(u32x4*)(vbuf + lst) = vc0;
            f32x4 O[2][4]; f32x4 rs[2];
#pragma unroll
            for (int hh = 0; hh < 2; ++hh) { rs[hh] = zero4;
#pragma unroll
                for (int dt = 0; dt < 4; ++dt) O[hh][dt] = zero4; }
            lds_barrier();
#pragma unroll 1
            for (int c = 0; c < nchunk; c += 2) {
                attn_chunk(kbuf, vbuf, selm, c, kh, fr, fq, Bqa, O, rs);
                if (c + 1 < nchunk) { *(u32x4*)(kbuf + 9216 + lst) = kx; *(u32x4*)(vbuf + 9216 + lst) = vx; }
                if (c + 3 < nchunk) { kx = *(const u32x4*)(kg + (size_t)(c + 3) * 64 * ZLD); vx = *(const u32x4*)(vg + (c + 3) * 64); }
                lds_barrier();
                if (c + 1 < nchunk) {
                    attn_chunk(kbuf + 9216, vbuf + 9216, selm, c + 1, kh, fr, fq, Bqa, O, rs);
                    if (c + 2 < nchunk) { *(u32x4*)(kbuf + lst) = ky; *(u32x4*)(vbuf + lst) = vy; }
                    if (c + 4 < nchunk) { ky = *(const u32x4*)(kg + (size_t)(c + 4) * 64 * ZLD); vy = *(const u32x4*)(vg + (c + 4) * 64); }
                    lds_barrier();
                }
            }
            float* xb = (float*)(vbuf + 2 * 9216) + (size_t)wave * (64 * 17);
            { const int oh = kh ^ 1;
#pragma unroll
              for (int dt = 0; dt < 4; ++dt)
#pragma unroll
                  for (int jj = 0; jj < 4; ++jj) xb[(dt * 4 + jj) * 64 + lane] = (oh == 0) ? O[0][dt][jj] : O[1][dt][jj];
              xb[16 * 64 + lane] = (oh == 0) ? rs[0][0] : rs[1][0]; }
            lds_barrier();
            { const float* pb = (const float*)(vbuf + 2 * 9216) + (size_t)(wave ^ 1) * (64 * 17);
              float tot = ((kh == 0) ? rs[0][0] : rs[1][0]) + pb[16 * 64 + lane];
              const float inv = 1.0f / tot;
              bf16_t* yp = F.yb + (Tb + q0 + fr) * 512 + (2 * hp + kh) * 64 + fq * 4;
#pragma unroll
              for (int dt = 0; dt < 4; ++dt) { float o[4];
#pragma unroll
                  for (int jj = 0; jj < 4; ++jj) o[jj] = (((kh == 0) ? O[0][dt][jj] : O[1][dt][jj]) + pb[(dt * 4 + jj) * 64 + lane]) * inv;
                  uint2 w; w.x = cvt_pk_bf16(o[0], o[1]); w.y = cvt_pk_bf16(o[2], o[3]); *(uint2*)(yp + dt * 16) = w; } }
        }
        __syncthreads();
    }
}

struct P4In { f32x4 y; uint2 vc, vp, gt; float bon; };
__device__ __forceinline__ void p4_load(P4In& I, const Frame& F, int g, int c) { const size_t t = (size_t)(g >> 3); const bf16_t* z = F.z;
    I.y = *(const f32x4*)(F.yraw + t * 512 + c); I.vc = *(const uint2*)(z + t * ZLD + C_V + c); I.vp = make_uint2(0u, 0u); if (t & (SEQ - 1)) I.vp = *(const uint2*)(z + (t - 1) * ZLD + C_V + c);
    I.gt = *(const uint2*)(F.gt + t * 512 + c); I.bon = F.bonus[t * 8 + (g & 7)]; }
__device__ __forceinline__ void p4_finish(const P4In& I, const Frame& F, int g, int c, const f32x4& m4, const f32x4& w4, const f32x4& b4) { const size_t t = (size_t)(g >> 3);
    const f32x4 y = I.y; const float mean = red16((y[0] + y[1]) + (y[2] + y[3])) * (1.0f / 64.0f); const f32x4 d = y - mean;
    const float var = red16((d[0] * d[0] + d[1] * d[1]) + (d[2] * d[2] + d[3] * d[3])) * (1.0f / 64.0f); const float rstd = rsqrtf(var + 64e-5f);
    f32x4 vcf, vpf, gtf; vcf[0] = bflo(I.vc.x); vcf[1] = bfhi(I.vc.x); vcf[2] = bflo(I.vc.y); vcf[3] = bfhi(I.vc.y); vpf[0] = bflo(I.vp.x); vpf[1] = bfhi(I.vp.x); vpf[2] = bflo(I.vp.y); vpf[3] = bfhi(I.vp.y);
    gtf[0] = bflo(I.gt.x); gtf[1] = bfhi(I.gt.x); gtf[2] = bflo(I.gt.y); gtf[3] = bfhi(I.gt.y);
    const f32x4 vs = vcf + (vpf - vcf) * m4; const f32x4 o = (d * rstd * w4 + b4 + vs * I.bon) * gtf;
    uint2 w; w.x = cvt_pk_bf16(o[0], o[1]); w.y = cvt_pk_bf16(o[2], o[3]); *(uint2*)(F.ya + t * 512 + c) = w; }
__device__ __forceinline__ void p4_post(const Frame& F) {
    const int tid = F.tid; const float* mu = F.in[3]; const float* gnw = F.in[12]; const float* gnb = F.in[13];
    const int gstep = gridDim.x * 32, g0 = blockIdx.x * 32 + (tid >> 4), c = (g0 & 7) * 64 + (tid & 15) * 4;
    const f32x4 m4 = *(const f32x4*)(mu + C_V + c), w4 = *(const f32x4*)(gnw + c), b4 = *(const f32x4*)(gnb + c);
    for (int g = g0; g < NTOK * 8; g += 2 * gstep) { const int g2 = g + gstep; const bool two = g2 < NTOK * 8;
        P4In A, B; p4_load(A, F, g, c); if (two) p4_load(B, F, g2, c);
        p4_finish(A, F, g, c, m4, w4, b4); if (two) p4_finish(B, F, g2, c, m4, w4, b4); }
}

__device__ __forceinline__ void p9_final(const Frame& F, const bool ident) {
    const float* g = F.in[19]; const int lane = F.lane; const int rstep = gridDim.x * 8;
    f32x4 gg[4];
#pragma unroll
    for (int i = 0; i < 4; ++i) gg[i] = *(const f32x4*)(g + i * 256 + lane * 4);
    for (int row = blockIdx.x * 8 + F.wave; row < NTOK; row += 2 * rstep) {
        const int row2 = row + rstep; const bool two = row2 < NTOK;
        float* xr = F.out + (size_t)row * DM; float* xr2 = F.out + (size_t)(two ? row2 : row) * DM;
        f32x4 v[4], u[4];
#pragma unroll
        for (int i = 0; i < 4; ++i) { v[i] = *(const f32x4*)(xr + i * 256 + lane * 4); u[i] = *(const f32x4*)(xr2 + i * 256 + lane * 4); }
        const float sc = ident ? 1.0f : rsqrtf(F.ss2[row] * (1.0f / 1024.0f) + 1e-6f), sc2 = ident ? 1.0f : rsqrtf(F.ss2[two ? row2 : row] * (1.0f / 1024.0f) + 1e-6f);
#pragma unroll
        for (int i = 0; i < 4; ++i) { if (!ident) { v[i] = v[i] * gg[i] * sc; u[i] = u[i] * gg[i] * sc2; }
            *(f32x4*)(xr + i * 256 + lane * 4) = v[i]; if (two) *(f32x4*)(xr2 + i * 256 + lane * 4) = u[i]; }
    }
}
#define XB_TMO      128
#define XB_XCNT(j)  (256  + 64 * (j))
#define XB_XSUB(j)  (1280 + 64 * (j))
#define XB_XGEN(j)  (2304 + 64 * (j))
#define XB_TOP      3328
#define XB_TOPGEN   3392
#define XCD_BAR_WORDS 3456
#define XB_SPIN_CAP (1u << 18)
#define LAS __attribute__((address_space(3)))

__device__ __forceinline__ unsigned xb_ld(unsigned* p)              { return __hip_atomic_load(p, __ATOMIC_RELAXED, __HIP_MEMORY_SCOPE_AGENT); }
__device__ __forceinline__ unsigned xb_add(unsigned* p, unsigned v) { return __hip_atomic_fetch_add(p, v, __ATOMIC_RELAXED, __HIP_MEMORY_SCOPE_AGENT); }
__device__ __forceinline__ unsigned xb_xcc_id() { return (unsigned)__builtin_amdgcn_s_getreg((3 << 11) | 20) & 0xFu; }
#define XB_SPIN(cond, bar) do { unsigned _sp = 0; while (cond) { __builtin_amdgcn_s_sleep(1); \
    if ((++_sp & 255u) == 0u) { if (xb_ld(&(bar)[XB_TMO])) break; if (_sp > XB_SPIN_CAP) { atomicAdd(&(bar)[XB_TMO], 1u); break; } } } } while (0)

struct XcdBarrier {
    unsigned* bar; unsigned x;
    volatile LAS unsigned* st;
};

__device__ __forceinline__ XcdBarrier xcd_barrier_post(unsigned* bar, volatile LAS unsigned* st) {
    XcdBarrier b; b.bar = bar; b.x = xb_xcc_id(); b.st = st;
    if (threadIdx.x == 0) (void)xb_add(&bar[XB_XCNT(b.x)], 1u);
    return b;
}
__device__ __forceinline__ void xcd_barrier_complete(unsigned* bar, unsigned x, unsigned& nloc, unsigned& nx) {
    const unsigned G = gridDim.x * gridDim.y * gridDim.z;
    unsigned sum, cnt, mine, sp = 0u;
    for (;;) {
        sum = 0u; cnt = 0u; mine = 0u;
#pragma unroll
        for (unsigned j = 0; j < 16; ++j) { const unsigned c = xb_ld(&bar[XB_XCNT(j)]); sum += c; cnt += (c > 0u) ? 1u : 0u; mine = (j == x) ? c : mine; }
        if (sum == G) break;
        __builtin_amdgcn_s_sleep(1);
        if ((++sp & 255u) == 0u) { if (xb_ld(&bar[XB_TMO])) break; if (sp > XB_SPIN_CAP) { atomicAdd(&bar[XB_TMO], 1u); break; } }
    }
    nloc = mine > 0u ? mine : 1u; nx = cnt > 0u ? cnt : 1u;
}

__device__ __forceinline__ void xcd_barrier(const XcdBarrier& b) {
    asm volatile("s_waitcnt vmcnt(0)" ::: "memory");
    __syncthreads();
    if (threadIdx.x == 0) {
        unsigned* bar = b.bar;
        __builtin_amdgcn_s_waitcnt(0);
        unsigned nloc = b.st[0], nx = b.st[1];
        if (nloc == 0u) { xcd_barrier_complete(bar, b.x, nloc, nx); b.st[0] = nloc; b.st[1] = nx; }
        const unsigned old = xb_add(&bar[XB_XSUB(b.x)], 1u);
        const unsigned gen = old / nloc;
        if (old + 1u == (gen + 1u) * nloc) {
            __builtin_amdgcn_fence(__ATOMIC_RELEASE, "agent");
            asm volatile("s_waitcnt vmcnt(0)" ::: "memory");
            const unsigned og = xb_add(&bar[XB_TOP], 1u);
            const unsigned tg = og / nx;
            if (og + 1u == (tg + 1u) * nx) xb_add(&bar[XB_TOPGEN], 1u);
            else XB_SPIN(xb_ld(&bar[XB_TOPGEN]) == tg, bar);
            __builtin_amdgcn_fence(__ATOMIC_ACQUIRE, "agent");
            xb_add(&bar[XB_XGEN(b.x)], 1u);
            asm volatile("s_waitcnt vmcnt(0)" ::: "memory");
        } else {
            XB_SPIN(xb_ld(&bar[XB_XGEN(b.x)]) == gen, bar);
            __builtin_amdgcn_fence(__ATOMIC_ACQUIRE, "agent");
            asm volatile("s_waitcnt vmcnt(0)" ::: "memory");
        }
    }
    __syncthreads();
}
#ifndef PHASE_MASK
#define PHASE_MASK 0x3ff
#endif
#ifndef GEMM_ALIGN
#define GEMM_ALIGN true
#endif
#ifndef GEMM_SP2
#define GEMM_SP2 true
#endif
constexpr int NPHASE = 10;
constexpr size_t WS_BAR = 3 * MiB;
template <class Epi> __device__ __forceinline__ void run_gemm(const bf16_t* A, const bf16_t* Bt, int N, int K, const Epi& E) {
    pg8::Gemm g{A, Bt, NTOK, N, K}; pg8::StaticOrder S; S.init(NTOK, N, (int)gridDim.x, (int)blockIdx.x);
    pg8::gemm_phase<Epi, pg8::StaticOrder, GEMM_ALIGN, GEMM_SP2>((PG8_LAS unsigned char*)g_lds, g, S, E);
}
__global__ void __launch_bounds__(NTHR, 2) mega_fwd(Args args) {
    Frame F;
#pragma unroll
    for (int i = 0; i < 20; ++i) F.in[i] = args.in[i];
    F.out = args.out; F.ws = args.ws; F.lds = nullptr; F.tid = threadIdx.x; F.lane = F.tid & 63; F.wave = __builtin_amdgcn_readfirstlane(F.tid >> 6);
    unsigned char* ws = args.ws;
    F.ss1 = (float*)(ws + WS_SS1); F.ss2 = (float*)(ws + WS_SS2); F.bonus = (float*)(ws + WS_BONUS); F.rope = (float2*)(ws + WS_ROPE);
    F.wd = (bf16_t*)(ws + WS_WD); F.wi = (bf16_t*)(ws + WS_WI); F.wg = (bf16_t*)(ws + WS_WG);
    F.win = (bf16_t*)(ws + WS_WIN); F.wup = (bf16_t*)(ws + WS_WUP); F.wdn = (bf16_t*)(ws + WS_WDN); F.wb = (bf16_t*)(ws + WS_WB); F.wo = (bf16_t*)(ws + WS_WO); F.vt = (bf16_t*)(ws + WS_VT);
    F.h = (bf16_t*)(ws + WS_H); F.ya = F.h; F.yb = F.h + (size_t)NTOK * 512; F.xb = F.h;
    F.z = (bf16_t*)(ws + WS_Z); F.hid = F.z;
    F.lw = (bf16_t*)(ws + WS_P); F.ic = F.lw + (size_t)NTOK * 512; F.mg = F.lw;
    F.yraw = args.out; F.gt = (bf16_t*)(args.out + (size_t)NTOK * 512);
    const int lo = args.ph_lo, hi = args.ph_hi;
    cg::grid_group grid = cg::this_grid();
    if (args.ph_lo < 0) grid.sync();
    volatile LAS unsigned* xst = (volatile LAS unsigned*)(g_lds + LDS_BYTES - 64);
    if (threadIdx.x == 0) { xst[0] = 0u; xst[1] = 0u; }
    __syncthreads();
    XcdBarrier xbar = xcd_barrier_post((unsigned*)(ws + WS_BAR), xst);
#define IN(k) (lo <= (k) && (k) < hi)
#define SEAM(k) do { if (IN(k) && IN((k) + 1)) { xcd_barrier(xbar); if (REP(17)) xcd_barrier(xbar); } } while (0)
    if (((PHASE_MASK >> 0) & 1) && IN(0)) { p0_prologue(F); __syncthreads(); if (REP(0)) { p0_prologue(F); __syncthreads(); } } SEAM(0);
    if (((PHASE_MASK >> 1) & 1) && IN(1)) { pg8::EpiZ E{F.z, ZLD}; run_gemm(F.h, F.win, 5120, 1024, E); __syncthreads(); if (REP(1)) { run_gemm(F.h, F.win, 5120, 1024, E); __syncthreads(); } if (REP(18)) { run_gemm(F.h, F.win, 4096, 1024, E); __syncthreads(); } } SEAM(1);
    if (((PHASE_MASK >> 2) & 1) && IN(2)) { if (REP(2)) { p2_prep(F, 0); __syncthreads(); } if (REP(16)) { p2_prep(F, 2); __syncthreads(); } p2_prep(F, 1); __syncthreads(); } SEAM(2);
    if (((PHASE_MASK >> 3) & 1) && IN(3)) { if (REP(14)) { p3_scan(F, 1); __syncthreads(); } if (REP(15)) { p3_scan(F, 2); __syncthreads(); } if (REP(3)) { p3_scan(F, 0); __syncthreads(); } p3_scan(F, 0); __syncthreads(); p3_dsa(F); __syncthreads(); if (REP(10)) { p3_dsa(F); __syncthreads(); } } SEAM(3);
    if (((PHASE_MASK >> 4) & 1) && IN(4)) { p4_post(F); __syncthreads(); if (REP(4)) { p4_post(F); __syncthreads(); } } SEAM(4);
    if (((PHASE_MASK >> 5) & 1) && IN(5)) { pg8::EpiGate<0> E0{F.mg, F.z, ZLD, C_G0}; run_gemm(F.ya, F.wb, 1024, 512, E0); __syncthreads();
                 pg8::EpiGate<1> E1{F.mg, F.z, ZLD, C_G1}; run_gemm(F.yb, F.wb + 1024 * 512, 1024, 512, E1); __syncthreads();
                 if (REP(5)) { run_gemm(F.ya, F.wb, 1024, 512, E0); __syncthreads(); run_gemm(F.yb, F.wb + 1024 * 512, 1024, 512, E1); __syncthreads(); } } SEAM(5);
    if (((PHASE_MASK >> 6) & 1) && IN(6)) { if (REP(6)) { pg8::EpiRes1 Ex{F.in[0], F.xb, F.bonus}; run_gemm(F.mg, F.wo, 1024, 1024, Ex); __syncthreads(); }
                 pg8::EpiRes1 E{F.in[0], F.xb, F.ss1}; run_gemm(F.mg, F.wo, 1024, 1024, E); __syncthreads(); } SEAM(6);
    if (((PHASE_MASK >> 7) & 1) && IN(7)) { pg8::EpiHid E{F.hid, F.ss1}; run_gemm(F.xb, F.wup, 4096, 1024, E); __syncthreads(); if (REP(7)) { run_gemm(F.xb, F.wup, 4096, 1024, E); __syncthreads(); } } SEAM(7);
    if (((PHASE_MASK >> 8) & 1) && IN(8)) { pg8::EpiRes2 E{F.xb, F.out, F.ss2}; run_gemm(F.hid, F.wdn, 1024, 4096, E); __syncthreads(); } SEAM(8);
    if (((PHASE_MASK >> 9) & 1) && IN(9)) { if (REP(9)) { p9_final(F, true); __syncthreads(); } p9_final(F, false); }
#undef IN
#undef SEAM
}

extern "C" void kernel_launch(void* const* d_in, const int* in_sizes, int n_in, void* d_out, int out_size, void* d_ws, size_t ws_size, hipStream_t stream) {
    static int grid = 0;
    if (grid == 0) {
        if (n_in != 20 || out_size != NTOK * DM || ws_size < WS_END) { fprintf(stderr, "kernel_launch: unexpected shapes (n_in %d, out %d, ws %zu < %zu)\n", n_in, out_size, ws_size, (size_t)WS_END); grid = -1; return; }
        int dev = 0, cus = 0, per_cu = 0;
        hipGetDevice(&dev); hipDeviceGetAttribute(&cus, hipDeviceAttributeMultiprocessorCount, dev);
        if (hipFuncSetAttribute((const void*)mega_fwd, hipFuncAttributeMaxDynamicSharedMemorySize, LDS_BYTES) != hipSuccess) { fprintf(stderr, "kernel_launch: hipFuncSetAttribute failed\n"); grid = -1; return; }
        if (hipOccupancyMaxActiveBlocksPerMultiprocessor(&per_cu, (const void*)mega_fwd, NTHR, LDS_BYTES) != hipSuccess || per_cu < 1) { fprintf(stderr, "kernel_launch: occupancy query failed (%d)\n", per_cu); per_cu = 1; }
        (void)hipGetLastError();
        grid = cus * per_cu;
        fprintf(stderr, "kernel_launch: grid %d (%d CUs x %d)\n", grid, cus, per_cu);
    }
    if (grid < 0) return;
    if (hipMemsetAsync((char*)d_ws + WS_BAR, 0, XCD_BAR_WORDS * 4, stream) != hipSuccess) { fprintf(stderr, "kernel_launch: memset of the barrier words failed\n"); return; }
    Args a{};
    for (int i = 0; i < 20; ++i) a.in[i] = (const float*)d_in[i];
    a.out = (float*)d_out; a.ws = (unsigned char*)d_ws;
#if MK_PER_PHASE_LAUNCH
    for (int p = 0; p < NPHASE; ++p) { a.ph_lo = p; a.ph_hi = p + 1; hipLaunchKernelGGL(mega_fwd, dim3(grid), dim3(NTHR), LDS_BYTES, stream, a); }
#else
    a.ph_lo = 0; a.ph_hi = NPHASE;
    void* kargs[] = {&a};
    hipError_t e = hipLaunchCooperativeKernel((const void*)mega_fwd, dim3(grid), dim3(NTHR), kargs, LDS_BYTES, stream);
    if (e != hipSuccess) fprintf(stderr, "kernel_launch: cooperative launch failed: %s (grid %d)\n", hipGetErrorString(e), grid);
#endif
}
```

```cpp
#include <hip/hip_runtime.h>
#include <hip/hip_cooperative_groups.h>
#include <cstdio>
#include <cstdint>
namespace cg = cooperative_groups;

#ifndef MK_PER_PHASE_LAUNCH
#define MK_PER_PHASE_LAUNCH 0
#endif

#ifndef REPEAT_MASK
#define REPEAT_MASK 0
#endif
#define REP(k) ((REPEAT_MASK >> (k)) & 1)
#ifndef TS_SEL
#define TS_SEL -1
#endif

namespace pg8 {
#define PG8_LAS __attribute__((address_space(3)))
typedef unsigned short bf16_t;
typedef short bf16x8 __attribute__((ext_vector_type(8)));
typedef float f32x4 __attribute__((ext_vector_type(4)));
typedef unsigned u32x4 __attribute__((ext_vector_type(4)));
constexpr int BM = 256, BK = 64, HALF = 128, HTB = HALF * BK * 2  , STAGE_BYTES = 8 * HTB, NXCD = 8, WGM = 8;

__host__ __device__ __forceinline__ int lds_byte(int r, int c) { const int st = (r >> 4) * 2 + (c >> 5), rr = r & 15, cc = c & 31, ob = rr * 64 + cc * 2; return st * 1024 + (ob ^ (((ob >> 9) & 1) << 5)); }
__host__ __device__ __forceinline__ void stage_rc(int b, int& R, int& C) { const int st = b / 1024, sb = b % 1024, swz = sb ^ (((sb >> 9) & 1) << 5); R = (st >> 1) * 16 + swz / 64; C = (st & 1) * 32 + (swz % 64) / 2; }
__host__ __device__ __forceinline__ int perm32(int rho) { const int n = rho >> 4, i = rho & 15; return 8 * (i >> 2) + 4 * n + (i & 3); }

struct Unit { int pm, pn; };
struct Gemm { const bf16_t* A; const bf16_t* Bt; int M, N, K; };

struct StaticOrder {
    int nM, nN, nwg, G, c;
    __host__ __device__ void init(int M, int N, int G_, int c_) { nM = M / BM; nN = N / BM; nwg = nM * nN; G = G_; c = c_; }
    __host__ __device__ bool next(int i, Unit& u) const {
        const long L = (long)i * G + c; if (L >= nwg) return false;
        int wgid = (int)L; { const int q = nwg / NXCD, r = nwg % NXCD, xcd = wgid % NXCD, off = wgid / NXCD; wgid = (xcd < r ? xcd * (q + 1) : r * (q + 1) + (xcd - r) * q) + off; }
        const int nig = WGM * nN, gid = wgid / nig, fm = gid * WGM, gsz = (nM - fm) < WGM ? (nM - fm) : WGM;
        u.pm = fm + ((wgid % nig) % gsz); u.pn = (wgid % nig) / gsz; return true;
    }
    __device__ __forceinline__ void a_ready(const Unit&) const {}
    __device__ __forceinline__ void done(const Unit&) const {}
};
__device__ __forceinline__ unsigned cvt_pk_bf16(float lo, float hi) { unsigned r; asm volatile("v_cvt_pk_bf16_f32 %0, %1, %2" : "=v"(r) : "v"(lo), "v"(hi)); return r; }
typedef float f32x2 __attribute__((ext_vector_type(2)));
__device__ __forceinline__ float bflo(unsigned u) { return __uint_as_float(u << 16); }
__device__ __forceinline__ float bfhi(unsigned u) { return __uint_as_float(u & 0xffff0000u); }
__device__ __forceinline__ float sigm(float x) { return 1.0f / (1.0f + __expf(-x)); }

struct EpiZ {
    static constexpr bool PERM = true, AFTER_DRAIN = false;
    bf16_t* O; int ldc;
    __device__ __forceinline__ void operator()(const f32x4 (&acc)[2][2][4][2], const Unit& u, int wr, int wc, int fr, int fq) const {
        const int row0 = u.pm * BM + wr * 64 + fr, col0 = u.pn * BM + wc * 32 + 8 * fq;
#pragma unroll
        for (int ai = 0; ai < 2; ++ai)
#pragma unroll
            for (int m = 0; m < 4; ++m) { bf16_t* rowp = O + (size_t)(row0 + ai * HALF + m * 16) * ldc + col0;
#pragma unroll
                for (int bj = 0; bj < 2; ++bj) { const f32x4 v0 = acc[ai][bj][m][0], v1 = acc[ai][bj][m][1];
                    u32x4 w; w.x = cvt_pk_bf16(v0[0], v0[1]); w.y = cvt_pk_bf16(v0[2], v0[3]); w.z = cvt_pk_bf16(v1[0], v1[1]); w.w = cvt_pk_bf16(v1[2], v1[3]);
                    *(u32x4*)(rowp + bj * HALF) = w; } }
    }
};
template <int MODE> struct EpiGate {
    static constexpr bool PERM = true, AFTER_DRAIN = false;
    bf16_t* O; const bf16_t* Z; int zld; int gcol;
    __device__ __forceinline__ void operator()(const f32x4 (&acc)[2][2][4][2], const Unit& u, int wr, int wc, int fr, int fq) const {
        const int row0 = u.pm * BM + wr * 64 + fr, col0 = u.pn * BM + wc * 32 + 8 * fq;
        u32x4 gn[2], pn[2];
        { const size_t row = (size_t)row0; gn[0] = *(const u32x4*)(Z + row * zld + gcol + col0); gn[1] = *(const u32x4*)(Z + row * zld + gcol + col0 + HALF);
          if (MODE == 1) { pn[0] = *(const u32x4*)(O + row * 1024 + col0); pn[1] = *(const u32x4*)(O + row * 1024 + col0 + HALF); } }
#pragma unroll
        for (int it = 0; it < 8; ++it) { const int ai = it >> 2, m = it & 3; const size_t row = (size_t)(row0 + ai * HALF + m * 16);
            u32x4 gc[2] = {gn[0], gn[1]}, pc[2];
            if (MODE == 1) { pc[0] = pn[0]; pc[1] = pn[1]; }
            if (it < 7) { const size_t rown = (size_t)(row0 + ((it + 1) >> 2) * HALF + ((it + 1) & 3) * 16);
                gn[0] = *(const u32x4*)(Z + rown * zld + gcol + col0); gn[1] = *(const u32x4*)(Z + rown * zld + gcol + col0 + HALF);
                if (MODE == 1) { pn[0] = *(const u32x4*)(O + rown * 1024 + col0); pn[1] = *(const u32x4*)(O + rown * 1024 + col0 + HALF); } }
            bf16_t* op = O + row * 1024 + col0;
#pragma unroll
            for (int bj = 0; bj < 2; ++bj) { const f32x4 v0 = acc[ai][bj][m][0], v1 = acc[ai][bj][m][1]; const u32x4 g = gc[bj];
                float r0 = v0[0] * sigm(bflo(g.x)), r1 = v0[1] * sigm(bfhi(g.x)), r2 = v0[2] * sigm(bflo(g.y)), r3 = v0[3] * sigm(bfhi(g.y));
                float r4 = v1[0] * sigm(bflo(g.z)), r5 = v1[1] * sigm(bfhi(g.z)), r6 = v1[2] * sigm(bflo(g.w)), r7 = v1[3] * sigm(bfhi(g.w));
                if (MODE == 1) { const u32x4 p = pc[bj];
                    r0 += bflo(p.x); r1 += bfhi(p.x); r2 += bflo(p.y); r3 += bfhi(p.y); r4 += bflo(p.z); r5 += bfhi(p.z); r6 += bflo(p.w); r7 += bfhi(p.w); }
                u32x4 w; w.x = cvt_pk_bf16(r0, r1); w.y = cvt_pk_bf16(r2, r3); w.z = cvt_pk_bf16(r4, r5); w.w = cvt_pk_bf16(r6, r7);
                *(u32x4*)(op + bj * HALF) = w; } }
    }
};
struct EpiRes1 {
    static constexpr bool PERM = true, AFTER_DRAIN = false;
    const float* X; bf16_t* XB; float* SS;
    __device__ __forceinline__ void operator()(const f32x4 (&acc)[2][2][4][2], const Unit& u, int wr, int wc, int fr, int fq) const {
        const int row0 = u.pm * BM + wr * 64 + fr, col0 = u.pn * BM + wc * 32 + 8 * fq;
        f32x4 xn[4];
        { const float* xp = X + (size_t)row0 * 1024 + col0; xn[0] = *(const f32x4*)(xp); xn[1] = *(const f32x4*)(xp + 4); xn[2] = *(const f32x4*)(xp + HALF); xn[3] = *(const f32x4*)(xp + HALF + 4); }
#pragma unroll
        for (int it = 0; it < 8; ++it) { const int ai = it >> 2, m = it & 3; const size_t row = (size_t)(row0 + ai * HALF + m * 16); float ssq = 0.f;
            const f32x4 xc[4] = {xn[0], xn[1], xn[2], xn[3]};
            if (it < 7) { const float* xp = X + (size_t)(row0 + ((it + 1) >> 2) * HALF + ((it + 1) & 3) * 16) * 1024 + col0;
                xn[0] = *(const f32x4*)(xp); xn[1] = *(const f32x4*)(xp + 4); xn[2] = *(const f32x4*)(xp + HALF); xn[3] = *(const f32x4*)(xp + HALF + 4); }
#pragma unroll
            for (int bj = 0; bj < 2; ++bj) { const size_t off = row * 1024 + col0 + bj * HALF;
                const f32x4 v0 = acc[ai][bj][m][0] + xc[2 * bj], v1 = acc[ai][bj][m][1] + xc[2 * bj + 1];
                ssq += (v0[0] * v0[0] + v0[1] * v0[1]) + (v0[2] * v0[2] + v0[3] * v0[3]) + (v1[0] * v1[0] + v1[1] * v1[1]) + (v1[2] * v1[2] + v1[3] * v1[3]);
                u32x4 w; w.x = cvt_pk_bf16(v0[0], v0[1]); w.y = cvt_pk_bf16(v0[2], v0[3]); w.z = cvt_pk_bf16(v1[0], v1[1]); w.w = cvt_pk_bf16(v1[2], v1[3]);
                *(u32x4*)(XB + off) = w; }
            ssq += __shfl_xor(ssq, 16); ssq += __shfl_xor(ssq, 32);
            if (fq == 0) atomicAdd(SS + row, ssq); }
    }
};
struct EpiRes2 {
    static constexpr bool PERM = true, AFTER_DRAIN = false;
    const bf16_t* XB; float* O; float* SS;
    __device__ __forceinline__ void operator()(const f32x4 (&acc)[2][2][4][2], const Unit& u, int wr, int wc, int fr, int fq) const {
        const int row0 = u.pm * BM + wr * 64 + fr, col0 = u.pn * BM + wc * 32 + 8 * fq;
        u32x4 xn[2];
        { const bf16_t* xp = XB + (size_t)row0 * 1024 + col0; xn[0] = *(const u32x4*)(xp); xn[1] = *(const u32x4*)(xp + HALF); }
#pragma unroll
        for (int it = 0; it < 8; ++it) { const int ai = it >> 2, m = it & 3; const size_t row = (size_t)(row0 + ai * HALF + m * 16); float ssq = 0.f;
            const u32x4 xc[2] = {xn[0], xn[1]};
            if (it < 7) { const bf16_t* xp = XB + (size_t)(row0 + ((it + 1) >> 2) * HALF + ((it + 1) & 3) * 16) * 1024 + col0; xn[0] = *(const u32x4*)(xp); xn[1] = *(const u32x4*)(xp + HALF); }
#pragma unroll
            for (int bj = 0; bj < 2; ++bj) { const size_t off = row * 1024 + col0 + bj * HALF;
                const u32x4 xw = xc[bj]; f32x4 v0 = acc[ai][bj][m][0], v1 = acc[ai][bj][m][1];
                v0[0] += bflo(xw.x); v0[1] += bfhi(xw.x); v0[2] += bflo(xw.y); v0[3] += bfhi(xw.y); v1[0] += bflo(xw.z); v1[1] += bfhi(xw.z); v1[2] += bflo(xw.w); v1[3] += bfhi(xw.w);
                *(f32x4*)(O + off) = v0; *(f32x4*)(O + off + 4) = v1;
                ssq += (v0[0] * v0[0] + v0[1] * v0[1]) + (v0[2] * v0[2] + v0[3] * v0[3]) + (v1[0] * v1[0] + v1[1] * v1[1]) + (v1[2] * v1[2] + v1[3] * v1[3]); }
            ssq += __shfl_xor(ssq, 16); ssq += __shfl_xor(ssq, 32);
            if (fq == 0) atomicAdd(SS + row, ssq); }
    }
};
struct EpiHid {
    static constexpr bool PERM = true, AFTER_DRAIN = false;
    bf16_t* O; const float* SS;
    __device__ __forceinline__ void operator()(const f32x4 (&acc)[2][2][4][2], const Unit& u, int wr, int wc, int fr, int fq) const {
        const int row0 = u.pm * BM + wr * 64 + fr, col0 = u.pn * BM + wc * 32 + 8 * fq;
#pragma unroll
        for (int ai = 0; ai < 2; ++ai)
#pragma unroll
            for (int m = 0; m < 4; ++m) { const size_t row = (size_t)(row0 + ai * HALF + m * 16);
                const float s2 = 1.0f / (SS[row] * (1.0f / 1024.0f) + 1e-6f);
                bf16_t* rowp = O + row * 4096 + col0;
#pragma unroll
                for (int bj = 0; bj < 2; ++bj) { f32x4 v0 = acc[ai][bj][m][0], v1 = acc[ai][bj][m][1];
#pragma unroll
                    for (int j = 0; j < 4; ++j) { float a = fmaxf(v0[j], 0.f), b = fmaxf(v1[j], 0.f); v0[j] = a * a * s2; v1[j] = b * b * s2; }
                    u32x4 w; w.x = cvt_pk_bf16(v0[0], v0[1]); w.y = cvt_pk_bf16(v0[2], v0[3]); w.z = cvt_pk_bf16(v1[0], v1[1]); w.w = cvt_pk_bf16(v1[2], v1[3]);
                    *(u32x4*)(rowp + bj * HALF) = w; } }
    }
};

template <class Epi, class Sched, bool ALIGN_EPI = false, bool SP2 = false>
__device__ __forceinline__ void gemm_phase(PG8_LAS unsigned char* lds, const Gemm g, const Sched& S, const Epi& E) {
    const int tid = threadIdx.x, wid = __builtin_amdgcn_readfirstlane(tid >> 6), lane = tid & 63, wr = wid >> 2, wc = wid & 3, fr = lane & 15, fq = lane >> 4;
    const int K = g.K, nt = K / BK;
    unsigned voffA[2], voffB[2];
#pragma unroll
    for (int i = 0; i < 2; ++i) { int R, C; stage_rc(tid * 16 + i * 8192, R, C); const int Rb = Epi::PERM ? ((R & ~31) + perm32(R & 31)) : R;
        voffA[i] = (unsigned)(R * K + C) * 2u; voffB[i] = (unsigned)(Rb * K + C) * 2u; }
    const size_t kstep = (size_t)(BK * 2);
    const size_t hstep = (size_t)HALF * K * 2;
    const size_t tstep = 2 * hstep;
    const unsigned ldsw = (unsigned)wid * 1024u;
    const int aoff = lds_byte(wr * 64 + fr, fq * 8), boff = lds_byte(wc * 32 + fr, fq * 8);
#define PG8_SA(b, h) (((b) * 2 + (h)) * HTB)
#define PG8_SB(b, h) ((4 + (b) * 2 + (h)) * HTB)
#define PG8_STAGE(bufoff, gbase, voff) do { _Pragma("unroll") for (int _i = 0; _i < 2; ++_i) \
        __builtin_amdgcn_global_load_lds((const unsigned*)((const char*)(gbase) + (voff)[_i]), (PG8_LAS unsigned*)(lds + (bufoff) + ldsw + _i * 8192), 16, 0, 0); } while (0)
#define PG8_LDA(dst, b, h) do { _Pragma("unroll") for (int m = 0; m < 4; ++m) _Pragma("unroll") for (int k = 0; k < 2; ++k) dst[m][k] = *(const PG8_LAS bf16x8*)(lds + PG8_SA(b, h) + aoff + m * 2048 + k * 1024); } while (0)
#define PG8_LDB(dst, b, h) do { _Pragma("unroll") for (int n = 0; n < 2; ++n) _Pragma("unroll") for (int k = 0; k < 2; ++k) dst[n][k] = *(const PG8_LAS bf16x8*)(lds + PG8_SB(b, h) + boff + n * 2048 + k * 1024); } while (0)
#define PG8_MMA(ai, bj, At, Bt) do { __builtin_amdgcn_s_setprio(1); _Pragma("unroll") for (int m = 0; m < 4; ++m) _Pragma("unroll") for (int n = 0; n < 2; ++n) _Pragma("unroll") for (int k = 0; k < 2; ++k) \
        acc[ai][bj][m][n] = __builtin_amdgcn_mfma_f32_16x16x32_bf16(Bt[n][k], At[m][k], acc[ai][bj][m][n], 0, 0, 0); __builtin_amdgcn_s_setprio(0); } while (0)
#define PG8_WAIT_V(n) asm volatile("s_waitcnt vmcnt(" #n ")" ::: "memory")
#define PG8_WAIT_L(n) asm volatile("s_waitcnt lgkmcnt(" #n ")" ::: "memory")
#define PG8_BAR __builtin_amdgcn_s_barrier()
#define PG8_SCHED __builtin_amdgcn_sched_barrier(0)
    Unit cur, nxt; int ui = 0;
    if (!S.next(0, cur)) return;
    f32x4 acc[2][2][4][2];
#pragma unroll
    for (int a = 0; a < 2; ++a)
#pragma unroll
        for (int b = 0; b < 2; ++b)
#pragma unroll
            for (int m = 0; m < 4; ++m)
#pragma unroll
                for (int n = 0; n < 2; ++n) acc[a][b][m][n] = (f32x4){0.f, 0.f, 0.f, 0.f};
    bf16x8 At[4][2], B0[2][2], B1[2][2];
    const char* cA = (const char*)g.A + (size_t)cur.pm * tstep; const char* cB = (const char*)g.Bt + (size_t)cur.pn * tstep;
    S.a_ready(cur);
    if constexpr (SP2) {
        PG8_STAGE(PG8_SB(0, 0), cB, voffB); PG8_STAGE(PG8_SB(0, 1), cB + hstep, voffB); PG8_STAGE(PG8_SA(0, 0), cA, voffA); PG8_STAGE(PG8_SA(0, 1), cA + hstep, voffA);
        if (wr == 1) PG8_BAR;
        PG8_WAIT_V(2); PG8_BAR;
        PG8_STAGE(PG8_SB(1, 0), cB + kstep, voffB); PG8_STAGE(PG8_SA(1, 0), cA + kstep, voffA); PG8_STAGE(PG8_SB(1, 1), cB + hstep + kstep, voffB);
        PG8_WAIT_V(6); PG8_BAR;
    } else {
        PG8_STAGE(PG8_SB(0, 0), cB, voffB); PG8_STAGE(PG8_SA(0, 0), cA, voffA); PG8_STAGE(PG8_SB(0, 1), cB + hstep, voffB); PG8_STAGE(PG8_SA(0, 1), cA + hstep, voffA);
        if (wr == 1) PG8_BAR;
        PG8_WAIT_V(4); PG8_BAR;
        PG8_STAGE(PG8_SB(1, 0), cB + kstep, voffB); PG8_STAGE(PG8_SA(1, 0), cA + kstep, voffA); PG8_STAGE(PG8_SB(1, 1), cB + hstep + kstep, voffB);
        PG8_WAIT_V(6); PG8_BAR;
    }
    for (;;) {
        const bool has_next = S.next(ui + 1, nxt);
        const char* nA = has_next ? (const char*)g.A + (size_t)nxt.pm * tstep : cA; const char* nB = has_next ? (const char*)g.Bt + (size_t)nxt.pn * tstep : cB;
        for (int t = 0; t < nt; t += 2) {
            const bool last = (t == nt - 2);
            const char* a1 = cA + (size_t)(t + 1) * kstep;
            const char* a2 = last ? nA : cA + (size_t)(t + 2) * kstep; const char* b2 = last ? nB : cB + (size_t)(t + 2) * kstep;
            const char* a3 = a2 + kstep; const char* b3 = b2 + kstep;
            if (last && has_next) S.a_ready(nxt);
            if constexpr (SP2) {
            PG8_LDB(B0, 0, 0); PG8_LDB(B1, 0, 1); PG8_SCHED; PG8_LDA(At, 0, 0); PG8_STAGE(PG8_SA(1, 1), a1 + hstep, voffA);
            PG8_WAIT_V(8); PG8_WAIT_L(0); PG8_BAR; PG8_MMA(0, 0, At, B0); PG8_MMA(0, 1, At, B1); PG8_BAR; PG8_SCHED;
            PG8_LDA(At, 0, 1); PG8_STAGE(PG8_SB(0, 0), b2, voffB); PG8_STAGE(PG8_SB(0, 1), b2 + hstep, voffB); PG8_STAGE(PG8_SA(0, 0), a2, voffA);
            PG8_WAIT_V(8); PG8_WAIT_L(0); PG8_BAR; PG8_MMA(1, 0, At, B0); PG8_MMA(1, 1, At, B1); PG8_BAR; PG8_SCHED;
            PG8_LDB(B0, 1, 0); PG8_LDB(B1, 1, 1); PG8_SCHED; PG8_LDA(At, 1, 0); PG8_STAGE(PG8_SA(0, 1), a2 + hstep, voffA);
            PG8_WAIT_V(8); PG8_WAIT_L(0); PG8_BAR; PG8_MMA(0, 0, At, B0); PG8_MMA(0, 1, At, B1); PG8_BAR; PG8_SCHED;
            PG8_LDA(At, 1, 1); PG8_STAGE(PG8_SB(1, 0), b3, voffB); PG8_STAGE(PG8_SB(1, 1), b3 + hstep, voffB); PG8_STAGE(PG8_SA(1, 0), a3, voffA);
            PG8_WAIT_V(8); PG8_WAIT_L(0); PG8_BAR; PG8_MMA(1, 0, At, B0); PG8_MMA(1, 1, At, B1); PG8_BAR; PG8_SCHED;
            } else {
            PG8_LDB(B0, 0, 0); PG8_SCHED; PG8_LDA(At, 0, 0); PG8_STAGE(PG8_SA(1, 1), a1 + hstep, voffA);
            PG8_WAIT_L(8); PG8_BAR; PG8_WAIT_L(0); PG8_MMA(0, 0, At, B0); PG8_BAR; PG8_SCHED;
            PG8_LDB(B1, 0, 1); PG8_STAGE(PG8_SB(0, 0), b2, voffB);
            PG8_BAR; PG8_WAIT_L(0); PG8_MMA(0, 1, At, B1); PG8_BAR;
            PG8_LDA(At, 0, 1); PG8_STAGE(PG8_SA(0, 0), a2, voffA);
            PG8_BAR; PG8_WAIT_L(0); PG8_MMA(1, 0, At, B0); PG8_BAR; PG8_SCHED;
            PG8_STAGE(PG8_SB(0, 1), b2 + hstep, voffB);
            PG8_WAIT_V(6); PG8_BAR; PG8_MMA(1, 1, At, B1); PG8_BAR;
            PG8_LDB(B0, 1, 0); PG8_SCHED; PG8_LDA(At, 1, 0); PG8_STAGE(PG8_SA(0, 1), a2 + hstep, voffA);
            PG8_WAIT_L(8); PG8_BAR; PG8_WAIT_L(0); PG8_MMA(0, 0, At, B0); PG8_BAR; PG8_SCHED;
            PG8_LDB(B1, 1, 1); PG8_STAGE(PG8_SB(1, 0), b3, voffB);
            PG8_BAR; PG8_WAIT_L(0); PG8_MMA(0, 1, At, B1); PG8_BAR;
            PG8_LDA(At, 1, 1); PG8_STAGE(PG8_SA(1, 0), a3, voffA);
            PG8_BAR; PG8_WAIT_L(0); PG8_MMA(1, 0, At, B0); PG8_BAR; PG8_SCHED;
            PG8_STAGE(PG8_SB(1, 1), b3 + hstep, voffB);
            PG8_WAIT_V(6); PG8_BAR; PG8_MMA(1, 1, At, B1); PG8_BAR;
            }
        }
        if constexpr (ALIGN_EPI) { if (wr == 0) PG8_BAR; }
        if constexpr (!Epi::AFTER_DRAIN) { E(acc, cur, wr, wc, fr, fq); S.done(cur); }
        if (!has_next) break;
#pragma unroll
        for (int a = 0; a < 2; ++a)
#pragma unroll
            for (int b = 0; b < 2; ++b)
#pragma unroll
                for (int m = 0; m < 4; ++m)
#pragma unroll
                    for (int n = 0; n < 2; ++n) acc[a][b][m][n] = (f32x4){0.f, 0.f, 0.f, 0.f};
        cur = nxt; cA = nA; cB = nB; ++ui;
        if constexpr (ALIGN_EPI) { if (wr == 1) PG8_BAR; }
    }
    PG8_WAIT_V(0);
    if constexpr (!ALIGN_EPI) { if (wr == 0) PG8_BAR; }
    PG8_BAR;
    if constexpr (Epi::AFTER_DRAIN) { E.fused(acc, cur, wr, wc, fr, fq, lds, wid, lane); S.done(cur); }
#undef PG8_SA
#undef PG8_SB
#undef PG8_STAGE
#undef PG8_LDA
#undef PG8_LDB
#undef PG8_MMA
#undef PG8_WAIT_V
#undef PG8_WAIT_L
#undef PG8_BAR
#undef PG8_SCHED
}
}
extern __shared__ __attribute__((aligned(16))) unsigned char g_lds[];
using pg8::bf16_t; using pg8::bf16x8; using pg8::f32x4; using pg8::u32x4; using pg8::cvt_pk_bf16; using pg8::bflo; using pg8::bfhi; using pg8::sigm;

constexpr int NTOK = 32768, DM = 1024, SEQ = 2048, NB = 16, ZLD = 5120, NTHR = 512;
constexpr int C_R = 0, C_K = 512, C_V = 1024, C_WD = 1536, C_AD = 1600, C_GD = 1664;
constexpr int C_Q = 1824, C_KA = 2336, C_VA = 2400, C_QI = 2464, C_KI = 2976, C_WI = 3040, C_G0 = 3048, C_G1 = 4072;
constexpr size_t MiB = 1024 * 1024;
constexpr size_t WS_SS1 = 0, WS_SS2 = 128 * 1024, WS_BONUS = 256 * 1024, WS_ROPE = 1280 * 1024, WS_WD = 1792 * 1024, WS_WI = 1856 * 1024, WS_WG = 1920 * 1024;
constexpr size_t WS_WIN = 4 * MiB, WS_WUP = 14 * MiB, WS_WDN = 22 * MiB, WS_WB = 30 * MiB, WS_WO = 32 * MiB, WS_VT = 34 * MiB, WS_H = 38 * MiB, WS_Z = 102 * MiB, WS_P = 422 * MiB, WS_END = 486 * MiB;
constexpr int LDS_BYTES = 163840;

struct Args { const float* in[20]; float* out; unsigned char* ws; int ph_lo, ph_hi; };

struct Frame {
    const float* in[20]; float* out; unsigned char* ws; unsigned char* lds; int tid, lane, wave;
    float *ss1, *ss2, *bonus; float2* rope; bf16_t *wd, *wi, *wg, *win, *wup, *wdn, *wb, *wo, *vt, *h, *ya, *yb, *xb, *z, *hid, *lw, *ic, *mg, *gt; float* yraw;
};

__device__ __forceinline__ bf16_t f2bf(float f) { return (bf16_t)(cvt_pk_bf16(f, 0.f) & 0xffffu); }
__device__ __forceinline__ float bf2f(bf16_t b) { return __uint_as_float(((unsigned)b) << 16); }
template <int CTRL> __device__ __forceinline__ float dpp_mov(float x) { return __int_as_float(__builtin_amdgcn_update_dpp(0, __float_as_int(x), CTRL, 0xF, 0xF, true)); }
__device__ __forceinline__ float red16(float x) { x += dpp_mov<0xB1>(x); x += dpp_mov<0x4E>(x); x += dpp_mov<0x141>(x); x += dpp_mov<0x140>(x); return x; }


__device__ __forceinline__ void lds_barrier() { asm volatile("s_waitcnt lgkmcnt(0)" ::: "memory"); __builtin_amdgcn_s_barrier(); asm volatile("" ::: "memory"); }
__device__ __forceinline__ void red16x4(float& a, float& b, float& c, float& d) {
#define DPP4(ctl) "v_add_f32_dpp %0, %0, %0 " ctl " row_mask:0xf bank_mask:0xf bound_ctrl:1\n" "v_add_f32_dpp %1, %1, %1 " ctl " row_mask:0xf bank_mask:0xf bound_ctrl:1\n" \
                  "v_add_f32_dpp %2, %2, %2 " ctl " row_mask:0xf bank_mask:0xf bound_ctrl:1\n" "v_add_f32_dpp %3, %3, %3 " ctl " row_mask:0xf bank_mask:0xf bound_ctrl:1\n"
    asm volatile("s_nop 1\n" DPP4("quad_perm:[1,0,3,2]") DPP4("quad_perm:[2,3,0,1]") DPP4("row_half_mirror") DPP4("row_mirror") : "+v"(a), "+v"(b), "+v"(c), "+v"(d));
#undef DPP4
}
__device__ __forceinline__ float red32(float x) { x += __shfl_xor(x, 1); x += __shfl_xor(x, 2); x += __shfl_xor(x, 4); x += __shfl_xor(x, 8); x += __shfl_xor(x, 16); return x; }
__device__ __forceinline__ float red64(float x) { x = red32(x); x += __shfl_xor(x, 32); return x; }
__device__ __forceinline__ float softplus_f(float x) { return fmaxf(x, 0.f) + log1pf(__expf(-fabsf(x))); }

__device__ __forceinline__ void tconv(const Frame& F, const float* __restrict__ W, int K, int N, int Npad, bf16_t* __restrict__ Wt, const float* __restrict__ rs) {
    float* tile = (float*)g_lds;
    const int ktn = (K + 63) / 64, ntn = Npad / 64, tid = F.tid;
    for (int tl = blockIdx.x; tl < ktn * ntn; tl += gridDim.x) {
        const int kt = tl % ktn, nt = tl / ktn;
#pragma unroll
        for (int i = 0; i < 2; ++i) { const int idx = tid + i * NTHR, kk = idx >> 4, n4 = (idx & 15) * 4, k = kt * 64 + kk, n = nt * 64 + n4;
            f32x4 v = {0.f, 0.f, 0.f, 0.f};
            if (k < K) { if (n + 3 < N) v = *(const f32x4*)(W + (size_t)k * N + n); else { for (int j = 0; j < 4; ++j) if (n + j < N) v[j] = W[(size_t)k * N + n + j]; }
                if (rs != nullptr) { const float r = rs[k]; v[0] *= r; v[1] *= r; v[2] *= r; v[3] *= r; } }
            tile[kk * 65 + n4] = v[0]; tile[kk * 65 + n4 + 1] = v[1]; tile[kk * 65 + n4 + 2] = v[2]; tile[kk * 65 + n4 + 3] = v[3]; }
        __syncthreads();
        { const int nn = tid >> 3, k8 = (tid & 7) * 8, k = kt * 64 + k8, n = nt * 64 + nn;
          if (k < K) { u32x4 w; const float* tp = tile + k8 * 65 + nn;
              w.x = cvt_pk_bf16(tp[0], tp[65]); w.y = cvt_pk_bf16(tp[130], tp[195]); w.z = cvt_pk_bf16(tp[260], tp[325]); w.w = cvt_pk_bf16(tp[390], tp[455]);
              *(u32x4*)(Wt + (size_t)n * K + k) = w; } }
        __syncthreads();
    }
}
__device__ __forceinline__ void p0_prologue(const Frame& F) {
    const int tid = F.tid, gtid = blockIdx.x * NTHR + tid, gn = gridDim.x * NTHR;
    for (int i = gtid; i < 2 * NTOK; i += gn) F.ss1[i] = 0.f;
    for (int i = gtid; i < SEQ * 32; i += gn) { const int pos = i >> 5, j = i & 31;
        const float inv = 1.0f / powf(10000.0f, (float)(2 * j) / 64.0f); const float ang = (float)pos * inv;
        double rev = (double)ang * 0.15915494309189535; rev -= floor(rev); const float fr = (float)rev;
        F.rope[i] = make_float2(__builtin_amdgcn_cosf(fr), __builtin_amdgcn_sinf(fr)); }
    tconv(F, F.in[2], 1024, 5096, 5120, F.win, nullptr);
    tconv(F, F.in[17], 1024, 4096, 4096, F.wup, F.in[16]);
    tconv(F, F.in[18], 4096, 1024, 1024, F.wdn, nullptr);
    tconv(F, F.in[14], 512, 1024, 1024, F.wb, nullptr);
    tconv(F, F.in[14] + 512 * 1024, 512, 1024, 1024, F.wb + 1024 * 512, nullptr);
    tconv(F, F.in[15], 1024, 1024, 1024, F.wo, nullptr);
    tconv(F, F.in[5], 64, 512, 512, F.wd, nullptr);
    tconv(F, F.in[7], 64, 512, 512, F.wi, nullptr);
    tconv(F, F.in[8], 160, 512, 512, F.wg, nullptr);
    const float* x = F.in[0]; const float* g = F.in[1]; const int lane = F.lane;
    const int rstep = gridDim.x * 8;
    f32x4 gq[4];
#pragma unroll
    for (int i = 0; i < 4; ++i) gq[i] = *(const f32x4*)(g + (i >> 1) * 512 + lane * 8 + (i & 1) * 4);
    for (int row = blockIdx.x * 8 + F.wave; row < NTOK; row += 2 * rstep) {
        const int row2 = (row + rstep) < NTOK ? row + rstep : row; const bool two = row2 != row;
        const float* xr = x + (size_t)row * DM; const float* xr2 = x + (size_t)row2 * DM; f32x4 v[4], u[4]; float ss = 0.f, ss2 = 0.f;
#pragma unroll
        for (int i = 0; i < 4; ++i) { v[i] = __builtin_nontemporal_load((const f32x4*)(xr + (i >> 1) * 512 + lane * 8 + (i & 1) * 4)); u[i] = __builtin_nontemporal_load((const f32x4*)(xr2 + (i >> 1) * 512 + lane * 8 + (i & 1) * 4)); }
#pragma unroll
        for (int i = 0; i < 4; ++i) { ss += v[i][0] * v[i][0] + v[i][1] * v[i][1] + v[i][2] * v[i][2] + v[i][3] * v[i][3]; ss2 += u[i][0] * u[i][0] + u[i][1] * u[i][1] + u[i][2] * u[i][2] + u[i][3] * u[i][3]; }
        ss = red64(ss); ss2 = red64(ss2); const float sc = rsqrtf(ss * (1.0f / 1024.0f) + 1e-6f), sc2 = rsqrtf(ss2 * (1.0f / 1024.0f) + 1e-6f);
#pragma unroll
        for (int i = 0; i < 2; ++i) { const f32x4 a = v[2 * i] * gq[2 * i] * sc, b2 = v[2 * i + 1] * gq[2 * i + 1] * sc, a2 = u[2 * i] * gq[2 * i] * sc2, b3 = u[2 * i + 1] * gq[2 * i + 1] * sc2; u32x4 w, w2;
            w.x = cvt_pk_bf16(a[0], a[1]); w.y = cvt_pk_bf16(a[2], a[3]); w.z = cvt_pk_bf16(b2[0], b2[1]); w.w = cvt_pk_bf16(b2[2], b2[3]);
            w2.x = cvt_pk_bf16(a2[0], a2[1]); w2.y = cvt_pk_bf16(a2[2], a2[3]); w2.z = cvt_pk_bf16(b3[0], b3[1]); w2.w = cvt_pk_bf16(b3[2], b3[3]);
            *(u32x4*)(F.h + (size_t)row * DM + i * 512 + lane * 8) = w; if (two) *(u32x4*)(F.h + (size_t)row2 * DM + i * 512 + lane * 8) = w2; }
    }
}

__device__ __forceinline__ void p2_prep(const Frame& F, const int mode) {
    const int tid = F.tid, lane = F.lane, wave = F.wave, fr = lane & 15, fq = lane >> 4;
    bf16_t* z = F.z; const float* mu = F.in[3];
    if (mode != 2) {
        constexpr int LDA = 296, TT = 32; bf16_t* At = (bf16_t*)g_lds;
        bf16_t* Ot = At + TT * LDA;
        const float* dbias = F.in[4]; const float* ibias = F.in[6];
        for (int tile = blockIdx.x; tile < NTOK / TT; tile += gridDim.x) {
            const int t0 = tile * TT;
            for (int idx = tid; idx < TT * 36; idx += NTHR) { const int tok = idx / 36, c8 = (idx - tok * 36) * 8, t = t0 + tok, col = C_WD + c8;
                const u32x4 zc = *(const u32x4*)(z + (size_t)t * ZLD + col); u32x4 zp = {0u, 0u, 0u, 0u}; if (t & (SEQ - 1)) zp = *(const u32x4*)(z + (size_t)(t - 1) * ZLD + col);
                const f32x4 m0 = *(const f32x4*)(mu + col), m1 = *(const f32x4*)(mu + col + 4);
                float v[8]; const unsigned zcu[4] = {zc.x, zc.y, zc.z, zc.w}, zpu[4] = {zp.x, zp.y, zp.z, zp.w};
#pragma unroll
                for (int j = 0; j < 4; ++j) { const float a = bflo(zcu[j]), b2 = bfhi(zcu[j]), pa = bflo(zpu[j]), pb = bfhi(zpu[j]);
                    const float mm0 = (j < 2) ? m0[2 * j] : m1[2 * j - 4], mm1 = (j < 2) ? m0[2 * j + 1] : m1[2 * j - 3];
                    v[2 * j] = a + (pa - a) * mm0; v[2 * j + 1] = b2 + (pb - b2) * mm1; }
                if (c8 < 64) {
#pragma unroll
                    for (int j = 0; j < 8; ++j) v[j] = tanhf(v[j]); }
                else if (c8 >= 128) {
#pragma unroll
                    for (int j = 0; j < 8; ++j) v[j] = sigm(v[j]); }
                u32x4 w; w.x = cvt_pk_bf16(v[0], v[1]); w.y = cvt_pk_bf16(v[2], v[3]); w.z = cvt_pk_bf16(v[4], v[5]); w.w = cvt_pk_bf16(v[6], v[7]);
                *(u32x4*)(At + tok * LDA + c8) = w; }
            __syncthreads();
            const int h = wave;
            bf16x8 Bc[9], Bn[9];
            { const int n = h * 64 + fr;
#pragma unroll
              for (int ks = 0; ks < 2; ++ks) { Bc[ks] = *(const bf16x8*)(F.wd + n * 64 + ks * 32 + fq * 8); Bc[2 + ks] = *(const bf16x8*)(F.wi + n * 64 + ks * 32 + fq * 8); }
#pragma unroll
              for (int ks = 0; ks < 5; ++ks) Bc[4 + ks] = *(const bf16x8*)(F.wg + n * 160 + ks * 32 + fq * 8); }
#pragma unroll 1
            for (int j = 0; j < 4; ++j) { const int n = h * 64 + j * 16 + fr;
                if (j < 3) { const int nn = n + 16;
#pragma unroll
                    for (int ks = 0; ks < 2; ++ks) { Bn[ks] = *(const bf16x8*)(F.wd + nn * 64 + ks * 32 + fq * 8); Bn[2 + ks] = *(const bf16x8*)(F.wi + nn * 64 + ks * 32 + fq * 8); }
#pragma unroll
                    for (int ks = 0; ks < 5; ++ks) Bn[4 + ks] = *(const bf16x8*)(F.wg + nn * 160 + ks * 32 + fq * 8); }
                const float db = dbias[n], ib = ibias[n];
#pragma unroll
                for (int mt = 0; mt < 2; ++mt) {
                    f32x4 ad = {0.f, 0.f, 0.f, 0.f}, ai = ad, ag = ad; const bf16_t* ap = At + (mt * 16 + fr) * LDA + fq * 8;
#pragma unroll
                    for (int ks = 0; ks < 2; ++ks) ad = __builtin_amdgcn_mfma_f32_16x16x32_bf16(*(const bf16x8*)(ap + ks * 32), Bc[ks], ad, 0, 0, 0);
#pragma unroll
                    for (int ks = 0; ks < 2; ++ks) ai = __builtin_amdgcn_mfma_f32_16x16x32_bf16(*(const bf16x8*)(ap + 64 + ks * 32), Bc[2 + ks], ai, 0, 0, 0);
#pragma unroll
                    for (int ks = 0; ks < 5; ++ks) ag = __builtin_amdgcn_mfma_f32_16x16x32_bf16(*(const bf16x8*)(ap + 128 + ks * 32), Bc[4 + ks], ag, 0, 0, 0);
#pragma unroll
                    for (int jj = 0; jj < 4; ++jj) {
                        const float dw = db + ad[jj]; const float wlog = -softplus_f(-dw) - 0.5f; const float lwv = -__expf(wlog);
                        const int tk = mt * 16 + fq * 4 + jj; Ot[tk * 520 + n] = f2bf(lwv); Ot[(TT + tk) * 520 + n] = f2bf(sigm(ib + ai[jj])); Ot[(2 * TT + tk) * 520 + n] = f2bf(ag[jj]); }
                }
#pragma unroll
                for (int q = 0; q < 9; ++q) Bc[q] = Bn[q];
            }
            __syncthreads();
#pragma unroll
            for (int i = 0; i < 12; ++i) { const int idx = tid + i * NTHR, arr = idx >> 11, rem = idx & 2047, tk = rem >> 6, c8 = (rem & 63) * 8;
                const u32x4 w = *(const u32x4*)(Ot + (arr * TT + tk) * 520 + c8); bf16_t* dst = arr == 0 ? F.lw : (arr == 1 ? F.ic : F.gt);
                *(u32x4*)(dst + (size_t)(t0 + tk) * 512 + c8) = w; }
            __syncthreads();
        }
    }
    if (mode != 2) {
        unsigned short* tl = (unsigned short*)g_lds;
        for (int tile = blockIdx.x; tile < NTOK / 64; tile += gridDim.x) { const int t0 = tile * 64, b = t0 / SEQ, tt0 = t0 % SEQ;
            { const int tok = tid >> 3, d8 = (tid & 7) * 8; *(u32x4*)(tl + tok * 72 + d8) = *(const u32x4*)(z + (size_t)(t0 + tok) * ZLD + C_VA + d8); }
            __syncthreads();
            { const int d = tid >> 3, k8 = (tid & 7) * 8; unsigned short e[8];
#pragma unroll
              for (int j = 0; j < 8; ++j) e[j] = tl[(k8 + j) * 72 + d];
              u32x4 w; w.x = e[0] | ((unsigned)e[1] << 16); w.y = e[2] | ((unsigned)e[3] << 16); w.z = e[4] | ((unsigned)e[5] << 16); w.w = e[6] | ((unsigned)e[7] << 16);
              *(u32x4*)(F.vt + ((size_t)b * 64 + d) * SEQ + tt0 + k8) = w; }
            __syncthreads();
        }
    }
    if (mode != 0) {
        const int gtid = blockIdx.x * NTHR + tid, gn = gridDim.x * NTHR;
        for (int idx = gtid; idx < NTOK * 72; idx += gn) { const int t = idx / 72, p = idx - t * 72, hd = p >> 2, i8 = (p & 3) * 8;
            const int base = hd < 8 ? C_Q + hd * 64 : (hd == 8 ? C_KA : (hd < 17 ? C_QI + (hd - 9) * 64 : C_KI));
            const float* rp = (const float*)&F.rope[(t & (SEQ - 1)) * 32 + i8];
            f32x4 cs[4];
#pragma unroll
            for (int j = 0; j < 4; ++j) { cs[j] = *(const f32x4*)(rp + 4 * j); if (mode == 2) cs[j] = (f32x4){1.f, 0.f, 1.f, 0.f}; }
            bf16_t* p1 = z + (size_t)t * ZLD + base + i8; const u32x4 a = *(const u32x4*)(p1), b2 = *(const u32x4*)(p1 + 32);
            const unsigned au[4] = {a.x, a.y, a.z, a.w}, bu[4] = {b2.x, b2.y, b2.z, b2.w}; unsigned o1[4], o2[4];
#pragma unroll
            for (int j = 0; j < 4; ++j) { const float x1a = bflo(au[j]), x1b = bfhi(au[j]), x2a = bflo(bu[j]), x2b = bfhi(bu[j]);
                o1[j] = cvt_pk_bf16(x1a * cs[j][0] - x2a * cs[j][1], x1b * cs[j][2] - x2b * cs[j][3]);
                o2[j] = cvt_pk_bf16(x2a * cs[j][0] + x1a * cs[j][1], x2b * cs[j][2] + x1b * cs[j][3]); }
            u32x4 w1, w2; w1.x = o1[0]; w1.y = o1[1]; w1.z = o1[2]; w1.w = o1[3]; w2.x = o2[0]; w2.y = o2[1]; w2.z = o2[2]; w2.w = o2[3];
            *(u32x4*)(p1) = w1; *(u32x4*)(p1 + 32) = w2; }
    }
}

struct ScanRaw { uint2 zr_c, zr_p, zk_c, zk_p, zv_c, zv_p, lwu, icu; };
struct ScanConst { f32x4 mur, muk, muv, kk, ka, rk; };
__device__ __forceinline__ void scan_load(ScanRaw& R, const bf16_t* z, const bf16_t* lw, const bf16_t* ic, size_t tokbase, int ch, int ptok, int gc) {
    const int t = ch * 16 + ptok; const size_t T = tokbase + t; const bf16_t* zp = z + T * ZLD + gc;
    R.zr_c = *(const uint2*)(zp + C_R); R.zk_c = *(const uint2*)(zp + C_K); R.zv_c = *(const uint2*)(zp + C_V);
    const uint2 zz = make_uint2(0u, 0u);
    if (t > 0) { R.zr_p = *(const uint2*)(zp - ZLD + C_R); R.zk_p = *(const uint2*)(zp - ZLD + C_K); R.zv_p = *(const uint2*)(zp - ZLD + C_V); } else { R.zr_p = zz; R.zk_p = zz; R.zv_p = zz; }
    R.lwu = *(const uint2*)(lw + T * 512 + gc); R.icu = *(const uint2*)(ic + T * 512 + gc);
}
__device__ __forceinline__ f32x4 unpack4(uint2 u) { f32x4 r; r[0] = bflo(u.x); r[1] = bfhi(u.x); r[2] = bflo(u.y); r[3] = bfhi(u.y); return r; }
__device__ __forceinline__ void scan_prep(const ScanRaw& R, const ScanConst& C, float* ops, float* vv, float* bonus_out, bool wr_bonus, int ptok, int pc, int v0) {
    const f32x4 rc = unpack4(R.zr_c), rp = unpack4(R.zr_p), kc = unpack4(R.zk_c), kp = unpack4(R.zk_p), vc = unpack4(R.zv_c), vp = unpack4(R.zv_p), ic = unpack4(R.icu), lw = unpack4(R.lwu);
    const f32x4 r = rc + (rp - rc) * C.mur, k = kc + (kp - kc) * C.muk, vs = vc + (vp - vc) * C.muv;
    f32x4 w; w[0] = __expf(lw[0]); w[1] = __expf(lw[1]); w[2] = __expf(lw[2]); w[3] = __expf(lw[3]);
    const f32x4 q = k * C.kk; const float ss = red16((q[0] * q[0] + q[1] * q[1]) + (q[2] * q[2] + q[3] * q[3]));
    const float inv = 1.0f / fmaxf(sqrtf(ss), 1e-12f); const f32x4 n = q * inv;
    const f32x4 kn = k * (1.0f + (ic - 1.0f) * C.ka);
    const f32x4 bt = r * kn * C.rk; const float bon = red16((bt[0] + bt[1]) + (bt[2] + bt[3]));
    if (wr_bonus) *bonus_out = bon;
    float* op = ops + ptok * 320 + pc;
    *(f32x4*)(op) = -n; *(f32x4*)(op + 64) = w; *(f32x4*)(op + 128) = n * ic; *(f32x4*)(op + 192) = kn; *(f32x4*)(op + 256) = r;
    if (pc >= v0 && pc < v0 + 32) *(f32x4*)(vv + ptok * 32 + pc - v0) = vs;
}
__device__ __forceinline__ void p3_scan(const Frame& F, const int mode) {
    const int tid = F.tid;
    float* opsb = (float*)g_lds;
    float* vvb = opsb + 2 * 5120;
    float* yob = vvb + 2 * 512;
    const bf16_t* z = F.z; const float* mu = F.in[3]; const float* k_k = F.in[9]; const float* k_a = F.in[10]; const float* r_k = F.in[11];
    for (int item = blockIdx.x; item < 256; item += gridDim.x) {
        const int bh = item >> 1, half = item & 1, b = bh >> 3, h = bh & 7, v0 = half * 32;
        const size_t tokbase = (size_t)b * SEQ;
        if (F.wave >= 4) {
            const int pt = tid - 256, ptok = pt >> 4, pc = (pt & 15) * 4, gc = h * 64 + pc;
            ScanConst C; C.mur = *(const f32x4*)(mu + C_R + gc); C.muk = *(const f32x4*)(mu + C_K + gc); C.muv = *(const f32x4*)(mu + C_V + gc);
            C.kk = *(const f32x4*)(k_k + gc); C.ka = *(const f32x4*)(k_a + gc); C.rk = *(const f32x4*)(r_k + gc);
            const bool wrb = (half == 0) && ((pt & 15) == 0);
            ScanRaw R;
            scan_load(R, z, F.lw, F.ic, tokbase, 0, ptok, gc);
            scan_prep(R, C, opsb, vvb, F.bonus + (tokbase + ptok) * 8 + h, wrb, ptok, pc, v0);
            scan_load(R, z, F.lw, F.ic, tokbase, 1, ptok, gc);
            lds_barrier();
            for (int ch = 0; ch < SEQ / 16; ++ch) {
                const int cur = ch & 1, nxt = cur ^ 1;
                if (mode != 2) {
                if (ch > 0) { const int tok = pt >> 4, r2 = (pt & 15) * 2;
                    *(float2*)(F.yraw + (tokbase + (ch - 1) * 16 + tok) * 512 + h * 64 + v0 + r2) = *(const float2*)(yob + nxt * 512 + tok * 32 + r2); }
                if (ch + 1 < SEQ / 16) {
                    scan_prep(R, C, opsb + nxt * 5120, vvb + nxt * 512, F.bonus + (tokbase + (ch + 1) * 16 + ptok) * 8 + h, wrb, ptok, pc, v0);
                    if (ch + 2 < SEQ / 16) scan_load(R, z, F.lw, F.ic, tokbase, ch + 2, ptok, gc);
                } }
                lds_barrier();
            }
            { const int tok = pt >> 4, r2 = (pt & 15) * 2;
              *(float2*)(F.yraw + (tokbase + (SEQ / 16 - 1) * 16 + tok) * 512 + h * 64 + v0 + r2) = *(const float2*)(yob + 512 + tok * 32 + r2); }
        } else {
            const int rp = tid >> 4, ks = tid & 15;
            float A0 = 0.f, A1 = 0.f, A2 = 0.f, A3 = 0.f, B0 = 0.f, B1 = 0.f, B2 = 0.f, B3 = 0.f;
            const int ywoff = (ks == 0) ? 2 * rp : (2 * 512 + 2 * tid), ywstep = (ks == 0) ? 32 : 0;
            lds_barrier();
            f32x4 rprev = {0.f, 0.f, 0.f, 0.f}; float* ywp = yob + 2 * 512 + 2 * tid;
            for (int ch = 0; ch < SEQ / 16; ++ch) {
                const int cur = ch & 1;
                const float* ops = opsb + cur * 5120 + ks * 4; const float* vv = vvb + cur * 512 + 2 * rp; float* yw = yob + cur * 512 + ywoff;
                if (mode != 1) {
#pragma unroll
                for (int s = 0; s < 16; ++s) {
                    const float* o = ops + s * 320;
                    const f32x4 a4 = *(const f32x4*)(o), w4 = *(const f32x4*)(o + 64), b4 = *(const f32x4*)(o + 128), k4 = *(const f32x4*)(o + 192), r4 = *(const f32x4*)(o + 256);
                    const float2 vab = *(const float2*)(vv + s * 32);
                    float sa = (A0 * a4[0] + A1 * a4[1]) + (A2 * a4[2] + A3 * a4[3]); float sb = (B0 * a4[0] + B1 * a4[1]) + (B2 * a4[2] + B3 * a4[3]);
                    float ya = (A0 * rprev[0] + A1 * rprev[1]) + (A2 * rprev[2] + A3 * rprev[3]); float yb2 = (B0 * rprev[0] + B1 * rprev[1]) + (B2 * rprev[2] + B3 * rprev[3]);
                    red16x4(sa, sb, ya, yb2);
                    *(float2*)(ywp) = make_float2(ya, yb2);
                    ywp = yw + s * ywstep;
                    A0 = A0 * w4[0] + sa * b4[0] + vab.x * k4[0]; A1 = A1 * w4[1] + sa * b4[1] + vab.x * k4[1];
                    A2 = A2 * w4[2] + sa * b4[2] + vab.x * k4[2]; A3 = A3 * w4[3] + sa * b4[3] + vab.x * k4[3];
                    B0 = B0 * w4[0] + sb * b4[0] + vab.y * k4[0]; B1 = B1 * w4[1] + sb * b4[1] + vab.y * k4[1];
                    B2 = B2 * w4[2] + sb * b4[2] + vab.y * k4[2]; B3 = B3 * w4[3] + sb * b4[3] + vab.y * k4[3];
                    rprev = r4;
                }
                {
                    float ya = (A0 * rprev[0] + A1 * rprev[1]) + (A2 * rprev[2] + A3 * rprev[3]); float yb2 = (B0 * rprev[0] + B1 * rprev[1]) + (B2 * rprev[2] + B3 * rprev[3]);
                    float d0 = 0.f, d1 = 0.f; red16x4(ya, yb2, d0, d1);
                    *(float2*)(ywp) = make_float2(ya, yb2); ywp = yob + 2 * 512 + 2 * tid; rprev = (f32x4){0.f, 0.f, 0.f, 0.f};
                } }
                lds_barrier();
            }
        }
        __syncthreads();
    }
}

__device__ __forceinline__ unsigned ordkey(float f) { const unsigned u = __float_as_uint(f); return (u & 0x80000000u) ? ~u : (u | 0x80000000u); }

__device__ __forceinline__ void attn_chunk(const unsigned char* kb, const unsigned char* vb, const unsigned* selm, int c, int p, int fr, int fq, const bf16x8 (&Bqa)[2][2], f32x4 (&O)[2][4], f32x4 (&RS)[2]) {
    const f32x4 zero4 = {0.f, 0.f, 0.f, 0.f};
    const u32x4 onesu = {0x3f803f80u, 0x3f803f80u, 0x3f803f80u, 0x3f803f80u}; const bf16x8 ones = __builtin_bit_cast(bf16x8, onesu);
    const float csc = 0.125f * 1.4426950408889634f;
    const unsigned char* k0p = kb + ((2 * p) * 16 + fr) * 144 + fq * 16; const unsigned char* k1p = k0p + 16 * 144;
    const bf16x8 KA00 = *(const bf16x8*)(k0p), KA01 = *(const bf16x8*)(k0p + 64), KA10 = *(const bf16x8*)(k1p), KA11 = *(const bf16x8*)(k1p + 64);
    const int mw = (int)selm[fr * 64 + 2 * c + p];
    bf16x8 VA[4];
#pragma unroll
    for (int dt = 0; dt < 4; ++dt) { const unsigned char* vp = vb + (dt * 16 + fr) * 144 + (2 * p) * 32 + fq * 8;
        const uint2 lo = *(const uint2*)(vp), hi = *(const uint2*)(vp + 32);
        u32x4 va; va.x = lo.x; va.y = lo.y; va.z = hi.x; va.w = hi.y; VA[dt] = __builtin_bit_cast(bf16x8, va); }
    unsigned km0[4], km1[4];
#pragma unroll
    for (int jj = 0; jj < 4; ++jj) { km0[jj] = (unsigned)__builtin_amdgcn_sbfe(mw, fq * 4 + jj, 1); km1[jj] = (unsigned)__builtin_amdgcn_sbfe(mw, 16 + fq * 4 + jj, 1); }
#pragma unroll
    for (int hh = 0; hh < 2; ++hh) {
        f32x4 s0 = __builtin_amdgcn_mfma_f32_16x16x32_bf16(KA00, Bqa[hh][0], zero4, 0, 0, 0); s0 = __builtin_amdgcn_mfma_f32_16x16x32_bf16(KA01, Bqa[hh][1], s0, 0, 0, 0);
        f32x4 s1 = __builtin_amdgcn_mfma_f32_16x16x32_bf16(KA10, Bqa[hh][0], zero4, 0, 0, 0); s1 = __builtin_amdgcn_mfma_f32_16x16x32_bf16(KA11, Bqa[hh][1], s1, 0, 0, 0);
        unsigned p0[4], p1[4];
#pragma unroll
        for (int jj = 0; jj < 4; ++jj) {
            p0[jj] = __float_as_uint(__builtin_amdgcn_exp2f(fminf(s0[jj] * csc, 86.f))) & km0[jj]; p1[jj] = __float_as_uint(__builtin_amdgcn_exp2f(fminf(s1[jj] * csc, 86.f))) & km1[jj]; }
        u32x4 pk; pk.x = cvt_pk_bf16(__uint_as_float(p0[0]), __uint_as_float(p0[1])); pk.y = cvt_pk_bf16(__uint_as_float(p0[2]), __uint_as_float(p0[3]));
        pk.z = cvt_pk_bf16(__uint_as_float(p1[0]), __uint_as_float(p1[1])); pk.w = cvt_pk_bf16(__uint_as_float(p1[2]), __uint_as_float(p1[3]));
        const bf16x8 PB = __builtin_bit_cast(bf16x8, pk);
        RS[hh] = __builtin_amdgcn_mfma_f32_16x16x32_bf16(ones, PB, RS[hh], 0, 0, 0);
#pragma unroll
        for (int dt = 0; dt < 4; ++dt) O[hh][dt] = __builtin_amdgcn_mfma_f32_16x16x32_bf16(VA[dt], PB, O[hh][dt], 0, 0, 0);
    }
}

__device__ __forceinline__ void p3_dsa(const Frame& F) {
    const int tid = F.tid, lane = F.lane, wave = F.wave, fr = lane & 15, fq = lane >> 4;
    unsigned* scl = (unsigned*)g_lds;
    unsigned* selm = (unsigned*)(g_lds + 131328);
    unsigned char* kbuf = (unsigned char*)g_lds;
    unsigned char* vbuf = kbuf + 2 * 9216;
    const bf16_t* z = F.z; const int G = gridDim.x, bx = blockIdx.x;
    const f32x4 zero4 = {0.f, 0.f, 0.f, 0.f};
    for (int rnd = 0; rnd * G < 2048; ++rnd) {
        const int n = rnd * G + ((rnd & 1) ? (G - 1 - bx) : bx);
        if (n >= 2048) continue;
        const int qg = 127 - (n >> 4), b = n & 15, q0 = qg * 16; const size_t Tb = (size_t)b * SEQ;
        for (int i = tid; i < 1024; i += NTHR) selm[i] = 0u;
        __syncthreads();
        const bf16_t* zq = z + (Tb + q0 + fr) * ZLD;
        const unsigned lofk = (unsigned)((fr * ZLD + fq * 8) * 2), lofv = (unsigned)((fr * SEQ + fq * 4) * 2);
        const int nchunk = (qg + 4) >> 2; const int lrow = tid >> 3, lseg = tid & 7;
        const bf16_t* kg = z + (Tb + lrow) * ZLD + C_KA + lseg * 8; const bf16_t* vg = F.vt + ((size_t)b * 64 + lrow) * SEQ + lseg * 8;
        const unsigned lst = (unsigned)(lrow * 144 + lseg * 16);
        const int hp = wave >> 1, kh = wave & 1;
        const u32x4 kc0 = *(const u32x4*)(kg), vc0 = *(const u32x4*)(vg);
        u32x4 kx = kc0, vx = vc0, ky = kc0, vy = vc0;
        if (1 < nchunk) { kx = *(const u32x4*)(kg + (size_t)64 * ZLD); vx = *(const u32x4*)(vg + 64); }
        if (2 < nchunk) { ky = *(const u32x4*)(kg + (size_t)128 * ZLD); vy = *(const u32x4*)(vg + 128); }
        bf16x8 Bqa[2][2];
#pragma unroll
        for (int hh = 0; hh < 2; ++hh)
#pragma unroll
            for (int ks = 0; ks < 2; ++ks) Bqa[hh][ks] = *(const bf16x8*)(zq + C_Q + (2 * hp + hh) * 64 + ks * 32 + fq * 8);
        if (qg >= 16) {
            const u32x4 wv = *(const u32x4*)(zq + C_WI);
            {
                bf16x8 Bq[8][2];
#pragma unroll
                for (int hh = 0; hh < 8; ++hh)
#pragma unroll
                    for (int ks = 0; ks < 2; ++ks) Bq[hh][ks] = *(const bf16x8*)(zq + C_QI + hh * 64 + ks * 32 + fq * 8);
                const float sc = 0.044194173824159216f;
                float wih[8]; wih[0] = bflo(wv.x) * sc; wih[1] = bfhi(wv.x) * sc; wih[2] = bflo(wv.y) * sc; wih[3] = bfhi(wv.y) * sc; wih[4] = bflo(wv.z) * sc; wih[5] = bfhi(wv.z) * sc; wih[6] = bflo(wv.w) * sc; wih[7] = bfhi(wv.w) * sc;
#pragma unroll 1
                for (int half = 0; half < 2; ++half) {
                    const int ktb = wave + 64 * half; if (ktb > qg) break;
                    bf16x8 W0[2], W1[2];
#pragma unroll
                    for (int j = 0; j < 2; ++j) { const int ktj = (ktb + 8 * j) < qg ? (ktb + 8 * j) : qg; const char* kb = (const char*)(z + (Tb + (size_t)ktj * 16) * ZLD + C_KI);
                        W0[j] = *(const bf16x8*)(kb + lofk); W1[j] = *(const bf16x8*)(kb + lofk + 64); }
#pragma unroll
                    for (int i = 0; i < 8; ++i) { const int kt = ktb + 8 * i;
                        if (kt <= qg) { f32x4 sv = zero4;
#pragma unroll
                            for (int hh = 0; hh < 8; ++hh) { f32x4 acc = __builtin_amdgcn_mfma_f32_16x16x32_bf16(W0[i & 1], Bq[hh][0], zero4, 0, 0, 0);
                                acc = __builtin_amdgcn_mfma_f32_16x16x32_bf16(W1[i & 1], Bq[hh][1], acc, 0, 0, 0);
#pragma unroll
                                for (int jj = 0; jj < 4; ++jj) sv[jj] += wih[hh] * fmaxf(acc[jj], 0.f); }
                            u32x4 w; w.x = ordkey(sv[0]); w.y = ordkey(sv[1]); w.z = ordkey(sv[2]); w.w = ordkey(sv[3]);
                            *(u32x4*)(scl + fr * 2052 + kt * 16 + fq * 4) = w;
                        }
                        if (i + 2 < 8) { const int ktn = (kt + 16) < qg ? (kt + 16) : qg; const char* kb = (const char*)(z + (Tb + (size_t)ktn * 16) * ZLD + C_KI);
                            unsigned lo2 = lofk; asm volatile("" : "+v"(lo2));
                            W0[i & 1] = *(const bf16x8*)(kb + lo2); W1[i & 1] = *(const bf16x8*)(kb + lo2 + 64); }
                    }
                }
            }
            __syncthreads();
#pragma unroll 1
            for (int qq = 0; qq < 2; ++qq) {
                const int q = 2 * wave + qq, qpos = q0 + q;
                unsigned uk[32];
#pragma unroll
                for (int r = 0; r < 32; ++r) { const int key = r * 64 + lane; uk[r] = 0x007fffffu;
                    if (r * 64 <= qpos) { const unsigned v = scl[q * 2052 + key]; uk[r] = (key <= qpos) ? v : 0x007fffffu; } }
                unsigned T = 0u; bool exact = false;
#pragma unroll 1
                for (int bit = 31; bit >= 0; --bit) {
                    const unsigned cand = T | (1u << bit); int c = 0;
#pragma unroll
                    for (int g = 0; g < 4; ++g) {
                        if (g * 512 > qpos) break;
                        unsigned long long m[8];
                        asm("v_cmp_ge_u32_e64 %0, %8, %16\n\tv_cmp_ge_u32_e64 %1, %9, %16\n\tv_cmp_ge_u32_e64 %2, %10, %16\n\tv_cmp_ge_u32_e64 %3, %11, %16\n\t"
                            "v_cmp_ge_u32_e64 %4, %12, %16\n\tv_cmp_ge_u32_e64 %5, %13, %16\n\tv_cmp_ge_u32_e64 %6, %14, %16\n\tv_cmp_ge_u32_e64 %7, %15, %16"
                            : "=&s"(m[0]), "=&s"(m[1]), "=&s"(m[2]), "=&s"(m[3]), "=&s"(m[4]), "=&s"(m[5]), "=&s"(m[6]), "=&s"(m[7])
                            : "v"(uk[g * 8 + 0]), "v"(uk[g * 8 + 1]), "v"(uk[g * 8 + 2]), "v"(uk[g * 8 + 3]), "v"(uk[g * 8 + 4]), "v"(uk[g * 8 + 5]), "v"(uk[g * 8 + 6]), "v"(uk[g * 8 + 7]), "v"(cand));
#pragma unroll
                        for (int j = 0; j < 8; ++j) c += __builtin_popcountll(m[j]);
                    }
                    if (c >= 256) { T = cand; if (c == 256) { exact = true; break; } }
                }
                int need = 0;
                if (!exact) { int c = 0;
#pragma unroll
                    for (int r = 0; r < 32; ++r) c += __builtin_popcountll(__builtin_amdgcn_ballot_w64(uk[r] > T));
                    need = 256 - c; }
#pragma unroll
                for (int r = 0; r < 32; ++r) {
                    if (r * 64 <= qpos) {
                        unsigned long long sel;
                        if (exact) sel = __builtin_amdgcn_ballot_w64(uk[r] >= T);
                        else { sel = __builtin_amdgcn_ballot_w64(uk[r] > T); unsigned long long e = __builtin_amdgcn_ballot_w64(uk[r] == T);
                            const int ne = __builtin_popcountll(e);
                            if (ne <= need) { sel |= e; need -= ne; }
                            else { for (int k = 0; k < need; ++k) { const unsigned long long lb = e & (0ull - e); sel |= lb; e ^= lb; } need = 0; } }
                        if (lane == 0) { selm[q * 64 + 2 * r] = (unsigned)sel; selm[q * 64 + 2 * r + 1] = (unsigned)(sel >> 32); }
                    }
                }
            }
        } else {
            for (int w = tid; w < 1024; w += NTHR) { const int q = w >> 6, word = w & 63, qpos = q0 + q, lo = word * 32;
                selm[w] = (qpos >= lo + 31) ? 0xffffffffu : (qpos < lo ? 0u : ((2u << (qpos - lo)) - 1u)); }
        }
        __syncthreads();
        {
            *(u32x4*)(kbuf + lst) = kc0; *(u32x4*)(vbuf + lst) = vc0;
            f32x4 O[2][4]; f32x4 rs[2];
#pragma unroll
            for (int hh = 0; hh < 2; ++hh) { rs[hh] = zero4;
#pragma unroll
                for (int dt = 0; dt < 4; ++dt) O[hh][dt] = zero4; }
            lds_barrier();
#pragma unroll 1
            for (int c = 0; c < nchunk; c += 2) {
                attn_chunk(kbuf, vbuf, selm, c, kh, fr, fq, Bqa, O, rs);
                if (c + 1 < nchunk) { *(u32x4*)(kbuf + 9216 + lst) = kx; *(u32x4*)(vbuf + 9216 + lst) = vx; }
                if (c + 3 < nchunk) { kx = *(const u32x4*)(kg + (size_t)(c + 3) * 64 * ZLD); vx = *(const u32x4*)(vg + (c + 3) * 64); }
                lds_barrier();
                if (c + 1 < nchunk) {
                    attn_chunk(kbuf + 9216, vbuf + 9216, selm, c + 1, kh, fr, fq, Bqa, O, rs);
                    if (c + 2 < nchunk) { *(u32x4*)(kbuf + lst) = ky; *(u32x4*)(vbuf + lst) = vy; }
                    if (c + 4 < nchunk) { ky = *(const u32x4*)(kg + (size_t)(c + 4) * 64 * ZLD); vy = *(const u32x4*)(vg + (c + 4) * 64); }
                    lds_barrier();
                }
            }
            float* xb = (float*)(vbuf + 2 * 9216) + (size_t)wave * (64 * 17);
            { const int oh = kh ^ 1;
#pragma unroll
              for (int dt = 0; dt < 4; ++dt)
#pragma unroll
                  for (int jj = 0; jj < 4; ++jj) xb[(dt * 4 + jj) * 64 + lane] = (oh == 0) ? O[0][dt][jj] : O[1][dt][jj];
              xb[16 * 64 + lane] = (oh == 0) ? rs[0][0] : rs[1][0]; }
            lds_barrier();
            { const float* pb = (const float*)(vbuf + 2 * 9216) + (size_t)(wave ^ 1) * (64 * 17);
              float tot = ((kh == 0) ? rs[0][0] : rs[1][0]) + pb[16 * 64 + lane];
              const float inv = 1.0f / tot;
              bf16_t* yp = F.yb + (Tb + q0 + fr) * 512 + (2 * hp + kh) * 64 + fq * 4;
#pragma unroll
              for (int dt = 0; dt < 4; ++dt) { float o[4];
#pragma unroll
                  for (int jj = 0; jj < 4; ++jj) o[jj] = (((kh == 0) ? O[0][dt][jj] : O[1][dt][jj]) + pb[(dt * 4 + jj) * 64 + lane]) * inv;
                  uint2 w; w.x = cvt_pk_bf16(o[0], o[1]); w.y = cvt_pk_bf16(o[2], o[3]); *(uint2*)(yp + dt * 16) = w; } }
        }
        __syncthreads();
    }
}

struct P4In { f32x4 y; uint2 vc, vp, gt; float bon; };
__device__ __forceinline__ void p4_load(P4In& I, const Frame& F, int g, int c) { const size_t t = (size_t)(g >> 3); const bf16_t* z = F.z;
    I.y = __builtin_nontemporal_load((const f32x4*)(F.yraw + t * 512 + c)); I.vc = *(const uint2*)(z + t * ZLD + C_V + c); I.vp = make_uint2(0u, 0u); if (t & (SEQ - 1)) I.vp = *(const uint2*)(z + (t - 1) * ZLD + C_V + c);
    { typedef unsigned u32x2v __attribute__((ext_vector_type(2))); const u32x2v gv = __builtin_nontemporal_load((const u32x2v*)(F.gt + t * 512 + c)); I.gt = make_uint2(gv.x, gv.y); } I.bon = F.bonus[t * 8 + (g & 7)]; }
__device__ __forceinline__ void p4_finish(const P4In& I, const Frame& F, int g, int c, const f32x4& m4, const f32x4& w4, const f32x4& b4) { const size_t t = (size_t)(g >> 3);
    const f32x4 y = I.y; const float mean = red16((y[0] + y[1]) + (y[2] + y[3])) * (1.0f / 64.0f); const f32x4 d = y - mean;
    const float var = red16((d[0] * d[0] + d[1] * d[1]) + (d[2] * d[2] + d[3] * d[3])) * (1.0f / 64.0f); const float rstd = rsqrtf(var + 64e-5f);
    f32x4 vcf, vpf, gtf; vcf[0] = bflo(I.vc.x); vcf[1] = bfhi(I.vc.x); vcf[2] = bflo(I.vc.y); vcf[3] = bfhi(I.vc.y); vpf[0] = bflo(I.vp.x); vpf[1] = bfhi(I.vp.x); vpf[2] = bflo(I.vp.y); vpf[3] = bfhi(I.vp.y);
    gtf[0] = bflo(I.gt.x); gtf[1] = bfhi(I.gt.x); gtf[2] = bflo(I.gt.y); gtf[3] = bfhi(I.gt.y);
    const f32x4 vs = vcf + (vpf - vcf) * m4; const f32x4 o = (d * rstd * w4 + b4 + vs * I.bon) * gtf;
    uint2 w; w.x = cvt_pk_bf16(o[0], o[1]); w.y = cvt_pk_bf16(o[2], o[3]); *(uint2*)(F.ya + t * 512 + c) = w; }
__device__ __forceinline__ void p4_post(const Frame& F) {
    const int tid = F.tid; const float* mu = F.in[3]; const float* gnw = F.in[12]; const float* gnb = F.in[13];
    const int gstep = gridDim.x * 32, g0 = blockIdx.x * 32 + (tid >> 4), c = (g0 & 7) * 64 + (tid & 15) * 4;
    const f32x4 m4 = *(const f32x4*)(mu + C_V + c), w4 = *(const f32x4*)(gnw + c), b4 = *(const f32x4*)(gnb + c);
    for (int g = g0; g < NTOK * 8; g += 2 * gstep) { const int g2 = g + gstep; const bool two = g2 < NTOK * 8;
        P4In A, B; p4_load(A, F, g, c); if (two) p4_load(B, F, g2, c);
        p4_finish(A, F, g, c, m4, w4, b4); if (two) p4_finish(B, F, g2, c, m4, w4, b4); }
}

__device__ __forceinline__ void p9_final(const Frame& F, const bool ident) {
    const float* g = F.in[19]; const int lane = F.lane; const int rstep = gridDim.x * 8;
    f32x4 gg[4];
#pragma unroll
    for (int i = 0; i < 4; ++i) gg[i] = *(const f32x4*)(g + i * 256 + lane * 4);
    for (int row = blockIdx.x * 8 + F.wave; row < NTOK; row += 2 * rstep) {
        const int row2 = row + rstep; const bool two = row2 < NTOK;
        float* xr = F.out + (size_t)row * DM; float* xr2 = F.out + (size_t)(two ? row2 : row) * DM;
        f32x4 v[4], u[4];
#pragma unroll
        for (int i = 0; i < 4; ++i) { v[i] = __builtin_nontemporal_load((const f32x4*)(xr + i * 256 + lane * 4)); u[i] = __builtin_nontemporal_load((const f32x4*)(xr2 + i * 256 + lane * 4)); }
        const float sc = ident ? 1.0f : rsqrtf(F.ss2[row] * (1.0f / 1024.0f) + 1e-6f), sc2 = ident ? 1.0f : rsqrtf(F.ss2[two ? row2 : row] * (1.0f / 1024.0f) + 1e-6f);
#pragma unroll
        for (int i = 0; i < 4; ++i) { if (!ident) { v[i] = v[i] * gg[i] * sc; u[i] = u[i] * gg[i] * sc2; }
            __builtin_nontemporal_store(v[i], (f32x4*)(xr + i * 256 + lane * 4)); if (two) __builtin_nontemporal_store(u[i], (f32x4*)(xr2 + i * 256 + lane * 4)); }
    }
}
#define XB_TMO      128
#define XB_XCNT(j)  (256  + 64 * (j))
#define XB_XSUB(j)  (1280 + 64 * (j))
#define XB_XGEN(j)  (2304 + 64 * (j))
#define XB_TOP      3328
#define XB_TOPGEN   3392
#define XCD_BAR_WORDS 3456
#define XB_SPIN_CAP (1u << 18)
#define LAS __attribute__((address_space(3)))

__device__ __forceinline__ unsigned xb_ld(unsigned* p)              { return __hip_atomic_load(p, __ATOMIC_RELAXED, __HIP_MEMORY_SCOPE_AGENT); }
__device__ __forceinline__ unsigned xb_add(unsigned* p, unsigned v) { return __hip_atomic_fetch_add(p, v, __ATOMIC_RELAXED, __HIP_MEMORY_SCOPE_AGENT); }
__device__ __forceinline__ unsigned xb_xcc_id() { return (unsigned)__builtin_amdgcn_s_getreg((3 << 11) | 20) & 0xFu; }
#define XB_SPIN(cond, bar) do { unsigned _sp = 0; while (cond) { __builtin_amdgcn_s_sleep(1); \
    if ((++_sp & 255u) == 0u) { if (xb_ld(&(bar)[XB_TMO])) break; if (_sp > XB_SPIN_CAP) { atomicAdd(&(bar)[XB_TMO], 1u); break; } } } } while (0)

struct XcdBarrier {
    unsigned* bar; unsigned x;
    volatile LAS unsigned* st;
};

__device__ __forceinline__ XcdBarrier xcd_barrier_post(unsigned* bar, volatile LAS unsigned* st) {
    XcdBarrier b; b.bar = bar; b.x = xb_xcc_id(); b.st = st;
    if (threadIdx.x == 0) (void)xb_add(&bar[XB_XCNT(b.x)], 1u);
    return b;
}
__device__ __forceinline__ void xcd_barrier_complete(unsigned* bar, unsigned x, unsigned& nloc, unsigned& nx) {
    const unsigned G = gridDim.x * gridDim.y * gridDim.z;
    unsigned sum, cnt, mine, sp = 0u;
    for (;;) {
        sum = 0u; cnt = 0u; mine = 0u;
#pragma unroll
        for (unsigned j = 0; j < 16; ++j) { const unsigned c = xb_ld(&bar[XB_XCNT(j)]); sum += c; cnt += (c > 0u) ? 1u : 0u; mine = (j == x) ? c : mine; }
        if (sum == G) break;
        __builtin_amdgcn_s_sleep(1);
        if ((++sp & 255u) == 0u) { if (xb_ld(&bar[XB_TMO])) break; if (sp > XB_SPIN_CAP) { atomicAdd(&bar[XB_TMO], 1u); break; } }
    }
    nloc = mine > 0u ? mine : 1u; nx = cnt > 0u ? cnt : 1u;
}

__device__ __forceinline__ void xcd_barrier(const XcdBarrier& b) {
    asm volatile("s_waitcnt vmcnt(0)" ::: "memory");
    __syncthreads();
    if (threadIdx.x == 0) {
        unsigned* bar = b.bar;
        __builtin_amdgcn_s_waitcnt(0);
        unsigned nloc = b.st[0], nx = b.st[1];
        if (nloc == 0u) { xcd_barrier_complete(bar, b.x, nloc, nx); b.st[0] = nloc; b.st[1] = nx; }
        const unsigned old = xb_add(&bar[XB_XSUB(b.x)], 1u);
        const unsigned gen = old / nloc;
        if (old + 1u == (gen + 1u) * nloc) {
            __builtin_amdgcn_fence(__ATOMIC_RELEASE, "agent");
            asm volatile("s_waitcnt vmcnt(0)" ::: "memory");
            const unsigned og = xb_add(&bar[XB_TOP], 1u);
            const unsigned tg = og / nx;
            if (og + 1u == (tg + 1u) * nx) xb_add(&bar[XB_TOPGEN], 1u);
            else XB_SPIN(xb_ld(&bar[XB_TOPGEN]) == tg, bar);
            __builtin_amdgcn_fence(__ATOMIC_ACQUIRE, "agent");
            xb_add(&bar[XB_XGEN(b.x)], 1u);
            asm volatile("s_waitcnt vmcnt(0)" ::: "memory");
        } else {
            XB_SPIN(xb_ld(&bar[XB_XGEN(b.x)]) == gen, bar);
            __builtin_amdgcn_fence(__ATOMIC_ACQUIRE, "agent");
            asm volatile("s_waitcnt vmcnt(0)" ::: "memory");
        }
    }
    __syncthreads();
}
#ifndef PHASE_MASK
#define PHASE_MASK 0x3ff
#endif
#ifndef GEMM_ALIGN
#define GEMM_ALIGN true
#endif
#ifndef GEMM_SP2
#define GEMM_SP2 true
#endif
constexpr int NPHASE = 10;
constexpr size_t WS_BAR = 3 * MiB;
template <class Epi> __device__ __forceinline__ void run_gemm(const bf16_t* A, const bf16_t* Bt, int N, int K, const Epi& E) {
    pg8::Gemm g{A, Bt, NTOK, N, K}; pg8::StaticOrder S; S.init(NTOK, N, (int)gridDim.x, (int)blockIdx.x);
    pg8::gemm_phase<Epi, pg8::StaticOrder, GEMM_ALIGN, GEMM_SP2>((PG8_LAS unsigned char*)g_lds, g, S, E);
}
__global__ void __launch_bounds__(NTHR, 2) mega_fwd(Args args) {
    Frame F;
#pragma unroll
    for (int i = 0; i < 20; ++i) F.in[i] = args.in[i];
    F.out = args.out; F.ws = args.ws; F.lds = nullptr; F.tid = threadIdx.x; F.lane = F.tid & 63; F.wave = __builtin_amdgcn_readfirstlane(F.tid >> 6);
    unsigned char* ws = args.ws;
    F.ss1 = (float*)(ws + WS_SS1); F.ss2 = (float*)(ws + WS_SS2); F.bonus = (float*)(ws + WS_BONUS); F.rope = (float2*)(ws + WS_ROPE);
    F.wd = (bf16_t*)(ws + WS_WD); F.wi = (bf16_t*)(ws + WS_WI); F.wg = (bf16_t*)(ws + WS_WG);
    F.win = (bf16_t*)(ws + WS_WIN); F.wup = (bf16_t*)(ws + WS_WUP); F.wdn = (bf16_t*)(ws + WS_WDN); F.wb = (bf16_t*)(ws + WS_WB); F.wo = (bf16_t*)(ws + WS_WO); F.vt = (bf16_t*)(ws + WS_VT);
    F.h = (bf16_t*)(ws + WS_H); F.ya = F.h; F.yb = F.h + (size_t)NTOK * 512; F.xb = F.h;
    F.z = (bf16_t*)(ws + WS_Z); F.hid = F.z;
    F.lw = (bf16_t*)(ws + WS_P); F.ic = F.lw + (size_t)NTOK * 512; F.mg = F.lw;
    F.yraw = args.out; F.gt = (bf16_t*)(args.out + (size_t)NTOK * 512);
    const int lo = args.ph_lo, hi = args.ph_hi;
    cg::grid_group grid = cg::this_grid();
    if (args.ph_lo < 0) grid.sync();
    volatile LAS unsigned* xst = (volatile LAS unsigned*)(g_lds + LDS_BYTES - 64);
    if (threadIdx.x == 0) { xst[0] = 0u; xst[1] = 0u; }
    __syncthreads();
    XcdBarrier xbar = xcd_barrier_post((unsigned*)(ws + WS_BAR), xst);
#define IN(k) (lo <= (k) && (k) < hi)
#define SEAM(k) do { if (IN(k) && IN((k) + 1)) { xcd_barrier(xbar); if (REP(17)) xcd_barrier(xbar); } } while (0)
    if (((PHASE_MASK >> 0) & 1) && IN(0)) { p0_prologue(F); __syncthreads(); if (REP(0)) { p0_prologue(F); __syncthreads(); } } SEAM(0);
    if (((PHASE_MASK >> 1) & 1) && IN(1)) { pg8::EpiZ E{F.z, ZLD}; run_gemm(F.h, F.win, 5120, 1024, E); __syncthreads(); if (REP(1)) { run_gemm(F.h, F.win, 5120, 1024, E); __syncthreads(); } if (REP(18)) { run_gemm(F.h, F.win, 4096, 1024, E); __syncthreads(); } } SEAM(1);
    if (((PHASE_MASK >> 2) & 1) && IN(2)) { if (REP(2)) { p2_prep(F, 0); __syncthreads(); } if (REP(16)) { p2_prep(F, 2); __syncthreads(); } p2_prep(F, 1); __syncthreads(); } SEAM(2);
    if (((PHASE_MASK >> 3) & 1) && IN(3)) { if (REP(14)) { p3_scan(F, 1); __syncthreads(); } if (REP(15)) { p3_scan(F, 2); __syncthreads(); } if (REP(3)) { p3_scan(F, 0); __syncthreads(); } p3_scan(F, 0); __syncthreads(); p3_dsa(F); __syncthreads(); if (REP(10)) { p3_dsa(F); __syncthreads(); } } SEAM(3);
    if (((PHASE_MASK >> 4) & 1) && IN(4)) { p4_post(F); __syncthreads(); if (REP(4)) { p4_post(F); __syncthreads(); } } SEAM(4);
    if (((PHASE_MASK >> 5) & 1) && IN(5)) { pg8::EpiGate<0> E0{F.mg, F.z, ZLD, C_G0}; run_gemm(F.ya, F.wb, 1024, 512, E0); __syncthreads();
                 pg8::EpiGate<1> E1{F.mg, F.z, ZLD, C_G1}; run_gemm(F.yb, F.wb + 1024 * 512, 1024, 512, E1); __syncthreads();
                 if (REP(5)) { run_gemm(F.ya, F.wb, 1024, 512, E0); __syncthreads(); run_gemm(F.yb, F.wb + 1024 * 512, 1024, 512, E1); __syncthreads(); } } SEAM(5);
    if (((PHASE_MASK >> 6) & 1) && IN(6)) { if (REP(6)) { pg8::EpiRes1 Ex{F.in[0], F.xb, F.bonus}; run_gemm(F.mg, F.wo, 1024, 1024, Ex); __syncthreads(); }
                 pg8::EpiRes1 E{F.in[0], F.xb, F.ss1}; run_gemm(F.mg, F.wo, 1024, 1024, E); __syncthreads(); } SEAM(6);
    if (((PHASE_MASK >> 7) & 1) && IN(7)) { pg8::EpiHid E{F.hid, F.ss1}; run_gemm(F.xb, F.wup, 4096, 1024, E); __syncthreads(); if (REP(7)) { run_gemm(F.xb, F.wup, 4096, 1024, E); __syncthreads(); } } SEAM(7);
    if (((PHASE_MASK >> 8) & 1) && IN(8)) { pg8::EpiRes2 E{F.xb, F.out, F.ss2}; run_gemm(F.hid, F.wdn, 1024, 4096, E); __syncthreads(); } SEAM(8);
    if (((PHASE_MASK >> 9) & 1) && IN(9)) { if (REP(9)) { p9_final(F, true); __syncthreads(); } p9_final(F, false); }
#undef IN
#undef SEAM
}

extern "C" void kernel_launch(void* const* d_in, const int* in_sizes, int n_in, void* d_out, int out_size, void* d_ws, size_t ws_size, hipStream_t stream) {
    static int grid = 0;
    if (grid == 0) {
        if (n_in != 20 || out_size != NTOK * DM || ws_size < WS_END) { fprintf(stderr, "kernel_launch: unexpected shapes (n_in %d, out %d, ws %zu < %zu)\n", n_in, out_size, ws_size, (size_t)WS_END); grid = -1; return; }
        int dev = 0, cus = 0, per_cu = 0;
        hipGetDevice(&dev); hipDeviceGetAttribute(&cus, hipDeviceAttributeMultiprocessorCount, dev);
        if (hipFuncSetAttribute((const void*)mega_fwd, hipFuncAttributeMaxDynamicSharedMemorySize, LDS_BYTES) != hipSuccess) { fprintf(stderr, "kernel_launch: hipFuncSetAttribute failed\n"); grid = -1; return; }
        if (hipOccupancyMaxActiveBlocksPerMultiprocessor(&per_cu, (const void*)mega_fwd, NTHR, LDS_BYTES) != hipSuccess || per_cu < 1) { fprintf(stderr, "kernel_launch: occupancy query failed (%d)\n", per_cu); per_cu = 1; }
        (void)hipGetLastError();
        grid = cus * per_cu;
        fprintf(stderr, "kernel_launch: grid %d (%d CUs x %d)\n", grid, cus, per_cu);
    }
    if (grid < 0) return;
    if (hipMemsetAsync((char*)d_ws + WS_BAR, 0, XCD_BAR_WORDS * 4, stream) != hipSuccess) { fprintf(stderr, "kernel_launch: memset of the barrier words failed\n"); return; }
    Args a{};
    for (int i = 0; i < 20; ++i) a.in[i] = (const float*)d_in[i];
    a.out = (float*)d_out; a.ws = (unsigned char*)d_ws;
#if MK_PER_PHASE_LAUNCH
    for (int p = 0; p < NPHASE; ++p) { a.ph_lo = p; a.ph_hi = p + 1; hipLaunchKernelGGL(mega_fwd, dim3(grid), dim3(NTHR), LDS_BYTES, stream, a); }
#else
    a.ph_lo = 0; a.ph_hi = NPHASE;
    void* kargs[] = {&a};
    hipError_t e = hipLaunchCooperativeKernel((const void*)mega_fwd, dim3(grid), dim3(NTHR), kargs, LDS_BYTES, stream);
    if (e != hipSuccess) fprintf(stderr, "kernel_launch: cooperative launch failed: %s (grid %d)\n", hipGetErrorString(e), grid);
#endif
}
```

```cpp
#include <hip/hip_runtime.h>
#include <hip/hip_cooperative_groups.h>
#include <cstdio>
#include <cstdint>
namespace cg = cooperative_groups;

#ifndef MK_PER_PHASE_LAUNCH
#define MK_PER_PHASE_LAUNCH 0
#endif

#ifndef REPEAT_MASK
#define REPEAT_MASK 0
#endif
#define REP(k) ((REPEAT_MASK >> (k)) & 1)
#ifndef TS_SEL
#define TS_SEL -1
#endif

namespace pg8 {
#define PG8_LAS __attribute__((address_space(3)))
typedef unsigned short bf16_t;
typedef short bf16x8 __attribute__((ext_vector_type(8)));
typedef float f32x4 __attribute__((ext_vector_type(4)));
typedef unsigned u32x4 __attribute__((ext_vector_type(4)));
constexpr int BM = 256, BK = 64, HALF = 128, HTB = HALF * BK * 2  , STAGE_BYTES = 8 * HTB, NXCD = 8, WGM = 8;

__host__ __device__ __forceinline__ int lds_byte(int r, int c) { const int st = (r >> 4) * 2 + (c >> 5), rr = r & 15, cc = c & 31, ob = rr * 64 + cc * 2; return st * 1024 + (ob ^ (((ob >> 9) & 1) << 5)); }
__host__ __device__ __forceinline__ void stage_rc(int b, int& R, int& C) { const int st = b / 1024, sb = b % 1024, swz = sb ^ (((sb >> 9) & 1) << 5); R = (st >> 1) * 16 + swz / 64; C = (st & 1) * 32 + (swz % 64) / 2; }
__host__ __device__ __forceinline__ int perm32(int rho) { const int n = rho >> 4, i = rho & 15; return 8 * (i >> 2) + 4 * n + (i & 3); }

struct Unit { int pm, pn; };
struct Gemm { const bf16_t* A; const bf16_t* Bt; int M, N, K; };

struct StaticOrder {
    int nM, nN, nwg, G, c;
    __host__ __device__ void init(int M, int N, int G_, int c_) { nM = M / BM; nN = N / BM; nwg = nM * nN; G = G_; c = c_; }
    __host__ __device__ bool next(int i, Unit& u) const {
        const long L = (long)i * G + c; if (L >= nwg) return false;
        int wgid = (int)L; { const int q = nwg / NXCD, r = nwg % NXCD, xcd = wgid % NXCD, off = wgid / NXCD; wgid = (xcd < r ? xcd * (q + 1) : r * (q + 1) + (xcd - r) * q) + off; }
        const int nig = WGM * nN, gid = wgid / nig, fm = gid * WGM, gsz = (nM - fm) < WGM ? (nM - fm) : WGM;
        u.pm = fm + ((wgid % nig) % gsz); u.pn = (wgid % nig) / gsz; return true;
    }
    __device__ __forceinline__ void a_ready(const Unit&) const {}
    __device__ __forceinline__ void done(const Unit&) const {}
};
__device__ __forceinline__ unsigned cvt_pk_bf16(float lo, float hi) { unsigned r; asm volatile("v_cvt_pk_bf16_f32 %0, %1, %2" : "=v"(r) : "v"(lo), "v"(hi)); return r; }
typedef float f32x2 __attribute__((ext_vector_type(2)));
__device__ __forceinline__ float bflo(unsigned u) { return __uint_as_float(u << 16); }
__device__ __forceinline__ float bfhi(unsigned u) { return __uint_as_float(u & 0xffff0000u); }
__device__ __forceinline__ float sigm(float x) { return 1.0f / (1.0f + __expf(-x)); }

struct EpiZ {
    static constexpr bool PERM = true, AFTER_DRAIN = false;
    bf16_t* O; int ldc;
    __device__ __forceinline__ void operator()(const f32x4 (&acc)[2][2][4][2], const Unit& u, int wr, int wc, int fr, int fq) const {
        const int row0 = u.pm * BM + wr * 64 + fr, col0 = u.pn * BM + wc * 32 + 8 * fq;
#pragma unroll
        for (int ai = 0; ai < 2; ++ai)
#pragma unroll
            for (int m = 0; m < 4; ++m) { bf16_t* rowp = O + (size_t)(row0 + ai * HALF + m * 16) * ldc + col0;
#pragma unroll
                for (int bj = 0; bj < 2; ++bj) { const f32x4 v0 = acc[ai][bj][m][0], v1 = acc[ai][bj][m][1];
                    u32x4 w; w.x = cvt_pk_bf16(v0[0], v0[1]); w.y = cvt_pk_bf16(v0[2], v0[3]); w.z = cvt_pk_bf16(v1[0], v1[1]); w.w = cvt_pk_bf16(v1[2], v1[3]);
                    *(u32x4*)(rowp + bj * HALF) = w; } }
    }
};
template <int MODE> struct EpiGate {
    static constexpr bool PERM = true, AFTER_DRAIN = false;
    bf16_t* O; const bf16_t* Z; int zld; int gcol;
    __device__ __forceinline__ void operator()(const f32x4 (&acc)[2][2][4][2], const Unit& u, int wr, int wc, int fr, int fq) const {
        const int row0 = u.pm * BM + wr * 64 + fr, col0 = u.pn * BM + wc * 32 + 8 * fq;
        u32x4 gn[2], pn[2];
        { const size_t row = (size_t)row0; gn[0] = *(const u32x4*)(Z + row * zld + gcol + col0); gn[1] = *(const u32x4*)(Z + row * zld + gcol + col0 + HALF);
          if (MODE == 1) { pn[0] = *(const u32x4*)(O + row * 1024 + col0); pn[1] = *(const u32x4*)(O + row * 1024 + col0 + HALF); } }
#pragma unroll
        for (int it = 0; it < 8; ++it) { const int ai = it >> 2, m = it & 3; const size_t row = (size_t)(row0 + ai * HALF + m * 16);
            u32x4 gc[2] = {gn[0], gn[1]}, pc[2];
            if (MODE == 1) { pc[0] = pn[0]; pc[1] = pn[1]; }
            if (it < 7) { const size_t rown = (size_t)(row0 + ((it + 1) >> 2) * HALF + ((it + 1) & 3) * 16);
                gn[0] = *(const u32x4*)(Z + rown * zld + gcol + col0); gn[1] = *(const u32x4*)(Z + rown * zld + gcol + col0 + HALF);
                if (MODE == 1) { pn[0] = *(const u32x4*)(O + rown * 1024 + col0); pn[1] = *(const u32x4*)(O + rown * 1024 + col0 + HALF); } }
            bf16_t* op = O + row * 1024 + col0;
#pragma unroll
            for (int bj = 0; bj < 2; ++bj) { const f32x4 v0 = acc[ai][bj][m][0], v1 = acc[ai][bj][m][1]; const u32x4 g = gc[bj];
                float r0 = v0[0] * sigm(bflo(g.x)), r1 = v0[1] * sigm(bfhi(g.x)), r2 = v0[2] * sigm(bflo(g.y)), r3 = v0[3] * sigm(bfhi(g.y));
                float r4 = v1[0] * sigm(bflo(g.z)), r5 = v1[1] * sigm(bfhi(g.z)), r6 = v1[2] * sigm(bflo(g.w)), r7 = v1[3] * sigm(bfhi(g.w));
                if (MODE == 1) { const u32x4 p = pc[bj];
                    r0 += bflo(p.x); r1 += bfhi(p.x); r2 += bflo(p.y); r3 += bfhi(p.y); r4 += bflo(p.z); r5 += bfhi(p.z); r6 += bflo(p.w); r7 += bfhi(p.w); }
                u32x4 w; w.x = cvt_pk_bf16(r0, r1); w.y = cvt_pk_bf16(r2, r3); w.z = cvt_pk_bf16(r4, r5); w.w = cvt_pk_bf16(r6, r7);
                *(u32x4*)(op + bj * HALF) = w; } }
    }
};
struct EpiRes1 {
    static constexpr bool PERM = true, AFTER_DRAIN = false;
    const float* X; bf16_t* XB; float* SS;
    __device__ __forceinline__ void operator()(const f32x4 (&acc)[2][2][4][2], const Unit& u, int wr, int wc, int fr, int fq) const {
        const int row0 = u.pm * BM + wr * 64 + fr, col0 = u.pn * BM + wc * 32 + 8 * fq;
        f32x4 xn[4];
        { const float* xp = X + (size_t)row0 * 1024 + col0; xn[0] = *(const f32x4*)(xp); xn[1] = *(const f32x4*)(xp + 4); xn[2] = *(const f32x4*)(xp + HALF); xn[3] = *(const f32x4*)(xp + HALF + 4); }
#pragma unroll
        for (int it = 0; it < 8; ++it) { const int ai = it >> 2, m = it & 3; const size_t row = (size_t)(row0 + ai * HALF + m * 16); float ssq = 0.f;
            const f32x4 xc[4] = {xn[0], xn[1], xn[2], xn[3]};
            if (it < 7) { const float* xp = X + (size_t)(row0 + ((it + 1) >> 2) * HALF + ((it + 1) & 3) * 16) * 1024 + col0;
                xn[0] = *(const f32x4*)(xp); xn[1] = *(const f32x4*)(xp + 4); xn[2] = *(const f32x4*)(xp + HALF); xn[3] = *(const f32x4*)(xp + HALF + 4); }
#pragma unroll
            for (int bj = 0; bj < 2; ++bj) { const size_t off = row * 1024 + col0 + bj * HALF;
                const f32x4 v0 = acc[ai][bj][m][0] + xc[2 * bj], v1 = acc[ai][bj][m][1] + xc[2 * bj + 1];
                ssq += (v0[0] * v0[0] + v0[1] * v0[1]) + (v0[2] * v0[2] + v0[3] * v0[3]) + (v1[0] * v1[0] + v1[1] * v1[1]) + (v1[2] * v1[2] + v1[3] * v1[3]);
                u32x4 w; w.x = cvt_pk_bf16(v0[0], v0[1]); w.y = cvt_pk_bf16(v0[2], v0[3]); w.z = cvt_pk_bf16(v1[0], v1[1]); w.w = cvt_pk_bf16(v1[2], v1[3]);
                *(u32x4*)(XB + off) = w; }
            ssq += __shfl_xor(ssq, 16); ssq += __shfl_xor(ssq, 32);
            if (fq == 0) atomicAdd(SS + row, ssq); }
    }
};
struct EpiRes2 {
    static constexpr bool PERM = true, AFTER_DRAIN = false;
    bf16_t* XB; float* SS;
    __device__ __forceinline__ void operator()(const f32x4 (&acc)[2][2][4][2], const Unit& u, int wr, int wc, int fr, int fq) const {
        const int row0 = u.pm * BM + wr * 64 + fr, col0 = u.pn * BM + wc * 32 + 8 * fq;
        u32x4 xn[2];
        { const bf16_t* xp = XB + (size_t)row0 * 1024 + col0; xn[0] = *(const u32x4*)(xp); xn[1] = *(const u32x4*)(xp + HALF); }
#pragma unroll
        for (int it = 0; it < 8; ++it) { const int ai = it >> 2, m = it & 3; const size_t row = (size_t)(row0 + ai * HALF + m * 16); float ssq = 0.f;
            const u32x4 xc[2] = {xn[0], xn[1]};
            if (it < 7) { const bf16_t* xp = XB + (size_t)(row0 + ((it + 1) >> 2) * HALF + ((it + 1) & 3) * 16) * 1024 + col0; xn[0] = *(const u32x4*)(xp); xn[1] = *(const u32x4*)(xp + HALF); }
#pragma unroll
            for (int bj = 0; bj < 2; ++bj) { const size_t off = row * 1024 + col0 + bj * HALF;
                const u32x4 xw = xc[bj]; f32x4 v0 = acc[ai][bj][m][0], v1 = acc[ai][bj][m][1];
                v0[0] += bflo(xw.x); v0[1] += bfhi(xw.x); v0[2] += bflo(xw.y); v0[3] += bfhi(xw.y); v1[0] += bflo(xw.z); v1[1] += bfhi(xw.z); v1[2] += bflo(xw.w); v1[3] += bfhi(xw.w);
                u32x4 w; w.x = cvt_pk_bf16(v0[0], v0[1]); w.y = cvt_pk_bf16(v0[2], v0[3]); w.z = cvt_pk_bf16(v1[0], v1[1]); w.w = cvt_pk_bf16(v1[2], v1[3]);
                *(u32x4*)(XB + off) = w;
                ssq += (v0[0] * v0[0] + v0[1] * v0[1]) + (v0[2] * v0[2] + v0[3] * v0[3]) + (v1[0] * v1[0] + v1[1] * v1[1]) + (v1[2] * v1[2] + v1[3] * v1[3]); }
            ssq += __shfl_xor(ssq, 16); ssq += __shfl_xor(ssq, 32);
            if (fq == 0) atomicAdd(SS + row, ssq); }
    }
};
struct EpiHid {
    static constexpr bool PERM = true, AFTER_DRAIN = false;
    bf16_t* O; const float* SS;
    __device__ __forceinline__ void operator()(const f32x4 (&acc)[2][2][4][2], const Unit& u, int wr, int wc, int fr, int fq) const {
        const int row0 = u.pm * BM + wr * 64 + fr, col0 = u.pn * BM + wc * 32 + 8 * fq;
#pragma unroll
        for (int ai = 0; ai < 2; ++ai)
#pragma unroll
            for (int m = 0; m < 4; ++m) { const size_t row = (size_t)(row0 + ai * HALF + m * 16);
                const float s2 = 1.0f / (SS[row] * (1.0f / 1024.0f) + 1e-6f);
                bf16_t* rowp = O + row * 4096 + col0;
#pragma unroll
                for (int bj = 0; bj < 2; ++bj) { f32x4 v0 = acc[ai][bj][m][0], v1 = acc[ai][bj][m][1];
#pragma unroll
                    for (int j = 0; j < 4; ++j) { float a = fmaxf(v0[j], 0.f), b = fmaxf(v1[j], 0.f); v0[j] = a * a * s2; v1[j] = b * b * s2; }
                    u32x4 w; w.x = cvt_pk_bf16(v0[0], v0[1]); w.y = cvt_pk_bf16(v0[2], v0[3]); w.z = cvt_pk_bf16(v1[0], v1[1]); w.w = cvt_pk_bf16(v1[2], v1[3]);
                    *(u32x4*)(rowp + bj * HALF) = w; } }
    }
};

template <class Epi, class Sched, bool ALIGN_EPI = false, bool SP2 = false>
__device__ __forceinline__ void gemm_phase(PG8_LAS unsigned char* lds, const Gemm g, const Sched& S, const Epi& E) {
    const int tid = threadIdx.x, wid = __builtin_amdgcn_readfirstlane(tid >> 6), lane = tid & 63, wr = wid >> 2, wc = wid & 3, fr = lane & 15, fq = lane >> 4;
    const int K = g.K, nt = K / BK;
    unsigned voffA[2], voffB[2];
#pragma unroll
    for (int i = 0; i < 2; ++i) { int R, C; stage_rc(tid * 16 + i * 8192, R, C); const int Rb = Epi::PERM ? ((R & ~31) + perm32(R & 31)) : R;
        voffA[i] = (unsigned)(R * K + C) * 2u; voffB[i] = (unsigned)(Rb * K + C) * 2u; }
    const size_t kstep = (size_t)(BK * 2);
    const size_t hstep = (size_t)HALF * K * 2;
    const size_t tstep = 2 * hstep;
    const unsigned ldsw = (unsigned)wid * 1024u;
    const int aoff = lds_byte(wr * 64 + fr, fq * 8), boff = lds_byte(wc * 32 + fr, fq * 8);
#define PG8_SA(b, h) (((b) * 2 + (h)) * HTB)
#define PG8_SB(b, h) ((4 + (b) * 2 + (h)) * HTB)
#define PG8_STAGE(bufoff, gbase, voff) do { _Pragma("unroll") for (int _i = 0; _i < 2; ++_i) \
        __builtin_amdgcn_global_load_lds((const unsigned*)((const char*)(gbase) + (voff)[_i]), (PG8_LAS unsigned*)(lds + (bufoff) + ldsw + _i * 8192), 16, 0, 0); } while (0)
#define PG8_LDA(dst, b, h) do { _Pragma("unroll") for (int m = 0; m < 4; ++m) _Pragma("unroll") for (int k = 0; k < 2; ++k) dst[m][k] = *(const PG8_LAS bf16x8*)(lds + PG8_SA(b, h) + aoff + m * 2048 + k * 1024); } while (0)
#define PG8_LDB(dst, b, h) do { _Pragma("unroll") for (int n = 0; n < 2; ++n) _Pragma("unroll") for (int k = 0; k < 2; ++k) dst[n][k] = *(const PG8_LAS bf16x8*)(lds + PG8_SB(b, h) + boff + n * 2048 + k * 1024); } while (0)
#define PG8_MMA(ai, bj, At, Bt) do { __builtin_amdgcn_s_setprio(1); _Pragma("unroll") for (int m = 0; m < 4; ++m) _Pragma("unroll") for (int n = 0; n < 2; ++n) _Pragma("unroll") for (int k = 0; k < 2; ++k) \
        acc[ai][bj][m][n] = __builtin_amdgcn_mfma_f32_16x16x32_bf16(Bt[n][k], At[m][k], acc[ai][bj][m][n], 0, 0, 0); __builtin_amdgcn_s_setprio(0); } while (0)
#define PG8_WAIT_V(n) asm volatile("s_waitcnt vmcnt(" #n ")" ::: "memory")
#define PG8_WAIT_L(n) asm volatile("s_waitcnt lgkmcnt(" #n ")" ::: "memory")
#define PG8_BAR __builtin_amdgcn_s_barrier()
#define PG8_SCHED __builtin_amdgcn_sched_barrier(0)
    Unit cur, nxt; int ui = 0;
    if (!S.next(0, cur)) return;
    f32x4 acc[2][2][4][2];
#pragma unroll
    for (int a = 0; a < 2; ++a)
#pragma unroll
        for (int b = 0; b < 2; ++b)
#pragma unroll
            for (int m = 0; m < 4; ++m)
#pragma unroll
                for (int n = 0; n < 2; ++n) acc[a][b][m][n] = (f32x4){0.f, 0.f, 0.f, 0.f};
    bf16x8 At[4][2], B0[2][2], B1[2][2];
    const char* cA = (const char*)g.A + (size_t)cur.pm * tstep; const char* cB = (const char*)g.Bt + (size_t)cur.pn * tstep;
    S.a_ready(cur);
    if constexpr (SP2) {
        PG8_STAGE(PG8_SB(0, 0), cB, voffB); PG8_STAGE(PG8_SB(0, 1), cB + hstep, voffB); PG8_STAGE(PG8_SA(0, 0), cA, voffA); PG8_STAGE(PG8_SA(0, 1), cA + hstep, voffA);
        if (wr == 1) PG8_BAR;
        PG8_WAIT_V(2); PG8_BAR;
        PG8_STAGE(PG8_SB(1, 0), cB + kstep, voffB); PG8_STAGE(PG8_SA(1, 0), cA + kstep, voffA); PG8_STAGE(PG8_SB(1, 1), cB + hstep + kstep, voffB);
        PG8_WAIT_V(6); PG8_BAR;
    } else {
        PG8_STAGE(PG8_SB(0, 0), cB, voffB); PG8_STAGE(PG8_SA(0, 0), cA, voffA); PG8_STAGE(PG8_SB(0, 1), cB + hstep, voffB); PG8_STAGE(PG8_SA(0, 1), cA + hstep, voffA);
        if (wr == 1) PG8_BAR;
        PG8_WAIT_V(4); PG8_BAR;
        PG8_STAGE(PG8_SB(1, 0), cB + kstep, voffB); PG8_STAGE(PG8_SA(1, 0), cA + kstep, voffA); PG8_STAGE(PG8_SB(1, 1), cB + hstep + kstep, voffB);
        PG8_WAIT_V(6); PG8_BAR;
    }
    for (;;) {
        const bool has_next = S.next(ui + 1, nxt);
        const char* nA = has_next ? (const char*)g.A + (size_t)nxt.pm * tstep : cA; const char* nB = has_next ? (const char*)g.Bt + (size_t)nxt.pn * tstep : cB;
        for (int t = 0; t < nt; t += 2) {
            const bool last = (t == nt - 2);
            const char* a1 = cA + (size_t)(t + 1) * kstep;
            const char* a2 = last ? nA : cA + (size_t)(t + 2) * kstep; const char* b2 = last ? nB : cB + (size_t)(t + 2) * kstep;
            const char* a3 = a2 + kstep; const char* b3 = b2 + kstep;
            if (last && has_next) S.a_ready(nxt);
            if constexpr (SP2) {
            PG8_LDB(B0, 0, 0); PG8_LDB(B1, 0, 1); PG8_SCHED; PG8_LDA(At, 0, 0); PG8_STAGE(PG8_SA(1, 1), a1 + hstep, voffA);
            PG8_WAIT_V(8); PG8_WAIT_L(0); PG8_BAR; PG8_MMA(0, 0, At, B0); PG8_MMA(0, 1, At, B1); PG8_BAR; PG8_SCHED;
            PG8_LDA(At, 0, 1); PG8_STAGE(PG8_SB(0, 0), b2, voffB); PG8_STAGE(PG8_SB(0, 1), b2 + hstep, voffB); PG8_STAGE(PG8_SA(0, 0), a2, voffA);
            PG8_WAIT_V(8); PG8_WAIT_L(0); PG8_BAR; PG8_MMA(1, 0, At, B0); PG8_MMA(1, 1, At, B1); PG8_BAR; PG8_SCHED;
            PG8_LDB(B0, 1, 0); PG8_LDB(B1, 1, 1); PG8_SCHED; PG8_LDA(At, 1, 0); PG8_STAGE(PG8_SA(0, 1), a2 + hstep, voffA);
            PG8_WAIT_V(8); PG8_WAIT_L(0); PG8_BAR; PG8_MMA(0, 0, At, B0); PG8_MMA(0, 1, At, B1); PG8_BAR; PG8_SCHED;
            PG8_LDA(At, 1, 1); PG8_STAGE(PG8_SB(1, 0), b3, voffB); PG8_STAGE(PG8_SB(1, 1), b3 + hstep, voffB); PG8_STAGE(PG8_SA(1, 0), a3, voffA);
            PG8_WAIT_V(8); PG8_WAIT_L(0); PG8_BAR; PG8_MMA(1, 0, At, B0); PG8_MMA(1, 1, At, B1); PG8_BAR; PG8_SCHED;
            } else {
            PG8_LDB(B0, 0, 0); PG8_SCHED; PG8_LDA(At, 0, 0); PG8_STAGE(PG8_SA(1, 1), a1 + hstep, voffA);
            PG8_WAIT_L(8); PG8_BAR; PG8_WAIT_L(0); PG8_MMA(0, 0, At, B0); PG8_BAR; PG8_SCHED;
            PG8_LDB(B1, 0, 1); PG8_STAGE(PG8_SB(0, 0), b2, voffB);
            PG8_BAR; PG8_WAIT_L(0); PG8_MMA(0, 1, At, B1); PG8_BAR;
            PG8_LDA(At, 0, 1); PG8_STAGE(PG8_SA(0, 0), a2, voffA);
            PG8_BAR; PG8_WAIT_L(0); PG8_MMA(1, 0, At, B0); PG8_BAR; PG8_SCHED;
            PG8_STAGE(PG8_SB(0, 1), b2 + hstep, voffB);
            PG8_WAIT_V(6); PG8_BAR; PG8_MMA(1, 1, At, B1); PG8_BAR;
            PG8_LDB(B0, 1, 0); PG8_SCHED; PG8_LDA(At, 1, 0); PG8_STAGE(PG8_SA(0, 1), a2 + hstep, voffA);
            PG8_WAIT_L(8); PG8_BAR; PG8_WAIT_L(0); PG8_MMA(0, 0, At, B0); PG8_BAR; PG8_SCHED;
            PG8_LDB(B1, 1, 1); PG8_STAGE(PG8_SB(1, 0), b3, voffB);
            PG8_BAR; PG8_WAIT_L(0); PG8_MMA(0, 1, At, B1); PG8_BAR;
            PG8_LDA(At, 1, 1); PG8_STAGE(PG8_SA(1, 0), a3, voffA);
            PG8_BAR; PG8_WAIT_L(0); PG8_MMA(1, 0, At, B0); PG8_BAR; PG8_SCHED;
            PG8_STAGE(PG8_SB(1, 1), b3 + hstep, voffB);
            PG8_WAIT_V(6); PG8_BAR; PG8_MMA(1, 1, At, B1); PG8_BAR;
            }
        }
        if constexpr (ALIGN_EPI) { if (wr == 0) PG8_BAR; }
        if constexpr (!Epi::AFTER_DRAIN) { E(acc, cur, wr, wc, fr, fq); S.done(cur); }
        if (!has_next) break;
#pragma unroll
        for (int a = 0; a < 2; ++a)
#pragma unroll
            for (int b = 0; b < 2; ++b)
#pragma unroll
                for (int m = 0; m < 4; ++m)
#pragma unroll
                    for (int n = 0; n < 2; ++n) acc[a][b][m][n] = (f32x4){0.f, 0.f, 0.f, 0.f};
        cur = nxt; cA = nA; cB = nB; ++ui;
        if constexpr (ALIGN_EPI) { if (wr == 1) PG8_BAR; }
    }
    PG8_WAIT_V(0);
    if constexpr (!ALIGN_EPI) { if (wr == 0) PG8_BAR; }
    PG8_BAR;
    if constexpr (Epi::AFTER_DRAIN) { E.fused(acc, cur, wr, wc, fr, fq, lds, wid, lane); S.done(cur); }
#undef PG8_SA
#undef PG8_SB
#undef PG8_STAGE
#undef PG8_LDA
#undef PG8_LDB
#undef PG8_MMA
#undef PG8_WAIT_V
#undef PG8_WAIT_L
#undef PG8_BAR
#undef PG8_SCHED
}
}
extern __shared__ __attribute__((aligned(16))) unsigned char g_lds[];
using pg8::bf16_t; using pg8::bf16x8; using pg8::f32x4; using pg8::u32x4; using pg8::cvt_pk_bf16; using pg8::bflo; using pg8::bfhi; using pg8::sigm;

constexpr int NTOK = 32768, DM = 1024, SEQ = 2048, NB = 16, ZLD = 5120, NTHR = 512;
constexpr int C_R = 0, C_K = 512, C_V = 1024, C_WD = 1536, C_AD = 1600, C_GD = 1664;
constexpr int C_Q = 1824, C_KA = 2336, C_VA = 2400, C_QI = 2464, C_KI = 2976, C_WI = 3040, C_G0 = 3048, C_G1 = 4072;
constexpr size_t MiB = 1024 * 1024;
constexpr size_t WS_SS1 = 0, WS_SS2 = 128 * 1024, WS_BONUS = 256 * 1024, WS_ROPE = 1280 * 1024, WS_WD = 1792 * 1024, WS_WI = 1856 * 1024, WS_WG = 1920 * 1024;
constexpr size_t WS_WIN = 4 * MiB, WS_WUP = 14 * MiB, WS_WDN = 22 * MiB, WS_WB = 30 * MiB, WS_WO = 32 * MiB, WS_VT = 34 * MiB, WS_H = 38 * MiB, WS_Z = 102 * MiB, WS_P = 422 * MiB, WS_END = 486 * MiB;
constexpr int LDS_BYTES = 163840;

struct Args { const float* in[20]; float* out; unsigned char* ws; int ph_lo, ph_hi; };

struct Frame {
    const float* in[20]; float* out; unsigned char* ws; unsigned char* lds; int tid, lane, wave;
    float *ss1, *ss2, *bonus; float2* rope; bf16_t *wd, *wi, *wg, *win, *wup, *wdn, *wb, *wo, *vt, *h, *ya, *yb, *xb, *z, *hid, *lw, *ic, *mg, *gt; float* yraw;
};

__device__ __forceinline__ bf16_t f2bf(float f) { return (bf16_t)(cvt_pk_bf16(f, 0.f) & 0xffffu); }
__device__ __forceinline__ float bf2f(bf16_t b) { return __uint_as_float(((unsigned)b) << 16); }
template <int CTRL> __device__ __forceinline__ float dpp_mov(float x) { return __int_as_float(__builtin_amdgcn_update_dpp(0, __float_as_int(x), CTRL, 0xF, 0xF, true)); }
__device__ __forceinline__ float red16(float x) { x += dpp_mov<0xB1>(x); x += dpp_mov<0x4E>(x); x += dpp_mov<0x141>(x); x += dpp_mov<0x140>(x); return x; }


__device__ __forceinline__ void lds_barrier() { asm volatile("s_waitcnt lgkmcnt(0)" ::: "memory"); __builtin_amdgcn_s_barrier(); asm volatile("" ::: "memory"); }
__device__ __forceinline__ void red16x4(float& a, float& b, float& c, float& d) {
#define DPP4(ctl) "v_add_f32_dpp %0, %0, %0 " ctl " row_mask:0xf bank_mask:0xf bound_ctrl:1\n" "v_add_f32_dpp %1, %1, %1 " ctl " row_mask:0xf bank_mask:0xf bound_ctrl:1\n" \
                  "v_add_f32_dpp %2, %2, %2 " ctl " row_mask:0xf bank_mask:0xf bound_ctrl:1\n" "v_add_f32_dpp %3, %3, %3 " ctl " row_mask:0xf bank_mask:0xf bound_ctrl:1\n"
    asm volatile("s_nop 1\n" DPP4("quad_perm:[1,0,3,2]") DPP4("quad_perm:[2,3,0,1]") DPP4("row_half_mirror") DPP4("row_mirror") : "+v"(a), "+v"(b), "+v"(c), "+v"(d));
#undef DPP4
}
__device__ __forceinline__ float red32(float x) { x += __shfl_xor(x, 1); x += __shfl_xor(x, 2); x += __shfl_xor(x, 4); x += __shfl_xor(x, 8); x += __shfl_xor(x, 16); return x; }
__device__ __forceinline__ float red64(float x) { x = red32(x); x += __shfl_xor(x, 32); return x; }
__device__ __forceinline__ float softplus_f(float x) { return fmaxf(x, 0.f) + log1pf(__expf(-fabsf(x))); }

__device__ __forceinline__ void tconv(const Frame& F, const float* __restrict__ W, int K, int N, int Npad, bf16_t* __restrict__ Wt, const float* __restrict__ rs) {
    float* tile = (float*)g_lds;
    const int ktn = (K + 63) / 64, ntn = Npad / 64, tid = F.tid;
    for (int tl = blockIdx.x; tl < ktn * ntn; tl += gridDim.x) {
        const int kt = tl % ktn, nt = tl / ktn;
#pragma unroll
        for (int i = 0; i < 2; ++i) { const int idx = tid + i * NTHR, kk = idx >> 4, n4 = (idx & 15) * 4, k = kt * 64 + kk, n = nt * 64 + n4;
            f32x4 v = {0.f, 0.f, 0.f, 0.f};
            if (k < K) { if (n + 3 < N) v = *(const f32x4*)(W + (size_t)k * N + n); else { for (int j = 0; j < 4; ++j) if (n + j < N) v[j] = W[(size_t)k * N + n + j]; }
                if (rs != nullptr) { const float r = rs[k]; v[0] *= r; v[1] *= r; v[2] *= r; v[3] *= r; } }
            tile[kk * 65 + n4] = v[0]; tile[kk * 65 + n4 + 1] = v[1]; tile[kk * 65 + n4 + 2] = v[2]; tile[kk * 65 + n4 + 3] = v[3]; }
        __syncthreads();
        { const int nn = tid >> 3, k8 = (tid & 7) * 8, k = kt * 64 + k8, n = nt * 64 + nn;
          if (k < K) { u32x4 w; const float* tp = tile + k8 * 65 + nn;
              w.x = cvt_pk_bf16(tp[0], tp[65]); w.y = cvt_pk_bf16(tp[130], tp[195]); w.z = cvt_pk_bf16(tp[260], tp[325]); w.w = cvt_pk_bf16(tp[390], tp[455]);
              *(u32x4*)(Wt + (size_t)n * K + k) = w; } }
        __syncthreads();
    }
}
__device__ __forceinline__ void p0_prologue(const Frame& F) {
    const int tid = F.tid, gtid = blockIdx.x * NTHR + tid, gn = gridDim.x * NTHR;
    for (int i = gtid; i < 2 * NTOK; i += gn) F.ss1[i] = 0.f;
    for (int i = gtid; i < SEQ * 32; i += gn) { const int pos = i >> 5, j = i & 31;
        const float inv = 1.0f / powf(10000.0f, (float)(2 * j) / 64.0f); const float ang = (float)pos * inv;
        double rev = (double)ang * 0.15915494309189535; rev -= floor(rev); const float fr = (float)rev;
        F.rope[i] = make_float2(__builtin_amdgcn_cosf(fr), __builtin_amdgcn_sinf(fr)); }
    tconv(F, F.in[2], 1024, 5096, 5120, F.win, nullptr);
    tconv(F, F.in[17], 1024, 4096, 4096, F.wup, F.in[16]);
    tconv(F, F.in[18], 4096, 1024, 1024, F.wdn, nullptr);
    tconv(F, F.in[14], 512, 1024, 1024, F.wb, nullptr);
    tconv(F, F.in[14] + 512 * 1024, 512, 1024, 1024, F.wb + 1024 * 512, nullptr);
    tconv(F, F.in[15], 1024, 1024, 1024, F.wo, nullptr);
    tconv(F, F.in[5], 64, 512, 512, F.wd, nullptr);
    tconv(F, F.in[7], 64, 512, 512, F.wi, nullptr);
    tconv(F, F.in[8], 160, 512, 512, F.wg, nullptr);
    const float* x = F.in[0]; const float* g = F.in[1]; const int lane = F.lane;
    const int rstep = gridDim.x * 8;
    f32x4 gq[4];
#pragma unroll
    for (int i = 0; i < 4; ++i) gq[i] = *(const f32x4*)(g + (i >> 1) * 512 + lane * 8 + (i & 1) * 4);
    for (int row = blockIdx.x * 8 + F.wave; row < NTOK; row += 2 * rstep) {
        const int row2 = (row + rstep) < NTOK ? row + rstep : row; const bool two = row2 != row;
        const float* xr = x + (size_t)row * DM; const float* xr2 = x + (size_t)row2 * DM; f32x4 v[4], u[4]; float ss = 0.f, ss2 = 0.f;
#pragma unroll
        for (int i = 0; i < 4; ++i) { v[i] = __builtin_nontemporal_load((const f32x4*)(xr + (i >> 1) * 512 + lane * 8 + (i & 1) * 4)); u[i] = __builtin_nontemporal_load((const f32x4*)(xr2 + (i >> 1) * 512 + lane * 8 + (i & 1) * 4)); }
#pragma unroll
        for (int i = 0; i < 4; ++i) { ss += v[i][0] * v[i][0] + v[i][1] * v[i][1] + v[i][2] * v[i][2] + v[i][3] * v[i][3]; ss2 += u[i][0] * u[i][0] + u[i][1] * u[i][1] + u[i][2] * u[i][2] + u[i][3] * u[i][3]; }
        ss = red64(ss); ss2 = red64(ss2); const float sc = rsqrtf(ss * (1.0f / 1024.0f) + 1e-6f), sc2 = rsqrtf(ss2 * (1.0f / 1024.0f) + 1e-6f);
#pragma unroll
        for (int i = 0; i < 2; ++i) { const f32x4 a = v[2 * i] * gq[2 * i] * sc, b2 = v[2 * i + 1] * gq[2 * i + 1] * sc, a2 = u[2 * i] * gq[2 * i] * sc2, b3 = u[2 * i + 1] * gq[2 * i + 1] * sc2; u32x4 w, w2;
            w.x = cvt_pk_bf16(a[0], a[1]); w.y = cvt_pk_bf16(a[2], a[3]); w.z = cvt_pk_bf16(b2[0], b2[1]); w.w = cvt_pk_bf16(b2[2], b2[3]);
            w2.x = cvt_pk_bf16(a2[0], a2[1]); w2.y = cvt_pk_bf16(a2[2], a2[3]); w2.z = cvt_pk_bf16(b3[0], b3[1]); w2.w = cvt_pk_bf16(b3[2], b3[3]);
            *(u32x4*)(F.h + (size_t)row * DM + i * 512 + lane * 8) = w; if (two) *(u32x4*)(F.h + (size_t)row2 * DM + i * 512 + lane * 8) = w2; }
    }
}

__device__ __forceinline__ void p2_prep(const Frame& F, const int mode) {
    const int tid = F.tid, lane = F.lane, wave = F.wave, fr = lane & 15, fq = lane >> 4;
    bf16_t* z = F.z; const float* mu = F.in[3];
    if (mode != 2) {
        constexpr int LDA = 296, TT = 32; bf16_t* At = (bf16_t*)g_lds;
        bf16_t* Ot = At + TT * LDA;
        const float* dbias = F.in[4]; const float* ibias = F.in[6];
        for (int tile = blockIdx.x; tile < NTOK / TT; tile += gridDim.x) {
            const int t0 = tile * TT;
            for (int idx = tid; idx < TT * 36; idx += NTHR) { const int tok = idx / 36, c8 = (idx - tok * 36) * 8, t = t0 + tok, col = C_WD + c8;
                const u32x4 zc = *(const u32x4*)(z + (size_t)t * ZLD + col); u32x4 zp = {0u, 0u, 0u, 0u}; if (t & (SEQ - 1)) zp = *(const u32x4*)(z + (size_t)(t - 1) * ZLD + col);
                const f32x4 m0 = *(const f32x4*)(mu + col), m1 = *(const f32x4*)(mu + col + 4);
                float v[8]; const unsigned zcu[4] = {zc.x, zc.y, zc.z, zc.w}, zpu[4] = {zp.x, zp.y, zp.z, zp.w};
#pragma unroll
                for (int j = 0; j < 4; ++j) { const float a = bflo(zcu[j]), b2 = bfhi(zcu[j]), pa = bflo(zpu[j]), pb = bfhi(zpu[j]);
                    const float mm0 = (j < 2) ? m0[2 * j] : m1[2 * j - 4], mm1 = (j < 2) ? m0[2 * j + 1] : m1[2 * j - 3];
                    v[2 * j] = a + (pa - a) * mm0; v[2 * j + 1] = b2 + (pb - b2) * mm1; }
                if (c8 < 64) {
#pragma unroll
                    for (int j = 0; j < 8; ++j) v[j] = tanhf(v[j]); }
                else if (c8 >= 128) {
#pragma unroll
                    for (int j = 0; j < 8; ++j) v[j] = sigm(v[j]); }
                u32x4 w; w.x = cvt_pk_bf16(v[0], v[1]); w.y = cvt_pk_bf16(v[2], v[3]); w.z = cvt_pk_bf16(v[4], v[5]); w.w = cvt_pk_bf16(v[6], v[7]);
                *(u32x4*)(At + tok * LDA + c8) = w; }
            __syncthreads();
            const int h = wave;
            bf16x8 Bc[9], Bn[9];
            { const int n = h * 64 + fr;
#pragma unroll
              for (int ks = 0; ks < 2; ++ks) { Bc[ks] = *(const bf16x8*)(F.wd + n * 64 + ks * 32 + fq * 8); Bc[2 + ks] = *(const bf16x8*)(F.wi + n * 64 + ks * 32 + fq * 8); }
#pragma unroll
              for (int ks = 0; ks < 5; ++ks) Bc[4 + ks] = *(const bf16x8*)(F.wg + n * 160 + ks * 32 + fq * 8); }
#pragma unroll 1
            for (int j = 0; j < 4; ++j) { const int n = h * 64 + j * 16 + fr;
                if (j < 3) { const int nn = n + 16;
#pragma unroll
                    for (int ks = 0; ks < 2; ++ks) { Bn[ks] = *(const bf16x8*)(F.wd + nn * 64 + ks * 32 + fq * 8); Bn[2 + ks] = *(const bf16x8*)(F.wi + nn * 64 + ks * 32 + fq * 8); }
#pragma unroll
                    for (int ks = 0; ks < 5; ++ks) Bn[4 + ks] = *(const bf16x8*)(F.wg + nn * 160 + ks * 32 + fq * 8); }
                const float db = dbias[n], ib = ibias[n];
#pragma unroll
                for (int mt = 0; mt < 2; ++mt) {
                    f32x4 ad = {0.f, 0.f, 0.f, 0.f}, ai = ad, ag = ad; const bf16_t* ap = At + (mt * 16 + fr) * LDA + fq * 8;
#pragma unroll
                    for (int ks = 0; ks < 2; ++ks) ad = __builtin_amdgcn_mfma_f32_16x16x32_bf16(*(const bf16x8*)(ap + ks * 32), Bc[ks], ad, 0, 0, 0);
#pragma unroll
                    for (int ks = 0; ks < 2; ++ks) ai = __builtin_amdgcn_mfma_f32_16x16x32_bf16(*(const bf16x8*)(ap + 64 + ks * 32), Bc[2 + ks], ai, 0, 0, 0);
#pragma unroll
                    for (int ks = 0; ks < 5; ++ks) ag = __builtin_amdgcn_mfma_f32_16x16x32_bf16(*(const bf16x8*)(ap + 128 + ks * 32), Bc[4 + ks], ag, 0, 0, 0);
#pragma unroll
                    for (int jj = 0; jj < 4; ++jj) {
                        const float dw = db + ad[jj]; const float wlog = -softplus_f(-dw) - 0.5f; const float lwv = -__expf(wlog);
                        const int tk = mt * 16 + fq * 4 + jj; Ot[tk * 520 + n] = f2bf(lwv); Ot[(TT + tk) * 520 + n] = f2bf(sigm(ib + ai[jj])); Ot[(2 * TT + tk) * 520 + n] = f2bf(ag[jj]); }
                }
#pragma unroll
                for (int q = 0; q < 9; ++q) Bc[q] = Bn[q];
            }
            __syncthreads();
#pragma unroll
            for (int i = 0; i < 12; ++i) { const int idx = tid + i * NTHR, arr = idx >> 11, rem = idx & 2047, tk = rem >> 6, c8 = (rem & 63) * 8;
                const u32x4 w = *(const u32x4*)(Ot + (arr * TT + tk) * 520 + c8); bf16_t* dst = arr == 0 ? F.lw : (arr == 1 ? F.ic : F.gt);
                *(u32x4*)(dst + (size_t)(t0 + tk) * 512 + c8) = w; }
            __syncthreads();
        }
    }
    if (mode != 2) {
        unsigned short* tl = (unsigned short*)g_lds;
        for (int tile = blockIdx.x; tile < NTOK / 64; tile += gridDim.x) { const int t0 = tile * 64, b = t0 / SEQ, tt0 = t0 % SEQ;
            { const int tok = tid >> 3, d8 = (tid & 7) * 8; *(u32x4*)(tl + tok * 72 + d8) = *(const u32x4*)(z + (size_t)(t0 + tok) * ZLD + C_VA + d8); }
            __syncthreads();
            { const int d = tid >> 3, k8 = (tid & 7) * 8; unsigned short e[8];
#pragma unroll
              for (int j = 0; j < 8; ++j) e[j] = tl[(k8 + j) * 72 + d];
              u32x4 w; w.x = e[0] | ((unsigned)e[1] << 16); w.y = e[2] | ((unsigned)e[3] << 16); w.z = e[4] | ((unsigned)e[5] << 16); w.w = e[6] | ((unsigned)e[7] << 16);
              *(u32x4*)(F.vt + ((size_t)b * 64 + d) * SEQ + tt0 + k8) = w; }
            __syncthreads();
        }
    }
    if (mode != 0) {
        const int gtid = blockIdx.x * NTHR + tid, gn = gridDim.x * NTHR;
        for (int idx = gtid; idx < NTOK * 72; idx += gn) { const int t = idx / 72, p = idx - t * 72, hd = p >> 2, i8 = (p & 3) * 8;
            const int base = hd < 8 ? C_Q + hd * 64 : (hd == 8 ? C_KA : (hd < 17 ? C_QI + (hd - 9) * 64 : C_KI));
            const float* rp = (const float*)&F.rope[(t & (SEQ - 1)) * 32 + i8];
            f32x4 cs[4];
#pragma unroll
            for (int j = 0; j < 4; ++j) { cs[j] = *(const f32x4*)(rp + 4 * j); if (mode == 2) cs[j] = (f32x4){1.f, 0.f, 1.f, 0.f}; }
            bf16_t* p1 = z + (size_t)t * ZLD + base + i8; const u32x4 a = *(const u32x4*)(p1), b2 = *(const u32x4*)(p1 + 32);
            const unsigned au[4] = {a.x, a.y, a.z, a.w}, bu[4] = {b2.x, b2.y, b2.z, b2.w}; unsigned o1[4], o2[4];
#pragma unroll
            for (int j = 0; j < 4; ++j) { const float x1a = bflo(au[j]), x1b = bfhi(au[j]), x2a = bflo(bu[j]), x2b = bfhi(bu[j]);
                o1[j] = cvt_pk_bf16(x1a * cs[j][0] - x2a * cs[j][1], x1b * cs[j][2] - x2b * cs[j][3]);
                o2[j] = cvt_pk_bf16(x2a * cs[j][0] + x1a * cs[j][1], x2b * cs[j][2] + x1b * cs[j][3]); }
            u32x4 w1, w2; w1.x = o1[0]; w1.y = o1[1]; w1.z = o1[2]; w1.w = o1[3]; w2.x = o2[0]; w2.y = o2[1]; w2.z = o2[2]; w2.w = o2[3];
            *(u32x4*)(p1) = w1; *(u32x4*)(p1 + 32) = w2; }
    }
}

struct ScanRaw { uint2 zr_c, zr_p, zk_c, zk_p, zv_c, zv_p, lwu, icu; };
struct ScanConst { f32x4 mur, muk, muv, kk, ka, rk; };
__device__ __forceinline__ void scan_load(ScanRaw& R, const bf16_t* z, const bf16_t* lw, const bf16_t* ic, size_t tokbase, int ch, int ptok, int gc) {
    const int t = ch * 16 + ptok; const size_t T = tokbase + t; const bf16_t* zp = z + T * ZLD + gc;
    R.zr_c = *(const uint2*)(zp + C_R); R.zk_c = *(const uint2*)(zp + C_K); R.zv_c = *(const uint2*)(zp + C_V);
    const uint2 zz = make_uint2(0u, 0u);
    if (t > 0) { R.zr_p = *(const uint2*)(zp - ZLD + C_R); R.zk_p = *(const uint2*)(zp - ZLD + C_K); R.zv_p = *(const uint2*)(zp - ZLD + C_V); } else { R.zr_p = zz; R.zk_p = zz; R.zv_p = zz; }
    R.lwu = *(const uint2*)(lw + T * 512 + gc); R.icu = *(const uint2*)(ic + T * 512 + gc);
}
__device__ __forceinline__ f32x4 unpack4(uint2 u) { f32x4 r; r[0] = bflo(u.x); r[1] = bfhi(u.x); r[2] = bflo(u.y); r[3] = bfhi(u.y); return r; }
__device__ __forceinline__ void scan_prep(const ScanRaw& R, const ScanConst& C, float* ops, float* vv, float* bonus_out, bool wr_bonus, int ptok, int pc, int v0) {
    const f32x4 rc = unpack4(R.zr_c), rp = unpack4(R.zr_p), kc = unpack4(R.zk_c), kp = unpack4(R.zk_p), vc = unpack4(R.zv_c), vp = unpack4(R.zv_p), ic = unpack4(R.icu), lw = unpack4(R.lwu);
    const f32x4 r = rc + (rp - rc) * C.mur, k = kc + (kp - kc) * C.muk, vs = vc + (vp - vc) * C.muv;
    f32x4 w; w[0] = __expf(lw[0]); w[1] = __expf(lw[1]); w[2] = __expf(lw[2]); w[3] = __expf(lw[3]);
    const f32x4 q = k * C.kk; const float ss = red16((q[0] * q[0] + q[1] * q[1]) + (q[2] * q[2] + q[3] * q[3]));
    const float inv = 1.0f / fmaxf(sqrtf(ss), 1e-12f); const f32x4 n = q * inv;
    const f32x4 kn = k * (1.0f + (ic - 1.0f) * C.ka);
    const f32x4 bt = r * kn * C.rk; const float bon = red16((bt[0] + bt[1]) + (bt[2] + bt[3]));
    if (wr_bonus) *bonus_out = bon;
    float* op = ops + ptok * 320 + pc;
    *(f32x4*)(op) = -n; *(f32x4*)(op + 64) = w; *(f32x4*)(op + 128) = n * ic; *(f32x4*)(op + 192) = kn; *(f32x4*)(op + 256) = r;
    if (pc >= v0 && pc < v0 + 32) *(f32x4*)(vv + ptok * 32 + pc - v0) = vs;
}
__device__ __forceinline__ void p3_scan(const Frame& F, const int mode) {
    const int tid = F.tid;
    float* opsb = (float*)g_lds;
    float* vvb = opsb + 2 * 5120;
    float* yob = vvb + 2 * 512;
    const bf16_t* z = F.z; const float* mu = F.in[3]; const float* k_k = F.in[9]; const float* k_a = F.in[10]; const float* r_k = F.in[11];
    for (int item = blockIdx.x; item < 256; item += gridDim.x) {
        const int bh = item >> 1, half = item & 1, b = bh >> 3, h = bh & 7, v0 = half * 32;
        const size_t tokbase = (size_t)b * SEQ;
        if (F.wave >= 4) {
            const int pt = tid - 256, ptok = pt >> 4, pc = (pt & 15) * 4, gc = h * 64 + pc;
            ScanConst C; C.mur = *(const f32x4*)(mu + C_R + gc); C.muk = *(const f32x4*)(mu + C_K + gc); C.muv = *(const f32x4*)(mu + C_V + gc);
            C.kk = *(const f32x4*)(k_k + gc); C.ka = *(const f32x4*)(k_a + gc); C.rk = *(const f32x4*)(r_k + gc);
            const bool wrb = (half == 0) && ((pt & 15) == 0);
            ScanRaw R;
            scan_load(R, z, F.lw, F.ic, tokbase, 0, ptok, gc);
            scan_prep(R, C, opsb, vvb, F.bonus + (tokbase + ptok) * 8 + h, wrb, ptok, pc, v0);
            scan_load(R, z, F.lw, F.ic, tokbase, 1, ptok, gc);
            lds_barrier();
            for (int ch = 0; ch < SEQ / 16; ++ch) {
                const int cur = ch & 1, nxt = cur ^ 1;
                if (mode != 2) {
                if (ch > 0) { const int tok = pt >> 4, r2 = (pt & 15) * 2;
                    *(float2*)(F.yraw + (tokbase + (ch - 1) * 16 + tok) * 512 + h * 64 + v0 + r2) = *(const float2*)(yob + nxt * 512 + tok * 32 + r2); }
                if (ch + 1 < SEQ / 16) {
                    scan_prep(R, C, opsb + nxt * 5120, vvb + nxt * 512, F.bonus + (tokbase + (ch + 1) * 16 + ptok) * 8 + h, wrb, ptok, pc, v0);
                    if (ch + 2 < SEQ / 16) scan_load(R, z, F.lw, F.ic, tokbase, ch + 2, ptok, gc);
                } }
                lds_barrier();
            }
            { const int tok = pt >> 4, r2 = (pt & 15) * 2;
              *(float2*)(F.yraw + (tokbase + (SEQ / 16 - 1) * 16 + tok) * 512 + h * 64 + v0 + r2) = *(const float2*)(yob + 512 + tok * 32 + r2); }
        } else {
            const int rp = tid >> 4, ks = tid & 15;
            float A0 = 0.f, A1 = 0.f, A2 = 0.f, A3 = 0.f, B0 = 0.f, B1 = 0.f, B2 = 0.f, B3 = 0.f;
            const int ywoff = (ks == 0) ? 2 * rp : (2 * 512 + 2 * tid), ywstep = (ks == 0) ? 32 : 0;
            lds_barrier();
            f32x4 rprev = {0.f, 0.f, 0.f, 0.f}; float* ywp = yob + 2 * 512 + 2 * tid;
            for (int ch = 0; ch < SEQ / 16; ++ch) {
                const int cur = ch & 1;
                const float* ops = opsb + cur * 5120 + ks * 4; const float* vv = vvb + cur * 512 + 2 * rp; float* yw = yob + cur * 512 + ywoff;
                if (mode != 1) {
#pragma unroll
                for (int s = 0; s < 16; ++s) {
                    const float* o = ops + s * 320;
                    const f32x4 a4 = *(const f32x4*)(o), w4 = *(const f32x4*)(o + 64), b4 = *(const f32x4*)(o + 128), k4 = *(const f32x4*)(o + 192), r4 = *(const f32x4*)(o + 256);
                    const float2 vab = *(const float2*)(vv + s * 32);
                    float sa = (A0 * a4[0] + A1 * a4[1]) + (A2 * a4[2] + A3 * a4[3]); float sb = (B0 * a4[0] + B1 * a4[1]) + (B2 * a4[2] + B3 * a4[3]);
                    float ya = (A0 * rprev[0] + A1 * rprev[1]) + (A2 * rprev[2] + A3 * rprev[3]); float yb2 = (B0 * rprev[0] + B1 * rprev[1]) + (B2 * rprev[2] + B3 * rprev[3]);
                    red16x4(sa, sb, ya, yb2);
                    *(float2*)(ywp) = make_float2(ya, yb2);
                    ywp = yw + s * ywstep;
                    A0 = A0 * w4[0] + sa * b4[0] + vab.x * k4[0]; A1 = A1 * w4[1] + sa * b4[1] + vab.x * k4[1];
                    A2 = A2 * w4[2] + sa * b4[2] + vab.x * k4[2]; A3 = A3 * w4[3] + sa * b4[3] + vab.x * k4[3];
                    B0 = B0 * w4[0] + sb * b4[0] + vab.y * k4[0]; B1 = B1 * w4[1] + sb * b4[1] + vab.y * k4[1];
                    B2 = B2 * w4[2] + sb * b4[2] + vab.y * k4[2]; B3 = B3 * w4[3] + sb * b4[3] + vab.y * k4[3];
                    rprev = r4;
                }
                {
                    float ya = (A0 * rprev[0] + A1 * rprev[1]) + (A2 * rprev[2] + A3 * rprev[3]); float yb2 = (B0 * rprev[0] + B1 * rprev[1]) + (B2 * rprev[2] + B3 * rprev[3]);
                    float d0 = 0.f, d1 = 0.f; red16x4(ya, yb2, d0, d1);
                    *(float2*)(ywp) = make_float2(ya, yb2); ywp = yob + 2 * 512 + 2 * tid; rprev = (f32x4){0.f, 0.f, 0.f, 0.f};
                } }
                lds_barrier();
            }
        }
        __syncthreads();
    }
}

__device__ __forceinline__ unsigned ordkey(float f) { const unsigned u = __float_as_uint(f); return (u & 0x80000000u) ? ~u : (u | 0x80000000u); }

__device__ __forceinline__ void attn_chunk(const unsigned char* kb, const unsigned char* vb, const unsigned* selm, int c, int p, int fr, int fq, const bf16x8 (&Bqa)[2][2], f32x4 (&O)[2][4], f32x4 (&RS)[2]) {
    const f32x4 zero4 = {0.f, 0.f, 0.f, 0.f};
    const u32x4 onesu = {0x3f803f80u, 0x3f803f80u, 0x3f803f80u, 0x3f803f80u}; const bf16x8 ones = __builtin_bit_cast(bf16x8, onesu);
    const float csc = 0.125f * 1.4426950408889634f;
    const unsigned char* k0p = kb + ((2 * p) * 16 + fr) * 144 + fq * 16; const unsigned char* k1p = k0p + 16 * 144;
    const bf16x8 KA00 = *(const bf16x8*)(k0p), KA01 = *(const bf16x8*)(k0p + 64), KA10 = *(const bf16x8*)(k1p), KA11 = *(const bf16x8*)(k1p + 64);
    const int mw = (int)selm[fr * 64 + 2 * c + p];
    bf16x8 VA[4];
#pragma unroll
    for (int dt = 0; dt < 4; ++dt) { const unsigned char* vp = vb + (dt * 16 + fr) * 144 + (2 * p) * 32 + fq * 8;
        const uint2 lo = *(const uint2*)(vp), hi = *(const uint2*)(vp + 32);
        u32x4 va; va.x = lo.x; va.y = lo.y; va.z = hi.x; va.w = hi.y; VA[dt] = __builtin_bit_cast(bf16x8, va); }
    unsigned km0[4], km1[4];
#pragma unroll
    for (int jj = 0; jj < 4; ++jj) { km0[jj] = (unsigned)__builtin_amdgcn_sbfe(mw, fq * 4 + jj, 1); km1[jj] = (unsigned)__builtin_amdgcn_sbfe(mw, 16 + fq * 4 + jj, 1); }
#pragma unroll
    for (int hh = 0; hh < 2; ++hh) {
        f32x4 s0 = __builtin_amdgcn_mfma_f32_16x16x32_bf16(KA00, Bqa[hh][0], zero4, 0, 0, 0); s0 = __builtin_amdgcn_mfma_f32_16x16x32_bf16(KA01, Bqa[hh][1], s0, 0, 0, 0);
        f32x4 s1 = __builtin_amdgcn_mfma_f32_16x16x32_bf16(KA10, Bqa[hh][0], zero4, 0, 0, 0); s1 = __builtin_amdgcn_mfma_f32_16x16x32_bf16(KA11, Bqa[hh][1], s1, 0, 0, 0);
        unsigned p0[4], p1[4];
#pragma unroll
        for (int jj = 0; jj < 4; ++jj) {
            p0[jj] = __float_as_uint(__builtin_amdgcn_exp2f(fminf(s0[jj] * csc, 86.f))) & km0[jj]; p1[jj] = __float_as_uint(__builtin_amdgcn_exp2f(fminf(s1[jj] * csc, 86.f))) & km1[jj]; }
        u32x4 pk; pk.x = cvt_pk_bf16(__uint_as_float(p0[0]), __uint_as_float(p0[1])); pk.y = cvt_pk_bf16(__uint_as_float(p0[2]), __uint_as_float(p0[3]));
        pk.z = cvt_pk_bf16(__uint_as_float(p1[0]), __uint_as_float(p1[1])); pk.w = cvt_pk_bf16(__uint_as_float(p1[2]), __uint_as_float(p1[3]));
        const bf16x8 PB = __builtin_bit_cast(bf16x8, pk);
        RS[hh] = __builtin_amdgcn_mfma_f32_16x16x32_bf16(ones, PB, RS[hh], 0, 0, 0);
#pragma unroll
        for (int dt = 0; dt < 4; ++dt) O[hh][dt] = __builtin_amdgcn_mfma_f32_16x16x32_bf16(VA[dt], PB, O[hh][dt], 0, 0, 0);
    }
}

__device__ __forceinline__ void p3_dsa(const Frame& F) {
    const int tid = F.tid, lane = F.lane, wave = F.wave, fr = lane & 15, fq = lane >> 4;
    unsigned* scl = (unsigned*)g_lds;
    unsigned* selm = (unsigned*)(g_lds + 131328);
    unsigned char* kbuf = (unsigned char*)g_lds;
    unsigned char* vbuf = kbuf + 2 * 9216;
    const bf16_t* z = F.z; const int G = gridDim.x, bx = blockIdx.x;
    const f32x4 zero4 = {0.f, 0.f, 0.f, 0.f};
    for (int rnd = 0; rnd * G < 2048; ++rnd) {
        const int n = rnd * G + ((rnd & 1) ? (G - 1 - bx) : bx);
        if (n >= 2048) continue;
        const int qg = 127 - (n >> 4), b = n & 15, q0 = qg * 16; const size_t Tb = (size_t)b * SEQ;
        for (int i = tid; i < 1024; i += NTHR) selm[i] = 0u;
        __syncthreads();
        const bf16_t* zq = z + (Tb + q0 + fr) * ZLD;
        const unsigned lofk = (unsigned)((fr * ZLD + fq * 8) * 2), lofv = (unsigned)((fr * SEQ + fq * 4) * 2);
        const int nchunk = (qg + 4) >> 2; const int lrow = tid >> 3, lseg = tid & 7;
        const bf16_t* kg = z + (Tb + lrow) * ZLD + C_KA + lseg * 8; const bf16_t* vg = F.vt + ((size_t)b * 64 + lrow) * SEQ + lseg * 8;
        const unsigned lst = (unsigned)(lrow * 144 + lseg * 16);
        const int hp = wave >> 1, kh = wave & 1;
        const u32x4 kc0 = *(const u32x4*)(kg), vc0 = *(const u32x4*)(vg);
        u32x4 kx = kc0, vx = vc0, ky = kc0, vy = vc0;
        if (1 < nchunk) { kx = *(const u32x4*)(kg + (size_t)64 * ZLD); vx = *(const u32x4*)(vg + 64); }
        if (2 < nchunk) { ky = *(const u32x4*)(kg + (size_t)128 * ZLD); vy = *(const u32x4*)(vg + 128); }
        bf16x8 Bqa[2][2];
#pragma unroll
        for (int hh = 0; hh < 2; ++hh)
#pragma unroll
            for (int ks = 0; ks < 2; ++ks) Bqa[hh][ks] = *(const bf16x8*)(zq + C_Q + (2 * hp + hh) * 64 + ks * 32 + fq * 8);
        if (qg >= 16) {
            const u32x4 wv = *(const u32x4*)(zq + C_WI);
            {
                bf16x8 Bq[8][2];
#pragma unroll
                for (int hh = 0; hh < 8; ++hh)
#pragma unroll
                    for (int ks = 0; ks < 2; ++ks) Bq[hh][ks] = *(const bf16x8*)(zq + C_QI + hh * 64 + ks * 32 + fq * 8);
                const float sc = 0.044194173824159216f;
                float wih[8]; wih[0] = bflo(wv.x) * sc; wih[1] = bfhi(wv.x) * sc; wih[2] = bflo(wv.y) * sc; wih[3] = bfhi(wv.y) * sc; wih[4] = bflo(wv.z) * sc; wih[5] = bfhi(wv.z) * sc; wih[6] = bflo(wv.w) * sc; wih[7] = bfhi(wv.w) * sc;
#pragma unroll 1
                for (int half = 0; half < 2; ++half) {
                    const int ktb = wave + 64 * half; if (ktb > qg) break;
                    bf16x8 W0[2], W1[2];
#pragma unroll
                    for (int j = 0; j < 2; ++j) { const int ktj = (ktb + 8 * j) < qg ? (ktb + 8 * j) : qg; const char* kb = (const char*)(z + (Tb + (size_t)ktj * 16) * ZLD + C_KI);
                        W0[j] = *(const bf16x8*)(kb + lofk); W1[j] = *(const bf16x8*)(kb + lofk + 64); }
#pragma unroll
                    for (int i = 0; i < 8; ++i) { const int kt = ktb + 8 * i;
                        if (kt <= qg) { f32x4 sv = zero4;
#pragma unroll
                            for (int hh = 0; hh < 8; ++hh) { f32x4 acc = __builtin_amdgcn_mfma_f32_16x16x32_bf16(W0[i & 1], Bq[hh][0], zero4, 0, 0, 0);
                                acc = __builtin_amdgcn_mfma_f32_16x16x32_bf16(W1[i & 1], Bq[hh][1], acc, 0, 0, 0);
#pragma unroll
                                for (int jj = 0; jj < 4; ++jj) sv[jj] += wih[hh] * fmaxf(acc[jj], 0.f); }
                            u32x4 w; w.x = ordkey(sv[0]); w.y = ordkey(sv[1]); w.z = ordkey(sv[2]); w.w = ordkey(sv[3]);
                            *(u32x4*)(scl + fr * 2052 + kt * 16 + fq * 4) = w;
                        }
                        if (i + 2 < 8) { const int ktn = (kt + 16) < qg ? (kt + 16) : qg; const char* kb = (const char*)(z + (Tb + (size_t)ktn * 16) * ZLD + C_KI);
                            unsigned lo2 = lofk; asm volatile("" : "+v"(lo2));
                            W0[i & 1] = *(const bf16x8*)(kb + lo2); W1[i & 1] = *(const bf16x8*)(kb + lo2 + 64); }
                    }
                }
            }
            __syncthreads();
#pragma unroll 1
            for (int qq = 0; qq < 2; ++qq) {
                const int q = 2 * wave + qq, qpos = q0 + q;
                unsigned uk[32];
#pragma unroll
                for (int r = 0; r < 32; ++r) { const int key = r * 64 + lane; uk[r] = 0x007fffffu;
                    if (r * 64 <= qpos) { const unsigned v = scl[q * 2052 + key]; uk[r] = (key <= qpos) ? v : 0x007fffffu; } }
                unsigned T = 0u; bool exact = false;
#pragma unroll 1
                for (int bit = 31; bit >= 0; --bit) {
                    const unsigned cand = T | (1u << bit); int c = 0;
#pragma unroll
                    for (int g = 0; g < 4; ++g) {
                        if (g * 512 > qpos) break;
                        unsigned long long m[8];
                        asm("v_cmp_ge_u32_e64 %0, %8, %16\n\tv_cmp_ge_u32_e64 %1, %9, %16\n\tv_cmp_ge_u32_e64 %2, %10, %16\n\tv_cmp_ge_u32_e64 %3, %11, %16\n\t"
                            "v_cmp_ge_u32_e64 %4, %12, %16\n\tv_cmp_ge_u32_e64 %5, %13, %16\n\tv_cmp_ge_u32_e64 %6, %14, %16\n\tv_cmp_ge_u32_e64 %7, %15, %16"
                            : "=&s"(m[0]), "=&s"(m[1]), "=&s"(m[2]), "=&s"(m[3]), "=&s"(m[4]), "=&s"(m[5]), "=&s"(m[6]), "=&s"(m[7])
                            : "v"(uk[g * 8 + 0]), "v"(uk[g * 8 + 1]), "v"(uk[g * 8 + 2]), "v"(uk[g * 8 + 3]), "v"(uk[g * 8 + 4]), "v"(uk[g * 8 + 5]), "v"(uk[g * 8 + 6]), "v"(uk[g * 8 + 7]), "v"(cand));
#pragma unroll
                        for (int j = 0; j < 8; ++j) c += __builtin_popcountll(m[j]);
                    }
                    if (c >= 256) { T = cand; if (c == 256) { exact = true; break; } }
                }
                int need = 0;
                if (!exact) { int c = 0;
#pragma unroll
                    for (int r = 0; r < 32; ++r) c += __builtin_popcountll(__builtin_amdgcn_ballot_w64(uk[r] > T));
                    need = 256 - c; }
#pragma unroll
                for (int r = 0; r < 32; ++r) {
                    if (r * 64 <= qpos) {
                        unsigned long long sel;
                        if (exact) sel = __builtin_amdgcn_ballot_w64(uk[r] >= T);
                        else { sel = __builtin_amdgcn_ballot_w64(uk[r] > T); unsigned long long e = __builtin_amdgcn_ballot_w64(uk[r] == T);
                            const int ne = __builtin_popcountll(e);
                            if (ne <= need) { sel |= e; need -= ne; }
                            else { for (int k = 0; k < need; ++k) { const unsigned long long lb = e & (0ull - e); sel |= lb; e ^= lb; } need = 0; } }
                        if (lane == 0) { selm[q * 64 + 2 * r] = (unsigned)sel; selm[q * 64 + 2 * r + 1] = (unsigned)(sel >> 32); }
                    }
                }
            }
        } else {
            for (int w = tid; w < 1024; w += NTHR) { const int q = w >> 6, word = w & 63, qpos = q0 + q, lo = word * 32;
                selm[w] = (qpos >= lo + 31) ? 0xffffffffu : (qpos < lo ? 0u : ((2u << (qpos - lo)) - 1u)); }
        }
        __syncthreads();
        {
            *(u32x4*)(kbuf + lst) = kc0; *(u32x4*)(vbuf + lst) = vc0;
            f32x4 O[2][4]; f32x4 rs[2];
#pragma unroll
            for (int hh = 0; hh < 2; ++hh) { rs[hh] = zero4;
#pragma unroll
                for (int dt = 0; dt < 4; ++dt) O[hh][dt] = zero4; }
            lds_barrier();
#pragma unroll 1
            for (int c = 0; c < nchunk; c += 2) {
                attn_chunk(kbuf, vbuf, selm, c, kh, fr, fq, Bqa, O, rs);
                if (c + 1 < nchunk) { *(u32x4*)(kbuf + 9216 + lst) = kx; *(u32x4*)(vbuf + 9216 + lst) = vx; }
                if (c + 3 < nchunk) { kx = *(const u32x4*)(kg + (size_t)(c + 3) * 64 * ZLD); vx = *(const u32x4*)(vg + (c + 3) * 64); }
                lds_barrier();
                if (c + 1 < nchunk) {
                    attn_chunk(kbuf + 9216, vbuf + 9216, selm, c + 1, kh, fr, fq, Bqa, O, rs);
                    if (c + 2 < nchunk) { *(u32x4*)(kbuf + lst) = ky; *(u32x4*)(vbuf + lst) = vy; }
                    if (c + 4 < nchunk) { ky = *(const u32x4*)(kg + (size_t)(c + 4) * 64 * ZLD); vy = *(const u32x4*)(vg + (c + 4) * 64); }
                    lds_barrier();
                }
            }
            float* xb = (float*)(vbuf + 2 * 9216) + (size_t)wave * (64 * 17);
            { const int oh = kh ^ 1;
#pragma unroll
              for (int dt = 0; dt < 4; ++dt)
#pragma unroll
                  for (int jj = 0; jj < 4; ++jj) xb[(dt * 4 + jj) * 64 + lane] = (oh == 0) ? O[0][dt][jj] : O[1][dt][jj];
              xb[16 * 64 + lane] = (oh == 0) ? rs[0][0] : rs[1][0]; }
            lds_barrier();
            { const float* pb = (const float*)(vbuf + 2 * 9216) + (size_t)(wave ^ 1) * (64 * 17);
              float tot = ((kh == 0) ? rs[0][0] : rs[1][0]) + pb[16 * 64 + lane];
              const float inv = 1.0f / tot;
              bf16_t* yp = F.yb + (Tb + q0 + fr) * 512 + (2 * hp + kh) * 64 + fq * 4;
#pragma unroll
              for (int dt = 0; dt < 4; ++dt) { float o[4];
#pragma unroll
                  for (int jj = 0; jj < 4; ++jj) o[jj] = (((kh == 0) ? O[0][dt][jj] : O[1][dt][jj]) + pb[(dt * 4 + jj) * 64 + lane]) * inv;
                  uint2 w; w.x = cvt_pk_bf16(o[0], o[1]); w.y = cvt_pk_bf16(o[2], o[3]); *(uint2*)(yp + dt * 16) = w; } }
        }
        __syncthreads();
    }
}

struct P4In { f32x4 y; uint2 vc, vp, gt; float bon; };
__device__ __forceinline__ void p4_load(P4In& I, const Frame& F, int g, int c) { const size_t t = (size_t)(g >> 3); const bf16_t* z = F.z;
    I.y = __builtin_nontemporal_load((const f32x4*)(F.yraw + t * 512 + c)); I.vc = *(const uint2*)(z + t * ZLD + C_V + c); I.vp = make_uint2(0u, 0u); if (t & (SEQ - 1)) I.vp = *(const uint2*)(z + (t - 1) * ZLD + C_V + c);
    { typedef unsigned u32x2v __attribute__((ext_vector_type(2))); const u32x2v gv = __builtin_nontemporal_load((const u32x2v*)(F.gt + t * 512 + c)); I.gt = make_uint2(gv.x, gv.y); } I.bon = F.bonus[t * 8 + (g & 7)]; }
__device__ __forceinline__ void p4_finish(const P4In& I, const Frame& F, int g, int c, const f32x4& m4, const f32x4& w4, const f32x4& b4) { const size_t t = (size_t)(g >> 3);
    const f32x4 y = I.y; const float mean = red16((y[0] + y[1]) + (y[2] + y[3])) * (1.0f / 64.0f); const f32x4 d = y - mean;
    const float var = red16((d[0] * d[0] + d[1] * d[1]) + (d[2] * d[2] + d[3] * d[3])) * (1.0f / 64.0f); const float rstd = rsqrtf(var + 64e-5f);
    f32x4 vcf, vpf, gtf; vcf[0] = bflo(I.vc.x); vcf[1] = bfhi(I.vc.x); vcf[2] = bflo(I.vc.y); vcf[3] = bfhi(I.vc.y); vpf[0] = bflo(I.vp.x); vpf[1] = bfhi(I.vp.x); vpf[2] = bflo(I.vp.y); vpf[3] = bfhi(I.vp.y);
    gtf[0] = bflo(I.gt.x); gtf[1] = bfhi(I.gt.x); gtf[2] = bflo(I.gt.y); gtf[3] = bfhi(I.gt.y);
    const f32x4 vs = vcf + (vpf - vcf) * m4; const f32x4 o = (d * rstd * w4 + b4 + vs * I.bon) * gtf;
    uint2 w; w.x = cvt_pk_bf16(o[0], o[1]); w.y = cvt_pk_bf16(o[2], o[3]); *(uint2*)(F.ya + t * 512 + c) = w; }
__device__ __forceinline__ void p4_post(const Frame& F) {
    const int tid = F.tid; const float* mu = F.in[3]; const float* gnw = F.in[12]; const float* gnb = F.in[13];
    const int gstep = gridDim.x * 32, g0 = blockIdx.x * 32 + (tid >> 4), c = (g0 & 7) * 64 + (tid & 15) * 4;
    const f32x4 m4 = *(const f32x4*)(mu + C_V + c), w4 = *(const f32x4*)(gnw + c), b4 = *(const f32x4*)(gnb + c);
    for (int g = g0; g < NTOK * 8; g += 2 * gstep) { const int g2 = g + gstep; const bool two = g2 < NTOK * 8;
        P4In A, B; p4_load(A, F, g, c); if (two) p4_load(B, F, g2, c);
        p4_finish(A, F, g, c, m4, w4, b4); if (two) p4_finish(B, F, g2, c, m4, w4, b4); }
}

__device__ __forceinline__ void p9_final(const Frame& F, const bool ident) {
    const float* g = F.in[19]; const int lane = F.lane; const int rstep = gridDim.x * 8;
    f32x4 gg[4];
#pragma unroll
    for (int i = 0; i < 4; ++i) gg[i] = *(const f32x4*)(g + (i >> 1) * 512 + lane * 8 + (i & 1) * 4);
    for (int row = blockIdx.x * 8 + F.wave; row < NTOK; row += 2 * rstep) {
        const int row2 = (row + rstep) < NTOK ? row + rstep : row; const bool two = row2 != row;
        u32x4 a[2], b[2];
#pragma unroll
        for (int i = 0; i < 2; ++i) { a[i] = __builtin_nontemporal_load((const u32x4*)(F.xb + (size_t)row * DM + i * 512 + lane * 8)); b[i] = __builtin_nontemporal_load((const u32x4*)(F.xb + (size_t)row2 * DM + i * 512 + lane * 8)); }
        const float sc = ident ? 1.0f : rsqrtf(F.ss2[row] * (1.0f / 1024.0f) + 1e-6f), sc2 = ident ? 1.0f : rsqrtf(F.ss2[row2] * (1.0f / 1024.0f) + 1e-6f);
#pragma unroll
        for (int i = 0; i < 2; ++i) {
            f32x4 v0, v1, u0, u1;
            v0[0] = bflo(a[i].x); v0[1] = bfhi(a[i].x); v0[2] = bflo(a[i].y); v0[3] = bfhi(a[i].y); v1[0] = bflo(a[i].z); v1[1] = bfhi(a[i].z); v1[2] = bflo(a[i].w); v1[3] = bfhi(a[i].w);
            u0[0] = bflo(b[i].x); u0[1] = bfhi(b[i].x); u0[2] = bflo(b[i].y); u0[3] = bfhi(b[i].y); u1[0] = bflo(b[i].z); u1[1] = bfhi(b[i].z); u1[2] = bflo(b[i].w); u1[3] = bfhi(b[i].w);
            if (!ident) { v0 = v0 * gg[2 * i] * sc; v1 = v1 * gg[2 * i + 1] * sc; u0 = u0 * gg[2 * i] * sc2; u1 = u1 * gg[2 * i + 1] * sc2; }
            float* o1 = F.out + (size_t)row * DM + i * 512 + lane * 8; float* o2 = F.out + (size_t)row2 * DM + i * 512 + lane * 8;
            __builtin_nontemporal_store(v0, (f32x4*)o1); __builtin_nontemporal_store(v1, (f32x4*)(o1 + 4));
            if (two) { __builtin_nontemporal_store(u0, (f32x4*)o2); __builtin_nontemporal_store(u1, (f32x4*)(o2 + 4)); } }
    }
}
#define XB_TMO      128
#define XB_XCNT(j)  (256  + 64 * (j))
#define XB_XSUB(j)  (1280 + 64 * (j))
#define XB_XGEN(j)  (2304 + 64 * (j))
#define XB_TOP      3328
#define XB_TOPGEN   3392
#define XCD_BAR_WORDS 3456
#define XB_SPIN_CAP (1u << 18)
#define LAS __attribute__((address_space(3)))

__device__ __forceinline__ unsigned xb_ld(unsigned* p)              { return __hip_atomic_load(p, __ATOMIC_RELAXED, __HIP_MEMORY_SCOPE_AGENT); }
__device__ __forceinline__ unsigned xb_add(unsigned* p, unsigned v) { return __hip_atomic_fetch_add(p, v, __ATOMIC_RELAXED, __HIP_MEMORY_SCOPE_AGENT); }
__device__ __forceinline__ unsigned xb_xcc_id() { return (unsigned)__builtin_amdgcn_s_getreg((3 << 11) | 20) & 0xFu; }
#define XB_SPIN(cond, bar) do { unsigned _sp = 0; while (cond) { __builtin_amdgcn_s_sleep(1); \
    if ((++_sp & 255u) == 0u) { if (xb_ld(&(bar)[XB_TMO])) break; if (_sp > XB_SPIN_CAP) { atomicAdd(&(bar)[XB_TMO], 1u); break; } } } } while (0)

struct XcdBarrier {
    unsigned* bar; unsigned x;
    volatile LAS unsigned* st;
};

__device__ __forceinline__ XcdBarrier xcd_barrier_post(unsigned* bar, volatile LAS unsigned* st) {
    XcdBarrier b; b.bar = bar; b.x = xb_xcc_id(); b.st = st;
    if (threadIdx.x == 0) (void)xb_add(&bar[XB_XCNT(b.x)], 1u);
    return b;
}
__device__ __forceinline__ void xcd_barrier_complete(unsigned* bar, unsigned x, unsigned& nloc, unsigned& nx) {
    const unsigned G = gridDim.x * gridDim.y * gridDim.z;
    unsigned sum, cnt, mine, sp = 0u;
    for (;;) {
        sum = 0u; cnt = 0u; mine = 0u;
#pragma unroll
        for (unsigned j = 0; j < 16; ++j) { const unsigned c = xb_ld(&bar[XB_XCNT(j)]); sum += c; cnt += (c > 0u) ? 1u : 0u; mine = (j == x) ? c : mine; }
        if (sum == G) break;
        __builtin_amdgcn_s_sleep(1);
        if ((++sp & 255u) == 0u) { if (xb_ld(&bar[XB_TMO])) break; if (sp > XB_SPIN_CAP) { atomicAdd(&bar[XB_TMO], 1u); break; } }
    }
    nloc = mine > 0u ? mine : 1u; nx = cnt > 0u ? cnt : 1u;
}

__device__ __forceinline__ void xcd_barrier(const XcdBarrier& b) {
    asm volatile("s_waitcnt vmcnt(0)" ::: "memory");
    __syncthreads();
    if (threadIdx.x == 0) {
        unsigned* bar = b.bar;
        __builtin_amdgcn_s_waitcnt(0);
        unsigned nloc = b.st[0], nx = b.st[1];
        if (nloc == 0u) { xcd_barrier_complete(bar, b.x, nloc, nx); b.st[0] = nloc; b.st[1] = nx; }
        const unsigned old = xb_add(&bar[XB_XSUB(b.x)], 1u);
        const unsigned gen = old / nloc;
        if (old + 1u == (gen + 1u) * nloc) {
            __builtin_amdgcn_fence(__ATOMIC_RELEASE, "agent");
            asm volatile("s_waitcnt vmcnt(0)" ::: "memory");
            const unsigned og = xb_add(&bar[XB_TOP], 1u);
            const unsigned tg = og / nx;
            if (og + 1u == (tg + 1u) * nx) xb_add(&bar[XB_TOPGEN], 1u);
            else XB_SPIN(xb_ld(&bar[XB_TOPGEN]) == tg, bar);
            __builtin_amdgcn_fence(__ATOMIC_ACQUIRE, "agent");
            xb_add(&bar[XB_XGEN(b.x)], 1u);
            asm volatile("s_waitcnt vmcnt(0)" ::: "memory");
        } else {
            XB_SPIN(xb_ld(&bar[XB_XGEN(b.x)]) == gen, bar);
            __builtin_amdgcn_fence(__ATOMIC_ACQUIRE, "agent");
            asm volatile("s_waitcnt vmcnt(0)" ::: "memory");
        }
    }
    __syncthreads();
}
#ifndef PHASE_MASK
#define PHASE_MASK 0x3ff
#endif
#ifndef GEMM_ALIGN
#define GEMM_ALIGN true
#endif
#ifndef GEMM_SP2
#define GEMM_SP2 true
#endif
constexpr int NPHASE = 10;
constexpr size_t WS_BAR = 3 * MiB;
template <class Epi> __device__ __forceinline__ void run_gemm(const bf16_t* A, const bf16_t* Bt, int N, int K, const Epi& E) {
    pg8::Gemm g{A, Bt, NTOK, N, K}; pg8::StaticOrder S; S.init(NTOK, N, (int)gridDim.x, (int)blockIdx.x);
    pg8::gemm_phase<Epi, pg8::StaticOrder, GEMM_ALIGN, GEMM_SP2>((PG8_LAS unsigned char*)g_lds, g, S, E);
}
__global__ void __launch_bounds__(NTHR, 2) mega_fwd(Args args) {
    Frame F;
#pragma unroll
    for (int i = 0; i < 20; ++i) F.in[i] = args.in[i];
    F.out = args.out; F.ws = args.ws; F.lds = nullptr; F.tid = threadIdx.x; F.lane = F.tid & 63; F.wave = __builtin_amdgcn_readfirstlane(F.tid >> 6);
    unsigned char* ws = args.ws;
    F.ss1 = (float*)(ws + WS_SS1); F.ss2 = (float*)(ws + WS_SS2); F.bonus = (float*)(ws + WS_BONUS); F.rope = (float2*)(ws + WS_ROPE);
    F.wd = (bf16_t*)(ws + WS_WD); F.wi = (bf16_t*)(ws + WS_WI); F.wg = (bf16_t*)(ws + WS_WG);
    F.win = (bf16_t*)(ws + WS_WIN); F.wup = (bf16_t*)(ws + WS_WUP); F.wdn = (bf16_t*)(ws + WS_WDN); F.wb = (bf16_t*)(ws + WS_WB); F.wo = (bf16_t*)(ws + WS_WO); F.vt = (bf16_t*)(ws + WS_VT);
    F.h = (bf16_t*)(ws + WS_H); F.ya = F.h; F.yb = F.h + (size_t)NTOK * 512; F.xb = F.h;
    F.z = (bf16_t*)(ws + WS_Z); F.hid = F.z;
    F.lw = (bf16_t*)(ws + WS_P); F.ic = F.lw + (size_t)NTOK * 512; F.mg = F.lw;
    F.yraw = args.out; F.gt = (bf16_t*)(args.out + (size_t)NTOK * 512);
    const int lo = args.ph_lo, hi = args.ph_hi;
    cg::grid_group grid = cg::this_grid();
    if (args.ph_lo < 0) grid.sync();
    volatile LAS unsigned* xst = (volatile LAS unsigned*)(g_lds + LDS_BYTES - 64);
    if (threadIdx.x == 0) { xst[0] = 0u; xst[1] = 0u; }
    __syncthreads();
    XcdBarrier xbar = xcd_barrier_post((unsigned*)(ws + WS_BAR), xst);
#define IN(k) (lo <= (k) && (k) < hi)
#define SEAM(k) do { if (IN(k) && IN((k) + 1)) { xcd_barrier(xbar); if (REP(17)) xcd_barrier(xbar); } } while (0)
    if (((PHASE_MASK >> 0) & 1) && IN(0)) { p0_prologue(F); __syncthreads(); if (REP(0)) { p0_prologue(F); __syncthreads(); } } SEAM(0);
    if (((PHASE_MASK >> 1) & 1) && IN(1)) { pg8::EpiZ E{F.z, ZLD}; run_gemm(F.h, F.win, 5120, 1024, E); __syncthreads(); if (REP(1)) { run_gemm(F.h, F.win, 5120, 1024, E); __syncthreads(); } if (REP(18)) { run_gemm(F.h, F.win, 4096, 1024, E); __syncthreads(); } } SEAM(1);
    if (((PHASE_MASK >> 2) & 1) && IN(2)) { if (REP(2)) { p2_prep(F, 0); __syncthreads(); } if (REP(16)) { p2_prep(F, 2); __syncthreads(); } p2_prep(F, 1); __syncthreads(); } SEAM(2);
    if (((PHASE_MASK >> 3) & 1) && IN(3)) { if (REP(14)) { p3_scan(F, 1); __syncthreads(); } if (REP(15)) { p3_scan(F, 2); __syncthreads(); } if (REP(3)) { p3_scan(F, 0); __syncthreads(); } p3_scan(F, 0); __syncthreads(); p3_dsa(F); __syncthreads(); if (REP(10)) { p3_dsa(F); __syncthreads(); } } SEAM(3);
    if (((PHASE_MASK >> 4) & 1) && IN(4)) { p4_post(F); __syncthreads(); if (REP(4)) { p4_post(F); __syncthreads(); } } SEAM(4);
    if (((PHASE_MASK >> 5) & 1) && IN(5)) { pg8::EpiGate<0> E0{F.mg, F.z, ZLD, C_G0}; run_gemm(F.ya, F.wb, 1024, 512, E0); __syncthreads();
                 pg8::EpiGate<1> E1{F.mg, F.z, ZLD, C_G1}; run_gemm(F.yb, F.wb + 1024 * 512, 1024, 512, E1); __syncthreads();
                 if (REP(5)) { run_gemm(F.ya, F.wb, 1024, 512, E0); __syncthreads(); run_gemm(F.yb, F.wb + 1024 * 512, 1024, 512, E1); __syncthreads(); } } SEAM(5);
    if (((PHASE_MASK >> 6) & 1) && IN(6)) { if (REP(6)) { pg8::EpiRes1 Ex{F.in[0], F.xb, F.bonus}; run_gemm(F.mg, F.wo, 1024, 1024, Ex); __syncthreads(); }
                 pg8::EpiRes1 E{F.in[0], F.xb, F.ss1}; run_gemm(F.mg, F.wo, 1024, 1024, E); __syncthreads(); } SEAM(6);
    if (((PHASE_MASK >> 7) & 1) && IN(7)) { pg8::EpiHid E{F.hid, F.ss1}; run_gemm(F.xb, F.wup, 4096, 1024, E); __syncthreads(); if (REP(7)) { run_gemm(F.xb, F.wup, 4096, 1024, E); __syncthreads(); } } SEAM(7);
    if (((PHASE_MASK >> 8) & 1) && IN(8)) { pg8::EpiRes2 E{F.xb, F.ss2}; run_gemm(F.hid, F.wdn, 1024, 4096, E); __syncthreads(); } SEAM(8);
    if (((PHASE_MASK >> 9) & 1) && IN(9)) { if (REP(9)) { p9_final(F, true); __syncthreads(); } p9_final(F, false); }
#undef IN
#undef SEAM
}

extern "C" void kernel_launch(void* const* d_in, const int* in_sizes, int n_in, void* d_out, int out_size, void* d_ws, size_t ws_size, hipStream_t stream) {
    static int grid = 0;
    if (grid == 0) {
        if (n_in != 20 || out_size != NTOK * DM || ws_size < WS_END) { fprintf(stderr, "kernel_launch: unexpected shapes (n_in %d, out %d, ws %zu < %zu)\n", n_in, out_size, ws_size, (size_t)WS_END); grid = -1; return; }
        int dev = 0, cus = 0, per_cu = 0;
        hipGetDevice(&dev); hipDeviceGetAttribute(&cus, hipDeviceAttributeMultiprocessorCount, dev);
        if (hipFuncSetAttribute((const void*)mega_fwd, hipFuncAttributeMaxDynamicSharedMemorySize, LDS_BYTES) != hipSuccess) { fprintf(stderr, "kernel_launch: hipFuncSetAttribute failed\n"); grid = -1; return; }
        if (hipOccupancyMaxActiveBlocksPerMultiprocessor(&per_cu, (const void*)mega_fwd, NTHR, LDS_BYTES) != hipSuccess || per_cu < 1) { fprintf(stderr, "kernel_launch: occupancy query failed (%d)\n", per_cu); per_cu = 1; }
        (void)hipGetLastError();
        grid = cus * per_cu;
        fprintf(stderr, "kernel_launch: grid %d (%d CUs x %d)\n", grid, cus, per_cu);
    }
    if (grid < 0) return;
    if (hipMemsetAsync((char*)d_ws + WS_BAR, 0, XCD_BAR_WORDS * 4, stream) != hipSuccess) { fprintf(stderr, "kernel_launch: memset of the barrier words failed\n"); return; }
    Args a{};
    for (int i = 0; i < 20; ++i) a.in[i] = (const float*)d_in[i];
    a.out = (float*)d_out; a.ws = (unsigned char*)d_ws;
#if MK_PER_PHASE_LAUNCH
    for (int p = 0; p < NPHASE; ++p) { a.ph_lo = p; a.ph_hi = p + 1; hipLaunchKernelGGL(mega_fwd, dim3(grid), dim3(NTHR), LDS_BYTES, stream, a); }
#else
    a.ph_lo = 0; a.ph_hi = NPHASE;
    void* kargs[] = {&a};
    hipError_t e = hipLaunchCooperativeKernel((const void*)mega_fwd, dim3(grid), dim3(NTHR), kargs, LDS_BYTES, stream);
    if (e != hipSuccess) fprintf(stderr, "kernel_launch: cooperative launch failed: %s (grid %d)\n", hipGetErrorString(e), grid);
#endif
}
```

```cpp
#include <hip/hip_runtime.h>
#include <hip/hip_cooperative_groups.h>
#include <cstdio>
#include <cstdint>
namespace cg = cooperative_groups;

#ifndef MK_PER_PHASE_LAUNCH
#define MK_PER_PHASE_LAUNCH 0
#endif

#ifndef REPEAT_MASK
#define REPEAT_MASK 0
#endif
#define REP(k) ((REPEAT_MASK >> (k)) & 1)
#ifndef TS_SEL
#define TS_SEL -1
#endif

namespace pg8 {
#define PG8_LAS __attribute__((address_space(3)))
typedef unsigned short bf16_t;
typedef short bf16x8 __attribute__((ext_vector_type(8)));
typedef float f32x4 __attribute__((ext_vector_type(4)));
typedef unsigned u32x4 __attribute__((ext_vector_type(4)));
constexpr int BM = 256, BK = 64, HALF = 128, HTB = HALF * BK * 2  , STAGE_BYTES = 8 * HTB, NXCD = 8, WGM = 8;

__host__ __device__ __forceinline__ int lds_byte(int r, int c) { const int st = (r >> 4) * 2 + (c >> 5), rr = r & 15, cc = c & 31, ob = rr * 64 + cc * 2; return st * 1024 + (ob ^ (((ob >> 9) & 1) << 5)); }
__host__ __device__ __forceinline__ void stage_rc(int b, int& R, int& C) { const int st = b / 1024, sb = b % 1024, swz = sb ^ (((sb >> 9) & 1) << 5); R = (st >> 1) * 16 + swz / 64; C = (st & 1) * 32 + (swz % 64) / 2; }
__host__ __device__ __forceinline__ int perm32(int rho) { const int n = rho >> 4, i = rho & 15; return 8 * (i >> 2) + 4 * n + (i & 3); }

struct Unit { int pm, pn; };
struct Gemm { const bf16_t* A; const bf16_t* Bt; int M, N, K; };

struct StaticOrder {
    int nM, nN, nwg, G, c;
    __host__ __device__ void init(int M, int N, int G_, int c_) { nM = M / BM; nN = N / BM; nwg = nM * nN; G = G_; c = c_; }
    __host__ __device__ bool next(int i, Unit& u) const {
        const long L = (long)i * G + c; if (L >= nwg) return false;
        int wgid = (int)L; { const int q = nwg / NXCD, r = nwg % NXCD, xcd = wgid % NXCD, off = wgid / NXCD; wgid = (xcd < r ? xcd * (q + 1) : r * (q + 1) + (xcd - r) * q) + off; }
        const int nig = WGM * nN, gid = wgid / nig, fm = gid * WGM, gsz = (nM - fm) < WGM ? (nM - fm) : WGM;
        u.pm = fm + ((wgid % nig) % gsz); u.pn = (wgid % nig) / gsz; return true;
    }
    __device__ __forceinline__ void a_ready(const Unit&) const {}
    __device__ __forceinline__ void done(const Unit&) const {}
};
__device__ __forceinline__ unsigned cvt_pk_bf16(float lo, float hi) { unsigned r; asm volatile("v_cvt_pk_bf16_f32 %0, %1, %2" : "=v"(r) : "v"(lo), "v"(hi)); return r; }
typedef float f32x2 __attribute__((ext_vector_type(2)));
__device__ __forceinline__ float bflo(unsigned u) { return __uint_as_float(u << 16); }
__device__ __forceinline__ float bfhi(unsigned u) { return __uint_as_float(u & 0xffff0000u); }
__device__ __forceinline__ float sigm(float x) { return 1.0f / (1.0f + __expf(-x)); }

struct EpiZ {
    static constexpr bool PERM = true, AFTER_DRAIN = false;
    bf16_t* O; int ldc; int nt_from;
    __device__ __forceinline__ void operator()(const f32x4 (&acc)[2][2][4][2], const Unit& u, int wr, int wc, int fr, int fq) const {
        const int row0 = u.pm * BM + wr * 64 + fr, col0 = u.pn * BM + wc * 32 + 8 * fq;
        const bool stream = u.pn >= nt_from;
#pragma unroll
        for (int ai = 0; ai < 2; ++ai)
#pragma unroll
            for (int m = 0; m < 4; ++m) { bf16_t* rowp = O + (size_t)(row0 + ai * HALF + m * 16) * ldc + col0;
#pragma unroll
                for (int bj = 0; bj < 2; ++bj) { const f32x4 v0 = acc[ai][bj][m][0], v1 = acc[ai][bj][m][1];
                    u32x4 w; w.x = cvt_pk_bf16(v0[0], v0[1]); w.y = cvt_pk_bf16(v0[2], v0[3]); w.z = cvt_pk_bf16(v1[0], v1[1]); w.w = cvt_pk_bf16(v1[2], v1[3]);
                    if (stream) __builtin_nontemporal_store(w, (u32x4*)(rowp + bj * HALF)); else *(u32x4*)(rowp + bj * HALF) = w; } }
    }
};
template <int MODE> struct EpiGate {
    static constexpr bool PERM = true, AFTER_DRAIN = false;
    bf16_t* O; const bf16_t* Z; int zld; int gcol;
    __device__ __forceinline__ void operator()(const f32x4 (&acc)[2][2][4][2], const Unit& u, int wr, int wc, int fr, int fq) const {
        const int row0 = u.pm * BM + wr * 64 + fr, col0 = u.pn * BM + wc * 32 + 8 * fq;
        u32x4 gn[2], pn[2];
        { const size_t row = (size_t)row0; gn[0] = *(const u32x4*)(Z + row * zld + gcol + col0); gn[1] = *(const u32x4*)(Z + row * zld + gcol + col0 + HALF);
          if (MODE == 1) { pn[0] = *(const u32x4*)(O + row * 1024 + col0); pn[1] = *(const u32x4*)(O + row * 1024 + col0 + HALF); } }
#pragma unroll
        for (int it = 0; it < 8; ++it) { const int ai = it >> 2, m = it & 3; const size_t row = (size_t)(row0 + ai * HALF + m * 16);
            u32x4 gc[2] = {gn[0], gn[1]}, pc[2];
            if (MODE == 1) { pc[0] = pn[0]; pc[1] = pn[1]; }
            if (it < 7) { const size_t rown = (size_t)(row0 + ((it + 1) >> 2) * HALF + ((it + 1) & 3) * 16);
                gn[0] = *(const u32x4*)(Z + rown * zld + gcol + col0); gn[1] = *(const u32x4*)(Z + rown * zld + gcol + col0 + HALF);
                if (MODE == 1) { pn[0] = *(const u32x4*)(O + rown * 1024 + col0); pn[1] = *(const u32x4*)(O + rown * 1024 + col0 + HALF); } }
            bf16_t* op = O + row * 1024 + col0;
#pragma unroll
            for (int bj = 0; bj < 2; ++bj) { const f32x4 v0 = acc[ai][bj][m][0], v1 = acc[ai][bj][m][1]; const u32x4 g = gc[bj];
                float r0 = v0[0] * sigm(bflo(g.x)), r1 = v0[1] * sigm(bfhi(g.x)), r2 = v0[2] * sigm(bflo(g.y)), r3 = v0[3] * sigm(bfhi(g.y));
                float r4 = v1[0] * sigm(bflo(g.z)), r5 = v1[1] * sigm(bfhi(g.z)), r6 = v1[2] * sigm(bflo(g.w)), r7 = v1[3] * sigm(bfhi(g.w));
                if (MODE == 1) { const u32x4 p = pc[bj];
                    r0 += bflo(p.x); r1 += bfhi(p.x); r2 += bflo(p.y); r3 += bfhi(p.y); r4 += bflo(p.z); r5 += bfhi(p.z); r6 += bflo(p.w); r7 += bfhi(p.w); }
                u32x4 w; w.x = cvt_pk_bf16(r0, r1); w.y = cvt_pk_bf16(r2, r3); w.z = cvt_pk_bf16(r4, r5); w.w = cvt_pk_bf16(r6, r7);
                *(u32x4*)(op + bj * HALF) = w; } }
    }
};
struct EpiRes1 {
    static constexpr bool PERM = true, AFTER_DRAIN = false;
    const float* X; bf16_t* XB; float* SS;
    __device__ __forceinline__ void operator()(const f32x4 (&acc)[2][2][4][2], const Unit& u, int wr, int wc, int fr, int fq) const {
        const int row0 = u.pm * BM + wr * 64 + fr, col0 = u.pn * BM + wc * 32 + 8 * fq;
        f32x4 xn[4];
        { const float* xp = X + (size_t)row0 * 1024 + col0; xn[0] = *(const f32x4*)(xp); xn[1] = *(const f32x4*)(xp + 4); xn[2] = *(const f32x4*)(xp + HALF); xn[3] = *(const f32x4*)(xp + HALF + 4); }
#pragma unroll
        for (int it = 0; it < 8; ++it) { const int ai = it >> 2, m = it & 3; const size_t row = (size_t)(row0 + ai * HALF + m * 16); float ssq = 0.f;
            const f32x4 xc[4] = {xn[0], xn[1], xn[2], xn[3]};
            if (it < 7) { const float* xp = X + (size_t)(row0 + ((it + 1) >> 2) * HALF + ((it + 1) & 3) * 16) * 1024 + col0;
                xn[0] = *(const f32x4*)(xp); xn[1] = *(const f32x4*)(xp + 4); xn[2] = *(const f32x4*)(xp + HALF); xn[3] = *(const f32x4*)(xp + HALF + 4); }
#pragma unroll
            for (int bj = 0; bj < 2; ++bj) { const size_t off = row * 1024 + col0 + bj * HALF;
                const f32x4 v0 = acc[ai][bj][m][0] + xc[2 * bj], v1 = acc[ai][bj][m][1] + xc[2 * bj + 1];
                ssq += (v0[0] * v0[0] + v0[1] * v0[1]) + (v0[2] * v0[2] + v0[3] * v0[3]) + (v1[0] * v1[0] + v1[1] * v1[1]) + (v1[2] * v1[2] + v1[3] * v1[3]);
                u32x4 w; w.x = cvt_pk_bf16(v0[0], v0[1]); w.y = cvt_pk_bf16(v0[2], v0[3]); w.z = cvt_pk_bf16(v1[0], v1[1]); w.w = cvt_pk_bf16(v1[2], v1[3]);
                *(u32x4*)(XB + off) = w; }
            ssq += __shfl_xor(ssq, 16); ssq += __shfl_xor(ssq, 32);
            if (fq == 0) atomicAdd(SS + row, ssq); }
    }
};
struct EpiRes2 {
    static constexpr bool PERM = true, AFTER_DRAIN = false;
    bf16_t* XB; float* SS;
    __device__ __forceinline__ void operator()(const f32x4 (&acc)[2][2][4][2], const Unit& u, int wr, int wc, int fr, int fq) const {
        const int row0 = u.pm * BM + wr * 64 + fr, col0 = u.pn * BM + wc * 32 + 8 * fq;
        u32x4 xn[2];
        { const bf16_t* xp = XB + (size_t)row0 * 1024 + col0; xn[0] = *(const u32x4*)(xp); xn[1] = *(const u32x4*)(xp + HALF); }
#pragma unroll
        for (int it = 0; it < 8; ++it) { const int ai = it >> 2, m = it & 3; const size_t row = (size_t)(row0 + ai * HALF + m * 16); float ssq = 0.f;
            const u32x4 xc[2] = {xn[0], xn[1]};
            if (it < 7) { const bf16_t* xp = XB + (size_t)(row0 + ((it + 1) >> 2) * HALF + ((it + 1) & 3) * 16) * 1024 + col0; xn[0] = *(const u32x4*)(xp); xn[1] = *(const u32x4*)(xp + HALF); }
#pragma unroll
            for (int bj = 0; bj < 2; ++bj) { const size_t off = row * 1024 + col0 + bj * HALF;
                const u32x4 xw = xc[bj]; f32x4 v0 = acc[ai][bj][m][0], v1 = acc[ai][bj][m][1];
                v0[0] += bflo(xw.x); v0[1] += bfhi(xw.x); v0[2] += bflo(xw.y); v0[3] += bfhi(xw.y); v1[0] += bflo(xw.z); v1[1] += bfhi(xw.z); v1[2] += bflo(xw.w); v1[3] += bfhi(xw.w);
                u32x4 w; w.x = cvt_pk_bf16(v0[0], v0[1]); w.y = cvt_pk_bf16(v0[2], v0[3]); w.z = cvt_pk_bf16(v1[0], v1[1]); w.w = cvt_pk_bf16(v1[2], v1[3]);
                *(u32x4*)(XB + off) = w;
                ssq += (v0[0] * v0[0] + v0[1] * v0[1]) + (v0[2] * v0[2] + v0[3] * v0[3]) + (v1[0] * v1[0] + v1[1] * v1[1]) + (v1[2] * v1[2] + v1[3] * v1[3]); }
            ssq += __shfl_xor(ssq, 16); ssq += __shfl_xor(ssq, 32);
            if (fq == 0) atomicAdd(SS + row, ssq); }
    }
};
struct EpiHid {
    static constexpr bool PERM = true, AFTER_DRAIN = false;
    bf16_t* O; const float* SS;
    __device__ __forceinline__ void operator()(const f32x4 (&acc)[2][2][4][2], const Unit& u, int wr, int wc, int fr, int fq) const {
        const int row0 = u.pm * BM + wr * 64 + fr, col0 = u.pn * BM + wc * 32 + 8 * fq;
#pragma unroll
        for (int ai = 0; ai < 2; ++ai)
#pragma unroll
            for (int m = 0; m < 4; ++m) { const size_t row = (size_t)(row0 + ai * HALF + m * 16);
                const float s2 = 1.0f / (SS[row] * (1.0f / 1024.0f) + 1e-6f);
                bf16_t* rowp = O + row * 4096 + col0;
#pragma unroll
                for (int bj = 0; bj < 2; ++bj) { f32x4 v0 = acc[ai][bj][m][0], v1 = acc[ai][bj][m][1];
#pragma unroll
                    for (int j = 0; j < 4; ++j) { float a = fmaxf(v0[j], 0.f), b = fmaxf(v1[j], 0.f); v0[j] = a * a * s2; v1[j] = b * b * s2; }
                    u32x4 w; w.x = cvt_pk_bf16(v0[0], v0[1]); w.y = cvt_pk_bf16(v0[2], v0[3]); w.z = cvt_pk_bf16(v1[0], v1[1]); w.w = cvt_pk_bf16(v1[2], v1[3]);
                    *(u32x4*)(rowp + bj * HALF) = w; } }
    }
};

template <class Epi, class Sched, bool ALIGN_EPI = false, bool SP2 = false>
__device__ __forceinline__ void gemm_phase(PG8_LAS unsigned char* lds, const Gemm g, const Sched& S, const Epi& E) {
    const int tid = threadIdx.x, wid = __builtin_amdgcn_readfirstlane(tid >> 6), lane = tid & 63, wr = wid >> 2, wc = wid & 3, fr = lane & 15, fq = lane >> 4;
    const int K = g.K, nt = K / BK;
    unsigned voffA[2], voffB[2];
#pragma unroll
    for (int i = 0; i < 2; ++i) { int R, C; stage_rc(tid * 16 + i * 8192, R, C); const int Rb = Epi::PERM ? ((R & ~31) + perm32(R & 31)) : R;
        voffA[i] = (unsigned)(R * K + C) * 2u; voffB[i] = (unsigned)(Rb * K + C) * 2u; }
    const size_t kstep = (size_t)(BK * 2);
    const size_t hstep = (size_t)HALF * K * 2;
    const size_t tstep = 2 * hstep;
    const unsigned ldsw = (unsigned)wid * 1024u;
    const int aoff = lds_byte(wr * 64 + fr, fq * 8), boff = lds_byte(wc * 32 + fr, fq * 8);
#define PG8_SA(b, h) (((b) * 2 + (h)) * HTB)
#define PG8_SB(b, h) ((4 + (b) * 2 + (h)) * HTB)
#define PG8_STAGE(bufoff, gbase, voff) do { _Pragma("unroll") for (int _i = 0; _i < 2; ++_i) \
        __builtin_amdgcn_global_load_lds((const unsigned*)((const char*)(gbase) + (voff)[_i]), (PG8_LAS unsigned*)(lds + (bufoff) + ldsw + _i * 8192), 16, 0, 0); } while (0)
#define PG8_LDA(dst, b, h) do { _Pragma("unroll") for (int m = 0; m < 4; ++m) _Pragma("unroll") for (int k = 0; k < 2; ++k) dst[m][k] = *(const PG8_LAS bf16x8*)(lds + PG8_SA(b, h) + aoff + m * 2048 + k * 1024); } while (0)
#define PG8_LDB(dst, b, h) do { _Pragma("unroll") for (int n = 0; n < 2; ++n) _Pragma("unroll") for (int k = 0; k < 2; ++k) dst[n][k] = *(const PG8_LAS bf16x8*)(lds + PG8_SB(b, h) + boff + n * 2048 + k * 1024); } while (0)
#define PG8_MMA(ai, bj, At, Bt) do { __builtin_amdgcn_s_setprio(1); _Pragma("unroll") for (int m = 0; m < 4; ++m) _Pragma("unroll") for (int n = 0; n < 2; ++n) _Pragma("unroll") for (int k = 0; k < 2; ++k) \
        acc[ai][bj][m][n] = __builtin_amdgcn_mfma_f32_16x16x32_bf16(Bt[n][k], At[m][k], acc[ai][bj][m][n], 0, 0, 0); __builtin_amdgcn_s_setprio(0); } while (0)
#define PG8_WAIT_V(n) asm volatile("s_waitcnt vmcnt(" #n ")" ::: "memory")
#define PG8_WAIT_L(n) asm volatile("s_waitcnt lgkmcnt(" #n ")" ::: "memory")
#define PG8_BAR __builtin_amdgcn_s_barrier()
#define PG8_SCHED __builtin_amdgcn_sched_barrier(0)
    Unit cur, nxt; int ui = 0;
    if (!S.next(0, cur)) return;
    f32x4 acc[2][2][4][2];
#pragma unroll
    for (int a = 0; a < 2; ++a)
#pragma unroll
        for (int b = 0; b < 2; ++b)
#pragma unroll
            for (int m = 0; m < 4; ++m)
#pragma unroll
                for (int n = 0; n < 2; ++n) acc[a][b][m][n] = (f32x4){0.f, 0.f, 0.f, 0.f};
    bf16x8 At[4][2], B0[2][2], B1[2][2];
    const char* cA = (const char*)g.A + (size_t)cur.pm * tstep; const char* cB = (const char*)g.Bt + (size_t)cur.pn * tstep;
    S.a_ready(cur);
    if constexpr (SP2) {
        PG8_STAGE(PG8_SB(0, 0), cB, voffB); PG8_STAGE(PG8_SB(0, 1), cB + hstep, voffB); PG8_STAGE(PG8_SA(0, 0), cA, voffA); PG8_STAGE(PG8_SA(0, 1), cA + hstep, voffA);
        if (wr == 1) PG8_BAR;
        PG8_WAIT_V(2); PG8_BAR;
        PG8_STAGE(PG8_SB(1, 0), cB + kstep, voffB); PG8_STAGE(PG8_SA(1, 0), cA + kstep, voffA); PG8_STAGE(PG8_SB(1, 1), cB + hstep + kstep, voffB);
        PG8_WAIT_V(6); PG8_BAR;
    } else {
        PG8_STAGE(PG8_SB(0, 0), cB, voffB); PG8_STAGE(PG8_SA(0, 0), cA, voffA); PG8_STAGE(PG8_SB(0, 1), cB + hstep, voffB); PG8_STAGE(PG8_SA(0, 1), cA + hstep, voffA);
        if (wr == 1) PG8_BAR;
        PG8_WAIT_V(4); PG8_BAR;
        PG8_STAGE(PG8_SB(1, 0), cB + kstep, voffB); PG8_STAGE(PG8_SA(1, 0), cA + kstep, voffA); PG8_STAGE(PG8_SB(1, 1), cB + hstep + kstep, voffB);
        PG8_WAIT_V(6); PG8_BAR;
    }
    for (;;) {
        const bool has_next = S.next(ui + 1, nxt);
        const char* nA = has_next ? (const char*)g.A + (size_t)nxt.pm * tstep : cA; const char* nB = has_next ? (const char*)g.Bt + (size_t)nxt.pn * tstep : cB;
        for (int t = 0; t < nt; t += 2) {
            const bool last = (t == nt - 2);
            const char* a1 = cA + (size_t)(t + 1) * kstep;
            const char* a2 = last ? nA : cA + (size_t)(t + 2) * kstep; const char* b2 = last ? nB : cB + (size_t)(t + 2) * kstep;
            const char* a3 = a2 + kstep; const char* b3 = b2 + kstep;
            if (last && has_next) S.a_ready(nxt);
            if constexpr (SP2) {
            PG8_LDB(B0, 0, 0); PG8_LDB(B1, 0, 1); PG8_SCHED; PG8_LDA(At, 0, 0); PG8_STAGE(PG8_SA(1, 1), a1 + hstep, voffA);
            PG8_WAIT_V(8); PG8_WAIT_L(0); PG8_BAR; PG8_MMA(0, 0, At, B0); PG8_MMA(0, 1, At, B1); PG8_BAR; PG8_SCHED;
            PG8_LDA(At, 0, 1); PG8_STAGE(PG8_SB(0, 0), b2, voffB); PG8_STAGE(PG8_SB(0, 1), b2 + hstep, voffB); PG8_STAGE(PG8_SA(0, 0), a2, voffA);
            PG8_WAIT_V(8); PG8_WAIT_L(0); PG8_BAR; PG8_MMA(1, 0, At, B0); PG8_MMA(1, 1, At, B1); PG8_BAR; PG8_SCHED;
            PG8_LDB(B0, 1, 0); PG8_LDB(B1, 1, 1); PG8_SCHED; PG8_LDA(At, 1, 0); PG8_STAGE(PG8_SA(0, 1), a2 + hstep, voffA);
            PG8_WAIT_V(8); PG8_WAIT_L(0); PG8_BAR; PG8_MMA(0, 0, At, B0); PG8_MMA(0, 1, At, B1); PG8_BAR; PG8_SCHED;
            PG8_LDA(At, 1, 1); PG8_STAGE(PG8_SB(1, 0), b3, voffB); PG8_STAGE(PG8_SB(1, 1), b3 + hstep, voffB); PG8_STAGE(PG8_SA(1, 0), a3, voffA);
            PG8_WAIT_V(8); PG8_WAIT_L(0); PG8_BAR; PG8_MMA(1, 0, At, B0); PG8_MMA(1, 1, At, B1); PG8_BAR; PG8_SCHED;
            } else {
            PG8_LDB(B0, 0, 0); PG8_SCHED; PG8_LDA(At, 0, 0); PG8_STAGE(PG8_SA(1, 1), a1 + hstep, voffA);
            PG8_WAIT_L(8); PG8_BAR; PG8_WAIT_L(0); PG8_MMA(0, 0, At, B0); PG8_BAR; PG8_SCHED;
            PG8_LDB(B1, 0, 1); PG8_STAGE(PG8_SB(0, 0), b2, voffB);
            PG8_BAR; PG8_WAIT_L(0); PG8_MMA(0, 1, At, B1); PG8_BAR;
            PG8_LDA(At, 0, 1); PG8_STAGE(PG8_SA(0, 0), a2, voffA);
            PG8_BAR; PG8_WAIT_L(0); PG8_MMA(1, 0, At, B0); PG8_BAR; PG8_SCHED;
            PG8_STAGE(PG8_SB(0, 1), b2 + hstep, voffB);
            PG8_WAIT_V(6); PG8_BAR; PG8_MMA(1, 1, At, B1); PG8_BAR;
            PG8_LDB(B0, 1, 0); PG8_SCHED; PG8_LDA(At, 1, 0); PG8_STAGE(PG8_SA(0, 1), a2 + hstep, voffA);
            PG8_WAIT_L(8); PG8_BAR; PG8_WAIT_L(0); PG8_MMA(0, 0, At, B0); PG8_BAR; PG8_SCHED;
            PG8_LDB(B1, 1, 1); PG8_STAGE(PG8_SB(1, 0), b3, voffB);
            PG8_BAR; PG8_WAIT_L(0); PG8_MMA(0, 1, At, B1); PG8_BAR;
            PG8_LDA(At, 1, 1); PG8_STAGE(PG8_SA(1, 0), a3, voffA);
            PG8_BAR; PG8_WAIT_L(0); PG8_MMA(1, 0, At, B0); PG8_BAR; PG8_SCHED;
            PG8_STAGE(PG8_SB(1, 1), b3 + hstep, voffB);
            PG8_WAIT_V(6); PG8_BAR; PG8_MMA(1, 1, At, B1); PG8_BAR;
            }
        }
        if constexpr (ALIGN_EPI) { if (wr == 0) PG8_BAR; }
        if constexpr (!Epi::AFTER_DRAIN) { E(acc, cur, wr, wc, fr, fq); S.done(cur); }
        if (!has_next) break;
#pragma unroll
        for (int a = 0; a < 2; ++a)
#pragma unroll
            for (int b = 0; b < 2; ++b)
#pragma unroll
                for (int m = 0; m < 4; ++m)
#pragma unroll
                    for (int n = 0; n < 2; ++n) acc[a][b][m][n] = (f32x4){0.f, 0.f, 0.f, 0.f};
        cur = nxt; cA = nA; cB = nB; ++ui;
        if constexpr (ALIGN_EPI) { if (wr == 1) PG8_BAR; }
    }
    PG8_WAIT_V(0);
    if constexpr (!ALIGN_EPI) { if (wr == 0) PG8_BAR; }
    PG8_BAR;
    if constexpr (Epi::AFTER_DRAIN) { E.fused(acc, cur, wr, wc, fr, fq, lds, wid, lane); S.done(cur); }
#undef PG8_SA
#undef PG8_SB
#undef PG8_STAGE
#undef PG8_LDA
#undef PG8_LDB
#undef PG8_MMA
#undef PG8_WAIT_V
#undef PG8_WAIT_L
#undef PG8_BAR
#undef PG8_SCHED
}
}
extern __shared__ __attribute__((aligned(16))) unsigned char g_lds[];
using pg8::bf16_t; using pg8::bf16x8; using pg8::f32x4; using pg8::u32x4; using pg8::cvt_pk_bf16; using pg8::bflo; using pg8::bfhi; using pg8::sigm;

constexpr int NTOK = 32768, DM = 1024, SEQ = 2048, NB = 16, ZLD = 5120, NTHR = 512;
constexpr int C_R = 0, C_K = 512, C_V = 1024, C_WD = 1536, C_AD = 1600, C_GD = 1664;
constexpr int C_Q = 1824, C_KA = 2336, C_VA = 2400, C_QI = 2464, C_KI = 2976, C_WI = 3040, C_G0 = 3048, C_G1 = 4072;
constexpr size_t MiB = 1024 * 1024;
constexpr size_t WS_SS1 = 0, WS_SS2 = 128 * 1024, WS_BONUS = 256 * 1024, WS_ROPE = 1280 * 1024, WS_WD = 1792 * 1024, WS_WI = 1856 * 1024, WS_WG = 1920 * 1024;
constexpr size_t WS_WIN = 4 * MiB, WS_WUP = 14 * MiB, WS_WDN = 22 * MiB, WS_WB = 30 * MiB, WS_WO = 32 * MiB, WS_VT = 34 * MiB, WS_H = 38 * MiB, WS_Z = 102 * MiB, WS_P = 422 * MiB, WS_END = 486 * MiB;
constexpr int LDS_BYTES = 163840;

struct Args { const float* in[20]; float* out; unsigned char* ws; int ph_lo, ph_hi; };

struct Frame {
    const float* in[20]; float* out; unsigned char* ws; unsigned char* lds; int tid, lane, wave;
    float *ss1, *ss2, *bonus; float2* rope; bf16_t *wd, *wi, *wg, *win, *wup, *wdn, *wb, *wo, *vt, *h, *ya, *yb, *xb, *z, *hid, *lw, *ic, *mg, *gt; float* yraw;
};

__device__ __forceinline__ bf16_t f2bf(float f) { return (bf16_t)(cvt_pk_bf16(f, 0.f) & 0xffffu); }
__device__ __forceinline__ float bf2f(bf16_t b) { return __uint_as_float(((unsigned)b) << 16); }
template <int CTRL> __device__ __forceinline__ float dpp_mov(float x) { return __int_as_float(__builtin_amdgcn_update_dpp(0, __float_as_int(x), CTRL, 0xF, 0xF, true)); }
__device__ __forceinline__ float red16(float x) { x += dpp_mov<0xB1>(x); x += dpp_mov<0x4E>(x); x += dpp_mov<0x141>(x); x += dpp_mov<0x140>(x); return x; }


__device__ __forceinline__ void lds_barrier() { asm volatile("s_waitcnt lgkmcnt(0)" ::: "memory"); __builtin_amdgcn_s_barrier(); asm volatile("" ::: "memory"); }
__device__ __forceinline__ void red16x4(float& a, float& b, float& c, float& d) {
#define DPP4(ctl) "v_add_f32_dpp %0, %0, %0 " ctl " row_mask:0xf bank_mask:0xf bound_ctrl:1\n" "v_add_f32_dpp %1, %1, %1 " ctl " row_mask:0xf bank_mask:0xf bound_ctrl:1\n" \
                  "v_add_f32_dpp %2, %2, %2 " ctl " row_mask:0xf bank_mask:0xf bound_ctrl:1\n" "v_add_f32_dpp %3, %3, %3 " ctl " row_mask:0xf bank_mask:0xf bound_ctrl:1\n"
    asm volatile("s_nop 1\n" DPP4("quad_perm:[1,0,3,2]") DPP4("quad_perm:[2,3,0,1]") DPP4("row_half_mirror") DPP4("row_mirror") : "+v"(a), "+v"(b), "+v"(c), "+v"(d));
#undef DPP4
}
__device__ __forceinline__ float red32(float x) { x += __shfl_xor(x, 1); x += __shfl_xor(x, 2); x += __shfl_xor(x, 4); x += __shfl_xor(x, 8); x += __shfl_xor(x, 16); return x; }
__device__ __forceinline__ float red64(float x) { x = red32(x); x += __shfl_xor(x, 32); return x; }
__device__ __forceinline__ float softplus_f(float x) { return fmaxf(x, 0.f) + log1pf(__expf(-fabsf(x))); }

__device__ __forceinline__ void tconv(const Frame& F, const float* __restrict__ W, int K, int N, int Npad, bf16_t* __restrict__ Wt, const float* __restrict__ rs) {
    float* tile = (float*)g_lds;
    const int ktn = (K + 63) / 64, ntn = Npad / 64, tid = F.tid;
    for (int tl = blockIdx.x; tl < ktn * ntn; tl += gridDim.x) {
        const int kt = tl % ktn, nt = tl / ktn;
#pragma unroll
        for (int i = 0; i < 2; ++i) { const int idx = tid + i * NTHR, kk = idx >> 4, n4 = (idx & 15) * 4, k = kt * 64 + kk, n = nt * 64 + n4;
            f32x4 v = {0.f, 0.f, 0.f, 0.f};
            if (k < K) { if (n + 3 < N) v = *(const f32x4*)(W + (size_t)k * N + n); else { for (int j = 0; j < 4; ++j) if (n + j < N) v[j] = W[(size_t)k * N + n + j]; }
                if (rs != nullptr) { const float r = rs[k]; v[0] *= r; v[1] *= r; v[2] *= r; v[3] *= r; } }
            tile[kk * 65 + n4] = v[0]; tile[kk * 65 + n4 + 1] = v[1]; tile[kk * 65 + n4 + 2] = v[2]; tile[kk * 65 + n4 + 3] = v[3]; }
        __syncthreads();
        { const int nn = tid >> 3, k8 = (tid & 7) * 8, k = kt * 64 + k8, n = nt * 64 + nn;
          if (k < K) { u32x4 w; const float* tp = tile + k8 * 65 + nn;
              w.x = cvt_pk_bf16(tp[0], tp[65]); w.y = cvt_pk_bf16(tp[130], tp[195]); w.z = cvt_pk_bf16(tp[260], tp[325]); w.w = cvt_pk_bf16(tp[390], tp[455]);
              *(u32x4*)(Wt + (size_t)n * K + k) = w; } }
        __syncthreads();
    }
}
__device__ __forceinline__ void p0_prologue(const Frame& F) {
    const int tid = F.tid, gtid = blockIdx.x * NTHR + tid, gn = gridDim.x * NTHR;
    for (int i = gtid; i < 2 * NTOK; i += gn) F.ss1[i] = 0.f;
    for (int i = gtid; i < SEQ * 32; i += gn) { const int pos = i >> 5, j = i & 31;
        const float inv = 1.0f / powf(10000.0f, (float)(2 * j) / 64.0f); const float ang = (float)pos * inv;
        double rev = (double)ang * 0.15915494309189535; rev -= floor(rev); const float fr = (float)rev;
        F.rope[i] = make_float2(__builtin_amdgcn_cosf(fr), __builtin_amdgcn_sinf(fr)); }
    tconv(F, F.in[2], 1024, 5096, 5120, F.win, nullptr);
    tconv(F, F.in[17], 1024, 4096, 4096, F.wup, F.in[16]);
    tconv(F, F.in[18], 4096, 1024, 1024, F.wdn, nullptr);
    tconv(F, F.in[14], 512, 1024, 1024, F.wb, nullptr);
    tconv(F, F.in[14] + 512 * 1024, 512, 1024, 1024, F.wb + 1024 * 512, nullptr);
    tconv(F, F.in[15], 1024, 1024, 1024, F.wo, nullptr);
    tconv(F, F.in[5], 64, 512, 512, F.wd, nullptr);
    tconv(F, F.in[7], 64, 512, 512, F.wi, nullptr);
    tconv(F, F.in[8], 160, 512, 512, F.wg, nullptr);
    const float* x = F.in[0]; const float* g = F.in[1]; const int lane = F.lane;
    const int rstep = gridDim.x * 8;
    f32x4 gq[4];
#pragma unroll
    for (int i = 0; i < 4; ++i) gq[i] = *(const f32x4*)(g + (i >> 1) * 512 + lane * 8 + (i & 1) * 4);
    for (int row = blockIdx.x * 8 + F.wave; row < NTOK; row += 2 * rstep) {
        const int row2 = (row + rstep) < NTOK ? row + rstep : row; const bool two = row2 != row;
        const float* xr = x + (size_t)row * DM; const float* xr2 = x + (size_t)row2 * DM; f32x4 v[4], u[4]; float ss = 0.f, ss2 = 0.f;
#pragma unroll
        for (int i = 0; i < 4; ++i) { v[i] = __builtin_nontemporal_load((const f32x4*)(xr + (i >> 1) * 512 + lane * 8 + (i & 1) * 4)); u[i] = __builtin_nontemporal_load((const f32x4*)(xr2 + (i >> 1) * 512 + lane * 8 + (i & 1) * 4)); }
#pragma unroll
        for (int i = 0; i < 4; ++i) { ss += v[i][0] * v[i][0] + v[i][1] * v[i][1] + v[i][2] * v[i][2] + v[i][3] * v[i][3]; ss2 += u[i][0] * u[i][0] + u[i][1] * u[i][1] + u[i][2] * u[i][2] + u[i][3] * u[i][3]; }
        ss = red64(ss); ss2 = red64(ss2); const float sc = rsqrtf(ss * (1.0f / 1024.0f) + 1e-6f), sc2 = rsqrtf(ss2 * (1.0f / 1024.0f) + 1e-6f);
#pragma unroll
        for (int i = 0; i < 2; ++i) { const f32x4 a = v[2 * i] * gq[2 * i] * sc, b2 = v[2 * i + 1] * gq[2 * i + 1] * sc, a2 = u[2 * i] * gq[2 * i] * sc2, b3 = u[2 * i + 1] * gq[2 * i + 1] * sc2; u32x4 w, w2;
            w.x = cvt_pk_bf16(a[0], a[1]); w.y = cvt_pk_bf16(a[2], a[3]); w.z = cvt_pk_bf16(b2[0], b2[1]); w.w = cvt_pk_bf16(b2[2], b2[3]);
            w2.x = cvt_pk_bf16(a2[0], a2[1]); w2.y = cvt_pk_bf16(a2[2], a2[3]); w2.z = cvt_pk_bf16(b3[0], b3[1]); w2.w = cvt_pk_bf16(b3[2], b3[3]);
            *(u32x4*)(F.h + (size_t)row * DM + i * 512 + lane * 8) = w; if (two) *(u32x4*)(F.h + (size_t)row2 * DM + i * 512 + lane * 8) = w2; }
    }
}

__device__ __forceinline__ void p2_prep(const Frame& F, const int mode) {
    const int tid = F.tid, lane = F.lane, wave = F.wave, fr = lane & 15, fq = lane >> 4;
    bf16_t* z = F.z; const float* mu = F.in[3];
    if (mode != 2) {
        constexpr int LDA = 296, TT = 32; bf16_t* At = (bf16_t*)g_lds;
        bf16_t* Ot = At + TT * LDA;
        const float* dbias = F.in[4]; const float* ibias = F.in[6];
        for (int tile = blockIdx.x; tile < NTOK / TT; tile += gridDim.x) {
            const int t0 = tile * TT;
            for (int idx = tid; idx < TT * 36; idx += NTHR) { const int tok = idx / 36, c8 = (idx - tok * 36) * 8, t = t0 + tok, col = C_WD + c8;
                const u32x4 zc = *(const u32x4*)(z + (size_t)t * ZLD + col); u32x4 zp = {0u, 0u, 0u, 0u}; if (t & (SEQ - 1)) zp = *(const u32x4*)(z + (size_t)(t - 1) * ZLD + col);
                const f32x4 m0 = *(const f32x4*)(mu + col), m1 = *(const f32x4*)(mu + col + 4);
                float v[8]; const unsigned zcu[4] = {zc.x, zc.y, zc.z, zc.w}, zpu[4] = {zp.x, zp.y, zp.z, zp.w};
#pragma unroll
                for (int j = 0; j < 4; ++j) { const float a = bflo(zcu[j]), b2 = bfhi(zcu[j]), pa = bflo(zpu[j]), pb = bfhi(zpu[j]);
                    const float mm0 = (j < 2) ? m0[2 * j] : m1[2 * j - 4], mm1 = (j < 2) ? m0[2 * j + 1] : m1[2 * j - 3];
                    v[2 * j] = a + (pa - a) * mm0; v[2 * j + 1] = b2 + (pb - b2) * mm1; }
                if (c8 < 64) {
#pragma unroll
                    for (int j = 0; j < 8; ++j) v[j] = tanhf(v[j]); }
                else if (c8 >= 128) {
#pragma unroll
                    for (int j = 0; j < 8; ++j) v[j] = sigm(v[j]); }
                u32x4 w; w.x = cvt_pk_bf16(v[0], v[1]); w.y = cvt_pk_bf16(v[2], v[3]); w.z = cvt_pk_bf16(v[4], v[5]); w.w = cvt_pk_bf16(v[6], v[7]);
                *(u32x4*)(At + tok * LDA + c8) = w; }
            __syncthreads();
            const int h = wave;
            bf16x8 Bc[9], Bn[9];
            { const int n = h * 64 + fr;
#pragma unroll
              for (int ks = 0; ks < 2; ++ks) { Bc[ks] = *(const bf16x8*)(F.wd + n * 64 + ks * 32 + fq * 8); Bc[2 + ks] = *(const bf16x8*)(F.wi + n * 64 + ks * 32 + fq * 8); }
#pragma unroll
              for (int ks = 0; ks < 5; ++ks) Bc[4 + ks] = *(const bf16x8*)(F.wg + n * 160 + ks * 32 + fq * 8); }
#pragma unroll 1
            for (int j = 0; j < 4; ++j) { const int n = h * 64 + j * 16 + fr;
                if (j < 3) { const int nn = n + 16;
#pragma unroll
                    for (int ks = 0; ks < 2; ++ks) { Bn[ks] = *(const bf16x8*)(F.wd + nn * 64 + ks * 32 + fq * 8); Bn[2 + ks] = *(const bf16x8*)(F.wi + nn * 64 + ks * 32 + fq * 8); }
#pragma unroll
                    for (int ks = 0; ks < 5; ++ks) Bn[4 + ks] = *(const bf16x8*)(F.wg + nn * 160 + ks * 32 + fq * 8); }
                const float db = dbias[n], ib = ibias[n];
#pragma unroll
                for (int mt = 0; mt < 2; ++mt) {
                    f32x4 ad = {0.f, 0.f, 0.f, 0.f}, ai = ad, ag = ad; const bf16_t* ap = At + (mt * 16 + fr) * LDA + fq * 8;
#pragma unroll
                    for (int ks = 0; ks < 2; ++ks) ad = __builtin_amdgcn_mfma_f32_16x16x32_bf16(*(const bf16x8*)(ap + ks * 32), Bc[ks], ad, 0, 0, 0);
#pragma unroll
                    for (int ks = 0; ks < 2; ++ks) ai = __builtin_amdgcn_mfma_f32_16x16x32_bf16(*(const bf16x8*)(ap + 64 + ks * 32), Bc[2 + ks], ai, 0, 0, 0);
#pragma unroll
                    for (int ks = 0; ks < 5; ++ks) ag = __builtin_amdgcn_mfma_f32_16x16x32_bf16(*(const bf16x8*)(ap + 128 + ks * 32), Bc[4 + ks], ag, 0, 0, 0);
#pragma unroll
                    for (int jj = 0; jj < 4; ++jj) {
                        const float dw = db + ad[jj]; const float wlog = -softplus_f(-dw) - 0.5f; const float lwv = -__expf(wlog);
                        const int tk = mt * 16 + fq * 4 + jj; Ot[tk * 520 + n] = f2bf(lwv); Ot[(TT + tk) * 520 + n] = f2bf(sigm(ib + ai[jj])); Ot[(2 * TT + tk) * 520 + n] = f2bf(ag[jj]); }
                }
#pragma unroll
                for (int q = 0; q < 9; ++q) Bc[q] = Bn[q];
            }
            __syncthreads();
#pragma unroll
            for (int i = 0; i < 12; ++i) { const int idx = tid + i * NTHR, arr = idx >> 11, rem = idx & 2047, tk = rem >> 6, c8 = (rem & 63) * 8;
                const u32x4 w = *(const u32x4*)(Ot + (arr * TT + tk) * 520 + c8); bf16_t* dst = arr == 0 ? F.lw : (arr == 1 ? F.ic : F.gt);
                *(u32x4*)(dst + (size_t)(t0 + tk) * 512 + c8) = w; }
            __syncthreads();
        }
    }
    if (mode != 2) {
        unsigned short* tl = (unsigned short*)g_lds;
        for (int tile = blockIdx.x; tile < NTOK / 64; tile += gridDim.x) { const int t0 = tile * 64, b = t0 / SEQ, tt0 = t0 % SEQ;
            { const int tok = tid >> 3, d8 = (tid & 7) * 8; *(u32x4*)(tl + tok * 72 + d8) = *(const u32x4*)(z + (size_t)(t0 + tok) * ZLD + C_VA + d8); }
            __syncthreads();
            { const int d = tid >> 3, k8 = (tid & 7) * 8; unsigned short e[8];
#pragma unroll
              for (int j = 0; j < 8; ++j) e[j] = tl[(k8 + j) * 72 + d];
              u32x4 w; w.x = e[0] | ((unsigned)e[1] << 16); w.y = e[2] | ((unsigned)e[3] << 16); w.z = e[4] | ((unsigned)e[5] << 16); w.w = e[6] | ((unsigned)e[7] << 16);
              *(u32x4*)(F.vt + ((size_t)b * 64 + d) * SEQ + tt0 + k8) = w; }
            __syncthreads();
        }
    }
    if (mode != 0) {
        const int gtid = blockIdx.x * NTHR + tid, gn = gridDim.x * NTHR;
        for (int idx = gtid; idx < NTOK * 72; idx += gn) { const int t = idx / 72, p = idx - t * 72, hd = p >> 2, i8 = (p & 3) * 8;
            const int base = hd < 8 ? C_Q + hd * 64 : (hd == 8 ? C_KA : (hd < 17 ? C_QI + (hd - 9) * 64 : C_KI));
            const float* rp = (const float*)&F.rope[(t & (SEQ - 1)) * 32 + i8];
            f32x4 cs[4];
#pragma unroll
            for (int j = 0; j < 4; ++j) { cs[j] = *(const f32x4*)(rp + 4 * j); if (mode == 2) cs[j] = (f32x4){1.f, 0.f, 1.f, 0.f}; }
            bf16_t* p1 = z + (size_t)t * ZLD + base + i8; const u32x4 a = *(const u32x4*)(p1), b2 = *(const u32x4*)(p1 + 32);
            const unsigned au[4] = {a.x, a.y, a.z, a.w}, bu[4] = {b2.x, b2.y, b2.z, b2.w}; unsigned o1[4], o2[4];
#pragma unroll
            for (int j = 0; j < 4; ++j) { const float x1a = bflo(au[j]), x1b = bfhi(au[j]), x2a = bflo(bu[j]), x2b = bfhi(bu[j]);
                o1[j] = cvt_pk_bf16(x1a * cs[j][0] - x2a * cs[j][1], x1b * cs[j][2] - x2b * cs[j][3]);
                o2[j] = cvt_pk_bf16(x2a * cs[j][0] + x1a * cs[j][1], x2b * cs[j][2] + x1b * cs[j][3]); }
            u32x4 w1, w2; w1.x = o1[0]; w1.y = o1[1]; w1.z = o1[2]; w1.w = o1[3]; w2.x = o2[0]; w2.y = o2[1]; w2.z = o2[2]; w2.w = o2[3];
            *(u32x4*)(p1) = w1; *(u32x4*)(p1 + 32) = w2; }
    }
}

struct ScanRaw { uint2 zr_c, zr_p, zk_c, zk_p, zv_c, zv_p, lwu, icu; };
struct ScanConst { f32x4 mur, muk, muv, kk, ka, rk; };
__device__ __forceinline__ void scan_load(ScanRaw& R, const bf16_t* z, const bf16_t* lw, const bf16_t* ic, size_t tokbase, int ch, int ptok, int gc) {
    const int t = ch * 16 + ptok; const size_t T = tokbase + t; const bf16_t* zp = z + T * ZLD + gc;
    R.zr_c = *(const uint2*)(zp + C_R); R.zk_c = *(const uint2*)(zp + C_K); R.zv_c = *(const uint2*)(zp + C_V);
    const uint2 zz = make_uint2(0u, 0u);
    if (t > 0) { R.zr_p = *(const uint2*)(zp - ZLD + C_R); R.zk_p = *(const uint2*)(zp - ZLD + C_K); R.zv_p = *(const uint2*)(zp - ZLD + C_V); } else { R.zr_p = zz; R.zk_p = zz; R.zv_p = zz; }
    R.lwu = *(const uint2*)(lw + T * 512 + gc); R.icu = *(const uint2*)(ic + T * 512 + gc);
}
__device__ __forceinline__ f32x4 unpack4(uint2 u) { f32x4 r; r[0] = bflo(u.x); r[1] = bfhi(u.x); r[2] = bflo(u.y); r[3] = bfhi(u.y); return r; }
__device__ __forceinline__ void scan_prep(const ScanRaw& R, const ScanConst& C, float* ops, float* vv, float* bonus_out, bool wr_bonus, int ptok, int pc, int v0) {
    const f32x4 rc = unpack4(R.zr_c), rp = unpack4(R.zr_p), kc = unpack4(R.zk_c), kp = unpack4(R.zk_p), vc = unpack4(R.zv_c), vp = unpack4(R.zv_p), ic = unpack4(R.icu), lw = unpack4(R.lwu);
    const f32x4 r = rc + (rp - rc) * C.mur, k = kc + (kp - kc) * C.muk, vs = vc + (vp - vc) * C.muv;
    f32x4 w; w[0] = __expf(lw[0]); w[1] = __expf(lw[1]); w[2] = __expf(lw[2]); w[3] = __expf(lw[3]);
    const f32x4 q = k * C.kk; const float ss = red16((q[0] * q[0] + q[1] * q[1]) + (q[2] * q[2] + q[3] * q[3]));
    const float inv = 1.0f / fmaxf(sqrtf(ss), 1e-12f); const f32x4 n = q * inv;
    const f32x4 kn = k * (1.0f + (ic - 1.0f) * C.ka);
    const f32x4 bt = r * kn * C.rk; const float bon = red16((bt[0] + bt[1]) + (bt[2] + bt[3]));
    if (wr_bonus) *bonus_out = bon;
    float* op = ops + ptok * 320 + pc;
    *(f32x4*)(op) = -n; *(f32x4*)(op + 64) = w; *(f32x4*)(op + 128) = n * ic; *(f32x4*)(op + 192) = kn; *(f32x4*)(op + 256) = r;
    if (pc >= v0 && pc < v0 + 32) *(f32x4*)(vv + ptok * 32 + pc - v0) = vs;
}
__device__ __forceinline__ void p3_scan(const Frame& F, const int mode) {
    const int tid = F.tid;
    float* opsb = (float*)g_lds;
    float* vvb = opsb + 2 * 5120;
    float* yob = vvb + 2 * 512;
    const bf16_t* z = F.z; const float* mu = F.in[3]; const float* k_k = F.in[9]; const float* k_a = F.in[10]; const float* r_k = F.in[11];
    for (int item = blockIdx.x; item < 256; item += gridDim.x) {
        const int bh = item >> 1, half = item & 1, b = bh >> 3, h = bh & 7, v0 = half * 32;
        const size_t tokbase = (size_t)b * SEQ;
        if (F.wave >= 4) {
            const int pt = tid - 256, ptok = pt >> 4, pc = (pt & 15) * 4, gc = h * 64 + pc;
            ScanConst C; C.mur = *(const f32x4*)(mu + C_R + gc); C.muk = *(const f32x4*)(mu + C_K + gc); C.muv = *(const f32x4*)(mu + C_V + gc);
            C.kk = *(const f32x4*)(k_k + gc); C.ka = *(const f32x4*)(k_a + gc); C.rk = *(const f32x4*)(r_k + gc);
            const bool wrb = (half == 0) && ((pt & 15) == 0);
            ScanRaw R;
            scan_load(R, z, F.lw, F.ic, tokbase, 0, ptok, gc);
            scan_prep(R, C, opsb, vvb, F.bonus + (tokbase + ptok) * 8 + h, wrb, ptok, pc, v0);
            scan_load(R, z, F.lw, F.ic, tokbase, 1, ptok, gc);
            lds_barrier();
            for (int ch = 0; ch < SEQ / 16; ++ch) {
                const int cur = ch & 1, nxt = cur ^ 1;
                if (mode != 2) {
                if (ch > 0) { const int tok = pt >> 4, r2 = (pt & 15) * 2;
                    *(float2*)(F.yraw + (tokbase + (ch - 1) * 16 + tok) * 512 + h * 64 + v0 + r2) = *(const float2*)(yob + nxt * 512 + tok * 32 + r2); }
                if (ch + 1 < SEQ / 16) {
                    scan_prep(R, C, opsb + nxt * 5120, vvb + nxt * 512, F.bonus + (tokbase + (ch + 1) * 16 + ptok) * 8 + h, wrb, ptok, pc, v0);
                    if (ch + 2 < SEQ / 16) scan_load(R, z, F.lw, F.ic, tokbase, ch + 2, ptok, gc);
                } }
                lds_barrier();
            }
            { const int tok = pt >> 4, r2 = (pt & 15) * 2;
              *(float2*)(F.yraw + (tokbase + (SEQ / 16 - 1) * 16 + tok) * 512 + h * 64 + v0 + r2) = *(const float2*)(yob + 512 + tok * 32 + r2); }
        } else {
            const int rp = tid >> 4, ks = tid & 15;
            float A0 = 0.f, A1 = 0.f, A2 = 0.f, A3 = 0.f, B0 = 0.f, B1 = 0.f, B2 = 0.f, B3 = 0.f;
            const int ywoff = (ks == 0) ? 2 * rp : (2 * 512 + 2 * tid), ywstep = (ks == 0) ? 32 : 0;
            lds_barrier();
            f32x4 rprev = {0.f, 0.f, 0.f, 0.f}; float* ywp = yob + 2 * 512 + 2 * tid;
            for (int ch = 0; ch < SEQ / 16; ++ch) {
                const int cur = ch & 1;
                const float* ops = opsb + cur * 5120 + ks * 4; const float* vv = vvb + cur * 512 + 2 * rp; float* yw = yob + cur * 512 + ywoff;
                if (mode != 1) {
#pragma unroll
                for (int s = 0; s < 16; ++s) {
                    const float* o = ops + s * 320;
                    const f32x4 a4 = *(const f32x4*)(o), w4 = *(const f32x4*)(o + 64), b4 = *(const f32x4*)(o + 128), k4 = *(const f32x4*)(o + 192), r4 = *(const f32x4*)(o + 256);
                    const float2 vab = *(const float2*)(vv + s * 32);
                    float sa = (A0 * a4[0] + A1 * a4[1]) + (A2 * a4[2] + A3 * a4[3]); float sb = (B0 * a4[0] + B1 * a4[1]) + (B2 * a4[2] + B3 * a4[3]);
                    float ya = (A0 * rprev[0] + A1 * rprev[1]) + (A2 * rprev[2] + A3 * rprev[3]); float yb2 = (B0 * rprev[0] + B1 * rprev[1]) + (B2 * rprev[2] + B3 * rprev[3]);
                    red16x4(sa, sb, ya, yb2);
                    *(float2*)(ywp) = make_float2(ya, yb2);
                    ywp = yw + s * ywstep;
                    A0 = A0 * w4[0] + sa * b4[0] + vab.x * k4[0]; A1 = A1 * w4[1] + sa * b4[1] + vab.x * k4[1];
                    A2 = A2 * w4[2] + sa * b4[2] + vab.x * k4[2]; A3 = A3 * w4[3] + sa * b4[3] + vab.x * k4[3];
                    B0 = B0 * w4[0] + sb * b4[0] + vab.y * k4[0]; B1 = B1 * w4[1] + sb * b4[1] + vab.y * k4[1];
                    B2 = B2 * w4[2] + sb * b4[2] + vab.y * k4[2]; B3 = B3 * w4[3] + sb * b4[3] + vab.y * k4[3];
                    rprev = r4;
                }
                {
                    float ya = (A0 * rprev[0] + A1 * rprev[1]) + (A2 * rprev[2] + A3 * rprev[3]); float yb2 = (B0 * rprev[0] + B1 * rprev[1]) + (B2 * rprev[2] + B3 * rprev[3]);
                    float d0 = 0.f, d1 = 0.f; red16x4(ya, yb2, d0, d1);
                    *(float2*)(ywp) = make_float2(ya, yb2); ywp = yob + 2 * 512 + 2 * tid; rprev = (f32x4){0.f, 0.f, 0.f, 0.f};
                } }
                lds_barrier();
            }
        }
        __syncthreads();
    }
}

__device__ __forceinline__ unsigned ordkey(float f) { const unsigned u = __float_as_uint(f); return (u & 0x80000000u) ? ~u : (u | 0x80000000u); }

__device__ __forceinline__ void attn_chunk(const unsigned char* kb, const unsigned char* vb, const unsigned* selm, int c, int p, int fr, int fq, const bf16x8 (&Bqa)[2][2], f32x4 (&O)[2][4], f32x4 (&RS)[2]) {
    const f32x4 zero4 = {0.f, 0.f, 0.f, 0.f};
    const u32x4 onesu = {0x3f803f80u, 0x3f803f80u, 0x3f803f80u, 0x3f803f80u}; const bf16x8 ones = __builtin_bit_cast(bf16x8, onesu);
    const float csc = 0.125f * 1.4426950408889634f;
    const unsigned char* k0p = kb + ((2 * p) * 16 + fr) * 144 + fq * 16; const unsigned char* k1p = k0p + 16 * 144;
    const bf16x8 KA00 = *(const bf16x8*)(k0p), KA01 = *(const bf16x8*)(k0p + 64), KA10 = *(const bf16x8*)(k1p), KA11 = *(const bf16x8*)(k1p + 64);
    const int mw = (int)selm[fr * 64 + 2 * c + p];
    bf16x8 VA[4];
#pragma unroll
    for (int dt = 0; dt < 4; ++dt) { const unsigned char* vp = vb + (dt * 16 + fr) * 144 + (2 * p) * 32 + fq * 8;
        const uint2 lo = *(const uint2*)(vp), hi = *(const uint2*)(vp + 32);
        u32x4 va; va.x = lo.x; va.y = lo.y; va.z = hi.x; va.w = hi.y; VA[dt] = __builtin_bit_cast(bf16x8, va); }
    unsigned km0[4], km1[4];
#pragma unroll
    for (int jj = 0; jj < 4; ++jj) { km0[jj] = (unsigned)__builtin_amdgcn_sbfe(mw, fq * 4 + jj, 1); km1[jj] = (unsigned)__builtin_amdgcn_sbfe(mw, 16 + fq * 4 + jj, 1); }
#pragma unroll
    for (int hh = 0; hh < 2; ++hh) {
        f32x4 s0 = __builtin_amdgcn_mfma_f32_16x16x32_bf16(KA00, Bqa[hh][0], zero4, 0, 0, 0); s0 = __builtin_amdgcn_mfma_f32_16x16x32_bf16(KA01, Bqa[hh][1], s0, 0, 0, 0);
        f32x4 s1 = __builtin_amdgcn_mfma_f32_16x16x32_bf16(KA10, Bqa[hh][0], zero4, 0, 0, 0); s1 = __builtin_amdgcn_mfma_f32_16x16x32_bf16(KA11, Bqa[hh][1], s1, 0, 0, 0);
        unsigned p0[4], p1[4];
#pragma unroll
        for (int jj = 0; jj < 4; ++jj) {
            p0[jj] = __float_as_uint(__builtin_amdgcn_exp2f(fminf(s0[jj] * csc, 86.f))) & km0[jj]; p1[jj] = __float_as_uint(__builtin_amdgcn_exp2f(fminf(s1[jj] * csc, 86.f))) & km1[jj]; }
        u32x4 pk; pk.x = cvt_pk_bf16(__uint_as_float(p0[0]), __uint_as_float(p0[1])); pk.y = cvt_pk_bf16(__uint_as_float(p0[2]), __uint_as_float(p0[3]));
        pk.z = cvt_pk_bf16(__uint_as_float(p1[0]), __uint_as_float(p1[1])); pk.w = cvt_pk_bf16(__uint_as_float(p1[2]), __uint_as_float(p1[3]));
        const bf16x8 PB = __builtin_bit_cast(bf16x8, pk);
        RS[hh] = __builtin_amdgcn_mfma_f32_16x16x32_bf16(ones, PB, RS[hh], 0, 0, 0);
#pragma unroll
        for (int dt = 0; dt < 4; ++dt) O[hh][dt] = __builtin_amdgcn_mfma_f32_16x16x32_bf16(VA[dt], PB, O[hh][dt], 0, 0, 0);
    }
}

__device__ __forceinline__ void p3_dsa(const Frame& F) {
    const int tid = F.tid, lane = F.lane, wave = F.wave, fr = lane & 15, fq = lane >> 4;
    unsigned* scl = (unsigned*)g_lds;
    unsigned* selm = (unsigned*)(g_lds + 131328);
    unsigned char* kbuf = (unsigned char*)g_lds;
    unsigned char* vbuf = kbuf + 2 * 9216;
    const bf16_t* z = F.z; const int G = gridDim.x, bx = blockIdx.x;
    const f32x4 zero4 = {0.f, 0.f, 0.f, 0.f};
    for (int rnd = 0; rnd * G < 2048; ++rnd) {
        const int n = rnd * G + ((rnd & 1) ? (G - 1 - bx) : bx);
        if (n >= 2048) continue;
        const int qg = 127 - (n >> 4), b = n & 15, q0 = qg * 16; const size_t Tb = (size_t)b * SEQ;
        for (int i = tid; i < 1024; i += NTHR) selm[i] = 0u;
        __syncthreads();
        const bf16_t* zq = z + (Tb + q0 + fr) * ZLD;
        const unsigned lofk = (unsigned)((fr * ZLD + fq * 8) * 2), lofv = (unsigned)((fr * SEQ + fq * 4) * 2);
        const int nchunk = (qg + 4) >> 2; const int lrow = tid >> 3, lseg = tid & 7;
        const bf16_t* kg = z + (Tb + lrow) * ZLD + C_KA + lseg * 8; const bf16_t* vg = F.vt + ((size_t)b * 64 + lrow) * SEQ + lseg * 8;
        const unsigned lst = (unsigned)(lrow * 144 + lseg * 16);
        const int hp = wave >> 1, kh = wave & 1;
        const u32x4 kc0 = *(const u32x4*)(kg), vc0 = *(const u32x4*)(vg);
        u32x4 kx = kc0, vx = vc0, ky = kc0, vy = vc0;
        if (1 < nchunk) { kx = *(const u32x4*)(kg + (size_t)64 * ZLD); vx = *(const u32x4*)(vg + 64); }
        if (2 < nchunk) { ky = *(const u32x4*)(kg + (size_t)128 * ZLD); vy = *(const u32x4*)(vg + 128); }
        bf16x8 Bqa[2][2];
#pragma unroll
        for (int hh = 0; hh < 2; ++hh)
#pragma unroll
            for (int ks = 0; ks < 2; ++ks) Bqa[hh][ks] = *(const bf16x8*)(zq + C_Q + (2 * hp + hh) * 64 + ks * 32 + fq * 8);
        if (qg >= 16) {
            const u32x4 wv = *(const u32x4*)(zq + C_WI);
            {
                bf16x8 Bq[8][2];
#pragma unroll
                for (int hh = 0; hh < 8; ++hh)
#pragma unroll
                    for (int ks = 0; ks < 2; ++ks) Bq[hh][ks] = *(const bf16x8*)(zq + C_QI + hh * 64 + ks * 32 + fq * 8);
                const float sc = 0.044194173824159216f;
                float wih[8]; wih[0] = bflo(wv.x) * sc; wih[1] = bfhi(wv.x) * sc; wih[2] = bflo(wv.y) * sc; wih[3] = bfhi(wv.y) * sc; wih[4] = bflo(wv.z) * sc; wih[5] = bfhi(wv.z) * sc; wih[6] = bflo(wv.w) * sc; wih[7] = bfhi(wv.w) * sc;
#pragma unroll 1
                for (int half = 0; half < 2; ++half) {
                    const int ktb = wave + 64 * half; if (ktb > qg) break;
                    bf16x8 W0[2], W1[2];
#pragma unroll
                    for (int j = 0; j < 2; ++j) { const int ktj = (ktb + 8 * j) < qg ? (ktb + 8 * j) : qg; const char* kb = (const char*)(z + (Tb + (size_t)ktj * 16) * ZLD + C_KI);
                        W0[j] = *(const bf16x8*)(kb + lofk); W1[j] = *(const bf16x8*)(kb + lofk + 64); }
#pragma unroll
                    for (int i = 0; i < 8; ++i) { const int kt = ktb + 8 * i;
                        if (kt <= qg) { f32x4 sv = zero4;
#pragma unroll
                            for (int hh = 0; hh < 8; ++hh) { f32x4 acc = __builtin_amdgcn_mfma_f32_16x16x32_bf16(W0[i & 1], Bq[hh][0], zero4, 0, 0, 0);
                                acc = __builtin_amdgcn_mfma_f32_16x16x32_bf16(W1[i & 1], Bq[hh][1], acc, 0, 0, 0);
#pragma unroll
                                for (int jj = 0; jj < 4; ++jj) sv[jj] += wih[hh] * fmaxf(acc[jj], 0.f); }
                            u32x4 w; w.x = ordkey(sv[0]); w.y = ordkey(sv[1]); w.z = ordkey(sv[2]); w.w = ordkey(sv[3]);
                            *(u32x4*)(scl + fr * 2052 + kt * 16 + fq * 4) = w;
                        }
                        if (i + 2 < 8) { const int ktn = (kt + 16) < qg ? (kt + 16) : qg; const char* kb = (const char*)(z + (Tb + (size_t)ktn * 16) * ZLD + C_KI);
                            unsigned lo2 = lofk; asm volatile("" : "+v"(lo2));
                            W0[i & 1] = *(const bf16x8*)(kb + lo2); W1[i & 1] = *(const bf16x8*)(kb + lo2 + 64); }
                    }
                }
            }
            __syncthreads();
#pragma unroll 1
            for (int qq = 0; qq < 2; ++qq) {
                const int q = 2 * wave + qq, qpos = q0 + q;
                unsigned uk[32];
#pragma unroll
                for (int r = 0; r < 32; ++r) { const int key = r * 64 + lane; uk[r] = 0x007fffffu;
                    if (r * 64 <= qpos) { const unsigned v = scl[q * 2052 + key]; uk[r] = (key <= qpos) ? v : 0x007fffffu; } }
                unsigned T = 0u; bool exact = false;
#pragma unroll 1
                for (int bit = 31; bit >= 0; --bit) {
                    const unsigned cand = T | (1u << bit); int c = 0;
#pragma unroll
                    for (int g = 0; g < 4; ++g) {
                        if (g * 512 > qpos) break;
                        unsigned long long m[8];
                        asm("v_cmp_ge_u32_e64 %0, %8, %16\n\tv_cmp_ge_u32_e64 %1, %9, %16\n\tv_cmp_ge_u32_e64 %2, %10, %16\n\tv_cmp_ge_u32_e64 %3, %11, %16\n\t"
                            "v_cmp_ge_u32_e64 %4, %12, %16\n\tv_cmp_ge_u32_e64 %5, %13, %16\n\tv_cmp_ge_u32_e64 %6, %14, %16\n\tv_cmp_ge_u32_e64 %7, %15, %16"
                            : "=&s"(m[0]), "=&s"(m[1]), "=&s"(m[2]), "=&s"(m[3]), "=&s"(m[4]), "=&s"(m[5]), "=&s"(m[6]), "=&s"(m[7])
                            : "v"(uk[g * 8 + 0]), "v"(uk[g * 8 + 1]), "v"(uk[g * 8 + 2]), "v"(uk[g * 8 + 3]), "v"(uk[g * 8 + 4]), "v"(uk[g * 8 + 5]), "v"(uk[g * 8 + 6]), "v"(uk[g * 8 + 7]), "v"(cand));
#pragma unroll
                        for (int j = 0; j < 8; ++j) c += __builtin_popcountll(m[j]);
                    }
                    if (c >= 256) { T = cand; if (c == 256) { exact = true; break; } }
                }
                int need = 0;
                if (!exact) { int c = 0;
#pragma unroll
                    for (int r = 0; r < 32; ++r) c += __builtin_popcountll(__builtin_amdgcn_ballot_w64(uk[r] > T));
                    need = 256 - c; }
#pragma unroll
                for (int r = 0; r < 32; ++r) {
                    if (r * 64 <= qpos) {
                        unsigned long long sel;
                        if (exact) sel = __builtin_amdgcn_ballot_w64(uk[r] >= T);
                        else { sel = __builtin_amdgcn_ballot_w64(uk[r] > T); unsigned long long e = __builtin_amdgcn_ballot_w64(uk[r] == T);
                            const int ne = __builtin_popcountll(e);
                            if (ne <= need) { sel |= e; need -= ne; }
                            else { for (int k = 0; k < need; ++k) { const unsigned long long lb = e & (0ull - e); sel |= lb; e ^= lb; } need = 0; } }
                        if (lane == 0) { selm[q * 64 + 2 * r] = (unsigned)sel; selm[q * 64 + 2 * r + 1] = (unsigned)(sel >> 32); }
                    }
                }
            }
        } else {
            for (int w = tid; w < 1024; w += NTHR) { const int q = w >> 6, word = w & 63, qpos = q0 + q, lo = word * 32;
                selm[w] = (qpos >= lo + 31) ? 0xffffffffu : (qpos < lo ? 0u : ((2u << (qpos - lo)) - 1u)); }
        }
        __syncthreads();
        {
            *(u32x4*)(kbuf + lst) = kc0; *(u32x4*)(vbuf + lst) = vc0;
            f32x4 O[2][4]; f32x4 rs[2];
#pragma unroll
            for (int hh = 0; hh < 2; ++hh) { rs[hh] = zero4;
#pragma unroll
                for (int dt = 0; dt < 4; ++dt) O[hh][dt] = zero4; }
            lds_barrier();
#pragma unroll 1
            for (int c = 0; c < nchunk; c += 2) {
                attn_chunk(kbuf, vbuf, selm, c, kh, fr, fq, Bqa, O, rs);
                if (c + 1 < nchunk) { *(u32x4*)(kbuf + 9216 + lst) = kx; *(u32x4*)(vbuf + 9216 + lst) = vx; }
                if (c + 3 < nchunk) { kx = *(const u32x4*)(kg + (size_t)(c + 3) * 64 * ZLD); vx = *(const u32x4*)(vg + (c + 3) * 64); }
                lds_barrier();
                if (c + 1 < nchunk) {
                    attn_chunk(kbuf + 9216, vbuf + 9216, selm, c + 1, kh, fr, fq, Bqa, O, rs);
                    if (c + 2 < nchunk) { *(u32x4*)(kbuf + lst) = ky; *(u32x4*)(vbuf + lst) = vy; }
                    if (c + 4 < nchunk) { ky = *(const u32x4*)(kg + (size_t)(c + 4) * 64 * ZLD); vy = *(const u32x4*)(vg + (c + 4) * 64); }
                    lds_barrier();
                }
            }
            float* xb = (float*)(vbuf + 2 * 9216) + (size_t)wave * (64 * 17);
            { const int oh = kh ^ 1;
#pragma unroll
              for (int dt = 0; dt < 4; ++dt)
#pragma unroll
                  for (int jj = 0; jj < 4; ++jj) xb[(dt * 4 + jj) * 64 + lane] = (oh == 0) ? O[0][dt][jj] : O[1][dt][jj];
              xb[16 * 64 + lane] = (oh == 0) ? rs[0][0] : rs[1][0]; }
            lds_barrier();
            { const float* pb = (const float*)(vbuf + 2 * 9216) + (size_t)(wave ^ 1) * (64 * 17);
              float tot = ((kh == 0) ? rs[0][0] : rs[1][0]) + pb[16 * 64 + lane];
              const float inv = 1.0f / tot;
              bf16_t* yp = F.yb + (Tb + q0 + fr) * 512 + (2 * hp + kh) * 64 + fq * 4;
#pragma unroll
              for (int dt = 0; dt < 4; ++dt) { float o[4];
#pragma unroll
                  for (int jj = 0; jj < 4; ++jj) o[jj] = (((kh == 0) ? O[0][dt][jj] : O[1][dt][jj]) + pb[(dt * 4 + jj) * 64 + lane]) * inv;
                  uint2 w; w.x = cvt_pk_bf16(o[0], o[1]); w.y = cvt_pk_bf16(o[2], o[3]); *(uint2*)(yp + dt * 16) = w; } }
        }
        __syncthreads();
    }
}

struct P4In { f32x4 y; uint2 vc, vp, gt; float bon; };
__device__ __forceinline__ void p4_load(P4In& I, const Frame& F, int g, int c) { const size_t t = (size_t)(g >> 3); const bf16_t* z = F.z;
    I.y = __builtin_nontemporal_load((const f32x4*)(F.yraw + t * 512 + c)); I.vc = *(const uint2*)(z + t * ZLD + C_V + c); I.vp = make_uint2(0u, 0u); if (t & (SEQ - 1)) I.vp = *(const uint2*)(z + (t - 1) * ZLD + C_V + c);
    { typedef unsigned u32x2v __attribute__((ext_vector_type(2))); const u32x2v gv = __builtin_nontemporal_load((const u32x2v*)(F.gt + t * 512 + c)); I.gt = make_uint2(gv.x, gv.y); } I.bon = F.bonus[t * 8 + (g & 7)]; }
__device__ __forceinline__ void p4_finish(const P4In& I, const Frame& F, int g, int c, const f32x4& m4, const f32x4& w4, const f32x4& b4) { const size_t t = (size_t)(g >> 3);
    const f32x4 y = I.y; const float mean = red16((y[0] + y[1]) + (y[2] + y[3])) * (1.0f / 64.0f); const f32x4 d = y - mean;
    const float var = red16((d[0] * d[0] + d[1] * d[1]) + (d[2] * d[2] + d[3] * d[3])) * (1.0f / 64.0f); const float rstd = rsqrtf(var + 64e-5f);
    f32x4 vcf, vpf, gtf; vcf[0] = bflo(I.vc.x); vcf[1] = bfhi(I.vc.x); vcf[2] = bflo(I.vc.y); vcf[3] = bfhi(I.vc.y); vpf[0] = bflo(I.vp.x); vpf[1] = bfhi(I.vp.x); vpf[2] = bflo(I.vp.y); vpf[3] = bfhi(I.vp.y);
    gtf[0] = bflo(I.gt.x); gtf[1] = bfhi(I.gt.x); gtf[2] = bflo(I.gt.y); gtf[3] = bfhi(I.gt.y);
    const f32x4 vs = vcf + (vpf - vcf) * m4; const f32x4 o = (d * rstd * w4 + b4 + vs * I.bon) * gtf;
    uint2 w; w.x = cvt_pk_bf16(o[0], o[1]); w.y = cvt_pk_bf16(o[2], o[3]); *(uint2*)(F.ya + t * 512 + c) = w; }
__device__ __forceinline__ void p4_post(const Frame& F) {
    const int tid = F.tid; const float* mu = F.in[3]; const float* gnw = F.in[12]; const float* gnb = F.in[13];
    const int gstep = gridDim.x * 32, g0 = blockIdx.x * 32 + (tid >> 4), c = (g0 & 7) * 64 + (tid & 15) * 4;
    const f32x4 m4 = *(const f32x4*)(mu + C_V + c), w4 = *(const f32x4*)(gnw + c), b4 = *(const f32x4*)(gnb + c);
    for (int g = g0; g < NTOK * 8; g += 2 * gstep) { const int g2 = g + gstep; const bool two = g2 < NTOK * 8;
        P4In A, B; p4_load(A, F, g, c); if (two) p4_load(B, F, g2, c);
        p4_finish(A, F, g, c, m4, w4, b4); if (two) p4_finish(B, F, g2, c, m4, w4, b4); }
}

__device__ __forceinline__ void p9_final(const Frame& F, const bool ident) {
    const float* g = F.in[19]; const int lane = F.lane; const int rstep = gridDim.x * 8;
    f32x4 gg[4];
#pragma unroll
    for (int i = 0; i < 4; ++i) gg[i] = *(const f32x4*)(g + (i >> 1) * 512 + lane * 8 + (i & 1) * 4);
    for (int row = blockIdx.x * 8 + F.wave; row < NTOK; row += 2 * rstep) {
        const int row2 = (row + rstep) < NTOK ? row + rstep : row; const bool two = row2 != row;
        u32x4 a[2], b[2];
#pragma unroll
        for (int i = 0; i < 2; ++i) { a[i] = __builtin_nontemporal_load((const u32x4*)(F.xb + (size_t)row * DM + i * 512 + lane * 8)); b[i] = __builtin_nontemporal_load((const u32x4*)(F.xb + (size_t)row2 * DM + i * 512 + lane * 8)); }
        const float sc = ident ? 1.0f : rsqrtf(F.ss2[row] * (1.0f / 1024.0f) + 1e-6f), sc2 = ident ? 1.0f : rsqrtf(F.ss2[row2] * (1.0f / 1024.0f) + 1e-6f);
#pragma unroll
        for (int i = 0; i < 2; ++i) {
            f32x4 v0, v1, u0, u1;
            v0[0] = bflo(a[i].x); v0[1] = bfhi(a[i].x); v0[2] = bflo(a[i].y); v0[3] = bfhi(a[i].y); v1[0] = bflo(a[i].z); v1[1] = bfhi(a[i].z); v1[2] = bflo(a[i].w); v1[3] = bfhi(a[i].w);
            u0[0] = bflo(b[i].x); u0[1] = bfhi(b[i].x); u0[2] = bflo(b[i].y); u0[3] = bfhi(b[i].y); u1[0] = bflo(b[i].z); u1[1] = bfhi(b[i].z); u1[2] = bflo(b[i].w); u1[3] = bfhi(b[i].w);
            if (!ident) { v0 = v0 * gg[2 * i] * sc; v1 = v1 * gg[2 * i + 1] * sc; u0 = u0 * gg[2 * i] * sc2; u1 = u1 * gg[2 * i + 1] * sc2; }
            float* o1 = F.out + (size_t)row * DM + i * 512 + lane * 8; float* o2 = F.out + (size_t)row2 * DM + i * 512 + lane * 8;
            __builtin_nontemporal_store(v0, (f32x4*)o1); __builtin_nontemporal_store(v1, (f32x4*)(o1 + 4));
            if (two) { __builtin_nontemporal_store(u0, (f32x4*)o2); __builtin_nontemporal_store(u1, (f32x4*)(o2 + 4)); } }
    }
}
#define XB_TMO      128
#define XB_XCNT(j)  (256  + 64 * (j))
#define XB_XSUB(j)  (1280 + 64 * (j))
#define XB_XGEN(j)  (2304 + 64 * (j))
#define XB_TOP      3328
#define XB_TOPGEN   3392
#define XCD_BAR_WORDS 3456
#define XB_SPIN_CAP (1u << 18)
#define LAS __attribute__((address_space(3)))

__device__ __forceinline__ unsigned xb_ld(unsigned* p)              { return __hip_atomic_load(p, __ATOMIC_RELAXED, __HIP_MEMORY_SCOPE_AGENT); }
__device__ __forceinline__ unsigned xb_add(unsigned* p, unsigned v) { return __hip_atomic_fetch_add(p, v, __ATOMIC_RELAXED, __HIP_MEMORY_SCOPE_AGENT); }
__device__ __forceinline__ unsigned xb_xcc_id() { return (unsigned)__builtin_amdgcn_s_getreg((3 << 11) | 20) & 0xFu; }
#define XB_SPIN(cond, bar) do { unsigned _sp = 0; while (cond) { __builtin_amdgcn_s_sleep(1); \
    if ((++_sp & 255u) == 0u) { if (xb_ld(&(bar)[XB_TMO])) break; if (_sp > XB_SPIN_CAP) { atomicAdd(&(bar)[XB_TMO], 1u); break; } } } } while (0)

struct XcdBarrier {
    unsigned* bar; unsigned x;
    volatile LAS unsigned* st;
};

__device__ __forceinline__ XcdBarrier xcd_barrier_post(unsigned* bar, volatile LAS unsigned* st) {
    XcdBarrier b; b.bar = bar; b.x = xb_xcc_id(); b.st = st;
    if (threadIdx.x == 0) (void)xb_add(&bar[XB_XCNT(b.x)], 1u);
    return b;
}
__device__ __forceinline__ void xcd_barrier_complete(unsigned* bar, unsigned x, unsigned& nloc, unsigned& nx) {
    const unsigned G = gridDim.x * gridDim.y * gridDim.z;
    unsigned sum, cnt, mine, sp = 0u;
    for (;;) {
        sum = 0u; cnt = 0u; mine = 0u;
#pragma unroll
        for (unsigned j = 0; j < 16; ++j) { const unsigned c = xb_ld(&bar[XB_XCNT(j)]); sum += c; cnt += (c > 0u) ? 1u : 0u; mine = (j == x) ? c : mine; }
        if (sum == G) break;
        __builtin_amdgcn_s_sleep(1);
        if ((++sp & 255u) == 0u) { if (xb_ld(&bar[XB_TMO])) break; if (sp > XB_SPIN_CAP) { atomicAdd(&bar[XB_TMO], 1u); break; } }
    }
    nloc = mine > 0u ? mine : 1u; nx = cnt > 0u ? cnt : 1u;
}

__device__ __forceinline__ void xcd_barrier(const XcdBarrier& b) {
    asm volatile("s_waitcnt vmcnt(0)" ::: "memory");
    __syncthreads();
    if (threadIdx.x == 0) {
        unsigned* bar = b.bar;
        __builtin_amdgcn_s_waitcnt(0);
        unsigned nloc = b.st[0], nx = b.st[1];
        if (nloc == 0u) { xcd_barrier_complete(bar, b.x, nloc, nx); b.st[0] = nloc; b.st[1] = nx; }
        const unsigned old = xb_add(&bar[XB_XSUB(b.x)], 1u);
        const unsigned gen = old / nloc;
        if (old + 1u == (gen + 1u) * nloc) {
            __builtin_amdgcn_fence(__ATOMIC_RELEASE, "agent");
            asm volatile("s_waitcnt vmcnt(0)" ::: "memory");
            const unsigned og = xb_add(&bar[XB_TOP], 1u);
            const unsigned tg = og / nx;
            if (og + 1u == (tg + 1u) * nx) xb_add(&bar[XB_TOPGEN], 1u);
            else XB_SPIN(xb_ld(&bar[XB_TOPGEN]) == tg, bar);
            __builtin_amdgcn_fence(__ATOMIC_ACQUIRE, "agent");
            xb_add(&bar[XB_XGEN(b.x)], 1u);
            asm volatile("s_waitcnt vmcnt(0)" ::: "memory");
        } else {
            XB_SPIN(xb_ld(&bar[XB_XGEN(b.x)]) == gen, bar);
            __builtin_amdgcn_fence(__ATOMIC_ACQUIRE, "agent");
            asm volatile("s_waitcnt vmcnt(0)" ::: "memory");
        }
    }
    __syncthreads();
}
#ifndef PHASE_MASK
#define PHASE_MASK 0x3ff
#endif
#ifndef GEMM_ALIGN
#define GEMM_ALIGN true
#endif
#ifndef GEMM_SP2
#define GEMM_SP2 true
#endif
constexpr int NPHASE = 10;
constexpr size_t WS_BAR = 3 * MiB;
template <class Epi> __device__ __forceinline__ void run_gemm(const bf16_t* A, const bf16_t* Bt, int N, int K, const Epi& E) {
    pg8::Gemm g{A, Bt, NTOK, N, K}; pg8::StaticOrder S; S.init(NTOK, N, (int)gridDim.x, (int)blockIdx.x);
    pg8::gemm_phase<Epi, pg8::StaticOrder, GEMM_ALIGN, GEMM_SP2>((PG8_LAS unsigned char*)g_lds, g, S, E);
}
__global__ void __launch_bounds__(NTHR, 2) mega_fwd(Args args) {
    Frame F;
#pragma unroll
    for (int i = 0; i < 20; ++i) F.in[i] = args.in[i];
    F.out = args.out; F.ws = args.ws; F.lds = nullptr; F.tid = threadIdx.x; F.lane = F.tid & 63; F.wave = __builtin_amdgcn_readfirstlane(F.tid >> 6);
    unsigned char* ws = args.ws;
    F.ss1 = (float*)(ws + WS_SS1); F.ss2 = (float*)(ws + WS_SS2); F.bonus = (float*)(ws + WS_BONUS); F.rope = (float2*)(ws + WS_ROPE);
    F.wd = (bf16_t*)(ws + WS_WD); F.wi = (bf16_t*)(ws + WS_WI); F.wg = (bf16_t*)(ws + WS_WG);
    F.win = (bf16_t*)(ws + WS_WIN); F.wup = (bf16_t*)(ws + WS_WUP); F.wdn = (bf16_t*)(ws + WS_WDN); F.wb = (bf16_t*)(ws + WS_WB); F.wo = (bf16_t*)(ws + WS_WO); F.vt = (bf16_t*)(ws + WS_VT);
    F.h = (bf16_t*)(ws + WS_H); F.ya = F.h; F.yb = F.h + (size_t)NTOK * 512; F.xb = F.h;
    F.z = (bf16_t*)(ws + WS_Z); F.hid = F.z;
    F.lw = (bf16_t*)(ws + WS_P); F.ic = F.lw + (size_t)NTOK * 512; F.mg = F.lw;
    F.yraw = args.out; F.gt = (bf16_t*)(args.out + (size_t)NTOK * 512);
    const int lo = args.ph_lo, hi = args.ph_hi;
    cg::grid_group grid = cg::this_grid();
    if (args.ph_lo < 0) grid.sync();
    volatile LAS unsigned* xst = (volatile LAS unsigned*)(g_lds + LDS_BYTES - 64);
    if (threadIdx.x == 0) { xst[0] = 0u; xst[1] = 0u; }
    __syncthreads();
    XcdBarrier xbar = xcd_barrier_post((unsigned*)(ws + WS_BAR), xst);
#define IN(k) (lo <= (k) && (k) < hi)
#define SEAM(k) do { if (IN(k) && IN((k) + 1)) { xcd_barrier(xbar); if (REP(17)) xcd_barrier(xbar); } } while (0)
    if (((PHASE_MASK >> 0) & 1) && IN(0)) { p0_prologue(F); __syncthreads(); if (REP(0)) { p0_prologue(F); __syncthreads(); } } SEAM(0);
    if (((PHASE_MASK >> 1) & 1) && IN(1)) { pg8::EpiZ E{F.z, ZLD, 12}; run_gemm(F.h, F.win, 5120, 1024, E); __syncthreads(); if (REP(1)) { run_gemm(F.h, F.win, 5120, 1024, E); __syncthreads(); } if (REP(18)) { run_gemm(F.h, F.win, 4096, 1024, E); __syncthreads(); } } SEAM(1);
    if (((PHASE_MASK >> 2) & 1) && IN(2)) { if (REP(2)) { p2_prep(F, 0); __syncthreads(); } if (REP(16)) { p2_prep(F, 2); __syncthreads(); } p2_prep(F, 1); __syncthreads(); } SEAM(2);
    if (((PHASE_MASK >> 3) & 1) && IN(3)) { if (REP(14)) { p3_scan(F, 1); __syncthreads(); } if (REP(15)) { p3_scan(F, 2); __syncthreads(); } if (REP(3)) { p3_scan(F, 0); __syncthreads(); } p3_scan(F, 0); __syncthreads(); p3_dsa(F); __syncthreads(); if (REP(10)) { p3_dsa(F); __syncthreads(); } } SEAM(3);
    if (((PHASE_MASK >> 4) & 1) && IN(4)) { p4_post(F); __syncthreads(); if (REP(4)) { p4_post(F); __syncthreads(); } } SEAM(4);
    if (((PHASE_MASK >> 5) & 1) && IN(5)) { pg8::EpiGate<0> E0{F.mg, F.z, ZLD, C_G0}; run_gemm(F.ya, F.wb, 1024, 512, E0); __syncthreads();
                 pg8::EpiGate<1> E1{F.mg, F.z, ZLD, C_G1}; run_gemm(F.yb, F.wb + 1024 * 512, 1024, 512, E1); __syncthreads();
                 if (REP(5)) { run_gemm(F.ya, F.wb, 1024, 512, E0); __syncthreads(); run_gemm(F.yb, F.wb + 1024 * 512, 1024, 512, E1); __syncthreads(); } } SEAM(5);
    if (((PHASE_MASK >> 6) & 1) && IN(6)) { if (REP(6)) { pg8::EpiRes1 Ex{F.in[0], F.xb, F.bonus}; run_gemm(F.mg, F.wo, 1024, 1024, Ex); __syncthreads(); }
                 pg8::EpiRes1 E{F.in[0], F.xb, F.ss1}; run_gemm(F.mg, F.wo, 1024, 1024, E); __syncthreads(); } SEAM(6);
    if (((PHASE_MASK >> 7) & 1) && IN(7)) { pg8::EpiHid E{F.hid, F.ss1}; run_gemm(F.xb, F.wup, 4096, 1024, E); __syncthreads(); if (REP(7)) { run_gemm(F.xb, F.wup, 4096, 1024, E); __syncthreads(); } } SEAM(7);
    if (((PHASE_MASK >> 8) & 1) && IN(8)) { pg8::EpiRes2 E{F.xb, F.ss2}; run_gemm(F.hid, F.wdn, 1024, 4096, E); __syncthreads(); } SEAM(8);
    if (((PHASE_MASK >> 9) & 1) && IN(9)) { if (REP(9)) { p9_final(F, true); __syncthreads(); } p9_final(F, false); }
#undef IN
#undef SEAM
}

extern "C" void kernel_launch(void* const* d_in, const int* in_sizes, int n_in, void* d_out, int out_size, void* d_ws, size_t ws_size, hipStream_t stream) {
    static int grid = 0;
    if (grid == 0) {
        if (n_in != 20 || out_size != NTOK * DM || ws_size < WS_END) { fprintf(stderr, "kernel_launch: unexpected shapes (n_in %d, out %d, ws %zu < %zu)\n", n_in, out_size, ws_size, (size_t)WS_END); grid = -1; return; }
        int dev = 0, cus = 0, per_cu = 0;
        hipGetDevice(&dev); hipDeviceGetAttribute(&cus, hipDeviceAttributeMultiprocessorCount, dev);
        if (hipFuncSetAttribute((const void*)mega_fwd, hipFuncAttributeMaxDynamicSharedMemorySize, LDS_BYTES) != hipSuccess) { fprintf(stderr, "kernel_launch: hipFuncSetAttribute failed\n"); grid = -1; return; }
        if (hipOccupancyMaxActiveBlocksPerMultiprocessor(&per_cu, (const void*)mega_fwd, NTHR, LDS_BYTES) != hipSuccess || per_cu < 1) { fprintf(stderr, "kernel_launch: occupancy query failed (%d)\n", per_cu); per_cu = 1; }
        (void)hipGetLastError();
        grid = cus * per_cu;
        fprintf(stderr, "kernel_launch: grid %d (%d CUs x %d)\n", grid, cus, per_cu);
    }
    if (grid < 0) return;
    if (hipMemsetAsync((char*)d_ws + WS_BAR, 0, XCD_BAR_WORDS * 4, stream) != hipSuccess) { fprintf(stderr, "kernel_launch: memset of the barrier words failed\n"); return; }
    Args a{};
    for (int i = 0; i < 20; ++i) a.in[i] = (const float*)d_in[i];
    a.out = (float*)d_out; a.ws = (unsigned char*)d_ws;
#if MK_PER_PHASE_LAUNCH
    for (int p = 0; p < NPHASE; ++p) { a.ph_lo = p; a.ph_hi = p + 1; hipLaunchKernelGGL(mega_fwd, dim3(grid), dim3(NTHR), LDS_BYTES, stream, a); }
#else
    a.ph_lo = 0; a.ph_hi = NPHASE;
    void* kargs[] = {&a};
    hipError_t e = hipLaunchCooperativeKernel((const void*)mega_fwd, dim3(grid), dim3(NTHR), kargs, LDS_BYTES, stream);
    if (e != hipSuccess) fprintf(stderr, "kernel_launch: cooperative launch failed: %s (grid %d)\n", hipGetErrorString(e), grid);
#endif
}
```

```cpp
#include <hip/hip_runtime.h>
#include <hip/hip_cooperative_groups.h>
#include <cstdio>
#include <cstdint>
namespace cg = cooperative_groups;

#ifndef MK_PER_PHASE_LAUNCH
#define MK_PER_PHASE_LAUNCH 0
#endif

#ifndef REPEAT_MASK
#define REPEAT_MASK 0
#endif
#define REP(k) ((REPEAT_MASK >> (k)) & 1)
#ifndef TS_SEL
#define TS_SEL -1
#endif

namespace pg8 {
#define PG8_LAS __attribute__((address_space(3)))
typedef unsigned short bf16_t;
typedef short bf16x8 __attribute__((ext_vector_type(8)));
typedef float f32x4 __attribute__((ext_vector_type(4)));
typedef unsigned u32x4 __attribute__((ext_vector_type(4)));
constexpr int BM = 256, BK = 64, HALF = 128, HTB = HALF * BK * 2  , STAGE_BYTES = 8 * HTB, NXCD = 8, WGM = 8;

__host__ __device__ __forceinline__ int lds_byte(int r, int c) { const int st = (r >> 4) * 2 + (c >> 5), rr = r & 15, cc = c & 31, ob = rr * 64 + cc * 2; return st * 1024 + (ob ^ (((ob >> 9) & 1) << 5)); }
__host__ __device__ __forceinline__ void stage_rc(int b, int& R, int& C) { const int st = b / 1024, sb = b % 1024, swz = sb ^ (((sb >> 9) & 1) << 5); R = (st >> 1) * 16 + swz / 64; C = (st & 1) * 32 + (swz % 64) / 2; }
__host__ __device__ __forceinline__ int perm32(int rho) { const int n = rho >> 4, i = rho & 15; return 8 * (i >> 2) + 4 * n + (i & 3); }

struct Unit { int pm, pn; };
struct Gemm { const bf16_t* A; const bf16_t* Bt; int M, N, K; };

struct StaticOrder {
    int nM, nN, nwg, G, c;
    __host__ __device__ void init(int M, int N, int G_, int c_) { nM = M / BM; nN = N / BM; nwg = nM * nN; G = G_; c = c_; }
    __host__ __device__ bool next(int i, Unit& u) const {
        const long L = (long)i * G + c; if (L >= nwg) return false;
        int wgid = (int)L; { const int q = nwg / NXCD, r = nwg % NXCD, xcd = wgid % NXCD, off = wgid / NXCD; wgid = (xcd < r ? xcd * (q + 1) : r * (q + 1) + (xcd - r) * q) + off; }
        const int nig = WGM * nN, gid = wgid / nig, fm = gid * WGM, gsz = (nM - fm) < WGM ? (nM - fm) : WGM;
        u.pm = fm + ((wgid % nig) % gsz); u.pn = (wgid % nig) / gsz; return true;
    }
    __device__ __forceinline__ void a_ready(const Unit&) const {}
    __device__ __forceinline__ void done(const Unit&) const {}
};
__device__ __forceinline__ unsigned cvt_pk_bf16(float lo, float hi) { unsigned r; asm volatile("v_cvt_pk_bf16_f32 %0, %1, %2" : "=v"(r) : "v"(lo), "v"(hi)); return r; }
typedef float f32x2 __attribute__((ext_vector_type(2)));
__device__ __forceinline__ float bflo(unsigned u) { return __uint_as_float(u << 16); }
__device__ __forceinline__ float bfhi(unsigned u) { return __uint_as_float(u & 0xffff0000u); }
__device__ __forceinline__ float sigm(float x) { return 1.0f / (1.0f + __expf(-x)); }

struct EpiZ {
    static constexpr bool PERM = true, AFTER_DRAIN = false;
    bf16_t* O; int ldc; int nt_from;
    __device__ __forceinline__ void operator()(const f32x4 (&acc)[2][2][4][2], const Unit& u, int wr, int wc, int fr, int fq) const {
        const int row0 = u.pm * BM + wr * 64 + fr, col0 = u.pn * BM + wc * 32 + 8 * fq;
        const bool stream = u.pn >= nt_from;
#pragma unroll
        for (int ai = 0; ai < 2; ++ai)
#pragma unroll
            for (int m = 0; m < 4; ++m) { bf16_t* rowp = O + (size_t)(row0 + ai * HALF + m * 16) * ldc + col0;
#pragma unroll
                for (int bj = 0; bj < 2; ++bj) { const f32x4 v0 = acc[ai][bj][m][0], v1 = acc[ai][bj][m][1];
                    u32x4 w; w.x = cvt_pk_bf16(v0[0], v0[1]); w.y = cvt_pk_bf16(v0[2], v0[3]); w.z = cvt_pk_bf16(v1[0], v1[1]); w.w = cvt_pk_bf16(v1[2], v1[3]);
                    if (stream) __builtin_nontemporal_store(w, (u32x4*)(rowp + bj * HALF)); else *(u32x4*)(rowp + bj * HALF) = w; } }
    }
};
template <int MODE> struct EpiGate {
    static constexpr bool PERM = true, AFTER_DRAIN = false;
    bf16_t* O; const bf16_t* Z; int zld; int gcol;
    __device__ __forceinline__ void operator()(const f32x4 (&acc)[2][2][4][2], const Unit& u, int wr, int wc, int fr, int fq) const {
        const int row0 = u.pm * BM + wr * 64 + fr, col0 = u.pn * BM + wc * 32 + 8 * fq;
        u32x4 gn[2], pn[2];
        { const size_t row = (size_t)row0; gn[0] = *(const u32x4*)(Z + row * zld + gcol + col0); gn[1] = *(const u32x4*)(Z + row * zld + gcol + col0 + HALF);
          if (MODE == 1) { pn[0] = *(const u32x4*)(O + row * 1024 + col0); pn[1] = *(const u32x4*)(O + row * 1024 + col0 + HALF); } }
#pragma unroll
        for (int it = 0; it < 8; ++it) { const int ai = it >> 2, m = it & 3; const size_t row = (size_t)(row0 + ai * HALF + m * 16);
            u32x4 gc[2] = {gn[0], gn[1]}, pc[2];
            if (MODE == 1) { pc[0] = pn[0]; pc[1] = pn[1]; }
            if (it < 7) { const size_t rown = (size_t)(row0 + ((it + 1) >> 2) * HALF + ((it + 1) & 3) * 16);
                gn[0] = *(const u32x4*)(Z + rown * zld + gcol + col0); gn[1] = *(const u32x4*)(Z + rown * zld + gcol + col0 + HALF);
                if (MODE == 1) { pn[0] = *(const u32x4*)(O + rown * 1024 + col0); pn[1] = *(const u32x4*)(O + rown * 1024 + col0 + HALF); } }
            bf16_t* op = O + row * 1024 + col0;
#pragma unroll
            for (int bj = 0; bj < 2; ++bj) { const f32x4 v0 = acc[ai][bj][m][0], v1 = acc[ai][bj][m][1]; const u32x4 g = gc[bj];
                float r0 = v0[0] * sigm(bflo(g.x)), r1 = v0[1] * sigm(bfhi(g.x)), r2 = v0[2] * sigm(bflo(g.y)), r3 = v0[3] * sigm(bfhi(g.y));
                float r4 = v1[0] * sigm(bflo(g.z)), r5 = v1[1] * sigm(bfhi(g.z)), r6 = v1[2] * sigm(bflo(g.w)), r7 = v1[3] * sigm(bfhi(g.w));
                if (MODE == 1) { const u32x4 p = pc[bj];
                    r0 += bflo(p.x); r1 += bfhi(p.x); r2 += bflo(p.y); r3 += bfhi(p.y); r4 += bflo(p.z); r5 += bfhi(p.z); r6 += bflo(p.w); r7 += bfhi(p.w); }
                u32x4 w; w.x = cvt_pk_bf16(r0, r1); w.y = cvt_pk_bf16(r2, r3); w.z = cvt_pk_bf16(r4, r5); w.w = cvt_pk_bf16(r6, r7);
                *(u32x4*)(op + bj * HALF) = w; } }
    }
};
struct EpiRes1 {
    static constexpr bool PERM = true, AFTER_DRAIN = false;
    const float* X; bf16_t* XB; float* SS;
    __device__ __forceinline__ void operator()(const f32x4 (&acc)[2][2][4][2], const Unit& u, int wr, int wc, int fr, int fq) const {
        const int row0 = u.pm * BM + wr * 64 + fr, col0 = u.pn * BM + wc * 32 + 8 * fq;
        f32x4 xn[4];
        { const float* xp = X + (size_t)row0 * 1024 + col0; xn[0] = *(const f32x4*)(xp); xn[1] = *(const f32x4*)(xp + 4); xn[2] = *(const f32x4*)(xp + HALF); xn[3] = *(const f32x4*)(xp + HALF + 4); }
#pragma unroll
        for (int it = 0; it < 8; ++it) { const int ai = it >> 2, m = it & 3; const size_t row = (size_t)(row0 + ai * HALF + m * 16); float ssq = 0.f;
            const f32x4 xc[4] = {xn[0], xn[1], xn[2], xn[3]};
            if (it < 7) { const float* xp = X + (size_t)(row0 + ((it + 1) >> 2) * HALF + ((it + 1) & 3) * 16) * 1024 + col0;
                xn[0] = *(const f32x4*)(xp); xn[1] = *(const f32x4*)(xp + 4); xn[2] = *(const f32x4*)(xp + HALF); xn[3] = *(const f32x4*)(xp + HALF + 4); }
#pragma unroll
            for (int bj = 0; bj < 2; ++bj) { const size_t off = row * 1024 + col0 + bj * HALF;
                const f32x4 v0 = acc[ai][bj][m][0] + xc[2 * bj], v1 = acc[ai][bj][m][1] + xc[2 * bj + 1];
                ssq += (v0[0] * v0[0] + v0[1] * v0[1]) + (v0[2] * v0[2] + v0[3] * v0[3]) + (v1[0] * v1[0] + v1[1] * v1[1]) + (v1[2] * v1[2] + v1[3] * v1[3]);
                u32x4 w; w.x = cvt_pk_bf16(v0[0], v0[1]); w.y = cvt_pk_bf16(v0[2], v0[3]); w.z = cvt_pk_bf16(v1[0], v1[1]); w.w = cvt_pk_bf16(v1[2], v1[3]);
                *(u32x4*)(XB + off) = w; }
            ssq += __shfl_xor(ssq, 16); ssq += __shfl_xor(ssq, 32);
            if (fq == 0) atomicAdd(SS + row, ssq); }
    }
};
struct EpiRes2 {
    static constexpr bool PERM = true, AFTER_DRAIN = false;
    bf16_t* XB; float* SS;
    __device__ __forceinline__ void operator()(const f32x4 (&acc)[2][2][4][2], const Unit& u, int wr, int wc, int fr, int fq) const {
        const int row0 = u.pm * BM + wr * 64 + fr, col0 = u.pn * BM + wc * 32 + 8 * fq;
        u32x4 xn[2];
        { const bf16_t* xp = XB + (size_t)row0 * 1024 + col0; xn[0] = *(const u32x4*)(xp); xn[1] = *(const u32x4*)(xp + HALF); }
#pragma unroll
        for (int it = 0; it < 8; ++it) { const int ai = it >> 2, m = it & 3; const size_t row = (size_t)(row0 + ai * HALF + m * 16); float ssq = 0.f;
            const u32x4 xc[2] = {xn[0], xn[1]};
            if (it < 7) { const bf16_t* xp = XB + (size_t)(row0 + ((it + 1) >> 2) * HALF + ((it + 1) & 3) * 16) * 1024 + col0; xn[0] = *(const u32x4*)(xp); xn[1] = *(const u32x4*)(xp + HALF); }
#pragma unroll
            for (int bj = 0; bj < 2; ++bj) { const size_t off = row * 1024 + col0 + bj * HALF;
                const u32x4 xw = xc[bj]; f32x4 v0 = acc[ai][bj][m][0], v1 = acc[ai][bj][m][1];
                v0[0] += bflo(xw.x); v0[1] += bfhi(xw.x); v0[2] += bflo(xw.y); v0[3] += bfhi(xw.y); v1[0] += bflo(xw.z); v1[1] += bfhi(xw.z); v1[2] += bflo(xw.w); v1[3] += bfhi(xw.w);
                u32x4 w; w.x = cvt_pk_bf16(v0[0], v0[1]); w.y = cvt_pk_bf16(v0[2], v0[3]); w.z = cvt_pk_bf16(v1[0], v1[1]); w.w = cvt_pk_bf16(v1[2], v1[3]);
                *(u32x4*)(XB + off) = w;
                ssq += (v0[0] * v0[0] + v0[1] * v0[1]) + (v0[2] * v0[2] + v0[3] * v0[3]) + (v1[0] * v1[0] + v1[1] * v1[1]) + (v1[2] * v1[2] + v1[3] * v1[3]); }
            ssq += __shfl_xor(ssq, 16); ssq += __shfl_xor(ssq, 32);
            if (fq == 0) atomicAdd(SS + row, ssq); }
    }
};
struct EpiHid {
    static constexpr bool PERM = true, AFTER_DRAIN = false;
    bf16_t* O; const float* SS;
    __device__ __forceinline__ void operator()(const f32x4 (&acc)[2][2][4][2], const Unit& u, int wr, int wc, int fr, int fq) const {
        const int row0 = u.pm * BM + wr * 64 + fr, col0 = u.pn * BM + wc * 32 + 8 * fq;
#pragma unroll
        for (int ai = 0; ai < 2; ++ai)
#pragma unroll
            for (int m = 0; m < 4; ++m) { const size_t row = (size_t)(row0 + ai * HALF + m * 16);
                const float s2 = 1.0f / (SS[row] * (1.0f / 1024.0f) + 1e-6f);
                bf16_t* rowp = O + row * 4096 + col0;
#pragma unroll
                for (int bj = 0; bj < 2; ++bj) { f32x4 v0 = acc[ai][bj][m][0], v1 = acc[ai][bj][m][1];
#pragma unroll
                    for (int j = 0; j < 4; ++j) { float a = fmaxf(v0[j], 0.f), b = fmaxf(v1[j], 0.f); v0[j] = a * a * s2; v1[j] = b * b * s2; }
                    u32x4 w; w.x = cvt_pk_bf16(v0[0], v0[1]); w.y = cvt_pk_bf16(v0[2], v0[3]); w.z = cvt_pk_bf16(v1[0], v1[1]); w.w = cvt_pk_bf16(v1[2], v1[3]);
                    *(u32x4*)(rowp + bj * HALF) = w; } }
    }
};

template <class Epi, class Sched, bool ALIGN_EPI = false, bool SP2 = false>
__device__ __forceinline__ void gemm_phase(PG8_LAS unsigned char* lds, const Gemm g, const Sched& S, const Epi& E) {
    const int tid = threadIdx.x, wid = __builtin_amdgcn_readfirstlane(tid >> 6), lane = tid & 63, wr = wid >> 2, wc = wid & 3, fr = lane & 15, fq = lane >> 4;
    const int K = g.K, nt = K / BK;
    unsigned voffA[2], voffB[2];
#pragma unroll
    for (int i = 0; i < 2; ++i) { int R, C; stage_rc(tid * 16 + i * 8192, R, C); const int Rb = Epi::PERM ? ((R & ~31) + perm32(R & 31)) : R;
        voffA[i] = (unsigned)(R * K + C) * 2u; voffB[i] = (unsigned)(Rb * K + C) * 2u; }
    const size_t kstep = (size_t)(BK * 2);
    const size_t hstep = (size_t)HALF * K * 2;
    const size_t tstep = 2 * hstep;
    const unsigned ldsw = (unsigned)wid * 1024u;
    const int aoff = lds_byte(wr * 64 + fr, fq * 8), boff = lds_byte(wc * 32 + fr, fq * 8);
#define PG8_SA(b, h) (((b) * 2 + (h)) * HTB)
#define PG8_SB(b, h) ((4 + (b) * 2 + (h)) * HTB)
#define PG8_STAGE(bufoff, gbase, voff) do { _Pragma("unroll") for (int _i = 0; _i < 2; ++_i) \
        __builtin_amdgcn_global_load_lds((const unsigned*)((const char*)(gbase) + (voff)[_i]), (PG8_LAS unsigned*)(lds + (bufoff) + ldsw + _i * 8192), 16, 0, 0); } while (0)
#define PG8_LDA(dst, b, h) do { _Pragma("unroll") for (int m = 0; m < 4; ++m) _Pragma("unroll") for (int k = 0; k < 2; ++k) dst[m][k] = *(const PG8_LAS bf16x8*)(lds + PG8_SA(b, h) + aoff + m * 2048 + k * 1024); } while (0)
#define PG8_LDB(dst, b, h) do { _Pragma("unroll") for (int n = 0; n < 2; ++n) _Pragma("unroll") for (int k = 0; k < 2; ++k) dst[n][k] = *(const PG8_LAS bf16x8*)(lds + PG8_SB(b, h) + boff + n * 2048 + k * 1024); } while (0)
#define PG8_MMA(ai, bj, At, Bt) do { __builtin_amdgcn_s_setprio(1); _Pragma("unroll") for (int m = 0; m < 4; ++m) _Pragma("unroll") for (int n = 0; n < 2; ++n) _Pragma("unroll") for (int k = 0; k < 2; ++k) \
        acc[ai][bj][m][n] = __builtin_amdgcn_mfma_f32_16x16x32_bf16(Bt[n][k], At[m][k], acc[ai][bj][m][n], 0, 0, 0); __builtin_amdgcn_s_setprio(0); } while (0)
#define PG8_WAIT_V(n) asm volatile("s_waitcnt vmcnt(" #n ")" ::: "memory")
#define PG8_WAIT_L(n) asm volatile("s_waitcnt lgkmcnt(" #n ")" ::: "memory")
#define PG8_BAR __builtin_amdgcn_s_barrier()
#define PG8_SCHED __builtin_amdgcn_sched_barrier(0)
    Unit cur, nxt; int ui = 0;
    if (!S.next(0, cur)) return;
    f32x4 acc[2][2][4][2];
#pragma unroll
    for (int a = 0; a < 2; ++a)
#pragma unroll
        for (int b = 0; b < 2; ++b)
#pragma unroll
            for (int m = 0; m < 4; ++m)
#pragma unroll
                for (int n = 0; n < 2; ++n) acc[a][b][m][n] = (f32x4){0.f, 0.f, 0.f, 0.f};
    bf16x8 At[4][2], B0[2][2], B1[2][2];
    const char* cA = (const char*)g.A + (size_t)cur.pm * tstep; const char* cB = (const char*)g.Bt + (size_t)cur.pn * tstep;
    S.a_ready(cur);
    if constexpr (SP2) {
        PG8_STAGE(PG8_SB(0, 0), cB, voffB); PG8_STAGE(PG8_SB(0, 1), cB + hstep, voffB); PG8_STAGE(PG8_SA(0, 0), cA, voffA); PG8_STAGE(PG8_SA(0, 1), cA + hstep, voffA);
        if (wr == 1) PG8_BAR;
        PG8_WAIT_V(2); PG8_BAR;
        PG8_STAGE(PG8_SB(1, 0), cB + kstep, voffB); PG8_STAGE(PG8_SA(1, 0), cA + kstep, voffA); PG8_STAGE(PG8_SB(1, 1), cB + hstep + kstep, voffB);
        PG8_WAIT_V(6); PG8_BAR;
    } else {
        PG8_STAGE(PG8_SB(0, 0), cB, voffB); PG8_STAGE(PG8_SA(0, 0), cA, voffA); PG8_STAGE(PG8_SB(0, 1), cB + hstep, voffB); PG8_STAGE(PG8_SA(0, 1), cA + hstep, voffA);
        if (wr == 1) PG8_BAR;
        PG8_WAIT_V(4); PG8_BAR;
        PG8_STAGE(PG8_SB(1, 0), cB + kstep, voffB); PG8_STAGE(PG8_SA(1, 0), cA + kstep, voffA); PG8_STAGE(PG8_SB(1, 1), cB + hstep + kstep, voffB);
        PG8_WAIT_V(6); PG8_BAR;
    }
    for (;;) {
        const bool has_next = S.next(ui + 1, nxt);
        const char* nA = has_next ? (const char*)g.A + (size_t)nxt.pm * tstep : cA; const char* nB = has_next ? (const char*)g.Bt + (size_t)nxt.pn * tstep : cB;
        for (int t = 0; t < nt; t += 2) {
            const bool last = (t == nt - 2);
            const char* a1 = cA + (size_t)(t + 1) * kstep;
            const char* a2 = last ? nA : cA + (size_t)(t + 2) * kstep; const char* b2 = last ? nB : cB + (size_t)(t + 2) * kstep;
            const char* a3 = a2 + kstep; const char* b3 = b2 + kstep;
            if (last && has_next) S.a_ready(nxt);
            if constexpr (SP2) {
            PG8_LDB(B0, 0, 0); PG8_LDB(B1, 0, 1); PG8_SCHED; PG8_LDA(At, 0, 0); PG8_STAGE(PG8_SA(1, 1), a1 + hstep, voffA);
            PG8_WAIT_V(8); PG8_WAIT_L(0); PG8_BAR; PG8_MMA(0, 0, At, B0); PG8_MMA(0, 1, At, B1); PG8_BAR; PG8_SCHED;
            PG8_LDA(At, 0, 1); PG8_STAGE(PG8_SB(0, 0), b2, voffB); PG8_STAGE(PG8_SB(0, 1), b2 + hstep, voffB); PG8_STAGE(PG8_SA(0, 0), a2, voffA);
            PG8_WAIT_V(8); PG8_WAIT_L(0); PG8_BAR; PG8_MMA(1, 0, At, B0); PG8_MMA(1, 1, At, B1); PG8_BAR; PG8_SCHED;
            PG8_LDB(B0, 1, 0); PG8_LDB(B1, 1, 1); PG8_SCHED; PG8_LDA(At, 1, 0); PG8_STAGE(PG8_SA(0, 1), a2 + hstep, voffA);
            PG8_WAIT_V(8); PG8_WAIT_L(0); PG8_BAR; PG8_MMA(0, 0, At, B0); PG8_MMA(0, 1, At, B1); PG8_BAR; PG8_SCHED;
            PG8_LDA(At, 1, 1); PG8_STAGE(PG8_SB(1, 0), b3, voffB); PG8_STAGE(PG8_SB(1, 1), b3 + hstep, voffB); PG8_STAGE(PG8_SA(1, 0), a3, voffA);
            PG8_WAIT_V(8); PG8_WAIT_L(0); PG8_BAR; PG8_MMA(1, 0, At, B0); PG8_MMA(1, 1, At, B1); PG8_BAR; PG8_SCHED;
            } else {
            PG8_LDB(B0, 0, 0); PG8_SCHED; PG8_LDA(At, 0, 0); PG8_STAGE(PG8_SA(1, 1), a1 + hstep, voffA);
            PG8_WAIT_L(8); PG8_BAR; PG8_WAIT_L(0); PG8_MMA(0, 0, At, B0); PG8_BAR; PG8_SCHED;
            PG8_LDB(B1, 0, 1); PG8_STAGE(PG8_SB(0, 0), b2, voffB);
            PG8_BAR; PG8_WAIT_L(0); PG8_MMA(0, 1, At, B1); PG8_BAR;
            PG8_LDA(At, 0, 1); PG8_STAGE(PG8_SA(0, 0), a2, voffA);
            PG8_BAR; PG8_WAIT_L(0); PG8_MMA(1, 0, At, B0); PG8_BAR; PG8_SCHED;
            PG8_STAGE(PG8_SB(0, 1), b2 + hstep, voffB);
            PG8_WAIT_V(6); PG8_BAR; PG8_MMA(1, 1, At, B1); PG8_BAR;
            PG8_LDB(B0, 1, 0); PG8_SCHED; PG8_LDA(At, 1, 0); PG8_STAGE(PG8_SA(0, 1), a2 + hstep, voffA);
            PG8_WAIT_L(8); PG8_BAR; PG8_WAIT_L(0); PG8_MMA(0, 0, At, B0); PG8_BAR; PG8_SCHED;
            PG8_LDB(B1, 1, 1); PG8_STAGE(PG8_SB(1, 0), b3, voffB);
            PG8_BAR; PG8_WAIT_L(0); PG8_MMA(0, 1, At, B1); PG8_BAR;
            PG8_LDA(At, 1, 1); PG8_STAGE(PG8_SA(1, 0), a3, voffA);
            PG8_BAR; PG8_WAIT_L(0); PG8_MMA(1, 0, At, B0); PG8_BAR; PG8_SCHED;
            PG8_STAGE(PG8_SB(1, 1), b3 + hstep, voffB);
            PG8_WAIT_V(6); PG8_BAR; PG8_MMA(1, 1, At, B1); PG8_BAR;
            }
        }
        if constexpr (ALIGN_EPI) { if (wr == 0) PG8_BAR; }
        if constexpr (!Epi::AFTER_DRAIN) { E(acc, cur, wr, wc, fr, fq); S.done(cur); }
        if (!has_next) break;
#pragma unroll
        for (int a = 0; a < 2; ++a)
#pragma unroll
            for (int b = 0; b < 2; ++b)
#pragma unroll
                for (int m = 0; m < 4; ++m)
#pragma unroll
                    for (int n = 0; n < 2; ++n) acc[a][b][m][n] = (f32x4){0.f, 0.f, 0.f, 0.f};
        cur = nxt; cA = nA; cB = nB; ++ui;
        if constexpr (ALIGN_EPI) { if (wr == 1) PG8_BAR; }
    }
    PG8_WAIT_V(0);
    if constexpr (!ALIGN_EPI) { if (wr == 0) PG8_BAR; }
    PG8_BAR;
    if constexpr (Epi::AFTER_DRAIN) { E.fused(acc, cur, wr, wc, fr, fq, lds, wid, lane); S.done(cur); }
#undef PG8_SA
#undef PG8_SB
#undef PG8_STAGE
#undef PG8_LDA
#undef PG8_LDB
#undef PG8_MMA
#undef PG8_WAIT_V
#undef PG8_WAIT_L
#undef PG8_BAR
#undef PG8_SCHED
}
}
extern __shared__ __attribute__((aligned(16))) unsigned char g_lds[];
using pg8::bf16_t; using pg8::bf16x8; using pg8::f32x4; using pg8::u32x4; using pg8::cvt_pk_bf16; using pg8::bflo; using pg8::bfhi; using pg8::sigm;

constexpr int NTOK = 32768, DM = 1024, SEQ = 2048, NB = 16, ZLD = 5120, NTHR = 512;
constexpr int C_R = 0, C_K = 512, C_V = 1024, C_WD = 1536, C_AD = 1600, C_GD = 1664;
constexpr int C_Q = 1824, C_KA = 2336, C_VA = 2400, C_QI = 2464, C_KI = 2976, C_WI = 3040, C_G0 = 3048, C_G1 = 4072;
constexpr size_t MiB = 1024 * 1024;
constexpr size_t WS_SS1 = 0, WS_SS2 = 128 * 1024, WS_BONUS = 256 * 1024, WS_ROPE = 1280 * 1024, WS_WD = 1792 * 1024, WS_WI = 1856 * 1024, WS_WG = 1920 * 1024;
constexpr size_t WS_WIN = 4 * MiB, WS_WUP = 14 * MiB, WS_WDN = 22 * MiB, WS_WB = 30 * MiB, WS_WO = 32 * MiB, WS_VT = 34 * MiB, WS_H = 38 * MiB, WS_Z = 102 * MiB, WS_P = 422 * MiB, WS_END = 486 * MiB;
constexpr int LDS_BYTES = 163840;

struct Args { const float* in[20]; float* out; unsigned char* ws; int ph_lo, ph_hi; };

struct Frame {
    const float* in[20]; float* out; unsigned char* ws; unsigned char* lds; int tid, lane, wave;
    float *ss1, *ss2, *bonus; float2* rope; bf16_t *wd, *wi, *wg, *win, *wup, *wdn, *wb, *wo, *vt, *h, *ya, *yb, *xb, *z, *hid, *lw, *ic, *mg, *gt; float* yraw;
};

__device__ __forceinline__ bf16_t f2bf(float f) { return (bf16_t)(cvt_pk_bf16(f, 0.f) & 0xffffu); }
__device__ __forceinline__ float bf2f(bf16_t b) { return __uint_as_float(((unsigned)b) << 16); }
template <int CTRL> __device__ __forceinline__ float dpp_mov(float x) { return __int_as_float(__builtin_amdgcn_update_dpp(0, __float_as_int(x), CTRL, 0xF, 0xF, true)); }
__device__ __forceinline__ float red16(float x) { x += dpp_mov<0xB1>(x); x += dpp_mov<0x4E>(x); x += dpp_mov<0x141>(x); x += dpp_mov<0x140>(x); return x; }


__device__ __forceinline__ void lds_barrier() { asm volatile("s_waitcnt lgkmcnt(0)" ::: "memory"); __builtin_amdgcn_s_barrier(); asm volatile("" ::: "memory"); }
__device__ __forceinline__ void red16x4(float& a, float& b, float& c, float& d) {
#define DPP4(ctl) "v_add_f32_dpp %0, %0, %0 " ctl " row_mask:0xf bank_mask:0xf bound_ctrl:1\n" "v_add_f32_dpp %1, %1, %1 " ctl " row_mask:0xf bank_mask:0xf bound_ctrl:1\n" \
                  "v_add_f32_dpp %2, %2, %2 " ctl " row_mask:0xf bank_mask:0xf bound_ctrl:1\n" "v_add_f32_dpp %3, %3, %3 " ctl " row_mask:0xf bank_mask:0xf bound_ctrl:1\n"
    asm volatile("s_nop 1\n" DPP4("quad_perm:[1,0,3,2]") DPP4("quad_perm:[2,3,0,1]") DPP4("row_half_mirror") DPP4("row_mirror") : "+v"(a), "+v"(b), "+v"(c), "+v"(d));
#undef DPP4
}
__device__ __forceinline__ float red32(float x) { x += __shfl_xor(x, 1); x += __shfl_xor(x, 2); x += __shfl_xor(x, 4); x += __shfl_xor(x, 8); x += __shfl_xor(x, 16); return x; }
__device__ __forceinline__ float red64(float x) { x = red32(x); x += __shfl_xor(x, 32); return x; }
__device__ __forceinline__ float softplus_f(float x) { return fmaxf(x, 0.f) + log1pf(__expf(-fabsf(x))); }

__device__ __forceinline__ void tconv(const Frame& F, const float* __restrict__ W, int K, int N, int Npad, bf16_t* __restrict__ Wt, const float* __restrict__ rs) {
    float* tile = (float*)g_lds;
    const int ktn = (K + 63) / 64, ntn = Npad / 64, tid = F.tid;
    for (int tl = blockIdx.x; tl < ktn * ntn; tl += gridDim.x) {
        const int kt = tl % ktn, nt = tl / ktn;
#pragma unroll
        for (int i = 0; i < 2; ++i) { const int idx = tid + i * NTHR, kk = idx >> 4, n4 = (idx & 15) * 4, k = kt * 64 + kk, n = nt * 64 + n4;
            f32x4 v = {0.f, 0.f, 0.f, 0.f};
            if (k < K) { if (n + 3 < N) v = *(const f32x4*)(W + (size_t)k * N + n); else { for (int j = 0; j < 4; ++j) if (n + j < N) v[j] = W[(size_t)k * N + n + j]; }
                if (rs != nullptr) { const float r = rs[k]; v[0] *= r; v[1] *= r; v[2] *= r; v[3] *= r; } }
            tile[kk * 65 + n4] = v[0]; tile[kk * 65 + n4 + 1] = v[1]; tile[kk * 65 + n4 + 2] = v[2]; tile[kk * 65 + n4 + 3] = v[3]; }
        __syncthreads();
        { const int nn = tid >> 3, k8 = (tid & 7) * 8, k = kt * 64 + k8, n = nt * 64 + nn;
          if (k < K) { u32x4 w; const float* tp = tile + k8 * 65 + nn;
              w.x = cvt_pk_bf16(tp[0], tp[65]); w.y = cvt_pk_bf16(tp[130], tp[195]); w.z = cvt_pk_bf16(tp[260], tp[325]); w.w = cvt_pk_bf16(tp[390], tp[455]);
              *(u32x4*)(Wt + (size_t)n * K + k) = w; } }
        __syncthreads();
    }
}
__device__ __forceinline__ void p0_prologue(const Frame& F) {
    const int tid = F.tid, gtid = blockIdx.x * NTHR + tid, gn = gridDim.x * NTHR;
    for (int i = gtid; i < 2 * NTOK; i += gn) F.ss1[i] = 0.f;
    for (int i = gtid; i < SEQ * 32; i += gn) { const int pos = i >> 5, j = i & 31;
        const float inv = 1.0f / powf(10000.0f, (float)(2 * j) / 64.0f); const float ang = (float)pos * inv;
        double rev = (double)ang * 0.15915494309189535; rev -= floor(rev); const float fr = (float)rev;
        F.rope[i] = make_float2(__builtin_amdgcn_cosf(fr), __builtin_amdgcn_sinf(fr)); }
    tconv(F, F.in[2], 1024, 5096, 5120, F.win, nullptr);
    tconv(F, F.in[17], 1024, 4096, 4096, F.wup, F.in[16]);
    tconv(F, F.in[18], 4096, 1024, 1024, F.wdn, nullptr);
    tconv(F, F.in[14], 512, 1024, 1024, F.wb, nullptr);
    tconv(F, F.in[14] + 512 * 1024, 512, 1024, 1024, F.wb + 1024 * 512, nullptr);
    tconv(F, F.in[15], 1024, 1024, 1024, F.wo, nullptr);
    tconv(F, F.in[5], 64, 512, 512, F.wd, nullptr);
    tconv(F, F.in[7], 64, 512, 512, F.wi, nullptr);
    tconv(F, F.in[8], 160, 512, 512, F.wg, nullptr);
    const float* x = F.in[0]; const float* g = F.in[1]; const int lane = F.lane;
    const int rstep = gridDim.x * 8;
    f32x4 gq[4];
#pragma unroll
    for (int i = 0; i < 4; ++i) gq[i] = *(const f32x4*)(g + (i >> 1) * 512 + lane * 8 + (i & 1) * 4);
    for (int row = blockIdx.x * 8 + F.wave; row < NTOK; row += 2 * rstep) {
        const int row2 = (row + rstep) < NTOK ? row + rstep : row; const bool two = row2 != row;
        const float* xr = x + (size_t)row * DM; const float* xr2 = x + (size_t)row2 * DM; f32x4 v[4], u[4]; float ss = 0.f, ss2 = 0.f;
#pragma unroll
        for (int i = 0; i < 4; ++i) { v[i] = __builtin_nontemporal_load((const f32x4*)(xr + (i >> 1) * 512 + lane * 8 + (i & 1) * 4)); u[i] = __builtin_nontemporal_load((const f32x4*)(xr2 + (i >> 1) * 512 + lane * 8 + (i & 1) * 4)); }
#pragma unroll
        for (int i = 0; i < 4; ++i) { ss += v[i][0] * v[i][0] + v[i][1] * v[i][1] + v[i][2] * v[i][2] + v[i][3] * v[i][3]; ss2 += u[i][0] * u[i][0] + u[i][1] * u[i][1] + u[i][2] * u[i][2] + u[i][3] * u[i][3]; }
        ss = red64(ss); ss2 = red64(ss2); const float sc = rsqrtf(ss * (1.0f / 1024.0f) + 1e-6f), sc2 = rsqrtf(ss2 * (1.0f / 1024.0f) + 1e-6f);
#pragma unroll
        for (int i = 0; i < 2; ++i) { const f32x4 a = v[2 * i] * gq[2 * i] * sc, b2 = v[2 * i + 1] * gq[2 * i + 1] * sc, a2 = u[2 * i] * gq[2 * i] * sc2, b3 = u[2 * i + 1] * gq[2 * i + 1] * sc2; u32x4 w, w2;
            w.x = cvt_pk_bf16(a[0], a[1]); w.y = cvt_pk_bf16(a[2], a[3]); w.z = cvt_pk_bf16(b2[0], b2[1]); w.w = cvt_pk_bf16(b2[2], b2[3]);
            w2.x = cvt_pk_bf16(a2[0], a2[1]); w2.y = cvt_pk_bf16(a2[2], a2[3]); w2.z = cvt_pk_bf16(b3[0], b3[1]); w2.w = cvt_pk_bf16(b3[2], b3[3]);
            *(u32x4*)(F.h + (size_t)row * DM + i * 512 + lane * 8) = w; if (two) *(u32x4*)(F.h + (size_t)row2 * DM + i * 512 + lane * 8) = w2; }
    }
}

__device__ __forceinline__ void p2_prep(const Frame& F, const int mode) {
    const int tid = F.tid, lane = F.lane, wave = F.wave, fr = lane & 15, fq = lane >> 4;
    bf16_t* z = F.z; const float* mu = F.in[3];
    if (mode != 2) {
        constexpr int LDA = 296, TT = 32; bf16_t* At = (bf16_t*)g_lds;
        bf16_t* Ot = At + TT * LDA;
        const float* dbias = F.in[4]; const float* ibias = F.in[6];
        for (int tile = blockIdx.x; tile < NTOK / TT; tile += gridDim.x) {
            const int t0 = tile * TT;
            for (int idx = tid; idx < TT * 36; idx += NTHR) { const int tok = idx / 36, c8 = (idx - tok * 36) * 8, t = t0 + tok, col = C_WD + c8;
                const u32x4 zc = *(const u32x4*)(z + (size_t)t * ZLD + col); u32x4 zp = {0u, 0u, 0u, 0u}; if (t & (SEQ - 1)) zp = *(const u32x4*)(z + (size_t)(t - 1) * ZLD + col);
                const f32x4 m0 = *(const f32x4*)(mu + col), m1 = *(const f32x4*)(mu + col + 4);
                float v[8]; const unsigned zcu[4] = {zc.x, zc.y, zc.z, zc.w}, zpu[4] = {zp.x, zp.y, zp.z, zp.w};
#pragma unroll
                for (int j = 0; j < 4; ++j) { const float a = bflo(zcu[j]), b2 = bfhi(zcu[j]), pa = bflo(zpu[j]), pb = bfhi(zpu[j]);
                    const float mm0 = (j < 2) ? m0[2 * j] : m1[2 * j - 4], mm1 = (j < 2) ? m0[2 * j + 1] : m1[2 * j - 3];
                    v[2 * j] = a + (pa - a) * mm0; v[2 * j + 1] = b2 + (pb - b2) * mm1; }
                if (c8 < 64) {
#pragma unroll
                    for (int j = 0; j < 8; ++j) v[j] = tanhf(v[j]); }
                else if (c8 >= 128) {
#pragma unroll
                    for (int j = 0; j < 8; ++j) v[j] = sigm(v[j]); }
                u32x4 w; w.x = cvt_pk_bf16(v[0], v[1]); w.y = cvt_pk_bf16(v[2], v[3]); w.z = cvt_pk_bf16(v[4], v[5]); w.w = cvt_pk_bf16(v[6], v[7]);
                *(u32x4*)(At + tok * LDA + c8) = w; }
            __syncthreads();
            const int h = wave;
            bf16x8 Bc[9], Bn[9];
            { const int n = h * 64 + fr;
#pragma unroll
              for (int ks = 0; ks < 2; ++ks) { Bc[ks] = *(const bf16x8*)(F.wd + n * 64 + ks * 32 + fq * 8); Bc[2 + ks] = *(const bf16x8*)(F.wi + n * 64 + ks * 32 + fq * 8); }
#pragma unroll
              for (int ks = 0; ks < 5; ++ks) Bc[4 + ks] = *(const bf16x8*)(F.wg + n * 160 + ks * 32 + fq * 8); }
#pragma unroll 1
            for (int j = 0; j < 4; ++j) { const int n = h * 64 + j * 16 + fr;
                if (j < 3) { const int nn = n + 16;
#pragma unroll
                    for (int ks = 0; ks < 2; ++ks) { Bn[ks] = *(const bf16x8*)(F.wd + nn * 64 + ks * 32 + fq * 8); Bn[2 + ks] = *(const bf16x8*)(F.wi + nn * 64 + ks * 32 + fq * 8); }
#pragma unroll
                    for (int ks = 0; ks < 5; ++ks) Bn[4 + ks] = *(const bf16x8*)(F.wg + nn * 160 + ks * 32 + fq * 8); }
                const float db = dbias[n], ib = ibias[n];
#pragma unroll
                for (int mt = 0; mt < 2; ++mt) {
                    f32x4 ad = {0.f, 0.f, 0.f, 0.f}, ai = ad, ag = ad; const bf16_t* ap = At + (mt * 16 + fr) * LDA + fq * 8;
#pragma unroll
                    for (int ks = 0; ks < 2; ++ks) ad = __builtin_amdgcn_mfma_f32_16x16x32_bf16(*(const bf16x8*)(ap + ks * 32), Bc[ks], ad, 0, 0, 0);
#pragma unroll
                    for (int ks = 0; ks < 2; ++ks) ai = __builtin_amdgcn_mfma_f32_16x16x32_bf16(*(const bf16x8*)(ap + 64 + ks * 32), Bc[2 + ks], ai, 0, 0, 0);
#pragma unroll
                    for (int ks = 0; ks < 5; ++ks) ag = __builtin_amdgcn_mfma_f32_16x16x32_bf16(*(const bf16x8*)(ap + 128 + ks * 32), Bc[4 + ks], ag, 0, 0, 0);
#pragma unroll
                    for (int jj = 0; jj < 4; ++jj) {
                        const float dw = db + ad[jj]; const float wlog = -softplus_f(-dw) - 0.5f; const float lwv = -__expf(wlog);
                        const int tk = mt * 16 + fq * 4 + jj; Ot[tk * 520 + n] = f2bf(lwv); Ot[(TT + tk) * 520 + n] = f2bf(sigm(ib + ai[jj])); Ot[(2 * TT + tk) * 520 + n] = f2bf(ag[jj]); }
                }
#pragma unroll
                for (int q = 0; q < 9; ++q) Bc[q] = Bn[q];
            }
            __syncthreads();
#pragma unroll
            for (int i = 0; i < 12; ++i) { const int idx = tid + i * NTHR, arr = idx >> 11, rem = idx & 2047, tk = rem >> 6, c8 = (rem & 63) * 8;
                const u32x4 w = *(const u32x4*)(Ot + (arr * TT + tk) * 520 + c8); bf16_t* dst = arr == 0 ? F.lw : (arr == 1 ? F.ic : F.gt);
                if (arr == 2) __builtin_nontemporal_store(w, (u32x4*)(dst + (size_t)(t0 + tk) * 512 + c8)); else *(u32x4*)(dst + (size_t)(t0 + tk) * 512 + c8) = w; }
            __syncthreads();
        }
    }
    if (mode != 2) {
        unsigned short* tl = (unsigned short*)g_lds;
        for (int tile = blockIdx.x; tile < NTOK / 64; tile += gridDim.x) { const int t0 = tile * 64, b = t0 / SEQ, tt0 = t0 % SEQ;
            { const int tok = tid >> 3, d8 = (tid & 7) * 8; *(u32x4*)(tl + tok * 72 + d8) = *(const u32x4*)(z + (size_t)(t0 + tok) * ZLD + C_VA + d8); }
            __syncthreads();
            { const int d = tid >> 3, k8 = (tid & 7) * 8; unsigned short e[8];
#pragma unroll
              for (int j = 0; j < 8; ++j) e[j] = tl[(k8 + j) * 72 + d];
              u32x4 w; w.x = e[0] | ((unsigned)e[1] << 16); w.y = e[2] | ((unsigned)e[3] << 16); w.z = e[4] | ((unsigned)e[5] << 16); w.w = e[6] | ((unsigned)e[7] << 16);
              *(u32x4*)(F.vt + ((size_t)b * 64 + d) * SEQ + tt0 + k8) = w; }
            __syncthreads();
        }
    }
    if (mode != 0) {
        const int gtid = blockIdx.x * NTHR + tid, gn = gridDim.x * NTHR;
        for (int idx = gtid; idx < NTOK * 72; idx += gn) { const int t = idx / 72, p = idx - t * 72, hd = p >> 2, i8 = (p & 3) * 8;
            const int base = hd < 8 ? C_Q + hd * 64 : (hd == 8 ? C_KA : (hd < 17 ? C_QI + (hd - 9) * 64 : C_KI));
            const float* rp = (const float*)&F.rope[(t & (SEQ - 1)) * 32 + i8];
            f32x4 cs[4];
#pragma unroll
            for (int j = 0; j < 4; ++j) { cs[j] = *(const f32x4*)(rp + 4 * j); if (mode == 2) cs[j] = (f32x4){1.f, 0.f, 1.f, 0.f}; }
            bf16_t* p1 = z + (size_t)t * ZLD + base + i8; const u32x4 a = *(const u32x4*)(p1), b2 = *(const u32x4*)(p1 + 32);
            const unsigned au[4] = {a.x, a.y, a.z, a.w}, bu[4] = {b2.x, b2.y, b2.z, b2.w}; unsigned o1[4], o2[4];
#pragma unroll
            for (int j = 0; j < 4; ++j) { const float x1a = bflo(au[j]), x1b = bfhi(au[j]), x2a = bflo(bu[j]), x2b = bfhi(bu[j]);
                o1[j] = cvt_pk_bf16(x1a * cs[j][0] - x2a * cs[j][1], x1b * cs[j][2] - x2b * cs[j][3]);
                o2[j] = cvt_pk_bf16(x2a * cs[j][0] + x1a * cs[j][1], x2b * cs[j][2] + x1b * cs[j][3]); }
            u32x4 w1, w2; w1.x = o1[0]; w1.y = o1[1]; w1.z = o1[2]; w1.w = o1[3]; w2.x = o2[0]; w2.y = o2[1]; w2.z = o2[2]; w2.w = o2[3];
            *(u32x4*)(p1) = w1; *(u32x4*)(p1 + 32) = w2; }
    }
}

struct ScanRaw { uint2 zr_c, zr_p, zk_c, zk_p, zv_c, zv_p, lwu, icu; };
struct ScanConst { f32x4 mur, muk, muv, kk, ka, rk; };
__device__ __forceinline__ void scan_load(ScanRaw& R, const bf16_t* z, const bf16_t* lw, const bf16_t* ic, size_t tokbase, int ch, int ptok, int gc) {
    const int t = ch * 16 + ptok; const size_t T = tokbase + t; const bf16_t* zp = z + T * ZLD + gc;
    R.zr_c = *(const uint2*)(zp + C_R); R.zk_c = *(const uint2*)(zp + C_K); R.zv_c = *(const uint2*)(zp + C_V);
    const uint2 zz = make_uint2(0u, 0u);
    if (t > 0) { R.zr_p = *(const uint2*)(zp - ZLD + C_R); R.zk_p = *(const uint2*)(zp - ZLD + C_K); R.zv_p = *(const uint2*)(zp - ZLD + C_V); } else { R.zr_p = zz; R.zk_p = zz; R.zv_p = zz; }
    R.lwu = *(const uint2*)(lw + T * 512 + gc); R.icu = *(const uint2*)(ic + T * 512 + gc);
}
__device__ __forceinline__ f32x4 unpack4(uint2 u) { f32x4 r; r[0] = bflo(u.x); r[1] = bfhi(u.x); r[2] = bflo(u.y); r[3] = bfhi(u.y); return r; }
__device__ __forceinline__ void scan_prep(const ScanRaw& R, const ScanConst& C, float* ops, float* vv, float* bonus_out, bool wr_bonus, int ptok, int pc, int v0) {
    const f32x4 rc = unpack4(R.zr_c), rp = unpack4(R.zr_p), kc = unpack4(R.zk_c), kp = unpack4(R.zk_p), vc = unpack4(R.zv_c), vp = unpack4(R.zv_p), ic = unpack4(R.icu), lw = unpack4(R.lwu);
    const f32x4 r = rc + (rp - rc) * C.mur, k = kc + (kp - kc) * C.muk, vs = vc + (vp - vc) * C.muv;
    f32x4 w; w[0] = __expf(lw[0]); w[1] = __expf(lw[1]); w[2] = __expf(lw[2]); w[3] = __expf(lw[3]);
    const f32x4 q = k * C.kk; const float ss = red16((q[0] * q[0] + q[1] * q[1]) + (q[2] * q[2] + q[3] * q[3]));
    const float inv = 1.0f / fmaxf(sqrtf(ss), 1e-12f); const f32x4 n = q * inv;
    const f32x4 kn = k * (1.0f + (ic - 1.0f) * C.ka);
    const f32x4 bt = r * kn * C.rk; const float bon = red16((bt[0] + bt[1]) + (bt[2] + bt[3]));
    if (wr_bonus) *bonus_out = bon;
    float* op = ops + ptok * 320 + pc;
    *(f32x4*)(op) = -n; *(f32x4*)(op + 64) = w; *(f32x4*)(op + 128) = n * ic; *(f32x4*)(op + 192) = kn; *(f32x4*)(op + 256) = r;
    if (pc >= v0 && pc < v0 + 32) *(f32x4*)(vv + ptok * 32 + pc - v0) = vs;
}
__device__ __forceinline__ void p3_scan(const Frame& F, const int mode) {
    const int tid = F.tid;
    float* opsb = (float*)g_lds;
    float* vvb = opsb + 2 * 5120;
    float* yob = vvb + 2 * 512;
    const bf16_t* z = F.z; const float* mu = F.in[3]; const float* k_k = F.in[9]; const float* k_a = F.in[10]; const float* r_k = F.in[11];
    for (int item = blockIdx.x; item < 256; item += gridDim.x) {
        const int bh = item >> 1, half = item & 1, b = bh >> 3, h = bh & 7, v0 = half * 32;
        const size_t tokbase = (size_t)b * SEQ;
        if (F.wave >= 4) {
            const int pt = tid - 256, ptok = pt >> 4, pc = (pt & 15) * 4, gc = h * 64 + pc;
            ScanConst C; C.mur = *(const f32x4*)(mu + C_R + gc); C.muk = *(const f32x4*)(mu + C_K + gc); C.muv = *(const f32x4*)(mu + C_V + gc);
            C.kk = *(const f32x4*)(k_k + gc); C.ka = *(const f32x4*)(k_a + gc); C.rk = *(const f32x4*)(r_k + gc);
            const bool wrb = (half == 0) && ((pt & 15) == 0);
            ScanRaw R;
            scan_load(R, z, F.lw, F.ic, tokbase, 0, ptok, gc);
            scan_prep(R, C, opsb, vvb, F.bonus + (tokbase + ptok) * 8 + h, wrb, ptok, pc, v0);
            scan_load(R, z, F.lw, F.ic, tokbase, 1, ptok, gc);
            lds_barrier();
            for (int ch = 0; ch < SEQ / 16; ++ch) {
                const int cur = ch & 1, nxt = cur ^ 1;
                if (mode != 2) {
                if (ch > 0) { const int tok = pt >> 4, r2 = (pt & 15) * 2;
                    typedef float f32x2v __attribute__((ext_vector_type(2))); const float2 yv = *(const float2*)(yob + nxt * 512 + tok * 32 + r2); const f32x2v y2 = {yv.x, yv.y}; __builtin_nontemporal_store(y2, (f32x2v*)(F.yraw + (tokbase + (ch - 1) * 16 + tok) * 512 + h * 64 + v0 + r2)); }
                if (ch + 1 < SEQ / 16) {
                    scan_prep(R, C, opsb + nxt * 5120, vvb + nxt * 512, F.bonus + (tokbase + (ch + 1) * 16 + ptok) * 8 + h, wrb, ptok, pc, v0);
                    if (ch + 2 < SEQ / 16) scan_load(R, z, F.lw, F.ic, tokbase, ch + 2, ptok, gc);
                } }
                lds_barrier();
            }
            { const int tok = pt >> 4, r2 = (pt & 15) * 2;
              typedef float f32x2v __attribute__((ext_vector_type(2))); const float2 yv = *(const float2*)(yob + 512 + tok * 32 + r2); const f32x2v y2 = {yv.x, yv.y}; __builtin_nontemporal_store(y2, (f32x2v*)(F.yraw + (tokbase + (SEQ / 16 - 1) * 16 + tok) * 512 + h * 64 + v0 + r2)); }
        } else {
            const int rp = tid >> 4, ks = tid & 15;
            float A0 = 0.f, A1 = 0.f, A2 = 0.f, A3 = 0.f, B0 = 0.f, B1 = 0.f, B2 = 0.f, B3 = 0.f;
            const int ywoff = (ks == 0) ? 2 * rp : (2 * 512 + 2 * tid), ywstep = (ks == 0) ? 32 : 0;
            lds_barrier();
            f32x4 rprev = {0.f, 0.f, 0.f, 0.f}; float* ywp = yob + 2 * 512 + 2 * tid;
            for (int ch = 0; ch < SEQ / 16; ++ch) {
                const int cur = ch & 1;
                const float* ops = opsb + cur * 5120 + ks * 4; const float* vv = vvb + cur * 512 + 2 * rp; float* yw = yob + cur * 512 + ywoff;
                if (mode != 1) {
#pragma unroll
                for (int s = 0; s < 16; ++s) {
                    const float* o = ops + s * 320;
                    const f32x4 a4 = *(const f32x4*)(o), w4 = *(const f32x4*)(o + 64), b4 = *(const f32x4*)(o + 128), k4 = *(const f32x4*)(o + 192), r4 = *(const f32x4*)(o + 256);
                    const float2 vab = *(const float2*)(vv + s * 32);
                    float sa = (A0 * a4[0] + A1 * a4[1]) + (A2 * a4[2] + A3 * a4[3]); float sb = (B0 * a4[0] + B1 * a4[1]) + (B2 * a4[2] + B3 * a4[3]);
                    float ya = (A0 * rprev[0] + A1 * rprev[1]) + (A2 * rprev[2] + A3 * rprev[3]); float yb2 = (B0 * rprev[0] + B1 * rprev[1]) + (B2 * rprev[2] + B3 * rprev[3]);
                    red16x4(sa, sb, ya, yb2);
                    *(float2*)(ywp) = make_float2(ya, yb2);
                    ywp = yw + s * ywstep;
                    A0 = A0 * w4[0] + sa * b4[0] + vab.x * k4[0]; A1 = A1 * w4[1] + sa * b4[1] + vab.x * k4[1];
                    A2 = A2 * w4[2] + sa * b4[2] + vab.x * k4[2]; A3 = A3 * w4[3] + sa * b4[3] + vab.x * k4[3];
                    B0 = B0 * w4[0] + sb * b4[0] + vab.y * k4[0]; B1 = B1 * w4[1] + sb * b4[1] + vab.y * k4[1];
                    B2 = B2 * w4[2] + sb * b4[2] + vab.y * k4[2]; B3 = B3 * w4[3] + sb * b4[3] + vab.y * k4[3];
                    rprev = r4;
                }
                {
                    float ya = (A0 * rprev[0] + A1 * rprev[1]) + (A2 * rprev[2] + A3 * rprev[3]); float yb2 = (B0 * rprev[0] + B1 * rprev[1]) + (B2 * rprev[2] + B3 * rprev[3]);
                    float d0 = 0.f, d1 = 0.f; red16x4(ya, yb2, d0, d1);
                    *(float2*)(ywp) = make_float2(ya, yb2); ywp = yob + 2 * 512 + 2 * tid; rprev = (f32x4){0.f, 0.f, 0.f, 0.f};
                } }
                lds_barrier();
            }
        }
        __syncthreads();
    }
}

__device__ __forceinline__ unsigned ordkey(float f) { const unsigned u = __float_as_uint(f); return (u & 0x80000000u) ? ~u : (u | 0x80000000u); }

__device__ __forceinline__ void attn_chunk(const unsigned char* kb, const unsigned char* vb, const unsigned* selm, int c, int p, int fr, int fq, const bf16x8 (&Bqa)[2][2], f32x4 (&O)[2][4], f32x4 (&RS)[2]) {
    const f32x4 zero4 = {0.f, 0.f, 0.f, 0.f};
    const u32x4 onesu = {0x3f803f80u, 0x3f803f80u, 0x3f803f80u, 0x3f803f80u}; const bf16x8 ones = __builtin_bit_cast(bf16x8, onesu);
    const float csc = 0.125f * 1.4426950408889634f;
    const unsigned char* k0p = kb + ((2 * p) * 16 + fr) * 144 + fq * 16; const unsigned char* k1p = k0p + 16 * 144;
    const bf16x8 KA00 = *(const bf16x8*)(k0p), KA01 = *(const bf16x8*)(k0p + 64), KA10 = *(const bf16x8*)(k1p), KA11 = *(const bf16x8*)(k1p + 64);
    const int mw = (int)selm[fr * 64 + 2 * c + p];
    bf16x8 VA[4];
#pragma unroll
    for (int dt = 0; dt < 4; ++dt) { const unsigned char* vp = vb + (dt * 16 + fr) * 144 + (2 * p) * 32 + fq * 8;
        const uint2 lo = *(const uint2*)(vp), hi = *(const uint2*)(vp + 32);
        u32x4 va; va.x = lo.x; va.y = lo.y; va.z = hi.x; va.w = hi.y; VA[dt] = __builtin_bit_cast(bf16x8, va); }
    unsigned km0[4], km1[4];
#pragma unroll
    for (int jj = 0; jj < 4; ++jj) { km0[jj] = (unsigned)__builtin_amdgcn_sbfe(mw, fq * 4 + jj, 1); km1[jj] = (unsigned)__builtin_amdgcn_sbfe(mw, 16 + fq * 4 + jj, 1); }
#pragma unroll
    for (int hh = 0; hh < 2; ++hh) {
        f32x4 s0 = __builtin_amdgcn_mfma_f32_16x16x32_bf16(KA00, Bqa[hh][0], zero4, 0, 0, 0); s0 = __builtin_amdgcn_mfma_f32_16x16x32_bf16(KA01, Bqa[hh][1], s0, 0, 0, 0);
        f32x4 s1 = __builtin_amdgcn_mfma_f32_16x16x32_bf16(KA10, Bqa[hh][0], zero4, 0, 0, 0); s1 = __builtin_amdgcn_mfma_f32_16x16x32_bf16(KA11, Bqa[hh][1], s1, 0, 0, 0);
        unsigned p0[4], p1[4];
#pragma unroll
        for (int jj = 0; jj < 4; ++jj) {
            p0[jj] = __float_as_uint(__builtin_amdgcn_exp2f(fminf(s0[jj] * csc, 86.f))) & km0[jj]; p1[jj] = __float_as_uint(__builtin_amdgcn_exp2f(fminf(s1[jj] * csc, 86.f))) & km1[jj]; }
        u32x4 pk; pk.x = cvt_pk_bf16(__uint_as_float(p0[0]), __uint_as_float(p0[1])); pk.y = cvt_pk_bf16(__uint_as_float(p0[2]), __uint_as_float(p0[3]));
        pk.z = cvt_pk_bf16(__uint_as_float(p1[0]), __uint_as_float(p1[1])); pk.w = cvt_pk_bf16(__uint_as_float(p1[2]), __uint_as_float(p1[3]));
        const bf16x8 PB = __builtin_bit_cast(bf16x8, pk);
        RS[hh] = __builtin_amdgcn_mfma_f32_16x16x32_bf16(ones, PB, RS[hh], 0, 0, 0);
#pragma unroll
        for (int dt = 0; dt < 4; ++dt) O[hh][dt] = __builtin_amdgcn_mfma_f32_16x16x32_bf16(VA[dt], PB, O[hh][dt], 0, 0, 0);
    }
}

__device__ __forceinline__ void p3_dsa(const Frame& F) {
    const int tid = F.tid, lane = F.lane, wave = F.wave, fr = lane & 15, fq = lane >> 4;
    unsigned* scl = (unsigned*)g_lds;
    unsigned* selm = (unsigned*)(g_lds + 131328);
    unsigned char* kbuf = (unsigned char*)g_lds;
    unsigned char* vbuf = kbuf + 2 * 9216;
    const bf16_t* z = F.z; const int G = gridDim.x, bx = blockIdx.x;
    const f32x4 zero4 = {0.f, 0.f, 0.f, 0.f};
    for (int rnd = 0; rnd * G < 2048; ++rnd) {
        const int n = rnd * G + ((rnd & 1) ? (G - 1 - bx) : bx);
        if (n >= 2048) continue;
        const int qg = 127 - (n >> 4), b = n & 15, q0 = qg * 16; const size_t Tb = (size_t)b * SEQ;
        for (int i = tid; i < 1024; i += NTHR) selm[i] = 0u;
        __syncthreads();
        const bf16_t* zq = z + (Tb + q0 + fr) * ZLD;
        const unsigned lofk = (unsigned)((fr * ZLD + fq * 8) * 2), lofv = (unsigned)((fr * SEQ + fq * 4) * 2);
        const int nchunk = (qg + 4) >> 2; const int lrow = tid >> 3, lseg = tid & 7;
        const bf16_t* kg = z + (Tb + lrow) * ZLD + C_KA + lseg * 8; const bf16_t* vg = F.vt + ((size_t)b * 64 + lrow) * SEQ + lseg * 8;
        const unsigned lst = (unsigned)(lrow * 144 + lseg * 16);
        const int hp = wave >> 1, kh = wave & 1;
        const u32x4 kc0 = *(const u32x4*)(kg), vc0 = *(const u32x4*)(vg);
        u32x4 kx = kc0, vx = vc0, ky = kc0, vy = vc0;
        if (1 < nchunk) { kx = *(const u32x4*)(kg + (size_t)64 * ZLD); vx = *(const u32x4*)(vg + 64); }
        if (2 < nchunk) { ky = *(const u32x4*)(kg + (size_t)128 * ZLD); vy = *(const u32x4*)(vg + 128); }
        bf16x8 Bqa[2][2];
#pragma unroll
        for (int hh = 0; hh < 2; ++hh)
#pragma unroll
            for (int ks = 0; ks < 2; ++ks) Bqa[hh][ks] = *(const bf16x8*)(zq + C_Q + (2 * hp + hh) * 64 + ks * 32 + fq * 8);
        if (qg >= 16) {
            const u32x4 wv = *(const u32x4*)(zq + C_WI);
            {
                bf16x8 Bq[8][2];
#pragma unroll
                for (int hh = 0; hh < 8; ++hh)
#pragma unroll
                    for (int ks = 0; ks < 2; ++ks) Bq[hh][ks] = *(const bf16x8*)(zq + C_QI + hh * 64 + ks * 32 + fq * 8);
                const float sc = 0.044194173824159216f;
                float wih[8]; wih[0] = bflo(wv.x) * sc; wih[1] = bfhi(wv.x) * sc; wih[2] = bflo(wv.y) * sc; wih[3] = bfhi(wv.y) * sc; wih[4] = bflo(wv.z) * sc; wih[5] = bfhi(wv.z) * sc; wih[6] = bflo(wv.w) * sc; wih[7] = bfhi(wv.w) * sc;
#pragma unroll 1
                for (int half = 0; half < 2; ++half) {
                    const int ktb = wave + 64 * half; if (ktb > qg) break;
                    bf16x8 W0[2], W1[2];
#pragma unroll
                    for (int j = 0; j < 2; ++j) { const int ktj = (ktb + 8 * j) < qg ? (ktb + 8 * j) : qg; const char* kb = (const char*)(z + (Tb + (size_t)ktj * 16) * ZLD + C_KI);
                        W0[j] = *(const bf16x8*)(kb + lofk); W1[j] = *(const bf16x8*)(kb + lofk + 64); }
#pragma unroll
                    for (int i = 0; i < 8; ++i) { const int kt = ktb + 8 * i;
                        if (kt <= qg) { f32x4 sv = zero4;
#pragma unroll
                            for (int hh = 0; hh < 8; ++hh) { f32x4 acc = __builtin_amdgcn_mfma_f32_16x16x32_bf16(W0[i & 1], Bq[hh][0], zero4, 0, 0, 0);
                                acc = __builtin_amdgcn_mfma_f32_16x16x32_bf16(W1[i & 1], Bq[hh][1], acc, 0, 0, 0);
#pragma unroll
                                for (int jj = 0; jj < 4; ++jj) sv[jj] += wih[hh] * fmaxf(acc[jj], 0.f); }
                            u32x4 w; w.x = ordkey(sv[0]); w.y = ordkey(sv[1]); w.z = ordkey(sv[2]); w.w = ordkey(sv[3]);
                            *(u32x4*)(scl + fr * 2052 + kt * 16 + fq * 4) = w;
                        }
                        if (i + 2 < 8) { const int ktn = (kt + 16) < qg ? (kt + 16) : qg; const char* kb = (const char*)(z + (Tb + (size_t)ktn * 16) * ZLD + C_KI);
                            unsigned lo2 = lofk; asm volatile("" : "+v"(lo2));
                            W0[i & 1] = *(const bf16x8*)(kb + lo2); W1[i & 1] = *(const bf16x8*)(kb + lo2 + 64); }
                    }
                }
            }
            __syncthreads();
#pragma unroll 1
            for (int qq = 0; qq < 2; ++qq) {
                const int q = 2 * wave + qq, qpos = q0 + q;
                unsigned uk[32];
#pragma unroll
                for (int r = 0; r < 32; ++r) { const int key = r * 64 + lane; uk[r] = 0x007fffffu;
                    if (r * 64 <= qpos) { const unsigned v = scl[q * 2052 + key]; uk[r] = (key <= qpos) ? v : 0x007fffffu; } }
                unsigned T = 0u; bool exact = false;
#pragma unroll 1
                for (int bit = 31; bit >= 0; --bit) {
                    const unsigned cand = T | (1u << bit); int c = 0;
#pragma unroll
                    for (int g = 0; g < 4; ++g) {
                        if (g * 512 > qpos) break;
                        unsigned long long m[8];
                        asm("v_cmp_ge_u32_e64 %0, %8, %16\n\tv_cmp_ge_u32_e64 %1, %9, %16\n\tv_cmp_ge_u32_e64 %2, %10, %16\n\tv_cmp_ge_u32_e64 %3, %11, %16\n\t"
                            "v_cmp_ge_u32_e64 %4, %12, %16\n\tv_cmp_ge_u32_e64 %5, %13, %16\n\tv_cmp_ge_u32_e64 %6, %14, %16\n\tv_cmp_ge_u32_e64 %7, %15, %16"
                            : "=&s"(m[0]), "=&s"(m[1]), "=&s"(m[2]), "=&s"(m[3]), "=&s"(m[4]), "=&s"(m[5]), "=&s"(m[6]), "=&s"(m[7])
                            : "v"(uk[g * 8 + 0]), "v"(uk[g * 8 + 1]), "v"(uk[g * 8 + 2]), "v"(uk[g * 8 + 3]), "v"(uk[g * 8 + 4]), "v"(uk[g * 8 + 5]), "v"(uk[g * 8 + 6]), "v"(uk[g * 8 + 7]), "v"(cand));
#pragma unroll
                        for (int j = 0; j < 8; ++j) c += __builtin_popcountll(m[j]);
                    }
                    if (c >= 256) { T = cand; if (c == 256) { exact = true; break; } }
                }
                int need = 0;
                if (!exact) { int c = 0;
#pragma unroll
                    for (int r = 0; r < 32; ++r) c += __builtin_popcountll(__builtin_amdgcn_ballot_w64(uk[r] > T));
                    need = 256 - c; }
#pragma unroll
                for (int r = 0; r < 32; ++r) {
                    if (r * 64 <= qpos) {
                        unsigned long long sel;
                        if (exact) sel = __builtin_amdgcn_ballot_w64(uk[r] >= T);
                        else { sel = __builtin_amdgcn_ballot_w64(uk[r] > T); unsigned long long e = __builtin_amdgcn_ballot_w64(uk[r] == T);
                            const int ne = __builtin_popcountll(e);
                            if (ne <= need) { sel |= e; need -= ne; }
                            else { for (int k = 0; k < need; ++k) { const unsigned long long lb = e & (0ull - e); sel |= lb; e ^= lb; } need = 0; } }
                        if (lane == 0) { selm[q * 64 + 2 * r] = (unsigned)sel; selm[q * 64 + 2 * r + 1] = (unsigned)(sel >> 32); }
                    }
                }
            }
        } else {
            for (int w = tid; w < 1024; w += NTHR) { const int q = w >> 6, word = w & 63, qpos = q0 + q, lo = word * 32;
                selm[w] = (qpos >= lo + 31) ? 0xffffffffu : (qpos < lo ? 0u : ((2u << (qpos - lo)) - 1u)); }
        }
        __syncthreads();
        {
            *(u32x4*)(kbuf + lst) = kc0; *(u32x4*)(vbuf + lst) = vc0;
            f32x4 O[2][4]; f32x4 rs[2];
#pragma unroll
            for (int hh = 0; hh < 2; ++hh) { rs[hh] = zero4;
#pragma unroll
                for (int dt = 0; dt < 4; ++dt) O[hh][dt] = zero4; }
            lds_barrier();
#pragma unroll 1
            for (int c = 0; c < nchunk; c += 2) {
                attn_chunk(kbuf, vbuf, selm, c, kh, fr, fq, Bqa, O, rs);
                if (c + 1 < nchunk) { *(u32x4*)(kbuf + 9216 + lst) = kx; *(u32x4*)(vbuf + 9216 + lst) = vx; }
                if (c + 3 < nchunk) { kx = *(const u32x4*)(kg + (size_t)(c + 3) * 64 * ZLD); vx = *(const u32x4*)(vg + (c + 3) * 64); }
                lds_barrier();
                if (c + 1 < nchunk) {
                    attn_chunk(kbuf + 9216, vbuf + 9216, selm, c + 1, kh, fr, fq, Bqa, O, rs);
                    if (c + 2 < nchunk) { *(u32x4*)(kbuf + lst) = ky; *(u32x4*)(vbuf + lst) = vy; }
                    if (c + 4 < nchunk) { ky = *(const u32x4*)(kg + (size_t)(c + 4) * 64 * ZLD); vy = *(const u32x4*)(vg + (c + 4) * 64); }
                    lds_barrier();
                }
            }
            float* xb = (float*)(vbuf + 2 * 9216) + (size_t)wave * (64 * 17);
            { const int oh = kh ^ 1;
#pragma unroll
              for (int dt = 0; dt < 4; ++dt)
#pragma unroll
                  for (int jj = 0; jj < 4; ++jj) xb[(dt * 4 + jj) * 64 + lane] = (oh == 0) ? O[0][dt][jj] : O[1][dt][jj];
              xb[16 * 64 + lane] = (oh == 0) ? rs[0][0] : rs[1][0]; }
            lds_barrier();
            { const float* pb = (const float*)(vbuf + 2 * 9216) + (size_t)(wave ^ 1) * (64 * 17);
              float tot = ((kh == 0) ? rs[0][0] : rs[1][0]) + pb[16 * 64 + lane];
              const float inv = 1.0f / tot;
              bf16_t* yp = F.yb + (Tb + q0 + fr) * 512 + (2 * hp + kh) * 64 + fq * 4;
#pragma unroll
              for (int dt = 0; dt < 4; ++dt) { float o[4];
#pragma unroll
                  for (int jj = 0; jj < 4; ++jj) o[jj] = (((kh == 0) ? O[0][dt][jj] : O[1][dt][jj]) + pb[(dt * 4 + jj) * 64 + lane]) * inv;
                  uint2 w; w.x = cvt_pk_bf16(o[0], o[1]); w.y = cvt_pk_bf16(o[2], o[3]); *(uint2*)(yp + dt * 16) = w; } }
        }
        __syncthreads();
    }
}

struct P4In { f32x4 y; uint2 vc, vp, gt; float bon; };
__device__ __forceinline__ void p4_load(P4In& I, const Frame& F, int g, int c) { const size_t t = (size_t)(g >> 3); const bf16_t* z = F.z;
    I.y = __builtin_nontemporal_load((const f32x4*)(F.yraw + t * 512 + c)); I.vc = *(const uint2*)(z + t * ZLD + C_V + c); I.vp = make_uint2(0u, 0u); if (t & (SEQ - 1)) I.vp = *(const uint2*)(z + (t - 1) * ZLD + C_V + c);
    { typedef unsigned u32x2v __attribute__((ext_vector_type(2))); const u32x2v gv = __builtin_nontemporal_load((const u32x2v*)(F.gt + t * 512 + c)); I.gt = make_uint2(gv.x, gv.y); } I.bon = F.bonus[t * 8 + (g & 7)]; }
__device__ __forceinline__ void p4_finish(const P4In& I, const Frame& F, int g, int c, const f32x4& m4, const f32x4& w4, const f32x4& b4) { const size_t t = (size_t)(g >> 3);
    const f32x4 y = I.y; const float mean = red16((y[0] + y[1]) + (y[2] + y[3])) * (1.0f / 64.0f); const f32x4 d = y - mean;
    const float var = red16((d[0] * d[0] + d[1] * d[1]) + (d[2] * d[2] + d[3] * d[3])) * (1.0f / 64.0f); const float rstd = rsqrtf(var + 64e-5f);
    f32x4 vcf, vpf, gtf; vcf[0] = bflo(I.vc.x); vcf[1] = bfhi(I.vc.x); vcf[2] = bflo(I.vc.y); vcf[3] = bfhi(I.vc.y); vpf[0] = bflo(I.vp.x); vpf[1] = bfhi(I.vp.x); vpf[2] = bflo(I.vp.y); vpf[3] = bfhi(I.vp.y);
    gtf[0] = bflo(I.gt.x); gtf[1] = bfhi(I.gt.x); gtf[2] = bflo(I.gt.y); gtf[3] = bfhi(I.gt.y);
    const f32x4 vs = vcf + (vpf - vcf) * m4; const f32x4 o = (d * rstd * w4 + b4 + vs * I.bon) * gtf;
    uint2 w; w.x = cvt_pk_bf16(o[0], o[1]); w.y = cvt_pk_bf16(o[2], o[3]); *(uint2*)(F.ya + t * 512 + c) = w; }
__device__ __forceinline__ void p4_post(const Frame& F) {
    const int tid = F.tid; const float* mu = F.in[3]; const float* gnw = F.in[12]; const float* gnb = F.in[13];
    const int gstep = gridDim.x * 32, g0 = blockIdx.x * 32 + (tid >> 4), c = (g0 & 7) * 64 + (tid & 15) * 4;
    const f32x4 m4 = *(const f32x4*)(mu + C_V + c), w4 = *(const f32x4*)(gnw + c), b4 = *(const f32x4*)(gnb + c);
    for (int g = g0; g < NTOK * 8; g += 2 * gstep) { const int g2 = g + gstep; const bool two = g2 < NTOK * 8;
        P4In A, B; p4_load(A, F, g, c); if (two) p4_load(B, F, g2, c);
        p4_finish(A, F, g, c, m4, w4, b4); if (two) p4_finish(B, F, g2, c, m4, w4, b4); }
}

__device__ __forceinline__ void p9_final(const Frame& F, const bool ident) {
    const float* g = F.in[19]; const int lane = F.lane; const int rstep = gridDim.x * 8;
    f32x4 gg[4];
#pragma unroll
    for (int i = 0; i < 4; ++i) gg[i] = *(const f32x4*)(g + (i >> 1) * 512 + lane * 8 + (i & 1) * 4);
    for (int row = blockIdx.x * 8 + F.wave; row < NTOK; row += 2 * rstep) {
        const int row2 = (row + rstep) < NTOK ? row + rstep : row; const bool two = row2 != row;
        u32x4 a[2], b[2];
#pragma unroll
        for (int i = 0; i < 2; ++i) { a[i] = __builtin_nontemporal_load((const u32x4*)(F.xb + (size_t)row * DM + i * 512 + lane * 8)); b[i] = __builtin_nontemporal_load((const u32x4*)(F.xb + (size_t)row2 * DM + i * 512 + lane * 8)); }
        const float sc = ident ? 1.0f : rsqrtf(F.ss2[row] * (1.0f / 1024.0f) + 1e-6f), sc2 = ident ? 1.0f : rsqrtf(F.ss2[row2] * (1.0f / 1024.0f) + 1e-6f);
#pragma unroll
        for (int i = 0; i < 2; ++i) {
            f32x4 v0, v1, u0, u1;
            v0[0] = bflo(a[i].x); v0[1] = bfhi(a[i].x); v0[2] = bflo(a[i].y); v0[3] = bfhi(a[i].y); v1[0] = bflo(a[i].z); v1[1] = bfhi(a[i].z); v1[2] = bflo(a[i].w); v1[3] = bfhi(a[i].w);
            u0[0] = bflo(b[i].x); u0[1] = bfhi(b[i].x); u0[2] = bflo(b[i].y); u0[3] = bfhi(b[i].y); u1[0] = bflo(b[i].z); u1[1] = bfhi(b[i].z); u1[2] = bflo(b[i].w); u1[3] = bfhi(b[i].w);
            if (!ident) { v0 = v0 * gg[2 * i] * sc; v1 = v1 * gg[2 * i + 1] * sc; u0 = u0 * gg[2 * i] * sc2; u1 = u1 * gg[2 * i + 1] * sc2; }
            float* o1 = F.out + (size_t)row * DM + i * 512 + lane * 8; float* o2 = F.out + (size_t)row2 * DM + i * 512 + lane * 8;
            __builtin_nontemporal_store(v0, (f32x4*)o1); __builtin_nontemporal_store(v1, (f32x4*)(o1 + 4));
            if (two) { __builtin_nontemporal_store(u0, (f32x4*)o2); __builtin_nontemporal_store(u1, (f32x4*)(o2 + 4)); } }
    }
}
#define XB_TMO      128
#define XB_XCNT(j)  (256  + 64 * (j))
#define XB_XSUB(j)  (1280 + 64 * (j))
#define XB_XGEN(j)  (2304 + 64 * (j))
#define XB_TOP      3328
#define XB_TOPGEN   3392
#define XCD_BAR_WORDS 3456
#define XB_SPIN_CAP (1u << 18)
#define LAS __attribute__((address_space(3)))

__device__ __forceinline__ unsigned xb_ld(unsigned* p)              { return __hip_atomic_load(p, __ATOMIC_RELAXED, __HIP_MEMORY_SCOPE_AGENT); }
__device__ __forceinline__ unsigned xb_add(unsigned* p, unsigned v) { return __hip_atomic_fetch_add(p, v, __ATOMIC_RELAXED, __HIP_MEMORY_SCOPE_AGENT); }
__device__ __forceinline__ unsigned xb_xcc_id() { return (unsigned)__builtin_amdgcn_s_getreg((3 << 11) | 20) & 0xFu; }
#define XB_SPIN(cond, bar) do { unsigned _sp = 0; while (cond) { __builtin_amdgcn_s_sleep(1); \
    if ((++_sp & 255u) == 0u) { if (xb_ld(&(bar)[XB_TMO])) break; if (_sp > XB_SPIN_CAP) { atomicAdd(&(bar)[XB_TMO], 1u); break; } } } } while (0)

struct XcdBarrier {
    unsigned* bar; unsigned x;
    volatile LAS unsigned* st;
};

__device__ __forceinline__ XcdBarrier xcd_barrier_post(unsigned* bar, volatile LAS unsigned* st) {
    XcdBarrier b; b.bar = bar; b.x = xb_xcc_id(); b.st = st;
    if (threadIdx.x == 0) (void)xb_add(&bar[XB_XCNT(b.x)], 1u);
    return b;
}
__device__ __forceinline__ void xcd_barrier_complete(unsigned* bar, unsigned x, unsigned& nloc, unsigned& nx) {
    const unsigned G = gridDim.x * gridDim.y * gridDim.z;
    unsigned sum, cnt, mine, sp = 0u;
    for (;;) {
        sum = 0u; cnt = 0u; mine = 0u;
#pragma unroll
        for (unsigned j = 0; j < 16; ++j) { const unsigned c = xb_ld(&bar[XB_XCNT(j)]); sum += c; cnt += (c > 0u) ? 1u : 0u; mine = (j == x) ? c : mine; }
        if (sum == G) break;
        __builtin_amdgcn_s_sleep(1);
        if ((++sp & 255u) == 0u) { if (xb_ld(&bar[XB_TMO])) break; if (sp > XB_SPIN_CAP) { atomicAdd(&bar[XB_TMO], 1u); break; } }
    }
    nloc = mine > 0u ? mine : 1u; nx = cnt > 0u ? cnt : 1u;
}

__device__ __forceinline__ void xcd_barrier(const XcdBarrier& b) {
    asm volatile("s_waitcnt vmcnt(0)" ::: "memory");
    __syncthreads();
    if (threadIdx.x == 0) {
        unsigned* bar = b.bar;
        __builtin_amdgcn_s_waitcnt(0);
        unsigned nloc = b.st[0], nx = b.st[1];
        if (nloc == 0u) { xcd_barrier_complete(bar, b.x, nloc, nx); b.st[0] = nloc; b.st[1] = nx; }
        const unsigned old = xb_add(&bar[XB_XSUB(b.x)], 1u);
        const unsigned gen = old / nloc;
        if (old + 1u == (gen + 1u) * nloc) {
            __builtin_amdgcn_fence(__ATOMIC_RELEASE, "agent");
            asm volatile("s_waitcnt vmcnt(0)" ::: "memory");
            const unsigned og = xb_add(&bar[XB_TOP], 1u);
            const unsigned tg = og / nx;
            if (og + 1u == (tg + 1u) * nx) xb_add(&bar[XB_TOPGEN], 1u);
            else XB_SPIN(xb_ld(&bar[XB_TOPGEN]) == tg, bar);
            __builtin_amdgcn_fence(__ATOMIC_ACQUIRE, "agent");
            xb_add(&bar[XB_XGEN(b.x)], 1u);
            asm volatile("s_waitcnt vmcnt(0)" ::: "memory");
        } else {
            XB_SPIN(xb_ld(&bar[XB_XGEN(b.x)]) == gen, bar);
            __builtin_amdgcn_fence(__ATOMIC_ACQUIRE, "agent");
            asm volatile("s_waitcnt vmcnt(0)" ::: "memory");
        }
    }
    __syncthreads();
}
#ifndef PHASE_MASK
#define PHASE_MASK 0x3ff
#endif
#ifndef GEMM_ALIGN
#define GEMM_ALIGN true
#endif
#ifndef GEMM_SP2
#define GEMM_SP2 true
#endif
constexpr int NPHASE = 10;
constexpr size_t WS_BAR = 3 * MiB;
template <class Epi> __device__ __forceinline__ void run_gemm(const bf16_t* A, const bf16_t* Bt, int N, int K, const Epi& E) {
    pg8::Gemm g{A, Bt, NTOK, N, K}; pg8::StaticOrder S; S.init(NTOK, N, (int)gridDim.x, (int)blockIdx.x);
    pg8::gemm_phase<Epi, pg8::StaticOrder, GEMM_ALIGN, GEMM_SP2>((PG8_LAS unsigned char*)g_lds, g, S, E);
}
__global__ void __launch_bounds__(NTHR, 2) mega_fwd(Args args) {
    Frame F;
#pragma unroll
    for (int i = 0; i < 20; ++i) F.in[i] = args.in[i];
    F.out = args.out; F.ws = args.ws; F.lds = nullptr; F.tid = threadIdx.x; F.lane = F.tid & 63; F.wave = __builtin_amdgcn_readfirstlane(F.tid >> 6);
    unsigned char* ws = args.ws;
    F.ss1 = (float*)(ws + WS_SS1); F.ss2 = (float*)(ws + WS_SS2); F.bonus = (float*)(ws + WS_BONUS); F.rope = (float2*)(ws + WS_ROPE);
    F.wd = (bf16_t*)(ws + WS_WD); F.wi = (bf16_t*)(ws + WS_WI); F.wg = (bf16_t*)(ws + WS_WG);
    F.win = (bf16_t*)(ws + WS_WIN); F.wup = (bf16_t*)(ws + WS_WUP); F.wdn = (bf16_t*)(ws + WS_WDN); F.wb = (bf16_t*)(ws + WS_WB); F.wo = (bf16_t*)(ws + WS_WO); F.vt = (bf16_t*)(ws + WS_VT);
    F.h = (bf16_t*)(ws + WS_H); F.ya = F.h; F.yb = F.h + (size_t)NTOK * 512; F.xb = F.h;
    F.z = (bf16_t*)(ws + WS_Z); F.hid = F.z;
    F.lw = (bf16_t*)(ws + WS_P); F.ic = F.lw + (size_t)NTOK * 512; F.mg = F.lw;
    F.yraw = args.out; F.gt = (bf16_t*)(args.out + (size_t)NTOK * 512);
    const int lo = args.ph_lo, hi = args.ph_hi;
    cg::grid_group grid = cg::this_grid();
    if (args.ph_lo < 0) grid.sync();
    volatile LAS unsigned* xst = (volatile LAS unsigned*)(g_lds + LDS_BYTES - 64);
    if (threadIdx.x == 0) { xst[0] = 0u; xst[1] = 0u; }
    __syncthreads();
    XcdBarrier xbar = xcd_barrier_post((unsigned*)(ws + WS_BAR), xst);
#define IN(k) (lo <= (k) && (k) < hi)
#define SEAM(k) do { if (IN(k) && IN((k) + 1)) { xcd_barrier(xbar); if (REP(17)) xcd_barrier(xbar); } } while (0)
    if (((PHASE_MASK >> 0) & 1) && IN(0)) { p0_prologue(F); __syncthreads(); if (REP(0)) { p0_prologue(F); __syncthreads(); } } SEAM(0);
    if (((PHASE_MASK >> 1) & 1) && IN(1)) { pg8::EpiZ E{F.z, ZLD, 12}; run_gemm(F.h, F.win, 5120, 1024, E); __syncthreads(); if (REP(1)) { run_gemm(F.h, F.win, 5120, 1024, E); __syncthreads(); } if (REP(18)) { run_gemm(F.h, F.win, 4096, 1024, E); __syncthreads(); } } SEAM(1);
    if (((PHASE_MASK >> 2) & 1) && IN(2)) { if (REP(2)) { p2_prep(F, 0); __syncthreads(); } if (REP(16)) { p2_prep(F, 2); __syncthreads(); } p2_prep(F, 1); __syncthreads(); } SEAM(2);
    if (((PHASE_MASK >> 3) & 1) && IN(3)) { if (REP(14)) { p3_scan(F, 1); __syncthreads(); } if (REP(15)) { p3_scan(F, 2); __syncthreads(); } if (REP(3)) { p3_scan(F, 0); __syncthreads(); } p3_scan(F, 0); __syncthreads(); p3_dsa(F); __syncthreads(); if (REP(10)) { p3_dsa(F); __syncthreads(); } } SEAM(3);
    if (((PHASE_MASK >> 4) & 1) && IN(4)) { p4_post(F); __syncthreads(); if (REP(4)) { p4_post(F); __syncthreads(); } } SEAM(4);
    if (((PHASE_MASK >> 5) & 1) && IN(5)) { pg8::EpiGate<0> E0{F.mg, F.z, ZLD, C_G0}; run_gemm(F.ya, F.wb, 1024, 512, E0); __syncthreads();
                 pg8::EpiGate<1> E1{F.mg, F.z, ZLD, C_G1}; run_gemm(F.yb, F.wb + 1024 * 512, 1024, 512, E1); __syncthreads();
                 if (REP(5)) { run_gemm(F.ya, F.wb, 1024, 512, E0); __syncthreads(); run_gemm(F.yb, F.wb + 1024 * 512, 1024, 512, E1); __syncthreads(); } } SEAM(5);
    if (((PHASE_MASK >> 6) & 1) && IN(6)) { if (REP(6)) { pg8::EpiRes1 Ex{F.in[0], F.xb, F.bonus}; run_gemm(F.mg, F.wo, 1024, 1024, Ex); __syncthreads(); }
                 pg8::EpiRes1 E{F.in[0], F.xb, F.ss1}; run_gemm(F.mg, F.wo, 1024, 1024, E); __syncthreads(); } SEAM(6);
    if (((PHASE_MASK >> 7) & 1) && IN(7)) { pg8::EpiHid E{F.hid, F.ss1}; run_gemm(F.xb, F.wup, 4096, 1024, E); __syncthreads(); if (REP(7)) { run_gemm(F.xb, F.wup, 4096, 1024, E); __syncthreads(); } } SEAM(7);
    if (((PHASE_MASK >> 8) & 1) && IN(8)) { pg8::EpiRes2 E{F.xb, F.ss2}; run_gemm(F.hid, F.wdn, 1024, 4096, E); __syncthreads(); } SEAM(8);
    if (((PHASE_MASK >> 9) & 1) && IN(9)) { if (REP(9)) { p9_final(F, true); __syncthreads(); } p9_final(F, false); }
#undef IN
#undef SEAM
}

extern "C" void kernel_launch(void* const* d_in, const int* in_sizes, int n_in, void* d_out, int out_size, void* d_ws, size_t ws_size, hipStream_t stream) {
    static int grid = 0;
    if (grid == 0) {
        if (n_in != 20 || out_size != NTOK * DM || ws_size < WS_END) { fprintf(stderr, "kernel_launch: unexpected shapes (n_in %d, out %d, ws %zu < %zu)\n", n_in, out_size, ws_size, (size_t)WS_END); grid = -1; return; }
        int dev = 0, cus = 0, per_cu = 0;
        hipGetDevice(&dev); hipDeviceGetAttribute(&cus, hipDeviceAttributeMultiprocessorCount, dev);
        if (hipFuncSetAttribute((const void*)mega_fwd, hipFuncAttributeMaxDynamicSharedMemorySize, LDS_BYTES) != hipSuccess) { fprintf(stderr, "kernel_launch: hipFuncSetAttribute failed\n"); grid = -1; return; }
        if (hipOccupancyMaxActiveBlocksPerMultiprocessor(&per_cu, (const void*)mega_fwd, NTHR, LDS_BYTES) != hipSuccess || per_cu < 1) { fprintf(stderr, "kernel_launch: occupancy query failed (%d)\n", per_cu); per_cu = 1; }
        (void)hipGetLastError();
        grid = cus * per_cu;
        fprintf(stderr, "kernel_launch: grid %d (%d CUs x %d)\n", grid, cus, per_cu);
    }
    if (grid < 0) return;
    if (hipMemsetAsync((char*)d_ws + WS_BAR, 0, XCD_BAR_WORDS * 4, stream) != hipSuccess) { fprintf(stderr, "kernel_launch: memset of the barrier words failed\n"); return; }
    Args a{};
    for (int i = 0; i < 20; ++i) a.in[i] = (const float*)d_in[i];
    a.out = (float*)d_out; a.ws = (unsigned char*)d_ws;
#if MK_PER_PHASE_LAUNCH
    for (int p = 0; p < NPHASE; ++p) { a.ph_lo = p; a.ph_hi = p + 1; hipLaunchKernelGGL(mega_fwd, dim3(grid), dim3(NTHR), LDS_BYTES, stream, a); }
#else
    a.ph_lo = 0; a.ph_hi = NPHASE;
    void* kargs[] = {&a};
    hipError_t e = hipLaunchCooperativeKernel((const void*)mega_fwd, dim3(grid), dim3(NTHR), kargs, LDS_BYTES, stream);
    if (e != hipSuccess) fprintf(stderr, "kernel_launch: cooperative launch failed: %s (grid %d)\n", hipGetErrorString(e), grid);
#endif
}
```

```cpp
#include <hip/hip_runtime.h>
#include <hip/hip_cooperative_groups.h>
#include <cstdio>
#include <cstdint>
namespace cg = cooperative_groups;

#ifndef MK_PER_PHASE_LAUNCH
#define MK_PER_PHASE_LAUNCH 0
#endif

#ifndef REPEAT_MASK
#define REPEAT_MASK 0
#endif
#define REP(k) ((REPEAT_MASK >> (k)) & 1)
#ifndef TS_SEL
#define TS_SEL -1
#endif

namespace pg8 {
#define PG8_LAS __attribute__((address_space(3)))
typedef unsigned short bf16_t;
typedef short bf16x8 __attribute__((ext_vector_type(8)));
typedef float f32x4 __attribute__((ext_vector_type(4)));
typedef unsigned u32x4 __attribute__((ext_vector_type(4)));
constexpr int BM = 256, BK = 64, HALF = 128, HTB = HALF * BK * 2  , STAGE_BYTES = 8 * HTB, NXCD = 8, WGM = 8;

__host__ __device__ __forceinline__ int lds_byte(int r, int c) { const int st = (r >> 4) * 2 + (c >> 5), rr = r & 15, cc = c & 31, ob = rr * 64 + cc * 2; return st * 1024 + (ob ^ (((ob >> 9) & 1) << 5)); }
__host__ __device__ __forceinline__ void stage_rc(int b, int& R, int& C) { const int st = b / 1024, sb = b % 1024, swz = sb ^ (((sb >> 9) & 1) << 5); R = (st >> 1) * 16 + swz / 64; C = (st & 1) * 32 + (swz % 64) / 2; }
__host__ __device__ __forceinline__ int perm32(int rho) { const int n = rho >> 4, i = rho & 15; return 8 * (i >> 2) + 4 * n + (i & 3); }

struct Unit { int pm, pn; };
struct Gemm { const bf16_t* A; const bf16_t* Bt; int M, N, K; };

struct StaticOrder {
    int nM, nN, nwg, G, c;
    __host__ __device__ void init(int M, int N, int G_, int c_) { nM = M / BM; nN = N / BM; nwg = nM * nN; G = G_; c = c_; }
    __host__ __device__ bool next(int i, Unit& u) const {
        const long L = (long)i * G + c; if (L >= nwg) return false;
        int wgid = (int)L; { const int q = nwg / NXCD, r = nwg % NXCD, xcd = wgid % NXCD, off = wgid / NXCD; wgid = (xcd < r ? xcd * (q + 1) : r * (q + 1) + (xcd - r) * q) + off; }
        const int nig = WGM * nN, gid = wgid / nig, fm = gid * WGM, gsz = (nM - fm) < WGM ? (nM - fm) : WGM;
        u.pm = fm + ((wgid % nig) % gsz); u.pn = (wgid % nig) / gsz; return true;
    }
    __device__ __forceinline__ void a_ready(const Unit&) const {}
    __device__ __forceinline__ void done(const Unit&) const {}
};
__device__ __forceinline__ unsigned cvt_pk_bf16(float lo, float hi) { unsigned r; asm volatile("v_cvt_pk_bf16_f32 %0, %1, %2" : "=v"(r) : "v"(lo), "v"(hi)); return r; }
typedef float f32x2 __attribute__((ext_vector_type(2)));
__device__ __forceinline__ float bflo(unsigned u) { return __uint_as_float(u << 16); }
__device__ __forceinline__ float bfhi(unsigned u) { return __uint_as_float(u & 0xffff0000u); }
__device__ __forceinline__ float sigm(float x) { return 1.0f / (1.0f + __expf(-x)); }

struct EpiZ {
    static constexpr bool PERM = true, AFTER_DRAIN = false;
    bf16_t* O; int ldc; int nt_from;
    __device__ __forceinline__ void operator()(const f32x4 (&acc)[2][2][4][2], const Unit& u, int wr, int wc, int fr, int fq) const {
        const int row0 = u.pm * BM + wr * 64 + fr, col0 = u.pn * BM + wc * 32 + 8 * fq;
        const bool stream = u.pn >= nt_from;
#pragma unroll
        for (int ai = 0; ai < 2; ++ai)
#pragma unroll
            for (int m = 0; m < 4; ++m) { bf16_t* rowp = O + (size_t)(row0 + ai * HALF + m * 16) * ldc + col0;
#pragma unroll
                for (int bj = 0; bj < 2; ++bj) { const f32x4 v0 = acc[ai][bj][m][0], v1 = acc[ai][bj][m][1];
                    u32x4 w; w.x = cvt_pk_bf16(v0[0], v0[1]); w.y = cvt_pk_bf16(v0[2], v0[3]); w.z = cvt_pk_bf16(v1[0], v1[1]); w.w = cvt_pk_bf16(v1[2], v1[3]);
                    if (stream) __builtin_nontemporal_store(w, (u32x4*)(rowp + bj * HALF)); else *(u32x4*)(rowp + bj * HALF) = w; } }
    }
};
template <int MODE> struct EpiGate {
    static constexpr bool PERM = true, AFTER_DRAIN = false;
    bf16_t* O; const bf16_t* Z; int zld; int gcol;
    __device__ __forceinline__ void operator()(const f32x4 (&acc)[2][2][4][2], const Unit& u, int wr, int wc, int fr, int fq) const {
        const int row0 = u.pm * BM + wr * 64 + fr, col0 = u.pn * BM + wc * 32 + 8 * fq;
        u32x4 gn[2], pn[2];
        { const size_t row = (size_t)row0; gn[0] = *(const u32x4*)(Z + row * zld + gcol + col0); gn[1] = *(const u32x4*)(Z + row * zld + gcol + col0 + HALF);
          if (MODE == 1) { pn[0] = *(const u32x4*)(O + row * 1024 + col0); pn[1] = *(const u32x4*)(O + row * 1024 + col0 + HALF); } }
#pragma unroll
        for (int it = 0; it < 8; ++it) { const int ai = it >> 2, m = it & 3; const size_t row = (size_t)(row0 + ai * HALF + m * 16);
            u32x4 gc[2] = {gn[0], gn[1]}, pc[2];
            if (MODE == 1) { pc[0] = pn[0]; pc[1] = pn[1]; }
            if (it < 7) { const size_t rown = (size_t)(row0 + ((it + 1) >> 2) * HALF + ((it + 1) & 3) * 16);
                gn[0] = *(const u32x4*)(Z + rown * zld + gcol + col0); gn[1] = *(const u32x4*)(Z + rown * zld + gcol + col0 + HALF);
                if (MODE == 1) { pn[0] = *(const u32x4*)(O + rown * 1024 + col0); pn[1] = *(const u32x4*)(O + rown * 1024 + col0 + HALF); } }
            bf16_t* op = O + row * 1024 + col0;
#pragma unroll
            for (int bj = 0; bj < 2; ++bj) { const f32x4 v0 = acc[ai][bj][m][0], v1 = acc[ai][bj][m][1]; const u32x4 g = gc[bj];
                float r0 = v0[0] * sigm(bflo(g.x)), r1 = v0[1] * sigm(bfhi(g.x)), r2 = v0[2] * sigm(bflo(g.y)), r3 = v0[3] * sigm(bfhi(g.y));
                float r4 = v1[0] * sigm(bflo(g.z)), r5 = v1[1] * sigm(bfhi(g.z)), r6 = v1[2] * sigm(bflo(g.w)), r7 = v1[3] * sigm(bfhi(g.w));
                if (MODE == 1) { const u32x4 p = pc[bj];
                    r0 += bflo(p.x); r1 += bfhi(p.x); r2 += bflo(p.y); r3 += bfhi(p.y); r4 += bflo(p.z); r5 += bfhi(p.z); r6 += bflo(p.w); r7 += bfhi(p.w); }
                u32x4 w; w.x = cvt_pk_bf16(r0, r1); w.y = cvt_pk_bf16(r2, r3); w.z = cvt_pk_bf16(r4, r5); w.w = cvt_pk_bf16(r6, r7);
                *(u32x4*)(op + bj * HALF) = w; } }
    }
};
struct EpiRes1 {
    static constexpr bool PERM = true, AFTER_DRAIN = false;
    const float* X; bf16_t* XB; float* SS;
    __device__ __forceinline__ void operator()(const f32x4 (&acc)[2][2][4][2], const Unit& u, int wr, int wc, int fr, int fq) const {
        const int row0 = u.pm * BM + wr * 64 + fr, col0 = u.pn * BM + wc * 32 + 8 * fq;
        f32x4 xn[4];
        { const float* xp = X + (size_t)row0 * 1024 + col0; xn[0] = *(const f32x4*)(xp); xn[1] = *(const f32x4*)(xp + 4); xn[2] = *(const f32x4*)(xp + HALF); xn[3] = *(const f32x4*)(xp + HALF + 4); }
#pragma unroll
        for (int it = 0; it < 8; ++it) { const int ai = it >> 2, m = it & 3; const size_t row = (size_t)(row0 + ai * HALF + m * 16); float ssq = 0.f;
            const f32x4 xc[4] = {xn[0], xn[1], xn[2], xn[3]};
            if (it < 7) { const float* xp = X + (size_t)(row0 + ((it + 1) >> 2) * HALF + ((it + 1) & 3) * 16) * 1024 + col0;
                xn[0] = *(const f32x4*)(xp); xn[1] = *(const f32x4*)(xp + 4); xn[2] = *(const f32x4*)(xp + HALF); xn[3] = *(const f32x4*)(xp + HALF + 4); }
#pragma unroll
            for (int bj = 0; bj < 2; ++bj) { const size_t off = row * 1024 + col0 + bj * HALF;
                const f32x4 v0 = acc[ai][bj][m][0] + xc[2 * bj], v1 = acc[ai][bj][m][1] + xc[2 * bj + 1];
                ssq += (v0[0] * v0[0] + v0[1] * v0[1]) + (v0[2] * v0[2] + v0[3] * v0[3]) + (v1[0] * v1[0] + v1[1] * v1[1]) + (v1[2] * v1[2] + v1[3] * v1[3]);
                u32x4 w; w.x = cvt_pk_bf16(v0[0], v0[1]); w.y = cvt_pk_bf16(v0[2], v0[3]); w.z = cvt_pk_bf16(v1[0], v1[1]); w.w = cvt_pk_bf16(v1[2], v1[3]);
                *(u32x4*)(XB + off) = w; }
            ssq += __shfl_xor(ssq, 16); ssq += __shfl_xor(ssq, 32);
            if (fq == 0) atomicAdd(SS + row, ssq); }
    }
};
struct EpiRes2 {
    static constexpr bool PERM = true, AFTER_DRAIN = false;
    bf16_t* XB; float* SS;
    __device__ __forceinline__ void operator()(const f32x4 (&acc)[2][2][4][2], const Unit& u, int wr, int wc, int fr, int fq) const {
        const int row0 = u.pm * BM + wr * 64 + fr, col0 = u.pn * BM + wc * 32 + 8 * fq;
        u32x4 xn[2];
        { const bf16_t* xp = XB + (size_t)row0 * 1024 + col0; xn[0] = *(const u32x4*)(xp); xn[1] = *(const u32x4*)(xp + HALF); }
#pragma unroll
        for (int it = 0; it < 8; ++it) { const int ai = it >> 2, m = it & 3; const size_t row = (size_t)(row0 + ai * HALF + m * 16); float ssq = 0.f;
            const u32x4 xc[2] = {xn[0], xn[1]};
            if (it < 7) { const bf16_t* xp = XB + (size_t)(row0 + ((it + 1) >> 2) * HALF + ((it + 1) & 3) * 16) * 1024 + col0; xn[0] = *(const u32x4*)(xp); xn[1] = *(const u32x4*)(xp + HALF); }
#pragma unroll
            for (int bj = 0; bj < 2; ++bj) { const size_t off = row * 1024 + col0 + bj * HALF;
                const u32x4 xw = xc[bj]; f32x4 v0 = acc[ai][bj][m][0], v1 = acc[ai][bj][m][1];
                v0[0] += bflo(xw.x); v0[1] += bfhi(xw.x); v0[2] += bflo(xw.y); v0[3] += bfhi(xw.y); v1[0] += bflo(xw.z); v1[1] += bfhi(xw.z); v1[2] += bflo(xw.w); v1[3] += bfhi(xw.w);
                u32x4 w; w.x = cvt_pk_bf16(v0[0], v0[1]); w.y = cvt_pk_bf16(v0[2], v0[3]); w.z = cvt_pk_bf16(v1[0], v1[1]); w.w = cvt_pk_bf16(v1[2], v1[3]);
                *(u32x4*)(XB + off) = w;
                ssq += (v0[0] * v0[0] + v0[1] * v0[1]) + (v0[2] * v0[2] + v0[3] * v0[3]) + (v1[0] * v1[0] + v1[1] * v1[1]) + (v1[2] * v1[2] + v1[3] * v1[3]); }
            ssq += __shfl_xor(ssq, 16); ssq += __shfl_xor(ssq, 32);
            if (fq == 0) atomicAdd(SS + row, ssq); }
    }
};
struct EpiHid {
    static constexpr bool PERM = true, AFTER_DRAIN = false;
    bf16_t* O; const float* SS;
    __device__ __forceinline__ void operator()(const f32x4 (&acc)[2][2][4][2], const Unit& u, int wr, int wc, int fr, int fq) const {
        const int row0 = u.pm * BM + wr * 64 + fr, col0 = u.pn * BM + wc * 32 + 8 * fq;
#pragma unroll
        for (int ai = 0; ai < 2; ++ai)
#pragma unroll
            for (int m = 0; m < 4; ++m) { const size_t row = (size_t)(row0 + ai * HALF + m * 16);
                const float s2 = 1.0f / (SS[row] * (1.0f / 1024.0f) + 1e-6f);
                bf16_t* rowp = O + row * 4096 + col0;
#pragma unroll
                for (int bj = 0; bj < 2; ++bj) { f32x4 v0 = acc[ai][bj][m][0], v1 = acc[ai][bj][m][1];
#pragma unroll
                    for (int j = 0; j < 4; ++j) { float a = fmaxf(v0[j], 0.f), b = fmaxf(v1[j], 0.f); v0[j] = a * a * s2; v1[j] = b * b * s2; }
                    u32x4 w; w.x = cvt_pk_bf16(v0[0], v0[1]); w.y = cvt_pk_bf16(v0[2], v0[3]); w.z = cvt_pk_bf16(v1[0], v1[1]); w.w = cvt_pk_bf16(v1[2], v1[3]);
                    *(u32x4*)(rowp + bj * HALF) = w; } }
    }
};

template <class Epi, class Sched, bool ALIGN_EPI = false, bool SP2 = false>
__device__ __forceinline__ void gemm_phase(PG8_LAS unsigned char* lds, const Gemm g, const Sched& S, const Epi& E) {
    const int tid = threadIdx.x, wid = __builtin_amdgcn_readfirstlane(tid >> 6), lane = tid & 63, wr = wid >> 2, wc = wid & 3, fr = lane & 15, fq = lane >> 4;
    const int K = g.K, nt = K / BK;
    unsigned voffA[2], voffB[2];
#pragma unroll
    for (int i = 0; i < 2; ++i) { int R, C; stage_rc(tid * 16 + i * 8192, R, C); const int Rb = Epi::PERM ? ((R & ~31) + perm32(R & 31)) : R;
        voffA[i] = (unsigned)(R * K + C) * 2u; voffB[i] = (unsigned)(Rb * K + C) * 2u; }
    const size_t kstep = (size_t)(BK * 2);
    const size_t hstep = (size_t)HALF * K * 2;
    const size_t tstep = 2 * hstep;
    const unsigned ldsw = (unsigned)wid * 1024u;
    const int aoff = lds_byte(wr * 64 + fr, fq * 8), boff = lds_byte(wc * 32 + fr, fq * 8);
#define PG8_SA(b, h) (((b) * 2 + (h)) * HTB)
#define PG8_SB(b, h) ((4 + (b) * 2 + (h)) * HTB)
#define PG8_STAGE(bufoff, gbase, voff) do { _Pragma("unroll") for (int _i = 0; _i < 2; ++_i) \
        __builtin_amdgcn_global_load_lds((const unsigned*)((const char*)(gbase) + (voff)[_i]), (PG8_LAS unsigned*)(lds + (bufoff) + ldsw + _i * 8192), 16, 0, 0); } while (0)
#define PG8_LDA(dst, b, h) do { _Pragma("unroll") for (int m = 0; m < 4; ++m) _Pragma("unroll") for (int k = 0; k < 2; ++k) dst[m][k] = *(const PG8_LAS bf16x8*)(lds + PG8_SA(b, h) + aoff + m * 2048 + k * 1024); } while (0)
#define PG8_LDB(dst, b, h) do { _Pragma("unroll") for (int n = 0; n < 2; ++n) _Pragma("unroll") for (int k = 0; k < 2; ++k) dst[n][k] = *(const PG8_LAS bf16x8*)(lds + PG8_SB(b, h) + boff + n * 2048 + k * 1024); } while (0)
#define PG8_MMA(ai, bj, At, Bt) do { __builtin_amdgcn_s_setprio(1); _Pragma("unroll") for (int m = 0; m < 4; ++m) _Pragma("unroll") for (int n = 0; n < 2; ++n) _Pragma("unroll") for (int k = 0; k < 2; ++k) \
        acc[ai][bj][m][n] = __builtin_amdgcn_mfma_f32_16x16x32_bf16(Bt[n][k], At[m][k], acc[ai][bj][m][n], 0, 0, 0); __builtin_amdgcn_s_setprio(0); } while (0)
#define PG8_WAIT_V(n) asm volatile("s_waitcnt vmcnt(" #n ")" ::: "memory")
#define PG8_WAIT_L(n) asm volatile("s_waitcnt lgkmcnt(" #n ")" ::: "memory")
#define PG8_BAR __builtin_amdgcn_s_barrier()
#define PG8_SCHED __builtin_amdgcn_sched_barrier(0)
    Unit cur, nxt; int ui = 0;
    if (!S.next(0, cur)) return;
    f32x4 acc[2][2][4][2];
#pragma unroll
    for (int a = 0; a < 2; ++a)
#pragma unroll
        for (int b = 0; b < 2; ++b)
#pragma unroll
            for (int m = 0; m < 4; ++m)
#pragma unroll
                for (int n = 0; n < 2; ++n) acc[a][b][m][n] = (f32x4){0.f, 0.f, 0.f, 0.f};
    bf16x8 At[4][2], B0[2][2], B1[2][2];
    const char* cA = (const char*)g.A + (size_t)cur.pm * tstep; const char* cB = (const char*)g.Bt + (size_t)cur.pn * tstep;
    S.a_ready(cur);
    if constexpr (SP2) {
        PG8_STAGE(PG8_SB(0, 0), cB, voffB); PG8_STAGE(PG8_SB(0, 1), cB + hstep, voffB); PG8_STAGE(PG8_SA(0, 0), cA, voffA); PG8_STAGE(PG8_SA(0, 1), cA + hstep, voffA);
        if (wr == 1) PG8_BAR;
        PG8_WAIT_V(2); PG8_BAR;
        PG8_STAGE(PG8_SB(1, 0), cB + kstep, voffB); PG8_STAGE(PG8_SA(1, 0), cA + kstep, voffA); PG8_STAGE(PG8_SB(1, 1), cB + hstep + kstep, voffB);
        PG8_WAIT_V(6); PG8_BAR;
    } else {
        PG8_STAGE(PG8_SB(0, 0), cB, voffB); PG8_STAGE(PG8_SA(0, 0), cA, voffA); PG8_STAGE(PG8_SB(0, 1), cB + hstep, voffB); PG8_STAGE(PG8_SA(0, 1), cA + hstep, voffA);
        if (wr == 1) PG8_BAR;
        PG8_WAIT_V(4); PG8_BAR;
        PG8_STAGE(PG8_SB(1, 0), cB + kstep, voffB); PG8_STAGE(PG8_SA(1, 0), cA + kstep, voffA); PG8_STAGE(PG8_SB(1, 1), cB + hstep + kstep, voffB);
        PG8_WAIT_V(6); PG8_BAR;
    }
    for (;;) {
        const bool has_next = S.next(ui + 1, nxt);
        const char* nA = has_next ? (const char*)g.A + (size_t)nxt.pm * tstep : cA; const char* nB = has_next ? (const char*)g.Bt + (size_t)nxt.pn * tstep : cB;
        for (int t = 0; t < nt; t += 2) {
            const bool last = (t == nt - 2);
            const char* a1 = cA + (size_t)(t + 1) * kstep;
            const char* a2 = last ? nA : cA + (size_t)(t + 2) * kstep; const char* b2 = last ? nB : cB + (size_t)(t + 2) * kstep;
            const char* a3 = a2 + kstep; const char* b3 = b2 + kstep;
            if (last && has_next) S.a_ready(nxt);
            if constexpr (SP2) {
            PG8_LDB(B0, 0, 0); PG8_LDB(B1, 0, 1); PG8_SCHED; PG8_LDA(At, 0, 0); PG8_STAGE(PG8_SA(1, 1), a1 + hstep, voffA);
            PG8_WAIT_V(8); PG8_WAIT_L(0); PG8_BAR; PG8_MMA(0, 0, At, B0); PG8_MMA(0, 1, At, B1); PG8_BAR; PG8_SCHED;
            PG8_LDA(At, 0, 1); PG8_STAGE(PG8_SB(0, 0), b2, voffB); PG8_STAGE(PG8_SB(0, 1), b2 + hstep, voffB); PG8_STAGE(PG8_SA(0, 0), a2, voffA);
            PG8_WAIT_V(8); PG8_WAIT_L(0); PG8_BAR; PG8_MMA(1, 0, At, B0); PG8_MMA(1, 1, At, B1); PG8_BAR; PG8_SCHED;
            PG8_LDB(B0, 1, 0); PG8_LDB(B1, 1, 1); PG8_SCHED; PG8_LDA(At, 1, 0); PG8_STAGE(PG8_SA(0, 1), a2 + hstep, voffA);
            PG8_WAIT_V(8); PG8_WAIT_L(0); PG8_BAR; PG8_MMA(0, 0, At, B0); PG8_MMA(0, 1, At, B1); PG8_BAR; PG8_SCHED;
            PG8_LDA(At, 1, 1); PG8_STAGE(PG8_SB(1, 0), b3, voffB); PG8_STAGE(PG8_SB(1, 1), b3 + hstep, voffB); PG8_STAGE(PG8_SA(1, 0), a3, voffA);
            PG8_WAIT_V(8); PG8_WAIT_L(0); PG8_BAR; PG8_MMA(1, 0, At, B0); PG8_MMA(1, 1, At, B1); PG8_BAR; PG8_SCHED;
            } else {
            PG8_LDB(B0, 0, 0); PG8_SCHED; PG8_LDA(At, 0, 0); PG8_STAGE(PG8_SA(1, 1), a1 + hstep, voffA);
            PG8_WAIT_L(8); PG8_BAR; PG8_WAIT_L(0); PG8_MMA(0, 0, At, B0); PG8_BAR; PG8_SCHED;
            PG8_LDB(B1, 0, 1); PG8_STAGE(PG8_SB(0, 0), b2, voffB);
            PG8_BAR; PG8_WAIT_L(0); PG8_MMA(0, 1, At, B1); PG8_BAR;
            PG8_LDA(At, 0, 1); PG8_STAGE(PG8_SA(0, 0), a2, voffA);
            PG8_BAR; PG8_WAIT_L(0); PG8_MMA(1, 0, At, B0); PG8_BAR; PG8_SCHED;
            PG8_STAGE(PG8_SB(0, 1), b2 + hstep, voffB);
            PG8_WAIT_V(6); PG8_BAR; PG8_MMA(1, 1, At, B1); PG8_BAR;
            PG8_LDB(B0, 1, 0); PG8_SCHED; PG8_LDA(At, 1, 0); PG8_STAGE(PG8_SA(0, 1), a2 + hstep, voffA);
            PG8_WAIT_L(8); PG8_BAR; PG8_WAIT_L(0); PG8_MMA(0, 0, At, B0); PG8_BAR; PG8_SCHED;
            PG8_LDB(B1, 1, 1); PG8_STAGE(PG8_SB(1, 0), b3, voffB);
            PG8_BAR; PG8_WAIT_L(0); PG8_MMA(0, 1, At, B1); PG8_BAR;
            PG8_LDA(At, 1, 1); PG8_STAGE(PG8_SA(1, 0), a3, voffA);
            PG8_BAR; PG8_WAIT_L(0); PG8_MMA(1, 0, At, B0); PG8_BAR; PG8_SCHED;
            PG8_STAGE(PG8_SB(1, 1), b3 + hstep, voffB);
            PG8_WAIT_V(6); PG8_BAR; PG8_MMA(1, 1, At, B1); PG8_BAR;
            }
        }
        if constexpr (ALIGN_EPI) { if (wr == 0) PG8_BAR; }
        if constexpr (!Epi::AFTER_DRAIN) { E(acc, cur, wr, wc, fr, fq); S.done(cur); }
        if (!has_next) break;
#pragma unroll
        for (int a = 0; a < 2; ++a)
#pragma unroll
            for (int b = 0; b < 2; ++b)
#pragma unroll
                for (int m = 0; m < 4; ++m)
#pragma unroll
                    for (int n = 0; n < 2; ++n) acc[a][b][m][n] = (f32x4){0.f, 0.f, 0.f, 0.f};
        cur = nxt; cA = nA; cB = nB; ++ui;
        if constexpr (ALIGN_EPI) { if (wr == 1) PG8_BAR; }
    }
    PG8_WAIT_V(0);
    if constexpr (!ALIGN_EPI) { if (wr == 0) PG8_BAR; }
    PG8_BAR;
    if constexpr (Epi::AFTER_DRAIN) { E.fused(acc, cur, wr, wc, fr, fq, lds, wid, lane); S.done(cur); }
#undef PG8_SA
#undef PG8_SB
#undef PG8_STAGE
#undef PG8_LDA
#undef PG8_LDB
#undef PG8_MMA
#undef PG8_WAIT_V
#undef PG8_WAIT_L
#undef PG8_BAR
#undef PG8_SCHED
}
}
extern __shared__ __attribute__((aligned(16))) unsigned char g_lds[];
using pg8::bf16_t; using pg8::bf16x8; using pg8::f32x4; using pg8::u32x4; using pg8::cvt_pk_bf16; using pg8::bflo; using pg8::bfhi; using pg8::sigm;

constexpr int NTOK = 32768, DM = 1024, SEQ = 2048, NB = 16, ZLD = 5120, NTHR = 512;
constexpr int C_R = 0, C_K = 512, C_V = 1024, C_WD = 1536, C_AD = 1600, C_GD = 1664;
constexpr int C_Q = 1824, C_KA = 2336, C_VA = 2400, C_QI = 2464, C_KI = 2976, C_WI = 3040, C_G0 = 3048, C_G1 = 4072;
constexpr size_t MiB = 1024 * 1024;
constexpr size_t WS_SS1 = 0, WS_SS2 = 128 * 1024, WS_BONUS = 256 * 1024, WS_ROPE = 1280 * 1024, WS_WD = 1792 * 1024, WS_WI = 1856 * 1024, WS_WG = 1920 * 1024;
constexpr size_t WS_WIN = 4 * MiB, WS_WUP = 14 * MiB, WS_WDN = 22 * MiB, WS_WB = 30 * MiB, WS_WO = 32 * MiB, WS_VT = 34 * MiB, WS_H = 38 * MiB, WS_Z = 102 * MiB, WS_P = 422 * MiB, WS_END = 486 * MiB;
constexpr int LDS_BYTES = 163840;

struct Args { const float* in[20]; float* out; unsigned char* ws; int ph_lo, ph_hi; };

struct Frame {
    const float* in[20]; float* out; unsigned char* ws; unsigned char* lds; int tid, lane, wave;
    float *ss1, *ss2, *bonus; float2* rope; bf16_t *wd, *wi, *wg, *win, *wup, *wdn, *wb, *wo, *vt, *h, *ya, *yb, *xb, *z, *hid, *lw, *ic, *mg, *gt; float* yraw;
};

__device__ __forceinline__ bf16_t f2bf(float f) { return (bf16_t)(cvt_pk_bf16(f, 0.f) & 0xffffu); }
__device__ __forceinline__ float bf2f(bf16_t b) { return __uint_as_float(((unsigned)b) << 16); }
template <int CTRL> __device__ __forceinline__ float dpp_mov(float x) { return __int_as_float(__builtin_amdgcn_update_dpp(0, __float_as_int(x), CTRL, 0xF, 0xF, true)); }
__device__ __forceinline__ float red16(float x) { x += dpp_mov<0xB1>(x); x += dpp_mov<0x4E>(x); x += dpp_mov<0x141>(x); x += dpp_mov<0x140>(x); return x; }


__device__ __forceinline__ void lds_barrier() { asm volatile("s_waitcnt lgkmcnt(0)" ::: "memory"); __builtin_amdgcn_s_barrier(); asm volatile("" ::: "memory"); }
__device__ __forceinline__ void red16x4(float& a, float& b, float& c, float& d) {
#define DPP4(ctl) "v_add_f32_dpp %0, %0, %0 " ctl " row_mask:0xf bank_mask:0xf bound_ctrl:1\n" "v_add_f32_dpp %1, %1, %1 " ctl " row_mask:0xf bank_mask:0xf bound_ctrl:1\n" \
                  "v_add_f32_dpp %2, %2, %2 " ctl " row_mask:0xf bank_mask:0xf bound_ctrl:1\n" "v_add_f32_dpp %3, %3, %3 " ctl " row_mask:0xf bank_mask:0xf bound_ctrl:1\n"
    asm volatile("s_nop 1\n" DPP4("quad_perm:[1,0,3,2]") DPP4("quad_perm:[2,3,0,1]") DPP4("row_half_mirror") DPP4("row_mirror") : "+v"(a), "+v"(b), "+v"(c), "+v"(d));
#undef DPP4
}
__device__ __forceinline__ float red32(float x) { x += __shfl_xor(x, 1); x += __shfl_xor(x, 2); x += __shfl_xor(x, 4); x += __shfl_xor(x, 8); x += __shfl_xor(x, 16); return x; }
__device__ __forceinline__ float red64(float x) { x = red32(x); x += __shfl_xor(x, 32); return x; }
__device__ __forceinline__ float softplus_f(float x) { return fmaxf(x, 0.f) + log1pf(__expf(-fabsf(x))); }

__device__ __forceinline__ void tconv(const Frame& F, const float* __restrict__ W, int K, int N, int Npad, bf16_t* __restrict__ Wt, const float* __restrict__ rs) {
    float* tile = (float*)g_lds;
    const int ktn = (K + 63) / 64, ntn = Npad / 64, tid = F.tid;
    for (int tl = blockIdx.x; tl < ktn * ntn; tl += gridDim.x) {
        const int kt = tl % ktn, nt = tl / ktn;
#pragma unroll
        for (int i = 0; i < 2; ++i) { const int idx = tid + i * NTHR, kk = idx >> 4, n4 = (idx & 15) * 4, k = kt * 64 + kk, n = nt * 64 + n4;
            f32x4 v = {0.f, 0.f, 0.f, 0.f};
            if (k < K) { if (n + 3 < N) v = *(const f32x4*)(W + (size_t)k * N + n); else { for (int j = 0; j < 4; ++j) if (n + j < N) v[j] = W[(size_t)k * N + n + j]; }
                if (rs != nullptr) { const float r = rs[k]; v[0] *= r; v[1] *= r; v[2] *= r; v[3] *= r; } }
            tile[kk * 65 + n4] = v[0]; tile[kk * 65 + n4 + 1] = v[1]; tile[kk * 65 + n4 + 2] = v[2]; tile[kk * 65 + n4 + 3] = v[3]; }
        __syncthreads();
        { const int nn = tid >> 3, k8 = (tid & 7) * 8, k = kt * 64 + k8, n = nt * 64 + nn;
          if (k < K) { u32x4 w; const float* tp = tile + k8 * 65 + nn;
              w.x = cvt_pk_bf16(tp[0], tp[65]); w.y = cvt_pk_bf16(tp[130], tp[195]); w.z = cvt_pk_bf16(tp[260], tp[325]); w.w = cvt_pk_bf16(tp[390], tp[455]);
              *(u32x4*)(Wt + (size_t)n * K + k) = w; } }
        __syncthreads();
    }
}
__device__ __forceinline__ void p0_prologue(const Frame& F) {
    const int tid = F.tid, gtid = blockIdx.x * NTHR + tid, gn = gridDim.x * NTHR;
    for (int i = gtid; i < 2 * NTOK; i += gn) F.ss1[i] = 0.f;
    for (int i = gtid; i < SEQ * 32; i += gn) { const int pos = i >> 5, j = i & 31;
        const float inv = 1.0f / powf(10000.0f, (float)(2 * j) / 64.0f); const float ang = (float)pos * inv;
        double rev = (double)ang * 0.15915494309189535; rev -= floor(rev); const float fr = (float)rev;
        F.rope[i] = make_float2(__builtin_amdgcn_cosf(fr), __builtin_amdgcn_sinf(fr)); }
    tconv(F, F.in[2], 1024, 5096, 5120, F.win, nullptr);
    tconv(F, F.in[17], 1024, 4096, 4096, F.wup, F.in[16]);
    tconv(F, F.in[18], 4096, 1024, 1024, F.wdn, nullptr);
    tconv(F, F.in[14], 512, 1024, 1024, F.wb, nullptr);
    tconv(F, F.in[14] + 512 * 1024, 512, 1024, 1024, F.wb + 1024 * 512, nullptr);
    tconv(F, F.in[15], 1024, 1024, 1024, F.wo, nullptr);
    tconv(F, F.in[5], 64, 512, 512, F.wd, nullptr);
    tconv(F, F.in[7], 64, 512, 512, F.wi, nullptr);
    tconv(F, F.in[8], 160, 512, 512, F.wg, nullptr);
    const float* x = F.in[0]; const float* g = F.in[1]; const int lane = F.lane;
    const int rstep = gridDim.x * 8;
    f32x4 gq[4];
#pragma unroll
    for (int i = 0; i < 4; ++i) gq[i] = *(const f32x4*)(g + (i >> 1) * 512 + lane * 8 + (i & 1) * 4);
    for (int row = blockIdx.x * 8 + F.wave; row < NTOK; row += 2 * rstep) {
        const int row2 = (row + rstep) < NTOK ? row + rstep : row; const bool two = row2 != row;
        const float* xr = x + (size_t)row * DM; const float* xr2 = x + (size_t)row2 * DM; f32x4 v[4], u[4]; float ss = 0.f, ss2 = 0.f;
#pragma unroll
        for (int i = 0; i < 4; ++i) { v[i] = __builtin_nontemporal_load((const f32x4*)(xr + (i >> 1) * 512 + lane * 8 + (i & 1) * 4)); u[i] = __builtin_nontemporal_load((const f32x4*)(xr2 + (i >> 1) * 512 + lane * 8 + (i & 1) * 4)); }
#pragma unroll
        for (int i = 0; i < 4; ++i) { ss += v[i][0] * v[i][0] + v[i][1] * v[i][1] + v[i][2] * v[i][2] + v[i][3] * v[i][3]; ss2 += u[i][0] * u[i][0] + u[i][1] * u[i][1] + u[i][2] * u[i][2] + u[i][3] * u[i][3]; }
        ss = red64(ss); ss2 = red64(ss2); const float sc = rsqrtf(ss * (1.0f / 1024.0f) + 1e-6f), sc2 = rsqrtf(ss2 * (1.0f / 1024.0f) + 1e-6f);
#pragma unroll
        for (int i = 0; i < 2; ++i) { const f32x4 a = v[2 * i] * gq[2 * i] * sc, b2 = v[2 * i + 1] * gq[2 * i + 1] * sc, a2 = u[2 * i] * gq[2 * i] * sc2, b3 = u[2 * i + 1] * gq[2 * i + 1] * sc2; u32x4 w, w2;
            w.x = cvt_pk_bf16(a[0], a[1]); w.y = cvt_pk_bf16(a[2], a[3]); w.z = cvt_pk_bf16(b2[0], b2[1]); w.w = cvt_pk_bf16(b2[2], b2[3]);
            w2.x = cvt_pk_bf16(a2[0], a2[1]); w2.y = cvt_pk_bf16(a2[2], a2[3]); w2.z = cvt_pk_bf16(b3[0], b3[1]); w2.w = cvt_pk_bf16(b3[2], b3[3]);
            *(u32x4*)(F.h + (size_t)row * DM + i * 512 + lane * 8) = w; if (two) *(u32x4*)(F.h + (size_t)row2 * DM + i * 512 + lane * 8) = w2; }
    }
}

__device__ __forceinline__ void p2_prep(const Frame& F, const int mode) {
    const int tid = F.tid, lane = F.lane, wave = F.wave, fr = lane & 15, fq = lane >> 4;
    bf16_t* z = F.z; const float* mu = F.in[3];
    if (mode != 2) {
        constexpr int LDA = 296, TT = 32; bf16_t* At = (bf16_t*)g_lds;
        bf16_t* Ot = At + TT * LDA;
        const float* dbias = F.in[4]; const float* ibias = F.in[6];
        for (int tile = blockIdx.x; tile < NTOK / TT; tile += gridDim.x) {
            const int t0 = tile * TT;
            for (int idx = tid; idx < TT * 36; idx += NTHR) { const int tok = idx / 36, c8 = (idx - tok * 36) * 8, t = t0 + tok, col = C_WD + c8;
                const u32x4 zc = *(const u32x4*)(z + (size_t)t * ZLD + col); u32x4 zp = {0u, 0u, 0u, 0u}; if (t & (SEQ - 1)) zp = *(const u32x4*)(z + (size_t)(t - 1) * ZLD + col);
                const f32x4 m0 = *(const f32x4*)(mu + col), m1 = *(const f32x4*)(mu + col + 4);
                float v[8]; const unsigned zcu[4] = {zc.x, zc.y, zc.z, zc.w}, zpu[4] = {zp.x, zp.y, zp.z, zp.w};
#pragma unroll
                for (int j = 0; j < 4; ++j) { const float a = bflo(zcu[j]), b2 = bfhi(zcu[j]), pa = bflo(zpu[j]), pb = bfhi(zpu[j]);
                    const float mm0 = (j < 2) ? m0[2 * j] : m1[2 * j - 4], mm1 = (j < 2) ? m0[2 * j + 1] : m1[2 * j - 3];
                    v[2 * j] = a + (pa - a) * mm0; v[2 * j + 1] = b2 + (pb - b2) * mm1; }
                if (c8 < 64) {
#pragma unroll
                    for (int j = 0; j < 8; ++j) v[j] = tanhf(v[j]); }
                else if (c8 >= 128) {
#pragma unroll
                    for (int j = 0; j < 8; ++j) v[j] = sigm(v[j]); }
                u32x4 w; w.x = cvt_pk_bf16(v[0], v[1]); w.y = cvt_pk_bf16(v[2], v[3]); w.z = cvt_pk_bf16(v[4], v[5]); w.w = cvt_pk_bf16(v[6], v[7]);
                *(u32x4*)(At + tok * LDA + c8) = w; }
            __syncthreads();
            const int h = wave;
            bf16x8 Bc[9], Bn[9];
            { const int n = h * 64 + fr;
#pragma unroll
              for (int ks = 0; ks < 2; ++ks) { Bc[ks] = *(const bf16x8*)(F.wd + n * 64 + ks * 32 + fq * 8); Bc[2 + ks] = *(const bf16x8*)(F.wi + n * 64 + ks * 32 + fq * 8); }
#pragma unroll
              for (int ks = 0; ks < 5; ++ks) Bc[4 + ks] = *(const bf16x8*)(F.wg + n * 160 + ks * 32 + fq * 8); }
#pragma unroll 1
            for (int j = 0; j < 4; ++j) { const int n = h * 64 + j * 16 + fr;
                if (j < 3) { const int nn = n + 16;
#pragma unroll
                    for (int ks = 0; ks < 2; ++ks) { Bn[ks] = *(const bf16x8*)(F.wd + nn * 64 + ks * 32 + fq * 8); Bn[2 + ks] = *(const bf16x8*)(F.wi + nn * 64 + ks * 32 + fq * 8); }
#pragma unroll
                    for (int ks = 0; ks < 5; ++ks) Bn[4 + ks] = *(const bf16x8*)(F.wg + nn * 160 + ks * 32 + fq * 8); }
                const float db = dbias[n], ib = ibias[n];
#pragma unroll
                for (int mt = 0; mt < 2; ++mt) {
                    f32x4 ad = {0.f, 0.f, 0.f, 0.f}, ai = ad, ag = ad; const bf16_t* ap = At + (mt * 16 + fr) * LDA + fq * 8;
#pragma unroll
                    for (int ks = 0; ks < 2; ++ks) ad = __builtin_amdgcn_mfma_f32_16x16x32_bf16(*(const bf16x8*)(ap + ks * 32), Bc[ks], ad, 0, 0, 0);
#pragma unroll
                    for (int ks = 0; ks < 2; ++ks) ai = __builtin_amdgcn_mfma_f32_16x16x32_bf16(*(const bf16x8*)(ap + 64 + ks * 32), Bc[2 + ks], ai, 0, 0, 0);
#pragma unroll
                    for (int ks = 0; ks < 5; ++ks) ag = __builtin_amdgcn_mfma_f32_16x16x32_bf16(*(const bf16x8*)(ap + 128 + ks * 32), Bc[4 + ks], ag, 0, 0, 0);
#pragma unroll
                    for (int jj = 0; jj < 4; ++jj) {
                        const float dw = db + ad[jj]; const float wlog = -softplus_f(-dw) - 0.5f; const float lwv = -__expf(wlog);
                        const int tk = mt * 16 + fq * 4 + jj; Ot[tk * 520 + n] = f2bf(lwv); Ot[(TT + tk) * 520 + n] = f2bf(sigm(ib + ai[jj])); Ot[(2 * TT + tk) * 520 + n] = f2bf(ag[jj]); }
                }
#pragma unroll
                for (int q = 0; q < 9; ++q) Bc[q] = Bn[q];
            }
            __syncthreads();
#pragma unroll
            for (int i = 0; i < 12; ++i) { const int idx = tid + i * NTHR, arr = idx >> 11, rem = idx & 2047, tk = rem >> 6, c8 = (rem & 63) * 8;
                const u32x4 w = *(const u32x4*)(Ot + (arr * TT + tk) * 520 + c8); bf16_t* dst = arr == 0 ? F.lw : (arr == 1 ? F.ic : F.gt);
                __builtin_nontemporal_store(w, (u32x4*)(dst + (size_t)(t0 + tk) * 512 + c8)); }
            __syncthreads();
        }
    }
    if (mode != 2) {
        unsigned short* tl = (unsigned short*)g_lds;
        for (int tile = blockIdx.x; tile < NTOK / 64; tile += gridDim.x) { const int t0 = tile * 64, b = t0 / SEQ, tt0 = t0 % SEQ;
            { const int tok = tid >> 3, d8 = (tid & 7) * 8; *(u32x4*)(tl + tok * 72 + d8) = *(const u32x4*)(z + (size_t)(t0 + tok) * ZLD + C_VA + d8); }
            __syncthreads();
            { const int d = tid >> 3, k8 = (tid & 7) * 8; unsigned short e[8];
#pragma unroll
              for (int j = 0; j < 8; ++j) e[j] = tl[(k8 + j) * 72 + d];
              u32x4 w; w.x = e[0] | ((unsigned)e[1] << 16); w.y = e[2] | ((unsigned)e[3] << 16); w.z = e[4] | ((unsigned)e[5] << 16); w.w = e[6] | ((unsigned)e[7] << 16);
              *(u32x4*)(F.vt + ((size_t)b * 64 + d) * SEQ + tt0 + k8) = w; }
            __syncthreads();
        }
    }
    if (mode != 0) {
        const int gtid = blockIdx.x * NTHR + tid, gn = gridDim.x * NTHR;
        for (int idx = gtid; idx < NTOK * 72; idx += gn) { const int t = idx / 72, p = idx - t * 72, hd = p >> 2, i8 = (p & 3) * 8;
            const int base = hd < 8 ? C_Q + hd * 64 : (hd == 8 ? C_KA : (hd < 17 ? C_QI + (hd - 9) * 64 : C_KI));
            const float* rp = (const float*)&F.rope[(t & (SEQ - 1)) * 32 + i8];
            f32x4 cs[4];
#pragma unroll
            for (int j = 0; j < 4; ++j) { cs[j] = *(const f32x4*)(rp + 4 * j); if (mode == 2) cs[j] = (f32x4){1.f, 0.f, 1.f, 0.f}; }
            bf16_t* p1 = z + (size_t)t * ZLD + base + i8; const u32x4 a = *(const u32x4*)(p1), b2 = *(const u32x4*)(p1 + 32);
            const unsigned au[4] = {a.x, a.y, a.z, a.w}, bu[4] = {b2.x, b2.y, b2.z, b2.w}; unsigned o1[4], o2[4];
#pragma unroll
            for (int j = 0; j < 4; ++j) { const float x1a = bflo(au[j]), x1b = bfhi(au[j]), x2a = bflo(bu[j]), x2b = bfhi(bu[j]);
                o1[j] = cvt_pk_bf16(x1a * cs[j][0] - x2a * cs[j][1], x1b * cs[j][2] - x2b * cs[j][3]);
                o2[j] = cvt_pk_bf16(x2a * cs[j][0] + x1a * cs[j][1], x2b * cs[j][2] + x1b * cs[j][3]); }
            u32x4 w1, w2; w1.x = o1[0]; w1.y = o1[1]; w1.z = o1[2]; w1.w = o1[3]; w2.x = o2[0]; w2.y = o2[1]; w2.z = o2[2]; w2.w = o2[3];
            *(u32x4*)(p1) = w1; *(u32x4*)(p1 + 32) = w2; }
    }
}

struct ScanRaw { uint2 zr_c, zr_p, zk_c, zk_p, zv_c, zv_p, lwu, icu; };
struct ScanConst { f32x4 mur, muk, muv, kk, ka, rk; };
__device__ __forceinline__ void scan_load(ScanRaw& R, const bf16_t* z, const bf16_t* lw, const bf16_t* ic, size_t tokbase, int ch, int ptok, int gc) {
    const int t = ch * 16 + ptok; const size_t T = tokbase + t; const bf16_t* zp = z + T * ZLD + gc;
    R.zr_c = *(const uint2*)(zp + C_R); R.zk_c = *(const uint2*)(zp + C_K); R.zv_c = *(const uint2*)(zp + C_V);
    const uint2 zz = make_uint2(0u, 0u);
    if (t > 0) { R.zr_p = *(const uint2*)(zp - ZLD + C_R); R.zk_p = *(const uint2*)(zp - ZLD + C_K); R.zv_p = *(const uint2*)(zp - ZLD + C_V); } else { R.zr_p = zz; R.zk_p = zz; R.zv_p = zz; }
    R.lwu = *(const uint2*)(lw + T * 512 + gc); R.icu = *(const uint2*)(ic + T * 512 + gc);
}
__device__ __forceinline__ f32x4 unpack4(uint2 u) { f32x4 r; r[0] = bflo(u.x); r[1] = bfhi(u.x); r[2] = bflo(u.y); r[3] = bfhi(u.y); return r; }
__device__ __forceinline__ void scan_prep(const ScanRaw& R, const ScanConst& C, float* ops, float* vv, float* bonus_out, bool wr_bonus, int ptok, int pc, int v0) {
    const f32x4 rc = unpack4(R.zr_c), rp = unpack4(R.zr_p), kc = unpack4(R.zk_c), kp = unpack4(R.zk_p), vc = unpack4(R.zv_c), vp = unpack4(R.zv_p), ic = unpack4(R.icu), lw = unpack4(R.lwu);
    const f32x4 r = rc + (rp - rc) * C.mur, k = kc + (kp - kc) * C.muk, vs = vc + (vp - vc) * C.muv;
    f32x4 w; w[0] = __expf(lw[0]); w[1] = __expf(lw[1]); w[2] = __expf(lw[2]); w[3] = __expf(lw[3]);
    const f32x4 q = k * C.kk; const float ss = red16((q[0] * q[0] + q[1] * q[1]) + (q[2] * q[2] + q[3] * q[3]));
    const float inv = 1.0f / fmaxf(sqrtf(ss), 1e-12f); const f32x4 n = q * inv;
    const f32x4 kn = k * (1.0f + (ic - 1.0f) * C.ka);
    const f32x4 bt = r * kn * C.rk; const float bon = red16((bt[0] + bt[1]) + (bt[2] + bt[3]));
    if (wr_bonus) *bonus_out = bon;
    float* op = ops + ptok * 320 + pc;
    *(f32x4*)(op) = -n; *(f32x4*)(op + 64) = w; *(f32x4*)(op + 128) = n * ic; *(f32x4*)(op + 192) = kn; *(f32x4*)(op + 256) = r;
    if (pc >= v0 && pc < v0 + 32) *(f32x4*)(vv + ptok * 32 + pc - v0) = vs;
}
__device__ __forceinline__ void p3_scan(const Frame& F, const int mode) {
    const int tid = F.tid;
    float* opsb = (float*)g_lds;
    float* vvb = opsb + 2 * 5120;
    float* yob = vvb + 2 * 512;
    const bf16_t* z = F.z; const float* mu = F.in[3]; const float* k_k = F.in[9]; const float* k_a = F.in[10]; const float* r_k = F.in[11];
    for (int item = blockIdx.x; item < 256; item += gridDim.x) {
        const int bh = item >> 1, half = item & 1, b = bh >> 3, h = bh & 7, v0 = half * 32;
        const size_t tokbase = (size_t)b * SEQ;
        if (F.wave >= 4) {
            const int pt = tid - 256, ptok = pt >> 4, pc = (pt & 15) * 4, gc = h * 64 + pc;
            ScanConst C; C.mur = *(const f32x4*)(mu + C_R + gc); C.muk = *(const f32x4*)(mu + C_K + gc); C.muv = *(const f32x4*)(mu + C_V + gc);
            C.kk = *(const f32x4*)(k_k + gc); C.ka = *(const f32x4*)(k_a + gc); C.rk = *(const f32x4*)(r_k + gc);
            const bool wrb = (half == 0) && ((pt & 15) == 0);
            ScanRaw R;
            scan_load(R, z, F.lw, F.ic, tokbase, 0, ptok, gc);
            scan_prep(R, C, opsb, vvb, F.bonus + (tokbase + ptok) * 8 + h, wrb, ptok, pc, v0);
            scan_load(R, z, F.lw, F.ic, tokbase, 1, ptok, gc);
            lds_barrier();
            for (int ch = 0; ch < SEQ / 16; ++ch) {
                const int cur = ch & 1, nxt = cur ^ 1;
                if (mode != 2) {
                if (ch > 0) { const int tok = pt >> 4, r2 = (pt & 15) * 2;
                    typedef float f32x2v __attribute__((ext_vector_type(2))); const float2 yv = *(const float2*)(yob + nxt * 512 + tok * 32 + r2); const f32x2v y2 = {yv.x, yv.y}; __builtin_nontemporal_store(y2, (f32x2v*)(F.yraw + (tokbase + (ch - 1) * 16 + tok) * 512 + h * 64 + v0 + r2)); }
                if (ch + 1 < SEQ / 16) {
                    scan_prep(R, C, opsb + nxt * 5120, vvb + nxt * 512, F.bonus + (tokbase + (ch + 1) * 16 + ptok) * 8 + h, wrb, ptok, pc, v0);
                    if (ch + 2 < SEQ / 16) scan_load(R, z, F.lw, F.ic, tokbase, ch + 2, ptok, gc);
                } }
                lds_barrier();
            }
            { const int tok = pt >> 4, r2 = (pt & 15) * 2;
              typedef float f32x2v __attribute__((ext_vector_type(2))); const float2 yv = *(const float2*)(yob + 512 + tok * 32 + r2); const f32x2v y2 = {yv.x, yv.y}; __builtin_nontemporal_store(y2, (f32x2v*)(F.yraw + (tokbase + (SEQ / 16 - 1) * 16 + tok) * 512 + h * 64 + v0 + r2)); }
        } else {
            const int rp = tid >> 4, ks = tid & 15;
            float A0 = 0.f, A1 = 0.f, A2 = 0.f, A3 = 0.f, B0 = 0.f, B1 = 0.f, B2 = 0.f, B3 = 0.f;
            const int ywoff = (ks == 0) ? 2 * rp : (2 * 512 + 2 * tid), ywstep = (ks == 0) ? 32 : 0;
            lds_barrier();
            f32x4 rprev = {0.f, 0.f, 0.f, 0.f}; float* ywp = yob + 2 * 512 + 2 * tid;
            for (int ch = 0; ch < SEQ / 16; ++ch) {
                const int cur = ch & 1;
                const float* ops = opsb + cur * 5120 + ks * 4; const float* vv = vvb + cur * 512 + 2 * rp; float* yw = yob + cur * 512 + ywoff;
                if (mode != 1) {
#pragma unroll
                for (int s = 0; s < 16; ++s) {
                    const float* o = ops + s * 320;
                    const f32x4 a4 = *(const f32x4*)(o), w4 = *(const f32x4*)(o + 64), b4 = *(const f32x4*)(o + 128), k4 = *(const f32x4*)(o + 192), r4 = *(const f32x4*)(o + 256);
                    const float2 vab = *(const float2*)(vv + s * 32);
                    float sa = (A0 * a4[0] + A1 * a4[1]) + (A2 * a4[2] + A3 * a4[3]); float sb = (B0 * a4[0] + B1 * a4[1]) + (B2 * a4[2] + B3 * a4[3]);
                    float ya = (A0 * rprev[0] + A1 * rprev[1]) + (A2 * rprev[2] + A3 * rprev[3]); float yb2 = (B0 * rprev[0] + B1 * rprev[1]) + (B2 * rprev[2] + B3 * rprev[3]);
                    red16x4(sa, sb, ya, yb2);
                    *(float2*)(ywp) = make_float2(ya, yb2);
                    ywp = yw + s * ywstep;
                    A0 = A0 * w4[0] + sa * b4[0] + vab.x * k4[0]; A1 = A1 * w4[1] + sa * b4[1] + vab.x * k4[1];
                    A2 = A2 * w4[2] + sa * b4[2] + vab.x * k4[2]; A3 = A3 * w4[3] + sa * b4[3] + vab.x * k4[3];
                    B0 = B0 * w4[0] + sb * b4[0] + vab.y * k4[0]; B1 = B1 * w4[1] + sb * b4[1] + vab.y * k4[1];
                    B2 = B2 * w4[2] + sb * b4[2] + vab.y * k4[2]; B3 = B3 * w4[3] + sb * b4[3] + vab.y * k4[3];
                    rprev = r4;
                }
                {
                    float ya = (A0 * rprev[0] + A1 * rprev[1]) + (A2 * rprev[2] + A3 * rprev[3]); float yb2 = (B0 * rprev[0] + B1 * rprev[1]) + (B2 * rprev[2] + B3 * rprev[3]);
                    float d0 = 0.f, d1 = 0.f; red16x4(ya, yb2, d0, d1);
                    *(float2*)(ywp) = make_float2(ya, yb2); ywp = yob + 2 * 512 + 2 * tid; rprev = (f32x4){0.f, 0.f, 0.f, 0.f};
                } }
                lds_barrier();
            }
        }
        __syncthreads();
    }
}

__device__ __forceinline__ unsigned ordkey(float f) { const unsigned u = __float_as_uint(f); return (u & 0x80000000u) ? ~u : (u | 0x80000000u); }

__device__ __forceinline__ void attn_chunk(const unsigned char* kb, const unsigned char* vb, const unsigned* selm, int c, int p, int fr, int fq, const bf16x8 (&Bqa)[2][2], f32x4 (&O)[2][4], f32x4 (&RS)[2]) {
    const f32x4 zero4 = {0.f, 0.f, 0.f, 0.f};
    const u32x4 onesu = {0x3f803f80u, 0x3f803f80u, 0x3f803f80u, 0x3f803f80u}; const bf16x8 ones = __builtin_bit_cast(bf16x8, onesu);
    const float csc = 0.125f * 1.4426950408889634f;
    const unsigned char* k0p = kb + ((2 * p) * 16 + fr) * 144 + fq * 16; const unsigned char* k1p = k0p + 16 * 144;
    const bf16x8 KA00 = *(const bf16x8*)(k0p), KA01 = *(const bf16x8*)(k0p + 64), KA10 = *(const bf16x8*)(k1p), KA11 = *(const bf16x8*)(k1p + 64);
    const int mw = (int)selm[fr * 64 + 2 * c + p];
    bf16x8 VA[4];
#pragma unroll
    for (int dt = 0; dt < 4; ++dt) { const unsigned char* vp = vb + (dt * 16 + fr) * 144 + (2 * p) * 32 + fq * 8;
        const uint2 lo = *(const uint2*)(vp), hi = *(const uint2*)(vp + 32);
        u32x4 va; va.x = lo.x; va.y = lo.y; va.z = hi.x; va.w = hi.y; VA[dt] = __builtin_bit_cast(bf16x8, va); }
    unsigned km0[4], km1[4];
#pragma unroll
    for (int jj = 0; jj < 4; ++jj) { km0[jj] = (unsigned)__builtin_amdgcn_sbfe(mw, fq * 4 + jj, 1); km1[jj] = (unsigned)__builtin_amdgcn_sbfe(mw, 16 + fq * 4 + jj, 1); }
#pragma unroll
    for (int hh = 0; hh < 2; ++hh) {
        f32x4 s0 = __builtin_amdgcn_mfma_f32_16x16x32_bf16(KA00, Bqa[hh][0], zero4, 0, 0, 0); s0 = __builtin_amdgcn_mfma_f32_16x16x32_bf16(KA01, Bqa[hh][1], s0, 0, 0, 0);
        f32x4 s1 = __builtin_amdgcn_mfma_f32_16x16x32_bf16(KA10, Bqa[hh][0], zero4, 0, 0, 0); s1 = __builtin_amdgcn_mfma_f32_16x16x32_bf16(KA11, Bqa[hh][1], s1, 0, 0, 0);
        unsigned p0[4], p1[4];
#pragma unroll
        for (int jj = 0; jj < 4; ++jj) {
            p0[jj] = __float_as_uint(__builtin_amdgcn_exp2f(fminf(s0[jj] * csc, 86.f))) & km0[jj]; p1[jj] = __float_as_uint(__builtin_amdgcn_exp2f(fminf(s1[jj] * csc, 86.f))) & km1[jj]; }
        u32x4 pk; pk.x = cvt_pk_bf16(__uint_as_float(p0[0]), __uint_as_float(p0[1])); pk.y = cvt_pk_bf16(__uint_as_float(p0[2]), __uint_as_float(p0[3]));
        pk.z = cvt_pk_bf16(__uint_as_float(p1[0]), __uint_as_float(p1[1])); pk.w = cvt_pk_bf16(__uint_as_float(p1[2]), __uint_as_float(p1[3]));
        const bf16x8 PB = __builtin_bit_cast(bf16x8, pk);
        RS[hh] = __builtin_amdgcn_mfma_f32_16x16x32_bf16(ones, PB, RS[hh], 0, 0, 0);
#pragma unroll
        for (int dt = 0; dt < 4; ++dt) O[hh][dt] = __builtin_amdgcn_mfma_f32_16x16x32_bf16(VA[dt], PB, O[hh][dt], 0, 0, 0);
    }
}

__device__ __forceinline__ void p3_dsa(const Frame& F) {
    const int tid = F.tid, lane = F.lane, wave = F.wave, fr = lane & 15, fq = lane >> 4;
    unsigned* scl = (unsigned*)g_lds;
    unsigned* selm = (unsigned*)(g_lds + 131328);
    unsigned char* kbuf = (unsigned char*)g_lds;
    unsigned char* vbuf = kbuf + 2 * 9216;
    const bf16_t* z = F.z; const int G = gridDim.x, bx = blockIdx.x;
    const f32x4 zero4 = {0.f, 0.f, 0.f, 0.f};
    for (int rnd = 0; rnd * G < 2048; ++rnd) {
        const int n = rnd * G + ((rnd & 1) ? (G - 1 - bx) : bx);
        if (n >= 2048) continue;
        const int qg = 127 - (n >> 4), b = n & 15, q0 = qg * 16; const size_t Tb = (size_t)b * SEQ;
        for (int i = tid; i < 1024; i += NTHR) selm[i] = 0u;
        __syncthreads();
        const bf16_t* zq = z + (Tb + q0 + fr) * ZLD;
        const unsigned lofk = (unsigned)((fr * ZLD + fq * 8) * 2), lofv = (unsigned)((fr * SEQ + fq * 4) * 2);
        const int nchunk = (qg + 4) >> 2; const int lrow = tid >> 3, lseg = tid & 7;
        const bf16_t* kg = z + (Tb + lrow) * ZLD + C_KA + lseg * 8; const bf16_t* vg = F.vt + ((size_t)b * 64 + lrow) * SEQ + lseg * 8;
        const unsigned lst = (unsigned)(lrow * 144 + lseg * 16);
        const int hp = wave >> 1, kh = wave & 1;
        const u32x4 kc0 = *(const u32x4*)(kg), vc0 = *(const u32x4*)(vg);
        u32x4 kx = kc0, vx = vc0, ky = kc0, vy = vc0;
        if (1 < nchunk) { kx = *(const u32x4*)(kg + (size_t)64 * ZLD); vx = *(const u32x4*)(vg + 64); }
        if (2 < nchunk) { ky = *(const u32x4*)(kg + (size_t)128 * ZLD); vy = *(const u32x4*)(vg + 128); }
        bf16x8 Bqa[2][2];
#pragma unroll
        for (int hh = 0; hh < 2; ++hh)
#pragma unroll
            for (int ks = 0; ks < 2; ++ks) Bqa[hh][ks] = *(const bf16x8*)(zq + C_Q + (2 * hp + hh) * 64 + ks * 32 + fq * 8);
        if (qg >= 16) {
            const u32x4 wv = *(const u32x4*)(zq + C_WI);
            {
                bf16x8 Bq[8][2];
#pragma unroll
                for (int hh = 0; hh < 8; ++hh)
#pragma unroll
                    for (int ks = 0; ks < 2; ++ks) Bq[hh][ks] = *(const bf16x8*)(zq + C_QI + hh * 64 + ks * 32 + fq * 8);
                const float sc = 0.044194173824159216f;
                float wih[8]; wih[0] = bflo(wv.x) * sc; wih[1] = bfhi(wv.x) * sc; wih[2] = bflo(wv.y) * sc; wih[3] = bfhi(wv.y) * sc; wih[4] = bflo(wv.z) * sc; wih[5] = bfhi(wv.z) * sc; wih[6] = bflo(wv.w) * sc; wih[7] = bfhi(wv.w) * sc;
#pragma unroll 1
                for (int half = 0; half < 2; ++half) {
                    const int ktb = wave + 64 * half; if (ktb > qg) break;
                    bf16x8 W0[2], W1[2];
#pragma unroll
                    for (int j = 0; j < 2; ++j) { const int ktj = (ktb + 8 * j) < qg ? (ktb + 8 * j) : qg; const char* kb = (const char*)(z + (Tb + (size_t)ktj * 16) * ZLD + C_KI);
                        W0[j] = *(const bf16x8*)(kb + lofk); W1[j] = *(const bf16x8*)(kb + lofk + 64); }
#pragma unroll
                    for (int i = 0; i < 8; ++i) { const int kt = ktb + 8 * i;
                        if (kt <= qg) { f32x4 sv = zero4;
#pragma unroll
                            for (int hh = 0; hh < 8; ++hh) { f32x4 acc = __builtin_amdgcn_mfma_f32_16x16x32_bf16(W0[i & 1], Bq[hh][0], zero4, 0, 0, 0);
                                acc = __builtin_amdgcn_mfma_f32_16x16x32_bf16(W1[i & 1], Bq[hh][1], acc, 0, 0, 0);
#pragma unroll
                                for (int jj = 0; jj < 4; ++jj) sv[jj] += wih[hh] * fmaxf(acc[jj], 0.f); }
                            u32x4 w; w.x = ordkey(sv[0]); w.y = ordkey(sv[1]); w.z = ordkey(sv[2]); w.w = ordkey(sv[3]);
                            *(u32x4*)(scl + fr * 2052 + kt * 16 + fq * 4) = w;
                        }
                        if (i + 2 < 8) { const int ktn = (kt + 16) < qg ? (kt + 16) : qg; const char* kb = (const char*)(z + (Tb + (size_t)ktn * 16) * ZLD + C_KI);
                            unsigned lo2 = lofk; asm volatile("" : "+v"(lo2));
                            W0[i & 1] = *(const bf16x8*)(kb + lo2); W1[i & 1] = *(const bf16x8*)(kb + lo2 + 64); }
                    }
                }
            }
            __syncthreads();
#pragma unroll 1
            for (int qq = 0; qq < 2; ++qq) {
                const int q = 2 * wave + qq, qpos = q0 + q;
                unsigned uk[32];
#pragma unroll
                for (int r = 0; r < 32; ++r) { const int key = r * 64 + lane; uk[r] = 0x007fffffu;
                    if (r * 64 <= qpos) { const unsigned v = scl[q * 2052 + key]; uk[r] = (key <= qpos) ? v : 0x007fffffu; } }
                unsigned T = 0u; bool exact = false;
#pragma unroll 1
                for (int bit = 31; bit >= 0; --bit) {
                    const unsigned cand = T | (1u << bit); int c = 0;
#pragma unroll
                    for (int g = 0; g < 4; ++g) {
                        if (g * 512 > qpos) break;
                        unsigned long long m[8];
                        asm("v_cmp_ge_u32_e64 %0, %8, %16\n\tv_cmp_ge_u32_e64 %1, %9, %16\n\tv_cmp_ge_u32_e64 %2, %10, %16\n\tv_cmp_ge_u32_e64 %3, %11, %16\n\t"
                            "v_cmp_ge_u32_e64 %4, %12, %16\n\tv_cmp_ge_u32_e64 %5, %13, %16\n\tv_cmp_ge_u32_e64 %6, %14, %16\n\tv_cmp_ge_u32_e64 %7, %15, %16"
                            : "=&s"(m[0]), "=&s"(m[1]), "=&s"(m[2]), "=&s"(m[3]), "=&s"(m[4]), "=&s"(m[5]), "=&s"(m[6]), "=&s"(m[7])
                            : "v"(uk[g * 8 + 0]), "v"(uk[g * 8 + 1]), "v"(uk[g * 8 + 2]), "v"(uk[g * 8 + 3]), "v"(uk[g * 8 + 4]), "v"(uk[g * 8 + 5]), "v"(uk[g * 8 + 6]), "v"(uk[g * 8 + 7]), "v"(cand));
#pragma unroll
                        for (int j = 0; j < 8; ++j) c += __builtin_popcountll(m[j]);
                    }
                    if (c >= 256) { T = cand; if (c == 256) { exact = true; break; } }
                }
                int need = 0;
                if (!exact) { int c = 0;
#pragma unroll
                    for (int r = 0; r < 32; ++r) c += __builtin_popcountll(__builtin_amdgcn_ballot_w64(uk[r] > T));
                    need = 256 - c; }
#pragma unroll
                for (int r = 0; r < 32; ++r) {
                    if (r * 64 <= qpos) {
                        unsigned long long sel;
                        if (exact) sel = __builtin_amdgcn_ballot_w64(uk[r] >= T);
                        else { sel = __builtin_amdgcn_ballot_w64(uk[r] > T); unsigned long long e = __builtin_amdgcn_ballot_w64(uk[r] == T);
                            const int ne = __builtin_popcountll(e);
                            if (ne <= need) { sel |= e; need -= ne; }
                            else { for (int k = 0; k < need; ++k) { const unsigned long long lb = e & (0ull - e); sel |= lb; e ^= lb; } need = 0; } }
                        if (lane == 0) { selm[q * 64 + 2 * r] = (unsigned)sel; selm[q * 64 + 2 * r + 1] = (unsigned)(sel >> 32); }
                    }
                }
            }
        } else {
            for (int w = tid; w < 1024; w += NTHR) { const int q = w >> 6, word = w & 63, qpos = q0 + q, lo = word * 32;
                selm[w] = (qpos >= lo + 31) ? 0xffffffffu : (qpos < lo ? 0u : ((2u << (qpos - lo)) - 1u)); }
        }
        __syncthreads();
        {
            *(u32x4*)(kbuf + lst) = kc0; *(u32x4*)(vbuf + lst) = vc0;
            f32x4 O[2][4]; f32x4 rs[2];
#pragma unroll
            for (int hh = 0; hh < 2; ++hh) { rs[hh] = zero4;
#pragma unroll
                for (int dt = 0; dt < 4; ++dt) O[hh][dt] = zero4; }
            lds_barrier();
#pragma unroll 1
            for (int c = 0; c < nchunk; c += 2) {
                attn_chunk(kbuf, vbuf, selm, c, kh, fr, fq, Bqa, O, rs);
                if (c + 1 < nchunk) { *(u32x4*)(kbuf + 9216 + lst) = kx; *(u32x4*)(vbuf + 9216 + lst) = vx; }
                if (c + 3 < nchunk) { kx = *(const u32x4*)(kg + (size_t)(c + 3) * 64 * ZLD); vx = *(const u32x4*)(vg + (c + 3) * 64); }
                lds_barrier();
                if (c + 1 < nchunk) {
                    attn_chunk(kbuf + 9216, vbuf + 9216, selm, c + 1, kh, fr, fq, Bqa, O, rs);
                    if (c + 2 < nchunk) { *(u32x4*)(kbuf + lst) = ky; *(u32x4*)(vbuf + lst) = vy; }
                    if (c + 4 < nchunk) { ky = *(const u32x4*)(kg + (size_t)(c + 4) * 64 * ZLD); vy = *(const u32x4*)(vg + (c + 4) * 64); }
                    lds_barrier();
                }
            }
            float* xb = (float*)(vbuf + 2 * 9216) + (size_t)wave * (64 * 17);
            { const int oh = kh ^ 1;
#pragma unroll
              for (int dt = 0; dt < 4; ++dt)
#pragma unroll
                  for (int jj = 0; jj < 4; ++jj) xb[(dt * 4 + jj) * 64 + lane] = (oh == 0) ? O[0][dt][jj] : O[1][dt][jj];
              xb[16 * 64 + lane] = (oh == 0) ? rs[0][0] : rs[1][0]; }
            lds_barrier();
            { const float* pb = (const float*)(vbuf + 2 * 9216) + (size_t)(wave ^ 1) * (64 * 17);
              float tot = ((kh == 0) ? rs[0][0] : rs[1][0]) + pb[16 * 64 + lane];
              const float inv = 1.0f / tot;
              bf16_t* yp = F.yb + (Tb + q0 + fr) * 512 + (2 * hp + kh) * 64 + fq * 4;
#pragma unroll
              for (int dt = 0; dt < 4; ++dt) { float o[4];
#pragma unroll
                  for (int jj = 0; jj < 4; ++jj) o[jj] = (((kh == 0) ? O[0][dt][jj] : O[1][dt][jj]) + pb[(dt * 4 + jj) * 64 + lane]) * inv;
                  uint2 w; w.x = cvt_pk_bf16(o[0], o[1]); w.y = cvt_pk_bf16(o[2], o[3]); *(uint2*)(yp + dt * 16) = w; } }
        }
        __syncthreads();
    }
}

struct P4In { f32x4 y; uint2 vc, vp, gt; float bon; };
__device__ __forceinline__ void p4_load(P4In& I, const Frame& F, int g, int c) { const size_t t = (size_t)(g >> 3); const bf16_t* z = F.z;
    I.y = __builtin_nontemporal_load((const f32x4*)(F.yraw + t * 512 + c)); I.vc = *(const uint2*)(z + t * ZLD + C_V + c); I.vp = make_uint2(0u, 0u); if (t & (SEQ - 1)) I.vp = *(const uint2*)(z + (t - 1) * ZLD + C_V + c);
    { typedef unsigned u32x2v __attribute__((ext_vector_type(2))); const u32x2v gv = __builtin_nontemporal_load((const u32x2v*)(F.gt + t * 512 + c)); I.gt = make_uint2(gv.x, gv.y); } I.bon = F.bonus[t * 8 + (g & 7)]; }
__device__ __forceinline__ void p4_finish(const P4In& I, const Frame& F, int g, int c, const f32x4& m4, const f32x4& w4, const f32x4& b4) { const size_t t = (size_t)(g >> 3);
    const f32x4 y = I.y; const float mean = red16((y[0] + y[1]) + (y[2] + y[3])) * (1.0f / 64.0f); const f32x4 d = y - mean;
    const float var = red16((d[0] * d[0] + d[1] * d[1]) + (d[2] * d[2] + d[3] * d[3])) * (1.0f / 64.0f); const float rstd = rsqrtf(var + 64e-5f);
    f32x4 vcf, vpf, gtf; vcf[0] = bflo(I.vc.x); vcf[1] = bfhi(I.vc.x); vcf[2] = bflo(I.vc.y); vcf[3] = bfhi(I.vc.y); vpf[0] = bflo(I.vp.x); vpf[1] = bfhi(I.vp.x); vpf[2] = bflo(I.vp.y); vpf[3] = bfhi(I.vp.y);
    gtf[0] = bflo(I.gt.x); gtf[1] = bfhi(I.gt.x); gtf[2] = bflo(I.gt.y); gtf[3] = bfhi(I.gt.y);
    const f32x4 vs = vcf + (vpf - vcf) * m4; const f32x4 o = (d * rstd * w4 + b4 + vs * I.bon) * gtf;
    uint2 w; w.x = cvt_pk_bf16(o[0], o[1]); w.y = cvt_pk_bf16(o[2], o[3]); *(uint2*)(F.ya + t * 512 + c) = w; }
__device__ __forceinline__ void p4_post(const Frame& F) {
    const int tid = F.tid; const float* mu = F.in[3]; const float* gnw = F.in[12]; const float* gnb = F.in[13];
    const int gstep = gridDim.x * 32, g0 = blockIdx.x * 32 + (tid >> 4), c = (g0 & 7) * 64 + (tid & 15) * 4;
    const f32x4 m4 = *(const f32x4*)(mu + C_V + c), w4 = *(const f32x4*)(gnw + c), b4 = *(const f32x4*)(gnb + c);
    for (int g = g0; g < NTOK * 8; g += 2 * gstep) { const int g2 = g + gstep; const bool two = g2 < NTOK * 8;
        P4In A, B; p4_load(A, F, g, c); if (two) p4_load(B, F, g2, c);
        p4_finish(A, F, g, c, m4, w4, b4); if (two) p4_finish(B, F, g2, c, m4, w4, b4); }
}

__device__ __forceinline__ void p9_final(const Frame& F, const bool ident) {
    const float* g = F.in[19]; const int lane = F.lane; const int rstep = gridDim.x * 8;
    f32x4 gg[4];
#pragma unroll
    for (int i = 0; i < 4; ++i) gg[i] = *(const f32x4*)(g + (i >> 1) * 512 + lane * 8 + (i & 1) * 4);
    for (int row = blockIdx.x * 8 + F.wave; row < NTOK; row += 2 * rstep) {
        const int row2 = (row + rstep) < NTOK ? row + rstep : row; const bool two = row2 != row;
        u32x4 a[2], b[2];
#pragma unroll
        for (int i = 0; i < 2; ++i) { a[i] = __builtin_nontemporal_load((const u32x4*)(F.xb + (size_t)row * DM + i * 512 + lane * 8)); b[i] = __builtin_nontemporal_load((const u32x4*)(F.xb + (size_t)row2 * DM + i * 512 + lane * 8)); }
        const float sc = ident ? 1.0f : rsqrtf(F.ss2[row] * (1.0f / 1024.0f) + 1e-6f), sc2 = ident ? 1.0f : rsqrtf(F.ss2[row2] * (1.0f / 1024.0f) + 1e-6f);
#pragma unroll
        for (int i = 0; i < 2; ++i) {
            f32x4 v0, v1, u0, u1;
            v0[0] = bflo(a[i].x); v0[1] = bfhi(a[i].x); v0[2] = bflo(a[i].y); v0[3] = bfhi(a[i].y); v1[0] = bflo(a[i].z); v1[1] = bfhi(a[i].z); v1[2] = bflo(a[i].w); v1[3] = bfhi(a[i].w);
            u0[0] = bflo(b[i].x); u0[1] = bfhi(b[i].x); u0[2] = bflo(b[i].y); u0[3] = bfhi(b[i].y); u1[0] = bflo(b[i].z); u1[1] = bfhi(b[i].z); u1[2] = bflo(b[i].w); u1[3] = bfhi(b[i].w);
            if (!ident) { v0 = v0 * gg[2 * i] * sc; v1 = v1 * gg[2 * i + 1] * sc; u0 = u0 * gg[2 * i] * sc2; u1 = u1 * gg[2 * i + 1] * sc2; }
            float* o1 = F.out + (size_t)row * DM + i * 512 + lane * 8; float* o2 = F.out + (size_t)row2 * DM + i * 512 + lane * 8;
            __builtin_nontemporal_store(v0, (f32x4*)o1); __builtin_nontemporal_store(v1, (f32x4*)(o1 + 4));
            if (two) { __builtin_nontemporal_store(u0, (f32x4*)o2); __builtin_nontemporal_store(u1, (f32x4*)(o2 + 4)); } }
    }
}
#define XB_TMO      128
#define XB_XCNT(j)  (256  + 64 * (j))
#define XB_XSUB(j)  (1280 + 64 * (j))
#define XB_XGEN(j)  (2304 + 64 * (j))
#define XB_TOP      3328
#define XB_TOPGEN   3392
#define XCD_BAR_WORDS 3456
#define XB_SPIN_CAP (1u << 18)
#define LAS __attribute__((address_space(3)))

__device__ __forceinline__ unsigned xb_ld(unsigned* p)              { return __hip_atomic_load(p, __ATOMIC_RELAXED, __HIP_MEMORY_SCOPE_AGENT); }
__device__ __forceinline__ unsigned xb_add(unsigned* p, unsigned v) { return __hip_atomic_fetch_add(p, v, __ATOMIC_RELAXED, __HIP_MEMORY_SCOPE_AGENT); }
__device__ __forceinline__ unsigned xb_xcc_id() { return (unsigned)__builtin_amdgcn_s_getreg((3 << 11) | 20) & 0xFu; }
#define XB_SPIN(cond, bar) do { unsigned _sp = 0; while (cond) { __builtin_amdgcn_s_sleep(1); \
    if ((++_sp & 255u) == 0u) { if (xb_ld(&(bar)[XB_TMO])) break; if (_sp > XB_SPIN_CAP) { atomicAdd(&(bar)[XB_TMO], 1u); break; } } } } while (0)

struct XcdBarrier {
    unsigned* bar; unsigned x;
    volatile LAS unsigned* st;
};

__device__ __forceinline__ XcdBarrier xcd_barrier_post(unsigned* bar, volatile LAS unsigned* st) {
    XcdBarrier b; b.bar = bar; b.x = xb_xcc_id(); b.st = st;
    if (threadIdx.x == 0) (void)xb_add(&bar[XB_XCNT(b.x)], 1u);
    return b;
}
__device__ __forceinline__ void xcd_barrier_complete(unsigned* bar, unsigned x, unsigned& nloc, unsigned& nx) {
    const unsigned G = gridDim.x * gridDim.y * gridDim.z;
    unsigned sum, cnt, mine, sp = 0u;
    for (;;) {
        sum = 0u; cnt = 0u; mine = 0u;
#pragma unroll
        for (unsigned j = 0; j < 16; ++j) { const unsigned c = xb_ld(&bar[XB_XCNT(j)]); sum += c; cnt += (c > 0u) ? 1u : 0u; mine = (j == x) ? c : mine; }
        if (sum == G) break;
        __builtin_amdgcn_s_sleep(1);
        if ((++sp & 255u) == 0u) { if (xb_ld(&bar[XB_TMO])) break; if (sp > XB_SPIN_CAP) { atomicAdd(&bar[XB_TMO], 1u); break; } }
    }
    nloc = mine > 0u ? mine : 1u; nx = cnt > 0u ? cnt : 1u;
}

__device__ __forceinline__ void xcd_barrier(const XcdBarrier& b) {
    asm volatile("s_waitcnt vmcnt(0)" ::: "memory");
    __syncthreads();
    if (threadIdx.x == 0) {
        unsigned* bar = b.bar;
        __builtin_amdgcn_s_waitcnt(0);
        unsigned nloc = b.st[0], nx = b.st[1];
        if (nloc == 0u) { xcd_barrier_complete(bar, b.x, nloc, nx); b.st[0] = nloc; b.st[1] = nx; }
        const unsigned old = xb_add(&bar[XB_XSUB(b.x)], 1u);
        const unsigned gen = old / nloc;
        if (old + 1u == (gen + 1u) * nloc) {
            __builtin_amdgcn_fence(__ATOMIC_RELEASE, "agent");
            asm volatile("s_waitcnt vmcnt(0)" ::: "memory");
            const unsigned og = xb_add(&bar[XB_TOP], 1u);
            const unsigned tg = og / nx;
            if (og + 1u == (tg + 1u) * nx) xb_add(&bar[XB_TOPGEN], 1u);
            else XB_SPIN(xb_ld(&bar[XB_TOPGEN]) == tg, bar);
            __builtin_amdgcn_fence(__ATOMIC_ACQUIRE, "agent");
            xb_add(&bar[XB_XGEN(b.x)], 1u);
            asm volatile("s_waitcnt vmcnt(0)" ::: "memory");
        } else {
            XB_SPIN(xb_ld(&bar[XB_XGEN(b.x)]) == gen, bar);
            __builtin_amdgcn_fence(__ATOMIC_ACQUIRE, "agent");
            asm volatile("s_waitcnt vmcnt(0)" ::: "memory");
        }
    }
    __syncthreads();
}
#ifndef PHASE_MASK
#define PHASE_MASK 0x3ff
#endif
#ifndef GEMM_ALIGN
#define GEMM_ALIGN true
#endif
#ifndef GEMM_SP2
#define GEMM_SP2 true
#endif
constexpr int NPHASE = 10;
constexpr size_t WS_BAR = 3 * MiB;
template <class Epi> __device__ __forceinline__ void run_gemm(const bf16_t* A, const bf16_t* Bt, int N, int K, const Epi& E) {
    pg8::Gemm g{A, Bt, NTOK, N, K}; pg8::StaticOrder S; S.init(NTOK, N, (int)gridDim.x, (int)blockIdx.x);
    pg8::gemm_phase<Epi, pg8::StaticOrder, GEMM_ALIGN, GEMM_SP2>((PG8_LAS unsigned char*)g_lds, g, S, E);
}
__global__ void __launch_bounds__(NTHR, 2) mega_fwd(Args args) {
    Frame F;
#pragma unroll
    for (int i = 0; i < 20; ++i) F.in[i] = args.in[i];
    F.out = args.out; F.ws = args.ws; F.lds = nullptr; F.tid = threadIdx.x; F.lane = F.tid & 63; F.wave = __builtin_amdgcn_readfirstlane(F.tid >> 6);
    unsigned char* ws = args.ws;
    F.ss1 = (float*)(ws + WS_SS1); F.ss2 = (float*)(ws + WS_SS2); F.bonus = (float*)(ws + WS_BONUS); F.rope = (float2*)(ws + WS_ROPE);
    F.wd = (bf16_t*)(ws + WS_WD); F.wi = (bf16_t*)(ws + WS_WI); F.wg = (bf16_t*)(ws + WS_WG);
    F.win = (bf16_t*)(ws + WS_WIN); F.wup = (bf16_t*)(ws + WS_WUP); F.wdn = (bf16_t*)(ws + WS_WDN); F.wb = (bf16_t*)(ws + WS_WB); F.wo = (bf16_t*)(ws + WS_WO); F.vt = (bf16_t*)(ws + WS_VT);
    F.h = (bf16_t*)(ws + WS_H); F.ya = F.h; F.yb = F.h + (size_t)NTOK * 512; F.xb = F.h;
    F.z = (bf16_t*)(ws + WS_Z); F.hid = F.z;
    F.lw = (bf16_t*)(ws + WS_P); F.ic = F.lw + (size_t)NTOK * 512; F.mg = F.lw;
    F.yraw = args.out; F.gt = (bf16_t*)(args.out + (size_t)NTOK * 512);
    const int lo = args.ph_lo, hi = args.ph_hi;
    cg::grid_group grid = cg::this_grid();
    if (args.ph_lo < 0) grid.sync();
    volatile LAS unsigned* xst = (volatile LAS unsigned*)(g_lds + LDS_BYTES - 64);
    if (threadIdx.x == 0) { xst[0] = 0u; xst[1] = 0u; }
    __syncthreads();
    XcdBarrier xbar = xcd_barrier_post((unsigned*)(ws + WS_BAR), xst);
#define IN(k) (lo <= (k) && (k) < hi)
#define SEAM(k) do { if (IN(k) && IN((k) + 1)) { xcd_barrier(xbar); if (REP(17)) xcd_barrier(xbar); } } while (0)
    if (((PHASE_MASK >> 0) & 1) && IN(0)) { p0_prologue(F); __syncthreads(); if (REP(0)) { p0_prologue(F); __syncthreads(); } } SEAM(0);
    if (((PHASE_MASK >> 1) & 1) && IN(1)) { pg8::EpiZ E{F.z, ZLD, 12}; run_gemm(F.h, F.win, 5120, 1024, E); __syncthreads(); if (REP(1)) { run_gemm(F.h, F.win, 5120, 1024, E); __syncthreads(); } if (REP(18)) { run_gemm(F.h, F.win, 4096, 1024, E); __syncthreads(); } } SEAM(1);
    if (((PHASE_MASK >> 2) & 1) && IN(2)) { if (REP(2)) { p2_prep(F, 0); __syncthreads(); } if (REP(16)) { p2_prep(F, 2); __syncthreads(); } p2_prep(F, 1); __syncthreads(); } SEAM(2);
    if (((PHASE_MASK >> 3) & 1) && IN(3)) { if (REP(14)) { p3_scan(F, 1); __syncthreads(); } if (REP(15)) { p3_scan(F, 2); __syncthreads(); } if (REP(3)) { p3_scan(F, 0); __syncthreads(); } p3_scan(F, 0); __syncthreads(); p3_dsa(F); __syncthreads(); if (REP(10)) { p3_dsa(F); __syncthreads(); } } SEAM(3);
    if (((PHASE_MASK >> 4) & 1) && IN(4)) { p4_post(F); __syncthreads(); if (REP(4)) { p4_post(F); __syncthreads(); } } SEAM(4);
    if (((PHASE_MASK >> 5) & 1) && IN(5)) { pg8::EpiGate<0> E0{F.mg, F.z, ZLD, C_G0}; run_gemm(F.ya, F.wb, 1024, 512, E0); __syncthreads();
                 pg8::EpiGate<1> E1{F.mg, F.z, ZLD, C_G1}; run_gemm(F.yb, F.wb + 1024 * 512, 1024, 512, E1); __syncthreads();
                 if (REP(5)) { run_gemm(F.ya, F.wb, 1024, 512, E0); __syncthreads(); run_gemm(F.yb, F.wb + 1024 * 512, 1024, 512, E1); __syncthreads(); } } SEAM(5);
    if (((PHASE_MASK >> 6) & 1) && IN(6)) { if (REP(6)) { pg8::EpiRes1 Ex{F.in[0], F.xb, F.bonus}; run_gemm(F.mg, F.wo, 1024, 1024, Ex); __syncthreads(); }
                 pg8::EpiRes1 E{F.in[0], F.xb, F.ss1}; run_gemm(F.mg, F.wo, 1024, 1024, E); __syncthreads(); } SEAM(6);
    if (((PHASE_MASK >> 7) & 1) && IN(7)) { pg8::EpiHid E{F.hid, F.ss1}; run_gemm(F.xb, F.wup, 4096, 1024, E); __syncthreads(); if (REP(7)) { run_gemm(F.xb, F.wup, 4096, 1024, E); __syncthreads(); } } SEAM(7);
    if (((PHASE_MASK >> 8) & 1) && IN(8)) { pg8::EpiRes2 E{F.xb, F.ss2}; run_gemm(F.hid, F.wdn, 1024, 4096, E); __syncthreads(); } SEAM(8);
    if (((PHASE_MASK >> 9) & 1) && IN(9)) { if (REP(9)) { p9_final(F, true); __syncthreads(); } p9_final(F, false); }
#undef IN
#undef SEAM
}

extern "C" void kernel_launch(void* const* d_in, const int* in_sizes, int n_in, void* d_out, int out_size, void* d_ws, size_t ws_size, hipStream_t stream) {
    static int grid = 0;
    if (grid == 0) {
        if (n_in != 20 || out_size != NTOK * DM || ws_size < WS_END) { fprintf(stderr, "kernel_launch: unexpected shapes (n_in %d, out %d, ws %zu < %zu)\n", n_in, out_size, ws_size, (size_t)WS_END); grid = -1; return; }
        int dev = 0, cus = 0, per_cu = 0;
        hipGetDevice(&dev); hipDeviceGetAttribute(&cus, hipDeviceAttributeMultiprocessorCount, dev);
        if (hipFuncSetAttribute((const void*)mega_fwd, hipFuncAttributeMaxDynamicSharedMemorySize, LDS_BYTES) != hipSuccess) { fprintf(stderr, "kernel_launch: hipFuncSetAttribute failed\n"); grid = -1; return; }
        if (hipOccupancyMaxActiveBlocksPerMultiprocessor(&per_cu, (const void*)mega_fwd, NTHR, LDS_BYTES) != hipSuccess || per_cu < 1) { fprintf(stderr, "kernel_launch: occupancy query failed (%d)\n", per_cu); per_cu = 1; }
        (void)hipGetLastError();
        grid = cus * per_cu;
        fprintf(stderr, "kernel_launch: grid %d (%d CUs x %d)\n", grid, cus, per_cu);
    }
    if (grid < 0) return;
    if (hipMemsetAsync((char*)d_ws + WS_BAR, 0, XCD_BAR_WORDS * 4, stream) != hipSuccess) { fprintf(stderr, "kernel_launch: memset of the barrier words failed\n"); return; }
    Args a{};
    for (int i = 0; i < 20; ++i) a.in[i] = (const float*)d_in[i];
    a.out = (float*)d_out; a.ws = (unsigned char*)d_ws;
#if MK_PER_PHASE_LAUNCH
    for (int p = 0; p < NPHASE; ++p) { a.ph_lo = p; a.ph_hi = p + 1; hipLaunchKernelGGL(mega_fwd, dim3(grid), dim3(NTHR), LDS_BYTES, stream, a); }
#else
    a.ph_lo = 0; a.ph_hi = NPHASE;
    void* kargs[] = {&a};
    hipError_t e = hipLaunchCooperativeKernel((const void*)mega_fwd, dim3(grid), dim3(NTHR), kargs, LDS_BYTES, stream);
    if (e != hipSuccess) fprintf(stderr, "kernel_launch: cooperative launch failed: %s (grid %d)\n", hipGetErrorString(e), grid);
#endif
}
```
